# Optimizing an MI355X kernel written in HIP

```python
import jax, jax.numpy as jnp
from jax import lax
import numpy as np

D_MODEL = 2048
BATCH = 8
SEQ = 2048
DEPTH = 1

HEAD_DIM = 128
N_HEADS_A = 8
N_HEADS_B = 8
D_A = N_HEADS_A * HEAD_DIM
D_B = N_HEADS_B * HEAD_DIM
D_MIX = D_A + D_B
IDX_HEADS = 16
IDX_DIM = 64
DSA_TOPK_MAX = 256
MOBA_BLOCK = 256
MOBA_TOPK_MAX = 3
DSA_Q_CHUNK = 64
MOBA_Q_CHUNK = 16
RMS_EPS = 1e-6
NEG_INF = -1e30

COL_WIDTHS = [D_A, D_A, D_A, D_A,
              IDX_HEADS * IDX_DIM, IDX_DIM, IDX_HEADS,
              D_B, D_B, D_B, D_B]
D_IN = sum(COL_WIDTHS)
COL_SPLITS = [int(s) for s in np.cumsum(COL_WIDTHS)[:-1]]

kernel_name = "hybrid_dsa_moba_adaln_block"


def _rms_norm(x, g):
    xf = x.astype(jnp.float32)
    y = xf * lax.rsqrt(jnp.mean(xf * xf, axis=-1, keepdims=True) + RMS_EPS)
    return (y * g.astype(jnp.float32)).astype(x.dtype)


def _alibi_slopes(n):
    return jnp.asarray(2.0 ** (-8.0 * np.arange(1, n + 1) / n), dtype=jnp.float32)


def _dsa_attention(q, k, v, q_idx, k_idx, w_idx, slopes):
    B, L, H, Dh = q.shape
    top_k = min(DSA_TOPK_MAX, L // 4)
    n_chunks = L // DSA_Q_CHUNK
    key_pos = jnp.arange(L)
    gather = jax.vmap(lambda t, i: t[i])

    def to_chunks(t):
        return jnp.swapaxes(t.reshape((B, n_chunks, DSA_Q_CHUNK) + t.shape[2:]), 0, 1)

    def chunk_fn(args):
        start, qc, qic, wc = args
        q_pos = start + jnp.arange(DSA_Q_CHUNK)
        logits = jnp.einsum('bqhd,bsd->bqhs', qic, k_idx).astype(jnp.float32) * IDX_DIM ** -0.5
        score = jnp.einsum('bqh,bqhs->bqs', wc.astype(jnp.float32), jax.nn.relu(logits)) * IDX_HEADS ** -0.5
        causal = key_pos[None, :] <= q_pos[:, None]
        score = jnp.where(causal[None], score, NEG_INF)
        _, sel = lax.top_k(score, top_k)
        valid = sel <= q_pos[None, :, None]
        k_sel = gather(k, sel)
        v_sel = gather(v, sel)
        s = jnp.einsum('bqhd,bqkhd->bqhk', qc, k_sel).astype(jnp.float32) * Dh ** -0.5
        dist = (q_pos[None, :, None] - sel).astype(jnp.float32)
        s = s - slopes[None, None, :, None] * dist[:, :, None, :]
        s = jnp.where(valid[:, :, None, :], s, NEG_INF)
        p = jax.nn.softmax(s, axis=-1).astype(v.dtype)
        return jnp.einsum('bqhk,bqkhd->bqhd', p, v_sel)

    starts = jnp.arange(n_chunks) * DSA_Q_CHUNK
    out = lax.map(chunk_fn, (starts, to_chunks(q), to_chunks(q_idx), to_chunks(w_idx)))
    return jnp.swapaxes(out, 0, 1).reshape(B, L, H, Dh)


def _moba_attention(q, k, v, slopes):
    B, L, H, Dh = q.shape
    nb = -(-L // MOBA_BLOCK)
    Lp = nb * MOBA_BLOCK
    pad = ((0, 0), (0, Lp - L), (0, 0), (0, 0))
    kp = jnp.pad(k, pad)
    vp = jnp.pad(v, pad)
    qp = jnp.pad(q, pad)
    scale = Dh ** -0.5
    offs = jnp.arange(MOBA_BLOCK)
    qb = qp.reshape(B, nb, MOBA_BLOCK, H, Dh)
    kb = kp.reshape(B, nb, MOBA_BLOCK, H, Dh)
    vb = vp.reshape(B, nb, MOBA_BLOCK, H, Dh)

    s_self = jnp.einsum('bnqhd,bnshd->bnhqs', qb, kb).astype(jnp.float32) * scale
    rel = offs[:, None] - offs[None, :]
    s_self = s_self - slopes[:, None, None] * rel.astype(jnp.float32)
    s_self = jnp.where(rel >= 0, s_self, NEG_INF)
    lse_self = jax.nn.logsumexp(s_self, axis=-1)
    p_self = jnp.exp(s_self - lse_self[..., None]).astype(v.dtype)
    o_self = jnp.einsum('bnhqs,bnshd->bnqhd', p_self, vb).reshape(B, Lp, H, Dh)[:, :L]
    lse_self = jnp.swapaxes(lse_self, 2, 3).reshape(B, Lp, H)[:, :L]

    top_k = min(MOBA_TOPK_MAX, nb - 1)
    if top_k == 0:
        return o_self.astype(q.dtype)

    k_mean = jnp.mean(kb.astype(jnp.float32), axis=2)
    gate = jnp.einsum('bthd,bnhd->bthn', q.astype(jnp.float32), k_mean)
    q_blk = jnp.arange(L) // MOBA_BLOCK
    past = jnp.arange(nb)[None, :] < q_blk[:, None]
    gate = jnp.where(past[None, :, None, :], gate, NEG_INF)
    _, sel = lax.top_k(gate, top_k)

    k_bh = jnp.transpose(kb, (0, 3, 1, 2, 4))
    v_bh = jnp.transpose(vb, (0, 3, 1, 2, 4))
    bi = jnp.arange(B)[:, None, None, None]
    hi = jnp.arange(H)[None, None, :, None]
    n_chunks = L // MOBA_Q_CHUNK

    def to_chunks(t):
        return jnp.swapaxes(t.reshape((B, n_chunks, MOBA_Q_CHUNK) + t.shape[2:]), 0, 1)

    def chunk_fn(args):
        start, qc, sc = args
        q_pos = start + jnp.arange(MOBA_Q_CHUNK)
        valid = sc < (q_pos // MOBA_BLOCK)[None, :, None, None]
        k_g = k_bh[bi, hi, sc]
        v_g = v_bh[bi, hi, sc]
        s = jnp.einsum('bqhd,bqhjsd->bqhjs', qc, k_g).astype(jnp.float32) * scale
        key_pos = sc[..., None] * MOBA_BLOCK + offs
        dist = (q_pos[None, :, None, None, None] - key_pos).astype(jnp.float32)
        s = s - slopes[None, None, :, None, None] * dist
        s = jnp.where(valid[..., None], s, NEG_INF)
        s = s.reshape(B, MOBA_Q_CHUNK, H, top_k * MOBA_BLOCK)
        lse = jax.nn.logsumexp(s, axis=-1)
        p = jnp.exp(s - lse[..., None]).astype(v.dtype).reshape(B, MOBA_Q_CHUNK, H, top_k, MOBA_BLOCK)
        o = jnp.einsum('bqhjs,bqhjsd->bqhd', p, v_g)
        return o, lse

    starts = jnp.arange(n_chunks) * MOBA_Q_CHUNK
    o_hist, lse_hist = lax.map(chunk_fn, (starts, to_chunks(q), to_chunks(sel)))
    o_hist = jnp.swapaxes(o_hist, 0, 1).reshape(B, L, H, Dh)
    lse_hist = jnp.swapaxes(lse_hist, 0, 1).reshape(B, L, H)

    lse = jnp.logaddexp(lse_self, lse_hist)
    w_self = jnp.exp(lse_self - lse)[..., None]
    w_hist = jnp.exp(lse_hist - lse)[..., None]
    return (o_self * w_self + o_hist * w_hist).astype(q.dtype)


def _hybrid_layer(x, c, w_ada, b_ada, g_norm, w_in, q_norm_a, k_norm_a, k_norm_idx,
                  q_norm_b, k_norm_b, w_out):
    B, L, _ = x.shape
    mod = jax.nn.silu(c) @ w_ada + b_ada
    shift, scale, gate = jnp.split(mod, 3, axis=-1)
    h = _rms_norm(x, g_norm) * (1.0 + scale[:, None, :]) + shift[:, None, :]

    proj = h @ w_in
    qa, ka, va, za, q_idx, k_idx, w_idx, qb, kb, vb, zb = jnp.split(proj, COL_SPLITS, axis=-1)

    heads_a = (B, L, N_HEADS_A, HEAD_DIM)
    heads_b = (B, L, N_HEADS_B, HEAD_DIM)
    qa = _rms_norm(qa.reshape(heads_a), q_norm_a)
    ka = _rms_norm(ka.reshape(heads_a), k_norm_a)
    va = va.reshape(heads_a)
    q_idx = q_idx.reshape(B, L, IDX_HEADS, IDX_DIM)
    k_idx = _rms_norm(k_idx, k_norm_idx)
    qb = _rms_norm(qb.reshape(heads_b), q_norm_b)
    kb = _rms_norm(kb.reshape(heads_b), k_norm_b)
    vb = vb.reshape(heads_b)

    ya = _dsa_attention(qa, ka, va, q_idx, k_idx, w_idx, _alibi_slopes(N_HEADS_A))
    yb = _moba_attention(qb, kb, vb, _alibi_slopes(N_HEADS_B))

    ya = ya.reshape(B, L, D_A) * jax.nn.silu(za)
    yb = yb.reshape(B, L, D_B) * jax.nn.silu(zb)
    y = jnp.concatenate([ya, yb], axis=-1) @ w_out
    return x + gate[:, None, :] * y


def setup_inputs(seed: int = 0) -> dict:
    key = jax.random.key(seed)
    ks = jax.random.split(key, 12)
    nrm = jax.random.normal
    x = nrm(ks[0], (BATCH, SEQ, D_MODEL), jnp.float32)
    c = nrm(ks[1], (BATCH, D_MODEL), jnp.float32)
    w_ada = nrm(ks[2], (DEPTH, D_MODEL, 3 * D_MODEL), jnp.float32) * (0.5 * D_MODEL ** -0.5)
    b_ada = 0.01 * nrm(ks[3], (DEPTH, 3 * D_MODEL), jnp.float32)
    g_norm = 1.0 + 0.02 * nrm(ks[4], (DEPTH, D_MODEL), jnp.float32)
    w_in = nrm(ks[5], (DEPTH, D_MODEL, D_IN), jnp.float32) * D_MODEL ** -0.5
    q_norm_a = 1.0 + 0.02 * nrm(ks[6], (DEPTH, HEAD_DIM), jnp.float32)
    k_norm_a = 1.0 + 0.02 * nrm(ks[7], (DEPTH, HEAD_DIM), jnp.float32)
    k_norm_idx = 1.0 + 0.02 * nrm(ks[8], (DEPTH, IDX_DIM), jnp.float32)
    q_norm_b = 1.0 + 0.02 * nrm(ks[9], (DEPTH, HEAD_DIM), jnp.float32)
    k_norm_b = 1.0 + 0.02 * nrm(ks[10], (DEPTH, HEAD_DIM), jnp.float32)
    w_out = nrm(ks[11], (DEPTH, D_MIX, D_MODEL), jnp.float32) * D_MIX ** -0.5
    return {"x": x, "c": c, "w_ada": w_ada, "b_ada": b_ada, "g_norm": g_norm, "w_in": w_in,
            "q_norm_a": q_norm_a, "k_norm_a": k_norm_a, "k_norm_idx": k_norm_idx,
            "q_norm_b": q_norm_b, "k_norm_b": k_norm_b, "w_out": w_out}


def reference(x, c, w_ada, b_ada, g_norm, w_in, q_norm_a, k_norm_a, k_norm_idx,
              q_norm_b, k_norm_b, w_out):
    for i in range(DEPTH):
        x = _hybrid_layer(x, c, w_ada[i], b_ada[i], g_norm[i], w_in[i], q_norm_a[i], k_norm_a[i],
                          k_norm_idx[i], q_norm_b[i], k_norm_b[i], w_out[i])
    return x
```

```cpp
#include <hip/hip_runtime.h>
#include <cstdio>
#include <cstdint>

typedef unsigned short bf16_t;
constexpr int BATCH = 8, SEQ = 2048, DM = 2048, M = BATCH * SEQ, NH = 8, HD = 128, DA = 1024, IH = 16, ID = 64, DIN = 9296;
constexpr int TOPK = 256, NBLK = 8;
constexpr float RMS_EPS = 1e-6f;
constexpr float QK_SCALE = 0.08838834764831845f;

__device__ __forceinline__ float bf2f(bf16_t v) { return __uint_as_float(((unsigned)v) << 16); }
__device__ __forceinline__ bf16_t f2bf(float f) { unsigned u = __float_as_uint(f); return (bf16_t)((u + 0x7fffu + ((u >> 16) & 1u)) >> 16); }
__device__ __forceinline__ float rbf(float f) { return bf2f(f2bf(f)); }
__device__ __forceinline__ float silu_f(float v) { return v / (1.f + __expf(-v)); }
__device__ __forceinline__ size_t HM(int b, int h, int t, int d) { return (((size_t)(b * NH + h) * SEQ + t) * HD + d); }
__device__ __forceinline__ float wave_sum(float v) {
#pragma unroll
    for (int o = 1; o < 64; o <<= 1) v += __shfl_xor(v, o);
    return v;
}
__device__ __forceinline__ float wave_max(float v) {
#pragma unroll
    for (int o = 1; o < 64; o <<= 1) v = fmaxf(v, __shfl_xor(v, o));
    return v;
}
__device__ __forceinline__ void mask_pos(int t, int s, size_t& word, int& bit) {
    const int rg = t >> 5, r32 = t & 31, kt = s >> 6, k64 = s & 63, half = k64 >> 5, c = k64 & 31, hi = (c >> 2) & 1, r = (c & 3) + 4 * (c >> 3);
    word = ((size_t)rg * 32 + kt) * 32 + (r + 16 * half); bit = r32 + 32 * hi;
}

__global__ void k_mod(const float* __restrict__ c, const float* __restrict__ w_ada, const float* __restrict__ b_ada, float* __restrict__ MOD) {
    __shared__ float sc[DM];
    const int b = blockIdx.y, n = blockIdx.x * 256 + threadIdx.x;
    for (int k = threadIdx.x; k < DM; k += 256) sc[k] = silu_f(c[b * DM + k]);
    __syncthreads();
    float acc = 0.f;
    for (int k = 0; k < DM; ++k) acc += sc[k] * w_ada[(size_t)k * (3 * DM) + n];
    MOD[b * 3 * DM + n] = acc + b_ada[n];
}
__global__ void k_norm(const float* __restrict__ x, const float* __restrict__ g, const float* __restrict__ MOD, bf16_t* __restrict__ HB) {
    const int lane = threadIdx.x & 63, row = blockIdx.x * 4 + (threadIdx.x >> 6), b = row / SEQ;
    const float* xr = x + (size_t)row * DM;
    float ss = 0.f;
    for (int k = lane; k < DM; k += 64) { const float v = xr[k]; ss += v * v; }
    ss = wave_sum(ss);
    const float rstd = rsqrtf(ss / DM + RMS_EPS);
    const float* shift = MOD + b * 3 * DM; const float* scale = shift + DM;
    for (int k = lane; k < DM; k += 64) HB[(size_t)row * DM + k] = f2bf(xr[k] * rstd * g[k] * (1.f + scale[k]) + shift[k]);
}
template <int MODE>
__global__ void k_gemm_naive(const bf16_t* __restrict__ A, int K, const float* __restrict__ W, int ldw, int n0, int ncols,
                             float* __restrict__ C, int ldc, const float* __restrict__ xres, const float* __restrict__ MOD) {
    __shared__ float As[16][65], Bs[16][65];
    const int tid = threadIdx.x, tx = tid & 15, ty = tid >> 4, m0 = blockIdx.y * 64, c0 = blockIdx.x * 64;
    float acc[4][4] = {};
    for (int k0 = 0; k0 < K; k0 += 16) {
        for (int i = tid; i < 1024; i += 256) { const int r = i >> 4, kk = i & 15; As[kk][r] = bf2f(A[(size_t)(m0 + r) * K + k0 + kk]); }
        for (int i = tid; i < 1024; i += 256) { const int kk = i >> 6, cc = i & 63; Bs[kk][cc] = (c0 + cc < ncols) ? rbf(W[(size_t)(k0 + kk) * ldw + n0 + c0 + cc]) : 0.f; }
        __syncthreads();
#pragma unroll
        for (int kk = 0; kk < 16; ++kk) {
            float a[4], bb[4];
#pragma unroll
            for (int i = 0; i < 4; ++i) { a[i] = As[kk][ty * 4 + i]; bb[i] = Bs[kk][tx * 4 + i]; }
#pragma unroll
            for (int i = 0; i < 4; ++i)
#pragma unroll
                for (int j = 0; j < 4; ++j) acc[i][j] += a[i] * bb[j];
        }
        __syncthreads();
    }
#pragma unroll
    for (int i = 0; i < 4; ++i)
#pragma unroll
        for (int j = 0; j < 4; ++j) {
            const int m = m0 + ty * 4 + i, cc = c0 + tx * 4 + j;
            if (cc < ncols) {
                if (MODE == 0) C[(size_t)m * ldc + cc] = acc[i][j];
                else { const int b = m / SEQ; C[(size_t)m * ldc + cc] = xres[(size_t)m * ldc + cc] + MOD[b * 3 * DM + 2 * DM + cc] * acc[i][j]; }
            }
        }
}
__global__ void k_post(const float* __restrict__ T32, const float* __restrict__ gain, bf16_t* __restrict__ dst, int mode) {
    const int lane = threadIdx.x & 63, item = blockIdx.x * 4 + (threadIdx.x >> 6), m = item >> 3, h = item & 7, b = m / SEQ, t = m % SEQ;
    const float* src = T32 + (size_t)m * 1024 + h * 128;
    float v0 = src[lane], v1 = src[lane + 64];
    if (mode == 0) { const float ss = wave_sum(v0 * v0 + v1 * v1); const float rstd = rsqrtf(ss / 128.f + RMS_EPS); v0 = v0 * rstd * gain[lane]; v1 = v1 * rstd * gain[lane + 64]; }
    if (mode == 2) { v0 = silu_f(v0); v1 = silu_f(v1); }
    if (mode == 3) { dst[(size_t)m * 1024 + h * 128 + lane] = f2bf(v0); dst[(size_t)m * 1024 + h * 128 + lane + 64] = f2bf(v1); }
    else { dst[HM(b, h, t, lane)] = f2bf(v0); dst[HM(b, h, t, lane + 64)] = f2bf(v1); }
}
__global__ void k_post_idx(const float* __restrict__ T32, const float* __restrict__ gain, bf16_t* __restrict__ KI, float* __restrict__ WI) {
    const int lane = threadIdx.x & 63, m = blockIdx.x * 4 + (threadIdx.x >> 6);
    const float v = T32[(size_t)m * 80 + lane];
    const float ss = wave_sum(v * v); const float rstd = rsqrtf(ss / 64.f + RMS_EPS);
    KI[(size_t)m * 64 + lane] = f2bf(v * rstd * gain[lane]);
    if (lane < 16) WI[(size_t)m * 16 + lane] = T32[(size_t)m * 80 + 64 + lane];
}
__global__ void k_kmean(const bf16_t* __restrict__ KB, float* __restrict__ KMEAN) {
    const int d = threadIdx.x, h = blockIdx.x & 7, n = (blockIdx.x >> 3) & 7, b = blockIdx.x >> 6;
    float s = 0.f;
    for (int t = 0; t < 256; ++t) s += bf2f(KB[HM(b, h, n * 256 + t, d)]);
    KMEAN[((size_t)(b * NBLK + n) * NH + h) * HD + d] = s * (1.f / 256.f);
}
__global__ void k_dsa_select_naive(const bf16_t* __restrict__ QI, const bf16_t* __restrict__ KI, const float* __restrict__ WI, unsigned long long* __restrict__ MASKT) {
    const int t = blockIdx.x, b = blockIdx.y, tid = threadIdx.x; const size_t m = (size_t)b * SEQ + t;
    __shared__ float q[1024]; __shared__ float w[16]; __shared__ float sc[SEQ];
    for (int i = tid; i < 1024; i += 256) q[i] = bf2f(QI[m * 1024 + i]);
    if (tid < 16) w[tid] = WI[m * 16 + tid];
    __syncthreads();
    for (int s = tid; s <= t; s += 256) {
        float k[64];
        const bf16_t* kp = KI + ((size_t)b * SEQ + s) * 64;
#pragma unroll
        for (int d = 0; d < 64; ++d) k[d] = bf2f(kp[d]);
        float score = 0.f;
        for (int h = 0; h < 16; ++h) { float dot = 0.f;
#pragma unroll
            for (int d = 0; d < 64; ++d) dot += q[h * 64 + d] * k[d];
            score += w[h] * fmaxf(dot * 0.125f, 0.f); }
        sc[s] = score * 0.25f;
    }
    __syncthreads();
    for (int s = tid; s <= t; s += 256) {
        bool sel = true;
        if (t >= TOPK) { const float v = sc[s]; int cnt = 0; for (int s2 = 0; s2 <= t; ++s2) { const float u = sc[s2]; cnt += (u > v || (u == v && s2 < s)) ? 1 : 0; } sel = cnt < TOPK; }
        if (sel) { size_t word; int bit; mask_pos(t, s, word, bit); atomicOr(&MASKT[(size_t)b * 65536 + word], 1ull << bit); }
    }
}
__global__ void k_dsa_attn_naive(const bf16_t* __restrict__ QA, const bf16_t* __restrict__ KA, const bf16_t* __restrict__ VA, const bf16_t* __restrict__ SZA,
                                 const unsigned long long* __restrict__ MASKT, bf16_t* __restrict__ Y) {
    const int t = blockIdx.x, b = blockIdx.y, tid = threadIdx.x, lane = tid & 63, w = tid >> 6; const size_t m = (size_t)b * SEQ + t;
    __shared__ int idx[512]; __shared__ int nsel; __shared__ float qs[8][128]; __shared__ float p[4][256];
    if (tid == 0) nsel = 0;
    __syncthreads();
    for (int s = tid; s <= t; s += 256) { size_t word; int bit; mask_pos(t, s, word, bit);
        if ((MASKT[(size_t)b * 65536 + word] >> bit) & 1ull) { const int pos = atomicAdd(&nsel, 1); if (pos < 512) idx[pos] = s; } }
    for (int i = tid; i < 1024; i += 256) qs[i >> 7][i & 127] = bf2f(QA[HM(b, i >> 7, t, i & 127)]);
    __syncthreads();
    const int n = nsel < 256 ? nsel : 256;
    for (int hh = 0; hh < 2; ++hh) {
        const int h = w + 4 * hh; const float slope = exp2f(-(float)(h + 1));
        float sv[4]; float mx = -INFINITY;
#pragma unroll
        for (int i = 0; i < 4; ++i) { const int j = lane + 64 * i; sv[i] = -INFINITY;
            if (j < n) { const int s = idx[j]; const bf16_t* kp = KA + HM(b, h, s, 0); float dot = 0.f;
                for (int d = 0; d < 128; ++d) dot += qs[h][d] * bf2f(kp[d]);
                sv[i] = dot * QK_SCALE - slope * (float)(t - s); }
            mx = fmaxf(mx, sv[i]); }
        mx = wave_max(mx);
        float sum = 0.f;
#pragma unroll
        for (int i = 0; i < 4; ++i) { const int j = lane + 64 * i; const float pv = (j < n) ? __expf(sv[i] - mx) : 0.f; sum += pv; p[w][j] = pv; }
        sum = wave_sum(sum);
        __syncthreads();
        float o0 = 0.f, o1 = 0.f;
        for (int j = 0; j < n; ++j) { const float pj = p[w][j]; const int s = idx[j]; const unsigned vv = *(const unsigned*)(VA + HM(b, h, s, 2 * lane));
            o0 += pj * __uint_as_float(vv << 16); o1 += pj * __uint_as_float(vv & 0xffff0000u); }
        const float inv = 1.f / sum;
        const unsigned zz = *(const unsigned*)(SZA + HM(b, h, t, 2 * lane));
        o0 = o0 * inv * __uint_as_float(zz << 16); o1 = o1 * inv * __uint_as_float(zz & 0xffff0000u);
        *(unsigned*)(Y + m * 2048 + h * 128 + 2 * lane) = (unsigned)f2bf(o0) | ((unsigned)f2bf(o1) << 16);
        __syncthreads();
    }
}
__global__ void k_moba_naive(const bf16_t* __restrict__ QB, const bf16_t* __restrict__ KB, const bf16_t* __restrict__ VB, const bf16_t* __restrict__ SZB,
                             const float* __restrict__ KMEAN, bf16_t* __restrict__ Y) {
    const int t = blockIdx.x, b = blockIdx.y, tid = threadIdx.x, lane = tid & 63, w = tid >> 6; const size_t m = (size_t)b * SEQ + t;
    __shared__ float qs[8][128]; __shared__ float sc[4][SEQ];
    for (int i = tid; i < 1024; i += 256) qs[i >> 7][i & 127] = bf2f(QB[HM(b, i >> 7, t, i & 127)]);
    __syncthreads();
    const int qblk = t >> 8;
    for (int hh = 0; hh < 2; ++hh) {
        const int h = w + 4 * hh; const float slope = exp2f(-(float)(h + 1));
        float g = -INFINITY;
        if (lane < qblk) { const float* km = KMEAN + ((size_t)(b * NBLK + lane) * NH + h) * HD; float dot = 0.f; for (int d = 0; d < 128; ++d) dot += qs[h][d] * km[d]; g = dot; }
        int rank = 0;
        for (int n2 = 0; n2 < NBLK; ++n2) { const float g2 = __shfl(g, n2); if (n2 < qblk && (g2 > g || (g2 == g && n2 < lane))) ++rank; }
        const bool sel = (lane < qblk) && (rank < 3);
        const unsigned selmask = (unsigned)(__ballot(sel) & 0xffull);
        float mx = -INFINITY;
        for (int s = lane; s <= t; s += 64) { const int blk = s >> 8; float v = -INFINITY;
            if (blk == qblk || ((selmask >> blk) & 1u)) { const bf16_t* kp = KB + HM(b, h, s, 0); float dot = 0.f;
                for (int d = 0; d < 128; ++d) dot += qs[h][d] * bf2f(kp[d]);
                v = dot * QK_SCALE - slope * (float)(t - s); }
            sc[w][s] = v; mx = fmaxf(mx, v); }
        mx = wave_max(mx);
        float sum = 0.f;
        for (int s = lane; s <= t; s += 64) { const float v = sc[w][s]; const float pv = (v == -INFINITY) ? 0.f : __expf(v - mx); sc[w][s] = pv; sum += pv; }
        sum = wave_sum(sum);
        __syncthreads();
        float o0 = 0.f, o1 = 0.f;
        for (int s = 0; s <= t; ++s) { const float pj = sc[w][s]; if (pj == 0.f) continue; const unsigned vv = *(const unsigned*)(VB + HM(b, h, s, 2 * lane));
            o0 += pj * __uint_as_float(vv << 16); o1 += pj * __uint_as_float(vv & 0xffff0000u); }
        const float inv = 1.f / sum;
        const unsigned zz = *(const unsigned*)(SZB + HM(b, h, t, 2 * lane));
        o0 = o0 * inv * __uint_as_float(zz << 16); o1 = o1 * inv * __uint_as_float(zz & 0xffff0000u);
        *(unsigned*)(Y + m * 2048 + 1024 + h * 128 + 2 * lane) = (unsigned)f2bf(o0) | ((unsigned)f2bf(o1) << 16);
        __syncthreads();
    }
}

constexpr size_t MiB = 1u << 20;
constexpr size_t WS_HB = 0;
constexpr size_t WS_QA = 64 * MiB, WS_KA = 96 * MiB, WS_VA = 128 * MiB, WS_SZA = 160 * MiB;
constexpr size_t WS_QB = 192 * MiB, WS_KB = 224 * MiB, WS_VB = 256 * MiB, WS_SZB = 288 * MiB;
constexpr size_t WS_QI = 320 * MiB;
constexpr size_t WS_KI = 352 * MiB;
constexpr size_t WS_WI = 354 * MiB;
constexpr size_t WS_KMEAN = 355 * MiB;
constexpr size_t WS_MOD = 356 * MiB;
constexpr size_t WS_MASK = 357 * MiB;
constexpr size_t WS_Y = 362 * MiB;
constexpr size_t WS_T32 = 362 * MiB;
constexpr size_t WS_END = 426 * MiB;

extern "C" void kernel_launch(void* const* d_in, const int* in_sizes, int n_in, void* d_out, int out_size, void* d_ws, size_t ws_size, hipStream_t stream) {
    if (n_in != 12 || in_sizes[0] != M * DM || out_size != M * DM || ws_size < WS_END) {
        fprintf(stderr, "kernel_launch: unexpected shapes (n_in %d, in0 %d, out %d, ws %zu); nothing launched\n", n_in, n_in > 0 ? in_sizes[0] : -1, out_size, ws_size); return; }
    const float* x = (const float*)d_in[0]; const float* c = (const float*)d_in[1]; const float* w_ada = (const float*)d_in[2]; const float* b_ada = (const float*)d_in[3];
    const float* g_norm = (const float*)d_in[4]; const float* w_in = (const float*)d_in[5]; const float* q_norm_a = (const float*)d_in[6]; const float* k_norm_a = (const float*)d_in[7];
    const float* k_norm_idx = (const float*)d_in[8]; const float* q_norm_b = (const float*)d_in[9]; const float* k_norm_b = (const float*)d_in[10]; const float* w_out = (const float*)d_in[11];
    char* ws = (char*)d_ws; float* out = (float*)d_out;
    bf16_t* HB = (bf16_t*)(ws + WS_HB); bf16_t* QA = (bf16_t*)(ws + WS_QA); bf16_t* KA = (bf16_t*)(ws + WS_KA); bf16_t* VA = (bf16_t*)(ws + WS_VA); bf16_t* SZA = (bf16_t*)(ws + WS_SZA);
    bf16_t* QB = (bf16_t*)(ws + WS_QB); bf16_t* KB = (bf16_t*)(ws + WS_KB); bf16_t* VB = (bf16_t*)(ws + WS_VB); bf16_t* SZB = (bf16_t*)(ws + WS_SZB);
    bf16_t* QI = (bf16_t*)(ws + WS_QI); bf16_t* KI = (bf16_t*)(ws + WS_KI); float* WI = (float*)(ws + WS_WI); float* KMEAN = (float*)(ws + WS_KMEAN); float* MOD = (float*)(ws + WS_MOD);
    unsigned long long* MASKT = (unsigned long long*)(ws + WS_MASK); bf16_t* Y = (bf16_t*)(ws + WS_Y); float* T32 = (float*)(ws + WS_T32);

    k_mod<<<dim3(3 * DM / 256, BATCH), 256, 0, stream>>>(c, w_ada, b_ada, MOD);
    k_norm<<<M / 4, 256, 0, stream>>>(x, g_norm, MOD, HB);
    struct Chunk { int n0; const float* gain; bf16_t* dst; int mode; };
    const Chunk chunks[9] = { {0, q_norm_a, QA, 0}, {1024, k_norm_a, KA, 0}, {2048, nullptr, VA, 1}, {3072, nullptr, SZA, 2}, {4096, nullptr, QI, 3},
                              {5200, q_norm_b, QB, 0}, {6224, k_norm_b, KB, 0}, {7248, nullptr, VB, 1}, {8272, nullptr, SZB, 2} };
    for (int i = 0; i < 9; ++i) {
        k_gemm_naive<0><<<dim3(16, M / 64), 256, 0, stream>>>(HB, DM, w_in, DIN, chunks[i].n0, 1024, T32, 1024, nullptr, nullptr);
        k_post<<<M * 8 / 4, 256, 0, stream>>>(T32, chunks[i].gain, chunks[i].dst, chunks[i].mode);
    }
    k_gemm_naive<0><<<dim3(2, M / 64), 256, 0, stream>>>(HB, DM, w_in, DIN, 5120, 80, T32, 80, nullptr, nullptr);
    k_post_idx<<<M / 4, 256, 0, stream>>>(T32, k_norm_idx, KI, WI);
    k_kmean<<<BATCH * NBLK * NH, 128, 0, stream>>>(KB, KMEAN);
    (void)hipMemsetAsync(MASKT, 0, 4 * MiB, stream);
    k_dsa_select_naive<<<dim3(SEQ, BATCH), 256, 0, stream>>>(QI, KI, WI, MASKT);
    k_dsa_attn_naive<<<dim3(SEQ, BATCH), 256, 0, stream>>>(QA, KA, VA, SZA, MASKT, Y);
    k_moba_naive<<<dim3(SEQ, BATCH), 256, 0, stream>>>(QB, KB, VB, SZB, KMEAN, Y);
    k_gemm_naive<1><<<dim3(DM / 64, M / 64), 256, 0, stream>>>(Y, DM, w_out, DM, 0, DM, out, DM, x, MOD);
}
```

```cpp
#include <hip/hip_runtime.h>
#include <cstdio>
#include <cstdint>

typedef unsigned short bf16_t;
constexpr int BATCH = 8, SEQ = 2048, DM = 2048, M = BATCH * SEQ, NH = 8, HD = 128, DA = 1024, IH = 16, ID = 64, DIN = 9296;
constexpr int TOPK = 256, NBLK = 8;
constexpr float RMS_EPS = 1e-6f;
constexpr float QK_SCALE = 0.08838834764831845f;

__device__ __forceinline__ float bf2f(bf16_t v) { return __uint_as_float(((unsigned)v) << 16); }
__device__ __forceinline__ bf16_t f2bf(float f) { unsigned u = __float_as_uint(f); return (bf16_t)((u + 0x7fffu + ((u >> 16) & 1u)) >> 16); }
__device__ __forceinline__ float rbf(float f) { return bf2f(f2bf(f)); }
__device__ __forceinline__ float silu_f(float v) { return v / (1.f + __expf(-v)); }
__device__ __forceinline__ size_t HM(int b, int h, int t, int d) { return (((size_t)(b * NH + h) * SEQ + t) * HD + d); }
__device__ __forceinline__ float wave_sum(float v) {
#pragma unroll
    for (int o = 1; o < 64; o <<= 1) v += __shfl_xor(v, o);
    return v;
}
__device__ __forceinline__ float wave_max(float v) {
#pragma unroll
    for (int o = 1; o < 64; o <<= 1) v = fmaxf(v, __shfl_xor(v, o));
    return v;
}
__device__ __forceinline__ void mask_pos(int t, int s, size_t& word, int& bit) {
    const int rg = t >> 5, r32 = t & 31, kt = s >> 6, k64 = s & 63, half = k64 >> 5, c = k64 & 31, hi = (c >> 2) & 1, r = (c & 3) + 4 * (c >> 3);
    word = ((size_t)rg * 32 + kt) * 32 + (r + 16 * half); bit = r32 + 32 * hi;
}

__global__ void k_mod(const float* __restrict__ c, const float* __restrict__ w_ada, const float* __restrict__ b_ada, float* __restrict__ MOD) {
    __shared__ float sc[DM];
    const int b = blockIdx.y, n = blockIdx.x * 256 + threadIdx.x;
    for (int k = threadIdx.x; k < DM; k += 256) sc[k] = silu_f(c[b * DM + k]);
    __syncthreads();
    float acc = 0.f;
    for (int k = 0; k < DM; ++k) acc += sc[k] * w_ada[(size_t)k * (3 * DM) + n];
    MOD[b * 3 * DM + n] = acc + b_ada[n];
}
__global__ void k_norm(const float* __restrict__ x, const float* __restrict__ g, const float* __restrict__ MOD, bf16_t* __restrict__ HB) {
    const int lane = threadIdx.x & 63, row = blockIdx.x * 4 + (threadIdx.x >> 6), b = row / SEQ;
    const float* xr = x + (size_t)row * DM;
    float ss = 0.f;
    for (int k = lane; k < DM; k += 64) { const float v = xr[k]; ss += v * v; }
    ss = wave_sum(ss);
    const float rstd = rsqrtf(ss / DM + RMS_EPS);
    const float* shift = MOD + b * 3 * DM; const float* scale = shift + DM;
    for (int k = lane; k < DM; k += 64) HB[(size_t)row * DM + k] = f2bf(xr[k] * rstd * g[k] * (1.f + scale[k]) + shift[k]);
}
template <int MODE>
__global__ void k_gemm_naive(const bf16_t* __restrict__ A, int K, const float* __restrict__ W, int ldw, int n0, int ncols,
                             float* __restrict__ C, int ldc, const float* __restrict__ xres, const float* __restrict__ MOD) {
    __shared__ float As[16][65], Bs[16][65];
    const int tid = threadIdx.x, tx = tid & 15, ty = tid >> 4, m0 = blockIdx.y * 64, c0 = blockIdx.x * 64;
    float acc[4][4] = {};
    for (int k0 = 0; k0 < K; k0 += 16) {
        for (int i = tid; i < 1024; i += 256) { const int r = i >> 4, kk = i & 15; As[kk][r] = bf2f(A[(size_t)(m0 + r) * K + k0 + kk]); }
        for (int i = tid; i < 1024; i += 256) { const int kk = i >> 6, cc = i & 63; Bs[kk][cc] = (c0 + cc < ncols) ? rbf(W[(size_t)(k0 + kk) * ldw + n0 + c0 + cc]) : 0.f; }
        __syncthreads();
#pragma unroll
        for (int kk = 0; kk < 16; ++kk) {
            float a[4], bb[4];
#pragma unroll
            for (int i = 0; i < 4; ++i) { a[i] = As[kk][ty * 4 + i]; bb[i] = Bs[kk][tx * 4 + i]; }
#pragma unroll
            for (int i = 0; i < 4; ++i)
#pragma unroll
                for (int j = 0; j < 4; ++j) acc[i][j] += a[i] * bb[j];
        }
        __syncthreads();
    }
#pragma unroll
    for (int i = 0; i < 4; ++i)
#pragma unroll
        for (int j = 0; j < 4; ++j) {
            const int m = m0 + ty * 4 + i, cc = c0 + tx * 4 + j;
            if (cc < ncols) {
                if (MODE == 0) C[(size_t)m * ldc + cc] = acc[i][j];
                else { const int b = m / SEQ; C[(size_t)m * ldc + cc] = xres[(size_t)m * ldc + cc] + MOD[b * 3 * DM + 2 * DM + cc] * acc[i][j]; }
            }
        }
}
__global__ void k_post(const float* __restrict__ T32, const float* __restrict__ gain, bf16_t* __restrict__ dst, int mode) {
    const int lane = threadIdx.x & 63, item = blockIdx.x * 4 + (threadIdx.x >> 6), m = item >> 3, h = item & 7, b = m / SEQ, t = m % SEQ;
    const float* src = T32 + (size_t)m * 1024 + h * 128;
    float v0 = src[lane], v1 = src[lane + 64];
    if (mode == 0) { const float ss = wave_sum(v0 * v0 + v1 * v1); const float rstd = rsqrtf(ss / 128.f + RMS_EPS); v0 = v0 * rstd * gain[lane]; v1 = v1 * rstd * gain[lane + 64]; }
    if (mode == 2) { v0 = silu_f(v0); v1 = silu_f(v1); }
    if (mode == 3) { dst[(size_t)m * 1024 + h * 128 + lane] = f2bf(v0); dst[(size_t)m * 1024 + h * 128 + lane + 64] = f2bf(v1); }
    else { dst[HM(b, h, t, lane)] = f2bf(v0); dst[HM(b, h, t, lane + 64)] = f2bf(v1); }
}
__global__ void k_post_idx(const float* __restrict__ T32, const float* __restrict__ gain, bf16_t* __restrict__ KI, float* __restrict__ WI) {
    const int lane = threadIdx.x & 63, m = blockIdx.x * 4 + (threadIdx.x >> 6);
    const float v = T32[(size_t)m * 80 + lane];
    const float ss = wave_sum(v * v); const float rstd = rsqrtf(ss / 64.f + RMS_EPS);
    KI[(size_t)m * 64 + lane] = f2bf(v * rstd * gain[lane]);
    if (lane < 16) WI[(size_t)m * 16 + lane] = T32[(size_t)m * 80 + 64 + lane];
}
__global__ void k_kmean(const bf16_t* __restrict__ KB, float* __restrict__ KMEAN) {
    const int d = threadIdx.x, h = blockIdx.x & 7, n = (blockIdx.x >> 3) & 7, b = blockIdx.x >> 6;
    float s = 0.f;
    for (int t = 0; t < 256; ++t) s += bf2f(KB[HM(b, h, n * 256 + t, d)]);
    KMEAN[((size_t)(b * NBLK + n) * NH + h) * HD + d] = s * (1.f / 256.f);
}
__global__ void k_dsa_select_naive(const bf16_t* __restrict__ QI, const bf16_t* __restrict__ KI, const float* __restrict__ WI, unsigned long long* __restrict__ MASKT) {
    const int t = blockIdx.x, b = blockIdx.y, tid = threadIdx.x; const size_t m = (size_t)b * SEQ + t;
    __shared__ float q[1024]; __shared__ float w[16]; __shared__ float sc[SEQ];
    for (int i = tid; i < 1024; i += 256) q[i] = bf2f(QI[m * 1024 + i]);
    if (tid < 16) w[tid] = WI[m * 16 + tid];
    __syncthreads();
    for (int s = tid; s <= t; s += 256) {
        float k[64];
        const bf16_t* kp = KI + ((size_t)b * SEQ + s) * 64;
#pragma unroll
        for (int d = 0; d < 64; ++d) k[d] = bf2f(kp[d]);
        float score = 0.f;
        for (int h = 0; h < 16; ++h) { float dot = 0.f;
#pragma unroll
            for (int d = 0; d < 64; ++d) dot += q[h * 64 + d] * k[d];
            score += w[h] * fmaxf(dot * 0.125f, 0.f); }
        sc[s] = score * 0.25f;
    }
    __syncthreads();
    for (int s = tid; s <= t; s += 256) {
        bool sel = true;
        if (t >= TOPK) { const float v = sc[s]; int cnt = 0; for (int s2 = 0; s2 <= t; ++s2) { const float u = sc[s2]; cnt += (u > v || (u == v && s2 < s)) ? 1 : 0; } sel = cnt < TOPK; }
        if (sel) { size_t word; int bit; mask_pos(t, s, word, bit); atomicOr(&MASKT[(size_t)b * 65536 + word], 1ull << bit); }
    }
}
__global__ void k_dsa_attn_naive(const bf16_t* __restrict__ QA, const bf16_t* __restrict__ KA, const bf16_t* __restrict__ VA, const bf16_t* __restrict__ SZA,
                                 const unsigned long long* __restrict__ MASKT, bf16_t* __restrict__ Y) {
    const int t = blockIdx.x, b = blockIdx.y, tid = threadIdx.x, lane = tid & 63, w = tid >> 6; const size_t m = (size_t)b * SEQ + t;
    __shared__ int idx[512]; __shared__ int nsel; __shared__ float qs[8][128]; __shared__ float p[4][256];
    if (tid == 0) nsel = 0;
    __syncthreads();
    for (int s = tid; s <= t; s += 256) { size_t word; int bit; mask_pos(t, s, word, bit);
        if ((MASKT[(size_t)b * 65536 + word] >> bit) & 1ull) { const int pos = atomicAdd(&nsel, 1); if (pos < 512) idx[pos] = s; } }
    for (int i = tid; i < 1024; i += 256) qs[i >> 7][i & 127] = bf2f(QA[HM(b, i >> 7, t, i & 127)]);
    __syncthreads();
    const int n = nsel < 256 ? nsel : 256;
    for (int hh = 0; hh < 2; ++hh) {
        const int h = w + 4 * hh; const float slope = exp2f(-(float)(h + 1));
        float sv[4]; float mx = -INFINITY;
#pragma unroll
        for (int i = 0; i < 4; ++i) { const int j = lane + 64 * i; sv[i] = -INFINITY;
            if (j < n) { const int s = idx[j]; const bf16_t* kp = KA + HM(b, h, s, 0); float dot = 0.f;
                for (int d = 0; d < 128; ++d) dot += qs[h][d] * bf2f(kp[d]);
                sv[i] = dot * QK_SCALE - slope * (float)(t - s); }
            mx = fmaxf(mx, sv[i]); }
        mx = wave_max(mx);
        float sum = 0.f;
#pragma unroll
        for (int i = 0; i < 4; ++i) { const int j = lane + 64 * i; const float pv = (j < n) ? __expf(sv[i] - mx) : 0.f; sum += pv; p[w][j] = pv; }
        sum = wave_sum(sum);
        __syncthreads();
        float o0 = 0.f, o1 = 0.f;
        for (int j = 0; j < n; ++j) { const float pj = p[w][j]; const int s = idx[j]; const unsigned vv = *(const unsigned*)(VA + HM(b, h, s, 2 * lane));
            o0 += pj * __uint_as_float(vv << 16); o1 += pj * __uint_as_float(vv & 0xffff0000u); }
        const float inv = 1.f / sum;
        const unsigned zz = *(const unsigned*)(SZA + HM(b, h, t, 2 * lane));
        o0 = o0 * inv * __uint_as_float(zz << 16); o1 = o1 * inv * __uint_as_float(zz & 0xffff0000u);
        *(unsigned*)(Y + m * 2048 + h * 128 + 2 * lane) = (unsigned)f2bf(o0) | ((unsigned)f2bf(o1) << 16);
        __syncthreads();
    }
}
__global__ void k_moba_naive(const bf16_t* __restrict__ QB, const bf16_t* __restrict__ KB, const bf16_t* __restrict__ VB, const bf16_t* __restrict__ SZB,
                             const float* __restrict__ KMEAN, bf16_t* __restrict__ Y) {
    const int t = blockIdx.x, b = blockIdx.y, tid = threadIdx.x, lane = tid & 63, w = tid >> 6; const size_t m = (size_t)b * SEQ + t;
    __shared__ float qs[8][128]; __shared__ float sc[4][SEQ];
    for (int i = tid; i < 1024; i += 256) qs[i >> 7][i & 127] = bf2f(QB[HM(b, i >> 7, t, i & 127)]);
    __syncthreads();
    const int qblk = t >> 8;
    for (int hh = 0; hh < 2; ++hh) {
        const int h = w + 4 * hh; const float slope = exp2f(-(float)(h + 1));
        float g = -INFINITY;
        if (lane < qblk) { const float* km = KMEAN + ((size_t)(b * NBLK + lane) * NH + h) * HD; float dot = 0.f; for (int d = 0; d < 128; ++d) dot += qs[h][d] * km[d]; g = dot; }
        int rank = 0;
        for (int n2 = 0; n2 < NBLK; ++n2) { const float g2 = __shfl(g, n2); if (n2 < qblk && (g2 > g || (g2 == g && n2 < lane))) ++rank; }
        const bool sel = (lane < qblk) && (rank < 3);
        const unsigned selmask = (unsigned)(__ballot(sel) & 0xffull);
        float mx = -INFINITY;
        for (int s = lane; s <= t; s += 64) { const int blk = s >> 8; float v = -INFINITY;
            if (blk == qblk || ((selmask >> blk) & 1u)) { const bf16_t* kp = KB + HM(b, h, s, 0); float dot = 0.f;
                for (int d = 0; d < 128; ++d) dot += qs[h][d] * bf2f(kp[d]);
                v = dot * QK_SCALE - slope * (float)(t - s); }
            sc[w][s] = v; mx = fmaxf(mx, v); }
        mx = wave_max(mx);
        float sum = 0.f;
        for (int s = lane; s <= t; s += 64) { const float v = sc[w][s]; const float pv = (v == -INFINITY) ? 0.f : __expf(v - mx); sc[w][s] = pv; sum += pv; }
        sum = wave_sum(sum);
        __syncthreads();
        float o0 = 0.f, o1 = 0.f;
        for (int s = 0; s <= t; ++s) { const float pj = sc[w][s]; if (pj == 0.f) continue; const unsigned vv = *(const unsigned*)(VB + HM(b, h, s, 2 * lane));
            o0 += pj * __uint_as_float(vv << 16); o1 += pj * __uint_as_float(vv & 0xffff0000u); }
        const float inv = 1.f / sum;
        const unsigned zz = *(const unsigned*)(SZB + HM(b, h, t, 2 * lane));
        o0 = o0 * inv * __uint_as_float(zz << 16); o1 = o1 * inv * __uint_as_float(zz & 0xffff0000u);
        *(unsigned*)(Y + m * 2048 + 1024 + h * 128 + 2 * lane) = (unsigned)f2bf(o0) | ((unsigned)f2bf(o1) << 16);
        __syncthreads();
    }
}

namespace pg8 {
#define PG8_LAS __attribute__((address_space(3)))
typedef unsigned short bf16_t;
typedef short bf16x8 __attribute__((ext_vector_type(8)));
typedef float f32x4 __attribute__((ext_vector_type(4)));
typedef unsigned u32x4 __attribute__((ext_vector_type(4)));
constexpr int BM = 256, BK = 64, HALF = 128, HTB = HALF * BK * 2  , STAGE_BYTES = 8 * HTB, NXCD = 8, WGM = 8;

__host__ __device__ __forceinline__ int lds_byte(int r, int c) { const int st = (r >> 4) * 2 + (c >> 5), rr = r & 15, cc = c & 31, ob = rr * 64 + cc * 2; return st * 1024 + (ob ^ (((ob >> 9) & 1) << 5)); }
__host__ __device__ __forceinline__ void stage_rc(int b, int& R, int& C) { const int st = b / 1024, sb = b % 1024, swz = sb ^ (((sb >> 9) & 1) << 5); R = (st >> 1) * 16 + swz / 64; C = (st & 1) * 32 + (swz % 64) / 2; }
__host__ __device__ __forceinline__ int perm32(int rho) { const int n = rho >> 4, i = rho & 15; return 8 * (i >> 2) + 4 * n + (i & 3); }

struct Unit { int pm, pn; };
struct Gemm { const bf16_t* A; const bf16_t* Bt; int M, N, K; };

struct StaticOrder {
    int nM, nN, nwg, G, c;
    __host__ __device__ void init(int M, int N, int G_, int c_) { nM = M / BM; nN = N / BM; nwg = nM * nN; G = G_; c = c_; }
    __host__ __device__ bool next(int i, Unit& u) const {
        const long L = (long)i * G + c; if (L >= nwg) return false;
        int wgid = (int)L; { const int q = nwg / NXCD, r = nwg % NXCD, xcd = wgid % NXCD, off = wgid / NXCD; wgid = (xcd < r ? xcd * (q + 1) : r * (q + 1) + (xcd - r) * q) + off; }
        const int nig = WGM * nN, gid = wgid / nig, fm = gid * WGM, gsz = (nM - fm) < WGM ? (nM - fm) : WGM;
        u.pm = fm + ((wgid % nig) % gsz); u.pn = (wgid % nig) / gsz; return true;
    }
    __device__ __forceinline__ void a_ready(const Unit&) const {}
    __device__ __forceinline__ void done(const Unit&) const {}
};

template <class Epi, class Sched, bool ALIGN_EPI = false, bool SP2 = false>
__device__ __forceinline__ void gemm_phase(PG8_LAS unsigned char* lds, const Gemm g, const Sched& S, const Epi& E) {
    const int tid = threadIdx.x, wid = __builtin_amdgcn_readfirstlane(tid >> 6), lane = tid & 63, wr = wid >> 2, wc = wid & 3, fr = lane & 15, fq = lane >> 4;
    const int K = g.K, nt = K / BK;
    unsigned voffA[2], voffB[2];
#pragma unroll
    for (int i = 0; i < 2; ++i) { int R, C; stage_rc(tid * 16 + i * 8192, R, C); const int Rb = Epi::PERM ? ((R & ~31) + perm32(R & 31)) : R;
        voffA[i] = (unsigned)(R * K + C) * 2u; voffB[i] = (unsigned)(Rb * K + C) * 2u; }
    const size_t kstep = (size_t)(BK * 2);
    const size_t hstep = (size_t)HALF * K * 2;
    const size_t tstep = 2 * hstep;
    const unsigned ldsw = (unsigned)wid * 1024u;
    const int aoff = lds_byte(wr * 64 + fr, fq * 8), boff = lds_byte(wc * 32 + fr, fq * 8);
#define PG8_SA(b, h) (((b) * 2 + (h)) * HTB)
#define PG8_SB(b, h) ((4 + (b) * 2 + (h)) * HTB)
#define PG8_STAGE(bufoff, gbase, voff) do { _Pragma("unroll") for (int _i = 0; _i < 2; ++_i) \
        __builtin_amdgcn_global_load_lds((const unsigned*)((const char*)(gbase) + (voff)[_i]), (PG8_LAS unsigned*)(lds + (bufoff) + ldsw + _i * 8192), 16, 0, 0); } while (0)
#define PG8_LDA(dst, b, h) do { _Pragma("unroll") for (int m = 0; m < 4; ++m) _Pragma("unroll") for (int k = 0; k < 2; ++k) dst[m][k] = *(const PG8_LAS bf16x8*)(lds + PG8_SA(b, h) + aoff + m * 2048 + k * 1024); } while (0)
#define PG8_LDB(dst, b, h) do { _Pragma("unroll") for (int n = 0; n < 2; ++n) _Pragma("unroll") for (int k = 0; k < 2; ++k) dst[n][k] = *(const PG8_LAS bf16x8*)(lds + PG8_SB(b, h) + boff + n * 2048 + k * 1024); } while (0)
#define PG8_MMA(ai, bj, At, Bt) do { __builtin_amdgcn_s_setprio(1); _Pragma("unroll") for (int m = 0; m < 4; ++m) _Pragma("unroll") for (int n = 0; n < 2; ++n) _Pragma("unroll") for (int k = 0; k < 2; ++k) \
        acc[ai][bj][m][n] = __builtin_amdgcn_mfma_f32_16x16x32_bf16(Bt[n][k], At[m][k], acc[ai][bj][m][n], 0, 0, 0); __builtin_amdgcn_s_setprio(0); } while (0)
#define PG8_WAIT_V(n) asm volatile("s_waitcnt vmcnt(" #n ")" ::: "memory")
#define PG8_WAIT_L(n) asm volatile("s_waitcnt lgkmcnt(" #n ")" ::: "memory")
#define PG8_BAR __builtin_amdgcn_s_barrier()
#define PG8_SCHED __builtin_amdgcn_sched_barrier(0)
    Unit cur, nxt; int ui = 0;
    if (!S.next(0, cur)) return;
    f32x4 acc[2][2][4][2];
#pragma unroll
    for (int a = 0; a < 2; ++a)
#pragma unroll
        for (int b = 0; b < 2; ++b)
#pragma unroll
            for (int m = 0; m < 4; ++m)
#pragma unroll
                for (int n = 0; n < 2; ++n) acc[a][b][m][n] = (f32x4){0.f, 0.f, 0.f, 0.f};
    bf16x8 At[4][2], B0[2][2], B1[2][2];
    const char* cA = (const char*)g.A + (size_t)cur.pm * tstep; const char* cB = (const char*)g.Bt + (size_t)cur.pn * tstep;
    S.a_ready(cur);
    if constexpr (SP2) {
        PG8_STAGE(PG8_SB(0, 0), cB, voffB); PG8_STAGE(PG8_SB(0, 1), cB + hstep, voffB); PG8_STAGE(PG8_SA(0, 0), cA, voffA); PG8_STAGE(PG8_SA(0, 1), cA + hstep, voffA);
        if (wr == 1) PG8_BAR;
        PG8_WAIT_V(2); PG8_BAR;
        PG8_STAGE(PG8_SB(1, 0), cB + kstep, voffB); PG8_STAGE(PG8_SA(1, 0), cA + kstep, voffA); PG8_STAGE(PG8_SB(1, 1), cB + hstep + kstep, voffB);
        PG8_WAIT_V(6); PG8_BAR;
    } else {
        PG8_STAGE(PG8_SB(0, 0), cB, voffB); PG8_STAGE(PG8_SA(0, 0), cA, voffA); PG8_STAGE(PG8_SB(0, 1), cB + hstep, voffB); PG8_STAGE(PG8_SA(0, 1), cA + hstep, voffA);
        if (wr == 1) PG8_BAR;
        PG8_WAIT_V(4); PG8_BAR;
        PG8_STAGE(PG8_SB(1, 0), cB + kstep, voffB); PG8_STAGE(PG8_SA(1, 0), cA + kstep, voffA); PG8_STAGE(PG8_SB(1, 1), cB + hstep + kstep, voffB);
        PG8_WAIT_V(6); PG8_BAR;
    }
    for (;;) {
        const bool has_next = S.next(ui + 1, nxt);
        const char* nA = has_next ? (const char*)g.A + (size_t)nxt.pm * tstep : cA; const char* nB = has_next ? (const char*)g.Bt + (size_t)nxt.pn * tstep : cB;
        for (int t = 0; t < nt; t += 2) {
            const bool last = (t == nt - 2);
            const char* a1 = cA + (size_t)(t + 1) * kstep;
            const char* a2 = last ? nA : cA + (size_t)(t + 2) * kstep; const char* b2 = last ? nB : cB + (size_t)(t + 2) * kstep;
            const char* a3 = a2 + kstep; const char* b3 = b2 + kstep;
            if (last && has_next) S.a_ready(nxt);
            if constexpr (SP2) {
            PG8_LDB(B0, 0, 0); PG8_LDB(B1, 0, 1); PG8_SCHED; PG8_LDA(At, 0, 0); PG8_STAGE(PG8_SA(1, 1), a1 + hstep, voffA);
            PG8_WAIT_V(8); PG8_WAIT_L(0); PG8_BAR; PG8_MMA(0, 0, At, B0); PG8_MMA(0, 1, At, B1); PG8_BAR; PG8_SCHED;
            PG8_LDA(At, 0, 1); PG8_STAGE(PG8_SB(0, 0), b2, voffB); PG8_STAGE(PG8_SB(0, 1), b2 + hstep, voffB); PG8_STAGE(PG8_SA(0, 0), a2, voffA);
            PG8_WAIT_V(8); PG8_WAIT_L(0); PG8_BAR; PG8_MMA(1, 0, At, B0); PG8_MMA(1, 1, At, B1); PG8_BAR; PG8_SCHED;
            PG8_LDB(B0, 1, 0); PG8_LDB(B1, 1, 1); PG8_SCHED; PG8_LDA(At, 1, 0); PG8_STAGE(PG8_SA(0, 1), a2 + hstep, voffA);
            PG8_WAIT_V(8); PG8_WAIT_L(0); PG8_BAR; PG8_MMA(0, 0, At, B0); PG8_MMA(0, 1, At, B1); PG8_BAR; PG8_SCHED;
            PG8_LDA(At, 1, 1); PG8_STAGE(PG8_SB(1, 0), b3, voffB); PG8_STAGE(PG8_SB(1, 1), b3 + hstep, voffB); PG8_STAGE(PG8_SA(1, 0), a3, voffA);
            PG8_WAIT_V(8); PG8_WAIT_L(0); PG8_BAR; PG8_MMA(1, 0, At, B0); PG8_MMA(1, 1, At, B1); PG8_BAR; PG8_SCHED;
            } else {
            PG8_LDB(B0, 0, 0); PG8_SCHED; PG8_LDA(At, 0, 0); PG8_STAGE(PG8_SA(1, 1), a1 + hstep, voffA);
            PG8_WAIT_L(8); PG8_BAR; PG8_WAIT_L(0); PG8_MMA(0, 0, At, B0); PG8_BAR; PG8_SCHED;
            PG8_LDB(B1, 0, 1); PG8_STAGE(PG8_SB(0, 0), b2, voffB);
            PG8_BAR; PG8_WAIT_L(0); PG8_MMA(0, 1, At, B1); PG8_BAR;
            PG8_LDA(At, 0, 1); PG8_STAGE(PG8_SA(0, 0), a2, voffA);
            PG8_BAR; PG8_WAIT_L(0); PG8_MMA(1, 0, At, B0); PG8_BAR; PG8_SCHED;
            PG8_STAGE(PG8_SB(0, 1), b2 + hstep, voffB);
            PG8_WAIT_V(6); PG8_BAR; PG8_MMA(1, 1, At, B1); PG8_BAR;
            PG8_LDB(B0, 1, 0); PG8_SCHED; PG8_LDA(At, 1, 0); PG8_STAGE(PG8_SA(0, 1), a2 + hstep, voffA);
            PG8_WAIT_L(8); PG8_BAR; PG8_WAIT_L(0); PG8_MMA(0, 0, At, B0); PG8_BAR; PG8_SCHED;
            PG8_LDB(B1, 1, 1); PG8_STAGE(PG8_SB(1, 0), b3, voffB);
            PG8_BAR; PG8_WAIT_L(0); PG8_MMA(0, 1, At, B1); PG8_BAR;
            PG8_LDA(At, 1, 1); PG8_STAGE(PG8_SA(1, 0), a3, voffA);
            PG8_BAR; PG8_WAIT_L(0); PG8_MMA(1, 0, At, B0); PG8_BAR; PG8_SCHED;
            PG8_STAGE(PG8_SB(1, 1), b3 + hstep, voffB);
            PG8_WAIT_V(6); PG8_BAR; PG8_MMA(1, 1, At, B1); PG8_BAR;
            }
        }
        if constexpr (ALIGN_EPI) { if (wr == 0) PG8_BAR; }
        if constexpr (!Epi::AFTER_DRAIN) { E(acc, cur, wr, wc, fr, fq); S.done(cur); }
        if (!has_next) break;
#pragma unroll
        for (int a = 0; a < 2; ++a)
#pragma unroll
            for (int b = 0; b < 2; ++b)
#pragma unroll
                for (int m = 0; m < 4; ++m)
#pragma unroll
                    for (int n = 0; n < 2; ++n) acc[a][b][m][n] = (f32x4){0.f, 0.f, 0.f, 0.f};
        cur = nxt; cA = nA; cB = nB; ++ui;
        if constexpr (ALIGN_EPI) { if (wr == 1) PG8_BAR; }
    }
    PG8_WAIT_V(0);
    if constexpr (!ALIGN_EPI) { if (wr == 0) PG8_BAR; }
    PG8_BAR;
    if constexpr (Epi::AFTER_DRAIN) { E.fused(acc, cur, wr, wc, fr, fq, lds, wid, lane); S.done(cur); }
#undef PG8_SA
#undef PG8_SB
#undef PG8_STAGE
#undef PG8_LDA
#undef PG8_LDB
#undef PG8_MMA
#undef PG8_WAIT_V
#undef PG8_WAIT_L
#undef PG8_BAR
#undef PG8_SCHED
}
}

#define GAS __attribute__((address_space(1)))
#define LAS __attribute__((address_space(3)))
typedef unsigned v4u __attribute__((ext_vector_type(4)));
typedef float f32x4 __attribute__((ext_vector_type(4)));
typedef GAS unsigned gu32;
#define RLX_AGENT __ATOMIC_RELAXED, __HIP_MEMORY_SCOPE_AGENT
#define LDS_WAIT() asm volatile("s_waitcnt lgkmcnt(0)" ::: "memory")
#define VM_WAIT() asm volatile("s_waitcnt vmcnt(0)" ::: "memory")
constexpr int NWAVES = 8;
constexpr int NPAD = 9472;
constexpr size_t MiB = 1u << 20;
constexpr size_t WS_CTL = 0, CTL_ZERO_BYTES = 1 * MiB;
constexpr size_t WS_MOD = 1 * MiB;
constexpr size_t WS_GAIN = 1 * MiB + 256 * 1024;
constexpr size_t WS_KMEAN = 1 * MiB + 512 * 1024;
constexpr size_t WS_WI = 2 * MiB;
constexpr size_t WS_KI = 3 * MiB;
constexpr size_t WS_MASK = 5 * MiB;
constexpr size_t WS_WOUT = 10 * MiB;
constexpr size_t WS_WIN = 18 * MiB;
constexpr size_t WS_HB = 56 * MiB;
constexpr size_t WS_Y = 56 * MiB;
constexpr size_t WS_QA = 120 * MiB, WS_KA = 152 * MiB, WS_VA = 184 * MiB, WS_SZA = 216 * MiB;
constexpr size_t WS_QB = 248 * MiB, WS_KB = 280 * MiB, WS_VB = 312 * MiB, WS_SZB = 344 * MiB;
constexpr size_t WS_QI = 376 * MiB;
constexpr size_t WS_T32 = 408 * MiB;
constexpr size_t WS_END = 472 * MiB;
constexpr int CW_BAR = 4096;
constexpr int RING_BYTES = 131072;
constexpr int EPI_OFF = RING_BYTES;
constexpr int LDSCTL_OFF = EPI_OFF + 16384, MISC_OFF = LDSCTL_OFF + 320;
constexpr int LDS_BYTES = 163840;

#define XB_TMO      128
#define XB_XCNT(j)  (256  + 64 * (j))
#define XB_XSUB(j)  (1280 + 64 * (j))
#define XB_XGEN(j)  (2304 + 64 * (j))
#define XB_TOP      3328
#define XB_TOPGEN   3392
#define XCD_BAR_WORDS 3456
#define XB_SPIN_CAP (1u << 18)

__device__ __forceinline__ unsigned xb_ld(unsigned* p)              { return __hip_atomic_load(p, __ATOMIC_RELAXED, __HIP_MEMORY_SCOPE_AGENT); }
__device__ __forceinline__ unsigned xb_add(unsigned* p, unsigned v) { return __hip_atomic_fetch_add(p, v, __ATOMIC_RELAXED, __HIP_MEMORY_SCOPE_AGENT); }
__device__ __forceinline__ unsigned xb_xcc_id() { return (unsigned)__builtin_amdgcn_s_getreg((3 << 11) | 20) & 0xFu; }
#define XB_SPIN(cond, bar) do { unsigned _sp = 0; while (cond) { __builtin_amdgcn_s_sleep(1); \
    if ((++_sp & 255u) == 0u) { if (xb_ld(&(bar)[XB_TMO])) break; if (_sp > XB_SPIN_CAP) { atomicAdd(&(bar)[XB_TMO], 1u); break; } } } } while (0)

struct XcdBarrier {
    unsigned* bar; unsigned x;
    volatile LAS unsigned* st;
};

__device__ __forceinline__ XcdBarrier xcd_barrier_post(unsigned* bar, volatile LAS unsigned* st) {
    XcdBarrier b; b.bar = bar; b.x = xb_xcc_id(); b.st = st;
    if (threadIdx.x == 0) (void)xb_add(&bar[XB_XCNT(b.x)], 1u);
    return b;
}
__device__ __forceinline__ void xcd_barrier_complete(unsigned* bar, unsigned x, unsigned& nloc, unsigned& nx) {
    const unsigned G = gridDim.x * gridDim.y * gridDim.z;
    unsigned sum, cnt, mine, sp = 0u;
    for (;;) {
        sum = 0u; cnt = 0u; mine = 0u;
#pragma unroll
        for (unsigned j = 0; j < 16; ++j) { const unsigned c = xb_ld(&bar[XB_XCNT(j)]); sum += c; cnt += (c > 0u) ? 1u : 0u; mine = (j == x) ? c : mine; }
        if (sum == G) break;
        __builtin_amdgcn_s_sleep(1);
        if ((++sp & 255u) == 0u) { if (xb_ld(&bar[XB_TMO])) break; if (sp > XB_SPIN_CAP) { atomicAdd(&bar[XB_TMO], 1u); break; } }
    }
    nloc = mine > 0u ? mine : 1u; nx = cnt > 0u ? cnt : 1u;
}

__device__ __forceinline__ void xcd_barrier(const XcdBarrier& b) {
    asm volatile("s_waitcnt vmcnt(0)" ::: "memory");
    __syncthreads();
    if (threadIdx.x == 0) {
        unsigned* bar = b.bar;
        __builtin_amdgcn_s_waitcnt(0);
        unsigned nloc = b.st[0], nx = b.st[1];
        if (nloc == 0u) { xcd_barrier_complete(bar, b.x, nloc, nx); b.st[0] = nloc; b.st[1] = nx; }
        const unsigned old = xb_add(&bar[XB_XSUB(b.x)], 1u);
        const unsigned gen = old / nloc;
        if (old + 1u == (gen + 1u) * nloc) {
            __builtin_amdgcn_fence(__ATOMIC_RELEASE, "agent");
            asm volatile("s_waitcnt vmcnt(0)" ::: "memory");
            const unsigned og = xb_add(&bar[XB_TOP], 1u);
            const unsigned tg = og / nx;
            if (og + 1u == (tg + 1u) * nx) xb_add(&bar[XB_TOPGEN], 1u);
            else XB_SPIN(xb_ld(&bar[XB_TOPGEN]) == tg, bar);
            __builtin_amdgcn_fence(__ATOMIC_ACQUIRE, "agent");
            xb_add(&bar[XB_XGEN(b.x)], 1u);
            asm volatile("s_waitcnt vmcnt(0)" ::: "memory");
        } else {
            XB_SPIN(xb_ld(&bar[XB_XGEN(b.x)]) == gen, bar);
            __builtin_amdgcn_fence(__ATOMIC_ACQUIRE, "agent");
            asm volatile("s_waitcnt vmcnt(0)" ::: "memory");
        }
    }
    __syncthreads();
}


struct Frame {
    LAS unsigned char* lds; volatile LAS unsigned* MISC; gu32* ctl; int tid, lane, wave, vcu, G;
};
__device__ __forceinline__ unsigned cvt_pk_bf16(float lo, float hi) { unsigned r; asm volatile("v_cvt_pk_bf16_f32 %0, %1, %2" : "=v"(r) : "v"(lo), "v"(hi)); return r; }
__device__ __forceinline__ unsigned f2bf_u(float f) { unsigned u = __builtin_bit_cast(unsigned, f); return (u + 0x7fffu + ((u >> 16) & 1u)) >> 16; }
__device__ __forceinline__ unsigned pk2(float lo, float hi) { return f2bf_u(lo) | (f2bf_u(hi) << 16); }
__device__ __forceinline__ float fast_silu(float v) { return v * __builtin_amdgcn_rcpf(1.f + __expf(-v)); }

__device__ __forceinline__ void p0_mod(Frame& F, int id, const float* __restrict__ c, const float* __restrict__ w_ada, const float* __restrict__ b_ada, float* __restrict__ MOD) {
    LAS float* sc = (LAS float*)(F.lds);
    LAS float* red = (LAS float*)(F.lds + 65536);
    for (int i = F.tid; i < BATCH * DM; i += NWAVES * 64) sc[i] = silu_f(c[i]);
    __syncthreads();
    const int cq = F.tid & 7, kq = F.tid >> 3, col0 = 32 * id + 4 * cq;
    f32x4 acc[8];
#pragma unroll
    for (int b = 0; b < 8; ++b) acc[b] = (f32x4){0.f, 0.f, 0.f, 0.f};
#pragma unroll 4
    for (int i = 0; i < 32; ++i) { const int k = kq + 64 * i; const f32x4 w = *(const f32x4*)(w_ada + (size_t)k * (3 * DM) + col0);
#pragma unroll
        for (int b = 0; b < 8; ++b) acc[b] += w * sc[b * DM + k]; }
#pragma unroll
    for (int b = 0; b < 8; ++b) *(LAS f32x4*)(red + (kq * 8 + b) * 32 + 4 * cq) = acc[b];
    __syncthreads();
    if (F.tid < 256) { const int b = F.tid >> 5, cc = F.tid & 31; float s = 0.f;
        for (int q = 0; q < 64; ++q) s += red[(q * 8 + b) * 32 + cc];
        MOD[b * 3 * DM + 32 * id + cc] = s + b_ada[32 * id + cc]; }
    __syncthreads();
}
template <bool MAPWIN>
__device__ __forceinline__ void p0_transpose_item(const float* __restrict__ W, int K, int N, int NP, bf16_t* __restrict__ WT, LAS float* scr, int item, int lane) {
    const int nblk = NP / 32, kb = item / nblk, nb = item % nblk, k0 = 64 * kb, n0 = 32 * nb;
    const int np = n0 + (lane & 31);
    int src = np; bool valid = true;
    if (MAPWIN) { if (np >= 5376) src = np - 176; else if (np >= 5200) valid = false; }
#pragma unroll 8
    for (int i = 0; i < 32; ++i) { const int kk = 2 * i + (lane >> 5); scr[kk * 33 + (lane & 31)] = valid ? W[(size_t)(k0 + kk) * N + src] : 0.f; }
    LDS_WAIT(); asm volatile("" ::: "memory");
    const int c = lane & 7;
#pragma unroll
    for (int j = 0; j < 4; ++j) { const int n = (lane >> 3) + 8 * j; const LAS float* s = scr + (8 * c) * 33 + n;
        v4u o; o.x = pk2(s[0 * 33], s[1 * 33]); o.y = pk2(s[2 * 33], s[3 * 33]); o.z = pk2(s[4 * 33], s[5 * 33]); o.w = pk2(s[6 * 33], s[7 * 33]);
        *(GAS v4u*)(WT + (size_t)(n0 + n) * K + k0 + 8 * c) = o; }
    LDS_WAIT(); asm volatile("" ::: "memory");
}
__device__ __forceinline__ void p0_convert(Frame& F, const float* __restrict__ w_in, const float* __restrict__ w_out, bf16_t* __restrict__ WinT, bf16_t* __restrict__ WoutT) {
    LAS float* scr = (LAS float*)(F.lds + F.wave * 16384);
    const int gw = F.vcu * NWAVES + F.wave, NGW = F.G * NWAVES;
    constexpr int I_IN = (DM / 64) * (NPAD / 32), I_OUT = (DM / 64) * (DM / 32);
    for (int it = gw; it < I_IN + I_OUT; it += NGW) {
        if (it < I_IN) p0_transpose_item<true>(w_in, DM, DIN, NPAD, WinT, scr, it, F.lane);
        else p0_transpose_item<false>(w_out, DM, DM, DM, WoutT, scr, it - I_IN, F.lane);
    }
}
__device__ __forceinline__ void p1_norm(Frame& F, const float* __restrict__ x, const float* __restrict__ g, const float* __restrict__ MOD, bf16_t* __restrict__ HB) {
    for (int v = F.vcu; v < M / 64; v += F.G) {
        const int b = v / (SEQ / 64);
        const float* shift = MOD + b * 3 * DM; const float* scale = shift + DM;
        f32x4 gs[8], sh[8];
#pragma unroll
        for (int j = 0; j < 8; ++j) { const int k = 4 * F.lane + 256 * j; const f32x4 gg = *(const f32x4*)(g + k), ss = *(const f32x4*)(scale + k); gs[j] = gg * (ss + 1.0f); sh[j] = *(const f32x4*)(shift + k); }
        for (int r = 0; r < 8; ++r) {
            const int row = 64 * v + 8 * F.wave + r;
            const f32x4* xr = (const f32x4*)(x + (size_t)row * DM) + F.lane;
            f32x4 xv[8]; float ss = 0.f;
#pragma unroll
            for (int j = 0; j < 8; ++j) { xv[j] = xr[64 * j]; ss += (xv[j].x * xv[j].x + xv[j].y * xv[j].y) + (xv[j].z * xv[j].z + xv[j].w * xv[j].w); }
            ss = wave_sum(ss);
            const float rstd = rsqrtf(ss * (1.f / DM) + RMS_EPS);
            unsigned long long* o8 = (unsigned long long*)(HB + (size_t)row * DM) + F.lane;
#pragma unroll
            for (int j = 0; j < 8; ++j) { const f32x4 h = xv[j] * rstd * gs[j] + sh[j];
                o8[64 * j] = (unsigned long long)pk2(h.x, h.y) | ((unsigned long long)pk2(h.z, h.w) << 32); }
        }
    }
}
struct EpiProj {
    static constexpr bool PERM = true, AFTER_DRAIN = false;
    unsigned char* ws;
    LAS float* P;
    __device__ __forceinline__ void operator()(const pg8::f32x4 (&acc)[2][2][4][2], const pg8::Unit& u, int wr, int wc, int fr, int fq) const {
        const int pn = u.pn;
        bf16_t* const KI = (bf16_t*)(ws + WS_KI); float* const WI = (float*)(ws + WS_WI); bf16_t* const QI = (bf16_t*)(ws + WS_QI);
        int grp, sub;
        if (pn < 20) { grp = pn >> 2; sub = pn & 3; } else if (pn == 20) { grp = 5; sub = 0; } else { grp = 6 + ((pn - 21) >> 2); sub = (pn - 21) & 3; }
        const int b = u.pm >> 3, t0 = (u.pm & 7) * 256 + wr * 64 + fr;
        const int cl = 32 * wc + 8 * fq;
        const bool norm = (grp == 0 || grp == 1 || grp == 6 || grp == 7 || grp == 5);
        float rs[2][4][2];
        if (norm) {
#pragma unroll
            for (int ai = 0; ai < 2; ++ai)
#pragma unroll
                for (int m = 0; m < 4; ++m)
#pragma unroll
                    for (int bj = 0; bj < 2; ++bj) { const pg8::f32x4 a = acc[ai][bj][m][0], c = acc[ai][bj][m][1];
                        float s = (a[0] * a[0] + a[1] * a[1]) + (a[2] * a[2] + a[3] * a[3]) + (c[0] * c[0] + c[1] * c[1]) + (c[2] * c[2] + c[3] * c[3]);
                        s += __shfl_xor(s, 16); s += __shfl_xor(s, 32);
                        if (fq == 0) P[((ai * 128 + wr * 64 + m * 16 + fr) * 2 + bj) * 4 + wc] = s; }
            asm volatile("s_waitcnt lgkmcnt(0)" ::: "memory"); __builtin_amdgcn_s_barrier(); asm volatile("" ::: "memory");
#pragma unroll
            for (int ai = 0; ai < 2; ++ai)
#pragma unroll
                for (int m = 0; m < 4; ++m)
#pragma unroll
                    for (int bj = 0; bj < 2; ++bj) { const pg8::f32x4 q = *(const LAS pg8::f32x4*)(P + ((ai * 128 + wr * 64 + m * 16 + fr) * 2 + bj) * 4);
                        rs[ai][m][bj] = (grp == 5) ? rsqrtf((q[0] + q[1]) * (1.f / 64.f) + RMS_EPS) : rsqrtf(((q[0] + q[1]) + (q[2] + q[3])) * (1.f / 128.f) + RMS_EPS); }
        }
        if (grp == 5) {
            if (wc < 2) { const float* gki = (const float*)(ws + WS_GAIN) + 4 * 128; const pg8::f32x4 g0 = *(const pg8::f32x4*)(gki + cl), g1 = *(const pg8::f32x4*)(gki + cl + 4);
#pragma unroll
                for (int ai = 0; ai < 2; ++ai)
#pragma unroll
                    for (int m = 0; m < 4; ++m) { const size_t row = (size_t)b * SEQ + t0 + 128 * ai + 16 * m; const float r = rs[ai][m][0];
                        const pg8::f32x4 v0 = acc[ai][0][m][0] * r * g0, v1 = acc[ai][0][m][1] * r * g1;
                        pg8::u32x4 w; w.x = cvt_pk_bf16(v0[0], v0[1]); w.y = cvt_pk_bf16(v0[2], v0[3]); w.z = cvt_pk_bf16(v1[0], v1[1]); w.w = cvt_pk_bf16(v1[2], v1[3]);
                        *(pg8::u32x4*)(KI + row * 64 + cl) = w; } }
            else if (wc == 2 && fq < 2) {
#pragma unroll
                for (int ai = 0; ai < 2; ++ai)
#pragma unroll
                    for (int m = 0; m < 4; ++m) { const size_t row = (size_t)b * SEQ + t0 + 128 * ai + 16 * m;
                        *(pg8::f32x4*)(WI + row * 16 + 8 * fq) = acc[ai][0][m][0]; *(pg8::f32x4*)(WI + row * 16 + 8 * fq + 4) = acc[ai][0][m][1]; } }
            return;
        }
        if (grp == 4) {
#pragma unroll
            for (int ai = 0; ai < 2; ++ai)
#pragma unroll
                for (int m = 0; m < 4; ++m) { const size_t row = (size_t)b * SEQ + t0 + 128 * ai + 16 * m;
#pragma unroll
                    for (int bj = 0; bj < 2; ++bj) { const pg8::f32x4 v0 = acc[ai][bj][m][0], v1 = acc[ai][bj][m][1];
                        pg8::u32x4 w; w.x = cvt_pk_bf16(v0[0], v0[1]); w.y = cvt_pk_bf16(v0[2], v0[3]); w.z = cvt_pk_bf16(v1[0], v1[1]); w.w = cvt_pk_bf16(v1[2], v1[3]);
                        *(pg8::u32x4*)(QI + row * 1024 + sub * 256 + bj * 128 + cl) = w; } }
            return;
        }
        bf16_t* dst; const float* gain = nullptr;
        { const int slot = grp < 4 ? grp : grp - 2;
          dst = (bf16_t*)(ws + WS_QA + (size_t)slot * (32 * MiB));
          gain = (const float*)(ws + WS_GAIN) + (grp < 2 ? grp : grp - 4) * 128; }
        pg8::f32x4 g0 = {1.f, 1.f, 1.f, 1.f}, g1 = {1.f, 1.f, 1.f, 1.f};
        if (norm) { g0 = *(const pg8::f32x4*)(gain + cl); g1 = *(const pg8::f32x4*)(gain + cl + 4); }
        const bool act = (grp == 3 || grp == 9);
#pragma unroll
        for (int ai = 0; ai < 2; ++ai)
#pragma unroll
            for (int m = 0; m < 4; ++m) { const int t = t0 + 128 * ai + 16 * m;
#pragma unroll
                for (int bj = 0; bj < 2; ++bj) { const int h = 2 * sub + bj;
                    pg8::f32x4 v0 = acc[ai][bj][m][0], v1 = acc[ai][bj][m][1];
                    if (norm) { const float r = rs[ai][m][bj]; v0 = v0 * r * g0; v1 = v1 * r * g1; }
                    if (act) { v0[0] = fast_silu(v0[0]); v0[1] = fast_silu(v0[1]); v0[2] = fast_silu(v0[2]); v0[3] = fast_silu(v0[3]);
                               v1[0] = fast_silu(v1[0]); v1[1] = fast_silu(v1[1]); v1[2] = fast_silu(v1[2]); v1[3] = fast_silu(v1[3]); }
                    pg8::u32x4 w; w.x = cvt_pk_bf16(v0[0], v0[1]); w.y = cvt_pk_bf16(v0[2], v0[3]); w.z = cvt_pk_bf16(v1[0], v1[1]); w.w = cvt_pk_bf16(v1[2], v1[3]);
                    *(pg8::u32x4*)(dst + HM(b, h, t, cl)) = w; } }
    }
};
struct EpiOut {
    static constexpr bool PERM = false, AFTER_DRAIN = false;
    const float* x; const float* MOD; float* out;
    __device__ __forceinline__ void operator()(const pg8::f32x4 (&acc)[2][2][4][2], const pg8::Unit& u, int wr, int wc, int fr, int fq) const {
        const int b = u.pm >> 3; const float* gate = MOD + b * 3 * DM + 2 * DM;
        const int col0 = u.pn * 256 + wc * 32 + 4 * fq;
        pg8::f32x4 gv[2][2];
#pragma unroll
        for (int bj = 0; bj < 2; ++bj)
#pragma unroll
            for (int n = 0; n < 2; ++n) gv[bj][n] = *(const pg8::f32x4*)(gate + col0 + bj * 128 + n * 16);
#pragma unroll
        for (int ai = 0; ai < 2; ++ai)
#pragma unroll
            for (int m = 0; m < 4; ++m) { const size_t off = (size_t)(u.pm * 256 + ai * 128 + wr * 64 + m * 16 + fr) * DM + col0;
#pragma unroll
                for (int bj = 0; bj < 2; ++bj)
#pragma unroll
                    for (int n = 0; n < 2; ++n) { const pg8::f32x4 xv = *(const pg8::f32x4*)(x + off + bj * 128 + n * 16);
                        *(pg8::f32x4*)(out + off + bj * 128 + n * 16) = xv + gv[bj][n] * acc[ai][bj][m][n]; }
                if (m & 1) asm volatile("" ::: "memory"); }
    }
};

struct Args { const float* in[12]; float* out; unsigned char* ws; int ph_lo, ph_hi, li, pad; };
__global__ void __launch_bounds__(NWAVES * 64, 2) mega_fwd(Args args) {
    extern __shared__ __attribute__((aligned(16))) unsigned char lds[];
    Frame F;
    F.lds = (LAS unsigned char*)lds; F.MISC = (volatile LAS unsigned*)(F.lds + MISC_OFF);
    F.tid = threadIdx.x; F.lane = F.tid & 63; F.wave = __builtin_amdgcn_readfirstlane(F.tid >> 6);
    F.G = gridDim.x; { const int bx = blockIdx.x; F.vcu = (F.G % 8 == 0) ? (bx % 8) * (F.G / 8) + bx / 8 : bx; }
    unsigned char* ws = args.ws;
    F.ctl = (gu32*)(ws + WS_CTL);
    const float* x = args.in[0]; const float* c = args.in[1]; const float* w_ada = args.in[2]; const float* b_ada = args.in[3]; const float* g_norm = args.in[4];
    const float* w_in = args.in[5]; const float* w_out = args.in[11];
    float* MOD = (float*)(ws + WS_MOD); bf16_t* WinT = (bf16_t*)(ws + WS_WIN); bf16_t* WoutT = (bf16_t*)(ws + WS_WOUT); bf16_t* HB = (bf16_t*)(ws + WS_HB); bf16_t* Y = (bf16_t*)(ws + WS_Y);
    for (int u = F.tid; u < (LDS_BYTES - LDSCTL_OFF) / 4; u += NWAVES * 64) ((LAS unsigned*)(F.lds + LDSCTL_OFF))[u] = 0u;
    __syncthreads();
    XcdBarrier bar = xcd_barrier_post((unsigned*)(F.ctl + CW_BAR) + args.li * XCD_BAR_WORDS, F.MISC + 8);
    const int lo = args.ph_lo, hi = args.ph_hi;
#define IN(k) (lo <= (k) && (k) < hi)
#define BOTH(k) (IN(k) && IN((k) + 1))
    if (IN(0)) {
        if ((int)blockIdx.x < 192) p0_mod(F, (int)blockIdx.x, c, w_ada, b_ada, MOD);
        else if ((int)blockIdx.x == 192) { float* G = (float*)(ws + WS_GAIN);
            if (F.tid < 128) { G[F.tid] = args.in[6][F.tid]; G[128 + F.tid] = args.in[7][F.tid]; G[256 + F.tid] = args.in[9][F.tid]; G[384 + F.tid] = args.in[10][F.tid]; }
            if (F.tid < 64) G[512 + F.tid] = args.in[8][F.tid]; }
        p0_convert(F, w_in, w_out, WinT, WoutT);
        if (BOTH(0)) xcd_barrier(bar);
    }
    if (IN(1)) {
        p1_norm(F, x, g_norm, MOD, HB);
        if (BOTH(1)) xcd_barrier(bar);
    }
    if (IN(2)) {
        pg8::Gemm g{HB, WinT, M, NPAD, DM}; pg8::StaticOrder S; S.init(M, NPAD, F.G, (int)blockIdx.x);
        EpiProj E{ws, (LAS float*)(F.lds + EPI_OFF)};
        pg8::gemm_phase<EpiProj, pg8::StaticOrder, true, true>(F.lds, g, S, E);
        if (BOTH(2)) xcd_barrier(bar);
    }
    if (IN(5)) {
        pg8::Gemm g{Y, WoutT, M, DM, DM}; pg8::StaticOrder S; S.init(M, DM, F.G, (int)blockIdx.x);
        EpiOut E{x, MOD, args.out};
        pg8::gemm_phase<EpiOut, pg8::StaticOrder, true, true>(F.lds, g, S, E);
    }
#undef IN
#undef BOTH
}

static int mega_setup() {
    static int grid = 0;
    if (grid == 0) {
        int dev = 0, cus = 0;
        if (hipGetDevice(&dev) != hipSuccess || hipDeviceGetAttribute(&cus, hipDeviceAttributeMultiprocessorCount, dev) != hipSuccess) { fprintf(stderr, "kernel_launch: device query failed\n"); grid = -1; return grid; }
        if (hipFuncSetAttribute((const void*)mega_fwd, hipFuncAttributeMaxDynamicSharedMemorySize, LDS_BYTES) != hipSuccess) { fprintf(stderr, "kernel_launch: hipFuncSetAttribute failed\n"); grid = -1; return grid; }
        (void)hipGetLastError();
        grid = cus;
    }
    return grid;
}
static void mega_launch(int grid, void* const* d_in, void* d_out, void* d_ws, int ph_lo, int ph_hi, int li, hipStream_t stream) {
    Args a{};
    for (int i = 0; i < 12; ++i) a.in[i] = (const float*)d_in[i];
    a.out = (float*)d_out; a.ws = (unsigned char*)d_ws; a.ph_lo = ph_lo; a.ph_hi = ph_hi; a.li = li;
    hipLaunchKernelGGL(mega_fwd, dim3(grid), dim3(NWAVES * 64), LDS_BYTES, stream, a);
}

extern "C" void kernel_launch(void* const* d_in, const int* in_sizes, int n_in, void* d_out, int out_size, void* d_ws, size_t ws_size, hipStream_t stream) {
    if (n_in != 12 || in_sizes[0] != M * DM || out_size != M * DM || ws_size < WS_END) {
        fprintf(stderr, "kernel_launch: unexpected shapes (n_in %d, in0 %d, out %d, ws %zu); nothing launched\n", n_in, n_in > 0 ? in_sizes[0] : -1, out_size, ws_size); return; }
    const int grid = mega_setup(); if (grid <= 0) return;
    char* ws = (char*)d_ws;
    bf16_t* QA = (bf16_t*)(ws + WS_QA); bf16_t* KA = (bf16_t*)(ws + WS_KA); bf16_t* VA = (bf16_t*)(ws + WS_VA); bf16_t* SZA = (bf16_t*)(ws + WS_SZA);
    bf16_t* QB = (bf16_t*)(ws + WS_QB); bf16_t* KB = (bf16_t*)(ws + WS_KB); bf16_t* VB = (bf16_t*)(ws + WS_VB); bf16_t* SZB = (bf16_t*)(ws + WS_SZB);
    bf16_t* QI = (bf16_t*)(ws + WS_QI); bf16_t* KI = (bf16_t*)(ws + WS_KI); float* WI = (float*)(ws + WS_WI); float* KMEAN = (float*)(ws + WS_KMEAN);
    unsigned long long* MASKT = (unsigned long long*)(ws + WS_MASK); bf16_t* Y = (bf16_t*)(ws + WS_Y);
    (void)hipMemsetAsync(ws + WS_CTL, 0, CTL_ZERO_BYTES, stream);
    mega_launch(grid, d_in, d_out, d_ws, 0, 3, 0, stream);
    k_kmean<<<BATCH * NBLK * NH, 128, 0, stream>>>(KB, KMEAN);
    (void)hipMemsetAsync(MASKT, 0, 4 * MiB, stream);
    k_dsa_select_naive<<<dim3(SEQ, BATCH), 256, 0, stream>>>(QI, KI, WI, MASKT);
    k_dsa_attn_naive<<<dim3(SEQ, BATCH), 256, 0, stream>>>(QA, KA, VA, SZA, MASKT, Y);
    k_moba_naive<<<dim3(SEQ, BATCH), 256, 0, stream>>>(QB, KB, VB, SZB, KMEAN, Y);
    mega_launch(grid, d_in, d_out, d_ws, 5, 6, 1, stream);
}
```

```cpp
#include <hip/hip_runtime.h>
#include <cstdio>
#include <cstdint>

typedef unsigned short bf16_t;
#ifndef NAIVE_ATTN
#define NAIVE_ATTN 0
#endif
constexpr int BATCH = 8, SEQ = 2048, DM = 2048, M = BATCH * SEQ, NH = 8, HD = 128, DA = 1024, IH = 16, ID = 64, DIN = 9296;
constexpr int TOPK = 256, NBLK = 8;
constexpr float RMS_EPS = 1e-6f;
constexpr float QK_SCALE = 0.08838834764831845f;

__device__ __forceinline__ float bf2f(bf16_t v) { return __uint_as_float(((unsigned)v) << 16); }
__device__ __forceinline__ bf16_t f2bf(float f) { unsigned u = __float_as_uint(f); return (bf16_t)((u + 0x7fffu + ((u >> 16) & 1u)) >> 16); }
__device__ __forceinline__ float rbf(float f) { return bf2f(f2bf(f)); }
__device__ __forceinline__ float silu_f(float v) { return v / (1.f + __expf(-v)); }
__device__ __forceinline__ size_t HM(int b, int h, int t, int d) { return (((size_t)(b * NH + h) * SEQ + t) * HD + d); }
__device__ __forceinline__ float wave_sum(float v) {
#pragma unroll
    for (int o = 1; o < 64; o <<= 1) v += __shfl_xor(v, o);
    return v;
}
__device__ __forceinline__ float wave_max(float v) {
#pragma unroll
    for (int o = 1; o < 64; o <<= 1) v = fmaxf(v, __shfl_xor(v, o));
    return v;
}
__device__ __forceinline__ void mask_pos(int t, int s, size_t& word, int& bit) { word = (size_t)t * 32 + (s >> 6); bit = s & 63; }

__global__ void k_mod(const float* __restrict__ c, const float* __restrict__ w_ada, const float* __restrict__ b_ada, float* __restrict__ MOD) {
    __shared__ float sc[DM];
    const int b = blockIdx.y, n = blockIdx.x * 256 + threadIdx.x;
    for (int k = threadIdx.x; k < DM; k += 256) sc[k] = silu_f(c[b * DM + k]);
    __syncthreads();
    float acc = 0.f;
    for (int k = 0; k < DM; ++k) acc += sc[k] * w_ada[(size_t)k * (3 * DM) + n];
    MOD[b * 3 * DM + n] = acc + b_ada[n];
}
__global__ void k_norm(const float* __restrict__ x, const float* __restrict__ g, const float* __restrict__ MOD, bf16_t* __restrict__ HB) {
    const int lane = threadIdx.x & 63, row = blockIdx.x * 4 + (threadIdx.x >> 6), b = row / SEQ;
    const float* xr = x + (size_t)row * DM;
    float ss = 0.f;
    for (int k = lane; k < DM; k += 64) { const float v = xr[k]; ss += v * v; }
    ss = wave_sum(ss);
    const float rstd = rsqrtf(ss / DM + RMS_EPS);
    const float* shift = MOD + b * 3 * DM; const float* scale = shift + DM;
    for (int k = lane; k < DM; k += 64) HB[(size_t)row * DM + k] = f2bf(xr[k] * rstd * g[k] * (1.f + scale[k]) + shift[k]);
}
template <int MODE>
__global__ void k_gemm_naive(const bf16_t* __restrict__ A, int K, const float* __restrict__ W, int ldw, int n0, int ncols,
                             float* __restrict__ C, int ldc, const float* __restrict__ xres, const float* __restrict__ MOD) {
    __shared__ float As[16][65], Bs[16][65];
    const int tid = threadIdx.x, tx = tid & 15, ty = tid >> 4, m0 = blockIdx.y * 64, c0 = blockIdx.x * 64;
    float acc[4][4] = {};
    for (int k0 = 0; k0 < K; k0 += 16) {
        for (int i = tid; i < 1024; i += 256) { const int r = i >> 4, kk = i & 15; As[kk][r] = bf2f(A[(size_t)(m0 + r) * K + k0 + kk]); }
        for (int i = tid; i < 1024; i += 256) { const int kk = i >> 6, cc = i & 63; Bs[kk][cc] = (c0 + cc < ncols) ? rbf(W[(size_t)(k0 + kk) * ldw + n0 + c0 + cc]) : 0.f; }
        __syncthreads();
#pragma unroll
        for (int kk = 0; kk < 16; ++kk) {
            float a[4], bb[4];
#pragma unroll
            for (int i = 0; i < 4; ++i) { a[i] = As[kk][ty * 4 + i]; bb[i] = Bs[kk][tx * 4 + i]; }
#pragma unroll
            for (int i = 0; i < 4; ++i)
#pragma unroll
                for (int j = 0; j < 4; ++j) acc[i][j] += a[i] * bb[j];
        }
        __syncthreads();
    }
#pragma unroll
    for (int i = 0; i < 4; ++i)
#pragma unroll
        for (int j = 0; j < 4; ++j) {
            const int m = m0 + ty * 4 + i, cc = c0 + tx * 4 + j;
            if (cc < ncols) {
                if (MODE == 0) C[(size_t)m * ldc + cc] = acc[i][j];
                else { const int b = m / SEQ; C[(size_t)m * ldc + cc] = xres[(size_t)m * ldc + cc] + MOD[b * 3 * DM + 2 * DM + cc] * acc[i][j]; }
            }
        }
}
__global__ void k_post(const float* __restrict__ T32, const float* __restrict__ gain, bf16_t* __restrict__ dst, int mode) {
    const int lane = threadIdx.x & 63, item = blockIdx.x * 4 + (threadIdx.x >> 6), m = item >> 3, h = item & 7, b = m / SEQ, t = m % SEQ;
    const float* src = T32 + (size_t)m * 1024 + h * 128;
    float v0 = src[lane], v1 = src[lane + 64];
    if (mode == 0) { const float ss = wave_sum(v0 * v0 + v1 * v1); const float rstd = rsqrtf(ss / 128.f + RMS_EPS); v0 = v0 * rstd * gain[lane]; v1 = v1 * rstd * gain[lane + 64]; }
    if (mode == 2) { v0 = silu_f(v0); v1 = silu_f(v1); }
    if (mode == 3) { dst[(size_t)m * 1024 + h * 128 + lane] = f2bf(v0); dst[(size_t)m * 1024 + h * 128 + lane + 64] = f2bf(v1); }
    else { dst[HM(b, h, t, lane)] = f2bf(v0); dst[HM(b, h, t, lane + 64)] = f2bf(v1); }
}
__global__ void k_post_idx(const float* __restrict__ T32, const float* __restrict__ gain, bf16_t* __restrict__ KI, float* __restrict__ WI) {
    const int lane = threadIdx.x & 63, m = blockIdx.x * 4 + (threadIdx.x >> 6);
    const float v = T32[(size_t)m * 80 + lane];
    const float ss = wave_sum(v * v); const float rstd = rsqrtf(ss / 64.f + RMS_EPS);
    KI[(size_t)m * 64 + lane] = f2bf(v * rstd * gain[lane]);
    if (lane < 16) WI[(size_t)m * 16 + lane] = T32[(size_t)m * 80 + 64 + lane];
}
__global__ void k_kmean(const bf16_t* __restrict__ KB, float* __restrict__ KMEAN) {
    const int d = threadIdx.x, h = blockIdx.x & 7, n = (blockIdx.x >> 3) & 7, b = blockIdx.x >> 6;
    float s = 0.f;
    for (int t = 0; t < 256; ++t) s += bf2f(KB[HM(b, h, n * 256 + t, d)]);
    KMEAN[((size_t)(b * NBLK + n) * NH + h) * HD + d] = s * (1.f / 256.f);
}
__global__ void k_dsa_select_naive(const bf16_t* __restrict__ QI, const bf16_t* __restrict__ KI, const float* __restrict__ WI, unsigned long long* __restrict__ MASKT) {
    const int t = blockIdx.x, b = blockIdx.y, tid = threadIdx.x; const size_t m = (size_t)b * SEQ + t;
    __shared__ float q[1024]; __shared__ float w[16]; __shared__ float sc[SEQ];
    for (int i = tid; i < 1024; i += 256) q[i] = bf2f(QI[m * 1024 + i]);
    if (tid < 16) w[tid] = WI[m * 16 + tid];
    __syncthreads();
    for (int s = tid; s <= t; s += 256) {
        float k[64];
        const bf16_t* kp = KI + ((size_t)b * SEQ + s) * 64;
#pragma unroll
        for (int d = 0; d < 64; ++d) k[d] = bf2f(kp[d]);
        float score = 0.f;
        for (int h = 0; h < 16; ++h) { float dot = 0.f;
#pragma unroll
            for (int d = 0; d < 64; ++d) dot += q[h * 64 + d] * k[d];
            score += w[h] * fmaxf(dot * 0.125f, 0.f); }
        sc[s] = score * 0.25f;
    }
    __syncthreads();
    for (int s = tid; s <= t; s += 256) {
        bool sel = true;
        if (t >= TOPK) { const float v = sc[s]; int cnt = 0; for (int s2 = 0; s2 <= t; ++s2) { const float u = sc[s2]; cnt += (u > v || (u == v && s2 < s)) ? 1 : 0; } sel = cnt < TOPK; }
        if (sel) { size_t word; int bit; mask_pos(t, s, word, bit); atomicOr(&MASKT[(size_t)b * 65536 + word], 1ull << bit); }
    }
}
__global__ void k_dsa_attn_naive(const bf16_t* __restrict__ QA, const bf16_t* __restrict__ KA, const bf16_t* __restrict__ VA, const bf16_t* __restrict__ SZA,
                                 const unsigned long long* __restrict__ MASKT, bf16_t* __restrict__ Y) {
    const int t = blockIdx.x, b = blockIdx.y, tid = threadIdx.x, lane = tid & 63, w = tid >> 6; const size_t m = (size_t)b * SEQ + t;
    __shared__ int idx[512]; __shared__ int nsel; __shared__ float qs[8][128]; __shared__ float p[4][256];
    if (tid == 0) nsel = 0;
    __syncthreads();
    for (int s = tid; s <= t; s += 256) { size_t word; int bit; mask_pos(t, s, word, bit);
        if ((MASKT[(size_t)b * 65536 + word] >> bit) & 1ull) { const int pos = atomicAdd(&nsel, 1); if (pos < 512) idx[pos] = s; } }
    for (int i = tid; i < 1024; i += 256) qs[i >> 7][i & 127] = bf2f(QA[HM(b, i >> 7, t, i & 127)]);
    __syncthreads();
    const int n = nsel < 256 ? nsel : 256;
    for (int hh = 0; hh < 2; ++hh) {
        const int h = w + 4 * hh; const float slope = exp2f(-(float)(h + 1));
        float sv[4]; float mx = -INFINITY;
#pragma unroll
        for (int i = 0; i < 4; ++i) { const int j = lane + 64 * i; sv[i] = -INFINITY;
            if (j < n) { const int s = idx[j]; const bf16_t* kp = KA + HM(b, h, s, 0); float dot = 0.f;
                for (int d = 0; d < 128; ++d) dot += qs[h][d] * bf2f(kp[d]);
                sv[i] = dot * QK_SCALE - slope * (float)(t - s); }
            mx = fmaxf(mx, sv[i]); }
        mx = wave_max(mx);
        float sum = 0.f;
#pragma unroll
        for (int i = 0; i < 4; ++i) { const int j = lane + 64 * i; const float pv = (j < n) ? __expf(sv[i] - mx) : 0.f; sum += pv; p[w][j] = pv; }
        sum = wave_sum(sum);
        __syncthreads();
        float o0 = 0.f, o1 = 0.f;
        for (int j = 0; j < n; ++j) { const float pj = p[w][j]; const int s = idx[j]; const unsigned vv = *(const unsigned*)(VA + HM(b, h, s, 2 * lane));
            o0 += pj * __uint_as_float(vv << 16); o1 += pj * __uint_as_float(vv & 0xffff0000u); }
        const float inv = 1.f / sum;
        const unsigned zz = *(const unsigned*)(SZA + HM(b, h, t, 2 * lane));
        o0 = o0 * inv * __uint_as_float(zz << 16); o1 = o1 * inv * __uint_as_float(zz & 0xffff0000u);
        *(unsigned*)(Y + m * 2048 + h * 128 + 2 * lane) = (unsigned)f2bf(o0) | ((unsigned)f2bf(o1) << 16);
        __syncthreads();
    }
}
__global__ void k_moba_naive(const bf16_t* __restrict__ QB, const bf16_t* __restrict__ KB, const bf16_t* __restrict__ VB, const bf16_t* __restrict__ SZB,
                             const float* __restrict__ KMEAN, bf16_t* __restrict__ Y) {
    const int t = blockIdx.x, b = blockIdx.y, tid = threadIdx.x, lane = tid & 63, w = tid >> 6; const size_t m = (size_t)b * SEQ + t;
    __shared__ float qs[8][128]; __shared__ float sc[4][SEQ];
    for (int i = tid; i < 1024; i += 256) qs[i >> 7][i & 127] = bf2f(QB[HM(b, i >> 7, t, i & 127)]);
    __syncthreads();
    const int qblk = t >> 8;
    for (int hh = 0; hh < 2; ++hh) {
        const int h = w + 4 * hh; const float slope = exp2f(-(float)(h + 1));
        float g = -INFINITY;
        if (lane < qblk) { const float* km = KMEAN + ((size_t)(b * NBLK + lane) * NH + h) * HD; float dot = 0.f; for (int d = 0; d < 128; ++d) dot += qs[h][d] * km[d]; g = dot; }
        int rank = 0;
        for (int n2 = 0; n2 < NBLK; ++n2) { const float g2 = __shfl(g, n2); if (n2 < qblk && (g2 > g || (g2 == g && n2 < lane))) ++rank; }
        const bool sel = (lane < qblk) && (rank < 3);
        const unsigned selmask = (unsigned)(__ballot(sel) & 0xffull);
        float mx = -INFINITY;
        for (int s = lane; s <= t; s += 64) { const int blk = s >> 8; float v = -INFINITY;
            if (blk == qblk || ((selmask >> blk) & 1u)) { const bf16_t* kp = KB + HM(b, h, s, 0); float dot = 0.f;
                for (int d = 0; d < 128; ++d) dot += qs[h][d] * bf2f(kp[d]);
                v = dot * QK_SCALE - slope * (float)(t - s); }
            sc[w][s] = v; mx = fmaxf(mx, v); }
        mx = wave_max(mx);
        float sum = 0.f;
        for (int s = lane; s <= t; s += 64) { const float v = sc[w][s]; const float pv = (v == -INFINITY) ? 0.f : __expf(v - mx); sc[w][s] = pv; sum += pv; }
        sum = wave_sum(sum);
        __syncthreads();
        float o0 = 0.f, o1 = 0.f;
        for (int s = 0; s <= t; ++s) { const float pj = sc[w][s]; if (pj == 0.f) continue; const unsigned vv = *(const unsigned*)(VB + HM(b, h, s, 2 * lane));
            o0 += pj * __uint_as_float(vv << 16); o1 += pj * __uint_as_float(vv & 0xffff0000u); }
        const float inv = 1.f / sum;
        const unsigned zz = *(const unsigned*)(SZB + HM(b, h, t, 2 * lane));
        o0 = o0 * inv * __uint_as_float(zz << 16); o1 = o1 * inv * __uint_as_float(zz & 0xffff0000u);
        *(unsigned*)(Y + m * 2048 + 1024 + h * 128 + 2 * lane) = (unsigned)f2bf(o0) | ((unsigned)f2bf(o1) << 16);
        __syncthreads();
    }
}

namespace pg8 {
#define PG8_LAS __attribute__((address_space(3)))
typedef unsigned short bf16_t;
typedef short bf16x8 __attribute__((ext_vector_type(8)));
typedef float f32x4 __attribute__((ext_vector_type(4)));
typedef unsigned u32x4 __attribute__((ext_vector_type(4)));
constexpr int BM = 256, BK = 64, HALF = 128, HTB = HALF * BK * 2  , STAGE_BYTES = 8 * HTB, NXCD = 8, WGM = 8;

__host__ __device__ __forceinline__ int lds_byte(int r, int c) { const int st = (r >> 4) * 2 + (c >> 5), rr = r & 15, cc = c & 31, ob = rr * 64 + cc * 2; return st * 1024 + (ob ^ (((ob >> 9) & 1) << 5)); }
__host__ __device__ __forceinline__ void stage_rc(int b, int& R, int& C) { const int st = b / 1024, sb = b % 1024, swz = sb ^ (((sb >> 9) & 1) << 5); R = (st >> 1) * 16 + swz / 64; C = (st & 1) * 32 + (swz % 64) / 2; }
__host__ __device__ __forceinline__ int perm32(int rho) { const int n = rho >> 4, i = rho & 15; return 8 * (i >> 2) + 4 * n + (i & 3); }

struct Unit { int pm, pn; };
struct Gemm { const bf16_t* A; const bf16_t* Bt; int M, N, K; };

struct StaticOrder {
    int nM, nN, nwg, G, c;
    __host__ __device__ void init(int M, int N, int G_, int c_) { nM = M / BM; nN = N / BM; nwg = nM * nN; G = G_; c = c_; }
    __host__ __device__ bool next(int i, Unit& u) const {
        const long L = (long)i * G + c; if (L >= nwg) return false;
        int wgid = (int)L; { const int q = nwg / NXCD, r = nwg % NXCD, xcd = wgid % NXCD, off = wgid / NXCD; wgid = (xcd < r ? xcd * (q + 1) : r * (q + 1) + (xcd - r) * q) + off; }
        const int nig = WGM * nN, gid = wgid / nig, fm = gid * WGM, gsz = (nM - fm) < WGM ? (nM - fm) : WGM;
        u.pm = fm + ((wgid % nig) % gsz); u.pn = (wgid % nig) / gsz; return true;
    }
    __device__ __forceinline__ void a_ready(const Unit&) const {}
    __device__ __forceinline__ void done(const Unit&) const {}
};

template <class Epi, class Sched, bool ALIGN_EPI = false, bool SP2 = false>
__device__ __forceinline__ void gemm_phase(PG8_LAS unsigned char* lds, const Gemm g, const Sched& S, const Epi& E) {
    const int tid = threadIdx.x, wid = __builtin_amdgcn_readfirstlane(tid >> 6), lane = tid & 63, wr = wid >> 2, wc = wid & 3, fr = lane & 15, fq = lane >> 4;
    const int K = g.K, nt = K / BK;
    unsigned voffA[2], voffB[2];
#pragma unroll
    for (int i = 0; i < 2; ++i) { int R, C; stage_rc(tid * 16 + i * 8192, R, C); const int Rb = Epi::PERM ? ((R & ~31) + perm32(R & 31)) : R;
        voffA[i] = (unsigned)(R * K + C) * 2u; voffB[i] = (unsigned)(Rb * K + C) * 2u; }
    const size_t kstep = (size_t)(BK * 2);
    const size_t hstep = (size_t)HALF * K * 2;
    const size_t tstep = 2 * hstep;
    const unsigned ldsw = (unsigned)wid * 1024u;
    const int aoff = lds_byte(wr * 64 + fr, fq * 8), boff = lds_byte(wc * 32 + fr, fq * 8);
#define PG8_SA(b, h) (((b) * 2 + (h)) * HTB)
#define PG8_SB(b, h) ((4 + (b) * 2 + (h)) * HTB)
#define PG8_STAGE(bufoff, gbase, voff) do { _Pragma("unroll") for (int _i = 0; _i < 2; ++_i) \
        __builtin_amdgcn_global_load_lds((const unsigned*)((const char*)(gbase) + (voff)[_i]), (PG8_LAS unsigned*)(lds + (bufoff) + ldsw + _i * 8192), 16, 0, 0); } while (0)
#define PG8_LDA(dst, b, h) do { _Pragma("unroll") for (int m = 0; m < 4; ++m) _Pragma("unroll") for (int k = 0; k < 2; ++k) dst[m][k] = *(const PG8_LAS bf16x8*)(lds + PG8_SA(b, h) + aoff + m * 2048 + k * 1024); } while (0)
#define PG8_LDB(dst, b, h) do { _Pragma("unroll") for (int n = 0; n < 2; ++n) _Pragma("unroll") for (int k = 0; k < 2; ++k) dst[n][k] = *(const PG8_LAS bf16x8*)(lds + PG8_SB(b, h) + boff + n * 2048 + k * 1024); } while (0)
#define PG8_MMA(ai, bj, At, Bt) do { __builtin_amdgcn_s_setprio(1); _Pragma("unroll") for (int m = 0; m < 4; ++m) _Pragma("unroll") for (int n = 0; n < 2; ++n) _Pragma("unroll") for (int k = 0; k < 2; ++k) \
        acc[ai][bj][m][n] = __builtin_amdgcn_mfma_f32_16x16x32_bf16(Bt[n][k], At[m][k], acc[ai][bj][m][n], 0, 0, 0); __builtin_amdgcn_s_setprio(0); } while (0)
#define PG8_WAIT_V(n) asm volatile("s_waitcnt vmcnt(" #n ")" ::: "memory")
#define PG8_WAIT_L(n) asm volatile("s_waitcnt lgkmcnt(" #n ")" ::: "memory")
#define PG8_BAR __builtin_amdgcn_s_barrier()
#define PG8_SCHED __builtin_amdgcn_sched_barrier(0)
    Unit cur, nxt; int ui = 0;
    if (!S.next(0, cur)) return;
    f32x4 acc[2][2][4][2];
#pragma unroll
    for (int a = 0; a < 2; ++a)
#pragma unroll
        for (int b = 0; b < 2; ++b)
#pragma unroll
            for (int m = 0; m < 4; ++m)
#pragma unroll
                for (int n = 0; n < 2; ++n) acc[a][b][m][n] = (f32x4){0.f, 0.f, 0.f, 0.f};
    bf16x8 At[4][2], B0[2][2], B1[2][2];
    const char* cA = (const char*)g.A + (size_t)cur.pm * tstep; const char* cB = (const char*)g.Bt + (size_t)cur.pn * tstep;
    S.a_ready(cur);
    if constexpr (SP2) {
        PG8_STAGE(PG8_SB(0, 0), cB, voffB); PG8_STAGE(PG8_SB(0, 1), cB + hstep, voffB); PG8_STAGE(PG8_SA(0, 0), cA, voffA); PG8_STAGE(PG8_SA(0, 1), cA + hstep, voffA);
        if (wr == 1) PG8_BAR;
        PG8_WAIT_V(2); PG8_BAR;
        PG8_STAGE(PG8_SB(1, 0), cB + kstep, voffB); PG8_STAGE(PG8_SA(1, 0), cA + kstep, voffA); PG8_STAGE(PG8_SB(1, 1), cB + hstep + kstep, voffB);
        PG8_WAIT_V(6); PG8_BAR;
    } else {
        PG8_STAGE(PG8_SB(0, 0), cB, voffB); PG8_STAGE(PG8_SA(0, 0), cA, voffA); PG8_STAGE(PG8_SB(0, 1), cB + hstep, voffB); PG8_STAGE(PG8_SA(0, 1), cA + hstep, voffA);
        if (wr == 1) PG8_BAR;
        PG8_WAIT_V(4); PG8_BAR;
        PG8_STAGE(PG8_SB(1, 0), cB + kstep, voffB); PG8_STAGE(PG8_SA(1, 0), cA + kstep, voffA); PG8_STAGE(PG8_SB(1, 1), cB + hstep + kstep, voffB);
        PG8_WAIT_V(6); PG8_BAR;
    }
    for (;;) {
        const bool has_next = S.next(ui + 1, nxt);
        const char* nA = has_next ? (const char*)g.A + (size_t)nxt.pm * tstep : cA; const char* nB = has_next ? (const char*)g.Bt + (size_t)nxt.pn * tstep : cB;
        for (int t = 0; t < nt; t += 2) {
            const bool last = (t == nt - 2);
            const char* a1 = cA + (size_t)(t + 1) * kstep;
            const char* a2 = last ? nA : cA + (size_t)(t + 2) * kstep; const char* b2 = last ? nB : cB + (size_t)(t + 2) * kstep;
            const char* a3 = a2 + kstep; const char* b3 = b2 + kstep;
            if (last && has_next) S.a_ready(nxt);
            if constexpr (SP2) {
            PG8_LDB(B0, 0, 0); PG8_LDB(B1, 0, 1); PG8_SCHED; PG8_LDA(At, 0, 0); PG8_STAGE(PG8_SA(1, 1), a1 + hstep, voffA);
            PG8_WAIT_V(8); PG8_WAIT_L(0); PG8_BAR; PG8_MMA(0, 0, At, B0); PG8_MMA(0, 1, At, B1); PG8_BAR; PG8_SCHED;
            PG8_LDA(At, 0, 1); PG8_STAGE(PG8_SB(0, 0), b2, voffB); PG8_STAGE(PG8_SB(0, 1), b2 + hstep, voffB); PG8_STAGE(PG8_SA(0, 0), a2, voffA);
            PG8_WAIT_V(8); PG8_WAIT_L(0); PG8_BAR; PG8_MMA(1, 0, At, B0); PG8_MMA(1, 1, At, B1); PG8_BAR; PG8_SCHED;
            PG8_LDB(B0, 1, 0); PG8_LDB(B1, 1, 1); PG8_SCHED; PG8_LDA(At, 1, 0); PG8_STAGE(PG8_SA(0, 1), a2 + hstep, voffA);
            PG8_WAIT_V(8); PG8_WAIT_L(0); PG8_BAR; PG8_MMA(0, 0, At, B0); PG8_MMA(0, 1, At, B1); PG8_BAR; PG8_SCHED;
            PG8_LDA(At, 1, 1); PG8_STAGE(PG8_SB(1, 0), b3, voffB); PG8_STAGE(PG8_SB(1, 1), b3 + hstep, voffB); PG8_STAGE(PG8_SA(1, 0), a3, voffA);
            PG8_WAIT_V(8); PG8_WAIT_L(0); PG8_BAR; PG8_MMA(1, 0, At, B0); PG8_MMA(1, 1, At, B1); PG8_BAR; PG8_SCHED;
            } else {
            PG8_LDB(B0, 0, 0); PG8_SCHED; PG8_LDA(At, 0, 0); PG8_STAGE(PG8_SA(1, 1), a1 + hstep, voffA);
            PG8_WAIT_L(8); PG8_BAR; PG8_WAIT_L(0); PG8_MMA(0, 0, At, B0); PG8_BAR; PG8_SCHED;
            PG8_LDB(B1, 0, 1); PG8_STAGE(PG8_SB(0, 0), b2, voffB);
            PG8_BAR; PG8_WAIT_L(0); PG8_MMA(0, 1, At, B1); PG8_BAR;
            PG8_LDA(At, 0, 1); PG8_STAGE(PG8_SA(0, 0), a2, voffA);
            PG8_BAR; PG8_WAIT_L(0); PG8_MMA(1, 0, At, B0); PG8_BAR; PG8_SCHED;
            PG8_STAGE(PG8_SB(0, 1), b2 + hstep, voffB);
            PG8_WAIT_V(6); PG8_BAR; PG8_MMA(1, 1, At, B1); PG8_BAR;
            PG8_LDB(B0, 1, 0); PG8_SCHED; PG8_LDA(At, 1, 0); PG8_STAGE(PG8_SA(0, 1), a2 + hstep, voffA);
            PG8_WAIT_L(8); PG8_BAR; PG8_WAIT_L(0); PG8_MMA(0, 0, At, B0); PG8_BAR; PG8_SCHED;
            PG8_LDB(B1, 1, 1); PG8_STAGE(PG8_SB(1, 0), b3, voffB);
            PG8_BAR; PG8_WAIT_L(0); PG8_MMA(0, 1, At, B1); PG8_BAR;
            PG8_LDA(At, 1, 1); PG8_STAGE(PG8_SA(1, 0), a3, voffA);
            PG8_BAR; PG8_WAIT_L(0); PG8_MMA(1, 0, At, B0); PG8_BAR; PG8_SCHED;
            PG8_STAGE(PG8_SB(1, 1), b3 + hstep, voffB);
            PG8_WAIT_V(6); PG8_BAR; PG8_MMA(1, 1, At, B1); PG8_BAR;
            }
        }
        if constexpr (ALIGN_EPI) { if (wr == 0) PG8_BAR; }
        if constexpr (!Epi::AFTER_DRAIN) { E(acc, cur, wr, wc, fr, fq); S.done(cur); }
        if (!has_next) break;
#pragma unroll
        for (int a = 0; a < 2; ++a)
#pragma unroll
            for (int b = 0; b < 2; ++b)
#pragma unroll
                for (int m = 0; m < 4; ++m)
#pragma unroll
                    for (int n = 0; n < 2; ++n) acc[a][b][m][n] = (f32x4){0.f, 0.f, 0.f, 0.f};
        cur = nxt; cA = nA; cB = nB; ++ui;
        if constexpr (ALIGN_EPI) { if (wr == 1) PG8_BAR; }
    }
    PG8_WAIT_V(0);
    if constexpr (!ALIGN_EPI) { if (wr == 0) PG8_BAR; }
    PG8_BAR;
    if constexpr (Epi::AFTER_DRAIN) { E.fused(acc, cur, wr, wc, fr, fq, lds, wid, lane); S.done(cur); }
#undef PG8_SA
#undef PG8_SB
#undef PG8_STAGE
#undef PG8_LDA
#undef PG8_LDB
#undef PG8_MMA
#undef PG8_WAIT_V
#undef PG8_WAIT_L
#undef PG8_BAR
#undef PG8_SCHED
}
}

#define GAS __attribute__((address_space(1)))
#define LAS __attribute__((address_space(3)))
typedef unsigned v4u __attribute__((ext_vector_type(4)));
typedef float f32x4 __attribute__((ext_vector_type(4)));
typedef GAS unsigned gu32;
#define RLX_AGENT __ATOMIC_RELAXED, __HIP_MEMORY_SCOPE_AGENT
#define LDS_WAIT() asm volatile("s_waitcnt lgkmcnt(0)" ::: "memory")
#define VM_WAIT() asm volatile("s_waitcnt vmcnt(0)" ::: "memory")
constexpr int NWAVES = 8;
constexpr int NPAD = 9472;
constexpr size_t MiB = 1u << 20;
constexpr size_t WS_CTL = 0, CTL_ZERO_BYTES = 1 * MiB;
constexpr size_t WS_MOD = 1 * MiB;
constexpr size_t WS_GAIN = 1 * MiB + 256 * 1024;
constexpr size_t WS_KMEAN = 1 * MiB + 512 * 1024;
constexpr size_t WS_WI = 2 * MiB;
constexpr size_t WS_KI = 3 * MiB;
constexpr size_t WS_MASK = 5 * MiB;
constexpr size_t WS_WOUT = 10 * MiB;
constexpr size_t WS_WIN = 18 * MiB;
constexpr size_t WS_HB = 56 * MiB;
constexpr size_t WS_Y = 56 * MiB;
constexpr size_t WS_QA = 120 * MiB, WS_KA = 152 * MiB, WS_VA = 184 * MiB, WS_SZA = 216 * MiB;
constexpr size_t WS_QB = 248 * MiB, WS_KB = 280 * MiB, WS_VB = 312 * MiB, WS_SZB = 344 * MiB;
constexpr size_t WS_QI = 376 * MiB;
constexpr size_t WS_T32 = 408 * MiB;
constexpr size_t WS_END = 472 * MiB;
constexpr int CW_BAR = 4096;
constexpr int RING_BYTES = 131072;
constexpr int EPI_OFF = RING_BYTES;
constexpr int LDSCTL_OFF = EPI_OFF + 16384, MISC_OFF = LDSCTL_OFF + 320;
constexpr int LDS_BYTES = 163840;

#define XB_TMO      128
#define XB_XCNT(j)  (256  + 64 * (j))
#define XB_XSUB(j)  (1280 + 64 * (j))
#define XB_XGEN(j)  (2304 + 64 * (j))
#define XB_TOP      3328
#define XB_TOPGEN   3392
#define XCD_BAR_WORDS 3456
#define XB_SPIN_CAP (1u << 18)

__device__ __forceinline__ unsigned xb_ld(unsigned* p)              { return __hip_atomic_load(p, __ATOMIC_RELAXED, __HIP_MEMORY_SCOPE_AGENT); }
__device__ __forceinline__ unsigned xb_add(unsigned* p, unsigned v) { return __hip_atomic_fetch_add(p, v, __ATOMIC_RELAXED, __HIP_MEMORY_SCOPE_AGENT); }
__device__ __forceinline__ unsigned xb_xcc_id() { return (unsigned)__builtin_amdgcn_s_getreg((3 << 11) | 20) & 0xFu; }
#define XB_SPIN(cond, bar) do { unsigned _sp = 0; while (cond) { __builtin_amdgcn_s_sleep(1); \
    if ((++_sp & 255u) == 0u) { if (xb_ld(&(bar)[XB_TMO])) break; if (_sp > XB_SPIN_CAP) { atomicAdd(&(bar)[XB_TMO], 1u); break; } } } } while (0)

struct XcdBarrier {
    unsigned* bar; unsigned x;
    volatile LAS unsigned* st;
};

__device__ __forceinline__ XcdBarrier xcd_barrier_post(unsigned* bar, volatile LAS unsigned* st) {
    XcdBarrier b; b.bar = bar; b.x = xb_xcc_id(); b.st = st;
    if (threadIdx.x == 0) (void)xb_add(&bar[XB_XCNT(b.x)], 1u);
    return b;
}
__device__ __forceinline__ void xcd_barrier_complete(unsigned* bar, unsigned x, unsigned& nloc, unsigned& nx) {
    const unsigned G = gridDim.x * gridDim.y * gridDim.z;
    unsigned sum, cnt, mine, sp = 0u;
    for (;;) {
        sum = 0u; cnt = 0u; mine = 0u;
#pragma unroll
        for (unsigned j = 0; j < 16; ++j) { const unsigned c = xb_ld(&bar[XB_XCNT(j)]); sum += c; cnt += (c > 0u) ? 1u : 0u; mine = (j == x) ? c : mine; }
        if (sum == G) break;
        __builtin_amdgcn_s_sleep(1);
        if ((++sp & 255u) == 0u) { if (xb_ld(&bar[XB_TMO])) break; if (sp > XB_SPIN_CAP) { atomicAdd(&bar[XB_TMO], 1u); break; } }
    }
    nloc = mine > 0u ? mine : 1u; nx = cnt > 0u ? cnt : 1u;
}

__device__ __forceinline__ void xcd_barrier(const XcdBarrier& b) {
    asm volatile("s_waitcnt vmcnt(0)" ::: "memory");
    __syncthreads();
    if (threadIdx.x == 0) {
        unsigned* bar = b.bar;
        __builtin_amdgcn_s_waitcnt(0);
        unsigned nloc = b.st[0], nx = b.st[1];
        if (nloc == 0u) { xcd_barrier_complete(bar, b.x, nloc, nx); b.st[0] = nloc; b.st[1] = nx; }
        const unsigned old = xb_add(&bar[XB_XSUB(b.x)], 1u);
        const unsigned gen = old / nloc;
        if (old + 1u == (gen + 1u) * nloc) {
            __builtin_amdgcn_fence(__ATOMIC_RELEASE, "agent");
            asm volatile("s_waitcnt vmcnt(0)" ::: "memory");
            const unsigned og = xb_add(&bar[XB_TOP], 1u);
            const unsigned tg = og / nx;
            if (og + 1u == (tg + 1u) * nx) xb_add(&bar[XB_TOPGEN], 1u);
            else XB_SPIN(xb_ld(&bar[XB_TOPGEN]) == tg, bar);
            __builtin_amdgcn_fence(__ATOMIC_ACQUIRE, "agent");
            xb_add(&bar[XB_XGEN(b.x)], 1u);
            asm volatile("s_waitcnt vmcnt(0)" ::: "memory");
        } else {
            XB_SPIN(xb_ld(&bar[XB_XGEN(b.x)]) == gen, bar);
            __builtin_amdgcn_fence(__ATOMIC_ACQUIRE, "agent");
            asm volatile("s_waitcnt vmcnt(0)" ::: "memory");
        }
    }
    __syncthreads();
}


struct Frame {
    LAS unsigned char* lds; volatile LAS unsigned* MISC; gu32* ctl; int tid, lane, wave, vcu, G;
};
__device__ __forceinline__ unsigned cvt_pk_bf16(float lo, float hi) { unsigned r; asm volatile("v_cvt_pk_bf16_f32 %0, %1, %2" : "=v"(r) : "v"(lo), "v"(hi)); return r; }
__device__ __forceinline__ unsigned f2bf_u(float f) { unsigned u = __builtin_bit_cast(unsigned, f); return (u + 0x7fffu + ((u >> 16) & 1u)) >> 16; }
__device__ __forceinline__ unsigned pk2(float lo, float hi) { return f2bf_u(lo) | (f2bf_u(hi) << 16); }
__device__ __forceinline__ float fast_silu(float v) { return v * __builtin_amdgcn_rcpf(1.f + __expf(-v)); }

__device__ __forceinline__ void p0_mod(Frame& F, int id, const float* __restrict__ c, const float* __restrict__ w_ada, const float* __restrict__ b_ada, float* __restrict__ MOD) {
    LAS float* sc = (LAS float*)(F.lds);
    LAS float* red = (LAS float*)(F.lds + 65536);
    for (int i = F.tid; i < BATCH * DM; i += NWAVES * 64) sc[i] = silu_f(c[i]);
    __syncthreads();
    const int cq = F.tid & 7, kq = F.tid >> 3, col0 = 32 * id + 4 * cq;
    f32x4 acc[8];
#pragma unroll
    for (int b = 0; b < 8; ++b) acc[b] = (f32x4){0.f, 0.f, 0.f, 0.f};
#pragma unroll 4
    for (int i = 0; i < 32; ++i) { const int k = kq + 64 * i; const f32x4 w = *(const f32x4*)(w_ada + (size_t)k * (3 * DM) + col0);
#pragma unroll
        for (int b = 0; b < 8; ++b) acc[b] += w * sc[b * DM + k]; }
#pragma unroll
    for (int b = 0; b < 8; ++b) *(LAS f32x4*)(red + (kq * 8 + b) * 32 + 4 * cq) = acc[b];
    __syncthreads();
    if (F.tid < 256) { const int b = F.tid >> 5, cc = F.tid & 31; float s = 0.f;
        for (int q = 0; q < 64; ++q) s += red[(q * 8 + b) * 32 + cc];
        MOD[b * 3 * DM + 32 * id + cc] = s + b_ada[32 * id + cc]; }
    __syncthreads();
}
template <bool MAPWIN>
__device__ __forceinline__ void p0_transpose_item(const float* __restrict__ W, int K, int N, int NP, bf16_t* __restrict__ WT, LAS float* scr, int item, int lane) {
    const int nblk = NP / 32, kb = item / nblk, nb = item % nblk, k0 = 64 * kb, n0 = 32 * nb;
    const int np = n0 + (lane & 31);
    int src = np; bool valid = true;
    if (MAPWIN) { if (np >= 5376) src = np - 176; else if (np >= 5200) valid = false; }
#pragma unroll 8
    for (int i = 0; i < 32; ++i) { const int kk = 2 * i + (lane >> 5); scr[kk * 33 + (lane & 31)] = valid ? W[(size_t)(k0 + kk) * N + src] : 0.f; }
    LDS_WAIT(); asm volatile("" ::: "memory");
    const int c = lane & 7;
#pragma unroll
    for (int j = 0; j < 4; ++j) { const int n = (lane >> 3) + 8 * j; const LAS float* s = scr + (8 * c) * 33 + n;
        v4u o; o.x = pk2(s[0 * 33], s[1 * 33]); o.y = pk2(s[2 * 33], s[3 * 33]); o.z = pk2(s[4 * 33], s[5 * 33]); o.w = pk2(s[6 * 33], s[7 * 33]);
        *(GAS v4u*)(WT + (size_t)(n0 + n) * K + k0 + 8 * c) = o; }
    LDS_WAIT(); asm volatile("" ::: "memory");
}
__device__ __forceinline__ void p0_convert(Frame& F, const float* __restrict__ w_in, const float* __restrict__ w_out, bf16_t* __restrict__ WinT, bf16_t* __restrict__ WoutT) {
    LAS float* scr = (LAS float*)(F.lds + F.wave * 16384);
    const int gw = F.vcu * NWAVES + F.wave, NGW = F.G * NWAVES;
    constexpr int I_IN = (DM / 64) * (NPAD / 32), I_OUT = (DM / 64) * (DM / 32);
    for (int it = gw; it < I_IN + I_OUT; it += NGW) {
        if (it < I_IN) p0_transpose_item<true>(w_in, DM, DIN, NPAD, WinT, scr, it, F.lane);
        else p0_transpose_item<false>(w_out, DM, DM, DM, WoutT, scr, it - I_IN, F.lane);
    }
}
__device__ __forceinline__ void p1_norm(Frame& F, const float* __restrict__ x, const float* __restrict__ g, const float* __restrict__ MOD, bf16_t* __restrict__ HB) {
    for (int v = F.vcu; v < M / 64; v += F.G) {
        const int b = v / (SEQ / 64);
        const float* shift = MOD + b * 3 * DM; const float* scale = shift + DM;
        f32x4 gs[8], sh[8];
#pragma unroll
        for (int j = 0; j < 8; ++j) { const int k = 4 * F.lane + 256 * j; const f32x4 gg = *(const f32x4*)(g + k), ss = *(const f32x4*)(scale + k); gs[j] = gg * (ss + 1.0f); sh[j] = *(const f32x4*)(shift + k); }
        for (int r = 0; r < 8; ++r) {
            const int row = 64 * v + 8 * F.wave + r;
            const f32x4* xr = (const f32x4*)(x + (size_t)row * DM) + F.lane;
            f32x4 xv[8]; float ss = 0.f;
#pragma unroll
            for (int j = 0; j < 8; ++j) { xv[j] = xr[64 * j]; ss += (xv[j].x * xv[j].x + xv[j].y * xv[j].y) + (xv[j].z * xv[j].z + xv[j].w * xv[j].w); }
            ss = wave_sum(ss);
            const float rstd = rsqrtf(ss * (1.f / DM) + RMS_EPS);
            unsigned long long* o8 = (unsigned long long*)(HB + (size_t)row * DM) + F.lane;
#pragma unroll
            for (int j = 0; j < 8; ++j) { const f32x4 h = xv[j] * rstd * gs[j] + sh[j];
                o8[64 * j] = (unsigned long long)pk2(h.x, h.y) | ((unsigned long long)pk2(h.z, h.w) << 32); }
        }
    }
}
struct EpiProj {
    static constexpr bool PERM = true, AFTER_DRAIN = false;
    unsigned char* ws;
    LAS float* P;
    __device__ __forceinline__ void operator()(const pg8::f32x4 (&acc)[2][2][4][2], const pg8::Unit& u, int wr, int wc, int fr, int fq) const {
        const int pn = u.pn;
        bf16_t* const KI = (bf16_t*)(ws + WS_KI); float* const WI = (float*)(ws + WS_WI); bf16_t* const QI = (bf16_t*)(ws + WS_QI);
        int grp, sub;
        if (pn < 20) { grp = pn >> 2; sub = pn & 3; } else if (pn == 20) { grp = 5; sub = 0; } else { grp = 6 + ((pn - 21) >> 2); sub = (pn - 21) & 3; }
        const int b = u.pm >> 3, t0 = (u.pm & 7) * 256 + wr * 64 + fr;
        const int cl = 32 * wc + 8 * fq;
        const bool norm = (grp == 0 || grp == 1 || grp == 6 || grp == 7 || grp == 5);
        float rs[2][4][2];
        if (norm) {
#pragma unroll
            for (int ai = 0; ai < 2; ++ai)
#pragma unroll
                for (int m = 0; m < 4; ++m)
#pragma unroll
                    for (int bj = 0; bj < 2; ++bj) { const pg8::f32x4 a = acc[ai][bj][m][0], c = acc[ai][bj][m][1];
                        float s = (a[0] * a[0] + a[1] * a[1]) + (a[2] * a[2] + a[3] * a[3]) + (c[0] * c[0] + c[1] * c[1]) + (c[2] * c[2] + c[3] * c[3]);
                        s += __shfl_xor(s, 16); s += __shfl_xor(s, 32);
                        if (fq == 0) P[((ai * 128 + wr * 64 + m * 16 + fr) * 2 + bj) * 4 + wc] = s; }
            asm volatile("s_waitcnt lgkmcnt(0)" ::: "memory"); __builtin_amdgcn_s_barrier(); asm volatile("" ::: "memory");
#pragma unroll
            for (int ai = 0; ai < 2; ++ai)
#pragma unroll
                for (int m = 0; m < 4; ++m)
#pragma unroll
                    for (int bj = 0; bj < 2; ++bj) { const pg8::f32x4 q = *(const LAS pg8::f32x4*)(P + ((ai * 128 + wr * 64 + m * 16 + fr) * 2 + bj) * 4);
                        rs[ai][m][bj] = (grp == 5) ? rsqrtf((q[0] + q[1]) * (1.f / 64.f) + RMS_EPS) : rsqrtf(((q[0] + q[1]) + (q[2] + q[3])) * (1.f / 128.f) + RMS_EPS); }
        }
        if (grp == 5) {
            if (wc < 2) { const float* gki = (const float*)(ws + WS_GAIN) + 4 * 128; const pg8::f32x4 g0 = *(const pg8::f32x4*)(gki + cl), g1 = *(const pg8::f32x4*)(gki + cl + 4);
#pragma unroll
                for (int ai = 0; ai < 2; ++ai)
#pragma unroll
                    for (int m = 0; m < 4; ++m) { const size_t row = (size_t)b * SEQ + t0 + 128 * ai + 16 * m; const float r = rs[ai][m][0];
                        const pg8::f32x4 v0 = acc[ai][0][m][0] * r * g0, v1 = acc[ai][0][m][1] * r * g1;
                        pg8::u32x4 w; w.x = cvt_pk_bf16(v0[0], v0[1]); w.y = cvt_pk_bf16(v0[2], v0[3]); w.z = cvt_pk_bf16(v1[0], v1[1]); w.w = cvt_pk_bf16(v1[2], v1[3]);
                        *(pg8::u32x4*)(KI + row * 64 + cl) = w; } }
            else if (wc == 2 && fq < 2) {
#pragma unroll
                for (int ai = 0; ai < 2; ++ai)
#pragma unroll
                    for (int m = 0; m < 4; ++m) { const size_t row = (size_t)b * SEQ + t0 + 128 * ai + 16 * m;
                        *(pg8::f32x4*)(WI + row * 16 + 8 * fq) = acc[ai][0][m][0]; *(pg8::f32x4*)(WI + row * 16 + 8 * fq + 4) = acc[ai][0][m][1]; } }
            return;
        }
        if (grp == 4) {
#pragma unroll
            for (int ai = 0; ai < 2; ++ai)
#pragma unroll
                for (int m = 0; m < 4; ++m) { const size_t row = (size_t)b * SEQ + t0 + 128 * ai + 16 * m;
#pragma unroll
                    for (int bj = 0; bj < 2; ++bj) { const pg8::f32x4 v0 = acc[ai][bj][m][0], v1 = acc[ai][bj][m][1];
                        pg8::u32x4 w; w.x = cvt_pk_bf16(v0[0], v0[1]); w.y = cvt_pk_bf16(v0[2], v0[3]); w.z = cvt_pk_bf16(v1[0], v1[1]); w.w = cvt_pk_bf16(v1[2], v1[3]);
                        *(pg8::u32x4*)(QI + row * 1024 + sub * 256 + bj * 128 + cl) = w; } }
            return;
        }
        bf16_t* dst; const float* gain = nullptr;
        { const int slot = grp < 4 ? grp : grp - 2;
          dst = (bf16_t*)(ws + WS_QA + (size_t)slot * (32 * MiB));
          gain = (const float*)(ws + WS_GAIN) + (grp < 2 ? grp : grp - 4) * 128; }
        pg8::f32x4 g0 = {1.f, 1.f, 1.f, 1.f}, g1 = {1.f, 1.f, 1.f, 1.f};
        if (norm) { g0 = *(const pg8::f32x4*)(gain + cl); g1 = *(const pg8::f32x4*)(gain + cl + 4); }
        const bool act = (grp == 3 || grp == 9);
#pragma unroll
        for (int ai = 0; ai < 2; ++ai)
#pragma unroll
            for (int m = 0; m < 4; ++m) { const int t = t0 + 128 * ai + 16 * m;
#pragma unroll
                for (int bj = 0; bj < 2; ++bj) { const int h = 2 * sub + bj;
                    pg8::f32x4 v0 = acc[ai][bj][m][0], v1 = acc[ai][bj][m][1];
                    if (norm) { const float r = rs[ai][m][bj]; v0 = v0 * r * g0; v1 = v1 * r * g1; }
                    if (act) { v0[0] = fast_silu(v0[0]); v0[1] = fast_silu(v0[1]); v0[2] = fast_silu(v0[2]); v0[3] = fast_silu(v0[3]);
                               v1[0] = fast_silu(v1[0]); v1[1] = fast_silu(v1[1]); v1[2] = fast_silu(v1[2]); v1[3] = fast_silu(v1[3]); }
                    pg8::u32x4 w; w.x = cvt_pk_bf16(v0[0], v0[1]); w.y = cvt_pk_bf16(v0[2], v0[3]); w.z = cvt_pk_bf16(v1[0], v1[1]); w.w = cvt_pk_bf16(v1[2], v1[3]);
                    *(pg8::u32x4*)(dst + HM(b, h, t, cl)) = w; } }
    }
};
struct EpiOut {
    static constexpr bool PERM = false, AFTER_DRAIN = false;
    const float* x; const float* MOD; float* out;
    __device__ __forceinline__ void operator()(const pg8::f32x4 (&acc)[2][2][4][2], const pg8::Unit& u, int wr, int wc, int fr, int fq) const {
        const int b = u.pm >> 3; const float* gate = MOD + b * 3 * DM + 2 * DM;
        const int col0 = u.pn * 256 + wc * 32 + 4 * fq;
        pg8::f32x4 gv[2][2];
#pragma unroll
        for (int bj = 0; bj < 2; ++bj)
#pragma unroll
            for (int n = 0; n < 2; ++n) gv[bj][n] = *(const pg8::f32x4*)(gate + col0 + bj * 128 + n * 16);
#pragma unroll
        for (int ai = 0; ai < 2; ++ai)
#pragma unroll
            for (int m = 0; m < 4; ++m) { const size_t off = (size_t)(u.pm * 256 + ai * 128 + wr * 64 + m * 16 + fr) * DM + col0;
#pragma unroll
                for (int bj = 0; bj < 2; ++bj)
#pragma unroll
                    for (int n = 0; n < 2; ++n) { const pg8::f32x4 xv = *(const pg8::f32x4*)(x + off + bj * 128 + n * 16);
                        *(pg8::f32x4*)(out + off + bj * 128 + n * 16) = xv + gv[bj][n] * acc[ai][bj][m][n]; }
                if (m & 1) asm volatile("" ::: "memory"); }
    }
};

namespace att {
typedef short bf16x8 __attribute__((ext_vector_type(8)));
typedef short s16x4 __attribute__((ext_vector_type(4)));
typedef float f32x16 __attribute__((ext_vector_type(16)));
typedef float f32x4 __attribute__((ext_vector_type(4)));
typedef unsigned u32x4 __attribute__((ext_vector_type(4)));
constexpr int NW = 8, QBLK = 32, KVBLK = 64, QB = NW * QBLK, D = 128;
constexpr int SHM_V = KVBLK * D * 2, SHM_K = KVBLK * D * 2;
constexpr int LDS_WS = 2 * SHM_V + 2 * SHM_K, LDS_KM = LDS_WS + NW * 64 * 4, LDS_OST = 73728, LDS_BYTES = LDS_OST + NW * QBLK * D * 2;
constexpr float SCALE = 0.08838834764831845f, THR = 8.f;
#define KSWZ(row, colB) ((row) * 256 + ((colB) ^ (((row) & 7) << 4)))
#define SBAR() __builtin_amdgcn_sched_barrier(0)
__device__ __forceinline__ int v_st(int k, int c) { const int kk = (k & ~0xC) | ((k & 4) << 1) | ((k & 8) >> 1); return ((kk >> 3) * 4 + (c >> 5)) * 512 + ((kk & 7) * 32 + (c & 31)) * 2; }
__device__ __forceinline__ int v_rd_base(int lane) { return ((lane & 3) << 3) | (((lane >> 2) & 3) << 6) | (((lane >> 4) & 1) << 5) | (((lane >> 5) & 1) << 8); }
constexpr int v_rd_off(int d0, int ks, int half) { return d0 * 512 + ks * 4096 + half * 2048; }
__device__ __forceinline__ int crow(int r, int hi) { return (r & 3) + 8 * (r >> 2) + 4 * hi; }
__device__ __forceinline__ unsigned cvtpk(float lo, float hi) { unsigned r; asm volatile("v_cvt_pk_bf16_f32 %0, %1, %2" : "=v"(r) : "v"(lo), "v"(hi)); return r; }
__device__ __forceinline__ unsigned cvt1(float v) { unsigned r; asm volatile("v_cvt_pk_bf16_f32 %0, %1, 0" : "=v"(r) : "v"(v)); return r; }
__device__ __forceinline__ bf16x8 load8(const bf16_t* p) { return *reinterpret_cast<const bf16x8*>(p); }
__device__ __forceinline__ void mask_causal(f32x16& p0, f32x16& p1, int dq) {
    const float NEG = -__builtin_inff();
#pragma unroll
    for (int r = 0; r < 16; ++r) { const int c = (r & 3) + 8 * (r >> 2); if (dq - c < 0) p0[r] = NEG; if (dq - c - 32 < 0) p1[r] = NEG; }
}
__device__ __forceinline__ void mask_bits(f32x16& p0, f32x16& p1, unsigned w0, unsigned w1) {
    const unsigned NEGB = 0xff800000u;
#pragma unroll
    for (int r = 0; r < 16; ++r) { const int c = (r & 3) + 8 * (r >> 2);
        const unsigned t0 = (unsigned)(((int)(w0 << (31 - c))) >> 31), t1 = (unsigned)(((int)(w1 << (31 - c))) >> 31);
        p0[r] = __uint_as_float((__float_as_uint(p0[r]) & t0) | (NEGB & ~t0));
        p1[r] = __uint_as_float((__float_as_uint(p1[r]) & t1) | (NEGB & ~t1)); }
}
__device__ __forceinline__ void partialSM(f32x16& p0, f32x16& p1, float& m_reg, float& mn, float& alpha) {
    float pmax = p0[0]; for (int r = 1; r < 16; ++r) pmax = fmaxf(pmax, p0[r]); for (int r = 0; r < 16; ++r) pmax = fmaxf(pmax, p1[r]);
    { auto rr = __builtin_amdgcn_permlane32_swap(__float_as_uint(pmax), __float_as_uint(pmax), false, false);
      pmax = fmaxf(__uint_as_float(rr[0]), __uint_as_float(rr[1])); }
    constexpr float C2 = 1.4426950408889634f * SCALE;
    if (__builtin_expect(__all((pmax - m_reg) * SCALE <= THR), 1)) { mn = m_reg; alpha = 1.f; }
    else { mn = fmaxf(m_reg, pmax); alpha = __builtin_amdgcn_exp2f((m_reg - mn) * C2); m_reg = mn; }
    const float mnL = -mn * C2;
    for (int r = 0; r < 16; ++r) p0[r] = fmaf(p0[r], C2, mnL); for (int r = 0; r < 16; ++r) p1[r] = fmaf(p1[r], C2, mnL);
    for (int r = 0; r < 16; ++r) p0[r] = __builtin_amdgcn_exp2f(p0[r]);
}
__device__ __forceinline__ void finishSM(f32x16& p0, f32x16& p1, float alpha, float& l_reg, bf16x8& pa0, bf16x8& pa1, bf16x8& pa2, bf16x8& pa3) {
    for (int r = 0; r < 16; ++r) p1[r] = __builtin_amdgcn_exp2f(p1[r]);
    float ps = 0; for (int r = 0; r < 16; ++r) ps += p0[r]; for (int r = 0; r < 16; ++r) ps += p1[r];
    { auto rr = __builtin_amdgcn_permlane32_swap(__float_as_uint(ps), __float_as_uint(ps), false, false);
      ps = __uint_as_float(rr[0]) + __uint_as_float(rr[1]); }
    l_reg = l_reg * alpha + ps;
#define PK4(P, B_, OUT) do { unsigned a0 = cvtpk(P[B_+0], P[B_+1]), a1 = cvtpk(P[B_+2], P[B_+3]);                          \
        unsigned b0 = cvtpk(P[B_+4], P[B_+5]), b1 = cvtpk(P[B_+6], P[B_+7]);                                             \
        auto r0 = __builtin_amdgcn_permlane32_swap(a0, b0, false, false); auto r1 = __builtin_amdgcn_permlane32_swap(a1, b1, false, false); \
        u32x4 w = {r0[0], r1[0], r0[1], r1[1]}; OUT = *reinterpret_cast<bf16x8*>(&w); } while (0)
    PK4(p0, 0, pa0); PK4(p0, 8, pa1); PK4(p1, 0, pa2); PK4(p1, 8, pa3);
#undef PK4
}
template <int KB>
__device__ __forceinline__ void qkt(f32x16& p0, f32x16& p1, const char* K_lds, int r32, int hi, const bf16x8* qr, float cb, float sl) {
#pragma unroll
    for (int r = 0; r < 16; ++r) { const int c = (r & 3) + 8 * (r >> 2); p0[r] = fmaf(sl, (float)c, cb); p1[r] = fmaf(sl, (float)(c + 32), cb); }
    const char* kb[4];
#pragma unroll
    for (int dd = 0; dd < 4; ++dd) kb[dd] = K_lds + KB * SHM_K + KSWZ(r32, (dd * 16 + hi * 8) * 2);
#pragma unroll
    for (int d0 = 0; d0 < 8; ++d0) { const char* a = kb[d0 & 3] + (d0 >> 2) * 128;
        bf16x8 b0 = *reinterpret_cast<const bf16x8*>(a);
        bf16x8 b1 = *reinterpret_cast<const bf16x8*>(a + 32 * 256);
        p0 = __builtin_amdgcn_mfma_f32_32x32x16_bf16(b0, qr[d0], p0, 0, 0, 0);
        p1 = __builtin_amdgcn_mfma_f32_32x32x16_bf16(b1, qr[d0], p1, 0, 0, 0); }
}
template <int VB>
__device__ __forceinline__ void pv_tile(f32x16* o, int vb0, bf16x8 pa0, bf16x8 pa1, bf16x8 pa2, bf16x8 pa3) {
#define TRRD(dst, off) asm volatile("ds_read_b64_tr_b16 %0, %1 offset:%2" : "=&v"(dst) : "v"(vb0), "i"(off) : "memory")
#define PV_D0(d0) do { s16x4 l0, l1, l2, l3, h0, h1, h2, h3; constexpr int b_ = VB * SHM_V + v_rd_off(d0, 0, 0); \
        TRRD(l0, b_); TRRD(h0, b_ + 2048); TRRD(l1, b_ + 4096); TRRD(h1, b_ + 6144); TRRD(l2, b_ + 8192); TRRD(h2, b_ + 10240); TRRD(l3, b_ + 12288); TRRD(h3, b_ + 14336); \
        asm volatile("s_waitcnt lgkmcnt(0)" ::: "memory"); SBAR();   \
        o[d0] = __builtin_amdgcn_mfma_f32_32x32x16_bf16(pa0, (bf16x8){l0[0], l0[1], l0[2], l0[3], h0[0], h0[1], h0[2], h0[3]}, o[d0], 0, 0, 0);   \
        o[d0] = __builtin_amdgcn_mfma_f32_32x32x16_bf16(pa1, (bf16x8){l1[0], l1[1], l1[2], l1[3], h1[0], h1[1], h1[2], h1[3]}, o[d0], 0, 0, 0);   \
        o[d0] = __builtin_amdgcn_mfma_f32_32x32x16_bf16(pa2, (bf16x8){l2[0], l2[1], l2[2], l2[3], h2[0], h2[1], h2[2], h2[3]}, o[d0], 0, 0, 0);   \
        o[d0] = __builtin_amdgcn_mfma_f32_32x32x16_bf16(pa3, (bf16x8){l3[0], l3[1], l3[2], l3[3], h3[0], h3[1], h3[2], h3[3]}, o[d0], 0, 0, 0); } while (0)
    PV_D0(0); PV_D0(1); PV_D0(2); PV_D0(3);
#undef PV_D0
#undef TRRD
}

struct BlockRef { int grp, b, h, qb; };
__device__ __forceinline__ size_t hm_off(const BlockRef& r) { return ((size_t)(r.b * NH + r.h) * SEQ) * D; }
__device__ __forceinline__ const bf16_t* ptrQ(unsigned char* wsb, const BlockRef& r) { return (const bf16_t*)(wsb + (r.grp ? WS_QB : WS_QA)) + hm_off(r) + (size_t)r.qb * QB * D; }
__device__ __forceinline__ const bf16_t* ptrK(unsigned char* wsb, const BlockRef& r) { return (const bf16_t*)(wsb + (r.grp ? WS_KB : WS_KA)) + hm_off(r); }
__device__ __forceinline__ const bf16_t* ptrV(unsigned char* wsb, const BlockRef& r) { return (const bf16_t*)(wsb + (r.grp ? WS_VB : WS_VA)) + hm_off(r); }
__device__ __forceinline__ const bf16_t* ptrZ(unsigned char* wsb, const BlockRef& r) { return (const bf16_t*)(wsb + (r.grp ? WS_SZB : WS_SZA)) + hm_off(r) + (size_t)r.qb * QB * D; }
struct Seam { bf16x8 qr[8]; bf16x8 st_v0, st_v1, st_k0, st_k1; };
#define ROW(p, k0, rr) ((const bf16_t*)((const char*)(p) + (unsigned)(((k0) + (rr)) * (D * 2) + sc * 2)))
#define VMW() asm volatile("s_waitcnt vmcnt(0)" ::: "memory")
#define VMWN(n) asm volatile("s_waitcnt vmcnt(%0)" :: "i"(n) : "memory")
#define SLOAD_H(Kp, Vp, k0) do { S.st_v0 = load8(ROW(Vp, k0, sr)); S.st_v1 = load8(ROW(Vp, k0, 32 + sr));              \
                         S.st_k0 = load8(ROW(Kp, k0, sr)); S.st_k1 = load8(ROW(Kp, k0, 32 + sr)); } while (0)
#define SWRITE_HK(bf) do { *(bf16x8*)(K_lds + (bf) * SHM_K + kws) = S.st_k0; *(bf16x8*)(K_lds + (bf) * SHM_K + kws + 32 * 256) = S.st_k1; } while (0)
#define SWRITE_HV(bf) do { *(bf16x8*)(V_lds + (bf) * SHM_V + vst0) = S.st_v0; *(bf16x8*)(V_lds + (bf) * SHM_V + vst1) = S.st_v1; } while (0)
#define SWRITE_H(bf) do { SWRITE_HV(bf); SWRITE_HK(bf); } while (0)
__device__ __forceinline__ void prime(const BlockRef& cur, unsigned char* wsb, char* lds, Seam& S) {
    const int tid = threadIdx.x, wid = __builtin_amdgcn_readfirstlane(tid >> 6), lane = tid & 63, r32 = lane & 31, hi = lane >> 5;
    const int sr = tid >> 4, sc = (tid & 15) * 8, kws = KSWZ(sr, sc * 2); char* K_lds = lds + 2 * SHM_V;
    const bf16_t* Qp = ptrQ(wsb, cur); const bf16_t* Kp = ptrK(wsb, cur); const bf16_t* Vp = ptrV(wsb, cur);
    for (int d0 = 0; d0 < 8; ++d0) S.qr[d0] = load8(Qp + (size_t)(wid * QBLK + r32) * D + d0 * 16 + hi * 8);
    SLOAD_H(Kp, Vp, 0); VMW(); SWRITE_HK(0);
    __syncthreads();
}
__device__ __forceinline__ void block(const BlockRef& cur, unsigned char* wsb, char* lds, Seam& S) {
    const int GRP = cur.grp;
    const int tid = threadIdx.x, wid = __builtin_amdgcn_readfirstlane(tid >> 6), lane = tid & 63, r32 = lane & 31, hi = lane >> 5;
    const int NT = 4 * cur.qb + 4;
    const int qlo = cur.qb * QB + wid * QBLK, qm = qlo + r32 - 4 * hi;
    char* V_lds = lds; char* K_lds = lds + 2 * SHM_V;
    float* ws = (float*)(lds + LDS_WS) + wid * 64; float* li_l = ws, * al_l = ws + 32;
    float m_reg = -1e30f, l_reg = 0; f32x16 o[4] = {};
    const int sr = tid >> 4, sc = (tid & 15) * 8, vst0 = v_st(sr, sc), vst1 = v_st(32 + sr, sc), kws = KSWZ(sr, sc * 2);
    const int vb0 = (int)(uintptr_t)V_lds + v_rd_base(lane);
    const bf16_t* Kh = ptrK(wsb, cur); const bf16_t* Vh = ptrV(wsb, cur);
    const float sl = exp2f(-(float)(cur.h + 1)) * 11.313708498984761f;
    unsigned selbits = 0xffu;
    if (GRP == 1) {
        float* km = (float*)(lds + LDS_KM);
        const float* KM = (const float*)(wsb + WS_KMEAN) + ((size_t)(cur.b * NBLK) * NH + cur.h) * 128;
        if (tid < cur.qb * 32) { const int n = tid >> 5, c4 = (tid & 31) * 4; *(f32x4*)(km + n * 128 + c4) = *(const f32x4*)(KM + (size_t)n * (NH * 128) + c4); }
        __syncthreads();
        float v1 = -__builtin_inff(), v2 = v1, v3 = v1; int i1 = 31, i2 = 31, i3 = 31;
#pragma unroll 1
        for (int n = 0; n < cur.qb; ++n) { float a = 0.f;
#pragma unroll
            for (int d0 = 0; d0 < 8; ++d0) { const f32x4 k0 = *(const f32x4*)(km + n * 128 + d0 * 16 + hi * 8), k1 = *(const f32x4*)(km + n * 128 + d0 * 16 + hi * 8 + 4);
                const bf16x8 q = S.qr[d0];
                a += bf2f((bf16_t)q[0]) * k0[0] + bf2f((bf16_t)q[1]) * k0[1] + bf2f((bf16_t)q[2]) * k0[2] + bf2f((bf16_t)q[3]) * k0[3]
                   + bf2f((bf16_t)q[4]) * k1[0] + bf2f((bf16_t)q[5]) * k1[1] + bf2f((bf16_t)q[6]) * k1[2] + bf2f((bf16_t)q[7]) * k1[3]; }
            const float other = __shfl_xor(a, 32); const float g = a + other;
            const bool c1 = g > v1, c2 = g > v2, c3 = g > v3;
            v3 = c2 ? v2 : (c3 ? g : v3); i3 = c2 ? i2 : (c3 ? n : i3);
            v2 = c1 ? v1 : (c2 ? g : v2); i2 = c1 ? i1 : (c2 ? n : i2);
            v1 = c1 ? g : v1;             i1 = c1 ? n : i1; }
        selbits = ((1u << i1) | (1u << i2) | (1u << i3)) & 0xffu;
    }
    const char* mbase = (const char*)(wsb + WS_MASK) + ((size_t)cur.b * SEQ + qlo) * 256;
    const unsigned moff = (unsigned)r32 * 256u;
#define RESC(a) do { if (__any((a) < 1.f)) { if (hi == 0) al_l[r32] = (a); asm volatile("s_waitcnt lgkmcnt(0)" ::: "memory");              \
                     for (int d_ = 0; d_ < 4; ++d_) for (int r = 0; r < 16; ++r) o[d_][r] *= al_l[crow(r, hi)]; } } while (0)
#define KBASE(t) ((t) * KVBLK)
#define CB(t) ((GRP == 1 && (t) < 4 * cur.qb && !((selbits >> ((t) >> 2)) & 1u)) ? -__builtin_inff() : sl * (float)(KBASE(t) - qm))
#define MLOAD(t) ((GRP == 0) ? *(const unsigned long long*)(mbase + (moff + (unsigned)(t) * 8u)) : 0ull)
#define MASKT(P0_, P1_, t, mw) do { const int kb_ = KBASE(t); \
        if (GRP == 0) { mask_bits(P0_, P1_, ((unsigned)(mw)) >> (4 * hi), ((unsigned)((mw) >> 32)) >> (4 * hi)); } \
        else if (kb_ + KVBLK - 1 > qlo) mask_causal(P0_, P1_, qm - kb_); } while (0)
    f32x16 pA0, pA1, pB0, pB1; float mnA, mnB, alA, alB; bf16x8 pa0, pa1, pa2, pa3;
    unsigned long long mwA, mwB;
    SWRITE_HV(0); SBAR();
    if (NT > 1) SLOAD_H(Kh, Vh, KBASE(1));
    mwA = MLOAD(0);
    SBAR(); qkt<0>(pA0, pA1, K_lds, r32, hi, S.qr, CB(0), sl);
    MASKT(pA0, pA1, 0, mwA); partialSM(pA0, pA1, m_reg, mnA, alA);
    if (NT > 1) { VMW(); SWRITE_H(1); }
    __syncthreads();
#define HALF_STEP(PX0, PX1, mnX, alX, mwX, PY0, PY1, alY, t, KB, VB, SB) do {                                                 \
        SBAR(); qkt<KB>(PX0, PX1, K_lds, r32, hi, S.qr, CB(t), sl);                                                           \
        finishSM(PY0, PY1, alY, l_reg, pa0, pa1, pa2, pa3); SBAR();                                                           \
        if ((t) + 1 < NT) { SLOAD_H(Kh, Vh, KBASE((t) + 1)); SBAR(); }                                                        \
        mwX = MLOAD(t); pv_tile<VB>(o, vb0, pa0, pa1, pa2, pa3); MASKT(PX0, PX1, (t), mwX); partialSM(PX0, PX1, m_reg, mnX, alX);             \
        __syncthreads();                                                                                                      \
        if ((t) + 1 < NT) { VMW(); SWRITE_H(SB); }                                                                            \
        RESC(alX); __syncthreads(); } while (0)
    for (int t = 1; t + 1 < NT; t += 2) {
        HALF_STEP(pB0, pB1, mnB, alB, mwB, pA0, pA1, alA, t, 1, 0, 0);
        HALF_STEP(pA0, pA1, mnA, alA, mwA, pB0, pB1, alB, t + 1, 0, 1, 1);
    }
    SBAR(); qkt<1>(pB0, pB1, K_lds, r32, hi, S.qr, CB(NT - 1), sl); SBAR();
    mwB = MLOAD(NT - 1);
    finishSM(pA0, pA1, alA, l_reg, pa0, pa1, pa2, pa3); SBAR();
    pv_tile<0>(o, vb0, pa0, pa1, pa2, pa3);
    MASKT(pB0, pB1, NT - 1, mwB); partialSM(pB0, pB1, m_reg, mnB, alB); __syncthreads(); RESC(alB);
    finishSM(pB0, pB1, alB, l_reg, pa0, pa1, pa2, pa3); SBAR(); pv_tile<1>(o, vb0, pa0, pa1, pa2, pa3);
    if (hi == 0) li_l[r32] = l_reg; asm volatile("s_waitcnt lgkmcnt(0)" ::: "memory");
    float rli[16];
#pragma unroll
    for (int r = 0; r < 16; ++r) rli[r] = __builtin_amdgcn_rcpf(li_l[crow(r, hi)]);
    { bf16_t* stg = (bf16_t*)(lds + LDS_OST) + wid * (QBLK * D);
      int lane_e = lane; asm volatile("" : "+v"(lane_e));
      bf16_t* stw = stg + (4 * (lane_e >> 5)) * D + (lane_e & 31);
#pragma unroll
      for (int r = 0; r < 16; ++r) { const int orow = (r & 3) + 8 * (r >> 2);
#pragma unroll
          for (int d0 = 0; d0 < 4; ++d0) stw[orow * D + d0 * 32] = (bf16_t)cvt1(o[d0][r] * rli[r]); }
      asm volatile("s_waitcnt lgkmcnt(0)" ::: "memory");
      char* Ow = (char*)((bf16_t*)(wsb + WS_Y) + ((size_t)cur.b * SEQ + qlo) * 2048 + cur.grp * 1024 + cur.h * 128);
      const char* Zw = (const char*)(ptrZ(wsb, cur) + (size_t)(wid * QBLK) * D);
      const unsigned eo = (unsigned)((lane_e >> 4) * 256 + (lane_e & 15) * 16), yo = (unsigned)((lane_e >> 4) * 4096 + (lane_e & 15) * 16);
#pragma unroll
      for (int i = 0; i < 8; ++i) {
          const u32x4 ov = *(const u32x4*)((const char*)stg + (eo + (unsigned)(i * 1024))), zv = *(const u32x4*)(Zw + (eo + (unsigned)(i * 1024))); u32x4 w;
#pragma unroll
          for (int j = 0; j < 4; ++j) w[j] = cvtpk(__uint_as_float(ov[j] << 16) * __uint_as_float(zv[j] << 16), __uint_as_float(ov[j] & 0xffff0000u) * __uint_as_float(zv[j] & 0xffff0000u));
          *(u32x4*)(Ow + (yo + (unsigned)(i * 16384))) = w; } }
    __syncthreads();
#undef RESC
#undef KBASE
#undef CB
#undef MLOAD
#undef MASKT
#undef HALF_STEP
}
#undef ROW
#undef VMW
#undef VMWN
#undef SLOAD_H
#undef SWRITE_HK
#undef SWRITE_HV
#undef SWRITE_H
__device__ __forceinline__ bool decode(int v, int G, int i, BlockRef& r) {
    const int L = v + (i >> 1) * G; if (L >= 512) return false;
    const int x = L & 3, k = L >> 5;
    r.h = (L >> 2) & 7; r.b = k & 7; r.grp = ((k & 1) ^ (k >> 3)) & 1; r.qb = (i & 1) ? 7 - x : x;
    return true;
}
__device__ __forceinline__ void attn_phase(char* lds, unsigned char* wsb, int v, int G) {
    BlockRef cur, nxt;
    if (!decode(v, G, 0, cur)) return;
    Seam S;
    prime(cur, wsb, lds, S);
    for (int i = 0;; ++i) {
        const bool more = decode(v, G, i + 1, nxt);
        if (!more) nxt = cur;
        block(cur, wsb, lds, S);
        if (!more) break;
        prime(nxt, wsb, lds, S);
        cur = nxt;
    }
}
#undef KSWZ
#undef SBAR
}

struct Args { const float* in[12]; float* out; unsigned char* ws; int ph_lo, ph_hi, li, pad; };
__global__ void __launch_bounds__(NWAVES * 64, 2) mega_fwd(Args args) {
    extern __shared__ __attribute__((aligned(16))) unsigned char lds[];
    Frame F;
    F.lds = (LAS unsigned char*)lds; F.MISC = (volatile LAS unsigned*)(F.lds + MISC_OFF);
    F.tid = threadIdx.x; F.lane = F.tid & 63; F.wave = __builtin_amdgcn_readfirstlane(F.tid >> 6);
    F.G = gridDim.x; { const int bx = blockIdx.x; F.vcu = (F.G % 8 == 0) ? (bx % 8) * (F.G / 8) + bx / 8 : bx; }
    unsigned char* ws = args.ws;
    F.ctl = (gu32*)(ws + WS_CTL);
    const float* x = args.in[0]; const float* c = args.in[1]; const float* w_ada = args.in[2]; const float* b_ada = args.in[3]; const float* g_norm = args.in[4];
    const float* w_in = args.in[5]; const float* w_out = args.in[11];
    float* MOD = (float*)(ws + WS_MOD); bf16_t* WinT = (bf16_t*)(ws + WS_WIN); bf16_t* WoutT = (bf16_t*)(ws + WS_WOUT); bf16_t* HB = (bf16_t*)(ws + WS_HB); bf16_t* Y = (bf16_t*)(ws + WS_Y);
    for (int u = F.tid; u < (LDS_BYTES - LDSCTL_OFF) / 4; u += NWAVES * 64) ((LAS unsigned*)(F.lds + LDSCTL_OFF))[u] = 0u;
    __syncthreads();
    XcdBarrier bar = xcd_barrier_post((unsigned*)(F.ctl + CW_BAR) + args.li * XCD_BAR_WORDS, F.MISC + 8);
    const int lo = args.ph_lo, hi = args.ph_hi;
#define IN(k) (lo <= (k) && (k) < hi)
#define BOTH(k) (IN(k) && IN((k) + 1))
    if (IN(0)) {
        if ((int)blockIdx.x < 192) p0_mod(F, (int)blockIdx.x, c, w_ada, b_ada, MOD);
        else if ((int)blockIdx.x == 192) { float* G = (float*)(ws + WS_GAIN);
            if (F.tid < 128) { G[F.tid] = args.in[6][F.tid]; G[128 + F.tid] = args.in[7][F.tid]; G[256 + F.tid] = args.in[9][F.tid]; G[384 + F.tid] = args.in[10][F.tid]; }
            if (F.tid < 64) G[512 + F.tid] = args.in[8][F.tid]; }
        p0_convert(F, w_in, w_out, WinT, WoutT);
        if (BOTH(0)) xcd_barrier(bar);
    }
    if (IN(1)) {
        p1_norm(F, x, g_norm, MOD, HB);
        if (BOTH(1)) xcd_barrier(bar);
    }
    if (IN(2)) {
        pg8::Gemm g{HB, WinT, M, NPAD, DM}; pg8::StaticOrder S; S.init(M, NPAD, F.G, (int)blockIdx.x);
        EpiProj E{ws, (LAS float*)(F.lds + EPI_OFF)};
        pg8::gemm_phase<EpiProj, pg8::StaticOrder, true, true>(F.lds, g, S, E);
        if (BOTH(2)) xcd_barrier(bar);
    }
    if (IN(4)) {
        att::attn_phase((char*)lds, ws, F.vcu, F.G);
        if (BOTH(4)) xcd_barrier(bar);
    }
    if (IN(5)) {
        pg8::Gemm g{Y, WoutT, M, DM, DM}; pg8::StaticOrder S; S.init(M, DM, F.G, (int)blockIdx.x);
        EpiOut E{x, MOD, args.out};
        pg8::gemm_phase<EpiOut, pg8::StaticOrder, true, true>(F.lds, g, S, E);
    }
#undef IN
#undef BOTH
}

static int mega_setup() {
    static int grid = 0;
    if (grid == 0) {
        int dev = 0, cus = 0;
        if (hipGetDevice(&dev) != hipSuccess || hipDeviceGetAttribute(&cus, hipDeviceAttributeMultiprocessorCount, dev) != hipSuccess) { fprintf(stderr, "kernel_launch: device query failed\n"); grid = -1; return grid; }
        if (hipFuncSetAttribute((const void*)mega_fwd, hipFuncAttributeMaxDynamicSharedMemorySize, LDS_BYTES) != hipSuccess) { fprintf(stderr, "kernel_launch: hipFuncSetAttribute failed\n"); grid = -1; return grid; }
        (void)hipGetLastError();
        grid = cus;
    }
    return grid;
}
static void mega_launch(int grid, void* const* d_in, void* d_out, void* d_ws, int ph_lo, int ph_hi, int li, hipStream_t stream) {
    Args a{};
    for (int i = 0; i < 12; ++i) a.in[i] = (const float*)d_in[i];
    a.out = (float*)d_out; a.ws = (unsigned char*)d_ws; a.ph_lo = ph_lo; a.ph_hi = ph_hi; a.li = li;
    hipLaunchKernelGGL(mega_fwd, dim3(grid), dim3(NWAVES * 64), LDS_BYTES, stream, a);
}

extern "C" void kernel_launch(void* const* d_in, const int* in_sizes, int n_in, void* d_out, int out_size, void* d_ws, size_t ws_size, hipStream_t stream) {
    if (n_in != 12 || in_sizes[0] != M * DM || out_size != M * DM || ws_size < WS_END) {
        fprintf(stderr, "kernel_launch: unexpected shapes (n_in %d, in0 %d, out %d, ws %zu); nothing launched\n", n_in, n_in > 0 ? in_sizes[0] : -1, out_size, ws_size); return; }
    const int grid = mega_setup(); if (grid <= 0) return;
    char* ws = (char*)d_ws;
    bf16_t* QA = (bf16_t*)(ws + WS_QA); bf16_t* KA = (bf16_t*)(ws + WS_KA); bf16_t* VA = (bf16_t*)(ws + WS_VA); bf16_t* SZA = (bf16_t*)(ws + WS_SZA);
    bf16_t* QB = (bf16_t*)(ws + WS_QB); bf16_t* KB = (bf16_t*)(ws + WS_KB); bf16_t* VB = (bf16_t*)(ws + WS_VB); bf16_t* SZB = (bf16_t*)(ws + WS_SZB);
    bf16_t* QI = (bf16_t*)(ws + WS_QI); bf16_t* KI = (bf16_t*)(ws + WS_KI); float* WI = (float*)(ws + WS_WI); float* KMEAN = (float*)(ws + WS_KMEAN);
    unsigned long long* MASKT = (unsigned long long*)(ws + WS_MASK); bf16_t* Y = (bf16_t*)(ws + WS_Y);
    (void)hipMemsetAsync(ws + WS_CTL, 0, CTL_ZERO_BYTES, stream);
    mega_launch(grid, d_in, d_out, d_ws, 0, 3, 0, stream);
    k_kmean<<<BATCH * NBLK * NH, 128, 0, stream>>>(KB, KMEAN);
    (void)hipMemsetAsync(MASKT, 0, 4 * MiB, stream);
    k_dsa_select_naive<<<dim3(SEQ, BATCH), 256, 0, stream>>>(QI, KI, WI, MASKT);
#if NAIVE_ATTN
    k_dsa_attn_naive<<<dim3(SEQ, BATCH), 256, 0, stream>>>(QA, KA, VA, SZA, MASKT, Y);
    k_moba_naive<<<dim3(SEQ, BATCH), 256, 0, stream>>>(QB, KB, VB, SZB, KMEAN, Y);
    mega_launch(grid, d_in, d_out, d_ws, 5, 6, 1, stream);
#else
    mega_launch(grid, d_in, d_out, d_ws, 4, 6, 1, stream);
#endif
}
```

```cpp
#include <hip/hip_runtime.h>
#include <cstdio>
#include <cstdint>

typedef unsigned short bf16_t;
#ifndef NAIVE_SEL
#define NAIVE_SEL 0
#endif
constexpr int BATCH = 8, SEQ = 2048, DM = 2048, M = BATCH * SEQ, NH = 8, HD = 128, DA = 1024, IH = 16, ID = 64, DIN = 9296;
constexpr int TOPK = 256, NBLK = 8;
constexpr float RMS_EPS = 1e-6f;
constexpr float QK_SCALE = 0.08838834764831845f;

__device__ __forceinline__ float bf2f(bf16_t v) { return __uint_as_float(((unsigned)v) << 16); }
__device__ __forceinline__ bf16_t f2bf(float f) { unsigned u = __float_as_uint(f); return (bf16_t)((u + 0x7fffu + ((u >> 16) & 1u)) >> 16); }
__device__ __forceinline__ float rbf(float f) { return bf2f(f2bf(f)); }
__device__ __forceinline__ float silu_f(float v) { return v / (1.f + __expf(-v)); }
__device__ __forceinline__ size_t HM(int b, int h, int t, int d) { return (((size_t)(b * NH + h) * SEQ + t) * HD + d); }
__device__ __forceinline__ float wave_sum(float v) {
#pragma unroll
    for (int o = 1; o < 64; o <<= 1) v += __shfl_xor(v, o);
    return v;
}
__device__ __forceinline__ float wave_max(float v) {
#pragma unroll
    for (int o = 1; o < 64; o <<= 1) v = fmaxf(v, __shfl_xor(v, o));
    return v;
}
__device__ __forceinline__ void mask_pos(int t, int s, size_t& word, int& bit) { word = (size_t)t * 32 + (s >> 6); bit = s & 63; }

__global__ void k_mod(const float* __restrict__ c, const float* __restrict__ w_ada, const float* __restrict__ b_ada, float* __restrict__ MOD) {
    __shared__ float sc[DM];
    const int b = blockIdx.y, n = blockIdx.x * 256 + threadIdx.x;
    for (int k = threadIdx.x; k < DM; k += 256) sc[k] = silu_f(c[b * DM + k]);
    __syncthreads();
    float acc = 0.f;
    for (int k = 0; k < DM; ++k) acc += sc[k] * w_ada[(size_t)k * (3 * DM) + n];
    MOD[b * 3 * DM + n] = acc + b_ada[n];
}
__global__ void k_norm(const float* __restrict__ x, const float* __restrict__ g, const float* __restrict__ MOD, bf16_t* __restrict__ HB) {
    const int lane = threadIdx.x & 63, row = blockIdx.x * 4 + (threadIdx.x >> 6), b = row / SEQ;
    const float* xr = x + (size_t)row * DM;
    float ss = 0.f;
    for (int k = lane; k < DM; k += 64) { const float v = xr[k]; ss += v * v; }
    ss = wave_sum(ss);
    const float rstd = rsqrtf(ss / DM + RMS_EPS);
    const float* shift = MOD + b * 3 * DM; const float* scale = shift + DM;
    for (int k = lane; k < DM; k += 64) HB[(size_t)row * DM + k] = f2bf(xr[k] * rstd * g[k] * (1.f + scale[k]) + shift[k]);
}
template <int MODE>
__global__ void k_gemm_naive(const bf16_t* __restrict__ A, int K, const float* __restrict__ W, int ldw, int n0, int ncols,
                             float* __restrict__ C, int ldc, const float* __restrict__ xres, const float* __restrict__ MOD) {
    __shared__ float As[16][65], Bs[16][65];
    const int tid = threadIdx.x, tx = tid & 15, ty = tid >> 4, m0 = blockIdx.y * 64, c0 = blockIdx.x * 64;
    float acc[4][4] = {};
    for (int k0 = 0; k0 < K; k0 += 16) {
        for (int i = tid; i < 1024; i += 256) { const int r = i >> 4, kk = i & 15; As[kk][r] = bf2f(A[(size_t)(m0 + r) * K + k0 + kk]); }
        for (int i = tid; i < 1024; i += 256) { const int kk = i >> 6, cc = i & 63; Bs[kk][cc] = (c0 + cc < ncols) ? rbf(W[(size_t)(k0 + kk) * ldw + n0 + c0 + cc]) : 0.f; }
        __syncthreads();
#pragma unroll
        for (int kk = 0; kk < 16; ++kk) {
            float a[4], bb[4];
#pragma unroll
            for (int i = 0; i < 4; ++i) { a[i] = As[kk][ty * 4 + i]; bb[i] = Bs[kk][tx * 4 + i]; }
#pragma unroll
            for (int i = 0; i < 4; ++i)
#pragma unroll
                for (int j = 0; j < 4; ++j) acc[i][j] += a[i] * bb[j];
        }
        __syncthreads();
    }
#pragma unroll
    for (int i = 0; i < 4; ++i)
#pragma unroll
        for (int j = 0; j < 4; ++j) {
            const int m = m0 + ty * 4 + i, cc = c0 + tx * 4 + j;
            if (cc < ncols) {
                if (MODE == 0) C[(size_t)m * ldc + cc] = acc[i][j];
                else { const int b = m / SEQ; C[(size_t)m * ldc + cc] = xres[(size_t)m * ldc + cc] + MOD[b * 3 * DM + 2 * DM + cc] * acc[i][j]; }
            }
        }
}
__global__ void k_post(const float* __restrict__ T32, const float* __restrict__ gain, bf16_t* __restrict__ dst, int mode) {
    const int lane = threadIdx.x & 63, item = blockIdx.x * 4 + (threadIdx.x >> 6), m = item >> 3, h = item & 7, b = m / SEQ, t = m % SEQ;
    const float* src = T32 + (size_t)m * 1024 + h * 128;
    float v0 = src[lane], v1 = src[lane + 64];
    if (mode == 0) { const float ss = wave_sum(v0 * v0 + v1 * v1); const float rstd = rsqrtf(ss / 128.f + RMS_EPS); v0 = v0 * rstd * gain[lane]; v1 = v1 * rstd * gain[lane + 64]; }
    if (mode == 2) { v0 = silu_f(v0); v1 = silu_f(v1); }
    if (mode == 3) { dst[(size_t)m * 1024 + h * 128 + lane] = f2bf(v0); dst[(size_t)m * 1024 + h * 128 + lane + 64] = f2bf(v1); }
    else { dst[HM(b, h, t, lane)] = f2bf(v0); dst[HM(b, h, t, lane + 64)] = f2bf(v1); }
}
__global__ void k_post_idx(const float* __restrict__ T32, const float* __restrict__ gain, bf16_t* __restrict__ KI, float* __restrict__ WI) {
    const int lane = threadIdx.x & 63, m = blockIdx.x * 4 + (threadIdx.x >> 6);
    const float v = T32[(size_t)m * 80 + lane];
    const float ss = wave_sum(v * v); const float rstd = rsqrtf(ss / 64.f + RMS_EPS);
    KI[(size_t)m * 64 + lane] = f2bf(v * rstd * gain[lane]);
    if (lane < 16) WI[(size_t)m * 16 + lane] = T32[(size_t)m * 80 + 64 + lane];
}
__global__ void k_kmean(const bf16_t* __restrict__ KB, float* __restrict__ KMEAN) {
    const int d = threadIdx.x, h = blockIdx.x & 7, n = (blockIdx.x >> 3) & 7, b = blockIdx.x >> 6;
    float s = 0.f;
    for (int t = 0; t < 256; ++t) s += bf2f(KB[HM(b, h, n * 256 + t, d)]);
    KMEAN[((size_t)(b * NBLK + n) * NH + h) * HD + d] = s * (1.f / 256.f);
}
__global__ void k_dsa_select_naive(const bf16_t* __restrict__ QI, const bf16_t* __restrict__ KI, const float* __restrict__ WI, unsigned long long* __restrict__ MASKT) {
    const int t = blockIdx.x, b = blockIdx.y, tid = threadIdx.x; const size_t m = (size_t)b * SEQ + t;
    __shared__ float q[1024]; __shared__ float w[16]; __shared__ float sc[SEQ];
    for (int i = tid; i < 1024; i += 256) q[i] = bf2f(QI[m * 1024 + i]);
    if (tid < 16) w[tid] = WI[m * 16 + tid];
    __syncthreads();
    for (int s = tid; s <= t; s += 256) {
        float k[64];
        const bf16_t* kp = KI + ((size_t)b * SEQ + s) * 64;
#pragma unroll
        for (int d = 0; d < 64; ++d) k[d] = bf2f(kp[d]);
        float score = 0.f;
        for (int h = 0; h < 16; ++h) { float dot = 0.f;
#pragma unroll
            for (int d = 0; d < 64; ++d) dot += q[h * 64 + d] * k[d];
            score += w[h] * fmaxf(dot * 0.125f, 0.f); }
        sc[s] = score * 0.25f;
    }
    __syncthreads();
    for (int s = tid; s <= t; s += 256) {
        bool sel = true;
        if (t >= TOPK) { const float v = sc[s]; int cnt = 0; for (int s2 = 0; s2 <= t; ++s2) { const float u = sc[s2]; cnt += (u > v || (u == v && s2 < s)) ? 1 : 0; } sel = cnt < TOPK; }
        if (sel) { size_t word; int bit; mask_pos(t, s, word, bit); atomicOr(&MASKT[(size_t)b * 65536 + word], 1ull << bit); }
    }
}
__global__ void k_dsa_attn_naive(const bf16_t* __restrict__ QA, const bf16_t* __restrict__ KA, const bf16_t* __restrict__ VA, const bf16_t* __restrict__ SZA,
                                 const unsigned long long* __restrict__ MASKT, bf16_t* __restrict__ Y) {
    const int t = blockIdx.x, b = blockIdx.y, tid = threadIdx.x, lane = tid & 63, w = tid >> 6; const size_t m = (size_t)b * SEQ + t;
    __shared__ int idx[512]; __shared__ int nsel; __shared__ float qs[8][128]; __shared__ float p[4][256];
    if (tid == 0) nsel = 0;
    __syncthreads();
    for (int s = tid; s <= t; s += 256) { size_t word; int bit; mask_pos(t, s, word, bit);
        if ((MASKT[(size_t)b * 65536 + word] >> bit) & 1ull) { const int pos = atomicAdd(&nsel, 1); if (pos < 512) idx[pos] = s; } }
    for (int i = tid; i < 1024; i += 256) qs[i >> 7][i & 127] = bf2f(QA[HM(b, i >> 7, t, i & 127)]);
    __syncthreads();
    const int n = nsel < 256 ? nsel : 256;
    for (int hh = 0; hh < 2; ++hh) {
        const int h = w + 4 * hh; const float slope = exp2f(-(float)(h + 1));
        float sv[4]; float mx = -INFINITY;
#pragma unroll
        for (int i = 0; i < 4; ++i) { const int j = lane + 64 * i; sv[i] = -INFINITY;
            if (j < n) { const int s = idx[j]; const bf16_t* kp = KA + HM(b, h, s, 0); float dot = 0.f;
                for (int d = 0; d < 128; ++d) dot += qs[h][d] * bf2f(kp[d]);
                sv[i] = dot * QK_SCALE - slope * (float)(t - s); }
            mx = fmaxf(mx, sv[i]); }
        mx = wave_max(mx);
        float sum = 0.f;
#pragma unroll
        for (int i = 0; i < 4; ++i) { const int j = lane + 64 * i; const float pv = (j < n) ? __expf(sv[i] - mx) : 0.f; sum += pv; p[w][j] = pv; }
        sum = wave_sum(sum);
        __syncthreads();
        float o0 = 0.f, o1 = 0.f;
        for (int j = 0; j < n; ++j) { const float pj = p[w][j]; const int s = idx[j]; const unsigned vv = *(const unsigned*)(VA + HM(b, h, s, 2 * lane));
            o0 += pj * __uint_as_float(vv << 16); o1 += pj * __uint_as_float(vv & 0xffff0000u); }
        const float inv = 1.f / sum;
        const unsigned zz = *(const unsigned*)(SZA + HM(b, h, t, 2 * lane));
        o0 = o0 * inv * __uint_as_float(zz << 16); o1 = o1 * inv * __uint_as_float(zz & 0xffff0000u);
        *(unsigned*)(Y + m * 2048 + h * 128 + 2 * lane) = (unsigned)f2bf(o0) | ((unsigned)f2bf(o1) << 16);
        __syncthreads();
    }
}
__global__ void k_moba_naive(const bf16_t* __restrict__ QB, const bf16_t* __restrict__ KB, const bf16_t* __restrict__ VB, const bf16_t* __restrict__ SZB,
                             const float* __restrict__ KMEAN, bf16_t* __restrict__ Y) {
    const int t = blockIdx.x, b = blockIdx.y, tid = threadIdx.x, lane = tid & 63, w = tid >> 6; const size_t m = (size_t)b * SEQ + t;
    __shared__ float qs[8][128]; __shared__ float sc[4][SEQ];
    for (int i = tid; i < 1024; i += 256) qs[i >> 7][i & 127] = bf2f(QB[HM(b, i >> 7, t, i & 127)]);
    __syncthreads();
    const int qblk = t >> 8;
    for (int hh = 0; hh < 2; ++hh) {
        const int h = w + 4 * hh; const float slope = exp2f(-(float)(h + 1));
        float g = -INFINITY;
        if (lane < qblk) { const float* km = KMEAN + ((size_t)(b * NBLK + lane) * NH + h) * HD; float dot = 0.f; for (int d = 0; d < 128; ++d) dot += qs[h][d] * km[d]; g = dot; }
        int rank = 0;
        for (int n2 = 0; n2 < NBLK; ++n2) { const float g2 = __shfl(g, n2); if (n2 < qblk && (g2 > g || (g2 == g && n2 < lane))) ++rank; }
        const bool sel = (lane < qblk) && (rank < 3);
        const unsigned selmask = (unsigned)(__ballot(sel) & 0xffull);
        float mx = -INFINITY;
        for (int s = lane; s <= t; s += 64) { const int blk = s >> 8; float v = -INFINITY;
            if (blk == qblk || ((selmask >> blk) & 1u)) { const bf16_t* kp = KB + HM(b, h, s, 0); float dot = 0.f;
                for (int d = 0; d < 128; ++d) dot += qs[h][d] * bf2f(kp[d]);
                v = dot * QK_SCALE - slope * (float)(t - s); }
            sc[w][s] = v; mx = fmaxf(mx, v); }
        mx = wave_max(mx);
        float sum = 0.f;
        for (int s = lane; s <= t; s += 64) { const float v = sc[w][s]; const float pv = (v == -INFINITY) ? 0.f : __expf(v - mx); sc[w][s] = pv; sum += pv; }
        sum = wave_sum(sum);
        __syncthreads();
        float o0 = 0.f, o1 = 0.f;
        for (int s = 0; s <= t; ++s) { const float pj = sc[w][s]; if (pj == 0.f) continue; const unsigned vv = *(const unsigned*)(VB + HM(b, h, s, 2 * lane));
            o0 += pj * __uint_as_float(vv << 16); o1 += pj * __uint_as_float(vv & 0xffff0000u); }
        const float inv = 1.f / sum;
        const unsigned zz = *(const unsigned*)(SZB + HM(b, h, t, 2 * lane));
        o0 = o0 * inv * __uint_as_float(zz << 16); o1 = o1 * inv * __uint_as_float(zz & 0xffff0000u);
        *(unsigned*)(Y + m * 2048 + 1024 + h * 128 + 2 * lane) = (unsigned)f2bf(o0) | ((unsigned)f2bf(o1) << 16);
        __syncthreads();
    }
}

namespace pg8 {
#define PG8_LAS __attribute__((address_space(3)))
typedef unsigned short bf16_t;
typedef short bf16x8 __attribute__((ext_vector_type(8)));
typedef float f32x4 __attribute__((ext_vector_type(4)));
typedef unsigned u32x4 __attribute__((ext_vector_type(4)));
constexpr int BM = 256, BK = 64, HALF = 128, HTB = HALF * BK * 2  , STAGE_BYTES = 8 * HTB, NXCD = 8, WGM = 8;

__host__ __device__ __forceinline__ int lds_byte(int r, int c) { const int st = (r >> 4) * 2 + (c >> 5), rr = r & 15, cc = c & 31, ob = rr * 64 + cc * 2; return st * 1024 + (ob ^ (((ob >> 9) & 1) << 5)); }
__host__ __device__ __forceinline__ void stage_rc(int b, int& R, int& C) { const int st = b / 1024, sb = b % 1024, swz = sb ^ (((sb >> 9) & 1) << 5); R = (st >> 1) * 16 + swz / 64; C = (st & 1) * 32 + (swz % 64) / 2; }
__host__ __device__ __forceinline__ int perm32(int rho) { const int n = rho >> 4, i = rho & 15; return 8 * (i >> 2) + 4 * n + (i & 3); }

struct Unit { int pm, pn; };
struct Gemm { const bf16_t* A; const bf16_t* Bt; int M, N, K; };

struct StaticOrder {
    int nM, nN, nwg, G, c;
    __host__ __device__ void init(int M, int N, int G_, int c_) { nM = M / BM; nN = N / BM; nwg = nM * nN; G = G_; c = c_; }
    __host__ __device__ bool next(int i, Unit& u) const {
        const long L = (long)i * G + c; if (L >= nwg) return false;
        int wgid = (int)L; { const int q = nwg / NXCD, r = nwg % NXCD, xcd = wgid % NXCD, off = wgid / NXCD; wgid = (xcd < r ? xcd * (q + 1) : r * (q + 1) + (xcd - r) * q) + off; }
        const int nig = WGM * nN, gid = wgid / nig, fm = gid * WGM, gsz = (nM - fm) < WGM ? (nM - fm) : WGM;
        u.pm = fm + ((wgid % nig) % gsz); u.pn = (wgid % nig) / gsz; return true;
    }
    __device__ __forceinline__ void a_ready(const Unit&) const {}
    __device__ __forceinline__ void done(const Unit&) const {}
};

template <class Epi, class Sched, bool ALIGN_EPI = false, bool SP2 = false>
__device__ __forceinline__ void gemm_phase(PG8_LAS unsigned char* lds, const Gemm g, const Sched& S, const Epi& E) {
    const int tid = threadIdx.x, wid = __builtin_amdgcn_readfirstlane(tid >> 6), lane = tid & 63, wr = wid >> 2, wc = wid & 3, fr = lane & 15, fq = lane >> 4;
    const int K = g.K, nt = K / BK;
    unsigned voffA[2], voffB[2];
#pragma unroll
    for (int i = 0; i < 2; ++i) { int R, C; stage_rc(tid * 16 + i * 8192, R, C); const int Rb = Epi::PERM ? ((R & ~31) + perm32(R & 31)) : R;
        voffA[i] = (unsigned)(R * K + C) * 2u; voffB[i] = (unsigned)(Rb * K + C) * 2u; }
    const size_t kstep = (size_t)(BK * 2);
    const size_t hstep = (size_t)HALF * K * 2;
    const size_t tstep = 2 * hstep;
    const unsigned ldsw = (unsigned)wid * 1024u;
    const int aoff = lds_byte(wr * 64 + fr, fq * 8), boff = lds_byte(wc * 32 + fr, fq * 8);
#define PG8_SA(b, h) (((b) * 2 + (h)) * HTB)
#define PG8_SB(b, h) ((4 + (b) * 2 + (h)) * HTB)
#define PG8_STAGE(bufoff, gbase, voff) do { _Pragma("unroll") for (int _i = 0; _i < 2; ++_i) \
        __builtin_amdgcn_global_load_lds((const unsigned*)((const char*)(gbase) + (voff)[_i]), (PG8_LAS unsigned*)(lds + (bufoff) + ldsw + _i * 8192), 16, 0, 0); } while (0)
#define PG8_LDA(dst, b, h) do { _Pragma("unroll") for (int m = 0; m < 4; ++m) _Pragma("unroll") for (int k = 0; k < 2; ++k) dst[m][k] = *(const PG8_LAS bf16x8*)(lds + PG8_SA(b, h) + aoff + m * 2048 + k * 1024); } while (0)
#define PG8_LDB(dst, b, h) do { _Pragma("unroll") for (int n = 0; n < 2; ++n) _Pragma("unroll") for (int k = 0; k < 2; ++k) dst[n][k] = *(const PG8_LAS bf16x8*)(lds + PG8_SB(b, h) + boff + n * 2048 + k * 1024); } while (0)
#define PG8_MMA(ai, bj, At, Bt) do { __builtin_amdgcn_s_setprio(1); _Pragma("unroll") for (int m = 0; m < 4; ++m) _Pragma("unroll") for (int n = 0; n < 2; ++n) _Pragma("unroll") for (int k = 0; k < 2; ++k) \
        acc[ai][bj][m][n] = __builtin_amdgcn_mfma_f32_16x16x32_bf16(Bt[n][k], At[m][k], acc[ai][bj][m][n], 0, 0, 0); __builtin_amdgcn_s_setprio(0); } while (0)
#define PG8_WAIT_V(n) asm volatile("s_waitcnt vmcnt(" #n ")" ::: "memory")
#define PG8_WAIT_L(n) asm volatile("s_waitcnt lgkmcnt(" #n ")" ::: "memory")
#define PG8_BAR __builtin_amdgcn_s_barrier()
#define PG8_SCHED __builtin_amdgcn_sched_barrier(0)
    Unit cur, nxt; int ui = 0;
    if (!S.next(0, cur)) return;
    f32x4 acc[2][2][4][2];
#pragma unroll
    for (int a = 0; a < 2; ++a)
#pragma unroll
        for (int b = 0; b < 2; ++b)
#pragma unroll
            for (int m = 0; m < 4; ++m)
#pragma unroll
                for (int n = 0; n < 2; ++n) acc[a][b][m][n] = (f32x4){0.f, 0.f, 0.f, 0.f};
    bf16x8 At[4][2], B0[2][2], B1[2][2];
    const char* cA = (const char*)g.A + (size_t)cur.pm * tstep; const char* cB = (const char*)g.Bt + (size_t)cur.pn * tstep;
    S.a_ready(cur);
    if constexpr (SP2) {
        PG8_STAGE(PG8_SB(0, 0), cB, voffB); PG8_STAGE(PG8_SB(0, 1), cB + hstep, voffB); PG8_STAGE(PG8_SA(0, 0), cA, voffA); PG8_STAGE(PG8_SA(0, 1), cA + hstep, voffA);
        if (wr == 1) PG8_BAR;
        PG8_WAIT_V(2); PG8_BAR;
        PG8_STAGE(PG8_SB(1, 0), cB + kstep, voffB); PG8_STAGE(PG8_SA(1, 0), cA + kstep, voffA); PG8_STAGE(PG8_SB(1, 1), cB + hstep + kstep, voffB);
        PG8_WAIT_V(6); PG8_BAR;
    } else {
        PG8_STAGE(PG8_SB(0, 0), cB, voffB); PG8_STAGE(PG8_SA(0, 0), cA, voffA); PG8_STAGE(PG8_SB(0, 1), cB + hstep, voffB); PG8_STAGE(PG8_SA(0, 1), cA + hstep, voffA);
        if (wr == 1) PG8_BAR;
        PG8_WAIT_V(4); PG8_BAR;
        PG8_STAGE(PG8_SB(1, 0), cB + kstep, voffB); PG8_STAGE(PG8_SA(1, 0), cA + kstep, voffA); PG8_STAGE(PG8_SB(1, 1), cB + hstep + kstep, voffB);
        PG8_WAIT_V(6); PG8_BAR;
    }
    for (;;) {
        const bool has_next = S.next(ui + 1, nxt);
        const char* nA = has_next ? (const char*)g.A + (size_t)nxt.pm * tstep : cA; const char* nB = has_next ? (const char*)g.Bt + (size_t)nxt.pn * tstep : cB;
        for (int t = 0; t < nt; t += 2) {
            const bool last = (t == nt - 2);
            const char* a1 = cA + (size_t)(t + 1) * kstep;
            const char* a2 = last ? nA : cA + (size_t)(t + 2) * kstep; const char* b2 = last ? nB : cB + (size_t)(t + 2) * kstep;
            const char* a3 = a2 + kstep; const char* b3 = b2 + kstep;
            if (last && has_next) S.a_ready(nxt);
            if constexpr (SP2) {
            PG8_LDB(B0, 0, 0); PG8_LDB(B1, 0, 1); PG8_SCHED; PG8_LDA(At, 0, 0); PG8_STAGE(PG8_SA(1, 1), a1 + hstep, voffA);
            PG8_WAIT_V(8); PG8_WAIT_L(0); PG8_BAR; PG8_MMA(0, 0, At, B0); PG8_MMA(0, 1, At, B1); PG8_BAR; PG8_SCHED;
            PG8_LDA(At, 0, 1); PG8_STAGE(PG8_SB(0, 0), b2, voffB); PG8_STAGE(PG8_SB(0, 1), b2 + hstep, voffB); PG8_STAGE(PG8_SA(0, 0), a2, voffA);
            PG8_WAIT_V(8); PG8_WAIT_L(0); PG8_BAR; PG8_MMA(1, 0, At, B0); PG8_MMA(1, 1, At, B1); PG8_BAR; PG8_SCHED;
            PG8_LDB(B0, 1, 0); PG8_LDB(B1, 1, 1); PG8_SCHED; PG8_LDA(At, 1, 0); PG8_STAGE(PG8_SA(0, 1), a2 + hstep, voffA);
            PG8_WAIT_V(8); PG8_WAIT_L(0); PG8_BAR; PG8_MMA(0, 0, At, B0); PG8_MMA(0, 1, At, B1); PG8_BAR; PG8_SCHED;
            PG8_LDA(At, 1, 1); PG8_STAGE(PG8_SB(1, 0), b3, voffB); PG8_STAGE(PG8_SB(1, 1), b3 + hstep, voffB); PG8_STAGE(PG8_SA(1, 0), a3, voffA);
            PG8_WAIT_V(8); PG8_WAIT_L(0); PG8_BAR; PG8_MMA(1, 0, At, B0); PG8_MMA(1, 1, At, B1); PG8_BAR; PG8_SCHED;
            } else {
            PG8_LDB(B0, 0, 0); PG8_SCHED; PG8_LDA(At, 0, 0); PG8_STAGE(PG8_SA(1, 1), a1 + hstep, voffA);
            PG8_WAIT_L(8); PG8_BAR; PG8_WAIT_L(0); PG8_MMA(0, 0, At, B0); PG8_BAR; PG8_SCHED;
            PG8_LDB(B1, 0, 1); PG8_STAGE(PG8_SB(0, 0), b2, voffB);
            PG8_BAR; PG8_WAIT_L(0); PG8_MMA(0, 1, At, B1); PG8_BAR;
            PG8_LDA(At, 0, 1); PG8_STAGE(PG8_SA(0, 0), a2, voffA);
            PG8_BAR; PG8_WAIT_L(0); PG8_MMA(1, 0, At, B0); PG8_BAR; PG8_SCHED;
            PG8_STAGE(PG8_SB(0, 1), b2 + hstep, voffB);
            PG8_WAIT_V(6); PG8_BAR; PG8_MMA(1, 1, At, B1); PG8_BAR;
            PG8_LDB(B0, 1, 0); PG8_SCHED; PG8_LDA(At, 1, 0); PG8_STAGE(PG8_SA(0, 1), a2 + hstep, voffA);
            PG8_WAIT_L(8); PG8_BAR; PG8_WAIT_L(0); PG8_MMA(0, 0, At, B0); PG8_BAR; PG8_SCHED;
            PG8_LDB(B1, 1, 1); PG8_STAGE(PG8_SB(1, 0), b3, voffB);
            PG8_BAR; PG8_WAIT_L(0); PG8_MMA(0, 1, At, B1); PG8_BAR;
            PG8_LDA(At, 1, 1); PG8_STAGE(PG8_SA(1, 0), a3, voffA);
            PG8_BAR; PG8_WAIT_L(0); PG8_MMA(1, 0, At, B0); PG8_BAR; PG8_SCHED;
            PG8_STAGE(PG8_SB(1, 1), b3 + hstep, voffB);
            PG8_WAIT_V(6); PG8_BAR; PG8_MMA(1, 1, At, B1); PG8_BAR;
            }
        }
        if constexpr (ALIGN_EPI) { if (wr == 0) PG8_BAR; }
        if constexpr (!Epi::AFTER_DRAIN) { E(acc, cur, wr, wc, fr, fq); S.done(cur); }
        if (!has_next) break;
#pragma unroll
        for (int a = 0; a < 2; ++a)
#pragma unroll
            for (int b = 0; b < 2; ++b)
#pragma unroll
                for (int m = 0; m < 4; ++m)
#pragma unroll
                    for (int n = 0; n < 2; ++n) acc[a][b][m][n] = (f32x4){0.f, 0.f, 0.f, 0.f};
        cur = nxt; cA = nA; cB = nB; ++ui;
        if constexpr (ALIGN_EPI) { if (wr == 1) PG8_BAR; }
    }
    PG8_WAIT_V(0);
    if constexpr (!ALIGN_EPI) { if (wr == 0) PG8_BAR; }
    PG8_BAR;
    if constexpr (Epi::AFTER_DRAIN) { E.fused(acc, cur, wr, wc, fr, fq, lds, wid, lane); S.done(cur); }
#undef PG8_SA
#undef PG8_SB
#undef PG8_STAGE
#undef PG8_LDA
#undef PG8_LDB
#undef PG8_MMA
#undef PG8_WAIT_V
#undef PG8_WAIT_L
#undef PG8_BAR
#undef PG8_SCHED
}
}

#define GAS __attribute__((address_space(1)))
#define LAS __attribute__((address_space(3)))
typedef unsigned v4u __attribute__((ext_vector_type(4)));
typedef float f32x4 __attribute__((ext_vector_type(4)));
typedef GAS unsigned gu32;
#define RLX_AGENT __ATOMIC_RELAXED, __HIP_MEMORY_SCOPE_AGENT
#define LDS_WAIT() asm volatile("s_waitcnt lgkmcnt(0)" ::: "memory")
#define VM_WAIT() asm volatile("s_waitcnt vmcnt(0)" ::: "memory")
constexpr int NWAVES = 8;
constexpr int NPAD = 9472;
constexpr size_t MiB = 1u << 20;
constexpr size_t WS_CTL = 0, CTL_ZERO_BYTES = 1 * MiB;
constexpr size_t WS_MOD = 1 * MiB;
constexpr size_t WS_GAIN = 1 * MiB + 256 * 1024;
constexpr size_t WS_KMEAN = 1 * MiB + 512 * 1024;
constexpr size_t WS_WI = 2 * MiB;
constexpr size_t WS_KI = 3 * MiB;
constexpr size_t WS_MASK = 5 * MiB;
constexpr size_t WS_WOUT = 10 * MiB;
constexpr size_t WS_WIN = 18 * MiB;
constexpr size_t WS_HB = 56 * MiB;
constexpr size_t WS_Y = 56 * MiB;
constexpr size_t WS_QA = 120 * MiB, WS_KA = 152 * MiB, WS_VA = 184 * MiB, WS_SZA = 216 * MiB;
constexpr size_t WS_QB = 248 * MiB, WS_KB = 280 * MiB, WS_VB = 312 * MiB, WS_SZB = 344 * MiB;
constexpr size_t WS_QI = 376 * MiB;
constexpr size_t WS_T32 = 408 * MiB;
constexpr size_t WS_END = 472 * MiB;
constexpr int CW_BAR = 4096;
constexpr int RING_BYTES = 131072;
constexpr int EPI_OFF = RING_BYTES;
constexpr int LDSCTL_OFF = EPI_OFF + 16384, MISC_OFF = LDSCTL_OFF + 320;
constexpr int LDS_BYTES = 163840;

#define XB_TMO      128
#define XB_XCNT(j)  (256  + 64 * (j))
#define XB_XSUB(j)  (1280 + 64 * (j))
#define XB_XGEN(j)  (2304 + 64 * (j))
#define XB_TOP      3328
#define XB_TOPGEN   3392
#define XCD_BAR_WORDS 3456
#define XB_SPIN_CAP (1u << 18)

__device__ __forceinline__ unsigned xb_ld(unsigned* p)              { return __hip_atomic_load(p, __ATOMIC_RELAXED, __HIP_MEMORY_SCOPE_AGENT); }
__device__ __forceinline__ unsigned xb_add(unsigned* p, unsigned v) { return __hip_atomic_fetch_add(p, v, __ATOMIC_RELAXED, __HIP_MEMORY_SCOPE_AGENT); }
__device__ __forceinline__ unsigned xb_xcc_id() { return (unsigned)__builtin_amdgcn_s_getreg((3 << 11) | 20) & 0xFu; }
#define XB_SPIN(cond, bar) do { unsigned _sp = 0; while (cond) { __builtin_amdgcn_s_sleep(1); \
    if ((++_sp & 255u) == 0u) { if (xb_ld(&(bar)[XB_TMO])) break; if (_sp > XB_SPIN_CAP) { atomicAdd(&(bar)[XB_TMO], 1u); break; } } } } while (0)

struct XcdBarrier {
    unsigned* bar; unsigned x;
    volatile LAS unsigned* st;
};

__device__ __forceinline__ XcdBarrier xcd_barrier_post(unsigned* bar, volatile LAS unsigned* st) {
    XcdBarrier b; b.bar = bar; b.x = xb_xcc_id(); b.st = st;
    if (threadIdx.x == 0) (void)xb_add(&bar[XB_XCNT(b.x)], 1u);
    return b;
}
__device__ __forceinline__ void xcd_barrier_complete(unsigned* bar, unsigned x, unsigned& nloc, unsigned& nx) {
    const unsigned G = gridDim.x * gridDim.y * gridDim.z;
    unsigned sum, cnt, mine, sp = 0u;
    for (;;) {
        sum = 0u; cnt = 0u; mine = 0u;
#pragma unroll
        for (unsigned j = 0; j < 16; ++j) { const unsigned c = xb_ld(&bar[XB_XCNT(j)]); sum += c; cnt += (c > 0u) ? 1u : 0u; mine = (j == x) ? c : mine; }
        if (sum == G) break;
        __builtin_amdgcn_s_sleep(1);
        if ((++sp & 255u) == 0u) { if (xb_ld(&bar[XB_TMO])) break; if (sp > XB_SPIN_CAP) { atomicAdd(&bar[XB_TMO], 1u); break; } }
    }
    nloc = mine > 0u ? mine : 1u; nx = cnt > 0u ? cnt : 1u;
}

__device__ __forceinline__ void xcd_barrier(const XcdBarrier& b) {
    asm volatile("s_waitcnt vmcnt(0)" ::: "memory");
    __syncthreads();
    if (threadIdx.x == 0) {
        unsigned* bar = b.bar;
        __builtin_amdgcn_s_waitcnt(0);
        unsigned nloc = b.st[0], nx = b.st[1];
        if (nloc == 0u) { xcd_barrier_complete(bar, b.x, nloc, nx); b.st[0] = nloc; b.st[1] = nx; }
        const unsigned old = xb_add(&bar[XB_XSUB(b.x)], 1u);
        const unsigned gen = old / nloc;
        if (old + 1u == (gen + 1u) * nloc) {
            __builtin_amdgcn_fence(__ATOMIC_RELEASE, "agent");
            asm volatile("s_waitcnt vmcnt(0)" ::: "memory");
            const unsigned og = xb_add(&bar[XB_TOP], 1u);
            const unsigned tg = og / nx;
            if (og + 1u == (tg + 1u) * nx) xb_add(&bar[XB_TOPGEN], 1u);
            else XB_SPIN(xb_ld(&bar[XB_TOPGEN]) == tg, bar);
            __builtin_amdgcn_fence(__ATOMIC_ACQUIRE, "agent");
            xb_add(&bar[XB_XGEN(b.x)], 1u);
            asm volatile("s_waitcnt vmcnt(0)" ::: "memory");
        } else {
            XB_SPIN(xb_ld(&bar[XB_XGEN(b.x)]) == gen, bar);
            __builtin_amdgcn_fence(__ATOMIC_ACQUIRE, "agent");
            asm volatile("s_waitcnt vmcnt(0)" ::: "memory");
        }
    }
    __syncthreads();
}


struct Frame {
    LAS unsigned char* lds; volatile LAS unsigned* MISC; gu32* ctl; int tid, lane, wave, vcu, G;
};
__device__ __forceinline__ unsigned cvt_pk_bf16(float lo, float hi) { unsigned r; asm volatile("v_cvt_pk_bf16_f32 %0, %1, %2" : "=v"(r) : "v"(lo), "v"(hi)); return r; }
__device__ __forceinline__ unsigned f2bf_u(float f) { unsigned u = __builtin_bit_cast(unsigned, f); return (u + 0x7fffu + ((u >> 16) & 1u)) >> 16; }
__device__ __forceinline__ unsigned pk2(float lo, float hi) { return f2bf_u(lo) | (f2bf_u(hi) << 16); }
__device__ __forceinline__ float fast_silu(float v) { return v * __builtin_amdgcn_rcpf(1.f + __expf(-v)); }

__device__ __forceinline__ void p0_mod(Frame& F, int id, const float* __restrict__ c, const float* __restrict__ w_ada, const float* __restrict__ b_ada, float* __restrict__ MOD) {
    LAS float* sc = (LAS float*)(F.lds);
    LAS float* red = (LAS float*)(F.lds + 65536);
    for (int i = F.tid; i < BATCH * DM; i += NWAVES * 64) sc[i] = silu_f(c[i]);
    __syncthreads();
    const int cq = F.tid & 7, kq = F.tid >> 3, col0 = 32 * id + 4 * cq;
    f32x4 acc[8];
#pragma unroll
    for (int b = 0; b < 8; ++b) acc[b] = (f32x4){0.f, 0.f, 0.f, 0.f};
#pragma unroll 4
    for (int i = 0; i < 32; ++i) { const int k = kq + 64 * i; const f32x4 w = *(const f32x4*)(w_ada + (size_t)k * (3 * DM) + col0);
#pragma unroll
        for (int b = 0; b < 8; ++b) acc[b] += w * sc[b * DM + k]; }
#pragma unroll
    for (int b = 0; b < 8; ++b) *(LAS f32x4*)(red + (kq * 8 + b) * 32 + 4 * cq) = acc[b];
    __syncthreads();
    if (F.tid < 256) { const int b = F.tid >> 5, cc = F.tid & 31; float s = 0.f;
        for (int q = 0; q < 64; ++q) s += red[(q * 8 + b) * 32 + cc];
        MOD[b * 3 * DM + 32 * id + cc] = s + b_ada[32 * id + cc]; }
    __syncthreads();
}
template <bool MAPWIN>
__device__ __forceinline__ void p0_transpose_item(const float* __restrict__ W, int K, int N, int NP, bf16_t* __restrict__ WT, LAS float* scr, int item, int lane) {
    const int nblk = NP / 32, kb = item / nblk, nb = item % nblk, k0 = 64 * kb, n0 = 32 * nb;
    const int np = n0 + (lane & 31);
    int src = np; bool valid = true;
    if (MAPWIN) { if (np >= 5376) src = np - 176; else if (np >= 5200) valid = false; }
#pragma unroll 8
    for (int i = 0; i < 32; ++i) { const int kk = 2 * i + (lane >> 5); scr[kk * 33 + (lane & 31)] = valid ? W[(size_t)(k0 + kk) * N + src] : 0.f; }
    LDS_WAIT(); asm volatile("" ::: "memory");
    const int c = lane & 7;
#pragma unroll
    for (int j = 0; j < 4; ++j) { const int n = (lane >> 3) + 8 * j; const LAS float* s = scr + (8 * c) * 33 + n;
        v4u o; o.x = pk2(s[0 * 33], s[1 * 33]); o.y = pk2(s[2 * 33], s[3 * 33]); o.z = pk2(s[4 * 33], s[5 * 33]); o.w = pk2(s[6 * 33], s[7 * 33]);
        *(GAS v4u*)(WT + (size_t)(n0 + n) * K + k0 + 8 * c) = o; }
    LDS_WAIT(); asm volatile("" ::: "memory");
}
__device__ __forceinline__ void p0_convert(Frame& F, const float* __restrict__ w_in, const float* __restrict__ w_out, bf16_t* __restrict__ WinT, bf16_t* __restrict__ WoutT) {
    LAS float* scr = (LAS float*)(F.lds + F.wave * 16384);
    const int gw = F.vcu * NWAVES + F.wave, NGW = F.G * NWAVES;
    constexpr int I_IN = (DM / 64) * (NPAD / 32), I_OUT = (DM / 64) * (DM / 32);
    for (int it = gw; it < I_IN + I_OUT; it += NGW) {
        if (it < I_IN) p0_transpose_item<true>(w_in, DM, DIN, NPAD, WinT, scr, it, F.lane);
        else p0_transpose_item<false>(w_out, DM, DM, DM, WoutT, scr, it - I_IN, F.lane);
    }
}
__device__ __forceinline__ void p1_norm(Frame& F, const float* __restrict__ x, const float* __restrict__ g, const float* __restrict__ MOD, bf16_t* __restrict__ HB) {
    for (int v = F.vcu; v < M / 64; v += F.G) {
        const int b = v / (SEQ / 64);
        const float* shift = MOD + b * 3 * DM; const float* scale = shift + DM;
        f32x4 gs[8], sh[8];
#pragma unroll
        for (int j = 0; j < 8; ++j) { const int k = 4 * F.lane + 256 * j; const f32x4 gg = *(const f32x4*)(g + k), ss = *(const f32x4*)(scale + k); gs[j] = gg * (ss + 1.0f); sh[j] = *(const f32x4*)(shift + k); }
        for (int r = 0; r < 8; ++r) {
            const int row = 64 * v + 8 * F.wave + r;
            const f32x4* xr = (const f32x4*)(x + (size_t)row * DM) + F.lane;
            f32x4 xv[8]; float ss = 0.f;
#pragma unroll
            for (int j = 0; j < 8; ++j) { xv[j] = xr[64 * j]; ss += (xv[j].x * xv[j].x + xv[j].y * xv[j].y) + (xv[j].z * xv[j].z + xv[j].w * xv[j].w); }
            ss = wave_sum(ss);
            const float rstd = rsqrtf(ss * (1.f / DM) + RMS_EPS);
            unsigned long long* o8 = (unsigned long long*)(HB + (size_t)row * DM) + F.lane;
#pragma unroll
            for (int j = 0; j < 8; ++j) { const f32x4 h = xv[j] * rstd * gs[j] + sh[j];
                o8[64 * j] = (unsigned long long)pk2(h.x, h.y) | ((unsigned long long)pk2(h.z, h.w) << 32); }
        }
    }
}
struct EpiProj {
    static constexpr bool PERM = true, AFTER_DRAIN = false;
    unsigned char* ws;
    LAS float* P;
    __device__ __forceinline__ void operator()(const pg8::f32x4 (&acc)[2][2][4][2], const pg8::Unit& u, int wr, int wc, int fr, int fq) const {
        asm volatile("" : "+v"(fr), "+v"(fq));
        const int pn = u.pn;
        bf16_t* const KI = (bf16_t*)(ws + WS_KI); float* const WI = (float*)(ws + WS_WI); bf16_t* const QI = (bf16_t*)(ws + WS_QI);
        int grp, sub;
        if (pn < 20) { grp = pn >> 2; sub = pn & 3; } else if (pn == 20) { grp = 5; sub = 0; } else { grp = 6 + ((pn - 21) >> 2); sub = (pn - 21) & 3; }
        const int b = u.pm >> 3, t0 = (u.pm & 7) * 256 + wr * 64 + fr;
        const int cl = 32 * wc + 8 * fq;
        const bool norm = (grp == 0 || grp == 1 || grp == 6 || grp == 7 || grp == 5);
        float rs[2][4][2];
        if (norm) {
#pragma unroll
            for (int ai = 0; ai < 2; ++ai)
#pragma unroll
                for (int m = 0; m < 4; ++m)
#pragma unroll
                    for (int bj = 0; bj < 2; ++bj) { const pg8::f32x4 a = acc[ai][bj][m][0], c = acc[ai][bj][m][1];
                        float s = (a[0] * a[0] + a[1] * a[1]) + (a[2] * a[2] + a[3] * a[3]) + (c[0] * c[0] + c[1] * c[1]) + (c[2] * c[2] + c[3] * c[3]);
                        s += __shfl_xor(s, 16); s += __shfl_xor(s, 32);
                        if (fq == 0) P[((ai * 128 + wr * 64 + m * 16 + fr) * 2 + bj) * 4 + wc] = s; }
            asm volatile("s_waitcnt lgkmcnt(0)" ::: "memory"); __builtin_amdgcn_s_barrier(); asm volatile("" ::: "memory");
#pragma unroll
            for (int ai = 0; ai < 2; ++ai)
#pragma unroll
                for (int m = 0; m < 4; ++m)
#pragma unroll
                    for (int bj = 0; bj < 2; ++bj) { const pg8::f32x4 q = *(const LAS pg8::f32x4*)(P + ((ai * 128 + wr * 64 + m * 16 + fr) * 2 + bj) * 4);
                        rs[ai][m][bj] = (grp == 5) ? rsqrtf((q[0] + q[1]) * (1.f / 64.f) + RMS_EPS) : rsqrtf(((q[0] + q[1]) + (q[2] + q[3])) * (1.f / 128.f) + RMS_EPS); }
        }
        if (grp == 5) {
            if (wc < 2) { const float* gki = (const float*)(ws + WS_GAIN) + 4 * 128; const pg8::f32x4 g0 = *(const pg8::f32x4*)(gki + cl), g1 = *(const pg8::f32x4*)(gki + cl + 4);
#pragma unroll
                for (int ai = 0; ai < 2; ++ai)
#pragma unroll
                    for (int m = 0; m < 4; ++m) { const size_t row = (size_t)b * SEQ + t0 + 128 * ai + 16 * m; const float r = rs[ai][m][0];
                        const pg8::f32x4 v0 = acc[ai][0][m][0] * r * g0, v1 = acc[ai][0][m][1] * r * g1;
                        pg8::u32x4 w; w.x = cvt_pk_bf16(v0[0], v0[1]); w.y = cvt_pk_bf16(v0[2], v0[3]); w.z = cvt_pk_bf16(v1[0], v1[1]); w.w = cvt_pk_bf16(v1[2], v1[3]);
                        *(pg8::u32x4*)(KI + row * 64 + cl) = w; } }
            else if (wc == 2 && fq < 2) {
#pragma unroll
                for (int ai = 0; ai < 2; ++ai)
#pragma unroll
                    for (int m = 0; m < 4; ++m) { const size_t row = (size_t)b * SEQ + t0 + 128 * ai + 16 * m;
                        *(pg8::f32x4*)(WI + row * 16 + 8 * fq) = acc[ai][0][m][0]; *(pg8::f32x4*)(WI + row * 16 + 8 * fq + 4) = acc[ai][0][m][1]; } }
            return;
        }
        if (grp == 4) {
#pragma unroll
            for (int ai = 0; ai < 2; ++ai)
#pragma unroll
                for (int m = 0; m < 4; ++m) { const size_t row = (size_t)b * SEQ + t0 + 128 * ai + 16 * m;
#pragma unroll
                    for (int bj = 0; bj < 2; ++bj) { const pg8::f32x4 v0 = acc[ai][bj][m][0], v1 = acc[ai][bj][m][1];
                        pg8::u32x4 w; w.x = cvt_pk_bf16(v0[0], v0[1]); w.y = cvt_pk_bf16(v0[2], v0[3]); w.z = cvt_pk_bf16(v1[0], v1[1]); w.w = cvt_pk_bf16(v1[2], v1[3]);
                        *(pg8::u32x4*)(QI + row * 1024 + sub * 256 + bj * 128 + cl) = w; } }
            return;
        }
        bf16_t* dst; const float* gain = nullptr;
        { const int slot = grp < 4 ? grp : grp - 2;
          dst = (bf16_t*)(ws + WS_QA + (size_t)slot * (32 * MiB));
          gain = (const float*)(ws + WS_GAIN) + (grp < 2 ? grp : grp - 4) * 128; }
        pg8::f32x4 g0 = {1.f, 1.f, 1.f, 1.f}, g1 = {1.f, 1.f, 1.f, 1.f};
        if (norm) { g0 = *(const pg8::f32x4*)(gain + cl); g1 = *(const pg8::f32x4*)(gain + cl + 4); }
        const bool act = (grp == 3 || grp == 9);
#pragma unroll
        for (int ai = 0; ai < 2; ++ai)
#pragma unroll
            for (int m = 0; m < 4; ++m) { const int t = t0 + 128 * ai + 16 * m;
#pragma unroll
                for (int bj = 0; bj < 2; ++bj) { const int h = 2 * sub + bj;
                    pg8::f32x4 v0 = acc[ai][bj][m][0], v1 = acc[ai][bj][m][1];
                    if (norm) { const float r = rs[ai][m][bj]; v0 = v0 * r * g0; v1 = v1 * r * g1; }
                    if (act) { v0[0] = fast_silu(v0[0]); v0[1] = fast_silu(v0[1]); v0[2] = fast_silu(v0[2]); v0[3] = fast_silu(v0[3]);
                               v1[0] = fast_silu(v1[0]); v1[1] = fast_silu(v1[1]); v1[2] = fast_silu(v1[2]); v1[3] = fast_silu(v1[3]); }
                    pg8::u32x4 w; w.x = cvt_pk_bf16(v0[0], v0[1]); w.y = cvt_pk_bf16(v0[2], v0[3]); w.z = cvt_pk_bf16(v1[0], v1[1]); w.w = cvt_pk_bf16(v1[2], v1[3]);
                    *(pg8::u32x4*)(dst + HM(b, h, t, cl)) = w; } }
    }
};
struct EpiOut {
    static constexpr bool PERM = false, AFTER_DRAIN = false;
    const float* x; const float* MOD; float* out;
    __device__ __forceinline__ void operator()(const pg8::f32x4 (&acc)[2][2][4][2], const pg8::Unit& u, int wr, int wc, int fr, int fq) const {
        asm volatile("" : "+v"(fr), "+v"(fq));
        const int b = u.pm >> 3; const float* gate = MOD + b * 3 * DM + 2 * DM;
        const int col0 = u.pn * 256 + wc * 32 + 4 * fq;
        pg8::f32x4 gv[2][2];
#pragma unroll
        for (int bj = 0; bj < 2; ++bj)
#pragma unroll
            for (int n = 0; n < 2; ++n) gv[bj][n] = *(const pg8::f32x4*)(gate + col0 + bj * 128 + n * 16);
#pragma unroll
        for (int ai = 0; ai < 2; ++ai)
#pragma unroll
            for (int m = 0; m < 4; ++m) { const size_t off = (size_t)(u.pm * 256 + ai * 128 + wr * 64 + m * 16 + fr) * DM + col0;
#pragma unroll
                for (int bj = 0; bj < 2; ++bj)
#pragma unroll
                    for (int n = 0; n < 2; ++n) { const pg8::f32x4 xv = *(const pg8::f32x4*)(x + off + bj * 128 + n * 16);
                        *(pg8::f32x4*)(out + off + bj * 128 + n * 16) = xv + gv[bj][n] * acc[ai][bj][m][n]; }
                if (m & 1) asm volatile("" ::: "memory"); }
    }
};

namespace att {
typedef short bf16x8 __attribute__((ext_vector_type(8)));
typedef short s16x4 __attribute__((ext_vector_type(4)));
typedef float f32x16 __attribute__((ext_vector_type(16)));
typedef float f32x4 __attribute__((ext_vector_type(4)));
typedef unsigned u32x4 __attribute__((ext_vector_type(4)));
constexpr int NW = 8, QBLK = 32, KVBLK = 64, QB = NW * QBLK, D = 128;
constexpr int SHM_V = KVBLK * D * 2, SHM_K = KVBLK * D * 2;
constexpr int LDS_WS = 2 * SHM_V + 2 * SHM_K, LDS_KM = LDS_WS + NW * 64 * 4, LDS_OST = 73728, LDS_BYTES = LDS_OST + NW * QBLK * D * 2;
constexpr float SCALE = 0.08838834764831845f, THR = 8.f;
#define KSWZ(row, colB) ((row) * 256 + ((colB) ^ (((row) & 7) << 4)))
#define SBAR() __builtin_amdgcn_sched_barrier(0)
__device__ __forceinline__ int v_st(int k, int c) { const int kk = (k & ~0xC) | ((k & 4) << 1) | ((k & 8) >> 1); return ((kk >> 3) * 4 + (c >> 5)) * 512 + ((kk & 7) * 32 + (c & 31)) * 2; }
__device__ __forceinline__ int v_rd_base(int lane) { return ((lane & 3) << 3) | (((lane >> 2) & 3) << 6) | (((lane >> 4) & 1) << 5) | (((lane >> 5) & 1) << 8); }
constexpr int v_rd_off(int d0, int ks, int half) { return d0 * 512 + ks * 4096 + half * 2048; }
__device__ __forceinline__ int crow(int r, int hi) { return (r & 3) + 8 * (r >> 2) + 4 * hi; }
__device__ __forceinline__ unsigned cvtpk(float lo, float hi) { unsigned r; asm volatile("v_cvt_pk_bf16_f32 %0, %1, %2" : "=v"(r) : "v"(lo), "v"(hi)); return r; }
__device__ __forceinline__ unsigned cvt1(float v) { unsigned r; asm volatile("v_cvt_pk_bf16_f32 %0, %1, 0" : "=v"(r) : "v"(v)); return r; }
__device__ __forceinline__ bf16x8 load8(const bf16_t* p) { return *reinterpret_cast<const bf16x8*>(p); }
__device__ __forceinline__ void mask_causal(f32x16& p0, f32x16& p1, int dq) {
    const float NEG = -__builtin_inff();
#pragma unroll
    for (int r = 0; r < 16; ++r) { const int c = (r & 3) + 8 * (r >> 2); if (dq - c < 0) p0[r] = NEG; if (dq - c - 32 < 0) p1[r] = NEG; }
}
__device__ __forceinline__ void mask_bits(f32x16& p0, f32x16& p1, unsigned w0, unsigned w1) {
    const unsigned NEGB = 0xff800000u;
#pragma unroll
    for (int r = 0; r < 16; ++r) { const int c = (r & 3) + 8 * (r >> 2);
        const unsigned t0 = (unsigned)(((int)(w0 << (31 - c))) >> 31), t1 = (unsigned)(((int)(w1 << (31 - c))) >> 31);
        p0[r] = __uint_as_float((__float_as_uint(p0[r]) & t0) | (NEGB & ~t0));
        p1[r] = __uint_as_float((__float_as_uint(p1[r]) & t1) | (NEGB & ~t1)); }
}
__device__ __forceinline__ void partialSM(f32x16& p0, f32x16& p1, float& m_reg, float& mn, float& alpha) {
    float pmax = p0[0]; for (int r = 1; r < 16; ++r) pmax = fmaxf(pmax, p0[r]); for (int r = 0; r < 16; ++r) pmax = fmaxf(pmax, p1[r]);
    { auto rr = __builtin_amdgcn_permlane32_swap(__float_as_uint(pmax), __float_as_uint(pmax), false, false);
      pmax = fmaxf(__uint_as_float(rr[0]), __uint_as_float(rr[1])); }
    constexpr float C2 = 1.4426950408889634f * SCALE;
    if (__builtin_expect(__all((pmax - m_reg) * SCALE <= THR), 1)) { mn = m_reg; alpha = 1.f; }
    else { mn = fmaxf(m_reg, pmax); alpha = __builtin_amdgcn_exp2f((m_reg - mn) * C2); m_reg = mn; }
    const float mnL = -mn * C2;
    for (int r = 0; r < 16; ++r) p0[r] = fmaf(p0[r], C2, mnL); for (int r = 0; r < 16; ++r) p1[r] = fmaf(p1[r], C2, mnL);
    for (int r = 0; r < 16; ++r) p0[r] = __builtin_amdgcn_exp2f(p0[r]);
}
__device__ __forceinline__ void finishSM(f32x16& p0, f32x16& p1, float alpha, float& l_reg, bf16x8& pa0, bf16x8& pa1, bf16x8& pa2, bf16x8& pa3) {
    for (int r = 0; r < 16; ++r) p1[r] = __builtin_amdgcn_exp2f(p1[r]);
    float ps = 0; for (int r = 0; r < 16; ++r) ps += p0[r]; for (int r = 0; r < 16; ++r) ps += p1[r];
    { auto rr = __builtin_amdgcn_permlane32_swap(__float_as_uint(ps), __float_as_uint(ps), false, false);
      ps = __uint_as_float(rr[0]) + __uint_as_float(rr[1]); }
    l_reg = l_reg * alpha + ps;
#define PK4(P, B_, OUT) do { unsigned a0 = cvtpk(P[B_+0], P[B_+1]), a1 = cvtpk(P[B_+2], P[B_+3]);                          \
        unsigned b0 = cvtpk(P[B_+4], P[B_+5]), b1 = cvtpk(P[B_+6], P[B_+7]);                                             \
        auto r0 = __builtin_amdgcn_permlane32_swap(a0, b0, false, false); auto r1 = __builtin_amdgcn_permlane32_swap(a1, b1, false, false); \
        u32x4 w = {r0[0], r1[0], r0[1], r1[1]}; OUT = *reinterpret_cast<bf16x8*>(&w); } while (0)
    PK4(p0, 0, pa0); PK4(p0, 8, pa1); PK4(p1, 0, pa2); PK4(p1, 8, pa3);
#undef PK4
}
template <int KB>
__device__ __forceinline__ void qkt(f32x16& p0, f32x16& p1, const char* K_lds, int r32, int hi, const bf16x8* qr, float cb, float sl) {
#pragma unroll
    for (int r = 0; r < 16; ++r) { const int c = (r & 3) + 8 * (r >> 2); p0[r] = fmaf(sl, (float)c, cb); p1[r] = fmaf(sl, (float)(c + 32), cb); }
    const char* kb[4];
#pragma unroll
    for (int dd = 0; dd < 4; ++dd) kb[dd] = K_lds + KB * SHM_K + KSWZ(r32, (dd * 16 + hi * 8) * 2);
#pragma unroll
    for (int d0 = 0; d0 < 8; ++d0) { const char* a = kb[d0 & 3] + (d0 >> 2) * 128;
        bf16x8 b0 = *reinterpret_cast<const bf16x8*>(a);
        bf16x8 b1 = *reinterpret_cast<const bf16x8*>(a + 32 * 256);
        p0 = __builtin_amdgcn_mfma_f32_32x32x16_bf16(b0, qr[d0], p0, 0, 0, 0);
        p1 = __builtin_amdgcn_mfma_f32_32x32x16_bf16(b1, qr[d0], p1, 0, 0, 0); }
}
template <int VB>
__device__ __forceinline__ void pv_tile(f32x16* o, int vb0, bf16x8 pa0, bf16x8 pa1, bf16x8 pa2, bf16x8 pa3) {
#define TRRD(dst, off) asm volatile("ds_read_b64_tr_b16 %0, %1 offset:%2" : "=&v"(dst) : "v"(vb0), "i"(off) : "memory")
#define PV_D0(d0) do { s16x4 l0, l1, l2, l3, h0, h1, h2, h3; constexpr int b_ = VB * SHM_V + v_rd_off(d0, 0, 0); \
        TRRD(l0, b_); TRRD(h0, b_ + 2048); TRRD(l1, b_ + 4096); TRRD(h1, b_ + 6144); TRRD(l2, b_ + 8192); TRRD(h2, b_ + 10240); TRRD(l3, b_ + 12288); TRRD(h3, b_ + 14336); \
        asm volatile("s_waitcnt lgkmcnt(0)" ::: "memory"); SBAR();   \
        o[d0] = __builtin_amdgcn_mfma_f32_32x32x16_bf16(pa0, (bf16x8){l0[0], l0[1], l0[2], l0[3], h0[0], h0[1], h0[2], h0[3]}, o[d0], 0, 0, 0);   \
        o[d0] = __builtin_amdgcn_mfma_f32_32x32x16_bf16(pa1, (bf16x8){l1[0], l1[1], l1[2], l1[3], h1[0], h1[1], h1[2], h1[3]}, o[d0], 0, 0, 0);   \
        o[d0] = __builtin_amdgcn_mfma_f32_32x32x16_bf16(pa2, (bf16x8){l2[0], l2[1], l2[2], l2[3], h2[0], h2[1], h2[2], h2[3]}, o[d0], 0, 0, 0);   \
        o[d0] = __builtin_amdgcn_mfma_f32_32x32x16_bf16(pa3, (bf16x8){l3[0], l3[1], l3[2], l3[3], h3[0], h3[1], h3[2], h3[3]}, o[d0], 0, 0, 0); } while (0)
    PV_D0(0); PV_D0(1); PV_D0(2); PV_D0(3);
#undef PV_D0
#undef TRRD
}

struct BlockRef { int grp, b, h, qb; };
__device__ __forceinline__ size_t hm_off(const BlockRef& r) { return ((size_t)(r.b * NH + r.h) * SEQ) * D; }
__device__ __forceinline__ const bf16_t* ptrQ(unsigned char* wsb, const BlockRef& r) { return (const bf16_t*)(wsb + (r.grp ? WS_QB : WS_QA)) + hm_off(r) + (size_t)r.qb * QB * D; }
__device__ __forceinline__ const bf16_t* ptrK(unsigned char* wsb, const BlockRef& r) { return (const bf16_t*)(wsb + (r.grp ? WS_KB : WS_KA)) + hm_off(r); }
__device__ __forceinline__ const bf16_t* ptrV(unsigned char* wsb, const BlockRef& r) { return (const bf16_t*)(wsb + (r.grp ? WS_VB : WS_VA)) + hm_off(r); }
__device__ __forceinline__ const bf16_t* ptrZ(unsigned char* wsb, const BlockRef& r) { return (const bf16_t*)(wsb + (r.grp ? WS_SZB : WS_SZA)) + hm_off(r) + (size_t)r.qb * QB * D; }
struct Seam { bf16x8 qr[8]; bf16x8 st_v0, st_v1, st_k0, st_k1; };
#define ROW(p, k0, rr) ((const bf16_t*)((const char*)(p) + (unsigned)(((k0) + (rr)) * (D * 2) + sc * 2)))
#define VMW() asm volatile("s_waitcnt vmcnt(0)" ::: "memory")
#define VMWN(n) asm volatile("s_waitcnt vmcnt(%0)" :: "i"(n) : "memory")
#define SLOAD_H(Kp, Vp, k0) do { S.st_v0 = load8(ROW(Vp, k0, sr)); S.st_v1 = load8(ROW(Vp, k0, 32 + sr));              \
                         S.st_k0 = load8(ROW(Kp, k0, sr)); S.st_k1 = load8(ROW(Kp, k0, 32 + sr)); } while (0)
#define SWRITE_HK(bf) do { *(bf16x8*)(K_lds + (bf) * SHM_K + kws) = S.st_k0; *(bf16x8*)(K_lds + (bf) * SHM_K + kws + 32 * 256) = S.st_k1; } while (0)
#define SWRITE_HV(bf) do { *(bf16x8*)(V_lds + (bf) * SHM_V + vst0) = S.st_v0; *(bf16x8*)(V_lds + (bf) * SHM_V + vst1) = S.st_v1; } while (0)
#define SWRITE_H(bf) do { SWRITE_HV(bf); SWRITE_HK(bf); } while (0)
__device__ __forceinline__ void prime(const BlockRef& cur, unsigned char* wsb, char* lds, Seam& S) {
    const int tid = threadIdx.x, wid = __builtin_amdgcn_readfirstlane(tid >> 6), lane = tid & 63, r32 = lane & 31, hi = lane >> 5;
    const int sr = tid >> 4, sc = (tid & 15) * 8, kws = KSWZ(sr, sc * 2); char* K_lds = lds + 2 * SHM_V;
    const bf16_t* Qp = ptrQ(wsb, cur); const bf16_t* Kp = ptrK(wsb, cur); const bf16_t* Vp = ptrV(wsb, cur);
    for (int d0 = 0; d0 < 8; ++d0) S.qr[d0] = load8(Qp + (size_t)(wid * QBLK + r32) * D + d0 * 16 + hi * 8);
    SLOAD_H(Kp, Vp, 0); VMW(); SWRITE_HK(0);
    __syncthreads();
}
__device__ __forceinline__ void block(const BlockRef& cur, unsigned char* wsb, char* lds, Seam& S) {
    const int GRP = cur.grp;
    const int tid = threadIdx.x, wid = __builtin_amdgcn_readfirstlane(tid >> 6), lane = tid & 63, r32 = lane & 31, hi = lane >> 5;
    const int NT = 4 * cur.qb + 4;
    const int qlo = cur.qb * QB + wid * QBLK, qm = qlo + r32 - 4 * hi;
    char* V_lds = lds; char* K_lds = lds + 2 * SHM_V;
    float* ws = (float*)(lds + LDS_WS) + wid * 64; float* li_l = ws, * al_l = ws + 32;
    float m_reg = -1e30f, l_reg = 0; f32x16 o[4] = {};
    const int sr = tid >> 4, sc = (tid & 15) * 8, vst0 = v_st(sr, sc), vst1 = v_st(32 + sr, sc), kws = KSWZ(sr, sc * 2);
    const int vb0 = (int)(uintptr_t)V_lds + v_rd_base(lane);
    const bf16_t* Kh = ptrK(wsb, cur); const bf16_t* Vh = ptrV(wsb, cur);
    const float sl = exp2f(-(float)(cur.h + 1)) * 11.313708498984761f;
    unsigned selbits = 0xffu;
    if (GRP == 1) {
        float* km = (float*)(lds + LDS_KM);
        const float* KM = (const float*)(wsb + WS_KMEAN) + ((size_t)(cur.b * NBLK) * NH + cur.h) * 128;
        if (tid < cur.qb * 32) { const int n = tid >> 5, c4 = (tid & 31) * 4; *(f32x4*)(km + n * 128 + c4) = *(const f32x4*)(KM + (size_t)n * (NH * 128) + c4); }
        __syncthreads();
        float v1 = -__builtin_inff(), v2 = v1, v3 = v1; int i1 = 31, i2 = 31, i3 = 31;
#pragma unroll 1
        for (int n = 0; n < cur.qb; ++n) { float a = 0.f;
#pragma unroll
            for (int d0 = 0; d0 < 8; ++d0) { const f32x4 k0 = *(const f32x4*)(km + n * 128 + d0 * 16 + hi * 8), k1 = *(const f32x4*)(km + n * 128 + d0 * 16 + hi * 8 + 4);
                const bf16x8 q = S.qr[d0];
                a += bf2f((bf16_t)q[0]) * k0[0] + bf2f((bf16_t)q[1]) * k0[1] + bf2f((bf16_t)q[2]) * k0[2] + bf2f((bf16_t)q[3]) * k0[3]
                   + bf2f((bf16_t)q[4]) * k1[0] + bf2f((bf16_t)q[5]) * k1[1] + bf2f((bf16_t)q[6]) * k1[2] + bf2f((bf16_t)q[7]) * k1[3]; }
            const float other = __shfl_xor(a, 32); const float g = a + other;
            const bool c1 = g > v1, c2 = g > v2, c3 = g > v3;
            v3 = c2 ? v2 : (c3 ? g : v3); i3 = c2 ? i2 : (c3 ? n : i3);
            v2 = c1 ? v1 : (c2 ? g : v2); i2 = c1 ? i1 : (c2 ? n : i2);
            v1 = c1 ? g : v1;             i1 = c1 ? n : i1; }
        selbits = ((1u << i1) | (1u << i2) | (1u << i3)) & 0xffu;
    }
    const char* mbase = (const char*)(wsb + WS_MASK) + ((size_t)cur.b * SEQ + qlo) * 256;
    const unsigned moff = (unsigned)r32 * 256u;
#define RESC(a) do { if (__any((a) < 1.f)) { if (hi == 0) al_l[r32] = (a); asm volatile("s_waitcnt lgkmcnt(0)" ::: "memory");              \
                     for (int d_ = 0; d_ < 4; ++d_) for (int r = 0; r < 16; ++r) o[d_][r] *= al_l[crow(r, hi)]; } } while (0)
#define KBASE(t) ((t) * KVBLK)
#define CB(t) ((GRP == 1 && (t) < 4 * cur.qb && !((selbits >> ((t) >> 2)) & 1u)) ? -__builtin_inff() : sl * (float)(KBASE(t) - qm))
#define MLOAD(t) ((GRP == 0) ? *(const unsigned long long*)(mbase + (moff + (unsigned)(t) * 8u)) : 0ull)
#define MASKT(P0_, P1_, t, mw) do { const int kb_ = KBASE(t); \
        if (GRP == 0) { mask_bits(P0_, P1_, ((unsigned)(mw)) >> (4 * hi), ((unsigned)((mw) >> 32)) >> (4 * hi)); } \
        else if (kb_ + KVBLK - 1 > qlo) mask_causal(P0_, P1_, qm - kb_); } while (0)
    f32x16 pA0, pA1, pB0, pB1; float mnA, mnB, alA, alB; bf16x8 pa0, pa1, pa2, pa3;
    unsigned long long mwA, mwB;
    SWRITE_HV(0); SBAR();
    if (NT > 1) SLOAD_H(Kh, Vh, KBASE(1));
    mwA = MLOAD(0);
    SBAR(); qkt<0>(pA0, pA1, K_lds, r32, hi, S.qr, CB(0), sl);
    MASKT(pA0, pA1, 0, mwA); partialSM(pA0, pA1, m_reg, mnA, alA);
    if (NT > 1) { VMW(); SWRITE_H(1); }
    __syncthreads();
#define HALF_STEP(PX0, PX1, mnX, alX, mwX, PY0, PY1, alY, t, KB, VB, SB) do {                                                 \
        SBAR(); qkt<KB>(PX0, PX1, K_lds, r32, hi, S.qr, CB(t), sl);                                                           \
        finishSM(PY0, PY1, alY, l_reg, pa0, pa1, pa2, pa3); SBAR();                                                           \
        if ((t) + 1 < NT) { SLOAD_H(Kh, Vh, KBASE((t) + 1)); SBAR(); }                                                        \
        mwX = MLOAD(t); pv_tile<VB>(o, vb0, pa0, pa1, pa2, pa3); MASKT(PX0, PX1, (t), mwX); partialSM(PX0, PX1, m_reg, mnX, alX);             \
        __syncthreads();                                                                                                      \
        if ((t) + 1 < NT) { VMW(); SWRITE_H(SB); }                                                                            \
        RESC(alX); __syncthreads(); } while (0)
    for (int t = 1; t + 1 < NT; t += 2) {
        HALF_STEP(pB0, pB1, mnB, alB, mwB, pA0, pA1, alA, t, 1, 0, 0);
        HALF_STEP(pA0, pA1, mnA, alA, mwA, pB0, pB1, alB, t + 1, 0, 1, 1);
    }
    SBAR(); qkt<1>(pB0, pB1, K_lds, r32, hi, S.qr, CB(NT - 1), sl); SBAR();
    mwB = MLOAD(NT - 1);
    finishSM(pA0, pA1, alA, l_reg, pa0, pa1, pa2, pa3); SBAR();
    pv_tile<0>(o, vb0, pa0, pa1, pa2, pa3);
    MASKT(pB0, pB1, NT - 1, mwB); partialSM(pB0, pB1, m_reg, mnB, alB); __syncthreads(); RESC(alB);
    finishSM(pB0, pB1, alB, l_reg, pa0, pa1, pa2, pa3); SBAR(); pv_tile<1>(o, vb0, pa0, pa1, pa2, pa3);
    if (hi == 0) li_l[r32] = l_reg; asm volatile("s_waitcnt lgkmcnt(0)" ::: "memory");
    float rli[16];
#pragma unroll
    for (int r = 0; r < 16; ++r) rli[r] = __builtin_amdgcn_rcpf(li_l[crow(r, hi)]);
    { bf16_t* stg = (bf16_t*)(lds + LDS_OST) + wid * (QBLK * D);
      int lane_e = lane; asm volatile("" : "+v"(lane_e));
      bf16_t* stw = stg + (4 * (lane_e >> 5)) * D + (lane_e & 31);
#pragma unroll
      for (int r = 0; r < 16; ++r) { const int orow = (r & 3) + 8 * (r >> 2);
#pragma unroll
          for (int d0 = 0; d0 < 4; ++d0) stw[orow * D + d0 * 32] = (bf16_t)cvt1(o[d0][r] * rli[r]); }
      asm volatile("s_waitcnt lgkmcnt(0)" ::: "memory");
      char* Ow = (char*)((bf16_t*)(wsb + WS_Y) + ((size_t)cur.b * SEQ + qlo) * 2048 + cur.grp * 1024 + cur.h * 128);
      const char* Zw = (const char*)(ptrZ(wsb, cur) + (size_t)(wid * QBLK) * D);
      const unsigned eo = (unsigned)((lane_e >> 4) * 256 + (lane_e & 15) * 16), yo = (unsigned)((lane_e >> 4) * 4096 + (lane_e & 15) * 16);
#pragma unroll
      for (int i = 0; i < 8; ++i) {
          const u32x4 ov = *(const u32x4*)((const char*)stg + (eo + (unsigned)(i * 1024))), zv = *(const u32x4*)(Zw + (eo + (unsigned)(i * 1024))); u32x4 w;
#pragma unroll
          for (int j = 0; j < 4; ++j) w[j] = cvtpk(__uint_as_float(ov[j] << 16) * __uint_as_float(zv[j] << 16), __uint_as_float(ov[j] & 0xffff0000u) * __uint_as_float(zv[j] & 0xffff0000u));
          *(u32x4*)(Ow + (yo + (unsigned)(i * 16384))) = w; } }
    __syncthreads();
#undef RESC
#undef KBASE
#undef CB
#undef MLOAD
#undef MASKT
#undef HALF_STEP
}
#undef ROW
#undef VMW
#undef VMWN
#undef SLOAD_H
#undef SWRITE_HK
#undef SWRITE_HV
#undef SWRITE_H
__device__ __forceinline__ bool decode(int v, int G, int i, BlockRef& r) {
    const int L = v + (i >> 1) * G; if (L >= 512) return false;
    const int x = L & 3, k = L >> 5;
    r.h = (L >> 2) & 7; r.b = k & 7; r.grp = ((k & 1) ^ (k >> 3)) & 1; r.qb = (i & 1) ? 7 - x : x;
    return true;
}
__device__ __forceinline__ void attn_phase(char* lds, unsigned char* wsb, int v, int G) {
    BlockRef cur, nxt;
    if (!decode(v, G, 0, cur)) return;
    Seam S;
    prime(cur, wsb, lds, S);
    for (int i = 0;; ++i) {
        const bool more = decode(v, G, i + 1, nxt);
        if (!more) nxt = cur;
        block(cur, wsb, lds, S);
        if (!more) break;
        prime(nxt, wsb, lds, S);
        cur = nxt;
    }
}
#undef KSWZ
#undef SBAR
}

namespace sel {
#define SLAS __attribute__((address_space(3)))
typedef short bf16x8 __attribute__((ext_vector_type(8)));
typedef float f32x16 __attribute__((ext_vector_type(16)));
typedef float f32x4 __attribute__((ext_vector_type(4)));
typedef unsigned u32x4 __attribute__((ext_vector_type(4)));
constexpr int KB_OFF = 131072;
constexpr int DUMMY_OFF = 147456 + 64;
__device__ __forceinline__ unsigned fkey(float x) { const unsigned b = __float_as_uint(x); return (b & 0x80000000u) ? ~b : (b | 0x80000000u); }
__device__ __forceinline__ void unit(SLAS unsigned char* lds, unsigned char* wsb, int b, int rg) {
    const int tid = threadIdx.x, wid = __builtin_amdgcn_readfirstlane(tid >> 6), lane = tid & 63, j = lane & 31, g = lane >> 5;
    const bf16_t* QI = (const bf16_t*)(wsb + WS_QI); const char* KIb = (const char*)((const bf16_t*)(wsb + WS_KI) + (size_t)b * SEQ * 64); const float* WI = (const float*)(wsb + WS_WI);
    unsigned long long* MASK = (unsigned long long*)(wsb + WS_MASK);
    const int ta = 16 * rg + 2 * wid, t = ta + g;
    const int nkeys = 16 * rg + 16, nk32 = (nkeys + 31) >> 5, nch = (nkeys + 63) >> 6;
    SLAS unsigned* sc = (SLAS unsigned*)lds + (wid * 2 + g) * 2048 + j;
    bf16x8 af[4];
    { const int i = lane & 31, tok = (i >> 2) & 1, head = (i & 3) + 4 * (i >> 3);
      const bf16_t* qp = QI + ((size_t)b * SEQ + ta + tok) * 1024 + head * 64 + 8 * (lane >> 5);
#pragma unroll
      for (int ks = 0; ks < 4; ++ks) af[ks] = *(const bf16x8*)(qp + 16 * ks); }
    float wv[16];
    { const float* wp = WI + ((size_t)b * SEQ + t) * 16;
#pragma unroll
      for (int q4 = 0; q4 < 4; ++q4) { const f32x4 w4 = *(const f32x4*)(wp + 4 * q4); wv[4 * q4] = w4[0] * 0.03125f; wv[4 * q4 + 1] = w4[1] * 0.03125f; wv[4 * q4 + 2] = w4[2] * 0.03125f; wv[4 * q4 + 3] = w4[3] * 0.03125f; } }
    const int srow = tid >> 3, scol = tid & 7, swr = srow * 128 + ((scol ^ ((srow >> 1) & 7)) << 4);
    int koff[4];
#pragma unroll
    for (int ks = 0; ks < 4; ++ks) koff[ks] = j * 128 + (((2 * ks + g) ^ ((j >> 1) & 7)) << 4);
    u32x4 st = *(const u32x4*)(KIb + (unsigned)(tid * 16));
    *(SLAS u32x4*)(lds + KB_OFF + swr) = st;
    __syncthreads();
#pragma unroll 1
    for (int c = 0; c < nch; ++c) {
        if (c + 1 < nch) st = *(const u32x4*)(KIb + (unsigned)((c + 1) * 8192 + tid * 16));
        SLAS unsigned char* kb = lds + KB_OFF + (c & 1) * 8192;
#pragma unroll
        for (int k2 = 0; k2 < 2; ++k2) { const int kt = 2 * c + k2;
            if (kt < nk32) {
                f32x16 acc = {};
#pragma unroll
                for (int ks = 0; ks < 4; ++ks) { const bf16x8 bfr = *(const SLAS bf16x8*)(kb + k2 * 4096 + koff[ks]);
                    acc = __builtin_amdgcn_mfma_f32_32x32x16_bf16(af[ks], bfr, acc, 0, 0, 0); }
                float s = 0.f;
#pragma unroll
                for (int r = 0; r < 16; ++r) s = fmaf(wv[r], fmaxf(acc[r], 0.f), s);
                unsigned uk = fkey(s);
                if (32 * kt + j > t) uk = 0u;
                sc[32 * kt] = uk;
            } }
        if (c + 1 < nch) *(SLAS u32x4*)(lds + KB_OFF + ((c + 1) & 1) * 8192 + swr) = st;
        __syncthreads();
    }
    unsigned T = 1u; int need = 0; bool ties = false;
    if (16 * rg >= TOPK) {
        SLAS unsigned* hist = (SLAS unsigned*)(lds + KB_OFF) + (wid * 2 + g) * 256;
        SLAS unsigned* dummy = (SLAS unsigned*)(lds + DUMMY_OFF);
        unsigned prefix = 0u; need = TOPK; int ceq = 0;
#pragma unroll 1
        for (int p = 0; p < 4; ++p) { const int shift = 24 - 8 * p;
            *(SLAS u32x4*)(hist + 8 * j) = (u32x4){0u, 0u, 0u, 0u}; *(SLAS u32x4*)(hist + 8 * j + 4) = (u32x4){0u, 0u, 0u, 0u};
            const unsigned phi = prefix >> ((shift + 8) & 31);
#pragma unroll 2
            for (int kt = 0; kt < nk32; ++kt) { const unsigned x = sc[32 * kt];
                const bool match = (p == 0) ? (x != 0u) : ((x >> ((shift + 8) & 31)) == phi);
                SLAS unsigned* dst = match ? (hist + ((x >> shift) & 255u)) : dummy;
                __hip_atomic_fetch_add(dst, 1u, __ATOMIC_RELAXED, __HIP_MEMORY_SCOPE_WORKGROUP); }
            asm volatile("s_waitcnt lgkmcnt(0)" ::: "memory");
            const u32x4 c0 = *(const SLAS u32x4*)(hist + 8 * j), c1 = *(const SLAS u32x4*)(hist + 8 * j + 4);
            const int cnt[8] = {(int)c0[0], (int)c0[1], (int)c0[2], (int)c0[3], (int)c1[0], (int)c1[1], (int)c1[2], (int)c1[3]};
            const int s = ((cnt[0] + cnt[1]) + (cnt[2] + cnt[3])) + ((cnt[4] + cnt[5]) + (cnt[6] + cnt[7]));
            int S = s;
#pragma unroll
            for (int off = 1; off < 32; off <<= 1) { const int v = __shfl_down(S, off, 32); if (j + off < 32) S += v; }
            const int above = S - s;
            const bool found = (S >= need) && (above < need);
            int dsel = 0, nneed = 0, csel = 0;
            { const int rem = need - above; int cum = 0; bool done = false;
#pragma unroll
              for (int i = 7; i >= 0; --i) { const int before = cum; cum += cnt[i]; if (!done && cum >= rem) { done = true; dsel = 8 * j + i; nneed = rem - before; csel = cnt[i]; } } }
            const unsigned long long bm = __ballot(found);
            const int src = 32 * g + __builtin_ctz((unsigned)(bm >> (32 * g)) | 0x80000000u);
            const int digit = __shfl(dsel, src); need = __shfl(nneed, src); ceq = __shfl(csel, src);
            prefix |= (unsigned)digit << shift;
        }
        T = prefix; ties = (ceq != need);
    }
    unsigned wlo = 0u, whi = 0u;
    if (!__any(ties)) {
#pragma unroll 2
        for (int k64 = 0; k64 < 32; ++k64) {
            const unsigned x0 = (2 * k64 < nk32) ? sc[64 * k64] : 0u, x1 = (2 * k64 + 1 < nk32) ? sc[64 * k64 + 32] : 0u;
            const unsigned long long b0 = __ballot(x0 >= T), b1 = __ballot(x1 >= T);
            const unsigned lo = g ? (unsigned)(b0 >> 32) : (unsigned)b0, hi = g ? (unsigned)(b1 >> 32) : (unsigned)b1;
            if (j == k64) { wlo = lo; whi = hi; } }
    } else {
        int base = 0;
#pragma unroll 1
        for (int k64 = 0; k64 < 32; ++k64) { unsigned lo = 0u, hi = 0u;
#pragma unroll
            for (int hh = 0; hh < 2; ++hh) { const unsigned x = (2 * k64 + hh < nk32) ? sc[64 * k64 + 32 * hh] : 0u;
                const unsigned long long be = __ballot(x == T); const unsigned em = g ? (unsigned)(be >> 32) : (unsigned)be;
                const int rank = base + __builtin_popcount(em & ((1u << j) - 1u));
                const bool s1 = (x > T) || (x == T && rank < need);
                base += __builtin_popcount(em);
                const unsigned long long bs = __ballot(s1); const unsigned sm = g ? (unsigned)(bs >> 32) : (unsigned)bs;
                if (hh == 0) lo = sm; else hi = sm; }
            if (j == k64) { wlo = lo; whi = hi; } }
    }
    MASK[((size_t)b * SEQ + t) * 32 + j] = (unsigned long long)wlo | ((unsigned long long)whi << 32);
    __syncthreads();
}
__device__ __forceinline__ void kmean_unit(SLAS unsigned char* lds, unsigned char* wsb, int b, int n, int h) {
    const int tid = threadIdx.x, d4 = tid & 31, rs = tid >> 5;
    const bf16_t* KB = (const bf16_t*)(wsb + WS_KB) + (((size_t)(b * NH + h) * SEQ) + n * 256) * 128;
    float a0 = 0.f, a1 = 0.f, a2 = 0.f, a3 = 0.f;
#pragma unroll 4
    for (int r = 0; r < 16; ++r) { const unsigned long long v = *(const unsigned long long*)(KB + (size_t)(rs * 16 + r) * 128 + d4 * 4);
        const unsigned lo = (unsigned)v, hi = (unsigned)(v >> 32);
        a0 += __uint_as_float(lo << 16); a1 += __uint_as_float(lo & 0xffff0000u); a2 += __uint_as_float(hi << 16); a3 += __uint_as_float(hi & 0xffff0000u); }
    SLAS float* red = (SLAS float*)lds;
    *(SLAS f32x4*)(red + rs * 128 + d4 * 4) = (f32x4){a0, a1, a2, a3};
    __syncthreads();
    if (tid < 128) { float s = 0.f;
#pragma unroll
        for (int q = 0; q < 16; ++q) s += red[q * 128 + tid];
        ((float*)(wsb + WS_KMEAN))[((size_t)(b * NBLK + n) * NH + h) * 128 + tid] = s * (1.f / 256.f); }
    __syncthreads();
}
__device__ __forceinline__ void select_phase(SLAS unsigned char* lds, unsigned char* wsb, int v, int G) {
    for (int L = v; L < 512; L += G) kmean_unit(lds, wsb, L >> 6, (L >> 3) & 7, L & 7);
    for (int L = v; L < 512; L += G) { const int b = L >> 6, x = L & 63;
        unit(lds, wsb, b, x);
        unit(lds, wsb, b, 127 - x); }
}
#undef SLAS
}

struct Args { const float* in[12]; float* out; unsigned char* ws; int ph_lo, ph_hi, li, pad; };
__global__ void __launch_bounds__(NWAVES * 64, 2) mega_fwd(Args args) {
    extern __shared__ __attribute__((aligned(16))) unsigned char lds[];
    Frame F;
    F.lds = (LAS unsigned char*)lds; F.MISC = (volatile LAS unsigned*)(F.lds + MISC_OFF);
    F.tid = threadIdx.x; F.lane = F.tid & 63; F.wave = __builtin_amdgcn_readfirstlane(F.tid >> 6);
    F.G = gridDim.x; { const int bx = blockIdx.x; F.vcu = (F.G % 8 == 0) ? (bx % 8) * (F.G / 8) + bx / 8 : bx; }
    unsigned char* ws = args.ws;
    F.ctl = (gu32*)(ws + WS_CTL);
    const float* x = args.in[0]; const float* c = args.in[1]; const float* w_ada = args.in[2]; const float* b_ada = args.in[3]; const float* g_norm = args.in[4];
    const float* w_in = args.in[5]; const float* w_out = args.in[11];
    float* MOD = (float*)(ws + WS_MOD); bf16_t* WinT = (bf16_t*)(ws + WS_WIN); bf16_t* WoutT = (bf16_t*)(ws + WS_WOUT); bf16_t* HB = (bf16_t*)(ws + WS_HB); bf16_t* Y = (bf16_t*)(ws + WS_Y);
    for (int u = F.tid; u < (LDS_BYTES - LDSCTL_OFF) / 4; u += NWAVES * 64) ((LAS unsigned*)(F.lds + LDSCTL_OFF))[u] = 0u;
    __syncthreads();
    XcdBarrier bar = xcd_barrier_post((unsigned*)(F.ctl + CW_BAR) + args.li * XCD_BAR_WORDS, F.MISC + 8);
    const int lo = args.ph_lo, hi = args.ph_hi;
#define IN(k) (lo <= (k) && (k) < hi)
#define BOTH(k) (IN(k) && IN((k) + 1))
    if (IN(0)) {
        if ((int)blockIdx.x < 192) p0_mod(F, (int)blockIdx.x, c, w_ada, b_ada, MOD);
        else if ((int)blockIdx.x == 192) { float* G = (float*)(ws + WS_GAIN);
            if (F.tid < 128) { G[F.tid] = args.in[6][F.tid]; G[128 + F.tid] = args.in[7][F.tid]; G[256 + F.tid] = args.in[9][F.tid]; G[384 + F.tid] = args.in[10][F.tid]; }
            if (F.tid < 64) G[512 + F.tid] = args.in[8][F.tid]; }
        p0_convert(F, w_in, w_out, WinT, WoutT);
        if (BOTH(0)) xcd_barrier(bar);
    }
    if (IN(1)) {
        p1_norm(F, x, g_norm, MOD, HB);
        if (BOTH(1)) xcd_barrier(bar);
    }
    if (IN(2)) {
        pg8::Gemm g{HB, WinT, M, NPAD, DM}; pg8::StaticOrder S; S.init(M, NPAD, F.G, (int)blockIdx.x);
        EpiProj E{ws, (LAS float*)(F.lds + EPI_OFF)};
        pg8::gemm_phase<EpiProj, pg8::StaticOrder, true, true>(F.lds, g, S, E);
        if (BOTH(2)) xcd_barrier(bar);
    }
    if (IN(3)) {
        sel::select_phase(F.lds, ws, F.vcu, F.G);
        if (BOTH(3)) xcd_barrier(bar);
    }
    if (IN(4)) {
        att::attn_phase((char*)lds, ws, F.vcu, F.G);
        if (BOTH(4)) xcd_barrier(bar);
    }
    if (IN(5)) {
        pg8::Gemm g{Y, WoutT, M, DM, DM}; pg8::StaticOrder S; S.init(M, DM, F.G, (int)blockIdx.x);
        EpiOut E{x, MOD, args.out};
        pg8::gemm_phase<EpiOut, pg8::StaticOrder, true, true>(F.lds, g, S, E);
    }
#undef IN
#undef BOTH
}

static int mega_setup() {
    static int grid = 0;
    if (grid == 0) {
        int dev = 0, cus = 0;
        if (hipGetDevice(&dev) != hipSuccess || hipDeviceGetAttribute(&cus, hipDeviceAttributeMultiprocessorCount, dev) != hipSuccess) { fprintf(stderr, "kernel_launch: device query failed\n"); grid = -1; return grid; }
        if (hipFuncSetAttribute((const void*)mega_fwd, hipFuncAttributeMaxDynamicSharedMemorySize, LDS_BYTES) != hipSuccess) { fprintf(stderr, "kernel_launch: hipFuncSetAttribute failed\n"); grid = -1; return grid; }
        (void)hipGetLastError();
        grid = cus;
    }
    return grid;
}
static void mega_launch(int grid, void* const* d_in, void* d_out, void* d_ws, int ph_lo, int ph_hi, int li, hipStream_t stream) {
    Args a{};
    for (int i = 0; i < 12; ++i) a.in[i] = (const float*)d_in[i];
    a.out = (float*)d_out; a.ws = (unsigned char*)d_ws; a.ph_lo = ph_lo; a.ph_hi = ph_hi; a.li = li;
    hipLaunchKernelGGL(mega_fwd, dim3(grid), dim3(NWAVES * 64), LDS_BYTES, stream, a);
}

extern "C" void kernel_launch(void* const* d_in, const int* in_sizes, int n_in, void* d_out, int out_size, void* d_ws, size_t ws_size, hipStream_t stream) {
    if (n_in != 12 || in_sizes[0] != M * DM || out_size != M * DM || ws_size < WS_END) {
        fprintf(stderr, "kernel_launch: unexpected shapes (n_in %d, in0 %d, out %d, ws %zu); nothing launched\n", n_in, n_in > 0 ? in_sizes[0] : -1, out_size, ws_size); return; }
    const int grid = mega_setup(); if (grid <= 0) return;
    char* ws = (char*)d_ws;
    bf16_t* QA = (bf16_t*)(ws + WS_QA); bf16_t* KA = (bf16_t*)(ws + WS_KA); bf16_t* VA = (bf16_t*)(ws + WS_VA); bf16_t* SZA = (bf16_t*)(ws + WS_SZA);
    bf16_t* QB = (bf16_t*)(ws + WS_QB); bf16_t* KB = (bf16_t*)(ws + WS_KB); bf16_t* VB = (bf16_t*)(ws + WS_VB); bf16_t* SZB = (bf16_t*)(ws + WS_SZB);
    bf16_t* QI = (bf16_t*)(ws + WS_QI); bf16_t* KI = (bf16_t*)(ws + WS_KI); float* WI = (float*)(ws + WS_WI); float* KMEAN = (float*)(ws + WS_KMEAN);
    unsigned long long* MASKT = (unsigned long long*)(ws + WS_MASK); bf16_t* Y = (bf16_t*)(ws + WS_Y);
    (void)hipMemsetAsync(ws + WS_CTL, 0, CTL_ZERO_BYTES, stream);
#if NAIVE_SEL
    mega_launch(grid, d_in, d_out, d_ws, 0, 3, 0, stream);
    k_kmean<<<BATCH * NBLK * NH, 128, 0, stream>>>(KB, KMEAN);
    (void)hipMemsetAsync(MASKT, 0, 4 * MiB, stream);
    k_dsa_select_naive<<<dim3(SEQ, BATCH), 256, 0, stream>>>(QI, KI, WI, MASKT);
    mega_launch(grid, d_in, d_out, d_ws, 4, 6, 1, stream);
#else
    mega_launch(grid, d_in, d_out, d_ws, 0, 6, 0, stream);
#endif
}
```

```cpp
#include <hip/hip_runtime.h>
#include <cstdio>
#include <cstdint>

typedef unsigned short bf16_t;
#ifndef NAIVE_SEL
#define NAIVE_SEL 0
#endif
#ifndef PROBE_DOUBLE
#define PROBE_DOUBLE 0
#endif
constexpr int BATCH = 8, SEQ = 2048, DM = 2048, M = BATCH * SEQ, NH = 8, HD = 128, DA = 1024, IH = 16, ID = 64, DIN = 9296;
constexpr int TOPK = 256, NBLK = 8;
constexpr float RMS_EPS = 1e-6f;
constexpr float QK_SCALE = 0.08838834764831845f;

__device__ __forceinline__ float bf2f(bf16_t v) { return __uint_as_float(((unsigned)v) << 16); }
__device__ __forceinline__ bf16_t f2bf(float f) { unsigned u = __float_as_uint(f); return (bf16_t)((u + 0x7fffu + ((u >> 16) & 1u)) >> 16); }
__device__ __forceinline__ float rbf(float f) { return bf2f(f2bf(f)); }
__device__ __forceinline__ float silu_f(float v) { return v / (1.f + __expf(-v)); }
__device__ __forceinline__ size_t HM(int b, int h, int t, int d) { return (((size_t)(b * NH + h) * SEQ + t) * HD + d); }
__device__ __forceinline__ float wave_sum(float v) {
#pragma unroll
    for (int o = 1; o < 64; o <<= 1) v += __shfl_xor(v, o);
    return v;
}
__device__ __forceinline__ float wave_max(float v) {
#pragma unroll
    for (int o = 1; o < 64; o <<= 1) v = fmaxf(v, __shfl_xor(v, o));
    return v;
}
__device__ __forceinline__ void mask_pos(int t, int s, size_t& word, int& bit) { word = (size_t)t * 32 + (s >> 6); bit = s & 63; }

__global__ void k_mod(const float* __restrict__ c, const float* __restrict__ w_ada, const float* __restrict__ b_ada, float* __restrict__ MOD) {
    __shared__ float sc[DM];
    const int b = blockIdx.y, n = blockIdx.x * 256 + threadIdx.x;
    for (int k = threadIdx.x; k < DM; k += 256) sc[k] = silu_f(c[b * DM + k]);
    __syncthreads();
    float acc = 0.f;
    for (int k = 0; k < DM; ++k) acc += sc[k] * w_ada[(size_t)k * (3 * DM) + n];
    MOD[b * 3 * DM + n] = acc + b_ada[n];
}
__global__ void k_norm(const float* __restrict__ x, const float* __restrict__ g, const float* __restrict__ MOD, bf16_t* __restrict__ HB) {
    const int lane = threadIdx.x & 63, row = blockIdx.x * 4 + (threadIdx.x >> 6), b = row / SEQ;
    const float* xr = x + (size_t)row * DM;
    float ss = 0.f;
    for (int k = lane; k < DM; k += 64) { const float v = xr[k]; ss += v * v; }
    ss = wave_sum(ss);
    const float rstd = rsqrtf(ss / DM + RMS_EPS);
    const float* shift = MOD + b * 3 * DM; const float* scale = shift + DM;
    for (int k = lane; k < DM; k += 64) HB[(size_t)row * DM + k] = f2bf(xr[k] * rstd * g[k] * (1.f + scale[k]) + shift[k]);
}
template <int MODE>
__global__ void k_gemm_naive(const bf16_t* __restrict__ A, int K, const float* __restrict__ W, int ldw, int n0, int ncols,
                             float* __restrict__ C, int ldc, const float* __restrict__ xres, const float* __restrict__ MOD) {
    __shared__ float As[16][65], Bs[16][65];
    const int tid = threadIdx.x, tx = tid & 15, ty = tid >> 4, m0 = blockIdx.y * 64, c0 = blockIdx.x * 64;
    float acc[4][4] = {};
    for (int k0 = 0; k0 < K; k0 += 16) {
        for (int i = tid; i < 1024; i += 256) { const int r = i >> 4, kk = i & 15; As[kk][r] = bf2f(A[(size_t)(m0 + r) * K + k0 + kk]); }
        for (int i = tid; i < 1024; i += 256) { const int kk = i >> 6, cc = i & 63; Bs[kk][cc] = (c0 + cc < ncols) ? rbf(W[(size_t)(k0 + kk) * ldw + n0 + c0 + cc]) : 0.f; }
        __syncthreads();
#pragma unroll
        for (int kk = 0; kk < 16; ++kk) {
            float a[4], bb[4];
#pragma unroll
            for (int i = 0; i < 4; ++i) { a[i] = As[kk][ty * 4 + i]; bb[i] = Bs[kk][tx * 4 + i]; }
#pragma unroll
            for (int i = 0; i < 4; ++i)
#pragma unroll
                for (int j = 0; j < 4; ++j) acc[i][j] += a[i] * bb[j];
        }
        __syncthreads();
    }
#pragma unroll
    for (int i = 0; i < 4; ++i)
#pragma unroll
        for (int j = 0; j < 4; ++j) {
            const int m = m0 + ty * 4 + i, cc = c0 + tx * 4 + j;
            if (cc < ncols) {
                if (MODE == 0) C[(size_t)m * ldc + cc] = acc[i][j];
                else { const int b = m / SEQ; C[(size_t)m * ldc + cc] = xres[(size_t)m * ldc + cc] + MOD[b * 3 * DM + 2 * DM + cc] * acc[i][j]; }
            }
        }
}
__global__ void k_post(const float* __restrict__ T32, const float* __restrict__ gain, bf16_t* __restrict__ dst, int mode) {
    const int lane = threadIdx.x & 63, item = blockIdx.x * 4 + (threadIdx.x >> 6), m = item >> 3, h = item & 7, b = m / SEQ, t = m % SEQ;
    const float* src = T32 + (size_t)m * 1024 + h * 128;
    float v0 = src[lane], v1 = src[lane + 64];
    if (mode == 0) { const float ss = wave_sum(v0 * v0 + v1 * v1); const float rstd = rsqrtf(ss / 128.f + RMS_EPS); v0 = v0 * rstd * gain[lane]; v1 = v1 * rstd * gain[lane + 64]; }
    if (mode == 2) { v0 = silu_f(v0); v1 = silu_f(v1); }
    if (mode == 3) { dst[(size_t)m * 1024 + h * 128 + lane] = f2bf(v0); dst[(size_t)m * 1024 + h * 128 + lane + 64] = f2bf(v1); }
    else { dst[HM(b, h, t, lane)] = f2bf(v0); dst[HM(b, h, t, lane + 64)] = f2bf(v1); }
}
__global__ void k_post_idx(const float* __restrict__ T32, const float* __restrict__ gain, bf16_t* __restrict__ KI, float* __restrict__ WI) {
    const int lane = threadIdx.x & 63, m = blockIdx.x * 4 + (threadIdx.x >> 6);
    const float v = T32[(size_t)m * 80 + lane];
    const float ss = wave_sum(v * v); const float rstd = rsqrtf(ss / 64.f + RMS_EPS);
    KI[(size_t)m * 64 + lane] = f2bf(v * rstd * gain[lane]);
    if (lane < 16) WI[(size_t)m * 16 + lane] = T32[(size_t)m * 80 + 64 + lane];
}
__global__ void k_kmean(const bf16_t* __restrict__ KB, float* __restrict__ KMEAN) {
    const int d = threadIdx.x, h = blockIdx.x & 7, n = (blockIdx.x >> 3) & 7, b = blockIdx.x >> 6;
    float s = 0.f;
    for (int t = 0; t < 256; ++t) s += bf2f(KB[HM(b, h, n * 256 + t, d)]);
    KMEAN[((size_t)(b * NBLK + n) * NH + h) * HD + d] = s * (1.f / 256.f);
}
__global__ void k_dsa_select_naive(const bf16_t* __restrict__ QI, const bf16_t* __restrict__ KI, const float* __restrict__ WI, unsigned long long* __restrict__ MASKT) {
    const int t = blockIdx.x, b = blockIdx.y, tid = threadIdx.x; const size_t m = (size_t)b * SEQ + t;
    __shared__ float q[1024]; __shared__ float w[16]; __shared__ float sc[SEQ];
    for (int i = tid; i < 1024; i += 256) q[i] = bf2f(QI[m * 1024 + i]);
    if (tid < 16) w[tid] = WI[m * 16 + tid];
    __syncthreads();
    for (int s = tid; s <= t; s += 256) {
        float k[64];
        const bf16_t* kp = KI + ((size_t)b * SEQ + s) * 64;
#pragma unroll
        for (int d = 0; d < 64; ++d) k[d] = bf2f(kp[d]);
        float score = 0.f;
        for (int h = 0; h < 16; ++h) { float dot = 0.f;
#pragma unroll
            for (int d = 0; d < 64; ++d) dot += q[h * 64 + d] * k[d];
            score += w[h] * fmaxf(dot * 0.125f, 0.f); }
        sc[s] = score * 0.25f;
    }
    __syncthreads();
    for (int s = tid; s <= t; s += 256) {
        bool sel = true;
        if (t >= TOPK) { const float v = sc[s]; int cnt = 0; for (int s2 = 0; s2 <= t; ++s2) { const float u = sc[s2]; cnt += (u > v || (u == v && s2 < s)) ? 1 : 0; } sel = cnt < TOPK; }
        if (sel) { size_t word; int bit; mask_pos(t, s, word, bit); atomicOr(&MASKT[(size_t)b * 65536 + word], 1ull << bit); }
    }
}
__global__ void k_dsa_attn_naive(const bf16_t* __restrict__ QA, const bf16_t* __restrict__ KA, const bf16_t* __restrict__ VA, const bf16_t* __restrict__ SZA,
                                 const unsigned long long* __restrict__ MASKT, bf16_t* __restrict__ Y) {
    const int t = blockIdx.x, b = blockIdx.y, tid = threadIdx.x, lane = tid & 63, w = tid >> 6; const size_t m = (size_t)b * SEQ + t;
    __shared__ int idx[512]; __shared__ int nsel; __shared__ float qs[8][128]; __shared__ float p[4][256];
    if (tid == 0) nsel = 0;
    __syncthreads();
    for (int s = tid; s <= t; s += 256) { size_t word; int bit; mask_pos(t, s, word, bit);
        if ((MASKT[(size_t)b * 65536 + word] >> bit) & 1ull) { const int pos = atomicAdd(&nsel, 1); if (pos < 512) idx[pos] = s; } }
    for (int i = tid; i < 1024; i += 256) qs[i >> 7][i & 127] = bf2f(QA[HM(b, i >> 7, t, i & 127)]);
    __syncthreads();
    const int n = nsel < 256 ? nsel : 256;
    for (int hh = 0; hh < 2; ++hh) {
        const int h = w + 4 * hh; const float slope = exp2f(-(float)(h + 1));
        float sv[4]; float mx = -INFINITY;
#pragma unroll
        for (int i = 0; i < 4; ++i) { const int j = lane + 64 * i; sv[i] = -INFINITY;
            if (j < n) { const int s = idx[j]; const bf16_t* kp = KA + HM(b, h, s, 0); float dot = 0.f;
                for (int d = 0; d < 128; ++d) dot += qs[h][d] * bf2f(kp[d]);
                sv[i] = dot * QK_SCALE - slope * (float)(t - s); }
            mx = fmaxf(mx, sv[i]); }
        mx = wave_max(mx);
        float sum = 0.f;
#pragma unroll
        for (int i = 0; i < 4; ++i) { const int j = lane + 64 * i; const float pv = (j < n) ? __expf(sv[i] - mx) : 0.f; sum += pv; p[w][j] = pv; }
        sum = wave_sum(sum);
        __syncthreads();
        float o0 = 0.f, o1 = 0.f;
        for (int j = 0; j < n; ++j) { const float pj = p[w][j]; const int s = idx[j]; const unsigned vv = *(const unsigned*)(VA + HM(b, h, s, 2 * lane));
            o0 += pj * __uint_as_float(vv << 16); o1 += pj * __uint_as_float(vv & 0xffff0000u); }
        const float inv = 1.f / sum;
        const unsigned zz = *(const unsigned*)(SZA + HM(b, h, t, 2 * lane));
        o0 = o0 * inv * __uint_as_float(zz << 16); o1 = o1 * inv * __uint_as_float(zz & 0xffff0000u);
        *(unsigned*)(Y + m * 2048 + h * 128 + 2 * lane) = (unsigned)f2bf(o0) | ((unsigned)f2bf(o1) << 16);
        __syncthreads();
    }
}
__global__ void k_moba_naive(const bf16_t* __restrict__ QB, const bf16_t* __restrict__ KB, const bf16_t* __restrict__ VB, const bf16_t* __restrict__ SZB,
                             const float* __restrict__ KMEAN, bf16_t* __restrict__ Y) {
    const int t = blockIdx.x, b = blockIdx.y, tid = threadIdx.x, lane = tid & 63, w = tid >> 6; const size_t m = (size_t)b * SEQ + t;
    __shared__ float qs[8][128]; __shared__ float sc[4][SEQ];
    for (int i = tid; i < 1024; i += 256) qs[i >> 7][i & 127] = bf2f(QB[HM(b, i >> 7, t, i & 127)]);
    __syncthreads();
    const int qblk = t >> 8;
    for (int hh = 0; hh < 2; ++hh) {
        const int h = w + 4 * hh; const float slope = exp2f(-(float)(h + 1));
        float g = -INFINITY;
        if (lane < qblk) { const float* km = KMEAN + ((size_t)(b * NBLK + lane) * NH + h) * HD; float dot = 0.f; for (int d = 0; d < 128; ++d) dot += qs[h][d] * km[d]; g = dot; }
        int rank = 0;
        for (int n2 = 0; n2 < NBLK; ++n2) { const float g2 = __shfl(g, n2); if (n2 < qblk && (g2 > g || (g2 == g && n2 < lane))) ++rank; }
        const bool sel = (lane < qblk) && (rank < 3);
        const unsigned selmask = (unsigned)(__ballot(sel) & 0xffull);
        float mx = -INFINITY;
        for (int s = lane; s <= t; s += 64) { const int blk = s >> 8; float v = -INFINITY;
            if (blk == qblk || ((selmask >> blk) & 1u)) { const bf16_t* kp = KB + HM(b, h, s, 0); float dot = 0.f;
                for (int d = 0; d < 128; ++d) dot += qs[h][d] * bf2f(kp[d]);
                v = dot * QK_SCALE - slope * (float)(t - s); }
            sc[w][s] = v; mx = fmaxf(mx, v); }
        mx = wave_max(mx);
        float sum = 0.f;
        for (int s = lane; s <= t; s += 64) { const float v = sc[w][s]; const float pv = (v == -INFINITY) ? 0.f : __expf(v - mx); sc[w][s] = pv; sum += pv; }
        sum = wave_sum(sum);
        __syncthreads();
        float o0 = 0.f, o1 = 0.f;
        for (int s = 0; s <= t; ++s) { const float pj = sc[w][s]; if (pj == 0.f) continue; const unsigned vv = *(const unsigned*)(VB + HM(b, h, s, 2 * lane));
            o0 += pj * __uint_as_float(vv << 16); o1 += pj * __uint_as_float(vv & 0xffff0000u); }
        const float inv = 1.f / sum;
        const unsigned zz = *(const unsigned*)(SZB + HM(b, h, t, 2 * lane));
        o0 = o0 * inv * __uint_as_float(zz << 16); o1 = o1 * inv * __uint_as_float(zz & 0xffff0000u);
        *(unsigned*)(Y + m * 2048 + 1024 + h * 128 + 2 * lane) = (unsigned)f2bf(o0) | ((unsigned)f2bf(o1) << 16);
        __syncthreads();
    }
}

namespace pg8 {
#define PG8_LAS __attribute__((address_space(3)))
typedef unsigned short bf16_t;
typedef short bf16x8 __attribute__((ext_vector_type(8)));
typedef float f32x4 __attribute__((ext_vector_type(4)));
typedef unsigned u32x4 __attribute__((ext_vector_type(4)));
constexpr int BM = 256, BK = 64, HALF = 128, HTB = HALF * BK * 2  , STAGE_BYTES = 8 * HTB, NXCD = 8, WGM = 8;

__host__ __device__ __forceinline__ int lds_byte(int r, int c) { const int st = (r >> 4) * 2 + (c >> 5), rr = r & 15, cc = c & 31, ob = rr * 64 + cc * 2; return st * 1024 + (ob ^ (((ob >> 9) & 1) << 5)); }
__host__ __device__ __forceinline__ void stage_rc(int b, int& R, int& C) { const int st = b / 1024, sb = b % 1024, swz = sb ^ (((sb >> 9) & 1) << 5); R = (st >> 1) * 16 + swz / 64; C = (st & 1) * 32 + (swz % 64) / 2; }
__host__ __device__ __forceinline__ int perm32(int rho) { const int n = rho >> 4, i = rho & 15; return 8 * (i >> 2) + 4 * n + (i & 3); }

struct Unit { int pm, pn; };
struct Gemm { const bf16_t* A; const bf16_t* Bt; int M, N, K; };

struct StaticOrder {
    int nM, nN, nwg, G, c;
    __host__ __device__ void init(int M, int N, int G_, int c_) { nM = M / BM; nN = N / BM; nwg = nM * nN; G = G_; c = c_; }
    __host__ __device__ bool next(int i, Unit& u) const {
        const long L = (long)i * G + c; if (L >= nwg) return false;
        int wgid = (int)L; { const int q = nwg / NXCD, r = nwg % NXCD, xcd = wgid % NXCD, off = wgid / NXCD; wgid = (xcd < r ? xcd * (q + 1) : r * (q + 1) + (xcd - r) * q) + off; }
        const int nig = WGM * nN, gid = wgid / nig, fm = gid * WGM, gsz = (nM - fm) < WGM ? (nM - fm) : WGM;
        u.pm = fm + ((wgid % nig) % gsz); u.pn = (wgid % nig) / gsz; return true;
    }
    __device__ __forceinline__ void a_ready(const Unit&) const {}
    __device__ __forceinline__ void done(const Unit&) const {}
};

template <class Epi, class Sched, bool ALIGN_EPI = false, bool SP2 = false>
__device__ __forceinline__ void gemm_phase(PG8_LAS unsigned char* lds, const Gemm g, const Sched& S, const Epi& E) {
    const int tid = threadIdx.x, wid = __builtin_amdgcn_readfirstlane(tid >> 6), lane = tid & 63, wr = wid >> 2, wc = wid & 3, fr = lane & 15, fq = lane >> 4;
    const int K = g.K, nt = K / BK;
    unsigned voffA[2], voffB[2];
#pragma unroll
    for (int i = 0; i < 2; ++i) { int R, C; stage_rc(tid * 16 + i * 8192, R, C); const int Rb = Epi::PERM ? ((R & ~31) + perm32(R & 31)) : R;
        voffA[i] = (unsigned)(R * K + C) * 2u; voffB[i] = (unsigned)(Rb * K + C) * 2u; }
    const size_t kstep = (size_t)(BK * 2);
    const size_t hstep = (size_t)HALF * K * 2;
    const size_t tstep = 2 * hstep;
    const unsigned ldsw = (unsigned)wid * 1024u;
    const int aoff = lds_byte(wr * 64 + fr, fq * 8), boff = lds_byte(wc * 32 + fr, fq * 8);
#define PG8_SA(b, h) (((b) * 2 + (h)) * HTB)
#define PG8_SB(b, h) ((4 + (b) * 2 + (h)) * HTB)
#define PG8_STAGE(bufoff, gbase, voff) do { _Pragma("unroll") for (int _i = 0; _i < 2; ++_i) \
        __builtin_amdgcn_global_load_lds((const unsigned*)((const char*)(gbase) + (voff)[_i]), (PG8_LAS unsigned*)(lds + (bufoff) + ldsw + _i * 8192), 16, 0, 0); } while (0)
#define PG8_LDA(dst, b, h) do { _Pragma("unroll") for (int m = 0; m < 4; ++m) _Pragma("unroll") for (int k = 0; k < 2; ++k) dst[m][k] = *(const PG8_LAS bf16x8*)(lds + PG8_SA(b, h) + aoff + m * 2048 + k * 1024); } while (0)
#define PG8_LDB(dst, b, h) do { _Pragma("unroll") for (int n = 0; n < 2; ++n) _Pragma("unroll") for (int k = 0; k < 2; ++k) dst[n][k] = *(const PG8_LAS bf16x8*)(lds + PG8_SB(b, h) + boff + n * 2048 + k * 1024); } while (0)
#define PG8_MMA(ai, bj, At, Bt) do { __builtin_amdgcn_s_setprio(1); _Pragma("unroll") for (int m = 0; m < 4; ++m) _Pragma("unroll") for (int n = 0; n < 2; ++n) _Pragma("unroll") for (int k = 0; k < 2; ++k) \
        acc[ai][bj][m][n] = __builtin_amdgcn_mfma_f32_16x16x32_bf16(Bt[n][k], At[m][k], acc[ai][bj][m][n], 0, 0, 0); __builtin_amdgcn_s_setprio(0); } while (0)
#define PG8_WAIT_V(n) asm volatile("s_waitcnt vmcnt(" #n ")" ::: "memory")
#define PG8_WAIT_L(n) asm volatile("s_waitcnt lgkmcnt(" #n ")" ::: "memory")
#define PG8_BAR __builtin_amdgcn_s_barrier()
#define PG8_SCHED __builtin_amdgcn_sched_barrier(0)
    Unit cur, nxt; int ui = 0;
    if (!S.next(0, cur)) return;
    f32x4 acc[2][2][4][2];
#pragma unroll
    for (int a = 0; a < 2; ++a)
#pragma unroll
        for (int b = 0; b < 2; ++b)
#pragma unroll
            for (int m = 0; m < 4; ++m)
#pragma unroll
                for (int n = 0; n < 2; ++n) acc[a][b][m][n] = (f32x4){0.f, 0.f, 0.f, 0.f};
    bf16x8 At[4][2], B0[2][2], B1[2][2];
    const char* cA = (const char*)g.A + (size_t)cur.pm * tstep; const char* cB = (const char*)g.Bt + (size_t)cur.pn * tstep;
    S.a_ready(cur);
    if constexpr (SP2) {
        PG8_STAGE(PG8_SB(0, 0), cB, voffB); PG8_STAGE(PG8_SB(0, 1), cB + hstep, voffB); PG8_STAGE(PG8_SA(0, 0), cA, voffA); PG8_STAGE(PG8_SA(0, 1), cA + hstep, voffA);
        if (wr == 1) PG8_BAR;
        PG8_WAIT_V(2); PG8_BAR;
        PG8_STAGE(PG8_SB(1, 0), cB + kstep, voffB); PG8_STAGE(PG8_SA(1, 0), cA + kstep, voffA); PG8_STAGE(PG8_SB(1, 1), cB + hstep + kstep, voffB);
        PG8_WAIT_V(6); PG8_BAR;
    } else {
        PG8_STAGE(PG8_SB(0, 0), cB, voffB); PG8_STAGE(PG8_SA(0, 0), cA, voffA); PG8_STAGE(PG8_SB(0, 1), cB + hstep, voffB); PG8_STAGE(PG8_SA(0, 1), cA + hstep, voffA);
        if (wr == 1) PG8_BAR;
        PG8_WAIT_V(4); PG8_BAR;
        PG8_STAGE(PG8_SB(1, 0), cB + kstep, voffB); PG8_STAGE(PG8_SA(1, 0), cA + kstep, voffA); PG8_STAGE(PG8_SB(1, 1), cB + hstep + kstep, voffB);
        PG8_WAIT_V(6); PG8_BAR;
    }
    for (;;) {
        const bool has_next = S.next(ui + 1, nxt);
        const char* nA = has_next ? (const char*)g.A + (size_t)nxt.pm * tstep : cA; const char* nB = has_next ? (const char*)g.Bt + (size_t)nxt.pn * tstep : cB;
        for (int t = 0; t < nt; t += 2) {
            const bool last = (t == nt - 2);
            const char* a1 = cA + (size_t)(t + 1) * kstep;
            const char* a2 = last ? nA : cA + (size_t)(t + 2) * kstep; const char* b2 = last ? nB : cB + (size_t)(t + 2) * kstep;
            const char* a3 = a2 + kstep; const char* b3 = b2 + kstep;
            if (last && has_next) S.a_ready(nxt);
            if constexpr (SP2) {
            PG8_LDB(B0, 0, 0); PG8_LDB(B1, 0, 1); PG8_SCHED; PG8_LDA(At, 0, 0); PG8_STAGE(PG8_SA(1, 1), a1 + hstep, voffA);
            PG8_WAIT_V(8); PG8_WAIT_L(0); PG8_BAR; PG8_MMA(0, 0, At, B0); PG8_MMA(0, 1, At, B1); PG8_BAR; PG8_SCHED;
            PG8_LDA(At, 0, 1); PG8_STAGE(PG8_SB(0, 0), b2, voffB); PG8_STAGE(PG8_SB(0, 1), b2 + hstep, voffB); PG8_STAGE(PG8_SA(0, 0), a2, voffA);
            PG8_WAIT_V(8); PG8_WAIT_L(0); PG8_BAR; PG8_MMA(1, 0, At, B0); PG8_MMA(1, 1, At, B1); PG8_BAR; PG8_SCHED;
            PG8_LDB(B0, 1, 0); PG8_LDB(B1, 1, 1); PG8_SCHED; PG8_LDA(At, 1, 0); PG8_STAGE(PG8_SA(0, 1), a2 + hstep, voffA);
            PG8_WAIT_V(8); PG8_WAIT_L(0); PG8_BAR; PG8_MMA(0, 0, At, B0); PG8_MMA(0, 1, At, B1); PG8_BAR; PG8_SCHED;
            PG8_LDA(At, 1, 1); PG8_STAGE(PG8_SB(1, 0), b3, voffB); PG8_STAGE(PG8_SB(1, 1), b3 + hstep, voffB); PG8_STAGE(PG8_SA(1, 0), a3, voffA);
            PG8_WAIT_V(8); PG8_WAIT_L(0); PG8_BAR; PG8_MMA(1, 0, At, B0); PG8_MMA(1, 1, At, B1); PG8_BAR; PG8_SCHED;
            } else {
            PG8_LDB(B0, 0, 0); PG8_SCHED; PG8_LDA(At, 0, 0); PG8_STAGE(PG8_SA(1, 1), a1 + hstep, voffA);
            PG8_WAIT_L(8); PG8_BAR; PG8_WAIT_L(0); PG8_MMA(0, 0, At, B0); PG8_BAR; PG8_SCHED;
            PG8_LDB(B1, 0, 1); PG8_STAGE(PG8_SB(0, 0), b2, voffB);
            PG8_BAR; PG8_WAIT_L(0); PG8_MMA(0, 1, At, B1); PG8_BAR;
            PG8_LDA(At, 0, 1); PG8_STAGE(PG8_SA(0, 0), a2, voffA);
            PG8_BAR; PG8_WAIT_L(0); PG8_MMA(1, 0, At, B0); PG8_BAR; PG8_SCHED;
            PG8_STAGE(PG8_SB(0, 1), b2 + hstep, voffB);
            PG8_WAIT_V(6); PG8_BAR; PG8_MMA(1, 1, At, B1); PG8_BAR;
            PG8_LDB(B0, 1, 0); PG8_SCHED; PG8_LDA(At, 1, 0); PG8_STAGE(PG8_SA(0, 1), a2 + hstep, voffA);
            PG8_WAIT_L(8); PG8_BAR; PG8_WAIT_L(0); PG8_MMA(0, 0, At, B0); PG8_BAR; PG8_SCHED;
            PG8_LDB(B1, 1, 1); PG8_STAGE(PG8_SB(1, 0), b3, voffB);
            PG8_BAR; PG8_WAIT_L(0); PG8_MMA(0, 1, At, B1); PG8_BAR;
            PG8_LDA(At, 1, 1); PG8_STAGE(PG8_SA(1, 0), a3, voffA);
            PG8_BAR; PG8_WAIT_L(0); PG8_MMA(1, 0, At, B0); PG8_BAR; PG8_SCHED;
            PG8_STAGE(PG8_SB(1, 1), b3 + hstep, voffB);
            PG8_WAIT_V(6); PG8_BAR; PG8_MMA(1, 1, At, B1); PG8_BAR;
            }
        }
        if constexpr (ALIGN_EPI) { if (wr == 0) PG8_BAR; }
        if constexpr (!Epi::AFTER_DRAIN) { E(acc, cur, wr, wc, fr, fq); S.done(cur); }
        if (!has_next) break;
#pragma unroll
        for (int a = 0; a < 2; ++a)
#pragma unroll
            for (int b = 0; b < 2; ++b)
#pragma unroll
                for (int m = 0; m < 4; ++m)
#pragma unroll
                    for (int n = 0; n < 2; ++n) acc[a][b][m][n] = (f32x4){0.f, 0.f, 0.f, 0.f};
        cur = nxt; cA = nA; cB = nB; ++ui;
        if constexpr (ALIGN_EPI) { if (wr == 1) PG8_BAR; }
    }
    PG8_WAIT_V(0);
    if constexpr (!ALIGN_EPI) { if (wr == 0) PG8_BAR; }
    PG8_BAR;
    if constexpr (Epi::AFTER_DRAIN) { E.fused(acc, cur, wr, wc, fr, fq, lds, wid, lane); S.done(cur); }
#undef PG8_SA
#undef PG8_SB
#undef PG8_STAGE
#undef PG8_LDA
#undef PG8_LDB
#undef PG8_MMA
#undef PG8_WAIT_V
#undef PG8_WAIT_L
#undef PG8_BAR
#undef PG8_SCHED
}
}

#define GAS __attribute__((address_space(1)))
#define LAS __attribute__((address_space(3)))
typedef unsigned v4u __attribute__((ext_vector_type(4)));
typedef float f32x4 __attribute__((ext_vector_type(4)));
typedef GAS unsigned gu32;
#define RLX_AGENT __ATOMIC_RELAXED, __HIP_MEMORY_SCOPE_AGENT
#define LDS_WAIT() asm volatile("s_waitcnt lgkmcnt(0)" ::: "memory")
#define VM_WAIT() asm volatile("s_waitcnt vmcnt(0)" ::: "memory")
constexpr int NWAVES = 8;
constexpr int NPAD = 9472;
constexpr size_t MiB = 1u << 20;
constexpr size_t WS_CTL = 0, CTL_ZERO_BYTES = 1 * MiB;
constexpr size_t WS_MOD = 1 * MiB;
constexpr size_t WS_GAIN = 1 * MiB + 256 * 1024;
constexpr size_t WS_KMEAN = 1 * MiB + 512 * 1024;
constexpr size_t WS_WI = 2 * MiB;
constexpr size_t WS_KI = 3 * MiB;
constexpr size_t WS_MASK = 5 * MiB;
constexpr size_t WS_WOUT = 10 * MiB;
constexpr size_t WS_WIN = 18 * MiB;
constexpr size_t WS_HB = 56 * MiB;
constexpr size_t WS_Y = 56 * MiB;
constexpr size_t WS_QA = 120 * MiB, WS_KA = 152 * MiB, WS_VA = 184 * MiB, WS_SZA = 216 * MiB;
constexpr size_t WS_QB = 248 * MiB, WS_KB = 280 * MiB, WS_VB = 312 * MiB, WS_SZB = 344 * MiB;
constexpr size_t WS_QI = 376 * MiB;
constexpr size_t WS_T32 = 408 * MiB;
constexpr size_t WS_END = 472 * MiB;
constexpr int CW_BAR = 4096;
constexpr int RING_BYTES = 131072;
constexpr int EPI_OFF = RING_BYTES;
constexpr int LDSCTL_OFF = EPI_OFF + 16384, MISC_OFF = LDSCTL_OFF + 320;
constexpr int LDS_BYTES = 163840;

#define XB_TMO      128
#define XB_XCNT(j)  (256  + 64 * (j))
#define XB_XSUB(j)  (1280 + 64 * (j))
#define XB_XGEN(j)  (2304 + 64 * (j))
#define XB_TOP      3328
#define XB_TOPGEN   3392
#define XCD_BAR_WORDS 3456
#define XB_SPIN_CAP (1u << 18)

__device__ __forceinline__ unsigned xb_ld(unsigned* p)              { return __hip_atomic_load(p, __ATOMIC_RELAXED, __HIP_MEMORY_SCOPE_AGENT); }
__device__ __forceinline__ unsigned xb_add(unsigned* p, unsigned v) { return __hip_atomic_fetch_add(p, v, __ATOMIC_RELAXED, __HIP_MEMORY_SCOPE_AGENT); }
__device__ __forceinline__ unsigned xb_xcc_id() { return (unsigned)__builtin_amdgcn_s_getreg((3 << 11) | 20) & 0xFu; }
#define XB_SPIN(cond, bar) do { unsigned _sp = 0; while (cond) { __builtin_amdgcn_s_sleep(1); \
    if ((++_sp & 255u) == 0u) { if (xb_ld(&(bar)[XB_TMO])) break; if (_sp > XB_SPIN_CAP) { atomicAdd(&(bar)[XB_TMO], 1u); break; } } } } while (0)

struct XcdBarrier {
    unsigned* bar; unsigned x;
    volatile LAS unsigned* st;
};

__device__ __forceinline__ XcdBarrier xcd_barrier_post(unsigned* bar, volatile LAS unsigned* st) {
    XcdBarrier b; b.bar = bar; b.x = xb_xcc_id(); b.st = st;
    if (threadIdx.x == 0) (void)xb_add(&bar[XB_XCNT(b.x)], 1u);
    return b;
}
__device__ __forceinline__ void xcd_barrier_complete(unsigned* bar, unsigned x, unsigned& nloc, unsigned& nx) {
    const unsigned G = gridDim.x * gridDim.y * gridDim.z;
    unsigned sum, cnt, mine, sp = 0u;
    for (;;) {
        sum = 0u; cnt = 0u; mine = 0u;
#pragma unroll
        for (unsigned j = 0; j < 16; ++j) { const unsigned c = xb_ld(&bar[XB_XCNT(j)]); sum += c; cnt += (c > 0u) ? 1u : 0u; mine = (j == x) ? c : mine; }
        if (sum == G) break;
        __builtin_amdgcn_s_sleep(1);
        if ((++sp & 255u) == 0u) { if (xb_ld(&bar[XB_TMO])) break; if (sp > XB_SPIN_CAP) { atomicAdd(&bar[XB_TMO], 1u); break; } }
    }
    nloc = mine > 0u ? mine : 1u; nx = cnt > 0u ? cnt : 1u;
}

__device__ __forceinline__ void xcd_barrier(const XcdBarrier& b) {
    asm volatile("s_waitcnt vmcnt(0)" ::: "memory");
    __syncthreads();
    if (threadIdx.x == 0) {
        unsigned* bar = b.bar;
        __builtin_amdgcn_s_waitcnt(0);
        unsigned nloc = b.st[0], nx = b.st[1];
        if (nloc == 0u) { xcd_barrier_complete(bar, b.x, nloc, nx); b.st[0] = nloc; b.st[1] = nx; }
        const unsigned old = xb_add(&bar[XB_XSUB(b.x)], 1u);
        const unsigned gen = old / nloc;
        if (old + 1u == (gen + 1u) * nloc) {
            __builtin_amdgcn_fence(__ATOMIC_RELEASE, "agent");
            asm volatile("s_waitcnt vmcnt(0)" ::: "memory");
            const unsigned og = xb_add(&bar[XB_TOP], 1u);
            const unsigned tg = og / nx;
            if (og + 1u == (tg + 1u) * nx) xb_add(&bar[XB_TOPGEN], 1u);
            else XB_SPIN(xb_ld(&bar[XB_TOPGEN]) == tg, bar);
            __builtin_amdgcn_fence(__ATOMIC_ACQUIRE, "agent");
            xb_add(&bar[XB_XGEN(b.x)], 1u);
            asm volatile("s_waitcnt vmcnt(0)" ::: "memory");
        } else {
            XB_SPIN(xb_ld(&bar[XB_XGEN(b.x)]) == gen, bar);
            __builtin_amdgcn_fence(__ATOMIC_ACQUIRE, "agent");
            asm volatile("s_waitcnt vmcnt(0)" ::: "memory");
        }
    }
    __syncthreads();
}


struct Frame {
    LAS unsigned char* lds; volatile LAS unsigned* MISC; gu32* ctl; int tid, lane, wave, vcu, G;
};
__device__ __forceinline__ unsigned cvt_pk_bf16(float lo, float hi) { unsigned r; asm volatile("v_cvt_pk_bf16_f32 %0, %1, %2" : "=v"(r) : "v"(lo), "v"(hi)); return r; }
__device__ __forceinline__ unsigned f2bf_u(float f) { unsigned u = __builtin_bit_cast(unsigned, f); return (u + 0x7fffu + ((u >> 16) & 1u)) >> 16; }
__device__ __forceinline__ unsigned pk2(float lo, float hi) { return f2bf_u(lo) | (f2bf_u(hi) << 16); }
__device__ __forceinline__ float fast_silu(float v) { return v * __builtin_amdgcn_rcpf(1.f + __expf(-v)); }

__device__ __forceinline__ void p0_mod(Frame& F, int id, const float* __restrict__ c, const float* __restrict__ w_ada, const float* __restrict__ b_ada, float* __restrict__ MOD) {
    LAS float* sc = (LAS float*)(F.lds);
    LAS float* red = (LAS float*)(F.lds + 65536);
    for (int i = F.tid; i < BATCH * DM; i += NWAVES * 64) sc[i] = silu_f(c[i]);
    __syncthreads();
    const int cq = F.tid & 7, kq = F.tid >> 3, col0 = 32 * id + 4 * cq;
    f32x4 acc[8];
#pragma unroll
    for (int b = 0; b < 8; ++b) acc[b] = (f32x4){0.f, 0.f, 0.f, 0.f};
#pragma unroll 4
    for (int i = 0; i < 32; ++i) { const int k = kq + 64 * i; const f32x4 w = *(const f32x4*)(w_ada + (size_t)k * (3 * DM) + col0);
#pragma unroll
        for (int b = 0; b < 8; ++b) acc[b] += w * sc[b * DM + k]; }
#pragma unroll
    for (int b = 0; b < 8; ++b) *(LAS f32x4*)(red + (kq * 8 + b) * 32 + 4 * cq) = acc[b];
    __syncthreads();
    if (F.tid < 256) { const int b = F.tid >> 5, cc = F.tid & 31; float s = 0.f;
        for (int q = 0; q < 64; ++q) s += red[(q * 8 + b) * 32 + cc];
        MOD[b * 3 * DM + 32 * id + cc] = s + b_ada[32 * id + cc]; }
    __syncthreads();
}
template <bool MAPWIN>
__device__ __forceinline__ void p0_transpose_item(const float* __restrict__ W, int K, int N, int NP, bf16_t* __restrict__ WT, LAS float* scr, int item, int lane) {
    const int nblk = NP / 32, kb = item / nblk, nb = item % nblk, k0 = 64 * kb, n0 = 32 * nb;
    const int np = n0 + (lane & 31);
    int src = np; bool valid = true;
    if (MAPWIN) { if (np >= 5376) src = np - 176; else if (np >= 5200) valid = false; }
#pragma unroll 8
    for (int i = 0; i < 32; ++i) { const int kk = 2 * i + (lane >> 5); scr[kk * 33 + (lane & 31)] = valid ? W[(size_t)(k0 + kk) * N + src] : 0.f; }
    LDS_WAIT(); asm volatile("" ::: "memory");
    const int c = lane & 7;
#pragma unroll
    for (int j = 0; j < 4; ++j) { const int n = (lane >> 3) + 8 * j; const LAS float* s = scr + (8 * c) * 33 + n;
        v4u o; o.x = pk2(s[0 * 33], s[1 * 33]); o.y = pk2(s[2 * 33], s[3 * 33]); o.z = pk2(s[4 * 33], s[5 * 33]); o.w = pk2(s[6 * 33], s[7 * 33]);
        *(GAS v4u*)(WT + (size_t)(n0 + n) * K + k0 + 8 * c) = o; }
    LDS_WAIT(); asm volatile("" ::: "memory");
}
__device__ __forceinline__ void p0_convert(Frame& F, const float* __restrict__ w_in, const float* __restrict__ w_out, bf16_t* __restrict__ WinT, bf16_t* __restrict__ WoutT) {
    LAS float* scr = (LAS float*)(F.lds + F.wave * 16384);
    const int gw = F.vcu * NWAVES + F.wave, NGW = F.G * NWAVES;
    constexpr int I_IN = (DM / 64) * (NPAD / 32), I_OUT = (DM / 64) * (DM / 32);
    for (int it = gw; it < I_IN + I_OUT; it += NGW) {
        if (it < I_IN) p0_transpose_item<true>(w_in, DM, DIN, NPAD, WinT, scr, it, F.lane);
        else p0_transpose_item<false>(w_out, DM, DM, DM, WoutT, scr, it - I_IN, F.lane);
    }
}
__device__ __forceinline__ void p1_norm(Frame& F, const float* __restrict__ x, const float* __restrict__ g, const float* __restrict__ MOD, bf16_t* __restrict__ HB) {
    for (int v = F.vcu; v < M / 64; v += F.G) {
        const int b = v / (SEQ / 64);
        const float* shift = MOD + b * 3 * DM; const float* scale = shift + DM;
        f32x4 gs[8], sh[8];
#pragma unroll
        for (int j = 0; j < 8; ++j) { const int k = 4 * F.lane + 256 * j; const f32x4 gg = *(const f32x4*)(g + k), ss = *(const f32x4*)(scale + k); gs[j] = gg * (ss + 1.0f); sh[j] = *(const f32x4*)(shift + k); }
        for (int r = 0; r < 8; ++r) {
            const int row = 64 * v + 8 * F.wave + r;
            const f32x4* xr = (const f32x4*)(x + (size_t)row * DM) + F.lane;
            f32x4 xv[8]; float ss = 0.f;
#pragma unroll
            for (int j = 0; j < 8; ++j) { xv[j] = xr[64 * j]; ss += (xv[j].x * xv[j].x + xv[j].y * xv[j].y) + (xv[j].z * xv[j].z + xv[j].w * xv[j].w); }
            ss = wave_sum(ss);
            const float rstd = rsqrtf(ss * (1.f / DM) + RMS_EPS);
            unsigned long long* o8 = (unsigned long long*)(HB + (size_t)row * DM) + F.lane;
#pragma unroll
            for (int j = 0; j < 8; ++j) { const f32x4 h = xv[j] * rstd * gs[j] + sh[j];
                o8[64 * j] = (unsigned long long)pk2(h.x, h.y) | ((unsigned long long)pk2(h.z, h.w) << 32); }
        }
    }
}
struct EpiProj {
    static constexpr bool PERM = true, AFTER_DRAIN = false;
    unsigned char* ws;
    LAS float* P;
    __device__ __forceinline__ void operator()(const pg8::f32x4 (&acc)[2][2][4][2], const pg8::Unit& u, int wr, int wc, int fr, int fq) const {
        asm volatile("" : "+v"(fr), "+v"(fq));
        const int pn = u.pn;
        bf16_t* const KI = (bf16_t*)(ws + WS_KI); float* const WI = (float*)(ws + WS_WI); bf16_t* const QI = (bf16_t*)(ws + WS_QI);
        int grp, sub;
        if (pn < 20) { grp = pn >> 2; sub = pn & 3; } else if (pn == 20) { grp = 5; sub = 0; } else { grp = 6 + ((pn - 21) >> 2); sub = (pn - 21) & 3; }
        const int b = u.pm >> 3, t0 = (u.pm & 7) * 256 + wr * 64 + fr;
        const int cl = 32 * wc + 8 * fq;
        const bool norm = (grp == 0 || grp == 1 || grp == 6 || grp == 7 || grp == 5);
        float rs[2][4][2];
        if (norm) {
#pragma unroll
            for (int ai = 0; ai < 2; ++ai)
#pragma unroll
                for (int m = 0; m < 4; ++m)
#pragma unroll
                    for (int bj = 0; bj < 2; ++bj) { const pg8::f32x4 a = acc[ai][bj][m][0], c = acc[ai][bj][m][1];
                        float s = (a[0] * a[0] + a[1] * a[1]) + (a[2] * a[2] + a[3] * a[3]) + (c[0] * c[0] + c[1] * c[1]) + (c[2] * c[2] + c[3] * c[3]);
                        s += __shfl_xor(s, 16); s += __shfl_xor(s, 32);
                        if (fq == 0) P[((ai * 128 + wr * 64 + m * 16 + fr) * 2 + bj) * 4 + wc] = s; }
            asm volatile("s_waitcnt lgkmcnt(0)" ::: "memory"); __builtin_amdgcn_s_barrier(); asm volatile("" ::: "memory");
#pragma unroll
            for (int ai = 0; ai < 2; ++ai)
#pragma unroll
                for (int m = 0; m < 4; ++m)
#pragma unroll
                    for (int bj = 0; bj < 2; ++bj) { const pg8::f32x4 q = *(const LAS pg8::f32x4*)(P + ((ai * 128 + wr * 64 + m * 16 + fr) * 2 + bj) * 4);
                        rs[ai][m][bj] = (grp == 5) ? rsqrtf((q[0] + q[1]) * (1.f / 64.f) + RMS_EPS) : rsqrtf(((q[0] + q[1]) + (q[2] + q[3])) * (1.f / 128.f) + RMS_EPS); }
        }
        if (grp == 5) {
            if (wc < 2) { const float* gki = (const float*)(ws + WS_GAIN) + 4 * 128; const pg8::f32x4 g0 = *(const pg8::f32x4*)(gki + cl), g1 = *(const pg8::f32x4*)(gki + cl + 4);
#pragma unroll
                for (int ai = 0; ai < 2; ++ai)
#pragma unroll
                    for (int m = 0; m < 4; ++m) { const size_t row = (size_t)b * SEQ + t0 + 128 * ai + 16 * m; const float r = rs[ai][m][0];
                        const pg8::f32x4 v0 = acc[ai][0][m][0] * r * g0, v1 = acc[ai][0][m][1] * r * g1;
                        pg8::u32x4 w; w.x = cvt_pk_bf16(v0[0], v0[1]); w.y = cvt_pk_bf16(v0[2], v0[3]); w.z = cvt_pk_bf16(v1[0], v1[1]); w.w = cvt_pk_bf16(v1[2], v1[3]);
                        *(pg8::u32x4*)(KI + row * 64 + cl) = w; } }
            else if (wc == 2 && fq < 2) {
#pragma unroll
                for (int ai = 0; ai < 2; ++ai)
#pragma unroll
                    for (int m = 0; m < 4; ++m) { const size_t row = (size_t)b * SEQ + t0 + 128 * ai + 16 * m;
                        *(pg8::f32x4*)(WI + row * 16 + 8 * fq) = acc[ai][0][m][0]; *(pg8::f32x4*)(WI + row * 16 + 8 * fq + 4) = acc[ai][0][m][1]; } }
            return;
        }
        if (grp == 4) {
#pragma unroll
            for (int ai = 0; ai < 2; ++ai)
#pragma unroll
                for (int m = 0; m < 4; ++m) { const size_t row = (size_t)b * SEQ + t0 + 128 * ai + 16 * m;
#pragma unroll
                    for (int bj = 0; bj < 2; ++bj) { const pg8::f32x4 v0 = acc[ai][bj][m][0], v1 = acc[ai][bj][m][1];
                        pg8::u32x4 w; w.x = cvt_pk_bf16(v0[0], v0[1]); w.y = cvt_pk_bf16(v0[2], v0[3]); w.z = cvt_pk_bf16(v1[0], v1[1]); w.w = cvt_pk_bf16(v1[2], v1[3]);
                        *(pg8::u32x4*)(QI + row * 1024 + sub * 256 + bj * 128 + cl) = w; } }
            return;
        }
        bf16_t* dst; const float* gain = nullptr;
        { const int slot = grp < 4 ? grp : grp - 2;
          dst = (bf16_t*)(ws + WS_QA + (size_t)slot * (32 * MiB));
          gain = (const float*)(ws + WS_GAIN) + (grp < 2 ? grp : grp - 4) * 128; }
        pg8::f32x4 g0 = {1.f, 1.f, 1.f, 1.f}, g1 = {1.f, 1.f, 1.f, 1.f};
        if (norm) { g0 = *(const pg8::f32x4*)(gain + cl); g1 = *(const pg8::f32x4*)(gain + cl + 4); }
        const bool act = (grp == 3 || grp == 9);
#pragma unroll
        for (int ai = 0; ai < 2; ++ai)
#pragma unroll
            for (int m = 0; m < 4; ++m) { const int t = t0 + 128 * ai + 16 * m;
#pragma unroll
                for (int bj = 0; bj < 2; ++bj) { const int h = 2 * sub + bj;
                    pg8::f32x4 v0 = acc[ai][bj][m][0], v1 = acc[ai][bj][m][1];
                    if (norm) { const float r = rs[ai][m][bj]; v0 = v0 * r * g0; v1 = v1 * r * g1; }
                    if (act) { v0[0] = fast_silu(v0[0]); v0[1] = fast_silu(v0[1]); v0[2] = fast_silu(v0[2]); v0[3] = fast_silu(v0[3]);
                               v1[0] = fast_silu(v1[0]); v1[1] = fast_silu(v1[1]); v1[2] = fast_silu(v1[2]); v1[3] = fast_silu(v1[3]); }
                    pg8::u32x4 w; w.x = cvt_pk_bf16(v0[0], v0[1]); w.y = cvt_pk_bf16(v0[2], v0[3]); w.z = cvt_pk_bf16(v1[0], v1[1]); w.w = cvt_pk_bf16(v1[2], v1[3]);
                    *(pg8::u32x4*)(dst + HM(b, h, t, cl)) = w; } }
    }
};
struct EpiOut {
    static constexpr bool PERM = false, AFTER_DRAIN = false;
    const float* x; const float* MOD; float* out;
    __device__ __forceinline__ void operator()(const pg8::f32x4 (&acc)[2][2][4][2], const pg8::Unit& u, int wr, int wc, int fr, int fq) const {
        asm volatile("" : "+v"(fr), "+v"(fq));
        const int b = u.pm >> 3; const float* gate = MOD + b * 3 * DM + 2 * DM;
        const int col0 = u.pn * 256 + wc * 32 + 4 * fq;
        pg8::f32x4 gv[2][2];
#pragma unroll
        for (int bj = 0; bj < 2; ++bj)
#pragma unroll
            for (int n = 0; n < 2; ++n) gv[bj][n] = *(const pg8::f32x4*)(gate + col0 + bj * 128 + n * 16);
#pragma unroll
        for (int ai = 0; ai < 2; ++ai)
#pragma unroll
            for (int m = 0; m < 4; ++m) { const size_t off = (size_t)(u.pm * 256 + ai * 128 + wr * 64 + m * 16 + fr) * DM + col0;
#pragma unroll
                for (int bj = 0; bj < 2; ++bj)
#pragma unroll
                    for (int n = 0; n < 2; ++n) { const pg8::f32x4 xv = *(const pg8::f32x4*)(x + off + bj * 128 + n * 16);
                        *(pg8::f32x4*)(out + off + bj * 128 + n * 16) = xv + gv[bj][n] * acc[ai][bj][m][n]; }
                if (m & 1) asm volatile("" ::: "memory"); }
    }
};

namespace att {
typedef short bf16x8 __attribute__((ext_vector_type(8)));
typedef short s16x4 __attribute__((ext_vector_type(4)));
typedef float f32x16 __attribute__((ext_vector_type(16)));
typedef float f32x4 __attribute__((ext_vector_type(4)));
typedef unsigned u32x4 __attribute__((ext_vector_type(4)));
constexpr int NW = 8, QBLK = 32, KVBLK = 64, QB = NW * QBLK, D = 128;
constexpr int SHM_V = KVBLK * D * 2, SHM_K = KVBLK * D * 2;
constexpr int LDS_WS = 2 * SHM_V + 2 * SHM_K, LDS_KM = LDS_WS + NW * 64 * 4, LDS_OST = 73728, LDS_BYTES = LDS_OST + NW * QBLK * D * 2;
constexpr float SCALE = 0.08838834764831845f, THR = 8.f;
#define KSWZ(row, colB) ((row) * 256 + ((colB) ^ (((row) & 7) << 4)))
#define SBAR() __builtin_amdgcn_sched_barrier(0)
__device__ __forceinline__ int v_st(int k, int c) { const int kk = (k & ~0xC) | ((k & 4) << 1) | ((k & 8) >> 1); return ((kk >> 3) * 4 + (c >> 5)) * 512 + ((kk & 7) * 32 + (c & 31)) * 2; }
__device__ __forceinline__ int v_rd_base(int lane) { return ((lane & 3) << 3) | (((lane >> 2) & 3) << 6) | (((lane >> 4) & 1) << 5) | (((lane >> 5) & 1) << 8); }
constexpr int v_rd_off(int d0, int ks, int half) { return d0 * 512 + ks * 4096 + half * 2048; }
__device__ __forceinline__ int crow(int r, int hi) { return (r & 3) + 8 * (r >> 2) + 4 * hi; }
__device__ __forceinline__ unsigned cvtpk(float lo, float hi) { unsigned r; asm volatile("v_cvt_pk_bf16_f32 %0, %1, %2" : "=v"(r) : "v"(lo), "v"(hi)); return r; }
__device__ __forceinline__ unsigned cvt1(float v) { unsigned r; asm volatile("v_cvt_pk_bf16_f32 %0, %1, 0" : "=v"(r) : "v"(v)); return r; }
__device__ __forceinline__ bf16x8 load8(const bf16_t* p) { return *reinterpret_cast<const bf16x8*>(p); }
__device__ __forceinline__ void mask_causal(f32x16& p0, f32x16& p1, int dq) {
    const float NEG = -__builtin_inff();
#pragma unroll
    for (int r = 0; r < 16; ++r) { const int c = (r & 3) + 8 * (r >> 2); if (dq - c < 0) p0[r] = NEG; if (dq - c - 32 < 0) p1[r] = NEG; }
}
__device__ __forceinline__ void mask_bits(f32x16& p0, f32x16& p1, unsigned w0, unsigned w1) {
    const unsigned NEGB = 0xff800000u;
#pragma unroll
    for (int r = 0; r < 16; ++r) { const int c = (r & 3) + 8 * (r >> 2);
        const unsigned t0 = (unsigned)(((int)(w0 << (31 - c))) >> 31), t1 = (unsigned)(((int)(w1 << (31 - c))) >> 31);
        p0[r] = __uint_as_float((__float_as_uint(p0[r]) & t0) | (NEGB & ~t0));
        p1[r] = __uint_as_float((__float_as_uint(p1[r]) & t1) | (NEGB & ~t1)); }
}
__device__ __forceinline__ void partialSM(f32x16& p0, f32x16& p1, float& m_reg, float& mn, float& alpha) {
    float pmax = p0[0]; for (int r = 1; r < 16; ++r) pmax = fmaxf(pmax, p0[r]); for (int r = 0; r < 16; ++r) pmax = fmaxf(pmax, p1[r]);
    { auto rr = __builtin_amdgcn_permlane32_swap(__float_as_uint(pmax), __float_as_uint(pmax), false, false);
      pmax = fmaxf(__uint_as_float(rr[0]), __uint_as_float(rr[1])); }
    constexpr float C2 = 1.4426950408889634f * SCALE;
    if (__builtin_expect(__all((pmax - m_reg) * SCALE <= THR), 1)) { mn = m_reg; alpha = 1.f; }
    else { mn = fmaxf(m_reg, pmax); alpha = __builtin_amdgcn_exp2f((m_reg - mn) * C2); m_reg = mn; }
    const float mnL = -mn * C2;
    for (int r = 0; r < 16; ++r) p0[r] = fmaf(p0[r], C2, mnL); for (int r = 0; r < 16; ++r) p1[r] = fmaf(p1[r], C2, mnL);
    for (int r = 0; r < 16; ++r) p0[r] = __builtin_amdgcn_exp2f(p0[r]);
}
__device__ __forceinline__ void finishSM(f32x16& p0, f32x16& p1, float alpha, float& l_reg, bf16x8& pa0, bf16x8& pa1, bf16x8& pa2, bf16x8& pa3) {
    for (int r = 0; r < 16; ++r) p1[r] = __builtin_amdgcn_exp2f(p1[r]);
    float ps = 0; for (int r = 0; r < 16; ++r) ps += p0[r]; for (int r = 0; r < 16; ++r) ps += p1[r];
    { auto rr = __builtin_amdgcn_permlane32_swap(__float_as_uint(ps), __float_as_uint(ps), false, false);
      ps = __uint_as_float(rr[0]) + __uint_as_float(rr[1]); }
    l_reg = l_reg * alpha + ps;
#define PK4(P, B_, OUT) do { unsigned a0 = cvtpk(P[B_+0], P[B_+1]), a1 = cvtpk(P[B_+2], P[B_+3]);                          \
        unsigned b0 = cvtpk(P[B_+4], P[B_+5]), b1 = cvtpk(P[B_+6], P[B_+7]);                                             \
        auto r0 = __builtin_amdgcn_permlane32_swap(a0, b0, false, false); auto r1 = __builtin_amdgcn_permlane32_swap(a1, b1, false, false); \
        u32x4 w = {r0[0], r1[0], r0[1], r1[1]}; OUT = *reinterpret_cast<bf16x8*>(&w); } while (0)
    PK4(p0, 0, pa0); PK4(p0, 8, pa1); PK4(p1, 0, pa2); PK4(p1, 8, pa3);
#undef PK4
}
template <int KB>
__device__ __forceinline__ void qkt(f32x16& p0, f32x16& p1, const char* K_lds, int r32, int hi, const bf16x8* qr, float cb, float sl) {
#pragma unroll
    for (int r = 0; r < 16; ++r) { const int c = (r & 3) + 8 * (r >> 2); p0[r] = fmaf(sl, (float)c, cb); p1[r] = fmaf(sl, (float)(c + 32), cb); }
    const char* kb[4];
#pragma unroll
    for (int dd = 0; dd < 4; ++dd) kb[dd] = K_lds + KB * SHM_K + KSWZ(r32, (dd * 16 + hi * 8) * 2);
#pragma unroll
    for (int d0 = 0; d0 < 8; ++d0) { const char* a = kb[d0 & 3] + (d0 >> 2) * 128;
        bf16x8 b0 = *reinterpret_cast<const bf16x8*>(a);
        bf16x8 b1 = *reinterpret_cast<const bf16x8*>(a + 32 * 256);
        p0 = __builtin_amdgcn_mfma_f32_32x32x16_bf16(b0, qr[d0], p0, 0, 0, 0);
        p1 = __builtin_amdgcn_mfma_f32_32x32x16_bf16(b1, qr[d0], p1, 0, 0, 0); }
}
template <int VB>
__device__ __forceinline__ void pv_tile(f32x16* o, int vb0, bf16x8 pa0, bf16x8 pa1, bf16x8 pa2, bf16x8 pa3) {
#define TRRD(dst, off) asm volatile("ds_read_b64_tr_b16 %0, %1 offset:%2" : "=&v"(dst) : "v"(vb0), "i"(off) : "memory")
#define PV_D0(d0) do { s16x4 l0, l1, l2, l3, h0, h1, h2, h3; constexpr int b_ = VB * SHM_V + v_rd_off(d0, 0, 0); \
        TRRD(l0, b_); TRRD(h0, b_ + 2048); TRRD(l1, b_ + 4096); TRRD(h1, b_ + 6144); TRRD(l2, b_ + 8192); TRRD(h2, b_ + 10240); TRRD(l3, b_ + 12288); TRRD(h3, b_ + 14336); \
        asm volatile("s_waitcnt lgkmcnt(0)" ::: "memory"); SBAR();   \
        o[d0] = __builtin_amdgcn_mfma_f32_32x32x16_bf16(pa0, (bf16x8){l0[0], l0[1], l0[2], l0[3], h0[0], h0[1], h0[2], h0[3]}, o[d0], 0, 0, 0);   \
        o[d0] = __builtin_amdgcn_mfma_f32_32x32x16_bf16(pa1, (bf16x8){l1[0], l1[1], l1[2], l1[3], h1[0], h1[1], h1[2], h1[3]}, o[d0], 0, 0, 0);   \
        o[d0] = __builtin_amdgcn_mfma_f32_32x32x16_bf16(pa2, (bf16x8){l2[0], l2[1], l2[2], l2[3], h2[0], h2[1], h2[2], h2[3]}, o[d0], 0, 0, 0);   \
        o[d0] = __builtin_amdgcn_mfma_f32_32x32x16_bf16(pa3, (bf16x8){l3[0], l3[1], l3[2], l3[3], h3[0], h3[1], h3[2], h3[3]}, o[d0], 0, 0, 0); } while (0)
    PV_D0(0); PV_D0(1); PV_D0(2); PV_D0(3);
#undef PV_D0
#undef TRRD
}

struct BlockRef { int grp, b, h, qb; };
__device__ __forceinline__ size_t hm_off(const BlockRef& r) { return ((size_t)(r.b * NH + r.h) * SEQ) * D; }
__device__ __forceinline__ const bf16_t* ptrQ(unsigned char* wsb, const BlockRef& r) { return (const bf16_t*)(wsb + (r.grp ? WS_QB : WS_QA)) + hm_off(r) + (size_t)r.qb * QB * D; }
__device__ __forceinline__ const bf16_t* ptrK(unsigned char* wsb, const BlockRef& r) { return (const bf16_t*)(wsb + (r.grp ? WS_KB : WS_KA)) + hm_off(r); }
__device__ __forceinline__ const bf16_t* ptrV(unsigned char* wsb, const BlockRef& r) { return (const bf16_t*)(wsb + (r.grp ? WS_VB : WS_VA)) + hm_off(r); }
__device__ __forceinline__ const bf16_t* ptrZ(unsigned char* wsb, const BlockRef& r) { return (const bf16_t*)(wsb + (r.grp ? WS_SZB : WS_SZA)) + hm_off(r) + (size_t)r.qb * QB * D; }
struct Seam { bf16x8 qr[8]; bf16x8 st_v0, st_v1, st_k0, st_k1; };
#define ROW(p, k0, rr) ((const bf16_t*)((const char*)(p) + (unsigned)(((k0) + (rr)) * (D * 2) + sc * 2)))
#define VMW() asm volatile("s_waitcnt vmcnt(0)" ::: "memory")
#define VMWN(n) asm volatile("s_waitcnt vmcnt(%0)" :: "i"(n) : "memory")
#define SLOAD_H(Kp, Vp, k0) do { S.st_v0 = load8(ROW(Vp, k0, sr)); S.st_v1 = load8(ROW(Vp, k0, 32 + sr));              \
                         S.st_k0 = load8(ROW(Kp, k0, sr)); S.st_k1 = load8(ROW(Kp, k0, 32 + sr)); } while (0)
#define SWRITE_HK(bf) do { *(bf16x8*)(K_lds + (bf) * SHM_K + kws) = S.st_k0; *(bf16x8*)(K_lds + (bf) * SHM_K + kws + 32 * 256) = S.st_k1; } while (0)
#define SWRITE_HV(bf) do { *(bf16x8*)(V_lds + (bf) * SHM_V + vst0) = S.st_v0; *(bf16x8*)(V_lds + (bf) * SHM_V + vst1) = S.st_v1; } while (0)
#define SWRITE_H(bf) do { SWRITE_HV(bf); SWRITE_HK(bf); } while (0)
__device__ __forceinline__ void prime(const BlockRef& cur, unsigned char* wsb, char* lds, Seam& S) {
    const int tid = threadIdx.x, wid = __builtin_amdgcn_readfirstlane(tid >> 6), lane = tid & 63, r32 = lane & 31, hi = lane >> 5;
    const int sr = tid >> 4, sc = (tid & 15) * 8, kws = KSWZ(sr, sc * 2); char* K_lds = lds + 2 * SHM_V;
    const bf16_t* Qp = ptrQ(wsb, cur); const bf16_t* Kp = ptrK(wsb, cur); const bf16_t* Vp = ptrV(wsb, cur);
    for (int d0 = 0; d0 < 8; ++d0) S.qr[d0] = load8(Qp + (size_t)(wid * QBLK + r32) * D + d0 * 16 + hi * 8);
    SLOAD_H(Kp, Vp, 0); VMW(); SWRITE_HK(0);
    __syncthreads();
}
__device__ __forceinline__ void block(const BlockRef& cur, unsigned char* wsb, char* lds, Seam& S) {
    const int GRP = cur.grp;
    const int tid = threadIdx.x, wid = __builtin_amdgcn_readfirstlane(tid >> 6), lane = tid & 63, r32 = lane & 31, hi = lane >> 5;
    const int NT = 4 * cur.qb + 4;
    const int qlo = cur.qb * QB + wid * QBLK, qm = qlo + r32 - 4 * hi;
    char* V_lds = lds; char* K_lds = lds + 2 * SHM_V;
    float* ws = (float*)(lds + LDS_WS) + wid * 64; float* li_l = ws, * al_l = ws + 32;
    float m_reg = -1e30f, l_reg = 0; f32x16 o[4] = {};
    const int sr = tid >> 4, sc = (tid & 15) * 8, vst0 = v_st(sr, sc), vst1 = v_st(32 + sr, sc), kws = KSWZ(sr, sc * 2);
    const int vb0 = (int)(uintptr_t)V_lds + v_rd_base(lane);
    const bf16_t* Kh = ptrK(wsb, cur); const bf16_t* Vh = ptrV(wsb, cur);
    const float sl = exp2f(-(float)(cur.h + 1)) * 11.313708498984761f;
    unsigned selbits = 0xffu;
    if (GRP == 1) {
        float* km = (float*)(lds + LDS_KM);
        const float* KM = (const float*)(wsb + WS_KMEAN) + ((size_t)(cur.b * NBLK) * NH + cur.h) * 128;
        if (tid < cur.qb * 32) { const int n = tid >> 5, c4 = (tid & 31) * 4; *(f32x4*)(km + n * 128 + c4) = *(const f32x4*)(KM + (size_t)n * (NH * 128) + c4); }
        __syncthreads();
        float v1 = -__builtin_inff(), v2 = v1, v3 = v1; int i1 = 31, i2 = 31, i3 = 31;
#pragma unroll 1
        for (int n = 0; n < cur.qb; ++n) { float a = 0.f;
#pragma unroll
            for (int d0 = 0; d0 < 8; ++d0) { const f32x4 k0 = *(const f32x4*)(km + n * 128 + d0 * 16 + hi * 8), k1 = *(const f32x4*)(km + n * 128 + d0 * 16 + hi * 8 + 4);
                const bf16x8 q = S.qr[d0];
                a += bf2f((bf16_t)q[0]) * k0[0] + bf2f((bf16_t)q[1]) * k0[1] + bf2f((bf16_t)q[2]) * k0[2] + bf2f((bf16_t)q[3]) * k0[3]
                   + bf2f((bf16_t)q[4]) * k1[0] + bf2f((bf16_t)q[5]) * k1[1] + bf2f((bf16_t)q[6]) * k1[2] + bf2f((bf16_t)q[7]) * k1[3]; }
            const float other = __shfl_xor(a, 32); const float g = a + other;
            const bool c1 = g > v1, c2 = g > v2, c3 = g > v3;
            v3 = c2 ? v2 : (c3 ? g : v3); i3 = c2 ? i2 : (c3 ? n : i3);
            v2 = c1 ? v1 : (c2 ? g : v2); i2 = c1 ? i1 : (c2 ? n : i2);
            v1 = c1 ? g : v1;             i1 = c1 ? n : i1; }
        selbits = ((1u << i1) | (1u << i2) | (1u << i3)) & 0xffu;
    }
    const char* mbase = (const char*)(wsb + WS_MASK) + ((size_t)cur.b * SEQ + qlo) * 256;
    const unsigned moff = (unsigned)r32 * 256u;
#define RESC(a) do { if (__any((a) < 1.f)) { if (hi == 0) al_l[r32] = (a); asm volatile("s_waitcnt lgkmcnt(0)" ::: "memory");              \
                     for (int d_ = 0; d_ < 4; ++d_) for (int r = 0; r < 16; ++r) o[d_][r] *= al_l[crow(r, hi)]; } } while (0)
#define KBASE(t) ((t) * KVBLK)
#define CB(t) ((GRP == 1 && (t) < 4 * cur.qb && !((selbits >> ((t) >> 2)) & 1u)) ? -__builtin_inff() : sl * (float)(KBASE(t) - qm))
#define MLOAD(t) ((GRP == 0) ? *(const unsigned long long*)(mbase + (moff + (unsigned)(t) * 8u)) : 0ull)
#define MASKT(P0_, P1_, t, mw) do { const int kb_ = KBASE(t); \
        if (GRP == 0) { mask_bits(P0_, P1_, ((unsigned)(mw)) >> (4 * hi), ((unsigned)((mw) >> 32)) >> (4 * hi)); } \
        else if (kb_ + KVBLK - 1 > qlo) mask_causal(P0_, P1_, qm - kb_); } while (0)
    f32x16 pA0, pA1, pB0, pB1; float mnA, mnB, alA, alB; bf16x8 pa0, pa1, pa2, pa3;
    unsigned long long mwA, mwB;
    SWRITE_HV(0); SBAR();
    if (NT > 1) SLOAD_H(Kh, Vh, KBASE(1));
    mwA = MLOAD(0);
    SBAR(); qkt<0>(pA0, pA1, K_lds, r32, hi, S.qr, CB(0), sl);
    MASKT(pA0, pA1, 0, mwA); partialSM(pA0, pA1, m_reg, mnA, alA);
    if (NT > 1) { VMW(); SWRITE_H(1); }
    __syncthreads();
#define HALF_STEP(PX0, PX1, mnX, alX, mwX, PY0, PY1, alY, t, KB, VB, SB) do {                                                 \
        SBAR(); qkt<KB>(PX0, PX1, K_lds, r32, hi, S.qr, CB(t), sl);                                                           \
        finishSM(PY0, PY1, alY, l_reg, pa0, pa1, pa2, pa3); SBAR();                                                           \
        if ((t) + 1 < NT) { SLOAD_H(Kh, Vh, KBASE((t) + 1)); SBAR(); }                                                        \
        mwX = MLOAD(t); pv_tile<VB>(o, vb0, pa0, pa1, pa2, pa3); MASKT(PX0, PX1, (t), mwX); partialSM(PX0, PX1, m_reg, mnX, alX);             \
        __syncthreads();                                                                                                      \
        if ((t) + 1 < NT) { VMW(); SWRITE_H(SB); }                                                                            \
        RESC(alX); __syncthreads(); } while (0)
    for (int t = 1; t + 1 < NT; t += 2) {
        HALF_STEP(pB0, pB1, mnB, alB, mwB, pA0, pA1, alA, t, 1, 0, 0);
        HALF_STEP(pA0, pA1, mnA, alA, mwA, pB0, pB1, alB, t + 1, 0, 1, 1);
    }
    SBAR(); qkt<1>(pB0, pB1, K_lds, r32, hi, S.qr, CB(NT - 1), sl); SBAR();
    mwB = MLOAD(NT - 1);
    finishSM(pA0, pA1, alA, l_reg, pa0, pa1, pa2, pa3); SBAR();
    pv_tile<0>(o, vb0, pa0, pa1, pa2, pa3);
    MASKT(pB0, pB1, NT - 1, mwB); partialSM(pB0, pB1, m_reg, mnB, alB); __syncthreads(); RESC(alB);
    finishSM(pB0, pB1, alB, l_reg, pa0, pa1, pa2, pa3); SBAR(); pv_tile<1>(o, vb0, pa0, pa1, pa2, pa3);
    if (hi == 0) li_l[r32] = l_reg; asm volatile("s_waitcnt lgkmcnt(0)" ::: "memory");
    float rli[16];
#pragma unroll
    for (int r = 0; r < 16; ++r) rli[r] = __builtin_amdgcn_rcpf(li_l[crow(r, hi)]);
    { bf16_t* stg = (bf16_t*)(lds + LDS_OST) + wid * (QBLK * D);
      int lane_e = lane; asm volatile("" : "+v"(lane_e));
      bf16_t* stw = stg + (4 * (lane_e >> 5)) * D + (lane_e & 31);
#pragma unroll
      for (int r = 0; r < 16; ++r) { const int orow = (r & 3) + 8 * (r >> 2);
#pragma unroll
          for (int d0 = 0; d0 < 4; ++d0) stw[orow * D + d0 * 32] = (bf16_t)cvt1(o[d0][r] * rli[r]); }
      asm volatile("s_waitcnt lgkmcnt(0)" ::: "memory");
      char* Ow = (char*)((bf16_t*)(wsb + WS_Y) + ((size_t)cur.b * SEQ + qlo) * 2048 + cur.grp * 1024 + cur.h * 128);
      const char* Zw = (const char*)(ptrZ(wsb, cur) + (size_t)(wid * QBLK) * D);
      const unsigned eo = (unsigned)((lane_e >> 4) * 256 + (lane_e & 15) * 16), yo = (unsigned)((lane_e >> 4) * 4096 + (lane_e & 15) * 16);
#pragma unroll
      for (int i = 0; i < 8; ++i) {
          const u32x4 ov = *(const u32x4*)((const char*)stg + (eo + (unsigned)(i * 1024))), zv = *(const u32x4*)(Zw + (eo + (unsigned)(i * 1024))); u32x4 w;
#pragma unroll
          for (int j = 0; j < 4; ++j) w[j] = cvtpk(__uint_as_float(ov[j] << 16) * __uint_as_float(zv[j] << 16), __uint_as_float(ov[j] & 0xffff0000u) * __uint_as_float(zv[j] & 0xffff0000u));
          *(u32x4*)(Ow + (yo + (unsigned)(i * 16384))) = w; } }
    __syncthreads();
#undef RESC
#undef KBASE
#undef CB
#undef MLOAD
#undef MASKT
#undef HALF_STEP
}
#undef ROW
#undef VMW
#undef VMWN
#undef SLOAD_H
#undef SWRITE_HK
#undef SWRITE_HV
#undef SWRITE_H
__device__ __forceinline__ bool decode(int v, int G, int i, BlockRef& r) {
    const int L = v + (i >> 1) * G; if (L >= 512) return false;
    const int x = L & 3, k = L >> 5;
    r.h = (L >> 2) & 7; r.b = k & 7; r.grp = ((k & 1) ^ (k >> 3)) & 1; r.qb = (i & 1) ? 7 - x : x;
    return true;
}
__device__ __forceinline__ void attn_phase(char* lds, unsigned char* wsb, int v, int G) {
    BlockRef cur, nxt;
    if (!decode(v, G, 0, cur)) return;
    Seam S;
    prime(cur, wsb, lds, S);
    for (int i = 0;; ++i) {
        const bool more = decode(v, G, i + 1, nxt);
        if (!more) nxt = cur;
        block(cur, wsb, lds, S);
        if (!more) break;
        prime(nxt, wsb, lds, S);
        cur = nxt;
    }
}
#undef KSWZ
#undef SBAR
}

namespace sel {
#define SLAS __attribute__((address_space(3)))
typedef short bf16x8 __attribute__((ext_vector_type(8)));
typedef float f32x16 __attribute__((ext_vector_type(16)));
typedef float f32x4 __attribute__((ext_vector_type(4)));
typedef unsigned u32x4 __attribute__((ext_vector_type(4)));
constexpr int KB_OFF = 131072;
constexpr int LIST_OFF = 147456 + 2048;
__device__ __forceinline__ unsigned fkey(float x) { const unsigned b = __float_as_uint(x); return (b & 0x80000000u) ? ~b : (b | 0x80000000u); }
__device__ __forceinline__ void unit(SLAS unsigned char* lds, unsigned char* wsb, int b, int rg) {
    const int tid = threadIdx.x, wid = __builtin_amdgcn_readfirstlane(tid >> 6), lane = tid & 63, j = lane & 31, g = lane >> 5;
    const bf16_t* QI = (const bf16_t*)(wsb + WS_QI); const char* KIb = (const char*)((const bf16_t*)(wsb + WS_KI) + (size_t)b * SEQ * 64); const float* WI = (const float*)(wsb + WS_WI);
    unsigned long long* MASK = (unsigned long long*)(wsb + WS_MASK);
    const int ta = 16 * rg + 2 * wid, t = ta + g;
    const int nkeys = 16 * rg + 16, nk32 = (nkeys + 31) >> 5, nch = (nkeys + 63) >> 6;
    SLAS float* sc = (SLAS float*)lds + (wid * 2 + g) * 2048 + j;
    float vmin = __builtin_inff(), vmax = -__builtin_inff();
    bf16x8 af[4];
    { const int i = lane & 31, tok = (i >> 2) & 1, head = (i & 3) + 4 * (i >> 3);
      const bf16_t* qp = QI + ((size_t)b * SEQ + ta + tok) * 1024 + head * 64 + 8 * (lane >> 5);
#pragma unroll
      for (int ks = 0; ks < 4; ++ks) af[ks] = *(const bf16x8*)(qp + 16 * ks); }
    float wv[16];
    { const float* wp = WI + ((size_t)b * SEQ + t) * 16;
#pragma unroll
      for (int q4 = 0; q4 < 4; ++q4) { const f32x4 w4 = *(const f32x4*)(wp + 4 * q4); wv[4 * q4] = w4[0] * 0.03125f; wv[4 * q4 + 1] = w4[1] * 0.03125f; wv[4 * q4 + 2] = w4[2] * 0.03125f; wv[4 * q4 + 3] = w4[3] * 0.03125f; } }
    const int srow = tid >> 3, scol = tid & 7, swr = srow * 128 + ((scol ^ ((srow >> 1) & 7)) << 4);
    int koff[4];
#pragma unroll
    for (int ks = 0; ks < 4; ++ks) koff[ks] = j * 128 + (((2 * ks + g) ^ ((j >> 1) & 7)) << 4);
    u32x4 st = *(const u32x4*)(KIb + (unsigned)(tid * 16));
    *(SLAS u32x4*)(lds + KB_OFF + swr) = st;
    __syncthreads();
#pragma unroll 1
    for (int c = 0; c < nch; ++c) {
        if (c + 1 < nch) st = *(const u32x4*)(KIb + (unsigned)((c + 1) * 8192 + tid * 16));
        SLAS unsigned char* kb = lds + KB_OFF + (c & 1) * 8192;
#pragma unroll
        for (int k2 = 0; k2 < 2; ++k2) { const int kt = 2 * c + k2;
            if (kt < nk32) {
                f32x16 acc = {};
#pragma unroll
                for (int ks = 0; ks < 4; ++ks) { const bf16x8 bfr = *(const SLAS bf16x8*)(kb + k2 * 4096 + koff[ks]);
                    acc = __builtin_amdgcn_mfma_f32_32x32x16_bf16(af[ks], bfr, acc, 0, 0, 0); }
                float s = 0.f;
#pragma unroll
                for (int r = 0; r < 16; ++r) s = fmaf(wv[r], fmaxf(acc[r], 0.f), s);
                if (32 * kt + j <= t) { vmin = fminf(vmin, s); vmax = fmaxf(vmax, s); }
                sc[32 * kt] = s;
            } }
        if (c + 1 < nch) *(SLAS u32x4*)(lds + KB_OFF + ((c + 1) & 1) * 8192 + swr) = st;
        __syncthreads();
    }
    unsigned T = 0u; int need = 0; bool ties = false;
    if (16 * rg >= TOPK) {
        SLAS unsigned* hist = (SLAS unsigned*)(lds + KB_OFF) + (wid * 2 + g) * 256;
#pragma unroll
        for (int off = 1; off < 32; off <<= 1) { vmin = fminf(vmin, __shfl_xor(vmin, off)); vmax = fmaxf(vmax, __shfl_xor(vmax, off)); }
        const float range = vmax - vmin, inv = (range > 0.f) ? 255.99f / range : 0.f;
        *(SLAS u32x4*)(hist + 8 * j) = (u32x4){0u, 0u, 0u, 0u}; *(SLAS u32x4*)(hist + 8 * j + 4) = (u32x4){0u, 0u, 0u, 0u};
#pragma unroll 2
        for (int kt = 0; kt < nk32; ++kt) { const float x = sc[32 * kt];
            if (32 * kt + j <= t) { const int q = min((int)((x - vmin) * inv), 255); __hip_atomic_fetch_add(hist + q, 1u, __ATOMIC_RELAXED, __HIP_MEMORY_SCOPE_WORKGROUP); } }
        asm volatile("s_waitcnt lgkmcnt(0)" ::: "memory");
        int qsel, cB;
        { const u32x4 c0 = *(const SLAS u32x4*)(hist + 8 * j), c1 = *(const SLAS u32x4*)(hist + 8 * j + 4);
          const int cnt[8] = {(int)c0[0], (int)c0[1], (int)c0[2], (int)c0[3], (int)c1[0], (int)c1[1], (int)c1[2], (int)c1[3]};
          const int s = ((cnt[0] + cnt[1]) + (cnt[2] + cnt[3])) + ((cnt[4] + cnt[5]) + (cnt[6] + cnt[7]));
          int S = s;
#pragma unroll
          for (int off = 1; off < 32; off <<= 1) { const int v = __shfl_down(S, off, 32); if (j + off < 32) S += v; }
          const int above = S - s;
          const bool found = (S >= TOPK) && (above < TOPK);
          int dsel = 0, nneed = 0, csel = 0;
          { const int rem = TOPK - above; int cum = 0; bool done = false;
#pragma unroll
            for (int i = 7; i >= 0; --i) { const int before = cum; cum += cnt[i]; if (!done && cum >= rem) { done = true; dsel = 8 * j + i; nneed = rem - before; csel = cnt[i]; } } }
          const unsigned long long bm = __ballot(found);
          const int src = 32 * g + __builtin_ctz((unsigned)(bm >> (32 * g)) | 0x80000000u);
          qsel = __shfl(dsel, src); need = __shfl(nneed, src); cB = __shfl(csel, src); }
        if (!__any(cB > 64)) {
            SLAS unsigned* list = (SLAS unsigned*)(lds + LIST_OFF) + (wid * 2 + g) * 128;
            int base = 0;
#pragma unroll 2
            for (int kt = 0; kt < nk32; ++kt) { const float x = sc[32 * kt];
                const bool m = (32 * kt + j <= t) && (min((int)((x - vmin) * inv), 255) == qsel);
                const unsigned long long bal = __ballot(m); const unsigned hm = g ? (unsigned)(bal >> 32) : (unsigned)bal;
                if (m) { const int pos = base + __builtin_popcount(hm & ((1u << j) - 1u)); list[2 * pos] = fkey(x); list[2 * pos + 1] = (unsigned)(32 * kt + j); }
                base += __builtin_popcount(hm); }
            asm volatile("s_waitcnt lgkmcnt(0)" ::: "memory");
            const unsigned u0 = list[2 * j], i0 = list[2 * j + 1], u1 = list[2 * (j + 32)], i1 = list[2 * (j + 32) + 1];
            int r0 = 0, r1 = 0; const int cmax = max(cB, __shfl_xor(cB, 32));
#pragma unroll 1
            for (int e = 0; e < cmax; ++e) { const unsigned ue = list[2 * e], ie = list[2 * e + 1]; const bool in = e < cB;
                r0 += (in && (ue > u0 || (ue == u0 && ie < i0))) ? 1 : 0; r1 += (in && (ue > u1 || (ue == u1 && ie < i1))) ? 1 : 0; }
            const bool h0 = (j < cB) && (r0 == need - 1), h1 = (j + 32 < cB) && (r1 == need - 1);
            const unsigned long long bh = __ballot(h0 || h1);
            const int src = 32 * g + __builtin_ctz((unsigned)(bh >> (32 * g)) | 0x80000000u);
            T = __shfl(h0 ? u0 : u1, src);
            const unsigned long long bg0 = __ballot(j < cB && u0 > T), bg1 = __ballot(j + 32 < cB && u1 > T), be0 = __ballot(j < cB && u0 == T), be1 = __ballot(j + 32 < cB && u1 == T);
            const int ngt = __builtin_popcount(g ? (unsigned)(bg0 >> 32) : (unsigned)bg0) + __builtin_popcount(g ? (unsigned)(bg1 >> 32) : (unsigned)bg1);
            const int neq = __builtin_popcount(g ? (unsigned)(be0 >> 32) : (unsigned)be0) + __builtin_popcount(g ? (unsigned)(be1 >> 32) : (unsigned)be1);
            need = need - ngt; ties = (neq != need);
        } else {
            unsigned prefix = 0u; need = TOPK; int ceq = 0;
#pragma unroll 1
            for (int p = 0; p < 4; ++p) { const int shift = 24 - 8 * p;
                *(SLAS u32x4*)(hist + 8 * j) = (u32x4){0u, 0u, 0u, 0u}; *(SLAS u32x4*)(hist + 8 * j + 4) = (u32x4){0u, 0u, 0u, 0u};
                const unsigned phi = prefix >> ((shift + 8) & 31);
#pragma unroll 1
                for (int kt = 0; kt < nk32; ++kt) { const unsigned x = fkey(sc[32 * kt]);
                    const bool match = (32 * kt + j <= t) && ((p == 0) || ((x >> ((shift + 8) & 31)) == phi));
                    if (match) __hip_atomic_fetch_add(hist + ((x >> shift) & 255u), 1u, __ATOMIC_RELAXED, __HIP_MEMORY_SCOPE_WORKGROUP); }
                asm volatile("s_waitcnt lgkmcnt(0)" ::: "memory");
                const u32x4 c0 = *(const SLAS u32x4*)(hist + 8 * j), c1 = *(const SLAS u32x4*)(hist + 8 * j + 4);
                const int cnt[8] = {(int)c0[0], (int)c0[1], (int)c0[2], (int)c0[3], (int)c1[0], (int)c1[1], (int)c1[2], (int)c1[3]};
                const int s = ((cnt[0] + cnt[1]) + (cnt[2] + cnt[3])) + ((cnt[4] + cnt[5]) + (cnt[6] + cnt[7]));
                int S = s;
#pragma unroll
                for (int off = 1; off < 32; off <<= 1) { const int v = __shfl_down(S, off, 32); if (j + off < 32) S += v; }
                const int above = S - s;
                const bool found = (S >= need) && (above < need);
                int dsel = 0, nneed = 0, csel = 0;
                { const int rem = need - above; int cum = 0; bool done = false;
#pragma unroll
                  for (int i = 7; i >= 0; --i) { const int before = cum; cum += cnt[i]; if (!done && cum >= rem) { done = true; dsel = 8 * j + i; nneed = rem - before; csel = cnt[i]; } } }
                const unsigned long long bm = __ballot(found);
                const int src = 32 * g + __builtin_ctz((unsigned)(bm >> (32 * g)) | 0x80000000u);
                const int digit = __shfl(dsel, src); need = __shfl(nneed, src); ceq = __shfl(csel, src);
                prefix |= (unsigned)digit << shift;
            }
            T = prefix; ties = (ceq != need);
        }
    }
    unsigned wlo = 0u, whi = 0u;
    if (!__any(ties)) {
#pragma unroll 2
        for (int k64 = 0; k64 < 32; ++k64) {
            const bool s0 = (64 * k64 + j <= t) && (fkey(sc[64 * k64]) >= T), s1 = (64 * k64 + 32 + j <= t) && (fkey(sc[64 * k64 + 32]) >= T);
            const unsigned long long b0 = __ballot(s0), b1 = __ballot(s1);
            const unsigned lo = g ? (unsigned)(b0 >> 32) : (unsigned)b0, hi = g ? (unsigned)(b1 >> 32) : (unsigned)b1;
            if (j == k64) { wlo = lo; whi = hi; } }
    } else {
        int base = 0;
#pragma unroll 1
        for (int k64 = 0; k64 < 32; ++k64) { unsigned lo = 0u, hi = 0u;
#pragma unroll
            for (int hh = 0; hh < 2; ++hh) { const bool vld = (64 * k64 + 32 * hh + j <= t); const unsigned x = vld ? fkey(sc[64 * k64 + 32 * hh]) : 0u;
                const unsigned long long be = __ballot(vld && x == T); const unsigned em = g ? (unsigned)(be >> 32) : (unsigned)be;
                const int rank = base + __builtin_popcount(em & ((1u << j) - 1u));
                const bool s1 = vld && ((x > T) || (x == T && rank < need));
                base += __builtin_popcount(em);
                const unsigned long long bs = __ballot(s1); const unsigned sm = g ? (unsigned)(bs >> 32) : (unsigned)bs;
                if (hh == 0) lo = sm; else hi = sm; }
            if (j == k64) { wlo = lo; whi = hi; } }
    }
    MASK[((size_t)b * SEQ + t) * 32 + j] = (unsigned long long)wlo | ((unsigned long long)whi << 32);
    __syncthreads();
}
__device__ __forceinline__ void kmean_unit(SLAS unsigned char* lds, unsigned char* wsb, int b, int n, int h) {
    const int tid = threadIdx.x, d4 = tid & 31, rs = tid >> 5;
    const bf16_t* KB = (const bf16_t*)(wsb + WS_KB) + (((size_t)(b * NH + h) * SEQ) + n * 256) * 128;
    float a0 = 0.f, a1 = 0.f, a2 = 0.f, a3 = 0.f;
#pragma unroll 4
    for (int r = 0; r < 16; ++r) { const unsigned long long v = *(const unsigned long long*)(KB + (size_t)(rs * 16 + r) * 128 + d4 * 4);
        const unsigned lo = (unsigned)v, hi = (unsigned)(v >> 32);
        a0 += __uint_as_float(lo << 16); a1 += __uint_as_float(lo & 0xffff0000u); a2 += __uint_as_float(hi << 16); a3 += __uint_as_float(hi & 0xffff0000u); }
    SLAS float* red = (SLAS float*)lds;
    *(SLAS f32x4*)(red + rs * 128 + d4 * 4) = (f32x4){a0, a1, a2, a3};
    __syncthreads();
    if (tid < 128) { float s = 0.f;
#pragma unroll
        for (int q = 0; q < 16; ++q) s += red[q * 128 + tid];
        ((float*)(wsb + WS_KMEAN))[((size_t)(b * NBLK + n) * NH + h) * 128 + tid] = s * (1.f / 256.f); }
    __syncthreads();
}
__device__ __forceinline__ void select_phase(SLAS unsigned char* lds, unsigned char* wsb, int v, int G) {
    for (int L = v; L < 512; L += G) kmean_unit(lds, wsb, L >> 6, (L >> 3) & 7, L & 7);
    for (int L = v; L < 512; L += G) { const int b = L >> 6, x = L & 63;
        unit(lds, wsb, b, x);
        unit(lds, wsb, b, 127 - x); }
}
#undef SLAS
}

struct Args { const float* in[12]; float* out; unsigned char* ws; int ph_lo, ph_hi, li, pad; };
__global__ void __launch_bounds__(NWAVES * 64, 2) mega_fwd(Args args) {
    extern __shared__ __attribute__((aligned(16))) unsigned char lds[];
    Frame F;
    F.lds = (LAS unsigned char*)lds; F.MISC = (volatile LAS unsigned*)(F.lds + MISC_OFF);
    F.tid = threadIdx.x; F.lane = F.tid & 63; F.wave = __builtin_amdgcn_readfirstlane(F.tid >> 6);
    F.G = gridDim.x; { const int bx = blockIdx.x; F.vcu = (F.G % 8 == 0) ? (bx % 8) * (F.G / 8) + bx / 8 : bx; }
    unsigned char* ws = args.ws;
    F.ctl = (gu32*)(ws + WS_CTL);
    const float* x = args.in[0]; const float* c = args.in[1]; const float* w_ada = args.in[2]; const float* b_ada = args.in[3]; const float* g_norm = args.in[4];
    const float* w_in = args.in[5]; const float* w_out = args.in[11];
    float* MOD = (float*)(ws + WS_MOD); bf16_t* WinT = (bf16_t*)(ws + WS_WIN); bf16_t* WoutT = (bf16_t*)(ws + WS_WOUT); bf16_t* HB = (bf16_t*)(ws + WS_HB); bf16_t* Y = (bf16_t*)(ws + WS_Y);
    for (int u = F.tid; u < (LDS_BYTES - LDSCTL_OFF) / 4; u += NWAVES * 64) ((LAS unsigned*)(F.lds + LDSCTL_OFF))[u] = 0u;
    __syncthreads();
    XcdBarrier bar = xcd_barrier_post((unsigned*)(F.ctl + CW_BAR) + args.li * XCD_BAR_WORDS, F.MISC + 8);
    const int lo = args.ph_lo, hi = args.ph_hi;
#define IN(k) (lo <= (k) && (k) < hi)
#define BOTH(k) (IN(k) && IN((k) + 1))
    if (IN(0)) for (int rep_ = 0; rep_ < (((PROBE_DOUBLE) >> 0) & 1) + 1; ++rep_) {
        if (rep_) __syncthreads();
        if ((int)blockIdx.x < 192) p0_mod(F, (int)blockIdx.x, c, w_ada, b_ada, MOD);
        else if ((int)blockIdx.x == 192) { float* G = (float*)(ws + WS_GAIN);
            if (F.tid < 128) { G[F.tid] = args.in[6][F.tid]; G[128 + F.tid] = args.in[7][F.tid]; G[256 + F.tid] = args.in[9][F.tid]; G[384 + F.tid] = args.in[10][F.tid]; }
            if (F.tid < 64) G[512 + F.tid] = args.in[8][F.tid]; }
        p0_convert(F, w_in, w_out, WinT, WoutT);
    }
    if (BOTH(0)) xcd_barrier(bar);
    if (IN(1)) for (int rep_ = 0; rep_ < (((PROBE_DOUBLE) >> 1) & 1) + 1; ++rep_) p1_norm(F, x, g_norm, MOD, HB);
    if (BOTH(1)) xcd_barrier(bar);
    if (IN(2)) for (int rep_ = 0; rep_ < (((PROBE_DOUBLE) >> 2) & 1) + 1; ++rep_) {
        pg8::Gemm g{HB, WinT, M, NPAD, DM}; pg8::StaticOrder S; S.init(M, NPAD, F.G, (int)blockIdx.x);
        EpiProj E{ws, (LAS float*)(F.lds + EPI_OFF)};
        pg8::gemm_phase<EpiProj, pg8::StaticOrder, true, true>(F.lds, g, S, E);
    }
    if (BOTH(2)) xcd_barrier(bar);
    if (IN(3)) for (int rep_ = 0; rep_ < (((PROBE_DOUBLE) >> 3) & 1) + 1; ++rep_) sel::select_phase(F.lds, ws, F.vcu, F.G);
    if (BOTH(3)) xcd_barrier(bar);
    if (IN(4)) for (int rep_ = 0; rep_ < (((PROBE_DOUBLE) >> 4) & 1) + 1; ++rep_) att::attn_phase((char*)lds, ws, F.vcu, F.G);
    if (BOTH(4)) xcd_barrier(bar);
    if (IN(5)) for (int rep_ = 0; rep_ < (((PROBE_DOUBLE) >> 5) & 1) + 1; ++rep_) {
        pg8::Gemm g{Y, WoutT, M, DM, DM}; pg8::StaticOrder S; S.init(M, DM, F.G, (int)blockIdx.x);
        EpiOut E{x, MOD, args.out};
        pg8::gemm_phase<EpiOut, pg8::StaticOrder, true, true>(F.lds, g, S, E);
    }
#undef IN
#undef BOTH
}

static int mega_setup() {
    static int grid = 0;
    if (grid == 0) {
        int dev = 0, cus = 0;
        if (hipGetDevice(&dev) != hipSuccess || hipDeviceGetAttribute(&cus, hipDeviceAttributeMultiprocessorCount, dev) != hipSuccess) { fprintf(stderr, "kernel_launch: device query failed\n"); grid = -1; return grid; }
        if (hipFuncSetAttribute((const void*)mega_fwd, hipFuncAttributeMaxDynamicSharedMemorySize, LDS_BYTES) != hipSuccess) { fprintf(stderr, "kernel_launch: hipFuncSetAttribute failed\n"); grid = -1; return grid; }
        (void)hipGetLastError();
        grid = cus;
    }
    return grid;
}
static void mega_launch(int grid, void* const* d_in, void* d_out, void* d_ws, int ph_lo, int ph_hi, int li, hipStream_t stream) {
    Args a{};
    for (int i = 0; i < 12; ++i) a.in[i] = (const float*)d_in[i];
    a.out = (float*)d_out; a.ws = (unsigned char*)d_ws; a.ph_lo = ph_lo; a.ph_hi = ph_hi; a.li = li;
    hipLaunchKernelGGL(mega_fwd, dim3(grid), dim3(NWAVES * 64), LDS_BYTES, stream, a);
}

extern "C" void kernel_launch(void* const* d_in, const int* in_sizes, int n_in, void* d_out, int out_size, void* d_ws, size_t ws_size, hipStream_t stream) {
    if (n_in != 12 || in_sizes[0] != M * DM || out_size != M * DM || ws_size < WS_END) {
        fprintf(stderr, "kernel_launch: unexpected shapes (n_in %d, in0 %d, out %d, ws %zu); nothing launched\n", n_in, n_in > 0 ? in_sizes[0] : -1, out_size, ws_size); return; }
    const int grid = mega_setup(); if (grid <= 0) return;
    char* ws = (char*)d_ws;
    bf16_t* QA = (bf16_t*)(ws + WS_QA); bf16_t* KA = (bf16_t*)(ws + WS_KA); bf16_t* VA = (bf16_t*)(ws + WS_VA); bf16_t* SZA = (bf16_t*)(ws + WS_SZA);
    bf16_t* QB = (bf16_t*)(ws + WS_QB); bf16_t* KB = (bf16_t*)(ws + WS_KB); bf16_t* VB = (bf16_t*)(ws + WS_VB); bf16_t* SZB = (bf16_t*)(ws + WS_SZB);
    bf16_t* QI = (bf16_t*)(ws + WS_QI); bf16_t* KI = (bf16_t*)(ws + WS_KI); float* WI = (float*)(ws + WS_WI); float* KMEAN = (float*)(ws + WS_KMEAN);
    unsigned long long* MASKT = (unsigned long long*)(ws + WS_MASK); bf16_t* Y = (bf16_t*)(ws + WS_Y);
    (void)hipMemsetAsync(ws + WS_CTL, 0, CTL_ZERO_BYTES, stream);
#if NAIVE_SEL
    mega_launch(grid, d_in, d_out, d_ws, 0, 3, 0, stream);
    k_kmean<<<BATCH * NBLK * NH, 128, 0, stream>>>(KB, KMEAN);
    (void)hipMemsetAsync(MASKT, 0, 4 * MiB, stream);
    k_dsa_select_naive<<<dim3(SEQ, BATCH), 256, 0, stream>>>(QI, KI, WI, MASKT);
    mega_launch(grid, d_in, d_out, d_ws, 4, 6, 1, stream);
#else
    mega_launch(grid, d_in, d_out, d_ws, 0, 6, 0, stream);
#endif
}
```

```cpp
#include <hip/hip_runtime.h>
#include <cstdio>
#include <cstdint>

typedef unsigned short bf16_t;
#ifndef NAIVE_SEL
#define NAIVE_SEL 0
#endif
#ifndef PROBE_SEL
#define PROBE_SEL 0
#endif
#ifndef PROBE_EXTRA
#define PROBE_EXTRA -1
#endif
#ifndef PROBE_DOUBLE
#define PROBE_DOUBLE 0
#endif
constexpr int BATCH = 8, SEQ = 2048, DM = 2048, M = BATCH * SEQ, NH = 8, HD = 128, DA = 1024, IH = 16, ID = 64, DIN = 9296;
constexpr int TOPK = 256, NBLK = 8;
constexpr float RMS_EPS = 1e-6f;
constexpr float QK_SCALE = 0.08838834764831845f;

__device__ __forceinline__ float bf2f(bf16_t v) { return __uint_as_float(((unsigned)v) << 16); }
__device__ __forceinline__ bf16_t f2bf(float f) { unsigned u = __float_as_uint(f); return (bf16_t)((u + 0x7fffu + ((u >> 16) & 1u)) >> 16); }
__device__ __forceinline__ float rbf(float f) { return bf2f(f2bf(f)); }
__device__ __forceinline__ float silu_f(float v) { return v / (1.f + __expf(-v)); }
__device__ __forceinline__ size_t HM(int b, int h, int t, int d) { return (((size_t)(b * NH + h) * SEQ + t) * HD + d); }
__device__ __forceinline__ float wave_sum(float v) {
#pragma unroll
    for (int o = 1; o < 64; o <<= 1) v += __shfl_xor(v, o);
    return v;
}
__device__ __forceinline__ float wave_max(float v) {
#pragma unroll
    for (int o = 1; o < 64; o <<= 1) v = fmaxf(v, __shfl_xor(v, o));
    return v;
}
__device__ __forceinline__ void mask_pos(int t, int s, size_t& word, int& bit) { word = (size_t)t * 32 + (s >> 6); bit = s & 63; }

__global__ void k_mod(const float* __restrict__ c, const float* __restrict__ w_ada, const float* __restrict__ b_ada, float* __restrict__ MOD) {
    __shared__ float sc[DM];
    const int b = blockIdx.y, n = blockIdx.x * 256 + threadIdx.x;
    for (int k = threadIdx.x; k < DM; k += 256) sc[k] = silu_f(c[b * DM + k]);
    __syncthreads();
    float acc = 0.f;
    for (int k = 0; k < DM; ++k) acc += sc[k] * w_ada[(size_t)k * (3 * DM) + n];
    MOD[b * 3 * DM + n] = acc + b_ada[n];
}
__global__ void k_norm(const float* __restrict__ x, const float* __restrict__ g, const float* __restrict__ MOD, bf16_t* __restrict__ HB) {
    const int lane = threadIdx.x & 63, row = blockIdx.x * 4 + (threadIdx.x >> 6), b = row / SEQ;
    const float* xr = x + (size_t)row * DM;
    float ss = 0.f;
    for (int k = lane; k < DM; k += 64) { const float v = xr[k]; ss += v * v; }
    ss = wave_sum(ss);
    const float rstd = rsqrtf(ss / DM + RMS_EPS);
    const float* shift = MOD + b * 3 * DM; const float* scale = shift + DM;
    for (int k = lane; k < DM; k += 64) HB[(size_t)row * DM + k] = f2bf(xr[k] * rstd * g[k] * (1.f + scale[k]) + shift[k]);
}
template <int MODE>
__global__ void k_gemm_naive(const bf16_t* __restrict__ A, int K, const float* __restrict__ W, int ldw, int n0, int ncols,
                             float* __restrict__ C, int ldc, const float* __restrict__ xres, const float* __restrict__ MOD) {
    __shared__ float As[16][65], Bs[16][65];
    const int tid = threadIdx.x, tx = tid & 15, ty = tid >> 4, m0 = blockIdx.y * 64, c0 = blockIdx.x * 64;
    float acc[4][4] = {};
    for (int k0 = 0; k0 < K; k0 += 16) {
        for (int i = tid; i < 1024; i += 256) { const int r = i >> 4, kk = i & 15; As[kk][r] = bf2f(A[(size_t)(m0 + r) * K + k0 + kk]); }
        for (int i = tid; i < 1024; i += 256) { const int kk = i >> 6, cc = i & 63; Bs[kk][cc] = (c0 + cc < ncols) ? rbf(W[(size_t)(k0 + kk) * ldw + n0 + c0 + cc]) : 0.f; }
        __syncthreads();
#pragma unroll
        for (int kk = 0; kk < 16; ++kk) {
            float a[4], bb[4];
#pragma unroll
            for (int i = 0; i < 4; ++i) { a[i] = As[kk][ty * 4 + i]; bb[i] = Bs[kk][tx * 4 + i]; }
#pragma unroll
            for (int i = 0; i < 4; ++i)
#pragma unroll
                for (int j = 0; j < 4; ++j) acc[i][j] += a[i] * bb[j];
        }
        __syncthreads();
    }
#pragma unroll
    for (int i = 0; i < 4; ++i)
#pragma unroll
        for (int j = 0; j < 4; ++j) {
            const int m = m0 + ty * 4 + i, cc = c0 + tx * 4 + j;
            if (cc < ncols) {
                if (MODE == 0) C[(size_t)m * ldc + cc] = acc[i][j];
                else { const int b = m / SEQ; C[(size_t)m * ldc + cc] = xres[(size_t)m * ldc + cc] + MOD[b * 3 * DM + 2 * DM + cc] * acc[i][j]; }
            }
        }
}
__global__ void k_post(const float* __restrict__ T32, const float* __restrict__ gain, bf16_t* __restrict__ dst, int mode) {
    const int lane = threadIdx.x & 63, item = blockIdx.x * 4 + (threadIdx.x >> 6), m = item >> 3, h = item & 7, b = m / SEQ, t = m % SEQ;
    const float* src = T32 + (size_t)m * 1024 + h * 128;
    float v0 = src[lane], v1 = src[lane + 64];
    if (mode == 0) { const float ss = wave_sum(v0 * v0 + v1 * v1); const float rstd = rsqrtf(ss / 128.f + RMS_EPS); v0 = v0 * rstd * gain[lane]; v1 = v1 * rstd * gain[lane + 64]; }
    if (mode == 2) { v0 = silu_f(v0); v1 = silu_f(v1); }
    if (mode == 3) { dst[(size_t)m * 1024 + h * 128 + lane] = f2bf(v0); dst[(size_t)m * 1024 + h * 128 + lane + 64] = f2bf(v1); }
    else { dst[HM(b, h, t, lane)] = f2bf(v0); dst[HM(b, h, t, lane + 64)] = f2bf(v1); }
}
__global__ void k_post_idx(const float* __restrict__ T32, const float* __restrict__ gain, bf16_t* __restrict__ KI, float* __restrict__ WI) {
    const int lane = threadIdx.x & 63, m = blockIdx.x * 4 + (threadIdx.x >> 6);
    const float v = T32[(size_t)m * 80 + lane];
    const float ss = wave_sum(v * v); const float rstd = rsqrtf(ss / 64.f + RMS_EPS);
    KI[(size_t)m * 64 + lane] = f2bf(v * rstd * gain[lane]);
    if (lane < 16) WI[(size_t)m * 16 + lane] = T32[(size_t)m * 80 + 64 + lane];
}
__global__ void k_kmean(const bf16_t* __restrict__ KB, float* __restrict__ KMEAN) {
    const int d = threadIdx.x, h = blockIdx.x & 7, n = (blockIdx.x >> 3) & 7, b = blockIdx.x >> 6;
    float s = 0.f;
    for (int t = 0; t < 256; ++t) s += bf2f(KB[HM(b, h, n * 256 + t, d)]);
    KMEAN[((size_t)(b * NBLK + n) * NH + h) * HD + d] = s * (1.f / 256.f);
}
__global__ void k_dsa_select_naive(const bf16_t* __restrict__ QI, const bf16_t* __restrict__ KI, const float* __restrict__ WI, unsigned long long* __restrict__ MASKT) {
    const int t = blockIdx.x, b = blockIdx.y, tid = threadIdx.x; const size_t m = (size_t)b * SEQ + t;
    __shared__ float q[1024]; __shared__ float w[16]; __shared__ float sc[SEQ];
    for (int i = tid; i < 1024; i += 256) q[i] = bf2f(QI[m * 1024 + i]);
    if (tid < 16) w[tid] = WI[m * 16 + tid];
    __syncthreads();
    for (int s = tid; s <= t; s += 256) {
        float k[64];
        const bf16_t* kp = KI + ((size_t)b * SEQ + s) * 64;
#pragma unroll
        for (int d = 0; d < 64; ++d) k[d] = bf2f(kp[d]);
        float score = 0.f;
        for (int h = 0; h < 16; ++h) { float dot = 0.f;
#pragma unroll
            for (int d = 0; d < 64; ++d) dot += q[h * 64 + d] * k[d];
            score += w[h] * fmaxf(dot * 0.125f, 0.f); }
        sc[s] = score * 0.25f;
    }
    __syncthreads();
    for (int s = tid; s <= t; s += 256) {
        bool sel = true;
        if (t >= TOPK) { const float v = sc[s]; int cnt = 0; for (int s2 = 0; s2 <= t; ++s2) { const float u = sc[s2]; cnt += (u > v || (u == v && s2 < s)) ? 1 : 0; } sel = cnt < TOPK; }
        if (sel) { size_t word; int bit; mask_pos(t, s, word, bit); atomicOr(&MASKT[(size_t)b * 65536 + word], 1ull << bit); }
    }
}
__global__ void k_dsa_attn_naive(const bf16_t* __restrict__ QA, const bf16_t* __restrict__ KA, const bf16_t* __restrict__ VA, const bf16_t* __restrict__ SZA,
                                 const unsigned long long* __restrict__ MASKT, bf16_t* __restrict__ Y) {
    const int t = blockIdx.x, b = blockIdx.y, tid = threadIdx.x, lane = tid & 63, w = tid >> 6; const size_t m = (size_t)b * SEQ + t;
    __shared__ int idx[512]; __shared__ int nsel; __shared__ float qs[8][128]; __shared__ float p[4][256];
    if (tid == 0) nsel = 0;
    __syncthreads();
    for (int s = tid; s <= t; s += 256) { size_t word; int bit; mask_pos(t, s, word, bit);
        if ((MASKT[(size_t)b * 65536 + word] >> bit) & 1ull) { const int pos = atomicAdd(&nsel, 1); if (pos < 512) idx[pos] = s; } }
    for (int i = tid; i < 1024; i += 256) qs[i >> 7][i & 127] = bf2f(QA[HM(b, i >> 7, t, i & 127)]);
    __syncthreads();
    const int n = nsel < 256 ? nsel : 256;
    for (int hh = 0; hh < 2; ++hh) {
        const int h = w + 4 * hh; const float slope = exp2f(-(float)(h + 1));
        float sv[4]; float mx = -INFINITY;
#pragma unroll
        for (int i = 0; i < 4; ++i) { const int j = lane + 64 * i; sv[i] = -INFINITY;
            if (j < n) { const int s = idx[j]; const bf16_t* kp = KA + HM(b, h, s, 0); float dot = 0.f;
                for (int d = 0; d < 128; ++d) dot += qs[h][d] * bf2f(kp[d]);
                sv[i] = dot * QK_SCALE - slope * (float)(t - s); }
            mx = fmaxf(mx, sv[i]); }
        mx = wave_max(mx);
        float sum = 0.f;
#pragma unroll
        for (int i = 0; i < 4; ++i) { const int j = lane + 64 * i; const float pv = (j < n) ? __expf(sv[i] - mx) : 0.f; sum += pv; p[w][j] = pv; }
        sum = wave_sum(sum);
        __syncthreads();
        float o0 = 0.f, o1 = 0.f;
        for (int j = 0; j < n; ++j) { const float pj = p[w][j]; const int s = idx[j]; const unsigned vv = *(const unsigned*)(VA + HM(b, h, s, 2 * lane));
            o0 += pj * __uint_as_float(vv << 16); o1 += pj * __uint_as_float(vv & 0xffff0000u); }
        const float inv = 1.f / sum;
        const unsigned zz = *(const unsigned*)(SZA + HM(b, h, t, 2 * lane));
        o0 = o0 * inv * __uint_as_float(zz << 16); o1 = o1 * inv * __uint_as_float(zz & 0xffff0000u);
        *(unsigned*)(Y + m * 2048 + h * 128 + 2 * lane) = (unsigned)f2bf(o0) | ((unsigned)f2bf(o1) << 16);
        __syncthreads();
    }
}
__global__ void k_moba_naive(const bf16_t* __restrict__ QB, const bf16_t* __restrict__ KB, const bf16_t* __restrict__ VB, const bf16_t* __restrict__ SZB,
                             const float* __restrict__ KMEAN, bf16_t* __restrict__ Y) {
    const int t = blockIdx.x, b = blockIdx.y, tid = threadIdx.x, lane = tid & 63, w = tid >> 6; const size_t m = (size_t)b * SEQ + t;
    __shared__ float qs[8][128]; __shared__ float sc[4][SEQ];
    for (int i = tid; i < 1024; i += 256) qs[i >> 7][i & 127] = bf2f(QB[HM(b, i >> 7, t, i & 127)]);
    __syncthreads();
    const int qblk = t >> 8;
    for (int hh = 0; hh < 2; ++hh) {
        const int h = w + 4 * hh; const float slope = exp2f(-(float)(h + 1));
        float g = -INFINITY;
        if (lane < qblk) { const float* km = KMEAN + ((size_t)(b * NBLK + lane) * NH + h) * HD; float dot = 0.f; for (int d = 0; d < 128; ++d) dot += qs[h][d] * km[d]; g = dot; }
        int rank = 0;
        for (int n2 = 0; n2 < NBLK; ++n2) { const float g2 = __shfl(g, n2); if (n2 < qblk && (g2 > g || (g2 == g && n2 < lane))) ++rank; }
        const bool sel = (lane < qblk) && (rank < 3);
        const unsigned selmask = (unsigned)(__ballot(sel) & 0xffull);
        float mx = -INFINITY;
        for (int s = lane; s <= t; s += 64) { const int blk = s >> 8; float v = -INFINITY;
            if (blk == qblk || ((selmask >> blk) & 1u)) { const bf16_t* kp = KB + HM(b, h, s, 0); float dot = 0.f;
                for (int d = 0; d < 128; ++d) dot += qs[h][d] * bf2f(kp[d]);
                v = dot * QK_SCALE - slope * (float)(t - s); }
            sc[w][s] = v; mx = fmaxf(mx, v); }
        mx = wave_max(mx);
        float sum = 0.f;
        for (int s = lane; s <= t; s += 64) { const float v = sc[w][s]; const float pv = (v == -INFINITY) ? 0.f : __expf(v - mx); sc[w][s] = pv; sum += pv; }
        sum = wave_sum(sum);
        __syncthreads();
        float o0 = 0.f, o1 = 0.f;
        for (int s = 0; s <= t; ++s) { const float pj = sc[w][s]; if (pj == 0.f) continue; const unsigned vv = *(const unsigned*)(VB + HM(b, h, s, 2 * lane));
            o0 += pj * __uint_as_float(vv << 16); o1 += pj * __uint_as_float(vv & 0xffff0000u); }
        const float inv = 1.f / sum;
        const unsigned zz = *(const unsigned*)(SZB + HM(b, h, t, 2 * lane));
        o0 = o0 * inv * __uint_as_float(zz << 16); o1 = o1 * inv * __uint_as_float(zz & 0xffff0000u);
        *(unsigned*)(Y + m * 2048 + 1024 + h * 128 + 2 * lane) = (unsigned)f2bf(o0) | ((unsigned)f2bf(o1) << 16);
        __syncthreads();
    }
}

namespace pg8 {
#define PG8_LAS __attribute__((address_space(3)))
typedef unsigned short bf16_t;
typedef short bf16x8 __attribute__((ext_vector_type(8)));
typedef float f32x4 __attribute__((ext_vector_type(4)));
typedef unsigned u32x4 __attribute__((ext_vector_type(4)));
constexpr int BM = 256, BK = 64, HALF = 128, HTB = HALF * BK * 2  , STAGE_BYTES = 8 * HTB, NXCD = 8, WGM = 8;

__host__ __device__ __forceinline__ int lds_byte(int r, int c) { const int st = (r >> 4) * 2 + (c >> 5), rr = r & 15, cc = c & 31, ob = rr * 64 + cc * 2; return st * 1024 + (ob ^ (((ob >> 9) & 1) << 5)); }
__host__ __device__ __forceinline__ void stage_rc(int b, int& R, int& C) { const int st = b / 1024, sb = b % 1024, swz = sb ^ (((sb >> 9) & 1) << 5); R = (st >> 1) * 16 + swz / 64; C = (st & 1) * 32 + (swz % 64) / 2; }
__host__ __device__ __forceinline__ int perm32(int rho) { const int n = rho >> 4, i = rho & 15; return 8 * (i >> 2) + 4 * n + (i & 3); }

struct Unit { int pm, pn; };
struct Gemm { const void* A; const void* Bt; int M, N, K; };

struct StaticOrder {
    int nM, nN, nwg, G, c;
    __host__ __device__ void init(int M, int N, int G_, int c_) { nM = M / BM; nN = N / BM; nwg = nM * nN; G = G_; c = c_; }
    __host__ __device__ bool next(int i, Unit& u) const {
        const long L = (long)i * G + c; if (L >= nwg) return false;
        int wgid = (int)L; { const int q = nwg / NXCD, r = nwg % NXCD, xcd = wgid % NXCD, off = wgid / NXCD; wgid = (xcd < r ? xcd * (q + 1) : r * (q + 1) + (xcd - r) * q) + off; }
        const int nig = WGM * nN, gid = wgid / nig, fm = gid * WGM, gsz = (nM - fm) < WGM ? (nM - fm) : WGM;
        u.pm = fm + ((wgid % nig) % gsz); u.pn = (wgid % nig) / gsz; return true;
    }
    __device__ __forceinline__ void a_ready(const Unit&) const {}
    __device__ __forceinline__ void done(const Unit&) const {}
};

template <class Epi, class Sched, bool ALIGN_EPI = false, bool SP2 = false, bool FP8 = false>
__device__ __forceinline__ void gemm_phase(PG8_LAS unsigned char* lds, const Gemm g, const Sched& S, const Epi& E) {
    const int tid = threadIdx.x, wid = __builtin_amdgcn_readfirstlane(tid >> 6), lane = tid & 63, wr = wid >> 2, wc = wid & 3, fr = lane & 15, fq = lane >> 4;
    const int K = FP8 ? g.K / 2 : g.K, nt = K / BK;
    typedef int i32x8 __attribute__((ext_vector_type(8))); typedef int i32x4v __attribute__((ext_vector_type(4)));
    unsigned voffA[2], voffB[2];
#pragma unroll
    for (int i = 0; i < 2; ++i) { int R, C; stage_rc(tid * 16 + i * 8192, R, C); const int Rb = Epi::PERM ? ((R & ~31) + perm32(R & 31)) : R;
        voffA[i] = (unsigned)(R * K + C) * 2u; voffB[i] = (unsigned)(Rb * K + C) * 2u; }
    const size_t kstep = (size_t)(BK * 2);
    const size_t hstep = (size_t)HALF * K * 2;
    const size_t tstep = 2 * hstep;
    const unsigned ldsw = (unsigned)wid * 1024u;
    const int aoff = lds_byte(wr * 64 + fr, fq * 8), boff = lds_byte(wc * 32 + fr, fq * 8);
#define PG8_SA(b, h) (((b) * 2 + (h)) * HTB)
#define PG8_SB(b, h) ((4 + (b) * 2 + (h)) * HTB)
#define PG8_STAGE(bufoff, gbase, voff) do { _Pragma("unroll") for (int _i = 0; _i < 2; ++_i) \
        __builtin_amdgcn_global_load_lds((const unsigned*)((const char*)(gbase) + (voff)[_i]), (PG8_LAS unsigned*)(lds + (bufoff) + ldsw + _i * 8192), 16, 0, 0); } while (0)
#define PG8_LDA(dst, b, h) do { _Pragma("unroll") for (int m = 0; m < 4; ++m) { dst[m].lo = *(const PG8_LAS i32x4v*)(lds + PG8_SA(b, h) + aoff + m * 2048); dst[m].hi = *(const PG8_LAS i32x4v*)(lds + PG8_SA(b, h) + aoff + m * 2048 + 1024); } } while (0)
#define PG8_LDB(dst, b, h) do { _Pragma("unroll") for (int n = 0; n < 2; ++n) { dst[n].lo = *(const PG8_LAS i32x4v*)(lds + PG8_SB(b, h) + boff + n * 2048); dst[n].hi = *(const PG8_LAS i32x4v*)(lds + PG8_SB(b, h) + boff + n * 2048 + 1024); } } while (0)
#define PG8_MMA(ai, bj, At, Bt) do { __builtin_amdgcn_s_setprio(1); \
        if constexpr (FP8) { _Pragma("unroll") for (int m = 0; m < 4; ++m) _Pragma("unroll") for (int n = 0; n < 2; ++n) \
            asm volatile("v_mfma_f32_16x16x128_f8f6f4 %0, %1, %2, %0" : "+v"(acc[ai][bj][m][n]) : "v"(Bt[n]), "v"(At[m])); }   \
        else { _Pragma("unroll") for (int m = 0; m < 4; ++m) _Pragma("unroll") for (int n = 0; n < 2; ++n) { \
            const i32x4v bl_ = Bt[n].lo, bh_ = Bt[n].hi, al_ = At[m].lo, ah_ = At[m].hi;     \
            acc[ai][bj][m][n] = __builtin_amdgcn_mfma_f32_16x16x32_bf16(__builtin_bit_cast(bf16x8, bl_), __builtin_bit_cast(bf16x8, al_), acc[ai][bj][m][n], 0, 0, 0); \
            acc[ai][bj][m][n] = __builtin_amdgcn_mfma_f32_16x16x32_bf16(__builtin_bit_cast(bf16x8, bh_), __builtin_bit_cast(bf16x8, ah_), acc[ai][bj][m][n], 0, 0, 0); } } \
        __builtin_amdgcn_s_setprio(0); } while (0)
#define PG8_WAIT_V(n) asm volatile("s_waitcnt vmcnt(" #n ")" ::: "memory")
#define PG8_WAIT_L(n) asm volatile("s_waitcnt lgkmcnt(" #n ")" ::: "memory")
#define PG8_BAR __builtin_amdgcn_s_barrier()
#define PG8_SCHED __builtin_amdgcn_sched_barrier(0)
    Unit cur, nxt; int ui = 0;
    if (!S.next(0, cur)) return;
    f32x4 acc[2][2][4][2];
#pragma unroll
    for (int a = 0; a < 2; ++a)
#pragma unroll
        for (int b = 0; b < 2; ++b)
#pragma unroll
            for (int m = 0; m < 4; ++m)
#pragma unroll
                for (int n = 0; n < 2; ++n) acc[a][b][m][n] = (f32x4){0.f, 0.f, 0.f, 0.f};
    i32x8 At[4], B0[2], B1[2];
    const char* cA = (const char*)g.A + (size_t)cur.pm * tstep; const char* cB = (const char*)g.Bt + (size_t)cur.pn * tstep;
    S.a_ready(cur);
    if constexpr (SP2) {
        PG8_STAGE(PG8_SB(0, 0), cB, voffB); PG8_STAGE(PG8_SB(0, 1), cB + hstep, voffB); PG8_STAGE(PG8_SA(0, 0), cA, voffA); PG8_STAGE(PG8_SA(0, 1), cA + hstep, voffA);
        if (wr == 1) PG8_BAR;
        PG8_WAIT_V(2); PG8_BAR;
        PG8_STAGE(PG8_SB(1, 0), cB + kstep, voffB); PG8_STAGE(PG8_SA(1, 0), cA + kstep, voffA); PG8_STAGE(PG8_SB(1, 1), cB + hstep + kstep, voffB);
        PG8_WAIT_V(6); PG8_BAR;
    } else {
        PG8_STAGE(PG8_SB(0, 0), cB, voffB); PG8_STAGE(PG8_SA(0, 0), cA, voffA); PG8_STAGE(PG8_SB(0, 1), cB + hstep, voffB); PG8_STAGE(PG8_SA(0, 1), cA + hstep, voffA);
        if (wr == 1) PG8_BAR;
        PG8_WAIT_V(4); PG8_BAR;
        PG8_STAGE(PG8_SB(1, 0), cB + kstep, voffB); PG8_STAGE(PG8_SA(1, 0), cA + kstep, voffA); PG8_STAGE(PG8_SB(1, 1), cB + hstep + kstep, voffB);
        PG8_WAIT_V(6); PG8_BAR;
    }
    for (;;) {
        const bool has_next = S.next(ui + 1, nxt);
        const char* nA = has_next ? (const char*)g.A + (size_t)nxt.pm * tstep : cA; const char* nB = has_next ? (const char*)g.Bt + (size_t)nxt.pn * tstep : cB;
        for (int t = 0; t < nt; t += 2) {
            const bool last = (t == nt - 2);
            const char* a1 = cA + (size_t)(t + 1) * kstep;
            const char* a2 = last ? nA : cA + (size_t)(t + 2) * kstep; const char* b2 = last ? nB : cB + (size_t)(t + 2) * kstep;
            const char* a3 = a2 + kstep; const char* b3 = b2 + kstep;
            if (last && has_next) S.a_ready(nxt);
            if constexpr (SP2) {
            PG8_LDB(B0, 0, 0); PG8_LDB(B1, 0, 1); PG8_SCHED; PG8_LDA(At, 0, 0); PG8_STAGE(PG8_SA(1, 1), a1 + hstep, voffA);
            PG8_WAIT_V(8); PG8_WAIT_L(0); PG8_BAR; PG8_MMA(0, 0, At, B0); PG8_MMA(0, 1, At, B1); PG8_BAR; PG8_SCHED;
            PG8_LDA(At, 0, 1); PG8_STAGE(PG8_SB(0, 0), b2, voffB); PG8_STAGE(PG8_SB(0, 1), b2 + hstep, voffB); PG8_STAGE(PG8_SA(0, 0), a2, voffA);
            PG8_WAIT_V(8); PG8_WAIT_L(0); PG8_BAR; PG8_MMA(1, 0, At, B0); PG8_MMA(1, 1, At, B1); PG8_BAR; PG8_SCHED;
            PG8_LDB(B0, 1, 0); PG8_LDB(B1, 1, 1); PG8_SCHED; PG8_LDA(At, 1, 0); PG8_STAGE(PG8_SA(0, 1), a2 + hstep, voffA);
            PG8_WAIT_V(8); PG8_WAIT_L(0); PG8_BAR; PG8_MMA(0, 0, At, B0); PG8_MMA(0, 1, At, B1); PG8_BAR; PG8_SCHED;
            PG8_LDA(At, 1, 1); PG8_STAGE(PG8_SB(1, 0), b3, voffB); PG8_STAGE(PG8_SB(1, 1), b3 + hstep, voffB); PG8_STAGE(PG8_SA(1, 0), a3, voffA);
            PG8_WAIT_V(8); PG8_WAIT_L(0); PG8_BAR; PG8_MMA(1, 0, At, B0); PG8_MMA(1, 1, At, B1); PG8_BAR; PG8_SCHED;
            } else {
            PG8_LDB(B0, 0, 0); PG8_SCHED; PG8_LDA(At, 0, 0); PG8_STAGE(PG8_SA(1, 1), a1 + hstep, voffA);
            PG8_WAIT_L(8); PG8_BAR; PG8_WAIT_L(0); PG8_MMA(0, 0, At, B0); PG8_BAR; PG8_SCHED;
            PG8_LDB(B1, 0, 1); PG8_STAGE(PG8_SB(0, 0), b2, voffB);
            PG8_BAR; PG8_WAIT_L(0); PG8_MMA(0, 1, At, B1); PG8_BAR;
            PG8_LDA(At, 0, 1); PG8_STAGE(PG8_SA(0, 0), a2, voffA);
            PG8_BAR; PG8_WAIT_L(0); PG8_MMA(1, 0, At, B0); PG8_BAR; PG8_SCHED;
            PG8_STAGE(PG8_SB(0, 1), b2 + hstep, voffB);
            PG8_WAIT_V(6); PG8_BAR; PG8_MMA(1, 1, At, B1); PG8_BAR;
            PG8_LDB(B0, 1, 0); PG8_SCHED; PG8_LDA(At, 1, 0); PG8_STAGE(PG8_SA(0, 1), a2 + hstep, voffA);
            PG8_WAIT_L(8); PG8_BAR; PG8_WAIT_L(0); PG8_MMA(0, 0, At, B0); PG8_BAR; PG8_SCHED;
            PG8_LDB(B1, 1, 1); PG8_STAGE(PG8_SB(1, 0), b3, voffB);
            PG8_BAR; PG8_WAIT_L(0); PG8_MMA(0, 1, At, B1); PG8_BAR;
            PG8_LDA(At, 1, 1); PG8_STAGE(PG8_SA(1, 0), a3, voffA);
            PG8_BAR; PG8_WAIT_L(0); PG8_MMA(1, 0, At, B0); PG8_BAR; PG8_SCHED;
            PG8_STAGE(PG8_SB(1, 1), b3 + hstep, voffB);
            PG8_WAIT_V(6); PG8_BAR; PG8_MMA(1, 1, At, B1); PG8_BAR;
            }
        }
        if constexpr (ALIGN_EPI) { if (wr == 0) PG8_BAR; }
        if constexpr (FP8) asm volatile("s_nop 15\n\ts_nop 15" ::: "memory");
        PG8_SCHED;
        if constexpr (!Epi::AFTER_DRAIN) { E(acc, cur, wr, wc, fr, fq); S.done(cur); }
        PG8_SCHED;
        if (!has_next) break;
#pragma unroll
        for (int a = 0; a < 2; ++a)
#pragma unroll
            for (int b = 0; b < 2; ++b)
#pragma unroll
                for (int m = 0; m < 4; ++m)
#pragma unroll
                    for (int n = 0; n < 2; ++n) acc[a][b][m][n] = (f32x4){0.f, 0.f, 0.f, 0.f};
        cur = nxt; cA = nA; cB = nB; ++ui;
        if constexpr (ALIGN_EPI) { if (wr == 1) PG8_BAR; }
    }
    PG8_WAIT_V(0);
    if constexpr (!ALIGN_EPI) { if (wr == 0) PG8_BAR; }
    PG8_BAR;
    if constexpr (Epi::AFTER_DRAIN) { E.fused(acc, cur, wr, wc, fr, fq, lds, wid, lane); S.done(cur); }
#undef PG8_SA
#undef PG8_SB
#undef PG8_STAGE
#undef PG8_LDA
#undef PG8_LDB
#undef PG8_MMA
#undef PG8_WAIT_V
#undef PG8_WAIT_L
#undef PG8_BAR
#undef PG8_SCHED
}
}

#define GAS __attribute__((address_space(1)))
#define LAS __attribute__((address_space(3)))
typedef unsigned v4u __attribute__((ext_vector_type(4)));
typedef float f32x4 __attribute__((ext_vector_type(4)));
typedef GAS unsigned gu32;
#define RLX_AGENT __ATOMIC_RELAXED, __HIP_MEMORY_SCOPE_AGENT
#define LDS_WAIT() asm volatile("s_waitcnt lgkmcnt(0)" ::: "memory")
#define VM_WAIT() asm volatile("s_waitcnt vmcnt(0)" ::: "memory")
constexpr int NWAVES = 8;
constexpr int NPAD = 9472;
constexpr size_t MiB = 1u << 20;
constexpr size_t WS_CTL = 0, CTL_ZERO_BYTES = 1 * MiB;
constexpr size_t WS_MOD = 1 * MiB;
constexpr size_t WS_GAIN = 1 * MiB + 256 * 1024;
constexpr size_t WS_KMEAN = 1 * MiB + 512 * 1024;
constexpr size_t WS_WI = 2 * MiB;
constexpr size_t WS_KI = 3 * MiB;
constexpr size_t WS_MASK = 5 * MiB;
constexpr size_t WS_WOUT = 10 * MiB;
constexpr size_t WS_WIN = 18 * MiB;
constexpr size_t WS_HB = 56 * MiB;
constexpr size_t WS_Y = 56 * MiB;
constexpr size_t WS_QA = 120 * MiB, WS_KA = 152 * MiB, WS_VA = 184 * MiB, WS_SZA = 216 * MiB;
constexpr size_t WS_QB = 248 * MiB, WS_KB = 280 * MiB, WS_VB = 312 * MiB, WS_SZB = 344 * MiB;
constexpr size_t WS_QI = 376 * MiB;
constexpr size_t WS_T32 = 408 * MiB;
constexpr size_t WS_Y8 = 408 * MiB;
constexpr size_t WS_HB8 = 440 * MiB;
constexpr size_t WS_WIN8 = 472 * MiB;
constexpr size_t WS_WOUT8 = 492 * MiB;
constexpr size_t WS_END = 496 * MiB;
constexpr float FP8_DESCALE = 1.f / 512.f;
constexpr int CW_BAR = 4096;
constexpr int RING_BYTES = 131072;
constexpr int EPI_OFF = RING_BYTES;
constexpr int LDSCTL_OFF = EPI_OFF + 16384, MISC_OFF = LDSCTL_OFF + 320;
constexpr int LDS_BYTES = 163840;

#define XB_TMO      128
#define XB_XCNT(j)  (256  + 64 * (j))
#define XB_XSUB(j)  (1280 + 64 * (j))
#define XB_XGEN(j)  (2304 + 64 * (j))
#define XB_TOP      3328
#define XB_TOPGEN   3392
#define XCD_BAR_WORDS 3456
#define XB_SPIN_CAP (1u << 18)

__device__ __forceinline__ unsigned xb_ld(unsigned* p)              { return __hip_atomic_load(p, __ATOMIC_RELAXED, __HIP_MEMORY_SCOPE_AGENT); }
__device__ __forceinline__ unsigned xb_add(unsigned* p, unsigned v) { return __hip_atomic_fetch_add(p, v, __ATOMIC_RELAXED, __HIP_MEMORY_SCOPE_AGENT); }
__device__ __forceinline__ unsigned xb_xcc_id() { return (unsigned)__builtin_amdgcn_s_getreg((3 << 11) | 20) & 0xFu; }
#define XB_SPIN(cond, bar) do { unsigned _sp = 0; while (cond) { __builtin_amdgcn_s_sleep(1); \
    if ((++_sp & 255u) == 0u) { if (xb_ld(&(bar)[XB_TMO])) break; if (_sp > XB_SPIN_CAP) { atomicAdd(&(bar)[XB_TMO], 1u); break; } } } } while (0)

struct XcdBarrier {
    unsigned* bar; unsigned x;
    volatile LAS unsigned* st;
};

__device__ __forceinline__ XcdBarrier xcd_barrier_post(unsigned* bar, volatile LAS unsigned* st) {
    XcdBarrier b; b.bar = bar; b.x = xb_xcc_id(); b.st = st;
    if (threadIdx.x == 0) (void)xb_add(&bar[XB_XCNT(b.x)], 1u);
    return b;
}
__device__ __forceinline__ void xcd_barrier_complete(unsigned* bar, unsigned x, unsigned& nloc, unsigned& nx) {
    const unsigned G = gridDim.x * gridDim.y * gridDim.z;
    unsigned sum, cnt, mine, sp = 0u;
    for (;;) {
        sum = 0u; cnt = 0u; mine = 0u;
#pragma unroll
        for (unsigned j = 0; j < 16; ++j) { const unsigned c = xb_ld(&bar[XB_XCNT(j)]); sum += c; cnt += (c > 0u) ? 1u : 0u; mine = (j == x) ? c : mine; }
        if (sum == G) break;
        __builtin_amdgcn_s_sleep(1);
        if ((++sp & 255u) == 0u) { if (xb_ld(&bar[XB_TMO])) break; if (sp > XB_SPIN_CAP) { atomicAdd(&bar[XB_TMO], 1u); break; } }
    }
    nloc = mine > 0u ? mine : 1u; nx = cnt > 0u ? cnt : 1u;
}

__device__ __forceinline__ void xcd_barrier(const XcdBarrier& b) {
    asm volatile("s_waitcnt vmcnt(0)" ::: "memory");
    __syncthreads();
    if (threadIdx.x == 0) {
        unsigned* bar = b.bar;
        __builtin_amdgcn_s_waitcnt(0);
        unsigned nloc = b.st[0], nx = b.st[1];
        if (nloc == 0u) { xcd_barrier_complete(bar, b.x, nloc, nx); b.st[0] = nloc; b.st[1] = nx; }
        const unsigned old = xb_add(&bar[XB_XSUB(b.x)], 1u);
        const unsigned gen = old / nloc;
        if (old + 1u == (gen + 1u) * nloc) {
            __builtin_amdgcn_fence(__ATOMIC_RELEASE, "agent");
            asm volatile("s_waitcnt vmcnt(0)" ::: "memory");
            const unsigned og = xb_add(&bar[XB_TOP], 1u);
            const unsigned tg = og / nx;
            if (og + 1u == (tg + 1u) * nx) xb_add(&bar[XB_TOPGEN], 1u);
            else XB_SPIN(xb_ld(&bar[XB_TOPGEN]) == tg, bar);
            __builtin_amdgcn_fence(__ATOMIC_ACQUIRE, "agent");
            xb_add(&bar[XB_XGEN(b.x)], 1u);
            asm volatile("s_waitcnt vmcnt(0)" ::: "memory");
        } else {
            XB_SPIN(xb_ld(&bar[XB_XGEN(b.x)]) == gen, bar);
            __builtin_amdgcn_fence(__ATOMIC_ACQUIRE, "agent");
            asm volatile("s_waitcnt vmcnt(0)" ::: "memory");
        }
    }
    __syncthreads();
}


struct Frame {
    LAS unsigned char* lds; volatile LAS unsigned* MISC; gu32* ctl; int tid, lane, wave, vcu, G;
};
__device__ __forceinline__ unsigned cvt_pk_bf16(float lo, float hi) { unsigned r; asm volatile("v_cvt_pk_bf16_f32 %0, %1, %2" : "=v"(r) : "v"(lo), "v"(hi)); return r; }
__device__ __forceinline__ unsigned f2bf_u(float f) { unsigned u = __builtin_bit_cast(unsigned, f); return (u + 0x7fffu + ((u >> 16) & 1u)) >> 16; }
__device__ __forceinline__ unsigned pk2(float lo, float hi) { return f2bf_u(lo) | (f2bf_u(hi) << 16); }
__device__ __forceinline__ float fast_silu(float v) { return v * __builtin_amdgcn_rcpf(1.f + __expf(-v)); }

__device__ __forceinline__ void p0_mod(Frame& F, int id, const float* __restrict__ c, const float* __restrict__ w_ada, const float* __restrict__ b_ada, float* __restrict__ MOD) {
    LAS float* sc = (LAS float*)(F.lds);
    LAS float* red = (LAS float*)(F.lds + 65536);
    for (int i = F.tid; i < BATCH * DM; i += NWAVES * 64) sc[i] = silu_f(c[i]);
    __syncthreads();
    const int cq = F.tid & 7, kq = F.tid >> 3, col0 = 32 * id + 4 * cq;
    f32x4 acc[8];
#pragma unroll
    for (int b = 0; b < 8; ++b) acc[b] = (f32x4){0.f, 0.f, 0.f, 0.f};
#pragma unroll 4
    for (int i = 0; i < 32; ++i) { const int k = kq + 64 * i; const f32x4 w = *(const f32x4*)(w_ada + (size_t)k * (3 * DM) + col0);
#pragma unroll
        for (int b = 0; b < 8; ++b) acc[b] += w * sc[b * DM + k]; }
#pragma unroll
    for (int b = 0; b < 8; ++b) *(LAS f32x4*)(red + (kq * 8 + b) * 32 + 4 * cq) = acc[b];
    __syncthreads();
    if (F.tid < 256) { const int b = F.tid >> 5, cc = F.tid & 31; float s = 0.f;
        for (int q = 0; q < 64; ++q) s += red[(q * 8 + b) * 32 + cc];
        MOD[b * 3 * DM + 32 * id + cc] = s + b_ada[32 * id + cc]; }
    __syncthreads();
}
__device__ __forceinline__ unsigned pk4_fp8(float a, float b, float c, float d) {
    a = fminf(fmaxf(a, -448.f), 448.f); b = fminf(fmaxf(b, -448.f), 448.f); c = fminf(fmaxf(c, -448.f), 448.f); d = fminf(fmaxf(d, -448.f), 448.f);
    int w = 0; w = __builtin_amdgcn_cvt_pk_fp8_f32(a, b, w, false); w = __builtin_amdgcn_cvt_pk_fp8_f32(c, d, w, true); return (unsigned)w; }
template <bool MAPWIN>
__device__ __forceinline__ void p0_transpose_item(const float* __restrict__ W, int K, int N, int NP, bf16_t* __restrict__ WT, unsigned char* __restrict__ WT8, LAS float* scr, int item, int lane) {
    const int nblk = NP / 32, kb = item / nblk, nb = item % nblk, k0 = 64 * kb, n0 = 32 * nb;
    const int np = n0 + (lane & 31);
    int src = np; bool valid = true;
    if (MAPWIN) { if (np >= 5376) src = np - 176; else if (np >= 5200) valid = false; }
#pragma unroll 8
    for (int i = 0; i < 32; ++i) { const int kk = 2 * i + (lane >> 5); scr[kk * 33 + (lane & 31)] = valid ? W[(size_t)(k0 + kk) * N + src] : 0.f; }
    LDS_WAIT(); asm volatile("" ::: "memory");
    const int c = lane & 7;
#pragma unroll
    for (int j = 0; j < 4; ++j) { const int n = (lane >> 3) + 8 * j; const LAS float* s = scr + (8 * c) * 33 + n;
        v4u o; o.x = pk2(s[0 * 33], s[1 * 33]); o.y = pk2(s[2 * 33], s[3 * 33]); o.z = pk2(s[4 * 33], s[5 * 33]); o.w = pk2(s[6 * 33], s[7 * 33]);
        *(GAS v4u*)(WT + (size_t)(n0 + n) * K + k0 + 8 * c) = o; }
    if (WT8) {
#pragma unroll
        for (int jj = 0; jj < 2; ++jj) { const int idx = lane + 64 * jj, n = idx >> 2, c4 = idx & 3; const LAS float* s = scr + (16 * c4) * 33 + n;
            v4u o; o.x = pk4_fp8(s[0 * 33] * 64.f, s[1 * 33] * 64.f, s[2 * 33] * 64.f, s[3 * 33] * 64.f); o.y = pk4_fp8(s[4 * 33] * 64.f, s[5 * 33] * 64.f, s[6 * 33] * 64.f, s[7 * 33] * 64.f);
            o.z = pk4_fp8(s[8 * 33] * 64.f, s[9 * 33] * 64.f, s[10 * 33] * 64.f, s[11 * 33] * 64.f); o.w = pk4_fp8(s[12 * 33] * 64.f, s[13 * 33] * 64.f, s[14 * 33] * 64.f, s[15 * 33] * 64.f);
            *(GAS v4u*)(WT8 + (size_t)(n0 + n) * K + k0 + 16 * c4) = o; } }
    LDS_WAIT(); asm volatile("" ::: "memory");
}
__device__ __forceinline__ void p0_convert(Frame& F, const float* __restrict__ w_in, const float* __restrict__ w_out, bf16_t* __restrict__ WinT, bf16_t* __restrict__ WoutT, unsigned char* __restrict__ WoutT8) {
    LAS float* scr = (LAS float*)(F.lds + F.wave * 16384);
    const int gw = F.vcu * NWAVES + F.wave, NGW = F.G * NWAVES;
    constexpr int I_IN = (DM / 64) * (NPAD / 32), I_OUT = (DM / 64) * (DM / 32);
    for (int it = gw; it < I_IN + I_OUT; it += NGW) {
        if (it < I_IN) p0_transpose_item<true>(w_in, DM, DIN, NPAD, WinT, nullptr, scr, it, F.lane);
        else p0_transpose_item<false>(w_out, DM, DM, DM, WoutT, WoutT8, scr, it - I_IN, F.lane);
    }
}
__device__ __forceinline__ void p1_norm(Frame& F, const float* __restrict__ x, const float* __restrict__ g, const float* __restrict__ MOD, bf16_t* __restrict__ HB) {
    for (int v = F.vcu; v < M / 64; v += F.G) {
        const int b = v / (SEQ / 64);
        const float* shift = MOD + b * 3 * DM; const float* scale = shift + DM;
        f32x4 gs[8], sh[8];
#pragma unroll
        for (int j = 0; j < 8; ++j) { const int k = 4 * F.lane + 256 * j; const f32x4 gg = *(const f32x4*)(g + k), ss = *(const f32x4*)(scale + k); gs[j] = gg * (ss + 1.0f); sh[j] = *(const f32x4*)(shift + k); }
        for (int r = 0; r < 8; ++r) {
            const int row = 64 * v + 8 * F.wave + r;
            const f32x4* xr = (const f32x4*)(x + (size_t)row * DM) + F.lane;
            f32x4 xv[8]; float ss = 0.f;
#pragma unroll
            for (int j = 0; j < 8; ++j) { xv[j] = xr[64 * j]; ss += (xv[j].x * xv[j].x + xv[j].y * xv[j].y) + (xv[j].z * xv[j].z + xv[j].w * xv[j].w); }
            ss = wave_sum(ss);
            const float rstd = rsqrtf(ss * (1.f / DM) + RMS_EPS);
            unsigned long long* o8 = (unsigned long long*)(HB + (size_t)row * DM) + F.lane;
#pragma unroll
            for (int j = 0; j < 8; ++j) { const f32x4 h = xv[j] * rstd * gs[j] + sh[j];
                o8[64 * j] = (unsigned long long)pk2(h.x, h.y) | ((unsigned long long)pk2(h.z, h.w) << 32); }
        }
    }
}
struct EpiProj {
    static constexpr bool PERM = true, AFTER_DRAIN = false;
    unsigned char* ws;
    LAS float* P;
    __device__ __forceinline__ void operator()(const pg8::f32x4 (&acc)[2][2][4][2], const pg8::Unit& u, int wr, int wc, int fr, int fq) const {
        { int l_ = threadIdx.x & 63; asm volatile("" : "+v"(l_)); fr = l_ & 15; fq = l_ >> 4; }
        const int pn = u.pn;
        bf16_t* const KI = (bf16_t*)(ws + WS_KI); float* const WI = (float*)(ws + WS_WI); bf16_t* const QI = (bf16_t*)(ws + WS_QI);
        int grp, sub;
        if (pn < 20) { grp = pn >> 2; sub = pn & 3; } else if (pn == 20) { grp = 5; sub = 0; } else { grp = 6 + ((pn - 21) >> 2); sub = (pn - 21) & 3; }
        const int b = u.pm >> 3, t0 = (u.pm & 7) * 256 + wr * 64 + fr;
        const int cl = 32 * wc + 8 * fq;
        const bool norm = (grp == 0 || grp == 1 || grp == 6 || grp == 7 || grp == 5);
        float rs[2][4][2];
        if (norm) {
#pragma unroll
            for (int ai = 0; ai < 2; ++ai)
#pragma unroll
                for (int m = 0; m < 4; ++m)
#pragma unroll
                    for (int bj = 0; bj < 2; ++bj) { const pg8::f32x4 a = acc[ai][bj][m][0], c = acc[ai][bj][m][1];
                        float s = (a[0] * a[0] + a[1] * a[1]) + (a[2] * a[2] + a[3] * a[3]) + (c[0] * c[0] + c[1] * c[1]) + (c[2] * c[2] + c[3] * c[3]);
                        s += __shfl_xor(s, 16); s += __shfl_xor(s, 32);
                        if (fq == 0) P[((ai * 128 + wr * 64 + m * 16 + fr) * 2 + bj) * 4 + wc] = s; }
            asm volatile("s_waitcnt lgkmcnt(0)" ::: "memory"); __builtin_amdgcn_s_barrier(); asm volatile("" ::: "memory");
#pragma unroll
            for (int ai = 0; ai < 2; ++ai)
#pragma unroll
                for (int m = 0; m < 4; ++m)
#pragma unroll
                    for (int bj = 0; bj < 2; ++bj) { const pg8::f32x4 q = *(const LAS pg8::f32x4*)(P + ((ai * 128 + wr * 64 + m * 16 + fr) * 2 + bj) * 4);
                        rs[ai][m][bj] = (grp == 5) ? rsqrtf((q[0] + q[1]) * (1.f / 64.f) + RMS_EPS) : rsqrtf(((q[0] + q[1]) + (q[2] + q[3])) * (1.f / 128.f) + RMS_EPS); }
        }
        if (grp == 5) {
            if (wc < 2) { const float* gki = (const float*)(ws + WS_GAIN) + 4 * 128; const pg8::f32x4 g0 = *(const pg8::f32x4*)(gki + cl), g1 = *(const pg8::f32x4*)(gki + cl + 4);
#pragma unroll
                for (int ai = 0; ai < 2; ++ai)
#pragma unroll
                    for (int m = 0; m < 4; ++m) { const size_t row = (size_t)b * SEQ + t0 + 128 * ai + 16 * m; const float r = rs[ai][m][0];
                        const pg8::f32x4 v0 = acc[ai][0][m][0] * r * g0, v1 = acc[ai][0][m][1] * r * g1;
                        pg8::u32x4 w; w.x = cvt_pk_bf16(v0[0], v0[1]); w.y = cvt_pk_bf16(v0[2], v0[3]); w.z = cvt_pk_bf16(v1[0], v1[1]); w.w = cvt_pk_bf16(v1[2], v1[3]);
                        *(pg8::u32x4*)(KI + row * 64 + cl) = w; } }
            else if (wc == 2 && fq < 2) {
#pragma unroll
                for (int ai = 0; ai < 2; ++ai)
#pragma unroll
                    for (int m = 0; m < 4; ++m) { const size_t row = (size_t)b * SEQ + t0 + 128 * ai + 16 * m;
                        *(pg8::f32x4*)(WI + row * 16 + 8 * fq) = acc[ai][0][m][0]; *(pg8::f32x4*)(WI + row * 16 + 8 * fq + 4) = acc[ai][0][m][1]; } }
            return;
        }
        if (grp == 4) {
#pragma unroll
            for (int ai = 0; ai < 2; ++ai)
#pragma unroll
                for (int m = 0; m < 4; ++m) { const size_t row = (size_t)b * SEQ + t0 + 128 * ai + 16 * m;
#pragma unroll
                    for (int bj = 0; bj < 2; ++bj) { const pg8::f32x4 v0 = acc[ai][bj][m][0], v1 = acc[ai][bj][m][1];
                        pg8::u32x4 w; w.x = cvt_pk_bf16(v0[0], v0[1]); w.y = cvt_pk_bf16(v0[2], v0[3]); w.z = cvt_pk_bf16(v1[0], v1[1]); w.w = cvt_pk_bf16(v1[2], v1[3]);
                        *(pg8::u32x4*)(QI + row * 1024 + sub * 256 + bj * 128 + cl) = w; } }
            return;
        }
        bf16_t* dst; const float* gain = nullptr;
        { const int slot = grp < 4 ? grp : grp - 2;
          dst = (bf16_t*)(ws + WS_QA + (size_t)slot * (32 * MiB));
          gain = (const float*)(ws + WS_GAIN) + (grp < 2 ? grp : grp - 4) * 128; }
        pg8::f32x4 g0 = {1.f, 1.f, 1.f, 1.f}, g1 = {1.f, 1.f, 1.f, 1.f};
        if (norm) { g0 = *(const pg8::f32x4*)(gain + cl); g1 = *(const pg8::f32x4*)(gain + cl + 4); }
        const bool act = (grp == 3 || grp == 9);
#pragma unroll
        for (int ai = 0; ai < 2; ++ai)
#pragma unroll
            for (int m = 0; m < 4; ++m) { const int t = t0 + 128 * ai + 16 * m;
#pragma unroll
                for (int bj = 0; bj < 2; ++bj) { const int h = 2 * sub + bj;
                    pg8::f32x4 v0 = acc[ai][bj][m][0], v1 = acc[ai][bj][m][1];
                    if (norm) { const float r = rs[ai][m][bj]; v0 = v0 * r * g0; v1 = v1 * r * g1; }
                    if (act) { v0[0] = fast_silu(v0[0]); v0[1] = fast_silu(v0[1]); v0[2] = fast_silu(v0[2]); v0[3] = fast_silu(v0[3]);
                               v1[0] = fast_silu(v1[0]); v1[1] = fast_silu(v1[1]); v1[2] = fast_silu(v1[2]); v1[3] = fast_silu(v1[3]); }
                    pg8::u32x4 w; w.x = cvt_pk_bf16(v0[0], v0[1]); w.y = cvt_pk_bf16(v0[2], v0[3]); w.z = cvt_pk_bf16(v1[0], v1[1]); w.w = cvt_pk_bf16(v1[2], v1[3]);
                    *(pg8::u32x4*)(dst + HM(b, h, t, cl)) = w; } }
    }
};
struct EpiOut {
    static constexpr bool PERM = false, AFTER_DRAIN = false;
    const float* x; const float* MOD; float* out; float oscale;
    __device__ __forceinline__ void operator()(const pg8::f32x4 (&acc)[2][2][4][2], const pg8::Unit& u, int wr, int wc, int fr, int fq) const {
        { int l_ = threadIdx.x & 63; asm volatile("" : "+v"(l_)); fr = l_ & 15; fq = l_ >> 4; }
        const int b = u.pm >> 3; const float* gate = MOD + b * 3 * DM + 2 * DM;
        const int col0 = u.pn * 256 + wc * 32 + 4 * fq;
        pg8::f32x4 gv[2][2];
#pragma unroll
        for (int bj = 0; bj < 2; ++bj)
#pragma unroll
            for (int n = 0; n < 2; ++n) gv[bj][n] = *(const pg8::f32x4*)(gate + col0 + bj * 128 + n * 16) * oscale;
#pragma unroll
        for (int ai = 0; ai < 2; ++ai)
#pragma unroll
            for (int m = 0; m < 4; ++m) { const size_t off = (size_t)(u.pm * 256 + ai * 128 + wr * 64 + m * 16 + fr) * DM + col0;
#pragma unroll
                for (int bj = 0; bj < 2; ++bj)
#pragma unroll
                    for (int n = 0; n < 2; ++n) { const pg8::f32x4 xv = *(const pg8::f32x4*)(x + off + bj * 128 + n * 16);
                        *(pg8::f32x4*)(out + off + bj * 128 + n * 16) = xv + gv[bj][n] * acc[ai][bj][m][n]; }
                if (m & 1) asm volatile("" ::: "memory"); }
    }
};

namespace att {
typedef short bf16x8 __attribute__((ext_vector_type(8)));
typedef short s16x4 __attribute__((ext_vector_type(4)));
typedef float f32x16 __attribute__((ext_vector_type(16)));
typedef float f32x4 __attribute__((ext_vector_type(4)));
typedef unsigned u32x4 __attribute__((ext_vector_type(4)));
constexpr int NW = 8, QBLK = 32, KVBLK = 64, QB = NW * QBLK, D = 128;
constexpr int SHM_V = KVBLK * D * 2, SHM_K = KVBLK * D * 2;
constexpr int LDS_WS = 2 * SHM_V + 2 * SHM_K, LDS_KM = LDS_WS + NW * 64 * 4, LDS_OST = 73728, MST_PITCH = 264, MST_WAVE = QBLK * MST_PITCH, LDS_BYTES = LDS_OST + NW * MST_WAVE;
constexpr float SCALE = 0.08838834764831845f, THR = 8.f;
#define KSWZ(row, colB) ((row) * 256 + ((colB) ^ (((row) & 7) << 4)))
#define SBAR() __builtin_amdgcn_sched_barrier(0)
__device__ __forceinline__ int v_st(int k, int c) { const int kk = (k & ~0xC) | ((k & 4) << 1) | ((k & 8) >> 1); return ((kk >> 3) * 4 + (c >> 5)) * 512 + ((kk & 7) * 32 + (c & 31)) * 2; }
__device__ __forceinline__ int v_rd_base(int lane) { return ((lane & 3) << 3) | (((lane >> 2) & 3) << 6) | (((lane >> 4) & 1) << 5) | (((lane >> 5) & 1) << 8); }
constexpr int v_rd_off(int d0, int ks, int half) { return d0 * 512 + ks * 4096 + half * 2048; }
__device__ __forceinline__ int crow(int r, int hi) { return (r & 3) + 8 * (r >> 2) + 4 * hi; }
__device__ __forceinline__ unsigned cvtpk(float lo, float hi) { unsigned r; asm volatile("v_cvt_pk_bf16_f32 %0, %1, %2" : "=v"(r) : "v"(lo), "v"(hi)); return r; }
__device__ __forceinline__ unsigned cvt1(float v) { unsigned r; asm volatile("v_cvt_pk_bf16_f32 %0, %1, 0" : "=v"(r) : "v"(v)); return r; }
__device__ __forceinline__ bf16x8 load8(const bf16_t* p) { return *reinterpret_cast<const bf16x8*>(p); }
__device__ __forceinline__ void mask_causal(f32x16& p0, f32x16& p1, int dq) {
    const float NEG = -__builtin_inff();
#pragma unroll
    for (int r = 0; r < 16; ++r) { const int c = (r & 3) + 8 * (r >> 2); if (dq - c < 0) p0[r] = NEG; if (dq - c - 32 < 0) p1[r] = NEG; }
}
__device__ __forceinline__ void mask_bits(f32x16& p0, f32x16& p1, unsigned w0, unsigned w1) {
    const unsigned NEGB = 0xff800000u;
#pragma unroll
    for (int r = 0; r < 16; ++r) { const int c = (r & 3) + 8 * (r >> 2);
        const unsigned t0 = (unsigned)(((int)(w0 << (31 - c))) >> 31), t1 = (unsigned)(((int)(w1 << (31 - c))) >> 31);
        p0[r] = __uint_as_float((__float_as_uint(p0[r]) & t0) | (NEGB & ~t0));
        p1[r] = __uint_as_float((__float_as_uint(p1[r]) & t1) | (NEGB & ~t1)); }
}
__device__ __forceinline__ void partialSM(f32x16& p0, f32x16& p1, float& m_reg, float& mn, float& alpha) {
    float pmax = p0[0]; for (int r = 1; r < 16; ++r) pmax = fmaxf(pmax, p0[r]); for (int r = 0; r < 16; ++r) pmax = fmaxf(pmax, p1[r]);
    { auto rr = __builtin_amdgcn_permlane32_swap(__float_as_uint(pmax), __float_as_uint(pmax), false, false);
      pmax = fmaxf(__uint_as_float(rr[0]), __uint_as_float(rr[1])); }
    constexpr float C2 = 1.4426950408889634f * SCALE;
    if (__builtin_expect(__all((pmax - m_reg) * SCALE <= THR), 1)) { mn = m_reg; alpha = 1.f; }
    else { mn = fmaxf(m_reg, pmax); alpha = __builtin_amdgcn_exp2f((m_reg - mn) * C2); m_reg = mn; }
    const float mnL = -mn * C2;
    for (int r = 0; r < 16; ++r) p0[r] = fmaf(p0[r], C2, mnL); for (int r = 0; r < 16; ++r) p1[r] = fmaf(p1[r], C2, mnL);
    for (int r = 0; r < 16; ++r) p0[r] = __builtin_amdgcn_exp2f(p0[r]);
}
__device__ __forceinline__ void finishSM(f32x16& p0, f32x16& p1, float alpha, float& l_reg, bf16x8& pa0, bf16x8& pa1, bf16x8& pa2, bf16x8& pa3) {
    for (int r = 0; r < 16; ++r) p1[r] = __builtin_amdgcn_exp2f(p1[r]);
    float ps = 0; for (int r = 0; r < 16; ++r) ps += p0[r]; for (int r = 0; r < 16; ++r) ps += p1[r];
    { auto rr = __builtin_amdgcn_permlane32_swap(__float_as_uint(ps), __float_as_uint(ps), false, false);
      ps = __uint_as_float(rr[0]) + __uint_as_float(rr[1]); }
    l_reg = l_reg * alpha + ps;
#define PK4(P, B_, OUT) do { unsigned a0 = cvtpk(P[B_+0], P[B_+1]), a1 = cvtpk(P[B_+2], P[B_+3]);                          \
        unsigned b0 = cvtpk(P[B_+4], P[B_+5]), b1 = cvtpk(P[B_+6], P[B_+7]);                                             \
        auto r0 = __builtin_amdgcn_permlane32_swap(a0, b0, false, false); auto r1 = __builtin_amdgcn_permlane32_swap(a1, b1, false, false); \
        u32x4 w = {r0[0], r1[0], r0[1], r1[1]}; OUT = *reinterpret_cast<bf16x8*>(&w); } while (0)
    PK4(p0, 0, pa0); PK4(p0, 8, pa1); PK4(p1, 0, pa2); PK4(p1, 8, pa3);
#undef PK4
}
template <int KB>
__device__ __forceinline__ void qkt(f32x16& p0, f32x16& p1, const char* K_lds, int r32, int hi, const bf16x8* qr, float cb, float sl) {
#pragma unroll
    for (int r = 0; r < 16; ++r) { const int c = (r & 3) + 8 * (r >> 2); p0[r] = fmaf(sl, (float)c, cb); p1[r] = fmaf(sl, (float)(c + 32), cb); }
    const char* kb[4];
#pragma unroll
    for (int dd = 0; dd < 4; ++dd) kb[dd] = K_lds + KB * SHM_K + KSWZ(r32, (dd * 16 + hi * 8) * 2);
#pragma unroll
    for (int d0 = 0; d0 < 8; ++d0) { const char* a = kb[d0 & 3] + (d0 >> 2) * 128;
        bf16x8 b0 = *reinterpret_cast<const bf16x8*>(a);
        bf16x8 b1 = *reinterpret_cast<const bf16x8*>(a + 32 * 256);
        p0 = __builtin_amdgcn_mfma_f32_32x32x16_bf16(b0, qr[d0], p0, 0, 0, 0);
        p1 = __builtin_amdgcn_mfma_f32_32x32x16_bf16(b1, qr[d0], p1, 0, 0, 0); }
}
template <int VB>
__device__ __forceinline__ void pv_tile(f32x16* o, int vb0, bf16x8 pa0, bf16x8 pa1, bf16x8 pa2, bf16x8 pa3) {
#define TRRD(dst, off) asm volatile("ds_read_b64_tr_b16 %0, %1 offset:%2" : "=&v"(dst) : "v"(vb0), "i"(off) : "memory")
#define PV_D0(d0) do { s16x4 l0, l1, l2, l3, h0, h1, h2, h3; constexpr int b_ = VB * SHM_V + v_rd_off(d0, 0, 0); \
        TRRD(l0, b_); TRRD(h0, b_ + 2048); TRRD(l1, b_ + 4096); TRRD(h1, b_ + 6144); TRRD(l2, b_ + 8192); TRRD(h2, b_ + 10240); TRRD(l3, b_ + 12288); TRRD(h3, b_ + 14336); \
        asm volatile("s_waitcnt lgkmcnt(0)" ::: "memory"); SBAR();   \
        o[d0] = __builtin_amdgcn_mfma_f32_32x32x16_bf16(pa0, (bf16x8){l0[0], l0[1], l0[2], l0[3], h0[0], h0[1], h0[2], h0[3]}, o[d0], 0, 0, 0);   \
        o[d0] = __builtin_amdgcn_mfma_f32_32x32x16_bf16(pa1, (bf16x8){l1[0], l1[1], l1[2], l1[3], h1[0], h1[1], h1[2], h1[3]}, o[d0], 0, 0, 0);   \
        o[d0] = __builtin_amdgcn_mfma_f32_32x32x16_bf16(pa2, (bf16x8){l2[0], l2[1], l2[2], l2[3], h2[0], h2[1], h2[2], h2[3]}, o[d0], 0, 0, 0);   \
        o[d0] = __builtin_amdgcn_mfma_f32_32x32x16_bf16(pa3, (bf16x8){l3[0], l3[1], l3[2], l3[3], h3[0], h3[1], h3[2], h3[3]}, o[d0], 0, 0, 0); } while (0)
    PV_D0(0); PV_D0(1); PV_D0(2); PV_D0(3);
#undef PV_D0
#undef TRRD
}

struct BlockRef { int grp, b, h, qb; };
__device__ __forceinline__ size_t hm_off(const BlockRef& r) { return ((size_t)(r.b * NH + r.h) * SEQ) * D; }
__device__ __forceinline__ const bf16_t* ptrQ(unsigned char* wsb, const BlockRef& r) { return (const bf16_t*)(wsb + (r.grp ? WS_QB : WS_QA)) + hm_off(r) + (size_t)r.qb * QB * D; }
__device__ __forceinline__ const bf16_t* ptrK(unsigned char* wsb, const BlockRef& r) { return (const bf16_t*)(wsb + (r.grp ? WS_KB : WS_KA)) + hm_off(r); }
__device__ __forceinline__ const bf16_t* ptrV(unsigned char* wsb, const BlockRef& r) { return (const bf16_t*)(wsb + (r.grp ? WS_VB : WS_VA)) + hm_off(r); }
__device__ __forceinline__ const bf16_t* ptrZ(unsigned char* wsb, const BlockRef& r) { return (const bf16_t*)(wsb + (r.grp ? WS_SZB : WS_SZA)) + hm_off(r) + (size_t)r.qb * QB * D; }
struct Seam { bf16x8 qr[8]; bf16x8 st_v0, st_v1, st_k0, st_k1; };
#define ROW(p, k0, rr) ((const bf16_t*)((const char*)(p) + (unsigned)(((k0) + (rr)) * (D * 2) + sc * 2)))
#define VMW() asm volatile("s_waitcnt vmcnt(0)" ::: "memory")
#define VMWN(n) asm volatile("s_waitcnt vmcnt(%0)" :: "i"(n) : "memory")
#define SLOAD_H(Kp, Vp, k0) do { S.st_v0 = load8(ROW(Vp, k0, sr)); S.st_v1 = load8(ROW(Vp, k0, 32 + sr));              \
                         S.st_k0 = load8(ROW(Kp, k0, sr)); S.st_k1 = load8(ROW(Kp, k0, 32 + sr)); } while (0)
#define SWRITE_HK(bf) do { *(bf16x8*)(K_lds + (bf) * SHM_K + kws) = S.st_k0; *(bf16x8*)(K_lds + (bf) * SHM_K + kws + 32 * 256) = S.st_k1; } while (0)
#define SWRITE_HV(bf) do { *(bf16x8*)(V_lds + (bf) * SHM_V + vst0) = S.st_v0; *(bf16x8*)(V_lds + (bf) * SHM_V + vst1) = S.st_v1; } while (0)
#define SWRITE_H(bf) do { SWRITE_HV(bf); SWRITE_HK(bf); } while (0)
__device__ __forceinline__ void prime(const BlockRef& cur, unsigned char* wsb, char* lds, Seam& S) {
    const int tid = threadIdx.x, wid = __builtin_amdgcn_readfirstlane(tid >> 6), lane = tid & 63, r32 = lane & 31, hi = lane >> 5;
    const int sr = tid >> 4, sc = (tid & 15) * 8, kws = KSWZ(sr, sc * 2); char* K_lds = lds + 2 * SHM_V;
    const bf16_t* Qp = ptrQ(wsb, cur); const bf16_t* Kp = ptrK(wsb, cur); const bf16_t* Vp = ptrV(wsb, cur);
    for (int d0 = 0; d0 < 8; ++d0) S.qr[d0] = load8(Qp + (size_t)(wid * QBLK + r32) * D + d0 * 16 + hi * 8);
    SLOAD_H(Kp, Vp, 0); VMW(); SWRITE_HK(0);
    __syncthreads();
}
__device__ __forceinline__ void block(const BlockRef& cur, unsigned char* wsb, char* lds, Seam& S) {
    const int GRP = cur.grp;
    const int tid = threadIdx.x, wid = __builtin_amdgcn_readfirstlane(tid >> 6), lane = tid & 63, r32 = lane & 31, hi = lane >> 5;
    const int NT = 4 * cur.qb + 4;
    const int qlo = cur.qb * QB + wid * QBLK, qm = qlo + r32 - 4 * hi;
    char* V_lds = lds; char* K_lds = lds + 2 * SHM_V;
    float* ws = (float*)(lds + LDS_WS) + wid * 64; float* li_l = ws, * al_l = ws + 32;
    float m_reg = -1e30f, l_reg = 0; f32x16 o[4] = {};
    const int sr = tid >> 4, sc = (tid & 15) * 8, vst0 = v_st(sr, sc), vst1 = v_st(32 + sr, sc), kws = KSWZ(sr, sc * 2);
    const int vb0 = (int)(uintptr_t)V_lds + v_rd_base(lane);
    const bf16_t* Kh = ptrK(wsb, cur); const bf16_t* Vh = ptrV(wsb, cur);
    const float sl = exp2f(-(float)(cur.h + 1)) * 11.313708498984761f;
    unsigned selbits = 0xffu;
    if (GRP == 1) {
        float* km = (float*)(lds + LDS_KM);
        const float* KM = (const float*)(wsb + WS_KMEAN) + ((size_t)(cur.b * NBLK) * NH + cur.h) * 128;
        if (tid < cur.qb * 32) { const int n = tid >> 5, c4 = (tid & 31) * 4; *(f32x4*)(km + n * 128 + c4) = *(const f32x4*)(KM + (size_t)n * (NH * 128) + c4); }
        __syncthreads();
        float v1 = -__builtin_inff(), v2 = v1, v3 = v1; int i1 = 31, i2 = 31, i3 = 31;
#pragma unroll 1
        for (int n = 0; n < cur.qb; ++n) { float a = 0.f;
#pragma unroll
            for (int d0 = 0; d0 < 8; ++d0) { const f32x4 k0 = *(const f32x4*)(km + n * 128 + d0 * 16 + hi * 8), k1 = *(const f32x4*)(km + n * 128 + d0 * 16 + hi * 8 + 4);
                const bf16x8 q = S.qr[d0];
                a += bf2f((bf16_t)q[0]) * k0[0] + bf2f((bf16_t)q[1]) * k0[1] + bf2f((bf16_t)q[2]) * k0[2] + bf2f((bf16_t)q[3]) * k0[3]
                   + bf2f((bf16_t)q[4]) * k1[0] + bf2f((bf16_t)q[5]) * k1[1] + bf2f((bf16_t)q[6]) * k1[2] + bf2f((bf16_t)q[7]) * k1[3]; }
            const float other = __shfl_xor(a, 32); const float g = a + other;
            const bool c1 = g > v1, c2 = g > v2, c3 = g > v3;
            v3 = c2 ? v2 : (c3 ? g : v3); i3 = c2 ? i2 : (c3 ? n : i3);
            v2 = c1 ? v1 : (c2 ? g : v2); i2 = c1 ? i1 : (c2 ? n : i2);
            v1 = c1 ? g : v1;             i1 = c1 ? n : i1; }
        selbits = ((1u << i1) | (1u << i2) | (1u << i3)) & 0xffu;
    }
    const char* mst = lds + LDS_OST + wid * MST_WAVE + r32 * MST_PITCH;
    if (GRP == 0) {
        const char* src = (const char*)(wsb + WS_MASK) + ((size_t)cur.b * SEQ + qlo) * 256 + (unsigned)(r32 * 256 + hi * 128);
        u32x4 tmp[8];
#pragma unroll
        for (int i = 0; i < 8; ++i) tmp[i] = *(const u32x4*)(src + 16 * i);
#pragma unroll
        for (int i = 0; i < 8; ++i) { unsigned long long* d = (unsigned long long*)(mst + hi * 128 + 16 * i);
            d[0] = (unsigned long long)tmp[i][0] | ((unsigned long long)tmp[i][1] << 32); d[1] = (unsigned long long)tmp[i][2] | ((unsigned long long)tmp[i][3] << 32); }
    }
#define RESC(a) do { if (__any((a) < 1.f)) { if (hi == 0) al_l[r32] = (a); asm volatile("s_waitcnt lgkmcnt(0)" ::: "memory");              \
                     for (int d_ = 0; d_ < 4; ++d_) for (int r = 0; r < 16; ++r) o[d_][r] *= al_l[crow(r, hi)]; } } while (0)
#define KBASE(t) ((t) * KVBLK)
#define CB(t) ((GRP == 1 && (t) < 4 * cur.qb && !((selbits >> ((t) >> 2)) & 1u)) ? -__builtin_inff() : sl * (float)(KBASE(t) - qm))
#define MLOAD(t) ((GRP == 0) ? *(const unsigned long long*)(mst + (t) * 8) : 0ull)
#define MASKT(P0_, P1_, t, mw) do { const int kb_ = KBASE(t); \
        if (GRP == 0) { mask_bits(P0_, P1_, ((unsigned)(mw)) >> (4 * hi), ((unsigned)((mw) >> 32)) >> (4 * hi)); } \
        else if (kb_ + KVBLK - 1 > qlo) mask_causal(P0_, P1_, qm - kb_); } while (0)
    f32x16 pA0, pA1, pB0, pB1; float mnA, mnB, alA, alB; bf16x8 pa0, pa1, pa2, pa3;
    unsigned long long mwA, mwB;
    SWRITE_HV(0); SBAR();
    if (NT > 1) SLOAD_H(Kh, Vh, KBASE(1));
    mwA = MLOAD(0);
    SBAR(); qkt<0>(pA0, pA1, K_lds, r32, hi, S.qr, CB(0), sl);
    MASKT(pA0, pA1, 0, mwA); partialSM(pA0, pA1, m_reg, mnA, alA);
    if (NT > 1) { VMW(); SWRITE_H(1); }
    __syncthreads();
#define HALF_STEP(PX0, PX1, mnX, alX, mwX, PY0, PY1, alY, t, KB, VB, SB) do {                                                 \
        SBAR(); qkt<KB>(PX0, PX1, K_lds, r32, hi, S.qr, CB(t), sl);                                                           \
        finishSM(PY0, PY1, alY, l_reg, pa0, pa1, pa2, pa3); SBAR();                                                           \
        if ((t) + 1 < NT) { SLOAD_H(Kh, Vh, KBASE((t) + 1)); SBAR(); }                                                        \
        mwX = MLOAD(t); pv_tile<VB>(o, vb0, pa0, pa1, pa2, pa3); MASKT(PX0, PX1, (t), mwX); partialSM(PX0, PX1, m_reg, mnX, alX);             \
        __syncthreads();                                                                                                      \
        if ((t) + 1 < NT) { VMW(); SWRITE_H(SB); }                                                                            \
        RESC(alX); __syncthreads(); } while (0)
    for (int t = 1; t + 1 < NT; t += 2) {
        HALF_STEP(pB0, pB1, mnB, alB, mwB, pA0, pA1, alA, t, 1, 0, 0);
        HALF_STEP(pA0, pA1, mnA, alA, mwA, pB0, pB1, alB, t + 1, 0, 1, 1);
    }
    SBAR(); qkt<1>(pB0, pB1, K_lds, r32, hi, S.qr, CB(NT - 1), sl); SBAR();
    mwB = MLOAD(NT - 1);
    finishSM(pA0, pA1, alA, l_reg, pa0, pa1, pa2, pa3); SBAR();
    pv_tile<0>(o, vb0, pa0, pa1, pa2, pa3);
    MASKT(pB0, pB1, NT - 1, mwB); partialSM(pB0, pB1, m_reg, mnB, alB); __syncthreads(); RESC(alB);
    finishSM(pB0, pB1, alB, l_reg, pa0, pa1, pa2, pa3); SBAR(); pv_tile<1>(o, vb0, pa0, pa1, pa2, pa3);
    if (hi == 0) li_l[r32] = l_reg; asm volatile("s_waitcnt lgkmcnt(0)" ::: "memory");
    float rli[16];
#pragma unroll
    for (int r = 0; r < 16; ++r) rli[r] = __builtin_amdgcn_rcpf(li_l[crow(r, hi)]);
    { bf16_t* stg = (bf16_t*)(lds + LDS_OST) + wid * (QBLK * D);
      int lane_e = lane; asm volatile("" : "+v"(lane_e));
      bf16_t* stw = stg + (4 * (lane_e >> 5)) * D + (lane_e & 31);
#pragma unroll
      for (int r = 0; r < 16; ++r) { const int orow = (r & 3) + 8 * (r >> 2);
#pragma unroll
          for (int d0 = 0; d0 < 4; ++d0) stw[orow * D + d0 * 32] = (bf16_t)cvt1(o[d0][r] * rli[r]); }
      asm volatile("s_waitcnt lgkmcnt(0)" ::: "memory");
      char* Ow = (char*)(wsb + WS_Y8) + ((size_t)cur.b * SEQ + qlo) * 2048 + cur.grp * 1024 + cur.h * 128;
      const char* Zw = (const char*)(ptrZ(wsb, cur) + (size_t)(wid * QBLK) * D);
      const unsigned eo = (unsigned)((lane_e >> 4) * 256 + (lane_e & 15) * 16), yo = (unsigned)((lane_e >> 4) * 2048 + (lane_e & 15) * 8);
#pragma unroll
      for (int i = 0; i < 8; ++i) {
          const u32x4 ov = *(const u32x4*)((const char*)stg + (eo + (unsigned)(i * 1024))), zv = *(const u32x4*)(Zw + (eo + (unsigned)(i * 1024))); float f[8];
#pragma unroll
          for (int j = 0; j < 4; ++j) { f[2 * j] = __uint_as_float(ov[j] << 16) * __uint_as_float(zv[j] << 16) * 8.f; f[2 * j + 1] = __uint_as_float(ov[j] & 0xffff0000u) * __uint_as_float(zv[j] & 0xffff0000u) * 8.f; }
          const unsigned long long w = (unsigned long long)pk4_fp8(f[0], f[1], f[2], f[3]) | ((unsigned long long)pk4_fp8(f[4], f[5], f[6], f[7]) << 32);
          *(unsigned long long*)(Ow + (yo + (unsigned)(i * 8192))) = w; } }
    __syncthreads();
#undef RESC
#undef KBASE
#undef CB
#undef MLOAD
#undef MASKT
#undef HALF_STEP
}
#undef ROW
#undef VMW
#undef VMWN
#undef SLOAD_H
#undef SWRITE_HK
#undef SWRITE_HV
#undef SWRITE_H
__device__ __forceinline__ bool decode(int v, int G, int i, BlockRef& r) {
    const int L = v + (i >> 1) * G; if (L >= 512) return false;
    const int x = L & 3, k = L >> 5;
    r.h = (L >> 2) & 7; r.b = k & 7; r.grp = ((k & 1) ^ (k >> 3)) & 1; r.qb = (i & 1) ? 7 - x : x;
    return true;
}
__device__ __forceinline__ void attn_phase(char* lds, unsigned char* wsb, int v, int G) {
    BlockRef cur, nxt;
    if (!decode(v, G, 0, cur)) return;
    Seam S;
    prime(cur, wsb, lds, S);
    for (int i = 0;; ++i) {
        const bool more = decode(v, G, i + 1, nxt);
        if (!more) nxt = cur;
        block(cur, wsb, lds, S);
        if (!more) break;
        prime(nxt, wsb, lds, S);
        cur = nxt;
    }
}
#undef KSWZ
#undef SBAR
}

namespace sel {
#define SLAS __attribute__((address_space(3)))
typedef short bf16x8 __attribute__((ext_vector_type(8)));
typedef float f32x16 __attribute__((ext_vector_type(16)));
typedef float f32x4 __attribute__((ext_vector_type(4)));
typedef unsigned u32x4 __attribute__((ext_vector_type(4)));
constexpr int KB_OFF = 131072;
constexpr int LIST_OFF = 147456 + 2048;
__device__ __forceinline__ unsigned fkey(float x) { const unsigned b = __float_as_uint(x); return (b & 0x80000000u) ? ~b : (b | 0x80000000u); }
__device__ __forceinline__ void unit(SLAS unsigned char* lds, unsigned char* wsb, int b, int rg) {
    const int tid = threadIdx.x, wid = __builtin_amdgcn_readfirstlane(tid >> 6), lane = tid & 63, j = lane & 31, g = lane >> 5;
    const bf16_t* QI = (const bf16_t*)(wsb + WS_QI); const char* KIb = (const char*)((const bf16_t*)(wsb + WS_KI) + (size_t)b * SEQ * 64); const float* WI = (const float*)(wsb + WS_WI);
    unsigned long long* MASK = (unsigned long long*)(wsb + WS_MASK);
    const int ta = 16 * rg + 2 * wid, t = ta + g;
    const int nkeys = 16 * rg + 16, nk32 = (nkeys + 31) >> 5, nch = (nkeys + 63) >> 6;
    SLAS float* sc = (SLAS float*)lds + (wid * 2 + g) * 2048 + j;
    float vmin = __builtin_inff(), vmax = -__builtin_inff();
    bf16x8 af[4];
    { const int i = lane & 31, tok = (i >> 2) & 1, head = (i & 3) + 4 * (i >> 3);
      const bf16_t* qp = QI + ((size_t)b * SEQ + ta + tok) * 1024 + head * 64 + 8 * (lane >> 5);
#pragma unroll
      for (int ks = 0; ks < 4; ++ks) af[ks] = *(const bf16x8*)(qp + 16 * ks); }
    float wv[16];
    { const float* wp = WI + ((size_t)b * SEQ + t) * 16;
#pragma unroll
      for (int q4 = 0; q4 < 4; ++q4) { const f32x4 w4 = *(const f32x4*)(wp + 4 * q4); wv[4 * q4] = w4[0] * 0.03125f; wv[4 * q4 + 1] = w4[1] * 0.03125f; wv[4 * q4 + 2] = w4[2] * 0.03125f; wv[4 * q4 + 3] = w4[3] * 0.03125f; } }
    const int srow = tid >> 3, scol = tid & 7, swr = srow * 128 + ((scol ^ ((srow >> 1) & 7)) << 4);
    int koff[4];
#pragma unroll
    for (int ks = 0; ks < 4; ++ks) koff[ks] = j * 128 + (((2 * ks + g) ^ ((j >> 1) & 7)) << 4);
    u32x4 stA = *(const u32x4*)(KIb + (unsigned)(tid * 16)), stB = stA;
    *(SLAS u32x4*)(lds + KB_OFF + swr) = stA;
    stA = *(const u32x4*)(KIb + (unsigned)(min(1, nch - 1) * 8192 + tid * 16));
    stB = *(const u32x4*)(KIb + (unsigned)(min(2, nch - 1) * 8192 + tid * 16));
    __syncthreads();
#define SEL_EPI(ACC, kt) do { float s0 = 0.f, s1 = 0.f, s2 = 0.f, s3 = 0.f; \
        _Pragma("unroll") for (int r = 0; r < 4; ++r) { s0 = fmaf(wv[r], fmaxf(ACC[r], 0.f), s0); s1 = fmaf(wv[4 + r], fmaxf(ACC[4 + r], 0.f), s1); \
                                                       s2 = fmaf(wv[8 + r], fmaxf(ACC[8 + r], 0.f), s2); s3 = fmaf(wv[12 + r], fmaxf(ACC[12 + r], 0.f), s3); } \
        const float s = (s0 + s1) + (s2 + s3); \
        if (32 * (kt) + j <= t) { vmin = fminf(vmin, s); vmax = fmaxf(vmax, s); }     \
        sc[32 * (kt)] = s; } while (0)
#define SEL_TILES(cc) do { SLAS unsigned char* kb = lds + KB_OFF + ((cc) & 1) * 8192; const int kt0 = 2 * (cc); \
        if (kt0 + 1 < nk32) {                                  \
            f32x16 acc0 = {}, acc1 = {}; \
            _Pragma("unroll") for (int ks = 0; ks < 4; ++ks) { const bf16x8 b0 = *(const SLAS bf16x8*)(kb + koff[ks]), b1 = *(const SLAS bf16x8*)(kb + 4096 + koff[ks]); \
                acc0 = __builtin_amdgcn_mfma_f32_32x32x16_bf16(af[ks], b0, acc0, 0, 0, 0); acc1 = __builtin_amdgcn_mfma_f32_32x32x16_bf16(af[ks], b1, acc1, 0, 0, 0); } \
            SEL_EPI(acc0, kt0); SEL_EPI(acc1, kt0 + 1); \
        } else if (kt0 < nk32) { f32x16 acc0 = {}; \
            _Pragma("unroll") for (int ks = 0; ks < 4; ++ks) { const bf16x8 b0 = *(const SLAS bf16x8*)(kb + koff[ks]); acc0 = __builtin_amdgcn_mfma_f32_32x32x16_bf16(af[ks], b0, acc0, 0, 0, 0); } \
            SEL_EPI(acc0, kt0); } } while (0)
#pragma unroll 1
    for (int c = 0; c < nch; c += 2) {
        SEL_TILES(c);
        *(SLAS u32x4*)(lds + KB_OFF + 8192 + swr) = stA; stA = *(const u32x4*)(KIb + (unsigned)(min(c + 3, nch - 1) * 8192 + tid * 16));
        __syncthreads();
        SEL_TILES(c + 1);
        *(SLAS u32x4*)(lds + KB_OFF + swr) = stB; stB = *(const u32x4*)(KIb + (unsigned)(min(c + 4, nch - 1) * 8192 + tid * 16));
        __syncthreads();
    }
#undef SEL_TILES
#undef SEL_EPI
    unsigned T = 0u; int need = 0; bool ties = false;
    if (16 * rg >= TOPK) {
        SLAS unsigned* hist = (SLAS unsigned*)(lds + KB_OFF) + (wid * 2 + g) * 256;
#pragma unroll
        for (int off = 1; off < 32; off <<= 1) { vmin = fminf(vmin, __shfl_xor(vmin, off)); vmax = fmaxf(vmax, __shfl_xor(vmax, off)); }
        const float range = vmax - vmin, inv = (range > 0.f) ? 255.99f / range : 0.f;
        *(SLAS u32x4*)(hist + 8 * j) = (u32x4){0u, 0u, 0u, 0u}; *(SLAS u32x4*)(hist + 8 * j + 4) = (u32x4){0u, 0u, 0u, 0u};
#pragma unroll 1
        for (int kt0 = 0; kt0 < nk32; kt0 += 4) { float x[4];
#pragma unroll
            for (int i = 0; i < 4; ++i) x[i] = sc[32 * (kt0 + i)];
#pragma unroll
            for (int i = 0; i < 4; ++i) if (32 * (kt0 + i) + j <= t) { const int q = min((int)((x[i] - vmin) * inv), 255); __hip_atomic_fetch_add(hist + q, 1u, __ATOMIC_RELAXED, __HIP_MEMORY_SCOPE_WORKGROUP); } }
        asm volatile("s_waitcnt lgkmcnt(0)" ::: "memory");
        int qsel, cB;
        { const u32x4 c0 = *(const SLAS u32x4*)(hist + 8 * j), c1 = *(const SLAS u32x4*)(hist + 8 * j + 4);
          const int cnt[8] = {(int)c0[0], (int)c0[1], (int)c0[2], (int)c0[3], (int)c1[0], (int)c1[1], (int)c1[2], (int)c1[3]};
          const int s = ((cnt[0] + cnt[1]) + (cnt[2] + cnt[3])) + ((cnt[4] + cnt[5]) + (cnt[6] + cnt[7]));
          int S = s;
#pragma unroll
          for (int off = 1; off < 32; off <<= 1) { const int v = __shfl_down(S, off, 32); if (j + off < 32) S += v; }
          const int above = S - s;
          const bool found = (S >= TOPK) && (above < TOPK);
          int dsel = 0, nneed = 0, csel = 0;
          { const int rem = TOPK - above; int cum = 0; bool done = false;
#pragma unroll
            for (int i = 7; i >= 0; --i) { const int before = cum; cum += cnt[i]; if (!done && cum >= rem) { done = true; dsel = 8 * j + i; nneed = rem - before; csel = cnt[i]; } } }
          const unsigned long long bm = __ballot(found);
          const int src = 32 * g + __builtin_ctz((unsigned)(bm >> (32 * g)) | 0x80000000u);
          qsel = __shfl(dsel, src); need = __shfl(nneed, src); cB = __shfl(csel, src); }
        if (!__any(cB > 64)) {
            SLAS unsigned* list = (SLAS unsigned*)(lds + LIST_OFF) + (wid * 2 + g) * 128;
            int base = 0;
#pragma unroll 1
            for (int kt0 = 0; kt0 < nk32; kt0 += 4) { float x[4];
#pragma unroll
                for (int i = 0; i < 4; ++i) x[i] = sc[32 * (kt0 + i)];
#pragma unroll
                for (int i = 0; i < 4; ++i) { const int kt = kt0 + i;
                    const bool m = (32 * kt + j <= t) && (min((int)((x[i] - vmin) * inv), 255) == qsel);
                    const unsigned long long bal = __ballot(m); const unsigned hm = g ? (unsigned)(bal >> 32) : (unsigned)bal;
                    if (m) { const int pos = base + __builtin_popcount(hm & ((1u << j) - 1u)); list[2 * pos] = fkey(x[i]); list[2 * pos + 1] = (unsigned)(32 * kt + j); }
                    base += __builtin_popcount(hm); } }
            asm volatile("s_waitcnt lgkmcnt(0)" ::: "memory");
            const unsigned u0 = list[2 * j], i0 = list[2 * j + 1], u1 = list[2 * (j + 32)], i1 = list[2 * (j + 32) + 1];
            int r0 = 0, r1 = 0; const int cmax = max(cB, __shfl_xor(cB, 32));
#pragma unroll 1
            for (int e = 0; e < cmax; ++e) { const unsigned ue = list[2 * e], ie = list[2 * e + 1]; const bool in = e < cB;
                r0 += (in && (ue > u0 || (ue == u0 && ie < i0))) ? 1 : 0; r1 += (in && (ue > u1 || (ue == u1 && ie < i1))) ? 1 : 0; }
            const bool h0 = (j < cB) && (r0 == need - 1), h1 = (j + 32 < cB) && (r1 == need - 1);
            const unsigned long long bh = __ballot(h0 || h1);
            const int src = 32 * g + __builtin_ctz((unsigned)(bh >> (32 * g)) | 0x80000000u);
            T = __shfl(h0 ? u0 : u1, src);
            const unsigned long long bg0 = __ballot(j < cB && u0 > T), bg1 = __ballot(j + 32 < cB && u1 > T), be0 = __ballot(j < cB && u0 == T), be1 = __ballot(j + 32 < cB && u1 == T);
            const int ngt = __builtin_popcount(g ? (unsigned)(bg0 >> 32) : (unsigned)bg0) + __builtin_popcount(g ? (unsigned)(bg1 >> 32) : (unsigned)bg1);
            const int neq = __builtin_popcount(g ? (unsigned)(be0 >> 32) : (unsigned)be0) + __builtin_popcount(g ? (unsigned)(be1 >> 32) : (unsigned)be1);
            need = need - ngt; ties = (neq != need);
        } else {
            unsigned prefix = 0u; need = TOPK; int ceq = 0;
#pragma unroll 1
            for (int p = 0; p < 4; ++p) { const int shift = 24 - 8 * p;
                *(SLAS u32x4*)(hist + 8 * j) = (u32x4){0u, 0u, 0u, 0u}; *(SLAS u32x4*)(hist + 8 * j + 4) = (u32x4){0u, 0u, 0u, 0u};
                const unsigned phi = prefix >> ((shift + 8) & 31);
#pragma unroll 1
                for (int kt = 0; kt < nk32; ++kt) { const unsigned x = fkey(sc[32 * kt]);
                    const bool match = (32 * kt + j <= t) && ((p == 0) || ((x >> ((shift + 8) & 31)) == phi));
                    if (match) __hip_atomic_fetch_add(hist + ((x >> shift) & 255u), 1u, __ATOMIC_RELAXED, __HIP_MEMORY_SCOPE_WORKGROUP); }
                asm volatile("s_waitcnt lgkmcnt(0)" ::: "memory");
                const u32x4 c0 = *(const SLAS u32x4*)(hist + 8 * j), c1 = *(const SLAS u32x4*)(hist + 8 * j + 4);
                const int cnt[8] = {(int)c0[0], (int)c0[1], (int)c0[2], (int)c0[3], (int)c1[0], (int)c1[1], (int)c1[2], (int)c1[3]};
                const int s = ((cnt[0] + cnt[1]) + (cnt[2] + cnt[3])) + ((cnt[4] + cnt[5]) + (cnt[6] + cnt[7]));
                int S = s;
#pragma unroll
                for (int off = 1; off < 32; off <<= 1) { const int v = __shfl_down(S, off, 32); if (j + off < 32) S += v; }
                const int above = S - s;
                const bool found = (S >= need) && (above < need);
                int dsel = 0, nneed = 0, csel = 0;
                { const int rem = need - above; int cum = 0; bool done = false;
#pragma unroll
                  for (int i = 7; i >= 0; --i) { const int before = cum; cum += cnt[i]; if (!done && cum >= rem) { done = true; dsel = 8 * j + i; nneed = rem - before; csel = cnt[i]; } } }
                const unsigned long long bm = __ballot(found);
                const int src = 32 * g + __builtin_ctz((unsigned)(bm >> (32 * g)) | 0x80000000u);
                const int digit = __shfl(dsel, src); need = __shfl(nneed, src); ceq = __shfl(csel, src);
                prefix |= (unsigned)digit << shift;
            }
            T = prefix; ties = (ceq != need);
        }
    }
    unsigned wlo = 0u, whi = 0u;
    if (!__any(ties)) {
#pragma unroll 4
        for (int k64 = 0; k64 < 32; ++k64) {
            const bool s0 = (64 * k64 + j <= t) && (fkey(sc[64 * k64]) >= T), s1 = (64 * k64 + 32 + j <= t) && (fkey(sc[64 * k64 + 32]) >= T);
            const unsigned long long b0 = __ballot(s0), b1 = __ballot(s1);
            const unsigned lo = g ? (unsigned)(b0 >> 32) : (unsigned)b0, hi = g ? (unsigned)(b1 >> 32) : (unsigned)b1;
            if (j == k64) { wlo = lo; whi = hi; } }
    } else {
        int base = 0;
#pragma unroll 1
        for (int k64 = 0; k64 < 32; ++k64) { unsigned lo = 0u, hi = 0u;
#pragma unroll
            for (int hh = 0; hh < 2; ++hh) { const bool vld = (64 * k64 + 32 * hh + j <= t); const unsigned x = vld ? fkey(sc[64 * k64 + 32 * hh]) : 0u;
                const unsigned long long be = __ballot(vld && x == T); const unsigned em = g ? (unsigned)(be >> 32) : (unsigned)be;
                const int rank = base + __builtin_popcount(em & ((1u << j) - 1u));
                const bool s1 = vld && ((x > T) || (x == T && rank < need));
                base += __builtin_popcount(em);
                const unsigned long long bs = __ballot(s1); const unsigned sm = g ? (unsigned)(bs >> 32) : (unsigned)bs;
                if (hh == 0) lo = sm; else hi = sm; }
            if (j == k64) { wlo = lo; whi = hi; } }
    }
    MASK[((size_t)b * SEQ + t) * 32 + j] = (unsigned long long)wlo | ((unsigned long long)whi << 32);
    __syncthreads();
}
__device__ __forceinline__ void kmean_unit(SLAS unsigned char* lds, unsigned char* wsb, int b, int n, int h) {
    const int tid = threadIdx.x, d4 = tid & 31, rs = tid >> 5;
    const bf16_t* KB = (const bf16_t*)(wsb + WS_KB) + (((size_t)(b * NH + h) * SEQ) + n * 256) * 128;
    float a0 = 0.f, a1 = 0.f, a2 = 0.f, a3 = 0.f;
#pragma unroll 4
    for (int r = 0; r < 16; ++r) { const unsigned long long v = *(const unsigned long long*)(KB + (size_t)(rs * 16 + r) * 128 + d4 * 4);
        const unsigned lo = (unsigned)v, hi = (unsigned)(v >> 32);
        a0 += __uint_as_float(lo << 16); a1 += __uint_as_float(lo & 0xffff0000u); a2 += __uint_as_float(hi << 16); a3 += __uint_as_float(hi & 0xffff0000u); }
    SLAS float* red = (SLAS float*)lds;
    *(SLAS f32x4*)(red + rs * 128 + d4 * 4) = (f32x4){a0, a1, a2, a3};
    __syncthreads();
    if (tid < 128) { float s = 0.f;
#pragma unroll
        for (int q = 0; q < 16; ++q) s += red[q * 128 + tid];
        ((float*)(wsb + WS_KMEAN))[((size_t)(b * NBLK + n) * NH + h) * 128 + tid] = s * (1.f / 256.f); }
    __syncthreads();
}
__device__ __forceinline__ void select_phase(SLAS unsigned char* lds, unsigned char* wsb, int v, int G) {
    for (int L = v; L < 512; L += G) kmean_unit(lds, wsb, L >> 6, (L >> 3) & 7, L & 7);
    for (int L = v; L < 512; L += G) { const int b = L >> 6, x = L & 63;
        unit(lds, wsb, b, x);
        unit(lds, wsb, b, 127 - x); }
}
#undef SLAS
}

struct Args { const float* in[12]; float* out; unsigned char* ws; int ph_lo, ph_hi, li, pad; };
__global__ void __launch_bounds__(NWAVES * 64, 2) mega_fwd(Args args) {
    extern __shared__ __attribute__((aligned(16))) unsigned char lds[];
    Frame F;
    F.lds = (LAS unsigned char*)lds; F.MISC = (volatile LAS unsigned*)(F.lds + MISC_OFF);
    F.tid = threadIdx.x; F.lane = F.tid & 63; F.wave = __builtin_amdgcn_readfirstlane(F.tid >> 6);
    F.G = gridDim.x; { const int bx = blockIdx.x; F.vcu = (F.G % 8 == 0) ? (bx % 8) * (F.G / 8) + bx / 8 : bx; }
    unsigned char* ws = args.ws;
    F.ctl = (gu32*)(ws + WS_CTL);
    const float* x = args.in[0]; const float* c = args.in[1]; const float* w_ada = args.in[2]; const float* b_ada = args.in[3]; const float* g_norm = args.in[4];
    const float* w_in = args.in[5]; const float* w_out = args.in[11];
    float* MOD = (float*)(ws + WS_MOD); bf16_t* WinT = (bf16_t*)(ws + WS_WIN); bf16_t* WoutT = (bf16_t*)(ws + WS_WOUT); bf16_t* HB = (bf16_t*)(ws + WS_HB); bf16_t* Y = (bf16_t*)(ws + WS_Y);
    for (int u = F.tid; u < (LDS_BYTES - LDSCTL_OFF) / 4; u += NWAVES * 64) ((LAS unsigned*)(F.lds + LDSCTL_OFF))[u] = 0u;
    __syncthreads();
    XcdBarrier bar = xcd_barrier_post((unsigned*)(F.ctl + CW_BAR) + args.li * XCD_BAR_WORDS, F.MISC + 8);
    const int lo = args.ph_lo, hi = args.ph_hi;
#define IN(k) (lo <= (k) && (k) < hi)
#define BOTH(k) (IN(k) && IN((k) + 1))
    if (IN(0)) for (int rep_ = 0; rep_ < (((PROBE_DOUBLE) >> 0) & 1) + 1; ++rep_) {
        if (rep_) __syncthreads();
        if ((int)blockIdx.x < 192) p0_mod(F, (int)blockIdx.x, c, w_ada, b_ada, MOD);
        else if ((int)blockIdx.x == 192) { float* G = (float*)(ws + WS_GAIN);
            if (F.tid < 128) { G[F.tid] = args.in[6][F.tid]; G[128 + F.tid] = args.in[7][F.tid]; G[256 + F.tid] = args.in[9][F.tid]; G[384 + F.tid] = args.in[10][F.tid]; }
            if (F.tid < 64) G[512 + F.tid] = args.in[8][F.tid]; }
        p0_convert(F, w_in, w_out, WinT, WoutT, ws + WS_WOUT8);
    }
    if (BOTH(0)) xcd_barrier(bar);
    if (IN(1)) for (int rep_ = 0; rep_ < (((PROBE_DOUBLE) >> 1) & 1) + 1; ++rep_) p1_norm(F, x, g_norm, MOD, HB);
    if (BOTH(1)) xcd_barrier(bar);
    if (IN(2)) for (int rep_ = 0; rep_ < (((PROBE_DOUBLE) >> 2) & 1) + 1; ++rep_) {
        pg8::Gemm g{HB, WinT, M, NPAD, DM}; pg8::StaticOrder S; S.init(M, NPAD, F.G, (int)blockIdx.x);
        EpiProj E{ws, (LAS float*)(F.lds + EPI_OFF)};
        pg8::gemm_phase<EpiProj, pg8::StaticOrder, true, true>(F.lds, g, S, E);
    }
    if (BOTH(2)) xcd_barrier(bar);
    if (IN(3)) for (int rep_ = 0; rep_ < (((PROBE_DOUBLE) >> 3) & 1) + 1; ++rep_) sel::select_phase(F.lds, ws, F.vcu, F.G);
    if (BOTH(3)) xcd_barrier(bar);
    if (IN(4)) {
#pragma unroll 1
        for (int rep_ = 0; rep_ < (((PROBE_DOUBLE) >> 4) & 1) + 1; ++rep_) att::attn_phase((char*)lds, ws, F.vcu, F.G);
    }
    if (BOTH(4)) xcd_barrier(bar);
    if (IN(5)) for (int rep_ = 0; rep_ < (((PROBE_DOUBLE) >> 5) & 1) + 1; ++rep_) {
        pg8::Gemm g{ws + WS_Y8, ws + WS_WOUT8, M, DM, DM}; pg8::StaticOrder S; S.init(M, DM, F.G, (int)blockIdx.x);
        EpiOut E{x, MOD, args.out, FP8_DESCALE};
        pg8::gemm_phase<EpiOut, pg8::StaticOrder, true, true, true>(F.lds, g, S, E);
    }
#undef IN
#undef BOTH
}

static int mega_setup() {
    static int grid = 0;
    if (grid == 0) {
        int dev = 0, cus = 0;
        if (hipGetDevice(&dev) != hipSuccess || hipDeviceGetAttribute(&cus, hipDeviceAttributeMultiprocessorCount, dev) != hipSuccess) { fprintf(stderr, "kernel_launch: device query failed\n"); grid = -1; return grid; }
        if (hipFuncSetAttribute((const void*)mega_fwd, hipFuncAttributeMaxDynamicSharedMemorySize, LDS_BYTES) != hipSuccess) { fprintf(stderr, "kernel_launch: hipFuncSetAttribute failed\n"); grid = -1; return grid; }
        (void)hipGetLastError();
        grid = cus;
    }
    return grid;
}
static void mega_launch(int grid, void* const* d_in, void* d_out, void* d_ws, int ph_lo, int ph_hi, int li, hipStream_t stream) {
    Args a{};
    for (int i = 0; i < 12; ++i) a.in[i] = (const float*)d_in[i];
    a.out = (float*)d_out; a.ws = (unsigned char*)d_ws; a.ph_lo = ph_lo; a.ph_hi = ph_hi; a.li = li;
    hipLaunchKernelGGL(mega_fwd, dim3(grid), dim3(NWAVES * 64), LDS_BYTES, stream, a);
}

extern "C" void kernel_launch(void* const* d_in, const int* in_sizes, int n_in, void* d_out, int out_size, void* d_ws, size_t ws_size, hipStream_t stream) {
    if (n_in != 12 || in_sizes[0] != M * DM || out_size != M * DM || ws_size < WS_END) {
        fprintf(stderr, "kernel_launch: unexpected shapes (n_in %d, in0 %d, out %d, ws %zu); nothing launched\n", n_in, n_in > 0 ? in_sizes[0] : -1, out_size, ws_size); return; }
    const int grid = mega_setup(); if (grid <= 0) return;
    char* ws = (char*)d_ws;
    bf16_t* QA = (bf16_t*)(ws + WS_QA); bf16_t* KA = (bf16_t*)(ws + WS_KA); bf16_t* VA = (bf16_t*)(ws + WS_VA); bf16_t* SZA = (bf16_t*)(ws + WS_SZA);
    bf16_t* QB = (bf16_t*)(ws + WS_QB); bf16_t* KB = (bf16_t*)(ws + WS_KB); bf16_t* VB = (bf16_t*)(ws + WS_VB); bf16_t* SZB = (bf16_t*)(ws + WS_SZB);
    bf16_t* QI = (bf16_t*)(ws + WS_QI); bf16_t* KI = (bf16_t*)(ws + WS_KI); float* WI = (float*)(ws + WS_WI); float* KMEAN = (float*)(ws + WS_KMEAN);
    unsigned long long* MASKT = (unsigned long long*)(ws + WS_MASK); bf16_t* Y = (bf16_t*)(ws + WS_Y);
    (void)hipMemsetAsync(ws + WS_CTL, 0, CTL_ZERO_BYTES, stream);
#if NAIVE_SEL
    mega_launch(grid, d_in, d_out, d_ws, 0, 3, 0, stream);
    k_kmean<<<BATCH * NBLK * NH, 128, 0, stream>>>(KB, KMEAN);
    (void)hipMemsetAsync(MASKT, 0, 4 * MiB, stream);
    k_dsa_select_naive<<<dim3(SEQ, BATCH), 256, 0, stream>>>(QI, KI, WI, MASKT);
    mega_launch(grid, d_in, d_out, d_ws, 4, 6, 1, stream);
#else
    mega_launch(grid, d_in, d_out, d_ws, 0, 6, 0, stream);
#if PROBE_EXTRA >= 0
    mega_launch(grid, d_in, d_out, d_ws, PROBE_EXTRA, PROBE_EXTRA + 1, 1, stream);
#endif
#endif
}
```

```cpp
#include <hip/hip_runtime.h>
#include <cstdio>
#include <cstdint>

typedef unsigned short bf16_t;
#ifndef NAIVE_SEL
#define NAIVE_SEL 0
#endif
#ifndef PROBE_SEL
#define PROBE_SEL 0
#endif
#ifndef PROBE_EXTRA
#define PROBE_EXTRA -1
#endif
#ifndef PROBE_DOUBLE
#define PROBE_DOUBLE 0
#endif
constexpr int BATCH = 8, SEQ = 2048, DM = 2048, M = BATCH * SEQ, NH = 8, HD = 128, DA = 1024, IH = 16, ID = 64, DIN = 9296;
constexpr int TOPK = 256, NBLK = 8;
constexpr float RMS_EPS = 1e-6f;
constexpr float QK_SCALE = 0.08838834764831845f;

__device__ __forceinline__ float bf2f(bf16_t v) { return __uint_as_float(((unsigned)v) << 16); }
__device__ __forceinline__ bf16_t f2bf(float f) { unsigned u = __float_as_uint(f); return (bf16_t)((u + 0x7fffu + ((u >> 16) & 1u)) >> 16); }
__device__ __forceinline__ float rbf(float f) { return bf2f(f2bf(f)); }
__device__ __forceinline__ float silu_f(float v) { return v / (1.f + __expf(-v)); }
__device__ __forceinline__ size_t HM(int b, int h, int t, int d) { return (((size_t)(b * NH + h) * SEQ + t) * HD + d); }
__device__ __forceinline__ float wave_sum(float v) {
#pragma unroll
    for (int o = 1; o < 64; o <<= 1) v += __shfl_xor(v, o);
    return v;
}
__device__ __forceinline__ float wave_max(float v) {
#pragma unroll
    for (int o = 1; o < 64; o <<= 1) v = fmaxf(v, __shfl_xor(v, o));
    return v;
}
__device__ __forceinline__ void mask_pos(int t, int s, size_t& word, int& bit) { word = (size_t)t * 32 + (s >> 6); bit = s & 63; }

__global__ void k_mod(const float* __restrict__ c, const float* __restrict__ w_ada, const float* __restrict__ b_ada, float* __restrict__ MOD) {
    __shared__ float sc[DM];
    const int b = blockIdx.y, n = blockIdx.x * 256 + threadIdx.x;
    for (int k = threadIdx.x; k < DM; k += 256) sc[k] = silu_f(c[b * DM + k]);
    __syncthreads();
    float acc = 0.f;
    for (int k = 0; k < DM; ++k) acc += sc[k] * w_ada[(size_t)k * (3 * DM) + n];
    MOD[b * 3 * DM + n] = acc + b_ada[n];
}
__global__ void k_norm(const float* __restrict__ x, const float* __restrict__ g, const float* __restrict__ MOD, bf16_t* __restrict__ HB) {
    const int lane = threadIdx.x & 63, row = blockIdx.x * 4 + (threadIdx.x >> 6), b = row / SEQ;
    const float* xr = x + (size_t)row * DM;
    float ss = 0.f;
    for (int k = lane; k < DM; k += 64) { const float v = xr[k]; ss += v * v; }
    ss = wave_sum(ss);
    const float rstd = rsqrtf(ss / DM + RMS_EPS);
    const float* shift = MOD + b * 3 * DM; const float* scale = shift + DM;
    for (int k = lane; k < DM; k += 64) HB[(size_t)row * DM + k] = f2bf(xr[k] * rstd * g[k] * (1.f + scale[k]) + shift[k]);
}
template <int MODE>
__global__ void k_gemm_naive(const bf16_t* __restrict__ A, int K, const float* __restrict__ W, int ldw, int n0, int ncols,
                             float* __restrict__ C, int ldc, const float* __restrict__ xres, const float* __restrict__ MOD) {
    __shared__ float As[16][65], Bs[16][65];
    const int tid = threadIdx.x, tx = tid & 15, ty = tid >> 4, m0 = blockIdx.y * 64, c0 = blockIdx.x * 64;
    float acc[4][4] = {};
    for (int k0 = 0; k0 < K; k0 += 16) {
        for (int i = tid; i < 1024; i += 256) { const int r = i >> 4, kk = i & 15; As[kk][r] = bf2f(A[(size_t)(m0 + r) * K + k0 + kk]); }
        for (int i = tid; i < 1024; i += 256) { const int kk = i >> 6, cc = i & 63; Bs[kk][cc] = (c0 + cc < ncols) ? rbf(W[(size_t)(k0 + kk) * ldw + n0 + c0 + cc]) : 0.f; }
        __syncthreads();
#pragma unroll
        for (int kk = 0; kk < 16; ++kk) {
            float a[4], bb[4];
#pragma unroll
            for (int i = 0; i < 4; ++i) { a[i] = As[kk][ty * 4 + i]; bb[i] = Bs[kk][tx * 4 + i]; }
#pragma unroll
            for (int i = 0; i < 4; ++i)
#pragma unroll
                for (int j = 0; j < 4; ++j) acc[i][j] += a[i] * bb[j];
        }
        __syncthreads();
    }
#pragma unroll
    for (int i = 0; i < 4; ++i)
#pragma unroll
        for (int j = 0; j < 4; ++j) {
            const int m = m0 + ty * 4 + i, cc = c0 + tx * 4 + j;
            if (cc < ncols) {
                if (MODE == 0) C[(size_t)m * ldc + cc] = acc[i][j];
                else { const int b = m / SEQ; C[(size_t)m * ldc + cc] = xres[(size_t)m * ldc + cc] + MOD[b * 3 * DM + 2 * DM + cc] * acc[i][j]; }
            }
        }
}
__global__ void k_post(const float* __restrict__ T32, const float* __restrict__ gain, bf16_t* __restrict__ dst, int mode) {
    const int lane = threadIdx.x & 63, item = blockIdx.x * 4 + (threadIdx.x >> 6), m = item >> 3, h = item & 7, b = m / SEQ, t = m % SEQ;
    const float* src = T32 + (size_t)m * 1024 + h * 128;
    float v0 = src[lane], v1 = src[lane + 64];
    if (mode == 0) { const float ss = wave_sum(v0 * v0 + v1 * v1); const float rstd = rsqrtf(ss / 128.f + RMS_EPS); v0 = v0 * rstd * gain[lane]; v1 = v1 * rstd * gain[lane + 64]; }
    if (mode == 2) { v0 = silu_f(v0); v1 = silu_f(v1); }
    if (mode == 3) { dst[(size_t)m * 1024 + h * 128 + lane] = f2bf(v0); dst[(size_t)m * 1024 + h * 128 + lane + 64] = f2bf(v1); }
    else { dst[HM(b, h, t, lane)] = f2bf(v0); dst[HM(b, h, t, lane + 64)] = f2bf(v1); }
}
__global__ void k_post_idx(const float* __restrict__ T32, const float* __restrict__ gain, bf16_t* __restrict__ KI, float* __restrict__ WI) {
    const int lane = threadIdx.x & 63, m = blockIdx.x * 4 + (threadIdx.x >> 6);
    const float v = T32[(size_t)m * 80 + lane];
    const float ss = wave_sum(v * v); const float rstd = rsqrtf(ss / 64.f + RMS_EPS);
    KI[(size_t)m * 64 + lane] = f2bf(v * rstd * gain[lane]);
    if (lane < 16) WI[(size_t)m * 16 + lane] = T32[(size_t)m * 80 + 64 + lane];
}
__global__ void k_kmean(const bf16_t* __restrict__ KB, float* __restrict__ KMEAN) {
    const int d = threadIdx.x, h = blockIdx.x & 7, n = (blockIdx.x >> 3) & 7, b = blockIdx.x >> 6;
    float s = 0.f;
    for (int t = 0; t < 256; ++t) s += bf2f(KB[HM(b, h, n * 256 + t, d)]);
    KMEAN[((size_t)(b * NBLK + n) * NH + h) * HD + d] = s * (1.f / 256.f);
}
__global__ void k_dsa_select_naive(const bf16_t* __restrict__ QI, const bf16_t* __restrict__ KI, const float* __restrict__ WI, unsigned long long* __restrict__ MASKT) {
    const int t = blockIdx.x, b = blockIdx.y, tid = threadIdx.x; const size_t m = (size_t)b * SEQ + t;
    __shared__ float q[1024]; __shared__ float w[16]; __shared__ float sc[SEQ];
    for (int i = tid; i < 1024; i += 256) q[i] = bf2f(QI[m * 1024 + i]);
    if (tid < 16) w[tid] = WI[m * 16 + tid];
    __syncthreads();
    for (int s = tid; s <= t; s += 256) {
        float k[64];
        const bf16_t* kp = KI + ((size_t)b * SEQ + s) * 64;
#pragma unroll
        for (int d = 0; d < 64; ++d) k[d] = bf2f(kp[d]);
        float score = 0.f;
        for (int h = 0; h < 16; ++h) { float dot = 0.f;
#pragma unroll
            for (int d = 0; d < 64; ++d) dot += q[h * 64 + d] * k[d];
            score += w[h] * fmaxf(dot * 0.125f, 0.f); }
        sc[s] = score * 0.25f;
    }
    __syncthreads();
    for (int s = tid; s <= t; s += 256) {
        bool sel = true;
        if (t >= TOPK) { const float v = sc[s]; int cnt = 0; for (int s2 = 0; s2 <= t; ++s2) { const float u = sc[s2]; cnt += (u > v || (u == v && s2 < s)) ? 1 : 0; } sel = cnt < TOPK; }
        if (sel) { size_t word; int bit; mask_pos(t, s, word, bit); atomicOr(&MASKT[(size_t)b * 65536 + word], 1ull << bit); }
    }
}
__global__ void k_dsa_attn_naive(const bf16_t* __restrict__ QA, const bf16_t* __restrict__ KA, const bf16_t* __restrict__ VA, const bf16_t* __restrict__ SZA,
                                 const unsigned long long* __restrict__ MASKT, bf16_t* __restrict__ Y) {
    const int t = blockIdx.x, b = blockIdx.y, tid = threadIdx.x, lane = tid & 63, w = tid >> 6; const size_t m = (size_t)b * SEQ + t;
    __shared__ int idx[512]; __shared__ int nsel; __shared__ float qs[8][128]; __shared__ float p[4][256];
    if (tid == 0) nsel = 0;
    __syncthreads();
    for (int s = tid; s <= t; s += 256) { size_t word; int bit; mask_pos(t, s, word, bit);
        if ((MASKT[(size_t)b * 65536 + word] >> bit) & 1ull) { const int pos = atomicAdd(&nsel, 1); if (pos < 512) idx[pos] = s; } }
    for (int i = tid; i < 1024; i += 256) qs[i >> 7][i & 127] = bf2f(QA[HM(b, i >> 7, t, i & 127)]);
    __syncthreads();
    const int n = nsel < 256 ? nsel : 256;
    for (int hh = 0; hh < 2; ++hh) {
        const int h = w + 4 * hh; const float slope = exp2f(-(float)(h + 1));
        float sv[4]; float mx = -INFINITY;
#pragma unroll
        for (int i = 0; i < 4; ++i) { const int j = lane + 64 * i; sv[i] = -INFINITY;
            if (j < n) { const int s = idx[j]; const bf16_t* kp = KA + HM(b, h, s, 0); float dot = 0.f;
                for (int d = 0; d < 128; ++d) dot += qs[h][d] * bf2f(kp[d]);
                sv[i] = dot * QK_SCALE - slope * (float)(t - s); }
            mx = fmaxf(mx, sv[i]); }
        mx = wave_max(mx);
        float sum = 0.f;
#pragma unroll
        for (int i = 0; i < 4; ++i) { const int j = lane + 64 * i; const float pv = (j < n) ? __expf(sv[i] - mx) : 0.f; sum += pv; p[w][j] = pv; }
        sum = wave_sum(sum);
        __syncthreads();
        float o0 = 0.f, o1 = 0.f;
        for (int j = 0; j < n; ++j) { const float pj = p[w][j]; const int s = idx[j]; const unsigned vv = *(const unsigned*)(VA + HM(b, h, s, 2 * lane));
            o0 += pj * __uint_as_float(vv << 16); o1 += pj * __uint_as_float(vv & 0xffff0000u); }
        const float inv = 1.f / sum;
        const unsigned zz = *(const unsigned*)(SZA + HM(b, h, t, 2 * lane));
        o0 = o0 * inv * __uint_as_float(zz << 16); o1 = o1 * inv * __uint_as_float(zz & 0xffff0000u);
        *(unsigned*)(Y + m * 2048 + h * 128 + 2 * lane) = (unsigned)f2bf(o0) | ((unsigned)f2bf(o1) << 16);
        __syncthreads();
    }
}
__global__ void k_moba_naive(const bf16_t* __restrict__ QB, const bf16_t* __restrict__ KB, const bf16_t* __restrict__ VB, const bf16_t* __restrict__ SZB,
                             const float* __restrict__ KMEAN, bf16_t* __restrict__ Y) {
    const int t = blockIdx.x, b = blockIdx.y, tid = threadIdx.x, lane = tid & 63, w = tid >> 6; const size_t m = (size_t)b * SEQ + t;
    __shared__ float qs[8][128]; __shared__ float sc[4][SEQ];
    for (int i = tid; i < 1024; i += 256) qs[i >> 7][i & 127] = bf2f(QB[HM(b, i >> 7, t, i & 127)]);
    __syncthreads();
    const int qblk = t >> 8;
    for (int hh = 0; hh < 2; ++hh) {
        const int h = w + 4 * hh; const float slope = exp2f(-(float)(h + 1));
        float g = -INFINITY;
        if (lane < qblk) { const float* km = KMEAN + ((size_t)(b * NBLK + lane) * NH + h) * HD; float dot = 0.f; for (int d = 0; d < 128; ++d) dot += qs[h][d] * km[d]; g = dot; }
        int rank = 0;
        for (int n2 = 0; n2 < NBLK; ++n2) { const float g2 = __shfl(g, n2); if (n2 < qblk && (g2 > g || (g2 == g && n2 < lane))) ++rank; }
        const bool sel = (lane < qblk) && (rank < 3);
        const unsigned selmask = (unsigned)(__ballot(sel) & 0xffull);
        float mx = -INFINITY;
        for (int s = lane; s <= t; s += 64) { const int blk = s >> 8; float v = -INFINITY;
            if (blk == qblk || ((selmask >> blk) & 1u)) { const bf16_t* kp = KB + HM(b, h, s, 0); float dot = 0.f;
                for (int d = 0; d < 128; ++d) dot += qs[h][d] * bf2f(kp[d]);
                v = dot * QK_SCALE - slope * (float)(t - s); }
            sc[w][s] = v; mx = fmaxf(mx, v); }
        mx = wave_max(mx);
        float sum = 0.f;
        for (int s = lane; s <= t; s += 64) { const float v = sc[w][s]; const float pv = (v == -INFINITY) ? 0.f : __expf(v - mx); sc[w][s] = pv; sum += pv; }
        sum = wave_sum(sum);
        __syncthreads();
        float o0 = 0.f, o1 = 0.f;
        for (int s = 0; s <= t; ++s) { const float pj = sc[w][s]; if (pj == 0.f) continue; const unsigned vv = *(const unsigned*)(VB + HM(b, h, s, 2 * lane));
            o0 += pj * __uint_as_float(vv << 16); o1 += pj * __uint_as_float(vv & 0xffff0000u); }
        const float inv = 1.f / sum;
        const unsigned zz = *(const unsigned*)(SZB + HM(b, h, t, 2 * lane));
        o0 = o0 * inv * __uint_as_float(zz << 16); o1 = o1 * inv * __uint_as_float(zz & 0xffff0000u);
        *(unsigned*)(Y + m * 2048 + 1024 + h * 128 + 2 * lane) = (unsigned)f2bf(o0) | ((unsigned)f2bf(o1) << 16);
        __syncthreads();
    }
}

namespace pg8 {
#define PG8_LAS __attribute__((address_space(3)))
typedef unsigned short bf16_t;
typedef short bf16x8 __attribute__((ext_vector_type(8)));
typedef float f32x4 __attribute__((ext_vector_type(4)));
typedef unsigned u32x4 __attribute__((ext_vector_type(4)));
constexpr int BM = 256, BK = 64, HALF = 128, HTB = HALF * BK * 2  , STAGE_BYTES = 8 * HTB, NXCD = 8, WGM = 8;

__host__ __device__ __forceinline__ int lds_byte(int r, int c) { const int st = (r >> 4) * 2 + (c >> 5), rr = r & 15, cc = c & 31, ob = rr * 64 + cc * 2; return st * 1024 + (ob ^ (((ob >> 9) & 1) << 5)); }
__host__ __device__ __forceinline__ void stage_rc(int b, int& R, int& C) { const int st = b / 1024, sb = b % 1024, swz = sb ^ (((sb >> 9) & 1) << 5); R = (st >> 1) * 16 + swz / 64; C = (st & 1) * 32 + (swz % 64) / 2; }
__host__ __device__ __forceinline__ int perm32(int rho) { const int n = rho >> 4, i = rho & 15; return 8 * (i >> 2) + 4 * n + (i & 3); }

struct Unit { int pm, pn; };
struct Gemm { const void* A; const void* Bt; int M, N, K; };

struct StaticOrder {
    int nM, nN, nwg, G, c, jump_at, jump, base;
    __host__ __device__ void init(int M, int N, int G_, int c_, int base_ = 0, int jump_at_ = 1 << 30, int jump_ = 0) { nM = M / BM; nN = N / BM; nwg = nM * nN; G = G_; c = c_; base = base_; jump_at = jump_at_; jump = jump_; }
    __host__ __device__ bool next(int i, Unit& u) const {
        const long L = (long)i * G + c; if (L >= nwg) return false;
        int wgid = (int)L; { const int q = nwg / NXCD, r = nwg % NXCD, xcd = wgid % NXCD, off = wgid / NXCD; wgid = (xcd < r ? xcd * (q + 1) : r * (q + 1) + (xcd - r) * q) + off; }
        const int nig = WGM * nN, gid = wgid / nig, fm = gid * WGM, gsz = (nM - fm) < WGM ? (nM - fm) : WGM;
        u.pm = fm + ((wgid % nig) % gsz); const int d = (wgid % nig) / gsz; u.pn = d + (d >= jump_at ? jump : base); return true;
    }
    __device__ __forceinline__ void a_ready(const Unit&) const {}
    __device__ __forceinline__ void done(const Unit&) const {}
};

template <class Epi, class Sched, bool ALIGN_EPI = false, bool SP2 = false, bool FP8 = false>
__device__ __forceinline__ void gemm_phase(PG8_LAS unsigned char* lds, const Gemm g, const Sched& S, const Epi& E) {
    const int tid = threadIdx.x, wid = __builtin_amdgcn_readfirstlane(tid >> 6), lane = tid & 63, wr = wid >> 2, wc = wid & 3, fr = lane & 15, fq = lane >> 4;
    const int K = FP8 ? g.K / 2 : g.K, nt = K / BK;
    typedef int i32x8 __attribute__((ext_vector_type(8))); typedef int i32x4v __attribute__((ext_vector_type(4)));
    unsigned voffA[2], voffB[2];
#pragma unroll
    for (int i = 0; i < 2; ++i) { int R, C; stage_rc(tid * 16 + i * 8192, R, C); const int Rb = Epi::PERM ? ((R & ~31) + perm32(R & 31)) : R;
        voffA[i] = (unsigned)(R * K + C) * 2u; voffB[i] = (unsigned)(Rb * K + C) * 2u; }
    const size_t kstep = (size_t)(BK * 2);
    const size_t hstep = (size_t)HALF * K * 2;
    const size_t tstep = 2 * hstep;
    const unsigned ldsw = (unsigned)wid * 1024u;
    const int aoff = lds_byte(wr * 64 + fr, fq * 8), boff = lds_byte(wc * 32 + fr, fq * 8);
#define PG8_SA(b, h) (((b) * 2 + (h)) * HTB)
#define PG8_SB(b, h) ((4 + (b) * 2 + (h)) * HTB)
#define PG8_STAGE(bufoff, gbase, voff) do { _Pragma("unroll") for (int _i = 0; _i < 2; ++_i) \
        __builtin_amdgcn_global_load_lds((const unsigned*)((const char*)(gbase) + (voff)[_i]), (PG8_LAS unsigned*)(lds + (bufoff) + ldsw + _i * 8192), 16, 0, 0); } while (0)
#define PG8_LDA(dst, b, h) do { _Pragma("unroll") for (int m = 0; m < 4; ++m) { dst[m].lo = *(const PG8_LAS i32x4v*)(lds + PG8_SA(b, h) + aoff + m * 2048); dst[m].hi = *(const PG8_LAS i32x4v*)(lds + PG8_SA(b, h) + aoff + m * 2048 + 1024); } } while (0)
#define PG8_LDB(dst, b, h) do { _Pragma("unroll") for (int n = 0; n < 2; ++n) { dst[n].lo = *(const PG8_LAS i32x4v*)(lds + PG8_SB(b, h) + boff + n * 2048); dst[n].hi = *(const PG8_LAS i32x4v*)(lds + PG8_SB(b, h) + boff + n * 2048 + 1024); } } while (0)
#define PG8_MMA(ai, bj, At, Bt) do { __builtin_amdgcn_s_setprio(1); \
        if constexpr (FP8) { _Pragma("unroll") for (int m = 0; m < 4; ++m) _Pragma("unroll") for (int n = 0; n < 2; ++n) \
            asm volatile("v_mfma_f32_16x16x128_f8f6f4 %0, %1, %2, %0" : "+v"(acc[ai][bj][m][n]) : "v"(Bt[n]), "v"(At[m])); }   \
        else { _Pragma("unroll") for (int m = 0; m < 4; ++m) _Pragma("unroll") for (int n = 0; n < 2; ++n) { \
            const i32x4v bl_ = Bt[n].lo, bh_ = Bt[n].hi, al_ = At[m].lo, ah_ = At[m].hi;     \
            acc[ai][bj][m][n] = __builtin_amdgcn_mfma_f32_16x16x32_bf16(__builtin_bit_cast(bf16x8, bl_), __builtin_bit_cast(bf16x8, al_), acc[ai][bj][m][n], 0, 0, 0); \
            acc[ai][bj][m][n] = __builtin_amdgcn_mfma_f32_16x16x32_bf16(__builtin_bit_cast(bf16x8, bh_), __builtin_bit_cast(bf16x8, ah_), acc[ai][bj][m][n], 0, 0, 0); } } \
        __builtin_amdgcn_s_setprio(0); } while (0)
#define PG8_WAIT_V(n) asm volatile("s_waitcnt vmcnt(" #n ")" ::: "memory")
#define PG8_WAIT_L(n) asm volatile("s_waitcnt lgkmcnt(" #n ")" ::: "memory")
#define PG8_BAR __builtin_amdgcn_s_barrier()
#define PG8_SCHED __builtin_amdgcn_sched_barrier(0)
    Unit cur, nxt; int ui = 0;
    if (!S.next(0, cur)) return;
    f32x4 acc[2][2][4][2];
#pragma unroll
    for (int a = 0; a < 2; ++a)
#pragma unroll
        for (int b = 0; b < 2; ++b)
#pragma unroll
            for (int m = 0; m < 4; ++m)
#pragma unroll
                for (int n = 0; n < 2; ++n) acc[a][b][m][n] = (f32x4){0.f, 0.f, 0.f, 0.f};
    i32x8 At[4], B0[2], B1[2];
    const char* cA = (const char*)g.A + (size_t)cur.pm * tstep; const char* cB = (const char*)g.Bt + (size_t)cur.pn * tstep;
    S.a_ready(cur);
    if constexpr (SP2) {
        PG8_STAGE(PG8_SB(0, 0), cB, voffB); PG8_STAGE(PG8_SB(0, 1), cB + hstep, voffB); PG8_STAGE(PG8_SA(0, 0), cA, voffA); PG8_STAGE(PG8_SA(0, 1), cA + hstep, voffA);
        if (wr == 1) PG8_BAR;
        PG8_WAIT_V(2); PG8_BAR;
        PG8_STAGE(PG8_SB(1, 0), cB + kstep, voffB); PG8_STAGE(PG8_SA(1, 0), cA + kstep, voffA); PG8_STAGE(PG8_SB(1, 1), cB + hstep + kstep, voffB);
        PG8_WAIT_V(6); PG8_BAR;
    } else {
        PG8_STAGE(PG8_SB(0, 0), cB, voffB); PG8_STAGE(PG8_SA(0, 0), cA, voffA); PG8_STAGE(PG8_SB(0, 1), cB + hstep, voffB); PG8_STAGE(PG8_SA(0, 1), cA + hstep, voffA);
        if (wr == 1) PG8_BAR;
        PG8_WAIT_V(4); PG8_BAR;
        PG8_STAGE(PG8_SB(1, 0), cB + kstep, voffB); PG8_STAGE(PG8_SA(1, 0), cA + kstep, voffA); PG8_STAGE(PG8_SB(1, 1), cB + hstep + kstep, voffB);
        PG8_WAIT_V(6); PG8_BAR;
    }
    for (;;) {
        const bool has_next = S.next(ui + 1, nxt);
        const char* nA = has_next ? (const char*)g.A + (size_t)nxt.pm * tstep : cA; const char* nB = has_next ? (const char*)g.Bt + (size_t)nxt.pn * tstep : cB;
        for (int t = 0; t < nt; t += 2) {
            const bool last = (t == nt - 2);
            const char* a1 = cA + (size_t)(t + 1) * kstep;
            const char* a2 = last ? nA : cA + (size_t)(t + 2) * kstep; const char* b2 = last ? nB : cB + (size_t)(t + 2) * kstep;
            const char* a3 = a2 + kstep; const char* b3 = b2 + kstep;
            if (last && has_next) S.a_ready(nxt);
            if constexpr (SP2) {
            PG8_LDB(B0, 0, 0); PG8_LDB(B1, 0, 1); PG8_SCHED; PG8_LDA(At, 0, 0); PG8_STAGE(PG8_SA(1, 1), a1 + hstep, voffA);
            PG8_WAIT_V(8); PG8_WAIT_L(0); PG8_BAR; PG8_MMA(0, 0, At, B0); PG8_MMA(0, 1, At, B1); PG8_BAR; PG8_SCHED;
            PG8_LDA(At, 0, 1); PG8_STAGE(PG8_SB(0, 0), b2, voffB); PG8_STAGE(PG8_SB(0, 1), b2 + hstep, voffB); PG8_STAGE(PG8_SA(0, 0), a2, voffA);
            PG8_WAIT_V(8); PG8_WAIT_L(0); PG8_BAR; PG8_MMA(1, 0, At, B0); PG8_MMA(1, 1, At, B1); PG8_BAR; PG8_SCHED;
            PG8_LDB(B0, 1, 0); PG8_LDB(B1, 1, 1); PG8_SCHED; PG8_LDA(At, 1, 0); PG8_STAGE(PG8_SA(0, 1), a2 + hstep, voffA);
            PG8_WAIT_V(8); PG8_WAIT_L(0); PG8_BAR; PG8_MMA(0, 0, At, B0); PG8_MMA(0, 1, At, B1); PG8_BAR; PG8_SCHED;
            PG8_LDA(At, 1, 1); PG8_STAGE(PG8_SB(1, 0), b3, voffB); PG8_STAGE(PG8_SB(1, 1), b3 + hstep, voffB); PG8_STAGE(PG8_SA(1, 0), a3, voffA);
            PG8_WAIT_V(8); PG8_WAIT_L(0); PG8_BAR; PG8_MMA(1, 0, At, B0); PG8_MMA(1, 1, At, B1); PG8_BAR; PG8_SCHED;
            } else {
            PG8_LDB(B0, 0, 0); PG8_SCHED; PG8_LDA(At, 0, 0); PG8_STAGE(PG8_SA(1, 1), a1 + hstep, voffA);
            PG8_WAIT_L(8); PG8_BAR; PG8_WAIT_L(0); PG8_MMA(0, 0, At, B0); PG8_BAR; PG8_SCHED;
            PG8_LDB(B1, 0, 1); PG8_STAGE(PG8_SB(0, 0), b2, voffB);
            PG8_BAR; PG8_WAIT_L(0); PG8_MMA(0, 1, At, B1); PG8_BAR;
            PG8_LDA(At, 0, 1); PG8_STAGE(PG8_SA(0, 0), a2, voffA);
            PG8_BAR; PG8_WAIT_L(0); PG8_MMA(1, 0, At, B0); PG8_BAR; PG8_SCHED;
            PG8_STAGE(PG8_SB(0, 1), b2 + hstep, voffB);
            PG8_WAIT_V(6); PG8_BAR; PG8_MMA(1, 1, At, B1); PG8_BAR;
            PG8_LDB(B0, 1, 0); PG8_SCHED; PG8_LDA(At, 1, 0); PG8_STAGE(PG8_SA(0, 1), a2 + hstep, voffA);
            PG8_WAIT_L(8); PG8_BAR; PG8_WAIT_L(0); PG8_MMA(0, 0, At, B0); PG8_BAR; PG8_SCHED;
            PG8_LDB(B1, 1, 1); PG8_STAGE(PG8_SB(1, 0), b3, voffB);
            PG8_BAR; PG8_WAIT_L(0); PG8_MMA(0, 1, At, B1); PG8_BAR;
            PG8_LDA(At, 1, 1); PG8_STAGE(PG8_SA(1, 0), a3, voffA);
            PG8_BAR; PG8_WAIT_L(0); PG8_MMA(1, 0, At, B0); PG8_BAR; PG8_SCHED;
            PG8_STAGE(PG8_SB(1, 1), b3 + hstep, voffB);
            PG8_WAIT_V(6); PG8_BAR; PG8_MMA(1, 1, At, B1); PG8_BAR;
            }
        }
        if constexpr (ALIGN_EPI) { if (wr == 0) PG8_BAR; }
        if constexpr (FP8) asm volatile("s_nop 15\n\ts_nop 15" ::: "memory");
        PG8_SCHED;
        if constexpr (!Epi::AFTER_DRAIN) { E(acc, cur, wr, wc, fr, fq); S.done(cur); }
        PG8_SCHED;
        if (!has_next) break;
#pragma unroll
        for (int a = 0; a < 2; ++a)
#pragma unroll
            for (int b = 0; b < 2; ++b)
#pragma unroll
                for (int m = 0; m < 4; ++m)
#pragma unroll
                    for (int n = 0; n < 2; ++n) acc[a][b][m][n] = (f32x4){0.f, 0.f, 0.f, 0.f};
        cur = nxt; cA = nA; cB = nB; ++ui;
        if constexpr (ALIGN_EPI) { if (wr == 1) PG8_BAR; }
    }
    PG8_WAIT_V(0);
    if constexpr (!ALIGN_EPI) { if (wr == 0) PG8_BAR; }
    PG8_BAR;
    if constexpr (Epi::AFTER_DRAIN) { E.fused(acc, cur, wr, wc, fr, fq, lds, wid, lane); S.done(cur); }
#undef PG8_SA
#undef PG8_SB
#undef PG8_STAGE
#undef PG8_LDA
#undef PG8_LDB
#undef PG8_MMA
#undef PG8_WAIT_V
#undef PG8_WAIT_L
#undef PG8_BAR
#undef PG8_SCHED
}
}

#define GAS __attribute__((address_space(1)))
#define LAS __attribute__((address_space(3)))
typedef unsigned v4u __attribute__((ext_vector_type(4)));
typedef float f32x4 __attribute__((ext_vector_type(4)));
typedef GAS unsigned gu32;
#define RLX_AGENT __ATOMIC_RELAXED, __HIP_MEMORY_SCOPE_AGENT
#define LDS_WAIT() asm volatile("s_waitcnt lgkmcnt(0)" ::: "memory")
#define VM_WAIT() asm volatile("s_waitcnt vmcnt(0)" ::: "memory")
constexpr int NWAVES = 8;
constexpr int NPAD = 9472;
constexpr size_t MiB = 1u << 20;
constexpr size_t WS_CTL = 0, CTL_ZERO_BYTES = 1 * MiB;
constexpr size_t WS_MOD = 1 * MiB;
constexpr size_t WS_GAIN = 1 * MiB + 256 * 1024;
constexpr size_t WS_KMEAN = 1 * MiB + 512 * 1024;
constexpr size_t WS_WI = 2 * MiB;
constexpr size_t WS_KI = 3 * MiB;
constexpr size_t WS_MASK = 5 * MiB;
constexpr size_t WS_WOUT = 10 * MiB;
constexpr size_t WS_WIN = 18 * MiB;
constexpr size_t WS_HB = 56 * MiB;
constexpr size_t WS_Y = 56 * MiB;
constexpr size_t WS_QA = 120 * MiB, WS_KA = 152 * MiB, WS_VA = 184 * MiB, WS_SZA = 216 * MiB;
constexpr size_t WS_QB = 248 * MiB, WS_KB = 280 * MiB, WS_VB = 312 * MiB, WS_SZB = 344 * MiB;
constexpr size_t WS_QI = 376 * MiB;
constexpr size_t WS_T32 = 408 * MiB;
constexpr size_t WS_Y8 = 408 * MiB;
constexpr size_t WS_HB8 = 440 * MiB;
constexpr size_t WS_WIN8 = 472 * MiB;
constexpr size_t WS_WOUT8 = 492 * MiB;
constexpr size_t WS_END = 496 * MiB;
constexpr float FP8_DESCALE = 1.f / 512.f;
constexpr int CW_BAR = 4096;
constexpr int RING_BYTES = 131072;
constexpr int EPI_OFF = RING_BYTES;
constexpr int LDSCTL_OFF = EPI_OFF + 16384, MISC_OFF = LDSCTL_OFF + 320;
constexpr int LDS_BYTES = 163840;

#define XB_TMO      128
#define XB_XCNT(j)  (256  + 64 * (j))
#define XB_XSUB(j)  (1280 + 64 * (j))
#define XB_XGEN(j)  (2304 + 64 * (j))
#define XB_TOP      3328
#define XB_TOPGEN   3392
#define XCD_BAR_WORDS 3456
#define XB_SPIN_CAP (1u << 18)

__device__ __forceinline__ unsigned xb_ld(unsigned* p)              { return __hip_atomic_load(p, __ATOMIC_RELAXED, __HIP_MEMORY_SCOPE_AGENT); }
__device__ __forceinline__ unsigned xb_add(unsigned* p, unsigned v) { return __hip_atomic_fetch_add(p, v, __ATOMIC_RELAXED, __HIP_MEMORY_SCOPE_AGENT); }
__device__ __forceinline__ unsigned xb_xcc_id() { return (unsigned)__builtin_amdgcn_s_getreg((3 << 11) | 20) & 0xFu; }
#define XB_SPIN(cond, bar) do { unsigned _sp = 0; while (cond) { __builtin_amdgcn_s_sleep(1); \
    if ((++_sp & 255u) == 0u) { if (xb_ld(&(bar)[XB_TMO])) break; if (_sp > XB_SPIN_CAP) { atomicAdd(&(bar)[XB_TMO], 1u); break; } } } } while (0)

struct XcdBarrier {
    unsigned* bar; unsigned x;
    volatile LAS unsigned* st;
};

__device__ __forceinline__ XcdBarrier xcd_barrier_post(unsigned* bar, volatile LAS unsigned* st) {
    XcdBarrier b; b.bar = bar; b.x = xb_xcc_id(); b.st = st;
    if (threadIdx.x == 0) (void)xb_add(&bar[XB_XCNT(b.x)], 1u);
    return b;
}
__device__ __forceinline__ void xcd_barrier_complete(unsigned* bar, unsigned x, unsigned& nloc, unsigned& nx) {
    const unsigned G = gridDim.x * gridDim.y * gridDim.z;
    unsigned sum, cnt, mine, sp = 0u;
    for (;;) {
        sum = 0u; cnt = 0u; mine = 0u;
#pragma unroll
        for (unsigned j = 0; j < 16; ++j) { const unsigned c = xb_ld(&bar[XB_XCNT(j)]); sum += c; cnt += (c > 0u) ? 1u : 0u; mine = (j == x) ? c : mine; }
        if (sum == G) break;
        __builtin_amdgcn_s_sleep(1);
        if ((++sp & 255u) == 0u) { if (xb_ld(&bar[XB_TMO])) break; if (sp > XB_SPIN_CAP) { atomicAdd(&bar[XB_TMO], 1u); break; } }
    }
    nloc = mine > 0u ? mine : 1u; nx = cnt > 0u ? cnt : 1u;
}

__device__ __forceinline__ void xcd_barrier(const XcdBarrier& b) {
    asm volatile("s_waitcnt vmcnt(0)" ::: "memory");
    __syncthreads();
    if (threadIdx.x == 0) {
        unsigned* bar = b.bar;
        __builtin_amdgcn_s_waitcnt(0);
        unsigned nloc = b.st[0], nx = b.st[1];
        if (nloc == 0u) { xcd_barrier_complete(bar, b.x, nloc, nx); b.st[0] = nloc; b.st[1] = nx; }
        const unsigned old = xb_add(&bar[XB_XSUB(b.x)], 1u);
        const unsigned gen = old / nloc;
        if (old + 1u == (gen + 1u) * nloc) {
            __builtin_amdgcn_fence(__ATOMIC_RELEASE, "agent");
            asm volatile("s_waitcnt vmcnt(0)" ::: "memory");
            const unsigned og = xb_add(&bar[XB_TOP], 1u);
            const unsigned tg = og / nx;
            if (og + 1u == (tg + 1u) * nx) xb_add(&bar[XB_TOPGEN], 1u);
            else XB_SPIN(xb_ld(&bar[XB_TOPGEN]) == tg, bar);
            __builtin_amdgcn_fence(__ATOMIC_ACQUIRE, "agent");
            xb_add(&bar[XB_XGEN(b.x)], 1u);
            asm volatile("s_waitcnt vmcnt(0)" ::: "memory");
        } else {
            XB_SPIN(xb_ld(&bar[XB_XGEN(b.x)]) == gen, bar);
            __builtin_amdgcn_fence(__ATOMIC_ACQUIRE, "agent");
            asm volatile("s_waitcnt vmcnt(0)" ::: "memory");
        }
    }
    __syncthreads();
}


struct Frame {
    LAS unsigned char* lds; volatile LAS unsigned* MISC; gu32* ctl; int tid, lane, wave, vcu, G;
};
__device__ __forceinline__ unsigned cvt_pk_bf16(float lo, float hi) { unsigned r; asm volatile("v_cvt_pk_bf16_f32 %0, %1, %2" : "=v"(r) : "v"(lo), "v"(hi)); return r; }
__device__ __forceinline__ unsigned f2bf_u(float f) { unsigned u = __builtin_bit_cast(unsigned, f); return (u + 0x7fffu + ((u >> 16) & 1u)) >> 16; }
__device__ __forceinline__ unsigned pk2(float lo, float hi) { return f2bf_u(lo) | (f2bf_u(hi) << 16); }
__device__ __forceinline__ float fast_silu(float v) { return v * __builtin_amdgcn_rcpf(1.f + __expf(-v)); }

__device__ __forceinline__ void p0_mod(Frame& F, int id, const float* __restrict__ c, const float* __restrict__ w_ada, const float* __restrict__ b_ada, float* __restrict__ MOD) {
    LAS float* sc = (LAS float*)(F.lds);
    LAS float* red = (LAS float*)(F.lds + 65536);
    for (int i = F.tid; i < BATCH * DM; i += NWAVES * 64) sc[i] = silu_f(c[i]);
    __syncthreads();
    const int cq = F.tid & 7, kq = F.tid >> 3, col0 = 32 * id + 4 * cq;
    f32x4 acc[8];
#pragma unroll
    for (int b = 0; b < 8; ++b) acc[b] = (f32x4){0.f, 0.f, 0.f, 0.f};
#pragma unroll 4
    for (int i = 0; i < 32; ++i) { const int k = kq + 64 * i; const f32x4 w = *(const f32x4*)(w_ada + (size_t)k * (3 * DM) + col0);
#pragma unroll
        for (int b = 0; b < 8; ++b) acc[b] += w * sc[b * DM + k]; }
#pragma unroll
    for (int b = 0; b < 8; ++b) *(LAS f32x4*)(red + (kq * 8 + b) * 32 + 4 * cq) = acc[b];
    __syncthreads();
    if (F.tid < 256) { const int b = F.tid >> 5, cc = F.tid & 31; float s = 0.f;
        for (int q = 0; q < 64; ++q) s += red[(q * 8 + b) * 32 + cc];
        MOD[b * 3 * DM + 32 * id + cc] = s + b_ada[32 * id + cc]; }
    __syncthreads();
}
__device__ __forceinline__ unsigned pk4_fp8(float a, float b, float c, float d) {
    a = fminf(fmaxf(a, -448.f), 448.f); b = fminf(fmaxf(b, -448.f), 448.f); c = fminf(fmaxf(c, -448.f), 448.f); d = fminf(fmaxf(d, -448.f), 448.f);
    int w = 0; w = __builtin_amdgcn_cvt_pk_fp8_f32(a, b, w, false); w = __builtin_amdgcn_cvt_pk_fp8_f32(c, d, w, true); return (unsigned)w; }
template <bool MAPWIN>
__device__ __forceinline__ void p0_transpose_item(const float* __restrict__ W, int K, int N, int NP, bf16_t* __restrict__ WT, unsigned char* __restrict__ WT8, LAS float* scr, int item, int lane) {
    const int nblk = NP / 32, kb = item / nblk, nb = item % nblk, k0 = 64 * kb, n0 = 32 * nb;
    const int np = n0 + (lane & 31);
    int src = np; bool valid = true;
    if (MAPWIN) { if (np >= 5376) src = np - 176; else if (np >= 5200) valid = false; }
#pragma unroll 8
    for (int i = 0; i < 32; ++i) { const int kk = 2 * i + (lane >> 5); scr[kk * 33 + (lane & 31)] = valid ? W[(size_t)(k0 + kk) * N + src] : 0.f; }
    LDS_WAIT(); asm volatile("" ::: "memory");
    const int c = lane & 7;
#pragma unroll
    for (int j = 0; j < 4; ++j) { const int n = (lane >> 3) + 8 * j; const LAS float* s = scr + (8 * c) * 33 + n;
        v4u o; o.x = pk2(s[0 * 33], s[1 * 33]); o.y = pk2(s[2 * 33], s[3 * 33]); o.z = pk2(s[4 * 33], s[5 * 33]); o.w = pk2(s[6 * 33], s[7 * 33]);
        *(GAS v4u*)(WT + (size_t)(n0 + n) * K + k0 + 8 * c) = o; }
    if (WT8) {
#pragma unroll
        for (int jj = 0; jj < 2; ++jj) { const int idx = lane + 64 * jj, n = idx >> 2, c4 = idx & 3; const LAS float* s = scr + (16 * c4) * 33 + n;
            v4u o; o.x = pk4_fp8(s[0 * 33] * 64.f, s[1 * 33] * 64.f, s[2 * 33] * 64.f, s[3 * 33] * 64.f); o.y = pk4_fp8(s[4 * 33] * 64.f, s[5 * 33] * 64.f, s[6 * 33] * 64.f, s[7 * 33] * 64.f);
            o.z = pk4_fp8(s[8 * 33] * 64.f, s[9 * 33] * 64.f, s[10 * 33] * 64.f, s[11 * 33] * 64.f); o.w = pk4_fp8(s[12 * 33] * 64.f, s[13 * 33] * 64.f, s[14 * 33] * 64.f, s[15 * 33] * 64.f);
            *(GAS v4u*)(WT8 + (size_t)(n0 + n) * K + k0 + 16 * c4) = o; } }
    LDS_WAIT(); asm volatile("" ::: "memory");
}
__device__ __forceinline__ void p0_convert(Frame& F, const float* __restrict__ w_in, const float* __restrict__ w_out, bf16_t* __restrict__ WinT, bf16_t* __restrict__ WoutT, unsigned char* __restrict__ WinT8, unsigned char* __restrict__ WoutT8) {
    LAS float* scr = (LAS float*)(F.lds + F.wave * 16384);
    const int gw = F.vcu * NWAVES + F.wave, NGW = F.G * NWAVES;
    constexpr int I_IN = (DM / 64) * (NPAD / 32), I_OUT = (DM / 64) * (DM / 32);
    for (int it = gw; it < I_IN + I_OUT; it += NGW) {
        if (it < I_IN) p0_transpose_item<true>(w_in, DM, DIN, NPAD, WinT, WinT8, scr, it, F.lane);
        else p0_transpose_item<false>(w_out, DM, DM, DM, WoutT, WoutT8, scr, it - I_IN, F.lane);
    }
}
__device__ __forceinline__ void p1_norm(Frame& F, const float* __restrict__ x, const float* __restrict__ g, const float* __restrict__ MOD, bf16_t* __restrict__ HB, unsigned char* __restrict__ HB8) {
    for (int v = F.vcu; v < M / 64; v += F.G) {
        const int b = v / (SEQ / 64);
        const float* shift = MOD + b * 3 * DM; const float* scale = shift + DM;
        f32x4 gs[8], sh[8];
#pragma unroll
        for (int j = 0; j < 8; ++j) { const int k = 4 * F.lane + 256 * j; const f32x4 gg = *(const f32x4*)(g + k), ss = *(const f32x4*)(scale + k); gs[j] = gg * (ss + 1.0f); sh[j] = *(const f32x4*)(shift + k); }
        for (int r = 0; r < 8; ++r) {
            const int row = 64 * v + 8 * F.wave + r;
            const f32x4* xr = (const f32x4*)(x + (size_t)row * DM) + F.lane;
            f32x4 xv[8]; float ss = 0.f;
#pragma unroll
            for (int j = 0; j < 8; ++j) { xv[j] = xr[64 * j]; ss += (xv[j].x * xv[j].x + xv[j].y * xv[j].y) + (xv[j].z * xv[j].z + xv[j].w * xv[j].w); }
            ss = wave_sum(ss);
            const float rstd = rsqrtf(ss * (1.f / DM) + RMS_EPS);
            unsigned long long* o8 = (unsigned long long*)(HB + (size_t)row * DM) + F.lane; unsigned* o4 = (unsigned*)(HB8 + (size_t)row * DM) + F.lane;
#pragma unroll
            for (int j = 0; j < 8; ++j) { const f32x4 h = xv[j] * rstd * gs[j] + sh[j];
                o8[64 * j] = (unsigned long long)pk2(h.x, h.y) | ((unsigned long long)pk2(h.z, h.w) << 32);
                o4[64 * j] = pk4_fp8(h.x * 8.f, h.y * 8.f, h.z * 8.f, h.w * 8.f); }
        }
    }
}
struct EpiProj {
    static constexpr bool PERM = true, AFTER_DRAIN = false;
    unsigned char* ws;
    LAS float* P; float osc;
    __device__ __forceinline__ void operator()(const pg8::f32x4 (&acc)[2][2][4][2], const pg8::Unit& u, int wr, int wc, int fr, int fq) const {
        { int l_ = threadIdx.x & 63; asm volatile("" : "+v"(l_)); fr = l_ & 15; fq = l_ >> 4; }
        const int pn = u.pn;
        bf16_t* const KI = (bf16_t*)(ws + WS_KI); float* const WI = (float*)(ws + WS_WI); bf16_t* const QI = (bf16_t*)(ws + WS_QI);
        int grp, sub;
        if (pn < 20) { grp = pn >> 2; sub = pn & 3; } else if (pn == 20) { grp = 5; sub = 0; } else { grp = 6 + ((pn - 21) >> 2); sub = (pn - 21) & 3; }
        const int b = u.pm >> 3, t0 = (u.pm & 7) * 256 + wr * 64 + fr;
        const int cl = 32 * wc + 8 * fq;
        const bool norm = (grp == 0 || grp == 1 || grp == 6 || grp == 7 || grp == 5);
        float rs[2][4][2];
        if (norm) {
#pragma unroll
            for (int ai = 0; ai < 2; ++ai)
#pragma unroll
                for (int m = 0; m < 4; ++m)
#pragma unroll
                    for (int bj = 0; bj < 2; ++bj) { const pg8::f32x4 a = acc[ai][bj][m][0], c = acc[ai][bj][m][1];
                        float s = (a[0] * a[0] + a[1] * a[1]) + (a[2] * a[2] + a[3] * a[3]) + (c[0] * c[0] + c[1] * c[1]) + (c[2] * c[2] + c[3] * c[3]);
                        s += __shfl_xor(s, 16); s += __shfl_xor(s, 32);
                        if (fq == 0) P[((ai * 128 + wr * 64 + m * 16 + fr) * 2 + bj) * 4 + wc] = s; }
            asm volatile("s_waitcnt lgkmcnt(0)" ::: "memory"); __builtin_amdgcn_s_barrier(); asm volatile("" ::: "memory");
#pragma unroll
            for (int ai = 0; ai < 2; ++ai)
#pragma unroll
                for (int m = 0; m < 4; ++m)
#pragma unroll
                    for (int bj = 0; bj < 2; ++bj) { const pg8::f32x4 q = *(const LAS pg8::f32x4*)(P + ((ai * 128 + wr * 64 + m * 16 + fr) * 2 + bj) * 4);
                        rs[ai][m][bj] = ((grp == 5) ? rsqrtf((q[0] + q[1]) * (osc * osc * (1.f / 64.f)) + RMS_EPS) : rsqrtf(((q[0] + q[1]) + (q[2] + q[3])) * (osc * osc * (1.f / 128.f)) + RMS_EPS)) * osc; }
        }
        if (grp == 5) {
            if (wc < 2) { const float* gki = (const float*)(ws + WS_GAIN) + 4 * 128; const pg8::f32x4 g0 = *(const pg8::f32x4*)(gki + cl), g1 = *(const pg8::f32x4*)(gki + cl + 4);
#pragma unroll
                for (int ai = 0; ai < 2; ++ai)
#pragma unroll
                    for (int m = 0; m < 4; ++m) { const size_t row = (size_t)b * SEQ + t0 + 128 * ai + 16 * m; const float r = rs[ai][m][0];
                        const pg8::f32x4 v0 = acc[ai][0][m][0] * r * g0, v1 = acc[ai][0][m][1] * r * g1;
                        pg8::u32x4 w; w.x = cvt_pk_bf16(v0[0], v0[1]); w.y = cvt_pk_bf16(v0[2], v0[3]); w.z = cvt_pk_bf16(v1[0], v1[1]); w.w = cvt_pk_bf16(v1[2], v1[3]);
                        *(pg8::u32x4*)(KI + row * 64 + cl) = w; } }
            else if (wc == 2 && fq < 2) {
#pragma unroll
                for (int ai = 0; ai < 2; ++ai)
#pragma unroll
                    for (int m = 0; m < 4; ++m) { const size_t row = (size_t)b * SEQ + t0 + 128 * ai + 16 * m;
                        *(pg8::f32x4*)(WI + row * 16 + 8 * fq) = acc[ai][0][m][0]; *(pg8::f32x4*)(WI + row * 16 + 8 * fq + 4) = acc[ai][0][m][1]; } }
            return;
        }
        if (grp == 4) {
#pragma unroll
            for (int ai = 0; ai < 2; ++ai)
#pragma unroll
                for (int m = 0; m < 4; ++m) { const size_t row = (size_t)b * SEQ + t0 + 128 * ai + 16 * m;
#pragma unroll
                    for (int bj = 0; bj < 2; ++bj) { const pg8::f32x4 v0 = acc[ai][bj][m][0], v1 = acc[ai][bj][m][1];
                        pg8::u32x4 w; w.x = cvt_pk_bf16(v0[0], v0[1]); w.y = cvt_pk_bf16(v0[2], v0[3]); w.z = cvt_pk_bf16(v1[0], v1[1]); w.w = cvt_pk_bf16(v1[2], v1[3]);
                        *(pg8::u32x4*)(QI + row * 1024 + sub * 256 + bj * 128 + cl) = w; } }
            return;
        }
        bf16_t* dst; const float* gain = nullptr;
        { const int slot = grp < 4 ? grp : grp - 2;
          dst = (bf16_t*)(ws + WS_QA + (size_t)slot * (32 * MiB));
          gain = (const float*)(ws + WS_GAIN) + (grp < 2 ? grp : grp - 4) * 128; }
        pg8::f32x4 g0 = {1.f, 1.f, 1.f, 1.f}, g1 = {1.f, 1.f, 1.f, 1.f};
        if (norm) { g0 = *(const pg8::f32x4*)(gain + cl); g1 = *(const pg8::f32x4*)(gain + cl + 4); }
        const bool act = (grp == 3 || grp == 9);
#pragma unroll
        for (int ai = 0; ai < 2; ++ai)
#pragma unroll
            for (int m = 0; m < 4; ++m) { const int t = t0 + 128 * ai + 16 * m;
#pragma unroll
                for (int bj = 0; bj < 2; ++bj) { const int h = 2 * sub + bj;
                    pg8::f32x4 v0 = acc[ai][bj][m][0], v1 = acc[ai][bj][m][1];
                    if (norm) { const float r = rs[ai][m][bj]; v0 = v0 * r * g0; v1 = v1 * r * g1; } else { v0 = v0 * osc; v1 = v1 * osc; }
                    if (act) { v0[0] = fast_silu(v0[0]); v0[1] = fast_silu(v0[1]); v0[2] = fast_silu(v0[2]); v0[3] = fast_silu(v0[3]);
                               v1[0] = fast_silu(v1[0]); v1[1] = fast_silu(v1[1]); v1[2] = fast_silu(v1[2]); v1[3] = fast_silu(v1[3]); }
                    pg8::u32x4 w; w.x = cvt_pk_bf16(v0[0], v0[1]); w.y = cvt_pk_bf16(v0[2], v0[3]); w.z = cvt_pk_bf16(v1[0], v1[1]); w.w = cvt_pk_bf16(v1[2], v1[3]);
                    *(pg8::u32x4*)(dst + HM(b, h, t, cl)) = w; } }
    }
};
struct EpiOut {
    static constexpr bool PERM = false, AFTER_DRAIN = false;
    const float* x; const float* MOD; float* out; float oscale;
    __device__ __forceinline__ void operator()(const pg8::f32x4 (&acc)[2][2][4][2], const pg8::Unit& u, int wr, int wc, int fr, int fq) const {
        { int l_ = threadIdx.x & 63; asm volatile("" : "+v"(l_)); fr = l_ & 15; fq = l_ >> 4; }
        const int b = u.pm >> 3; const float* gate = MOD + b * 3 * DM + 2 * DM;
        const int col0 = u.pn * 256 + wc * 32 + 4 * fq;
        pg8::f32x4 gv[2][2];
#pragma unroll
        for (int bj = 0; bj < 2; ++bj)
#pragma unroll
            for (int n = 0; n < 2; ++n) gv[bj][n] = *(const pg8::f32x4*)(gate + col0 + bj * 128 + n * 16) * oscale;
#pragma unroll
        for (int ai = 0; ai < 2; ++ai)
#pragma unroll
            for (int m = 0; m < 4; ++m) { const size_t off = (size_t)(u.pm * 256 + ai * 128 + wr * 64 + m * 16 + fr) * DM + col0;
#pragma unroll
                for (int bj = 0; bj < 2; ++bj)
#pragma unroll
                    for (int n = 0; n < 2; ++n) { const pg8::f32x4 xv = *(const pg8::f32x4*)(x + off + bj * 128 + n * 16);
                        *(pg8::f32x4*)(out + off + bj * 128 + n * 16) = xv + gv[bj][n] * acc[ai][bj][m][n]; }
                if (m & 1) asm volatile("" ::: "memory"); }
    }
};

namespace att {
typedef short bf16x8 __attribute__((ext_vector_type(8)));
typedef short s16x4 __attribute__((ext_vector_type(4)));
typedef float f32x16 __attribute__((ext_vector_type(16)));
typedef float f32x4 __attribute__((ext_vector_type(4)));
typedef unsigned u32x4 __attribute__((ext_vector_type(4)));
constexpr int NW = 8, QBLK = 32, KVBLK = 64, QB = NW * QBLK, D = 128;
constexpr int SHM_V = KVBLK * D * 2, SHM_K = KVBLK * D * 2;
constexpr int LDS_WS = 2 * SHM_V + 2 * SHM_K, LDS_KM = LDS_WS + NW * 64 * 4, LDS_OST = 73728, MST_PITCH = 264, MST_WAVE = QBLK * MST_PITCH, LDS_BYTES = LDS_OST + NW * MST_WAVE;
constexpr float SCALE = 0.08838834764831845f, THR = 8.f;
#define KSWZ(row, colB) ((row) * 256 + ((colB) ^ (((row) & 7) << 4)))
#define SBAR() __builtin_amdgcn_sched_barrier(0)
__device__ __forceinline__ int v_st(int k, int c) { const int kk = (k & ~0xC) | ((k & 4) << 1) | ((k & 8) >> 1); return ((kk >> 3) * 4 + (c >> 5)) * 512 + ((kk & 7) * 32 + (c & 31)) * 2; }
__device__ __forceinline__ int v_rd_base(int lane) { return ((lane & 3) << 3) | (((lane >> 2) & 3) << 6) | (((lane >> 4) & 1) << 5) | (((lane >> 5) & 1) << 8); }
constexpr int v_rd_off(int d0, int ks, int half) { return d0 * 512 + ks * 4096 + half * 2048; }
__device__ __forceinline__ int crow(int r, int hi) { return (r & 3) + 8 * (r >> 2) + 4 * hi; }
__device__ __forceinline__ unsigned cvtpk(float lo, float hi) { unsigned r; asm volatile("v_cvt_pk_bf16_f32 %0, %1, %2" : "=v"(r) : "v"(lo), "v"(hi)); return r; }
__device__ __forceinline__ unsigned cvt1(float v) { unsigned r; asm volatile("v_cvt_pk_bf16_f32 %0, %1, 0" : "=v"(r) : "v"(v)); return r; }
__device__ __forceinline__ bf16x8 load8(const bf16_t* p) { return *reinterpret_cast<const bf16x8*>(p); }
__device__ __forceinline__ void mask_causal(f32x16& p0, f32x16& p1, int dq) {
    const float NEG = -__builtin_inff();
#pragma unroll
    for (int r = 0; r < 16; ++r) { const int c = (r & 3) + 8 * (r >> 2); if (dq - c < 0) p0[r] = NEG; if (dq - c - 32 < 0) p1[r] = NEG; }
}
__device__ __forceinline__ void mask_bits(f32x16& p0, f32x16& p1, unsigned w0, unsigned w1) {
    const unsigned NEGB = 0xff800000u;
#pragma unroll
    for (int r = 0; r < 16; ++r) { const int c = (r & 3) + 8 * (r >> 2);
        const unsigned t0 = (unsigned)(((int)(w0 << (31 - c))) >> 31), t1 = (unsigned)(((int)(w1 << (31 - c))) >> 31);
        p0[r] = __uint_as_float((__float_as_uint(p0[r]) & t0) | (NEGB & ~t0));
        p1[r] = __uint_as_float((__float_as_uint(p1[r]) & t1) | (NEGB & ~t1)); }
}
__device__ __forceinline__ void partialSM(f32x16& p0, f32x16& p1, float& m_reg, float& mn, float& alpha) {
    float pmax = p0[0]; for (int r = 1; r < 16; ++r) pmax = fmaxf(pmax, p0[r]); for (int r = 0; r < 16; ++r) pmax = fmaxf(pmax, p1[r]);
    { auto rr = __builtin_amdgcn_permlane32_swap(__float_as_uint(pmax), __float_as_uint(pmax), false, false);
      pmax = fmaxf(__uint_as_float(rr[0]), __uint_as_float(rr[1])); }
    constexpr float C2 = 1.4426950408889634f * SCALE;
    if (__builtin_expect(__all((pmax - m_reg) * SCALE <= THR), 1)) { mn = m_reg; alpha = 1.f; }
    else { mn = fmaxf(m_reg, pmax); alpha = __builtin_amdgcn_exp2f((m_reg - mn) * C2); m_reg = mn; }
    const float mnL = -mn * C2;
    for (int r = 0; r < 16; ++r) p0[r] = fmaf(p0[r], C2, mnL); for (int r = 0; r < 16; ++r) p1[r] = fmaf(p1[r], C2, mnL);
    for (int r = 0; r < 16; ++r) p0[r] = __builtin_amdgcn_exp2f(p0[r]);
}
__device__ __forceinline__ void finishSM(f32x16& p0, f32x16& p1, float alpha, float& l_reg, bf16x8& pa0, bf16x8& pa1, bf16x8& pa2, bf16x8& pa3) {
    for (int r = 0; r < 16; ++r) p1[r] = __builtin_amdgcn_exp2f(p1[r]);
    float ps = 0; for (int r = 0; r < 16; ++r) ps += p0[r]; for (int r = 0; r < 16; ++r) ps += p1[r];
    { auto rr = __builtin_amdgcn_permlane32_swap(__float_as_uint(ps), __float_as_uint(ps), false, false);
      ps = __uint_as_float(rr[0]) + __uint_as_float(rr[1]); }
    l_reg = l_reg * alpha + ps;
#define PK4(P, B_, OUT) do { unsigned a0 = cvtpk(P[B_+0], P[B_+1]), a1 = cvtpk(P[B_+2], P[B_+3]);                          \
        unsigned b0 = cvtpk(P[B_+4], P[B_+5]), b1 = cvtpk(P[B_+6], P[B_+7]);                                             \
        auto r0 = __builtin_amdgcn_permlane32_swap(a0, b0, false, false); auto r1 = __builtin_amdgcn_permlane32_swap(a1, b1, false, false); \
        u32x4 w = {r0[0], r1[0], r0[1], r1[1]}; OUT = *reinterpret_cast<bf16x8*>(&w); } while (0)
    PK4(p0, 0, pa0); PK4(p0, 8, pa1); PK4(p1, 0, pa2); PK4(p1, 8, pa3);
#undef PK4
}
template <int KB>
__device__ __forceinline__ void qkt(f32x16& p0, f32x16& p1, const char* K_lds, int r32, int hi, const bf16x8* qr, float cb, float sl) {
#pragma unroll
    for (int r = 0; r < 16; ++r) { const int c = (r & 3) + 8 * (r >> 2); p0[r] = fmaf(sl, (float)c, cb); p1[r] = fmaf(sl, (float)(c + 32), cb); }
    const char* kb[4];
#pragma unroll
    for (int dd = 0; dd < 4; ++dd) kb[dd] = K_lds + KB * SHM_K + KSWZ(r32, (dd * 16 + hi * 8) * 2);
#pragma unroll
    for (int d0 = 0; d0 < 8; ++d0) { const char* a = kb[d0 & 3] + (d0 >> 2) * 128;
        bf16x8 b0 = *reinterpret_cast<const bf16x8*>(a);
        bf16x8 b1 = *reinterpret_cast<const bf16x8*>(a + 32 * 256);
        p0 = __builtin_amdgcn_mfma_f32_32x32x16_bf16(b0, qr[d0], p0, 0, 0, 0);
        p1 = __builtin_amdgcn_mfma_f32_32x32x16_bf16(b1, qr[d0], p1, 0, 0, 0); }
}
template <int VB>
__device__ __forceinline__ void pv_tile(f32x16* o, int vb0, bf16x8 pa0, bf16x8 pa1, bf16x8 pa2, bf16x8 pa3) {
#define TRRD(dst, off) asm volatile("ds_read_b64_tr_b16 %0, %1 offset:%2" : "=&v"(dst) : "v"(vb0), "i"(off) : "memory")
#define PV_D0(d0) do { s16x4 l0, l1, l2, l3, h0, h1, h2, h3; constexpr int b_ = VB * SHM_V + v_rd_off(d0, 0, 0); \
        TRRD(l0, b_); TRRD(h0, b_ + 2048); TRRD(l1, b_ + 4096); TRRD(h1, b_ + 6144); TRRD(l2, b_ + 8192); TRRD(h2, b_ + 10240); TRRD(l3, b_ + 12288); TRRD(h3, b_ + 14336); \
        asm volatile("s_waitcnt lgkmcnt(0)" ::: "memory"); SBAR();   \
        o[d0] = __builtin_amdgcn_mfma_f32_32x32x16_bf16(pa0, (bf16x8){l0[0], l0[1], l0[2], l0[3], h0[0], h0[1], h0[2], h0[3]}, o[d0], 0, 0, 0);   \
        o[d0] = __builtin_amdgcn_mfma_f32_32x32x16_bf16(pa1, (bf16x8){l1[0], l1[1], l1[2], l1[3], h1[0], h1[1], h1[2], h1[3]}, o[d0], 0, 0, 0);   \
        o[d0] = __builtin_amdgcn_mfma_f32_32x32x16_bf16(pa2, (bf16x8){l2[0], l2[1], l2[2], l2[3], h2[0], h2[1], h2[2], h2[3]}, o[d0], 0, 0, 0);   \
        o[d0] = __builtin_amdgcn_mfma_f32_32x32x16_bf16(pa3, (bf16x8){l3[0], l3[1], l3[2], l3[3], h3[0], h3[1], h3[2], h3[3]}, o[d0], 0, 0, 0); } while (0)
    PV_D0(0); PV_D0(1); PV_D0(2); PV_D0(3);
#undef PV_D0
#undef TRRD
}

struct BlockRef { int grp, b, h, qb; };
__device__ __forceinline__ size_t hm_off(const BlockRef& r) { return ((size_t)(r.b * NH + r.h) * SEQ) * D; }
__device__ __forceinline__ const bf16_t* ptrQ(unsigned char* wsb, const BlockRef& r) { return (const bf16_t*)(wsb + (r.grp ? WS_QB : WS_QA)) + hm_off(r) + (size_t)r.qb * QB * D; }
__device__ __forceinline__ const bf16_t* ptrK(unsigned char* wsb, const BlockRef& r) { return (const bf16_t*)(wsb + (r.grp ? WS_KB : WS_KA)) + hm_off(r); }
__device__ __forceinline__ const bf16_t* ptrV(unsigned char* wsb, const BlockRef& r) { return (const bf16_t*)(wsb + (r.grp ? WS_VB : WS_VA)) + hm_off(r); }
__device__ __forceinline__ const bf16_t* ptrZ(unsigned char* wsb, const BlockRef& r) { return (const bf16_t*)(wsb + (r.grp ? WS_SZB : WS_SZA)) + hm_off(r) + (size_t)r.qb * QB * D; }
struct Seam { bf16x8 qr[8]; bf16x8 st_v0, st_v1, st_k0, st_k1; };
#define ROW(p, k0, rr) ((const bf16_t*)((const char*)(p) + (unsigned)(((k0) + (rr)) * (D * 2) + sc * 2)))
#define VMW() asm volatile("s_waitcnt vmcnt(0)" ::: "memory")
#define VMWN(n) asm volatile("s_waitcnt vmcnt(%0)" :: "i"(n) : "memory")
#define SLOAD_H(Kp, Vp, k0) do { S.st_v0 = load8(ROW(Vp, k0, sr)); S.st_v1 = load8(ROW(Vp, k0, 32 + sr));              \
                         S.st_k0 = load8(ROW(Kp, k0, sr)); S.st_k1 = load8(ROW(Kp, k0, 32 + sr)); } while (0)
#define SWRITE_HK(bf) do { *(bf16x8*)(K_lds + (bf) * SHM_K + kws) = S.st_k0; *(bf16x8*)(K_lds + (bf) * SHM_K + kws + 32 * 256) = S.st_k1; } while (0)
#define SWRITE_HV(bf) do { *(bf16x8*)(V_lds + (bf) * SHM_V + vst0) = S.st_v0; *(bf16x8*)(V_lds + (bf) * SHM_V + vst1) = S.st_v1; } while (0)
#define SWRITE_H(bf) do { SWRITE_HV(bf); SWRITE_HK(bf); } while (0)
__device__ __forceinline__ void prime(const BlockRef& cur, unsigned char* wsb, char* lds, Seam& S) {
    const int tid = threadIdx.x, wid = __builtin_amdgcn_readfirstlane(tid >> 6), lane = tid & 63, r32 = lane & 31, hi = lane >> 5;
    const int sr = tid >> 4, sc = (tid & 15) * 8, kws = KSWZ(sr, sc * 2); char* K_lds = lds + 2 * SHM_V;
    const bf16_t* Qp = ptrQ(wsb, cur); const bf16_t* Kp = ptrK(wsb, cur); const bf16_t* Vp = ptrV(wsb, cur);
    for (int d0 = 0; d0 < 8; ++d0) S.qr[d0] = load8(Qp + (size_t)(wid * QBLK + r32) * D + d0 * 16 + hi * 8);
    SLOAD_H(Kp, Vp, 0); VMW(); SWRITE_HK(0);
    __syncthreads();
}
__device__ __forceinline__ void block(const BlockRef& cur, unsigned char* wsb, char* lds, Seam& S) {
    const int GRP = cur.grp;
    const int tid = threadIdx.x, wid = __builtin_amdgcn_readfirstlane(tid >> 6), lane = tid & 63, r32 = lane & 31, hi = lane >> 5;
    const int NT = 4 * cur.qb + 4;
    const int qlo = cur.qb * QB + wid * QBLK, qm = qlo + r32 - 4 * hi;
    char* V_lds = lds; char* K_lds = lds + 2 * SHM_V;
    float* ws = (float*)(lds + LDS_WS) + wid * 64; float* li_l = ws, * al_l = ws + 32;
    float m_reg = -1e30f, l_reg = 0; f32x16 o[4] = {};
    const int sr = tid >> 4, sc = (tid & 15) * 8, vst0 = v_st(sr, sc), vst1 = v_st(32 + sr, sc), kws = KSWZ(sr, sc * 2);
    const int vb0 = (int)(uintptr_t)V_lds + v_rd_base(lane);
    const bf16_t* Kh = ptrK(wsb, cur); const bf16_t* Vh = ptrV(wsb, cur);
    const float sl = exp2f(-(float)(cur.h + 1)) * 11.313708498984761f;
    unsigned selbits = 0xffu;
    if (GRP == 1) {
        float* km = (float*)(lds + LDS_KM);
        const float* KM = (const float*)(wsb + WS_KMEAN) + ((size_t)(cur.b * NBLK) * NH + cur.h) * 128;
        if (tid < cur.qb * 32) { const int n = tid >> 5, c4 = (tid & 31) * 4; *(f32x4*)(km + n * 128 + c4) = *(const f32x4*)(KM + (size_t)n * (NH * 128) + c4); }
        __syncthreads();
        float v1 = -__builtin_inff(), v2 = v1, v3 = v1; int i1 = 31, i2 = 31, i3 = 31;
#pragma unroll 1
        for (int n = 0; n < cur.qb; ++n) { float a = 0.f;
#pragma unroll
            for (int d0 = 0; d0 < 8; ++d0) { const f32x4 k0 = *(const f32x4*)(km + n * 128 + d0 * 16 + hi * 8), k1 = *(const f32x4*)(km + n * 128 + d0 * 16 + hi * 8 + 4);
                const bf16x8 q = S.qr[d0];
                a += bf2f((bf16_t)q[0]) * k0[0] + bf2f((bf16_t)q[1]) * k0[1] + bf2f((bf16_t)q[2]) * k0[2] + bf2f((bf16_t)q[3]) * k0[3]
                   + bf2f((bf16_t)q[4]) * k1[0] + bf2f((bf16_t)q[5]) * k1[1] + bf2f((bf16_t)q[6]) * k1[2] + bf2f((bf16_t)q[7]) * k1[3]; }
            const float other = __shfl_xor(a, 32); const float g = a + other;
            const bool c1 = g > v1, c2 = g > v2, c3 = g > v3;
            v3 = c2 ? v2 : (c3 ? g : v3); i3 = c2 ? i2 : (c3 ? n : i3);
            v2 = c1 ? v1 : (c2 ? g : v2); i2 = c1 ? i1 : (c2 ? n : i2);
            v1 = c1 ? g : v1;             i1 = c1 ? n : i1; }
        selbits = ((1u << i1) | (1u << i2) | (1u << i3)) & 0xffu;
    }
    const char* mst = lds + LDS_OST + wid * MST_WAVE + r32 * MST_PITCH;
    if (GRP == 0) {
        const char* src = (const char*)(wsb + WS_MASK) + ((size_t)cur.b * SEQ + qlo) * 256 + (unsigned)(r32 * 256 + hi * 128);
        u32x4 tmp[8];
#pragma unroll
        for (int i = 0; i < 8; ++i) tmp[i] = *(const u32x4*)(src + 16 * i);
#pragma unroll
        for (int i = 0; i < 8; ++i) { unsigned long long* d = (unsigned long long*)(mst + hi * 128 + 16 * i);
            d[0] = (unsigned long long)tmp[i][0] | ((unsigned long long)tmp[i][1] << 32); d[1] = (unsigned long long)tmp[i][2] | ((unsigned long long)tmp[i][3] << 32); }
    }
#define RESC(a) do { if (__any((a) < 1.f)) { if (hi == 0) al_l[r32] = (a); asm volatile("s_waitcnt lgkmcnt(0)" ::: "memory");              \
                     for (int d_ = 0; d_ < 4; ++d_) for (int r = 0; r < 16; ++r) o[d_][r] *= al_l[crow(r, hi)]; } } while (0)
#define KBASE(t) ((t) * KVBLK)
#define CB(t) ((GRP == 1 && (t) < 4 * cur.qb && !((selbits >> ((t) >> 2)) & 1u)) ? -__builtin_inff() : sl * (float)(KBASE(t) - qm))
#define MLOAD(t) ((GRP == 0) ? *(const unsigned long long*)(mst + (t) * 8) : 0ull)
#define MASKT(P0_, P1_, t, mw) do { const int kb_ = KBASE(t); \
        if (GRP == 0) { mask_bits(P0_, P1_, ((unsigned)(mw)) >> (4 * hi), ((unsigned)((mw) >> 32)) >> (4 * hi)); } \
        else if (kb_ + KVBLK - 1 > qlo) mask_causal(P0_, P1_, qm - kb_); } while (0)
    f32x16 pA0, pA1, pB0, pB1; float mnA, mnB, alA, alB; bf16x8 pa0, pa1, pa2, pa3;
    unsigned long long mwA, mwB;
    SWRITE_HV(0); SBAR();
    if (NT > 1) SLOAD_H(Kh, Vh, KBASE(1));
    mwA = MLOAD(0);
    SBAR(); qkt<0>(pA0, pA1, K_lds, r32, hi, S.qr, CB(0), sl);
    MASKT(pA0, pA1, 0, mwA); partialSM(pA0, pA1, m_reg, mnA, alA);
    if (NT > 1) { VMW(); SWRITE_H(1); }
    __syncthreads();
#define HALF_STEP(PX0, PX1, mnX, alX, mwX, PY0, PY1, alY, t, KB, VB, SB) do {                                                 \
        SBAR(); qkt<KB>(PX0, PX1, K_lds, r32, hi, S.qr, CB(t), sl);                                                           \
        finishSM(PY0, PY1, alY, l_reg, pa0, pa1, pa2, pa3); SBAR();                                                           \
        if ((t) + 1 < NT) { SLOAD_H(Kh, Vh, KBASE((t) + 1)); SBAR(); }                                                        \
        mwX = MLOAD(t); pv_tile<VB>(o, vb0, pa0, pa1, pa2, pa3); MASKT(PX0, PX1, (t), mwX); partialSM(PX0, PX1, m_reg, mnX, alX);             \
        __syncthreads();                                                                                                      \
        if ((t) + 1 < NT) { VMW(); SWRITE_H(SB); }                                                                            \
        RESC(alX); __syncthreads(); } while (0)
    for (int t = 1; t + 1 < NT; t += 2) {
        HALF_STEP(pB0, pB1, mnB, alB, mwB, pA0, pA1, alA, t, 1, 0, 0);
        HALF_STEP(pA0, pA1, mnA, alA, mwA, pB0, pB1, alB, t + 1, 0, 1, 1);
    }
    SBAR(); qkt<1>(pB0, pB1, K_lds, r32, hi, S.qr, CB(NT - 1), sl); SBAR();
    mwB = MLOAD(NT - 1);
    finishSM(pA0, pA1, alA, l_reg, pa0, pa1, pa2, pa3); SBAR();
    pv_tile<0>(o, vb0, pa0, pa1, pa2, pa3);
    MASKT(pB0, pB1, NT - 1, mwB); partialSM(pB0, pB1, m_reg, mnB, alB); __syncthreads(); RESC(alB);
    finishSM(pB0, pB1, alB, l_reg, pa0, pa1, pa2, pa3); SBAR(); pv_tile<1>(o, vb0, pa0, pa1, pa2, pa3);
    if (hi == 0) li_l[r32] = l_reg; asm volatile("s_waitcnt lgkmcnt(0)" ::: "memory");
    float rli[16];
#pragma unroll
    for (int r = 0; r < 16; ++r) rli[r] = __builtin_amdgcn_rcpf(li_l[crow(r, hi)]);
    { bf16_t* stg = (bf16_t*)(lds + LDS_OST) + wid * (QBLK * D);
      int lane_e = lane; asm volatile("" : "+v"(lane_e));
      bf16_t* stw = stg + (4 * (lane_e >> 5)) * D + (lane_e & 31);
#pragma unroll
      for (int r = 0; r < 16; ++r) { const int orow = (r & 3) + 8 * (r >> 2);
#pragma unroll
          for (int d0 = 0; d0 < 4; ++d0) stw[orow * D + d0 * 32] = (bf16_t)cvt1(o[d0][r] * rli[r]); }
      asm volatile("s_waitcnt lgkmcnt(0)" ::: "memory");
      char* Ow = (char*)(wsb + WS_Y8) + ((size_t)cur.b * SEQ + qlo) * 2048 + cur.grp * 1024 + cur.h * 128;
      const char* Zw = (const char*)(ptrZ(wsb, cur) + (size_t)(wid * QBLK) * D);
      const unsigned eo = (unsigned)((lane_e >> 4) * 256 + (lane_e & 15) * 16), yo = (unsigned)((lane_e >> 4) * 2048 + (lane_e & 15) * 8);
#pragma unroll
      for (int i = 0; i < 8; ++i) {
          const u32x4 ov = *(const u32x4*)((const char*)stg + (eo + (unsigned)(i * 1024))), zv = *(const u32x4*)(Zw + (eo + (unsigned)(i * 1024))); float f[8];
#pragma unroll
          for (int j = 0; j < 4; ++j) { f[2 * j] = __uint_as_float(ov[j] << 16) * __uint_as_float(zv[j] << 16) * 8.f; f[2 * j + 1] = __uint_as_float(ov[j] & 0xffff0000u) * __uint_as_float(zv[j] & 0xffff0000u) * 8.f; }
          const unsigned long long w = (unsigned long long)pk4_fp8(f[0], f[1], f[2], f[3]) | ((unsigned long long)pk4_fp8(f[4], f[5], f[6], f[7]) << 32);
          *(unsigned long long*)(Ow + (yo + (unsigned)(i * 8192))) = w; } }
    __syncthreads();
#undef RESC
#undef KBASE
#undef CB
#undef MLOAD
#undef MASKT
#undef HALF_STEP
}
#undef ROW
#undef VMW
#undef VMWN
#undef SLOAD_H
#undef SWRITE_HK
#undef SWRITE_HV
#undef SWRITE_H
__device__ __forceinline__ bool decode(int v, int G, int i, BlockRef& r) {
    const int L = v + (i >> 1) * G; if (L >= 512) return false;
    const int x = L & 3, k = L >> 5;
    r.h = (L >> 2) & 7; r.b = k & 7; r.grp = ((k & 1) ^ (k >> 3)) & 1; r.qb = (i & 1) ? 7 - x : x;
    return true;
}
__device__ __forceinline__ void attn_phase(char* lds, unsigned char* wsb, int v, int G) {
    BlockRef cur, nxt;
    if (!decode(v, G, 0, cur)) return;
    Seam S;
    prime(cur, wsb, lds, S);
    for (int i = 0;; ++i) {
        const bool more = decode(v, G, i + 1, nxt);
        if (!more) nxt = cur;
        block(cur, wsb, lds, S);
        if (!more) break;
        prime(nxt, wsb, lds, S);
        cur = nxt;
    }
}
#undef KSWZ
#undef SBAR
}

namespace sel {
#define SLAS __attribute__((address_space(3)))
typedef short bf16x8 __attribute__((ext_vector_type(8)));
typedef float f32x16 __attribute__((ext_vector_type(16)));
typedef float f32x4 __attribute__((ext_vector_type(4)));
typedef unsigned u32x4 __attribute__((ext_vector_type(4)));
constexpr int KB_OFF = 131072;
constexpr int LIST_OFF = 147456 + 2048;
__device__ __forceinline__ unsigned fkey(float x) { const unsigned b = __float_as_uint(x); return (b & 0x80000000u) ? ~b : (b | 0x80000000u); }
__device__ __forceinline__ void unit(SLAS unsigned char* lds, unsigned char* wsb, int b, int rg) {
    const int tid = threadIdx.x, wid = __builtin_amdgcn_readfirstlane(tid >> 6), lane = tid & 63, j = lane & 31, g = lane >> 5;
    const bf16_t* QI = (const bf16_t*)(wsb + WS_QI); const char* KIb = (const char*)((const bf16_t*)(wsb + WS_KI) + (size_t)b * SEQ * 64); const float* WI = (const float*)(wsb + WS_WI);
    unsigned long long* MASK = (unsigned long long*)(wsb + WS_MASK);
    const int ta = 16 * rg + 2 * wid, t = ta + g;
    const int nkeys = 16 * rg + 16, nk32 = (nkeys + 31) >> 5, nch = (nkeys + 63) >> 6;
    SLAS float* sc = (SLAS float*)lds + (wid * 2 + g) * 2048 + j;
    float vmin = __builtin_inff(), vmax = -__builtin_inff();
    bf16x8 af[4];
    { const int i = lane & 31, tok = (i >> 2) & 1, head = (i & 3) + 4 * (i >> 3);
      const bf16_t* qp = QI + ((size_t)b * SEQ + ta + tok) * 1024 + head * 64 + 8 * (lane >> 5);
#pragma unroll
      for (int ks = 0; ks < 4; ++ks) af[ks] = *(const bf16x8*)(qp + 16 * ks); }
    float wv[16];
    { const float* wp = WI + ((size_t)b * SEQ + t) * 16;
#pragma unroll
      for (int q4 = 0; q4 < 4; ++q4) { const f32x4 w4 = *(const f32x4*)(wp + 4 * q4); wv[4 * q4] = w4[0] * 0.03125f; wv[4 * q4 + 1] = w4[1] * 0.03125f; wv[4 * q4 + 2] = w4[2] * 0.03125f; wv[4 * q4 + 3] = w4[3] * 0.03125f; } }
    const int srow = tid >> 3, scol = tid & 7, swr = srow * 128 + ((scol ^ ((srow >> 1) & 7)) << 4);
    int koff[4];
#pragma unroll
    for (int ks = 0; ks < 4; ++ks) koff[ks] = j * 128 + (((2 * ks + g) ^ ((j >> 1) & 7)) << 4);
    u32x4 stA = *(const u32x4*)(KIb + (unsigned)(tid * 16)), stB = stA;
    *(SLAS u32x4*)(lds + KB_OFF + swr) = stA;
    stA = *(const u32x4*)(KIb + (unsigned)(min(1, nch - 1) * 8192 + tid * 16));
    stB = *(const u32x4*)(KIb + (unsigned)(min(2, nch - 1) * 8192 + tid * 16));
    __syncthreads();
#define SEL_EPI(ACC, kt) do { float s0 = 0.f, s1 = 0.f, s2 = 0.f, s3 = 0.f; \
        _Pragma("unroll") for (int r = 0; r < 4; ++r) { s0 = fmaf(wv[r], fmaxf(ACC[r], 0.f), s0); s1 = fmaf(wv[4 + r], fmaxf(ACC[4 + r], 0.f), s1); \
                                                       s2 = fmaf(wv[8 + r], fmaxf(ACC[8 + r], 0.f), s2); s3 = fmaf(wv[12 + r], fmaxf(ACC[12 + r], 0.f), s3); } \
        const float s = (s0 + s1) + (s2 + s3); \
        if (32 * (kt) + j <= t) { vmin = fminf(vmin, s); vmax = fmaxf(vmax, s); }     \
        sc[32 * (kt)] = s; } while (0)
#define SEL_TILES(cc) do { SLAS unsigned char* kb = lds + KB_OFF + ((cc) & 1) * 8192; const int kt0 = 2 * (cc); \
        if (kt0 + 1 < nk32) {                                  \
            f32x16 acc0 = {}, acc1 = {}; \
            _Pragma("unroll") for (int ks = 0; ks < 4; ++ks) { const bf16x8 b0 = *(const SLAS bf16x8*)(kb + koff[ks]), b1 = *(const SLAS bf16x8*)(kb + 4096 + koff[ks]); \
                acc0 = __builtin_amdgcn_mfma_f32_32x32x16_bf16(af[ks], b0, acc0, 0, 0, 0); acc1 = __builtin_amdgcn_mfma_f32_32x32x16_bf16(af[ks], b1, acc1, 0, 0, 0); } \
            SEL_EPI(acc0, kt0); SEL_EPI(acc1, kt0 + 1); \
        } else if (kt0 < nk32) { f32x16 acc0 = {}; \
            _Pragma("unroll") for (int ks = 0; ks < 4; ++ks) { const bf16x8 b0 = *(const SLAS bf16x8*)(kb + koff[ks]); acc0 = __builtin_amdgcn_mfma_f32_32x32x16_bf16(af[ks], b0, acc0, 0, 0, 0); } \
            SEL_EPI(acc0, kt0); } } while (0)
#pragma unroll 1
    for (int c = 0; c < nch; c += 2) {
        SEL_TILES(c);
        *(SLAS u32x4*)(lds + KB_OFF + 8192 + swr) = stA; stA = *(const u32x4*)(KIb + (unsigned)(min(c + 3, nch - 1) * 8192 + tid * 16));
        __syncthreads();
        SEL_TILES(c + 1);
        *(SLAS u32x4*)(lds + KB_OFF + swr) = stB; stB = *(const u32x4*)(KIb + (unsigned)(min(c + 4, nch - 1) * 8192 + tid * 16));
        __syncthreads();
    }
#undef SEL_TILES
#undef SEL_EPI
    unsigned T = 0u; int need = 0; bool ties = false;
    if (16 * rg >= TOPK) {
        SLAS unsigned* hist = (SLAS unsigned*)(lds + KB_OFF) + (wid * 2 + g) * 256;
#pragma unroll
        for (int off = 1; off < 32; off <<= 1) { vmin = fminf(vmin, __shfl_xor(vmin, off)); vmax = fmaxf(vmax, __shfl_xor(vmax, off)); }
        const float range = vmax - vmin, inv = (range > 0.f) ? 255.99f / range : 0.f;
        *(SLAS u32x4*)(hist + 8 * j) = (u32x4){0u, 0u, 0u, 0u}; *(SLAS u32x4*)(hist + 8 * j + 4) = (u32x4){0u, 0u, 0u, 0u};
#pragma unroll 1
        for (int kt0 = 0; kt0 < nk32; kt0 += 4) { float x[4];
#pragma unroll
            for (int i = 0; i < 4; ++i) x[i] = sc[32 * (kt0 + i)];
#pragma unroll
            for (int i = 0; i < 4; ++i) if (32 * (kt0 + i) + j <= t) { const int q = min((int)((x[i] - vmin) * inv), 255); __hip_atomic_fetch_add(hist + q, 1u, __ATOMIC_RELAXED, __HIP_MEMORY_SCOPE_WORKGROUP); } }
        asm volatile("s_waitcnt lgkmcnt(0)" ::: "memory");
        int qsel, cB;
        { const u32x4 c0 = *(const SLAS u32x4*)(hist + 8 * j), c1 = *(const SLAS u32x4*)(hist + 8 * j + 4);
          const int cnt[8] = {(int)c0[0], (int)c0[1], (int)c0[2], (int)c0[3], (int)c1[0], (int)c1[1], (int)c1[2], (int)c1[3]};
          const int s = ((cnt[0] + cnt[1]) + (cnt[2] + cnt[3])) + ((cnt[4] + cnt[5]) + (cnt[6] + cnt[7]));
          int S = s;
#pragma unroll
          for (int off = 1; off < 32; off <<= 1) { const int v = __shfl_down(S, off, 32); if (j + off < 32) S += v; }
          const int above = S - s;
          const bool found = (S >= TOPK) && (above < TOPK);
          int dsel = 0, nneed = 0, csel = 0;
          { const int rem = TOPK - above; int cum = 0; bool done = false;
#pragma unroll
            for (int i = 7; i >= 0; --i) { const int before = cum; cum += cnt[i]; if (!done && cum >= rem) { done = true; dsel = 8 * j + i; nneed = rem - before; csel = cnt[i]; } } }
          const unsigned long long bm = __ballot(found);
          const int src = 32 * g + __builtin_ctz((unsigned)(bm >> (32 * g)) | 0x80000000u);
          qsel = __shfl(dsel, src); need = __shfl(nneed, src); cB = __shfl(csel, src); }
        if (!__any(cB > 64)) {
            SLAS unsigned* list = (SLAS unsigned*)(lds + LIST_OFF) + (wid * 2 + g) * 128;
            int base = 0;
#pragma unroll 1
            for (int kt0 = 0; kt0 < nk32; kt0 += 4) { float x[4];
#pragma unroll
                for (int i = 0; i < 4; ++i) x[i] = sc[32 * (kt0 + i)];
#pragma unroll
                for (int i = 0; i < 4; ++i) { const int kt = kt0 + i;
                    const bool m = (32 * kt + j <= t) && (min((int)((x[i] - vmin) * inv), 255) == qsel);
                    const unsigned long long bal = __ballot(m); const unsigned hm = g ? (unsigned)(bal >> 32) : (unsigned)bal;
                    if (m) { const int pos = base + __builtin_popcount(hm & ((1u << j) - 1u)); list[2 * pos] = fkey(x[i]); list[2 * pos + 1] = (unsigned)(32 * kt + j); }
                    base += __builtin_popcount(hm); } }
            asm volatile("s_waitcnt lgkmcnt(0)" ::: "memory");
            const unsigned u0 = list[2 * j], i0 = list[2 * j + 1], u1 = list[2 * (j + 32)], i1 = list[2 * (j + 32) + 1];
            int r0 = 0, r1 = 0; const int cmax = max(cB, __shfl_xor(cB, 32));
#pragma unroll 1
            for (int e = 0; e < cmax; ++e) { const unsigned ue = list[2 * e], ie = list[2 * e + 1]; const bool in = e < cB;
                r0 += (in && (ue > u0 || (ue == u0 && ie < i0))) ? 1 : 0; r1 += (in && (ue > u1 || (ue == u1 && ie < i1))) ? 1 : 0; }
            const bool h0 = (j < cB) && (r0 == need - 1), h1 = (j + 32 < cB) && (r1 == need - 1);
            const unsigned long long bh = __ballot(h0 || h1);
            const int src = 32 * g + __builtin_ctz((unsigned)(bh >> (32 * g)) | 0x80000000u);
            T = __shfl(h0 ? u0 : u1, src);
            const unsigned long long bg0 = __ballot(j < cB && u0 > T), bg1 = __ballot(j + 32 < cB && u1 > T), be0 = __ballot(j < cB && u0 == T), be1 = __ballot(j + 32 < cB && u1 == T);
            const int ngt = __builtin_popcount(g ? (unsigned)(bg0 >> 32) : (unsigned)bg0) + __builtin_popcount(g ? (unsigned)(bg1 >> 32) : (unsigned)bg1);
            const int neq = __builtin_popcount(g ? (unsigned)(be0 >> 32) : (unsigned)be0) + __builtin_popcount(g ? (unsigned)(be1 >> 32) : (unsigned)be1);
            need = need - ngt; ties = (neq != need);
        } else {
            unsigned prefix = 0u; need = TOPK; int ceq = 0;
#pragma unroll 1
            for (int p = 0; p < 4; ++p) { const int shift = 24 - 8 * p;
                *(SLAS u32x4*)(hist + 8 * j) = (u32x4){0u, 0u, 0u, 0u}; *(SLAS u32x4*)(hist + 8 * j + 4) = (u32x4){0u, 0u, 0u, 0u};
                const unsigned phi = prefix >> ((shift + 8) & 31);
#pragma unroll 1
                for (int kt = 0; kt < nk32; ++kt) { const unsigned x = fkey(sc[32 * kt]);
                    const bool match = (32 * kt + j <= t) && ((p == 0) || ((x >> ((shift + 8) & 31)) == phi));
                    if (match) __hip_atomic_fetch_add(hist + ((x >> shift) & 255u), 1u, __ATOMIC_RELAXED, __HIP_MEMORY_SCOPE_WORKGROUP); }
                asm volatile("s_waitcnt lgkmcnt(0)" ::: "memory");
                const u32x4 c0 = *(const SLAS u32x4*)(hist + 8 * j), c1 = *(const SLAS u32x4*)(hist + 8 * j + 4);
                const int cnt[8] = {(int)c0[0], (int)c0[1], (int)c0[2], (int)c0[3], (int)c1[0], (int)c1[1], (int)c1[2], (int)c1[3]};
                const int s = ((cnt[0] + cnt[1]) + (cnt[2] + cnt[3])) + ((cnt[4] + cnt[5]) + (cnt[6] + cnt[7]));
                int S = s;
#pragma unroll
                for (int off = 1; off < 32; off <<= 1) { const int v = __shfl_down(S, off, 32); if (j + off < 32) S += v; }
                const int above = S - s;
                const bool found = (S >= need) && (above < need);
                int dsel = 0, nneed = 0, csel = 0;
                { const int rem = need - above; int cum = 0; bool done = false;
#pragma unroll
                  for (int i = 7; i >= 0; --i) { const int before = cum; cum += cnt[i]; if (!done && cum >= rem) { done = true; dsel = 8 * j + i; nneed = rem - before; csel = cnt[i]; } } }
                const unsigned long long bm = __ballot(found);
                const int src = 32 * g + __builtin_ctz((unsigned)(bm >> (32 * g)) | 0x80000000u);
                const int digit = __shfl(dsel, src); need = __shfl(nneed, src); ceq = __shfl(csel, src);
                prefix |= (unsigned)digit << shift;
            }
            T = prefix; ties = (ceq != need);
        }
    }
    unsigned wlo = 0u, whi = 0u;
    if (!__any(ties)) {
#pragma unroll 4
        for (int k64 = 0; k64 < 32; ++k64) {
            const bool s0 = (64 * k64 + j <= t) && (fkey(sc[64 * k64]) >= T), s1 = (64 * k64 + 32 + j <= t) && (fkey(sc[64 * k64 + 32]) >= T);
            const unsigned long long b0 = __ballot(s0), b1 = __ballot(s1);
            const unsigned lo = g ? (unsigned)(b0 >> 32) : (unsigned)b0, hi = g ? (unsigned)(b1 >> 32) : (unsigned)b1;
            if (j == k64) { wlo = lo; whi = hi; } }
    } else {
        int base = 0;
#pragma unroll 1
        for (int k64 = 0; k64 < 32; ++k64) { unsigned lo = 0u, hi = 0u;
#pragma unroll
            for (int hh = 0; hh < 2; ++hh) { const bool vld = (64 * k64 + 32 * hh + j <= t); const unsigned x = vld ? fkey(sc[64 * k64 + 32 * hh]) : 0u;
                const unsigned long long be = __ballot(vld && x == T); const unsigned em = g ? (unsigned)(be >> 32) : (unsigned)be;
                const int rank = base + __builtin_popcount(em & ((1u << j) - 1u));
                const bool s1 = vld && ((x > T) || (x == T && rank < need));
                base += __builtin_popcount(em);
                const unsigned long long bs = __ballot(s1); const unsigned sm = g ? (unsigned)(bs >> 32) : (unsigned)bs;
                if (hh == 0) lo = sm; else hi = sm; }
            if (j == k64) { wlo = lo; whi = hi; } }
    }
    MASK[((size_t)b * SEQ + t) * 32 + j] = (unsigned long long)wlo | ((unsigned long long)whi << 32);
    __syncthreads();
}
__device__ __forceinline__ void kmean_unit(SLAS unsigned char* lds, unsigned char* wsb, int b, int n, int h) {
    const int tid = threadIdx.x, d4 = tid & 31, rs = tid >> 5;
    const bf16_t* KB = (const bf16_t*)(wsb + WS_KB) + (((size_t)(b * NH + h) * SEQ) + n * 256) * 128;
    float a0 = 0.f, a1 = 0.f, a2 = 0.f, a3 = 0.f;
#pragma unroll 4
    for (int r = 0; r < 16; ++r) { const unsigned long long v = *(const unsigned long long*)(KB + (size_t)(rs * 16 + r) * 128 + d4 * 4);
        const unsigned lo = (unsigned)v, hi = (unsigned)(v >> 32);
        a0 += __uint_as_float(lo << 16); a1 += __uint_as_float(lo & 0xffff0000u); a2 += __uint_as_float(hi << 16); a3 += __uint_as_float(hi & 0xffff0000u); }
    SLAS float* red = (SLAS float*)lds;
    *(SLAS f32x4*)(red + rs * 128 + d4 * 4) = (f32x4){a0, a1, a2, a3};
    __syncthreads();
    if (tid < 128) { float s = 0.f;
#pragma unroll
        for (int q = 0; q < 16; ++q) s += red[q * 128 + tid];
        ((float*)(wsb + WS_KMEAN))[((size_t)(b * NBLK + n) * NH + h) * 128 + tid] = s * (1.f / 256.f); }
    __syncthreads();
}
__device__ __forceinline__ void select_phase(SLAS unsigned char* lds, unsigned char* wsb, int v, int G) {
    for (int L = v; L < 512; L += G) kmean_unit(lds, wsb, L >> 6, (L >> 3) & 7, L & 7);
    for (int L = v; L < 512; L += G) { const int b = L >> 6, x = L & 63;
        unit(lds, wsb, b, x);
        unit(lds, wsb, b, 127 - x); }
}
#undef SLAS
}

struct Args { const float* in[12]; float* out; unsigned char* ws; int ph_lo, ph_hi, li, pad; };
__global__ void __launch_bounds__(NWAVES * 64, 2) mega_fwd(Args args) {
    extern __shared__ __attribute__((aligned(16))) unsigned char lds[];
    Frame F;
    F.lds = (LAS unsigned char*)lds; F.MISC = (volatile LAS unsigned*)(F.lds + MISC_OFF);
    F.tid = threadIdx.x; F.lane = F.tid & 63; F.wave = __builtin_amdgcn_readfirstlane(F.tid >> 6);
    F.G = gridDim.x; { const int bx = blockIdx.x; F.vcu = (F.G % 8 == 0) ? (bx % 8) * (F.G / 8) + bx / 8 : bx; }
    unsigned char* ws = args.ws;
    F.ctl = (gu32*)(ws + WS_CTL);
    const float* x = args.in[0]; const float* c = args.in[1]; const float* w_ada = args.in[2]; const float* b_ada = args.in[3]; const float* g_norm = args.in[4];
    const float* w_in = args.in[5]; const float* w_out = args.in[11];
    float* MOD = (float*)(ws + WS_MOD); bf16_t* WinT = (bf16_t*)(ws + WS_WIN); bf16_t* WoutT = (bf16_t*)(ws + WS_WOUT); bf16_t* HB = (bf16_t*)(ws + WS_HB); bf16_t* Y = (bf16_t*)(ws + WS_Y);
    for (int u = F.tid; u < (LDS_BYTES - LDSCTL_OFF) / 4; u += NWAVES * 64) ((LAS unsigned*)(F.lds + LDSCTL_OFF))[u] = 0u;
    __syncthreads();
    XcdBarrier bar = xcd_barrier_post((unsigned*)(F.ctl + CW_BAR) + args.li * XCD_BAR_WORDS, F.MISC + 8);
    const int lo = args.ph_lo, hi = args.ph_hi;
#define IN(k) (lo <= (k) && (k) < hi)
#define BOTH(k) (IN(k) && IN((k) + 1))
    if (IN(0)) for (int rep_ = 0; rep_ < (((PROBE_DOUBLE) >> 0) & 1) + 1; ++rep_) {
        if (rep_) __syncthreads();
        if ((int)blockIdx.x < 192) p0_mod(F, (int)blockIdx.x, c, w_ada, b_ada, MOD);
        else if ((int)blockIdx.x == 192) { float* G = (float*)(ws + WS_GAIN);
            if (F.tid < 128) { G[F.tid] = args.in[6][F.tid]; G[128 + F.tid] = args.in[7][F.tid]; G[256 + F.tid] = args.in[9][F.tid]; G[384 + F.tid] = args.in[10][F.tid]; }
            if (F.tid < 64) G[512 + F.tid] = args.in[8][F.tid]; }
        p0_convert(F, w_in, w_out, WinT, WoutT, ws + WS_WIN8, ws + WS_WOUT8);
    }
    if (BOTH(0)) xcd_barrier(bar);
    if (IN(1)) for (int rep_ = 0; rep_ < (((PROBE_DOUBLE) >> 1) & 1) + 1; ++rep_) p1_norm(F, x, g_norm, MOD, HB, ws + WS_HB8);
    if (BOTH(1)) xcd_barrier(bar);
    if (IN(2)) for (int rep_ = 0; rep_ < (((PROBE_DOUBLE) >> 2) & 1) + 1; ++rep_) {
        { pg8::Gemm g{ws + WS_HB8, ws + WS_WIN8, M, 28 * 256, DM}; pg8::StaticOrder S; S.init(M, 28 * 256, F.G, (int)blockIdx.x, 0, 16, 9);
          EpiProj E{ws, (LAS float*)(F.lds + EPI_OFF), FP8_DESCALE};
          pg8::gemm_phase<EpiProj, pg8::StaticOrder, true, true, true>(F.lds, g, S, E); }
        { pg8::Gemm g{HB, WinT, M, 9 * 256, DM}; pg8::StaticOrder S; S.init(M, 9 * 256, F.G, (int)blockIdx.x, 16);
          EpiProj E{ws, (LAS float*)(F.lds + EPI_OFF), 1.f};
          pg8::gemm_phase<EpiProj, pg8::StaticOrder, true, true, false>(F.lds, g, S, E); }
    }
    if (BOTH(2)) xcd_barrier(bar);
    if (IN(3)) for (int rep_ = 0; rep_ < (((PROBE_DOUBLE) >> 3) & 1) + 1; ++rep_) sel::select_phase(F.lds, ws, F.vcu, F.G);
    if (BOTH(3)) xcd_barrier(bar);
    if (IN(4)) {
#pragma unroll 1
        for (int rep_ = 0; rep_ < (((PROBE_DOUBLE) >> 4) & 1) + 1; ++rep_) att::attn_phase((char*)lds, ws, F.vcu, F.G);
    }
    if (BOTH(4)) xcd_barrier(bar);
    if (IN(5)) for (int rep_ = 0; rep_ < (((PROBE_DOUBLE) >> 5) & 1) + 1; ++rep_) {
        pg8::Gemm g{ws + WS_Y8, ws + WS_WOUT8, M, DM, DM}; pg8::StaticOrder S; S.init(M, DM, F.G, (int)blockIdx.x);
        EpiOut E{x, MOD, args.out, FP8_DESCALE};
        pg8::gemm_phase<EpiOut, pg8::StaticOrder, true, true, true>(F.lds, g, S, E);
    }
#undef IN
#undef BOTH
}

static int mega_setup() {
    static int grid = 0;
    if (grid == 0) {
        int dev = 0, cus = 0;
        if (hipGetDevice(&dev) != hipSuccess || hipDeviceGetAttribute(&cus, hipDeviceAttributeMultiprocessorCount, dev) != hipSuccess) { fprintf(stderr, "kernel_launch: device query failed\n"); grid = -1; return grid; }
        if (hipFuncSetAttribute((const void*)mega_fwd, hipFuncAttributeMaxDynamicSharedMemorySize, LDS_BYTES) != hipSuccess) { fprintf(stderr, "kernel_launch: hipFuncSetAttribute failed\n"); grid = -1; return grid; }
        (void)hipGetLastError();
        grid = cus;
    }
    return grid;
}
static void mega_launch(int grid, void* const* d_in, void* d_out, void* d_ws, int ph_lo, int ph_hi, int li, hipStream_t stream) {
    Args a{};
    for (int i = 0; i < 12; ++i) a.in[i] = (const float*)d_in[i];
    a.out = (float*)d_out; a.ws = (unsigned char*)d_ws; a.ph_lo = ph_lo; a.ph_hi = ph_hi; a.li = li;
    hipLaunchKernelGGL(mega_fwd, dim3(grid), dim3(NWAVES * 64), LDS_BYTES, stream, a);
}

extern "C" void kernel_launch(void* const* d_in, const int* in_sizes, int n_in, void* d_out, int out_size, void* d_ws, size_t ws_size, hipStream_t stream) {
    if (n_in != 12 || in_sizes[0] != M * DM || out_size != M * DM || ws_size < WS_END) {
        fprintf(stderr, "kernel_launch: unexpected shapes (n_in %d, in0 %d, out %d, ws %zu); nothing launched\n", n_in, n_in > 0 ? in_sizes[0] : -1, out_size, ws_size); return; }
    const int grid = mega_setup(); if (grid <= 0) return;
    char* ws = (char*)d_ws;
    bf16_t* QA = (bf16_t*)(ws + WS_QA); bf16_t* KA = (bf16_t*)(ws + WS_KA); bf16_t* VA = (bf16_t*)(ws + WS_VA); bf16_t* SZA = (bf16_t*)(ws + WS_SZA);
    bf16_t* QB = (bf16_t*)(ws + WS_QB); bf16_t* KB = (bf16_t*)(ws + WS_KB); bf16_t* VB = (bf16_t*)(ws + WS_VB); bf16_t* SZB = (bf16_t*)(ws + WS_SZB);
    bf16_t* QI = (bf16_t*)(ws + WS_QI); bf16_t* KI = (bf16_t*)(ws + WS_KI); float* WI = (float*)(ws + WS_WI); float* KMEAN = (float*)(ws + WS_KMEAN);
    unsigned long long* MASKT = (unsigned long long*)(ws + WS_MASK); bf16_t* Y = (bf16_t*)(ws + WS_Y);
    (void)hipMemsetAsync(ws + WS_CTL, 0, CTL_ZERO_BYTES, stream);
#if NAIVE_SEL
    mega_launch(grid, d_in, d_out, d_ws, 0, 3, 0, stream);
    k_kmean<<<BATCH * NBLK * NH, 128, 0, stream>>>(KB, KMEAN);
    (void)hipMemsetAsync(MASKT, 0, 4 * MiB, stream);
    k_dsa_select_naive<<<dim3(SEQ, BATCH), 256, 0, stream>>>(QI, KI, WI, MASKT);
    mega_launch(grid, d_in, d_out, d_ws, 4, 6, 1, stream);
#else
    mega_launch(grid, d_in, d_out, d_ws, 0, 6, 0, stream);
#if PROBE_EXTRA >= 0
    mega_launch(grid, d_in, d_out, d_ws, PROBE_EXTRA, PROBE_EXTRA + 1, 1, stream);
#endif
#endif
}
```

```cpp
#include <hip/hip_runtime.h>
#include <cstdio>
#include <cstdint>

typedef unsigned short bf16_t;
#ifndef NAIVE_SEL
#define NAIVE_SEL 0
#endif
#ifndef PROBE_SEL
#define PROBE_SEL 0
#endif
#ifndef PROBE_EXTRA
#define PROBE_EXTRA -1
#endif
#ifndef PROBE_DOUBLE
#define PROBE_DOUBLE 0
#endif
constexpr int BATCH = 8, SEQ = 2048, DM = 2048, M = BATCH * SEQ, NH = 8, HD = 128, DA = 1024, IH = 16, ID = 64, DIN = 9296;
constexpr int TOPK = 256, NBLK = 8;
constexpr float RMS_EPS = 1e-6f;
constexpr float QK_SCALE = 0.08838834764831845f;

__device__ __forceinline__ float bf2f(bf16_t v) { return __uint_as_float(((unsigned)v) << 16); }
__device__ __forceinline__ bf16_t f2bf(float f) { unsigned u = __float_as_uint(f); return (bf16_t)((u + 0x7fffu + ((u >> 16) & 1u)) >> 16); }
__device__ __forceinline__ float rbf(float f) { return bf2f(f2bf(f)); }
__device__ __forceinline__ float silu_f(float v) { return v / (1.f + __expf(-v)); }
__device__ __forceinline__ size_t HM(int b, int h, int t, int d) { return (((size_t)(b * NH + h) * SEQ + t) * HD + d); }
__device__ __forceinline__ float wave_sum(float v) {
#pragma unroll
    for (int o = 1; o < 64; o <<= 1) v += __shfl_xor(v, o);
    return v;
}
__device__ __forceinline__ float wave_max(float v) {
#pragma unroll
    for (int o = 1; o < 64; o <<= 1) v = fmaxf(v, __shfl_xor(v, o));
    return v;
}
__device__ __forceinline__ void mask_pos(int t, int s, size_t& word, int& bit) { word = (size_t)t * 32 + (s >> 6); bit = s & 63; }

__global__ void k_mod(const float* __restrict__ c, const float* __restrict__ w_ada, const float* __restrict__ b_ada, float* __restrict__ MOD) {
    __shared__ float sc[DM];
    const int b = blockIdx.y, n = blockIdx.x * 256 + threadIdx.x;
    for (int k = threadIdx.x; k < DM; k += 256) sc[k] = silu_f(c[b * DM + k]);
    __syncthreads();
    float acc = 0.f;
    for (int k = 0; k < DM; ++k) acc += sc[k] * w_ada[(size_t)k * (3 * DM) + n];
    MOD[b * 3 * DM + n] = acc + b_ada[n];
}
__global__ void k_norm(const float* __restrict__ x, const float* __restrict__ g, const float* __restrict__ MOD, bf16_t* __restrict__ HB) {
    const int lane = threadIdx.x & 63, row = blockIdx.x * 4 + (threadIdx.x >> 6), b = row / SEQ;
    const float* xr = x + (size_t)row * DM;
    float ss = 0.f;
    for (int k = lane; k < DM; k += 64) { const float v = xr[k]; ss += v * v; }
    ss = wave_sum(ss);
    const float rstd = rsqrtf(ss / DM + RMS_EPS);
    const float* shift = MOD + b * 3 * DM; const float* scale = shift + DM;
    for (int k = lane; k < DM; k += 64) HB[(size_t)row * DM + k] = f2bf(xr[k] * rstd * g[k] * (1.f + scale[k]) + shift[k]);
}
template <int MODE>
__global__ void k_gemm_naive(const bf16_t* __restrict__ A, int K, const float* __restrict__ W, int ldw, int n0, int ncols,
                             float* __restrict__ C, int ldc, const float* __restrict__ xres, const float* __restrict__ MOD) {
    __shared__ float As[16][65], Bs[16][65];
    const int tid = threadIdx.x, tx = tid & 15, ty = tid >> 4, m0 = blockIdx.y * 64, c0 = blockIdx.x * 64;
    float acc[4][4] = {};
    for (int k0 = 0; k0 < K; k0 += 16) {
        for (int i = tid; i < 1024; i += 256) { const int r = i >> 4, kk = i & 15; As[kk][r] = bf2f(A[(size_t)(m0 + r) * K + k0 + kk]); }
        for (int i = tid; i < 1024; i += 256) { const int kk = i >> 6, cc = i & 63; Bs[kk][cc] = (c0 + cc < ncols) ? rbf(W[(size_t)(k0 + kk) * ldw + n0 + c0 + cc]) : 0.f; }
        __syncthreads();
#pragma unroll
        for (int kk = 0; kk < 16; ++kk) {
            float a[4], bb[4];
#pragma unroll
            for (int i = 0; i < 4; ++i) { a[i] = As[kk][ty * 4 + i]; bb[i] = Bs[kk][tx * 4 + i]; }
#pragma unroll
            for (int i = 0; i < 4; ++i)
#pragma unroll
                for (int j = 0; j < 4; ++j) acc[i][j] += a[i] * bb[j];
        }
        __syncthreads();
    }
#pragma unroll
    for (int i = 0; i < 4; ++i)
#pragma unroll
        for (int j = 0; j < 4; ++j) {
            const int m = m0 + ty * 4 + i, cc = c0 + tx * 4 + j;
            if (cc < ncols) {
                if (MODE == 0) C[(size_t)m * ldc + cc] = acc[i][j];
                else { const int b = m / SEQ; C[(size_t)m * ldc + cc] = xres[(size_t)m * ldc + cc] + MOD[b * 3 * DM + 2 * DM + cc] * acc[i][j]; }
            }
        }
}
__global__ void k_post(const float* __restrict__ T32, const float* __restrict__ gain, bf16_t* __restrict__ dst, int mode) {
    const int lane = threadIdx.x & 63, item = blockIdx.x * 4 + (threadIdx.x >> 6), m = item >> 3, h = item & 7, b = m / SEQ, t = m % SEQ;
    const float* src = T32 + (size_t)m * 1024 + h * 128;
    float v0 = src[lane], v1 = src[lane + 64];
    if (mode == 0) { const float ss = wave_sum(v0 * v0 + v1 * v1); const float rstd = rsqrtf(ss / 128.f + RMS_EPS); v0 = v0 * rstd * gain[lane]; v1 = v1 * rstd * gain[lane + 64]; }
    if (mode == 2) { v0 = silu_f(v0); v1 = silu_f(v1); }
    if (mode == 3) { dst[(size_t)m * 1024 + h * 128 + lane] = f2bf(v0); dst[(size_t)m * 1024 + h * 128 + lane + 64] = f2bf(v1); }
    else { dst[HM(b, h, t, lane)] = f2bf(v0); dst[HM(b, h, t, lane + 64)] = f2bf(v1); }
}
__global__ void k_post_idx(const float* __restrict__ T32, const float* __restrict__ gain, bf16_t* __restrict__ KI, float* __restrict__ WI) {
    const int lane = threadIdx.x & 63, m = blockIdx.x * 4 + (threadIdx.x >> 6);
    const float v = T32[(size_t)m * 80 + lane];
    const float ss = wave_sum(v * v); const float rstd = rsqrtf(ss / 64.f + RMS_EPS);
    KI[(size_t)m * 64 + lane] = f2bf(v * rstd * gain[lane]);
    if (lane < 16) WI[(size_t)m * 16 + lane] = T32[(size_t)m * 80 + 64 + lane];
}
__global__ void k_kmean(const bf16_t* __restrict__ KB, float* __restrict__ KMEAN) {
    const int d = threadIdx.x, h = blockIdx.x & 7, n = (blockIdx.x >> 3) & 7, b = blockIdx.x >> 6;
    float s = 0.f;
    for (int t = 0; t < 256; ++t) s += bf2f(KB[HM(b, h, n * 256 + t, d)]);
    KMEAN[((size_t)(b * NBLK + n) * NH + h) * HD + d] = s * (1.f / 256.f);
}
__global__ void k_dsa_select_naive(const bf16_t* __restrict__ QI, const bf16_t* __restrict__ KI, const float* __restrict__ WI, unsigned long long* __restrict__ MASKT) {
    const int t = blockIdx.x, b = blockIdx.y, tid = threadIdx.x; const size_t m = (size_t)b * SEQ + t;
    __shared__ float q[1024]; __shared__ float w[16]; __shared__ float sc[SEQ];
    for (int i = tid; i < 1024; i += 256) q[i] = bf2f(QI[m * 1024 + i]);
    if (tid < 16) w[tid] = WI[m * 16 + tid];
    __syncthreads();
    for (int s = tid; s <= t; s += 256) {
        float k[64];
        const bf16_t* kp = KI + ((size_t)b * SEQ + s) * 64;
#pragma unroll
        for (int d = 0; d < 64; ++d) k[d] = bf2f(kp[d]);
        float score = 0.f;
        for (int h = 0; h < 16; ++h) { float dot = 0.f;
#pragma unroll
            for (int d = 0; d < 64; ++d) dot += q[h * 64 + d] * k[d];
            score += w[h] * fmaxf(dot * 0.125f, 0.f); }
        sc[s] = score * 0.25f;
    }
    __syncthreads();
    for (int s = tid; s <= t; s += 256) {
        bool sel = true;
        if (t >= TOPK) { const float v = sc[s]; int cnt = 0; for (int s2 = 0; s2 <= t; ++s2) { const float u = sc[s2]; cnt += (u > v || (u == v && s2 < s)) ? 1 : 0; } sel = cnt < TOPK; }
        if (sel) { size_t word; int bit; mask_pos(t, s, word, bit); atomicOr(&MASKT[(size_t)b * 65536 + word], 1ull << bit); }
    }
}
__global__ void k_dsa_attn_naive(const bf16_t* __restrict__ QA, const bf16_t* __restrict__ KA, const bf16_t* __restrict__ VA, const bf16_t* __restrict__ SZA,
                                 const unsigned long long* __restrict__ MASKT, bf16_t* __restrict__ Y) {
    const int t = blockIdx.x, b = blockIdx.y, tid = threadIdx.x, lane = tid & 63, w = tid >> 6; const size_t m = (size_t)b * SEQ + t;
    __shared__ int idx[512]; __shared__ int nsel; __shared__ float qs[8][128]; __shared__ float p[4][256];
    if (tid == 0) nsel = 0;
    __syncthreads();
    for (int s = tid; s <= t; s += 256) { size_t word; int bit; mask_pos(t, s, word, bit);
        if ((MASKT[(size_t)b * 65536 + word] >> bit) & 1ull) { const int pos = atomicAdd(&nsel, 1); if (pos < 512) idx[pos] = s; } }
    for (int i = tid; i < 1024; i += 256) qs[i >> 7][i & 127] = bf2f(QA[HM(b, i >> 7, t, i & 127)]);
    __syncthreads();
    const int n = nsel < 256 ? nsel : 256;
    for (int hh = 0; hh < 2; ++hh) {
        const int h = w + 4 * hh; const float slope = exp2f(-(float)(h + 1));
        float sv[4]; float mx = -INFINITY;
#pragma unroll
        for (int i = 0; i < 4; ++i) { const int j = lane + 64 * i; sv[i] = -INFINITY;
            if (j < n) { const int s = idx[j]; const bf16_t* kp = KA + HM(b, h, s, 0); float dot = 0.f;
                for (int d = 0; d < 128; ++d) dot += qs[h][d] * bf2f(kp[d]);
                sv[i] = dot * QK_SCALE - slope * (float)(t - s); }
            mx = fmaxf(mx, sv[i]); }
        mx = wave_max(mx);
        float sum = 0.f;
#pragma unroll
        for (int i = 0; i < 4; ++i) { const int j = lane + 64 * i; const float pv = (j < n) ? __expf(sv[i] - mx) : 0.f; sum += pv; p[w][j] = pv; }
        sum = wave_sum(sum);
        __syncthreads();
        float o0 = 0.f, o1 = 0.f;
        for (int j = 0; j < n; ++j) { const float pj = p[w][j]; const int s = idx[j]; const unsigned vv = *(const unsigned*)(VA + HM(b, h, s, 2 * lane));
            o0 += pj * __uint_as_float(vv << 16); o1 += pj * __uint_as_float(vv & 0xffff0000u); }
        const float inv = 1.f / sum;
        const unsigned zz = *(const unsigned*)(SZA + HM(b, h, t, 2 * lane));
        o0 = o0 * inv * __uint_as_float(zz << 16); o1 = o1 * inv * __uint_as_float(zz & 0xffff0000u);
        *(unsigned*)(Y + m * 2048 + h * 128 + 2 * lane) = (unsigned)f2bf(o0) | ((unsigned)f2bf(o1) << 16);
        __syncthreads();
    }
}
__global__ void k_moba_naive(const bf16_t* __restrict__ QB, const bf16_t* __restrict__ KB, const bf16_t* __restrict__ VB, const bf16_t* __restrict__ SZB,
                             const float* __restrict__ KMEAN, bf16_t* __restrict__ Y) {
    const int t = blockIdx.x, b = blockIdx.y, tid = threadIdx.x, lane = tid & 63, w = tid >> 6; const size_t m = (size_t)b * SEQ + t;
    __shared__ float qs[8][128]; __shared__ float sc[4][SEQ];
    for (int i = tid; i < 1024; i += 256) qs[i >> 7][i & 127] = bf2f(QB[HM(b, i >> 7, t, i & 127)]);
    __syncthreads();
    const int qblk = t >> 8;
    for (int hh = 0; hh < 2; ++hh) {
        const int h = w + 4 * hh; const float slope = exp2f(-(float)(h + 1));
        float g = -INFINITY;
        if (lane < qblk) { const float* km = KMEAN + ((size_t)(b * NBLK + lane) * NH + h) * HD; float dot = 0.f; for (int d = 0; d < 128; ++d) dot += qs[h][d] * km[d]; g = dot; }
        int rank = 0;
        for (int n2 = 0; n2 < NBLK; ++n2) { const float g2 = __shfl(g, n2); if (n2 < qblk && (g2 > g || (g2 == g && n2 < lane))) ++rank; }
        const bool sel = (lane < qblk) && (rank < 3);
        const unsigned selmask = (unsigned)(__ballot(sel) & 0xffull);
        float mx = -INFINITY;
        for (int s = lane; s <= t; s += 64) { const int blk = s >> 8; float v = -INFINITY;
            if (blk == qblk || ((selmask >> blk) & 1u)) { const bf16_t* kp = KB + HM(b, h, s, 0); float dot = 0.f;
                for (int d = 0; d < 128; ++d) dot += qs[h][d] * bf2f(kp[d]);
                v = dot * QK_SCALE - slope * (float)(t - s); }
            sc[w][s] = v; mx = fmaxf(mx, v); }
        mx = wave_max(mx);
        float sum = 0.f;
        for (int s = lane; s <= t; s += 64) { const float v = sc[w][s]; const float pv = (v == -INFINITY) ? 0.f : __expf(v - mx); sc[w][s] = pv; sum += pv; }
        sum = wave_sum(sum);
        __syncthreads();
        float o0 = 0.f, o1 = 0.f;
        for (int s = 0; s <= t; ++s) { const float pj = sc[w][s]; if (pj == 0.f) continue; const unsigned vv = *(const unsigned*)(VB + HM(b, h, s, 2 * lane));
            o0 += pj * __uint_as_float(vv << 16); o1 += pj * __uint_as_float(vv & 0xffff0000u); }
        const float inv = 1.f / sum;
        const unsigned zz = *(const unsigned*)(SZB + HM(b, h, t, 2 * lane));
        o0 = o0 * inv * __uint_as_float(zz << 16); o1 = o1 * inv * __uint_as_float(zz & 0xffff0000u);
        *(unsigned*)(Y + m * 2048 + 1024 + h * 128 + 2 * lane) = (unsigned)f2bf(o0) | ((unsigned)f2bf(o1) << 16);
        __syncthreads();
    }
}

namespace pg8 {
#define PG8_LAS __attribute__((address_space(3)))
typedef unsigned short bf16_t;
typedef short bf16x8 __attribute__((ext_vector_type(8)));
typedef float f32x4 __attribute__((ext_vector_type(4)));
typedef unsigned u32x4 __attribute__((ext_vector_type(4)));
constexpr int BM = 256, BK = 64, HALF = 128, HTB = HALF * BK * 2  , STAGE_BYTES = 8 * HTB, NXCD = 8, WGM = 8;

__host__ __device__ __forceinline__ int lds_byte(int r, int c) { const int st = (r >> 4) * 2 + (c >> 5), rr = r & 15, cc = c & 31, ob = rr * 64 + cc * 2; return st * 1024 + (ob ^ (((ob >> 9) & 1) << 5)); }
__host__ __device__ __forceinline__ void stage_rc(int b, int& R, int& C) { const int st = b / 1024, sb = b % 1024, swz = sb ^ (((sb >> 9) & 1) << 5); R = (st >> 1) * 16 + swz / 64; C = (st & 1) * 32 + (swz % 64) / 2; }
__host__ __device__ __forceinline__ int perm32(int rho) { const int n = rho >> 4, i = rho & 15; return 8 * (i >> 2) + 4 * n + (i & 3); }

struct Unit { int pm, pn; };
struct Gemm { const void* A; const void* Bt; int M, N, K; };

struct StaticOrder {
    int nM, nN, nwg, G, c, jump_at, jump, base;
    __host__ __device__ void init(int M, int N, int G_, int c_, int base_ = 0, int jump_at_ = 1 << 30, int jump_ = 0) { nM = M / BM; nN = N / BM; nwg = nM * nN; G = G_; c = c_; base = base_; jump_at = jump_at_; jump = jump_; }
    __host__ __device__ bool next(int i, Unit& u) const {
        const long L = (long)i * G + c; if (L >= nwg) return false;
        int wgid = (int)L; { const int q = nwg / NXCD, r = nwg % NXCD, xcd = wgid % NXCD, off = wgid / NXCD; wgid = (xcd < r ? xcd * (q + 1) : r * (q + 1) + (xcd - r) * q) + off; }
        const int nig = WGM * nN, gid = wgid / nig, fm = gid * WGM, gsz = (nM - fm) < WGM ? (nM - fm) : WGM;
        u.pm = fm + ((wgid % nig) % gsz); const int d = (wgid % nig) / gsz; u.pn = d + (d >= jump_at ? jump : base); return true;
    }
    __device__ __forceinline__ void a_ready(const Unit&) const {}
    __device__ __forceinline__ void done(const Unit&) const {}
};

template <class Epi, class Sched, bool ALIGN_EPI = false, bool SP2 = false, bool FP8 = false>
__device__ __forceinline__ void gemm_phase(PG8_LAS unsigned char* lds, const Gemm g, const Sched& S, const Epi& E) {
    const int tid = threadIdx.x, wid = __builtin_amdgcn_readfirstlane(tid >> 6), lane = tid & 63, wr = wid >> 2, wc = wid & 3, fr = lane & 15, fq = lane >> 4;
    const int K = FP8 ? g.K / 2 : g.K, nt = K / BK;
    typedef int i32x8 __attribute__((ext_vector_type(8))); typedef int i32x4v __attribute__((ext_vector_type(4)));
    unsigned voffA[2], voffB[2];
#pragma unroll
    for (int i = 0; i < 2; ++i) { int R, C; stage_rc(tid * 16 + i * 8192, R, C); const int Rb = Epi::PERM ? ((R & ~31) + perm32(R & 31)) : R;
        voffA[i] = (unsigned)(R * K + C) * 2u; voffB[i] = (unsigned)(Rb * K + C) * 2u; }
    const size_t kstep = (size_t)(BK * 2);
    const size_t hstep = (size_t)HALF * K * 2;
    const size_t tstep = 2 * hstep;
    const unsigned ldsw = (unsigned)wid * 1024u;
    const int aoff = lds_byte(wr * 64 + fr, fq * 8), boff = lds_byte(wc * 32 + fr, fq * 8);
#define PG8_SA(b, h) (((b) * 2 + (h)) * HTB)
#define PG8_SB(b, h) ((4 + (b) * 2 + (h)) * HTB)
#define PG8_STAGE(bufoff, gbase, voff) do { _Pragma("unroll") for (int _i = 0; _i < 2; ++_i) \
        __builtin_amdgcn_global_load_lds((const unsigned*)((const char*)(gbase) + (voff)[_i]), (PG8_LAS unsigned*)(lds + (bufoff) + ldsw + _i * 8192), 16, 0, 0); } while (0)
#define PG8_LDA(dst, b, h) do { _Pragma("unroll") for (int m = 0; m < 4; ++m) { dst[m].lo = *(const PG8_LAS i32x4v*)(lds + PG8_SA(b, h) + aoff + m * 2048); dst[m].hi = *(const PG8_LAS i32x4v*)(lds + PG8_SA(b, h) + aoff + m * 2048 + 1024); } } while (0)
#define PG8_LDB(dst, b, h) do { _Pragma("unroll") for (int n = 0; n < 2; ++n) { dst[n].lo = *(const PG8_LAS i32x4v*)(lds + PG8_SB(b, h) + boff + n * 2048); dst[n].hi = *(const PG8_LAS i32x4v*)(lds + PG8_SB(b, h) + boff + n * 2048 + 1024); } } while (0)
#define PG8_MMA(ai, bj, At, Bt) do { __builtin_amdgcn_s_setprio(1); \
        if constexpr (FP8) { _Pragma("unroll") for (int m = 0; m < 4; ++m) _Pragma("unroll") for (int n = 0; n < 2; ++n) \
            asm volatile("v_mfma_f32_16x16x128_f8f6f4 %0, %1, %2, %0" : "+v"(acc[ai][bj][m][n]) : "v"(Bt[n]), "v"(At[m])); }   \
        else { _Pragma("unroll") for (int m = 0; m < 4; ++m) _Pragma("unroll") for (int n = 0; n < 2; ++n) { \
            const i32x4v bl_ = Bt[n].lo, bh_ = Bt[n].hi, al_ = At[m].lo, ah_ = At[m].hi;     \
            acc[ai][bj][m][n] = __builtin_amdgcn_mfma_f32_16x16x32_bf16(__builtin_bit_cast(bf16x8, bl_), __builtin_bit_cast(bf16x8, al_), acc[ai][bj][m][n], 0, 0, 0); \
            acc[ai][bj][m][n] = __builtin_amdgcn_mfma_f32_16x16x32_bf16(__builtin_bit_cast(bf16x8, bh_), __builtin_bit_cast(bf16x8, ah_), acc[ai][bj][m][n], 0, 0, 0); } } \
        __builtin_amdgcn_s_setprio(0); } while (0)
#define PG8_WAIT_V(n) asm volatile("s_waitcnt vmcnt(" #n ")" ::: "memory")
#define PG8_WAIT_L(n) asm volatile("s_waitcnt lgkmcnt(" #n ")" ::: "memory")
#define PG8_BAR __builtin_amdgcn_s_barrier()
#define PG8_SCHED __builtin_amdgcn_sched_barrier(0)
    Unit cur, nxt; int ui = 0;
    if (!S.next(0, cur)) return;
    f32x4 acc[2][2][4][2];
#pragma unroll
    for (int a = 0; a < 2; ++a)
#pragma unroll
        for (int b = 0; b < 2; ++b)
#pragma unroll
            for (int m = 0; m < 4; ++m)
#pragma unroll
                for (int n = 0; n < 2; ++n) acc[a][b][m][n] = (f32x4){0.f, 0.f, 0.f, 0.f};
    i32x8 At[4], B0[2], B1[2];
    const char* cA = (const char*)g.A + (size_t)cur.pm * tstep; const char* cB = (const char*)g.Bt + (size_t)cur.pn * tstep;
    S.a_ready(cur);
    if constexpr (SP2) {
        PG8_STAGE(PG8_SB(0, 0), cB, voffB); PG8_STAGE(PG8_SB(0, 1), cB + hstep, voffB); PG8_STAGE(PG8_SA(0, 0), cA, voffA); PG8_STAGE(PG8_SA(0, 1), cA + hstep, voffA);
        if (wr == 1) PG8_BAR;
        PG8_WAIT_V(2); PG8_BAR;
        PG8_STAGE(PG8_SB(1, 0), cB + kstep, voffB); PG8_STAGE(PG8_SA(1, 0), cA + kstep, voffA); PG8_STAGE(PG8_SB(1, 1), cB + hstep + kstep, voffB);
        PG8_WAIT_V(6); PG8_BAR;
    } else {
        PG8_STAGE(PG8_SB(0, 0), cB, voffB); PG8_STAGE(PG8_SA(0, 0), cA, voffA); PG8_STAGE(PG8_SB(0, 1), cB + hstep, voffB); PG8_STAGE(PG8_SA(0, 1), cA + hstep, voffA);
        if (wr == 1) PG8_BAR;
        PG8_WAIT_V(4); PG8_BAR;
        PG8_STAGE(PG8_SB(1, 0), cB + kstep, voffB); PG8_STAGE(PG8_SA(1, 0), cA + kstep, voffA); PG8_STAGE(PG8_SB(1, 1), cB + hstep + kstep, voffB);
        PG8_WAIT_V(6); PG8_BAR;
    }
    for (;;) {
        const bool has_next = S.next(ui + 1, nxt);
        const char* nA = has_next ? (const char*)g.A + (size_t)nxt.pm * tstep : cA; const char* nB = has_next ? (const char*)g.Bt + (size_t)nxt.pn * tstep : cB;
        for (int t = 0; t < nt; t += 2) {
            const bool last = (t == nt - 2);
            const char* a1 = cA + (size_t)(t + 1) * kstep;
            const char* a2 = last ? nA : cA + (size_t)(t + 2) * kstep; const char* b2 = last ? nB : cB + (size_t)(t + 2) * kstep;
            const char* a3 = a2 + kstep; const char* b3 = b2 + kstep;
            if (last && has_next) S.a_ready(nxt);
            if constexpr (SP2) {
            PG8_LDB(B0, 0, 0); PG8_LDB(B1, 0, 1); PG8_SCHED; PG8_LDA(At, 0, 0); PG8_STAGE(PG8_SA(1, 1), a1 + hstep, voffA);
            PG8_WAIT_V(8); PG8_WAIT_L(0); PG8_BAR; PG8_MMA(0, 0, At, B0); PG8_MMA(0, 1, At, B1); PG8_BAR; PG8_SCHED;
            PG8_LDA(At, 0, 1); PG8_STAGE(PG8_SB(0, 0), b2, voffB); PG8_STAGE(PG8_SB(0, 1), b2 + hstep, voffB); PG8_STAGE(PG8_SA(0, 0), a2, voffA);
            PG8_WAIT_V(8); PG8_WAIT_L(0); PG8_BAR; PG8_MMA(1, 0, At, B0); PG8_MMA(1, 1, At, B1); PG8_BAR; PG8_SCHED;
            PG8_LDB(B0, 1, 0); PG8_LDB(B1, 1, 1); PG8_SCHED; PG8_LDA(At, 1, 0); PG8_STAGE(PG8_SA(0, 1), a2 + hstep, voffA);
            PG8_WAIT_V(8); PG8_WAIT_L(0); PG8_BAR; PG8_MMA(0, 0, At, B0); PG8_MMA(0, 1, At, B1); PG8_BAR; PG8_SCHED;
            PG8_LDA(At, 1, 1); PG8_STAGE(PG8_SB(1, 0), b3, voffB); PG8_STAGE(PG8_SB(1, 1), b3 + hstep, voffB); PG8_STAGE(PG8_SA(1, 0), a3, voffA);
            PG8_WAIT_V(8); PG8_WAIT_L(0); PG8_BAR; PG8_MMA(1, 0, At, B0); PG8_MMA(1, 1, At, B1); PG8_BAR; PG8_SCHED;
            } else {
            PG8_LDB(B0, 0, 0); PG8_SCHED; PG8_LDA(At, 0, 0); PG8_STAGE(PG8_SA(1, 1), a1 + hstep, voffA);
            PG8_WAIT_L(8); PG8_BAR; PG8_WAIT_L(0); PG8_MMA(0, 0, At, B0); PG8_BAR; PG8_SCHED;
            PG8_LDB(B1, 0, 1); PG8_STAGE(PG8_SB(0, 0), b2, voffB);
            PG8_BAR; PG8_WAIT_L(0); PG8_MMA(0, 1, At, B1); PG8_BAR;
            PG8_LDA(At, 0, 1); PG8_STAGE(PG8_SA(0, 0), a2, voffA);
            PG8_BAR; PG8_WAIT_L(0); PG8_MMA(1, 0, At, B0); PG8_BAR; PG8_SCHED;
            PG8_STAGE(PG8_SB(0, 1), b2 + hstep, voffB);
            PG8_WAIT_V(6); PG8_BAR; PG8_MMA(1, 1, At, B1); PG8_BAR;
            PG8_LDB(B0, 1, 0); PG8_SCHED; PG8_LDA(At, 1, 0); PG8_STAGE(PG8_SA(0, 1), a2 + hstep, voffA);
            PG8_WAIT_L(8); PG8_BAR; PG8_WAIT_L(0); PG8_MMA(0, 0, At, B0); PG8_BAR; PG8_SCHED;
            PG8_LDB(B1, 1, 1); PG8_STAGE(PG8_SB(1, 0), b3, voffB);
            PG8_BAR; PG8_WAIT_L(0); PG8_MMA(0, 1, At, B1); PG8_BAR;
            PG8_LDA(At, 1, 1); PG8_STAGE(PG8_SA(1, 0), a3, voffA);
            PG8_BAR; PG8_WAIT_L(0); PG8_MMA(1, 0, At, B0); PG8_BAR; PG8_SCHED;
            PG8_STAGE(PG8_SB(1, 1), b3 + hstep, voffB);
            PG8_WAIT_V(6); PG8_BAR; PG8_MMA(1, 1, At, B1); PG8_BAR;
            }
        }
        if constexpr (ALIGN_EPI) { if (wr == 0) PG8_BAR; }
        if constexpr (FP8) asm volatile("s_nop 15\n\ts_nop 15" ::: "memory");
        PG8_SCHED;
        if constexpr (!Epi::AFTER_DRAIN) { E(acc, cur, wr, wc, fr, fq); S.done(cur); }
        PG8_SCHED;
        if (!has_next) break;
#pragma unroll
        for (int a = 0; a < 2; ++a)
#pragma unroll
            for (int b = 0; b < 2; ++b)
#pragma unroll
                for (int m = 0; m < 4; ++m)
#pragma unroll
                    for (int n = 0; n < 2; ++n) acc[a][b][m][n] = (f32x4){0.f, 0.f, 0.f, 0.f};
        cur = nxt; cA = nA; cB = nB; ++ui;
        if constexpr (ALIGN_EPI) { if (wr == 1) PG8_BAR; }
    }
    PG8_WAIT_V(0);
    if constexpr (!ALIGN_EPI) { if (wr == 0) PG8_BAR; }
    PG8_BAR;
    if constexpr (Epi::AFTER_DRAIN) { E.fused(acc, cur, wr, wc, fr, fq, lds, wid, lane); S.done(cur); }
#undef PG8_SA
#undef PG8_SB
#undef PG8_STAGE
#undef PG8_LDA
#undef PG8_LDB
#undef PG8_MMA
#undef PG8_WAIT_V
#undef PG8_WAIT_L
#undef PG8_BAR
#undef PG8_SCHED
}
}

#define GAS __attribute__((address_space(1)))
#define LAS __attribute__((address_space(3)))
typedef unsigned v4u __attribute__((ext_vector_type(4)));
typedef float f32x4 __attribute__((ext_vector_type(4)));
typedef GAS unsigned gu32;
#define RLX_AGENT __ATOMIC_RELAXED, __HIP_MEMORY_SCOPE_AGENT
#define LDS_WAIT() asm volatile("s_waitcnt lgkmcnt(0)" ::: "memory")
#define VM_WAIT() asm volatile("s_waitcnt vmcnt(0)" ::: "memory")
constexpr int NWAVES = 8;
constexpr int NPAD = 9472;
constexpr size_t MiB = 1u << 20;
constexpr size_t WS_CTL = 0, CTL_ZERO_BYTES = 1 * MiB;
constexpr size_t WS_MOD = 1 * MiB;
constexpr size_t WS_GAIN = 1 * MiB + 256 * 1024;
constexpr size_t WS_KMEAN = 1 * MiB + 512 * 1024;
constexpr size_t WS_WI = 2 * MiB;
constexpr size_t WS_KI = 3 * MiB;
constexpr size_t WS_MASK = 5 * MiB;
constexpr size_t WS_MODP = 10 * MiB;
constexpr size_t WS_WIN = 18 * MiB;
constexpr size_t WS_HB = 56 * MiB;
constexpr size_t WS_Y = 56 * MiB;
constexpr size_t WS_QA = 120 * MiB, WS_KA = 152 * MiB, WS_VA = 184 * MiB, WS_SZA = 216 * MiB;
constexpr size_t WS_QB = 248 * MiB, WS_KB = 280 * MiB, WS_VB = 312 * MiB, WS_SZB = 344 * MiB;
constexpr size_t WS_QI = 376 * MiB;
constexpr size_t WS_T32 = 408 * MiB;
constexpr size_t WS_Y8 = 408 * MiB;
constexpr size_t WS_HB8 = 440 * MiB;
constexpr size_t WS_WIN8 = 472 * MiB;
constexpr size_t WS_WOUT8 = 492 * MiB;
constexpr size_t WS_END = 496 * MiB;
constexpr float FP8_DESCALE = 1.f / 512.f;
constexpr int CW_BAR = 4096;
constexpr int RING_BYTES = 131072;
constexpr int EPI_OFF = RING_BYTES;
constexpr int LDSCTL_OFF = EPI_OFF + 16384, MISC_OFF = LDSCTL_OFF + 320;
constexpr int LDS_BYTES = 163840;

#define XB_TMO      128
#define XB_XCNT(j)  (256  + 64 * (j))
#define XB_XSUB(j)  (1280 + 64 * (j))
#define XB_XGEN(j)  (2304 + 64 * (j))
#define XB_TOP      3328
#define XB_TOPGEN   3392
#define XCD_BAR_WORDS 3456
#define XB_SPIN_CAP (1u << 18)

__device__ __forceinline__ unsigned xb_ld(unsigned* p)              { return __hip_atomic_load(p, __ATOMIC_RELAXED, __HIP_MEMORY_SCOPE_AGENT); }
__device__ __forceinline__ unsigned xb_add(unsigned* p, unsigned v) { return __hip_atomic_fetch_add(p, v, __ATOMIC_RELAXED, __HIP_MEMORY_SCOPE_AGENT); }
__device__ __forceinline__ unsigned xb_xcc_id() { return (unsigned)__builtin_amdgcn_s_getreg((3 << 11) | 20) & 0xFu; }
#define XB_SPIN(cond, bar) do { unsigned _sp = 0; while (cond) { __builtin_amdgcn_s_sleep(1); \
    if ((++_sp & 255u) == 0u) { if (xb_ld(&(bar)[XB_TMO])) break; if (_sp > XB_SPIN_CAP) { atomicAdd(&(bar)[XB_TMO], 1u); break; } } } } while (0)

struct XcdBarrier {
    unsigned* bar; unsigned x;
    volatile LAS unsigned* st;
};

__device__ __forceinline__ XcdBarrier xcd_barrier_post(unsigned* bar, volatile LAS unsigned* st) {
    XcdBarrier b; b.bar = bar; b.x = xb_xcc_id(); b.st = st;
    if (threadIdx.x == 0) (void)xb_add(&bar[XB_XCNT(b.x)], 1u);
    return b;
}
__device__ __forceinline__ void xcd_barrier_complete(unsigned* bar, unsigned x, unsigned& nloc, unsigned& nx) {
    const unsigned G = gridDim.x * gridDim.y * gridDim.z;
    unsigned sum, cnt, mine, sp = 0u;
    for (;;) {
        sum = 0u; cnt = 0u; mine = 0u;
#pragma unroll
        for (unsigned j = 0; j < 16; ++j) { const unsigned c = xb_ld(&bar[XB_XCNT(j)]); sum += c; cnt += (c > 0u) ? 1u : 0u; mine = (j == x) ? c : mine; }
        if (sum == G) break;
        __builtin_amdgcn_s_sleep(1);
        if ((++sp & 255u) == 0u) { if (xb_ld(&bar[XB_TMO])) break; if (sp > XB_SPIN_CAP) { atomicAdd(&bar[XB_TMO], 1u); break; } }
    }
    nloc = mine > 0u ? mine : 1u; nx = cnt > 0u ? cnt : 1u;
}

__device__ __forceinline__ void xcd_barrier(const XcdBarrier& b) {
    asm volatile("s_waitcnt vmcnt(0)" ::: "memory");
    __syncthreads();
    if (threadIdx.x == 0) {
        unsigned* bar = b.bar;
        __builtin_amdgcn_s_waitcnt(0);
        unsigned nloc = b.st[0], nx = b.st[1];
        if (nloc == 0u) { xcd_barrier_complete(bar, b.x, nloc, nx); b.st[0] = nloc; b.st[1] = nx; }
        const unsigned old = xb_add(&bar[XB_XSUB(b.x)], 1u);
        const unsigned gen = old / nloc;
        if (old + 1u == (gen + 1u) * nloc) {
            __builtin_amdgcn_fence(__ATOMIC_RELEASE, "agent");
            asm volatile("s_waitcnt vmcnt(0)" ::: "memory");
            const unsigned og = xb_add(&bar[XB_TOP], 1u);
            const unsigned tg = og / nx;
            if (og + 1u == (tg + 1u) * nx) xb_add(&bar[XB_TOPGEN], 1u);
            else XB_SPIN(xb_ld(&bar[XB_TOPGEN]) == tg, bar);
            __builtin_amdgcn_fence(__ATOMIC_ACQUIRE, "agent");
            xb_add(&bar[XB_XGEN(b.x)], 1u);
            asm volatile("s_waitcnt vmcnt(0)" ::: "memory");
        } else {
            XB_SPIN(xb_ld(&bar[XB_XGEN(b.x)]) == gen, bar);
            __builtin_amdgcn_fence(__ATOMIC_ACQUIRE, "agent");
            asm volatile("s_waitcnt vmcnt(0)" ::: "memory");
        }
    }
    __syncthreads();
}


struct Frame {
    LAS unsigned char* lds; volatile LAS unsigned* MISC; gu32* ctl; int tid, lane, wave, vcu, G;
};
__device__ __forceinline__ unsigned cvt_pk_bf16(float lo, float hi) { unsigned r; asm volatile("v_cvt_pk_bf16_f32 %0, %1, %2" : "=v"(r) : "v"(lo), "v"(hi)); return r; }
__device__ __forceinline__ unsigned f2bf_u(float f) { unsigned u = __builtin_bit_cast(unsigned, f); return (u + 0x7fffu + ((u >> 16) & 1u)) >> 16; }
__device__ __forceinline__ unsigned pk2(float lo, float hi) { return f2bf_u(lo) | (f2bf_u(hi) << 16); }
__device__ __forceinline__ float fast_silu(float v) { return v * __builtin_amdgcn_rcpf(1.f + __expf(-v)); }

__device__ __forceinline__ void p0_mod(Frame& F, int id, const float* __restrict__ c, const float* __restrict__ w_ada, float* __restrict__ MODP) {
    const int cs = id & 15, ks = id >> 4;
    LAS float* sc = (LAS float*)(F.lds);
    LAS float* red = (LAS float*)(F.lds + 4096);
    for (int i = F.tid; i < BATCH * 128; i += NWAVES * 64) sc[i] = silu_f(c[(i >> 7) * DM + ks * 128 + (i & 127)]);
    __syncthreads();
    const int cq = F.tid % 96, kq = F.tid / 96;
    if (F.tid < 480) {
        f32x4 acc[8];
#pragma unroll
        for (int b = 0; b < 8; ++b) acc[b] = (f32x4){0.f, 0.f, 0.f, 0.f};
        const float* wp = w_ada + (size_t)(ks * 128) * (3 * DM) + cs * 384 + 4 * cq;
#pragma unroll 4
        for (int k = kq; k < 128; k += 5) { const f32x4 w = *(const f32x4*)(wp + (size_t)k * (3 * DM));
#pragma unroll
            for (int b = 0; b < 8; ++b) acc[b] += w * sc[b * 128 + k]; }
#pragma unroll
        for (int b = 0; b < 8; ++b) *(LAS f32x4*)(red + (kq * 8 + b) * 384 + 4 * cq) = acc[b];
    }
    __syncthreads();
    for (int o = F.tid; o < 8 * 384; o += NWAVES * 64) { const int b = o / 384, col = o % 384; float s = 0.f;
#pragma unroll
        for (int q = 0; q < 5; ++q) s += red[(q * 8 + b) * 384 + col];
        MODP[((size_t)ks * BATCH + b) * (3 * DM) + cs * 384 + col] = s; }
    __syncthreads();
}
__device__ __forceinline__ unsigned pk4_fp8(float a, float b, float c, float d) {
    a = fminf(fmaxf(a, -448.f), 448.f); b = fminf(fmaxf(b, -448.f), 448.f); c = fminf(fmaxf(c, -448.f), 448.f); d = fminf(fmaxf(d, -448.f), 448.f);
    int w = 0; w = __builtin_amdgcn_cvt_pk_fp8_f32(a, b, w, false); w = __builtin_amdgcn_cvt_pk_fp8_f32(c, d, w, true); return (unsigned)w; }
template <bool MAPWIN>
__device__ __forceinline__ void p0_transpose_item(const float* __restrict__ W, int K, int N, int NP, bf16_t* __restrict__ WT, unsigned char* __restrict__ WT8, LAS float* scr, int item, int lane) {
    const int nblk = NP / 32, kb = item / nblk, nb = item % nblk, k0 = 64 * kb, n0 = 32 * nb;
    const int np = n0 + (lane & 31);
    int src = np; bool valid = true;
    if (MAPWIN) { if (np >= 5376) src = np - 176; else if (np >= 5200) valid = false; }
    float wv_[32];
#pragma unroll
    for (int i = 0; i < 32; ++i) { const int kk = 2 * i + (lane >> 5); wv_[i] = valid ? W[(size_t)(k0 + kk) * N + src] : 0.f; }
#pragma unroll
    for (int i = 0; i < 32; ++i) { const int kk = 2 * i + (lane >> 5); scr[kk * 33 + (lane & 31)] = wv_[i]; }
    LDS_WAIT(); asm volatile("" ::: "memory");
    const int c = lane & 7;
    if (WT) {
#pragma unroll
    for (int j = 0; j < 4; ++j) { const int n = (lane >> 3) + 8 * j; const LAS float* s = scr + (8 * c) * 33 + n;
        v4u o; o.x = pk2(s[0 * 33], s[1 * 33]); o.y = pk2(s[2 * 33], s[3 * 33]); o.z = pk2(s[4 * 33], s[5 * 33]); o.w = pk2(s[6 * 33], s[7 * 33]);
        *(GAS v4u*)(WT + (size_t)(n0 + n) * K + k0 + 8 * c) = o; } }
    if (WT8) {
#pragma unroll
        for (int jj = 0; jj < 2; ++jj) { const int idx = lane + 64 * jj, n = idx >> 2, c4 = idx & 3; const LAS float* s = scr + (16 * c4) * 33 + n;
            v4u o; o.x = pk4_fp8(s[0 * 33] * 64.f, s[1 * 33] * 64.f, s[2 * 33] * 64.f, s[3 * 33] * 64.f); o.y = pk4_fp8(s[4 * 33] * 64.f, s[5 * 33] * 64.f, s[6 * 33] * 64.f, s[7 * 33] * 64.f);
            o.z = pk4_fp8(s[8 * 33] * 64.f, s[9 * 33] * 64.f, s[10 * 33] * 64.f, s[11 * 33] * 64.f); o.w = pk4_fp8(s[12 * 33] * 64.f, s[13 * 33] * 64.f, s[14 * 33] * 64.f, s[15 * 33] * 64.f);
            *(GAS v4u*)(WT8 + (size_t)(n0 + n) * K + k0 + 16 * c4) = o; } }
    LDS_WAIT(); asm volatile("" ::: "memory");
}
__device__ __forceinline__ void p0_convert(Frame& F, const float* __restrict__ w_in, const float* __restrict__ w_out, bf16_t* __restrict__ WinT, unsigned char* __restrict__ WinT8, unsigned char* __restrict__ WoutT8) {
    LAS float* scr = (LAS float*)(F.lds + F.wave * 16384);
    const int gw = F.vcu * NWAVES + F.wave, NGW = F.G * NWAVES;
    constexpr int I_IN = (DM / 64) * (NPAD / 32), I_OUT = (DM / 64) * (DM / 32);
    for (int it = gw; it < I_IN + I_OUT; it += NGW) {
        if (it < I_IN) { const int tile = (it % (NPAD / 32)) >> 3; const bool b16 = (tile >= 16 && tile <= 24);
            p0_transpose_item<true>(w_in, DM, DIN, NPAD, b16 ? WinT : nullptr, b16 ? nullptr : WinT8, scr, it, F.lane); }
        else p0_transpose_item<false>(w_out, DM, DM, DM, nullptr, WoutT8, scr, it - I_IN, F.lane);
    }
}
__device__ __forceinline__ void p1_norm(Frame& F, const float* __restrict__ x, const float* __restrict__ g, const float* __restrict__ MODP, const float* __restrict__ b_ada, float* __restrict__ MOD,
                                        bf16_t* __restrict__ HB, unsigned char* __restrict__ HB8) {
    LAS float* gsl = (LAS float*)(F.lds);
    LAS float* shl = (LAS float*)(F.lds + 8192);
    for (int v = F.vcu; v < M / 64; v += F.G) {
        const int b = v / (SEQ / 64);
        { const int k4 = F.tid * 4; const float* pp = MODP + (size_t)b * (3 * DM) + k4;
          f32x4 sh = *(const f32x4*)(b_ada + k4), scl = *(const f32x4*)(b_ada + DM + k4);
#pragma unroll 4
          for (int q = 0; q < 16; ++q) { sh += *(const f32x4*)(pp + (size_t)q * BATCH * (3 * DM)); scl += *(const f32x4*)(pp + (size_t)q * BATCH * (3 * DM) + DM); }
          const f32x4 gg = *(const f32x4*)(g + k4);
          *(LAS f32x4*)(gsl + k4) = gg * (scl + 1.0f); *(LAS f32x4*)(shl + k4) = sh;
          if (F.tid < 64) { const int col = 2 * DM + 64 * (v % (SEQ / 64)) + F.tid; float gt = b_ada[col];
              for (int q = 0; q < 16; ++q) gt += MODP[((size_t)q * BATCH + b) * (3 * DM) + col];
              MOD[b * 3 * DM + col] = gt; } }
        __syncthreads();
        f32x4 gs[8], sh[8];
#pragma unroll
        for (int j = 0; j < 8; ++j) { const int k = 4 * F.lane + 256 * j; gs[j] = *(const LAS f32x4*)(gsl + k); sh[j] = *(const LAS f32x4*)(shl + k); }
        for (int r = 0; r < 8; ++r) {
            const int row = 64 * v + 8 * F.wave + r;
            const f32x4* xr = (const f32x4*)(x + (size_t)row * DM) + F.lane;
            f32x4 xv[8]; float ss = 0.f;
#pragma unroll
            for (int j = 0; j < 8; ++j) { xv[j] = xr[64 * j]; ss += (xv[j].x * xv[j].x + xv[j].y * xv[j].y) + (xv[j].z * xv[j].z + xv[j].w * xv[j].w); }
            ss = wave_sum(ss);
            const float rstd = rsqrtf(ss * (1.f / DM) + RMS_EPS);
            unsigned long long* o8 = (unsigned long long*)(HB + (size_t)row * DM) + F.lane; unsigned* o4 = (unsigned*)(HB8 + (size_t)row * DM) + F.lane;
#pragma unroll
            for (int j = 0; j < 8; ++j) { const f32x4 h = xv[j] * rstd * gs[j] + sh[j];
                o8[64 * j] = (unsigned long long)pk2(h.x, h.y) | ((unsigned long long)pk2(h.z, h.w) << 32);
                o4[64 * j] = pk4_fp8(h.x * 8.f, h.y * 8.f, h.z * 8.f, h.w * 8.f); }
        }
        __syncthreads();
    }
}
struct EpiProj {
    static constexpr bool PERM = true, AFTER_DRAIN = false;
    unsigned char* ws;
    LAS float* P; float osc;
    __device__ __forceinline__ void operator()(const pg8::f32x4 (&acc)[2][2][4][2], const pg8::Unit& u, int wr, int wc, int fr, int fq) const {
        { int l_ = threadIdx.x & 63; asm volatile("" : "+v"(l_)); fr = l_ & 15; fq = l_ >> 4; }
        const int pn = u.pn;
        bf16_t* const KI = (bf16_t*)(ws + WS_KI); float* const WI = (float*)(ws + WS_WI); bf16_t* const QI = (bf16_t*)(ws + WS_QI);
        int grp, sub;
        if (pn < 20) { grp = pn >> 2; sub = pn & 3; } else if (pn == 20) { grp = 5; sub = 0; } else { grp = 6 + ((pn - 21) >> 2); sub = (pn - 21) & 3; }
        const int b = u.pm >> 3, t0 = (u.pm & 7) * 256 + wr * 64 + fr;
        const int cl = 32 * wc + 8 * fq;
        const bool norm = (grp == 0 || grp == 1 || grp == 6 || grp == 7 || grp == 5);
        float rs[2][4][2];
        if (norm) {
#pragma unroll
            for (int ai = 0; ai < 2; ++ai)
#pragma unroll
                for (int m = 0; m < 4; ++m)
#pragma unroll
                    for (int bj = 0; bj < 2; ++bj) { const pg8::f32x4 a = acc[ai][bj][m][0], c = acc[ai][bj][m][1];
                        float s = (a[0] * a[0] + a[1] * a[1]) + (a[2] * a[2] + a[3] * a[3]) + (c[0] * c[0] + c[1] * c[1]) + (c[2] * c[2] + c[3] * c[3]);
                        s += __shfl_xor(s, 16); s += __shfl_xor(s, 32);
                        if (fq == 0) P[((ai * 128 + wr * 64 + m * 16 + fr) * 2 + bj) * 4 + wc] = s; }
            asm volatile("s_waitcnt lgkmcnt(0)" ::: "memory"); __builtin_amdgcn_s_barrier(); asm volatile("" ::: "memory");
#pragma unroll
            for (int ai = 0; ai < 2; ++ai)
#pragma unroll
                for (int m = 0; m < 4; ++m)
#pragma unroll
                    for (int bj = 0; bj < 2; ++bj) { const pg8::f32x4 q = *(const LAS pg8::f32x4*)(P + ((ai * 128 + wr * 64 + m * 16 + fr) * 2 + bj) * 4);
                        rs[ai][m][bj] = ((grp == 5) ? rsqrtf((q[0] + q[1]) * (osc * osc * (1.f / 64.f)) + RMS_EPS) : rsqrtf(((q[0] + q[1]) + (q[2] + q[3])) * (osc * osc * (1.f / 128.f)) + RMS_EPS)) * osc; }
        }
        if (grp == 5) {
            if (wc < 2) { const float* gki = (const float*)(ws + WS_GAIN) + 4 * 128; const pg8::f32x4 g0 = *(const pg8::f32x4*)(gki + cl), g1 = *(const pg8::f32x4*)(gki + cl + 4);
#pragma unroll
                for (int ai = 0; ai < 2; ++ai)
#pragma unroll
                    for (int m = 0; m < 4; ++m) { const size_t row = (size_t)b * SEQ + t0 + 128 * ai + 16 * m; const float r = rs[ai][m][0];
                        const pg8::f32x4 v0 = acc[ai][0][m][0] * r * g0, v1 = acc[ai][0][m][1] * r * g1;
                        pg8::u32x4 w; w.x = cvt_pk_bf16(v0[0], v0[1]); w.y = cvt_pk_bf16(v0[2], v0[3]); w.z = cvt_pk_bf16(v1[0], v1[1]); w.w = cvt_pk_bf16(v1[2], v1[3]);
                        *(pg8::u32x4*)(KI + row * 64 + cl) = w; } }
            else if (wc == 2 && fq < 2) {
#pragma unroll
                for (int ai = 0; ai < 2; ++ai)
#pragma unroll
                    for (int m = 0; m < 4; ++m) { const size_t row = (size_t)b * SEQ + t0 + 128 * ai + 16 * m;
                        *(pg8::f32x4*)(WI + row * 16 + 8 * fq) = acc[ai][0][m][0]; *(pg8::f32x4*)(WI + row * 16 + 8 * fq + 4) = acc[ai][0][m][1]; } }
            return;
        }
        if (grp == 4) {
#pragma unroll
            for (int ai = 0; ai < 2; ++ai)
#pragma unroll
                for (int m = 0; m < 4; ++m) { const size_t row = (size_t)b * SEQ + t0 + 128 * ai + 16 * m;
#pragma unroll
                    for (int bj = 0; bj < 2; ++bj) { const pg8::f32x4 v0 = acc[ai][bj][m][0], v1 = acc[ai][bj][m][1];
                        pg8::u32x4 w; w.x = cvt_pk_bf16(v0[0], v0[1]); w.y = cvt_pk_bf16(v0[2], v0[3]); w.z = cvt_pk_bf16(v1[0], v1[1]); w.w = cvt_pk_bf16(v1[2], v1[3]);
                        *(pg8::u32x4*)(QI + row * 1024 + sub * 256 + bj * 128 + cl) = w; } }
            return;
        }
        bf16_t* dst; const float* gain = nullptr;
        { const int slot = grp < 4 ? grp : grp - 2;
          dst = (bf16_t*)(ws + WS_QA + (size_t)slot * (32 * MiB));
          gain = (const float*)(ws + WS_GAIN) + (grp < 2 ? grp : grp - 4) * 128; }
        pg8::f32x4 g0 = {1.f, 1.f, 1.f, 1.f}, g1 = {1.f, 1.f, 1.f, 1.f};
        if (norm) { g0 = *(const pg8::f32x4*)(gain + cl); g1 = *(const pg8::f32x4*)(gain + cl + 4); }
        const bool act = (grp == 3 || grp == 9);
#pragma unroll
        for (int ai = 0; ai < 2; ++ai)
#pragma unroll
            for (int m = 0; m < 4; ++m) { const int t = t0 + 128 * ai + 16 * m;
#pragma unroll
                for (int bj = 0; bj < 2; ++bj) { const int h = 2 * sub + bj;
                    pg8::f32x4 v0 = acc[ai][bj][m][0], v1 = acc[ai][bj][m][1];
                    if (norm) { const float r = rs[ai][m][bj]; v0 = v0 * r * g0; v1 = v1 * r * g1; } else { v0 = v0 * osc; v1 = v1 * osc; }
                    if (act) { v0[0] = fast_silu(v0[0]); v0[1] = fast_silu(v0[1]); v0[2] = fast_silu(v0[2]); v0[3] = fast_silu(v0[3]);
                               v1[0] = fast_silu(v1[0]); v1[1] = fast_silu(v1[1]); v1[2] = fast_silu(v1[2]); v1[3] = fast_silu(v1[3]); }
                    pg8::u32x4 w; w.x = cvt_pk_bf16(v0[0], v0[1]); w.y = cvt_pk_bf16(v0[2], v0[3]); w.z = cvt_pk_bf16(v1[0], v1[1]); w.w = cvt_pk_bf16(v1[2], v1[3]);
                    *(pg8::u32x4*)(dst + HM(b, h, t, cl)) = w; } }
    }
};
struct EpiOut {
    static constexpr bool PERM = false, AFTER_DRAIN = false;
    const float* x; const float* MOD; float* out; float oscale;
    __device__ __forceinline__ void operator()(const pg8::f32x4 (&acc)[2][2][4][2], const pg8::Unit& u, int wr, int wc, int fr, int fq) const {
        { int l_ = threadIdx.x & 63; asm volatile("" : "+v"(l_)); fr = l_ & 15; fq = l_ >> 4; }
        const int b = u.pm >> 3; const float* gate = MOD + b * 3 * DM + 2 * DM;
        const int col0 = u.pn * 256 + wc * 32 + 4 * fq;
        pg8::f32x4 gv[2][2];
#pragma unroll
        for (int bj = 0; bj < 2; ++bj)
#pragma unroll
            for (int n = 0; n < 2; ++n) gv[bj][n] = *(const pg8::f32x4*)(gate + col0 + bj * 128 + n * 16) * oscale;
#pragma unroll
        for (int ai = 0; ai < 2; ++ai)
#pragma unroll
            for (int m = 0; m < 4; ++m) { const size_t off = (size_t)(u.pm * 256 + ai * 128 + wr * 64 + m * 16 + fr) * DM + col0;
#pragma unroll
                for (int bj = 0; bj < 2; ++bj)
#pragma unroll
                    for (int n = 0; n < 2; ++n) { const pg8::f32x4 xv = *(const pg8::f32x4*)(x + off + bj * 128 + n * 16);
                        *(pg8::f32x4*)(out + off + bj * 128 + n * 16) = xv + gv[bj][n] * acc[ai][bj][m][n]; }
                if (m & 1) asm volatile("" ::: "memory"); }
    }
};

namespace att {
typedef short bf16x8 __attribute__((ext_vector_type(8)));
typedef short s16x4 __attribute__((ext_vector_type(4)));
typedef float f32x16 __attribute__((ext_vector_type(16)));
typedef float f32x4 __attribute__((ext_vector_type(4)));
typedef unsigned u32x4 __attribute__((ext_vector_type(4)));
constexpr int NW = 8, QBLK = 32, KVBLK = 64, QB = NW * QBLK, D = 128;
constexpr int SHM_V = KVBLK * D * 2, SHM_K = KVBLK * D * 2;
constexpr int LDS_WS = 2 * SHM_V + 2 * SHM_K, LDS_KM = LDS_WS + NW * 64 * 4, LDS_OST = 73728, MST_PITCH = 264, MST_WAVE = QBLK * MST_PITCH, LDS_BYTES = LDS_OST + NW * MST_WAVE;
constexpr float SCALE = 0.08838834764831845f, THR = 8.f;
#define KSWZ(row, colB) ((row) * 256 + ((colB) ^ (((row) & 7) << 4)))
#define SBAR() __builtin_amdgcn_sched_barrier(0)
__device__ __forceinline__ int v_st(int k, int c) { const int kk = (k & ~0xC) | ((k & 4) << 1) | ((k & 8) >> 1); return ((kk >> 3) * 4 + (c >> 5)) * 512 + ((kk & 7) * 32 + (c & 31)) * 2; }
__device__ __forceinline__ int v_rd_base(int lane) { return ((lane & 3) << 3) | (((lane >> 2) & 3) << 6) | (((lane >> 4) & 1) << 5) | (((lane >> 5) & 1) << 8); }
constexpr int v_rd_off(int d0, int ks, int half) { return d0 * 512 + ks * 4096 + half * 2048; }
__device__ __forceinline__ int crow(int r, int hi) { return (r & 3) + 8 * (r >> 2) + 4 * hi; }
__device__ __forceinline__ unsigned cvtpk(float lo, float hi) { unsigned r; asm volatile("v_cvt_pk_bf16_f32 %0, %1, %2" : "=v"(r) : "v"(lo), "v"(hi)); return r; }
__device__ __forceinline__ unsigned cvt1(float v) { unsigned r; asm volatile("v_cvt_pk_bf16_f32 %0, %1, 0" : "=v"(r) : "v"(v)); return r; }
__device__ __forceinline__ bf16x8 load8(const bf16_t* p) { return *reinterpret_cast<const bf16x8*>(p); }
__device__ __forceinline__ void mask_causal(f32x16& p0, f32x16& p1, int dq) {
    const float NEG = -__builtin_inff();
#pragma unroll
    for (int r = 0; r < 16; ++r) { const int c = (r & 3) + 8 * (r >> 2); if (dq - c < 0) p0[r] = NEG; if (dq - c - 32 < 0) p1[r] = NEG; }
}
__device__ __forceinline__ void mask_bits(f32x16& p0, f32x16& p1, unsigned w0, unsigned w1) {
    const unsigned NEGB = 0xff800000u;
#pragma unroll
    for (int r = 0; r < 16; ++r) { const int c = (r & 3) + 8 * (r >> 2);
        const unsigned t0 = (unsigned)(((int)(w0 << (31 - c))) >> 31), t1 = (unsigned)(((int)(w1 << (31 - c))) >> 31);
        p0[r] = __uint_as_float((__float_as_uint(p0[r]) & t0) | (NEGB & ~t0));
        p1[r] = __uint_as_float((__float_as_uint(p1[r]) & t1) | (NEGB & ~t1)); }
}
__device__ __forceinline__ void partialSM(f32x16& p0, f32x16& p1, float& m_reg, float& mn, float& alpha) {
    float pmax = p0[0]; for (int r = 1; r < 16; ++r) pmax = fmaxf(pmax, p0[r]); for (int r = 0; r < 16; ++r) pmax = fmaxf(pmax, p1[r]);
    { auto rr = __builtin_amdgcn_permlane32_swap(__float_as_uint(pmax), __float_as_uint(pmax), false, false);
      pmax = fmaxf(__uint_as_float(rr[0]), __uint_as_float(rr[1])); }
    constexpr float C2 = 1.4426950408889634f * SCALE;
    if (__builtin_expect(__all((pmax - m_reg) * SCALE <= THR), 1)) { mn = m_reg; alpha = 1.f; }
    else { mn = fmaxf(m_reg, pmax); alpha = __builtin_amdgcn_exp2f((m_reg - mn) * C2); m_reg = mn; }
    const float mnL = -mn * C2;
    for (int r = 0; r < 16; ++r) p0[r] = fmaf(p0[r], C2, mnL); for (int r = 0; r < 16; ++r) p1[r] = fmaf(p1[r], C2, mnL);
    for (int r = 0; r < 16; ++r) p0[r] = __builtin_amdgcn_exp2f(p0[r]);
}
__device__ __forceinline__ void finishSM(f32x16& p0, f32x16& p1, float alpha, float& l_reg, bf16x8& pa0, bf16x8& pa1, bf16x8& pa2, bf16x8& pa3) {
    for (int r = 0; r < 16; ++r) p1[r] = __builtin_amdgcn_exp2f(p1[r]);
    float ps = 0; for (int r = 0; r < 16; ++r) ps += p0[r]; for (int r = 0; r < 16; ++r) ps += p1[r];
    { auto rr = __builtin_amdgcn_permlane32_swap(__float_as_uint(ps), __float_as_uint(ps), false, false);
      ps = __uint_as_float(rr[0]) + __uint_as_float(rr[1]); }
    l_reg = l_reg * alpha + ps;
#define PK4(P, B_, OUT) do { unsigned a0 = cvtpk(P[B_+0], P[B_+1]), a1 = cvtpk(P[B_+2], P[B_+3]);                          \
        unsigned b0 = cvtpk(P[B_+4], P[B_+5]), b1 = cvtpk(P[B_+6], P[B_+7]);                                             \
        auto r0 = __builtin_amdgcn_permlane32_swap(a0, b0, false, false); auto r1 = __builtin_amdgcn_permlane32_swap(a1, b1, false, false); \
        u32x4 w = {r0[0], r1[0], r0[1], r1[1]}; OUT = *reinterpret_cast<bf16x8*>(&w); } while (0)
    PK4(p0, 0, pa0); PK4(p0, 8, pa1); PK4(p1, 0, pa2); PK4(p1, 8, pa3);
#undef PK4
}
template <int KB>
__device__ __forceinline__ void qkt(f32x16& p0, f32x16& p1, const char* K_lds, int r32, int hi, const bf16x8* qr, float cb, float sl) {
#pragma unroll
    for (int r = 0; r < 16; ++r) { const int c = (r & 3) + 8 * (r >> 2); p0[r] = fmaf(sl, (float)c, cb); p1[r] = fmaf(sl, (float)(c + 32), cb); }
    const char* kb[4];
#pragma unroll
    for (int dd = 0; dd < 4; ++dd) kb[dd] = K_lds + KB * SHM_K + KSWZ(r32, (dd * 16 + hi * 8) * 2);
#pragma unroll
    for (int d0 = 0; d0 < 8; ++d0) { const char* a = kb[d0 & 3] + (d0 >> 2) * 128;
        bf16x8 b0 = *reinterpret_cast<const bf16x8*>(a);
        bf16x8 b1 = *reinterpret_cast<const bf16x8*>(a + 32 * 256);
        p0 = __builtin_amdgcn_mfma_f32_32x32x16_bf16(b0, qr[d0], p0, 0, 0, 0);
        p1 = __builtin_amdgcn_mfma_f32_32x32x16_bf16(b1, qr[d0], p1, 0, 0, 0); }
}
template <int VB>
__device__ __forceinline__ void pv_tile(f32x16* o, int vb0, bf16x8 pa0, bf16x8 pa1, bf16x8 pa2, bf16x8 pa3) {
#define TRRD(dst, off) asm volatile("ds_read_b64_tr_b16 %0, %1 offset:%2" : "=&v"(dst) : "v"(vb0), "i"(off) : "memory")
#define PV_D0(d0) do { s16x4 l0, l1, l2, l3, h0, h1, h2, h3; constexpr int b_ = VB * SHM_V + v_rd_off(d0, 0, 0); \
        TRRD(l0, b_); TRRD(h0, b_ + 2048); TRRD(l1, b_ + 4096); TRRD(h1, b_ + 6144); TRRD(l2, b_ + 8192); TRRD(h2, b_ + 10240); TRRD(l3, b_ + 12288); TRRD(h3, b_ + 14336); \
        asm volatile("s_waitcnt lgkmcnt(0)" ::: "memory"); SBAR();   \
        o[d0] = __builtin_amdgcn_mfma_f32_32x32x16_bf16(pa0, (bf16x8){l0[0], l0[1], l0[2], l0[3], h0[0], h0[1], h0[2], h0[3]}, o[d0], 0, 0, 0);   \
        o[d0] = __builtin_amdgcn_mfma_f32_32x32x16_bf16(pa1, (bf16x8){l1[0], l1[1], l1[2], l1[3], h1[0], h1[1], h1[2], h1[3]}, o[d0], 0, 0, 0);   \
        o[d0] = __builtin_amdgcn_mfma_f32_32x32x16_bf16(pa2, (bf16x8){l2[0], l2[1], l2[2], l2[3], h2[0], h2[1], h2[2], h2[3]}, o[d0], 0, 0, 0);   \
        o[d0] = __builtin_amdgcn_mfma_f32_32x32x16_bf16(pa3, (bf16x8){l3[0], l3[1], l3[2], l3[3], h3[0], h3[1], h3[2], h3[3]}, o[d0], 0, 0, 0); } while (0)
    PV_D0(0); PV_D0(1); PV_D0(2); PV_D0(3);
#undef PV_D0
#undef TRRD
}

struct BlockRef { int grp, b, h, qb; };
__device__ __forceinline__ size_t hm_off(const BlockRef& r) { return ((size_t)(r.b * NH + r.h) * SEQ) * D; }
__device__ __forceinline__ const bf16_t* ptrQ(unsigned char* wsb, const BlockRef& r) { return (const bf16_t*)(wsb + (r.grp ? WS_QB : WS_QA)) + hm_off(r) + (size_t)r.qb * QB * D; }
__device__ __forceinline__ const bf16_t* ptrK(unsigned char* wsb, const BlockRef& r) { return (const bf16_t*)(wsb + (r.grp ? WS_KB : WS_KA)) + hm_off(r); }
__device__ __forceinline__ const bf16_t* ptrV(unsigned char* wsb, const BlockRef& r) { return (const bf16_t*)(wsb + (r.grp ? WS_VB : WS_VA)) + hm_off(r); }
__device__ __forceinline__ const bf16_t* ptrZ(unsigned char* wsb, const BlockRef& r) { return (const bf16_t*)(wsb + (r.grp ? WS_SZB : WS_SZA)) + hm_off(r) + (size_t)r.qb * QB * D; }
struct Seam { bf16x8 qr[8]; bf16x8 st_v0, st_v1, st_k0, st_k1; };
#define ROW(p, k0, rr) ((const bf16_t*)((const char*)(p) + (unsigned)(((k0) + (rr)) * (D * 2) + sc * 2)))
#define VMW() asm volatile("s_waitcnt vmcnt(0)" ::: "memory")
#define VMWN(n) asm volatile("s_waitcnt vmcnt(%0)" :: "i"(n) : "memory")
#define SLOAD_H(Kp, Vp, k0) do { S.st_v0 = load8(ROW(Vp, k0, sr)); S.st_v1 = load8(ROW(Vp, k0, 32 + sr));              \
                         S.st_k0 = load8(ROW(Kp, k0, sr)); S.st_k1 = load8(ROW(Kp, k0, 32 + sr)); } while (0)
#define SWRITE_HK(bf) do { *(bf16x8*)(K_lds + (bf) * SHM_K + kws) = S.st_k0; *(bf16x8*)(K_lds + (bf) * SHM_K + kws + 32 * 256) = S.st_k1; } while (0)
#define SWRITE_HV(bf) do { *(bf16x8*)(V_lds + (bf) * SHM_V + vst0) = S.st_v0; *(bf16x8*)(V_lds + (bf) * SHM_V + vst1) = S.st_v1; } while (0)
#define SWRITE_H(bf) do { SWRITE_HV(bf); SWRITE_HK(bf); } while (0)
__device__ __forceinline__ void prime(const BlockRef& cur, unsigned char* wsb, char* lds, Seam& S) {
    const int tid = threadIdx.x, wid = __builtin_amdgcn_readfirstlane(tid >> 6), lane = tid & 63, r32 = lane & 31, hi = lane >> 5;
    const int sr = tid >> 4, sc = (tid & 15) * 8, kws = KSWZ(sr, sc * 2); char* K_lds = lds + 2 * SHM_V;
    const bf16_t* Qp = ptrQ(wsb, cur); const bf16_t* Kp = ptrK(wsb, cur); const bf16_t* Vp = ptrV(wsb, cur);
    for (int d0 = 0; d0 < 8; ++d0) S.qr[d0] = load8(Qp + (size_t)(wid * QBLK + r32) * D + d0 * 16 + hi * 8);
    SLOAD_H(Kp, Vp, 0); VMW(); SWRITE_HK(0);
    __syncthreads();
}
__device__ __forceinline__ void block(const BlockRef& cur, unsigned char* wsb, char* lds, Seam& S) {
    const int GRP = cur.grp;
    const int tid = threadIdx.x, wid = __builtin_amdgcn_readfirstlane(tid >> 6), lane = tid & 63, r32 = lane & 31, hi = lane >> 5;
    const int NT = 4 * cur.qb + 4;
    const int qlo = cur.qb * QB + wid * QBLK, qm = qlo + r32 - 4 * hi;
    char* V_lds = lds; char* K_lds = lds + 2 * SHM_V;
    float* ws = (float*)(lds + LDS_WS) + wid * 64; float* li_l = ws, * al_l = ws + 32;
    float m_reg = -1e30f, l_reg = 0; f32x16 o[4] = {};
    const int sr = tid >> 4, sc = (tid & 15) * 8, vst0 = v_st(sr, sc), vst1 = v_st(32 + sr, sc), kws = KSWZ(sr, sc * 2);
    const int vb0 = (int)(uintptr_t)V_lds + v_rd_base(lane);
    const bf16_t* Kh = ptrK(wsb, cur); const bf16_t* Vh = ptrV(wsb, cur);
    const float sl = exp2f(-(float)(cur.h + 1)) * 11.313708498984761f;
    unsigned selbits = 0xffu;
    if (GRP == 1) {
        float* km = (float*)(lds + LDS_KM);
        const float* KM = (const float*)(wsb + WS_KMEAN) + ((size_t)(cur.b * NBLK) * NH + cur.h) * 128;
        if (tid < cur.qb * 32) { const int n = tid >> 5, c4 = (tid & 31) * 4; *(f32x4*)(km + n * 128 + c4) = *(const f32x4*)(KM + (size_t)n * (NH * 128) + c4); }
        __syncthreads();
        float v1 = -__builtin_inff(), v2 = v1, v3 = v1; int i1 = 31, i2 = 31, i3 = 31;
#pragma unroll 1
        for (int n = 0; n < cur.qb; ++n) { float a = 0.f;
#pragma unroll
            for (int d0 = 0; d0 < 8; ++d0) { const f32x4 k0 = *(const f32x4*)(km + n * 128 + d0 * 16 + hi * 8), k1 = *(const f32x4*)(km + n * 128 + d0 * 16 + hi * 8 + 4);
                const bf16x8 q = S.qr[d0];
                a += bf2f((bf16_t)q[0]) * k0[0] + bf2f((bf16_t)q[1]) * k0[1] + bf2f((bf16_t)q[2]) * k0[2] + bf2f((bf16_t)q[3]) * k0[3]
                   + bf2f((bf16_t)q[4]) * k1[0] + bf2f((bf16_t)q[5]) * k1[1] + bf2f((bf16_t)q[6]) * k1[2] + bf2f((bf16_t)q[7]) * k1[3]; }
            const float other = __shfl_xor(a, 32); const float g = a + other;
            const bool c1 = g > v1, c2 = g > v2, c3 = g > v3;
            v3 = c2 ? v2 : (c3 ? g : v3); i3 = c2 ? i2 : (c3 ? n : i3);
            v2 = c1 ? v1 : (c2 ? g : v2); i2 = c1 ? i1 : (c2 ? n : i2);
            v1 = c1 ? g : v1;             i1 = c1 ? n : i1; }
        selbits = ((1u << i1) | (1u << i2) | (1u << i3)) & 0xffu;
    }
    const char* mst = lds + LDS_OST + wid * MST_WAVE + r32 * MST_PITCH;
    if (GRP == 0) {
        const char* src = (const char*)(wsb + WS_MASK) + ((size_t)cur.b * SEQ + qlo) * 256 + (unsigned)(r32 * 256 + hi * 128);
        u32x4 tmp[8];
#pragma unroll
        for (int i = 0; i < 8; ++i) tmp[i] = *(const u32x4*)(src + 16 * i);
#pragma unroll
        for (int i = 0; i < 8; ++i) { unsigned long long* d = (unsigned long long*)(mst + hi * 128 + 16 * i);
            d[0] = (unsigned long long)tmp[i][0] | ((unsigned long long)tmp[i][1] << 32); d[1] = (unsigned long long)tmp[i][2] | ((unsigned long long)tmp[i][3] << 32); }
    }
#define RESC(a) do { if (__any((a) < 1.f)) { if (hi == 0) al_l[r32] = (a); asm volatile("s_waitcnt lgkmcnt(0)" ::: "memory");              \
                     for (int d_ = 0; d_ < 4; ++d_) for (int r = 0; r < 16; ++r) o[d_][r] *= al_l[crow(r, hi)]; } } while (0)
#define KBASE(t) ((t) * KVBLK)
#define CB(t) ((GRP == 1 && (t) < 4 * cur.qb && !((selbits >> ((t) >> 2)) & 1u)) ? -__builtin_inff() : sl * (float)(KBASE(t) - qm))
#define MLOAD(t) ((GRP == 0) ? *(const unsigned long long*)(mst + (t) * 8) : 0ull)
#define MASKT(P0_, P1_, t, mw) do { const int kb_ = KBASE(t); \
        if (GRP == 0) { mask_bits(P0_, P1_, ((unsigned)(mw)) >> (4 * hi), ((unsigned)((mw) >> 32)) >> (4 * hi)); } \
        else if (kb_ + KVBLK - 1 > qlo) mask_causal(P0_, P1_, qm - kb_); } while (0)
    f32x16 pA0, pA1, pB0, pB1; float mnA, mnB, alA, alB; bf16x8 pa0, pa1, pa2, pa3;
    unsigned long long mwA, mwB;
    SWRITE_HV(0); SBAR();
    if (NT > 1) SLOAD_H(Kh, Vh, KBASE(1));
    mwA = MLOAD(0);
    SBAR(); qkt<0>(pA0, pA1, K_lds, r32, hi, S.qr, CB(0), sl);
    MASKT(pA0, pA1, 0, mwA); partialSM(pA0, pA1, m_reg, mnA, alA);
    if (NT > 1) { VMW(); SWRITE_H(1); }
    __syncthreads();
#define HALF_STEP(PX0, PX1, mnX, alX, mwX, PY0, PY1, alY, t, KB, VB, SB) do {                                                 \
        SBAR(); qkt<KB>(PX0, PX1, K_lds, r32, hi, S.qr, CB(t), sl);                                                           \
        finishSM(PY0, PY1, alY, l_reg, pa0, pa1, pa2, pa3); SBAR();                                                           \
        if ((t) + 1 < NT) { SLOAD_H(Kh, Vh, KBASE((t) + 1)); SBAR(); }                                                        \
        mwX = MLOAD(t); pv_tile<VB>(o, vb0, pa0, pa1, pa2, pa3); MASKT(PX0, PX1, (t), mwX); partialSM(PX0, PX1, m_reg, mnX, alX);             \
        __syncthreads();                                                                                                      \
        if ((t) + 1 < NT) { VMW(); SWRITE_H(SB); }                                                                            \
        RESC(alX); __syncthreads(); } while (0)
    for (int t = 1; t + 1 < NT; t += 2) {
        HALF_STEP(pB0, pB1, mnB, alB, mwB, pA0, pA1, alA, t, 1, 0, 0);
        HALF_STEP(pA0, pA1, mnA, alA, mwA, pB0, pB1, alB, t + 1, 0, 1, 1);
    }
    SBAR(); qkt<1>(pB0, pB1, K_lds, r32, hi, S.qr, CB(NT - 1), sl); SBAR();
    mwB = MLOAD(NT - 1);
    finishSM(pA0, pA1, alA, l_reg, pa0, pa1, pa2, pa3); SBAR();
    pv_tile<0>(o, vb0, pa0, pa1, pa2, pa3);
    MASKT(pB0, pB1, NT - 1, mwB); partialSM(pB0, pB1, m_reg, mnB, alB); __syncthreads(); RESC(alB);
    finishSM(pB0, pB1, alB, l_reg, pa0, pa1, pa2, pa3); SBAR(); pv_tile<1>(o, vb0, pa0, pa1, pa2, pa3);
    if (hi == 0) li_l[r32] = l_reg; asm volatile("s_waitcnt lgkmcnt(0)" ::: "memory");
    float rli[16];
#pragma unroll
    for (int r = 0; r < 16; ++r) rli[r] = __builtin_amdgcn_rcpf(li_l[crow(r, hi)]);
    { bf16_t* stg = (bf16_t*)(lds + LDS_OST) + wid * (QBLK * D);
      int lane_e = lane; asm volatile("" : "+v"(lane_e));
      bf16_t* stw = stg + (4 * (lane_e >> 5)) * D + (lane_e & 31);
#pragma unroll
      for (int r = 0; r < 16; ++r) { const int orow = (r & 3) + 8 * (r >> 2);
#pragma unroll
          for (int d0 = 0; d0 < 4; ++d0) stw[orow * D + d0 * 32] = (bf16_t)cvt1(o[d0][r] * rli[r]); }
      asm volatile("s_waitcnt lgkmcnt(0)" ::: "memory");
      char* Ow = (char*)(wsb + WS_Y8) + ((size_t)cur.b * SEQ + qlo) * 2048 + cur.grp * 1024 + cur.h * 128;
      const char* Zw = (const char*)(ptrZ(wsb, cur) + (size_t)(wid * QBLK) * D);
      const unsigned eo = (unsigned)((lane_e >> 4) * 256 + (lane_e & 15) * 16), yo = (unsigned)((lane_e >> 4) * 2048 + (lane_e & 15) * 8);
#pragma unroll
      for (int i = 0; i < 8; ++i) {
          const u32x4 ov = *(const u32x4*)((const char*)stg + (eo + (unsigned)(i * 1024))), zv = *(const u32x4*)(Zw + (eo + (unsigned)(i * 1024))); float f[8];
#pragma unroll
          for (int j = 0; j < 4; ++j) { f[2 * j] = __uint_as_float(ov[j] << 16) * __uint_as_float(zv[j] << 16) * 8.f; f[2 * j + 1] = __uint_as_float(ov[j] & 0xffff0000u) * __uint_as_float(zv[j] & 0xffff0000u) * 8.f; }
          const unsigned long long w = (unsigned long long)pk4_fp8(f[0], f[1], f[2], f[3]) | ((unsigned long long)pk4_fp8(f[4], f[5], f[6], f[7]) << 32);
          *(unsigned long long*)(Ow + (yo + (unsigned)(i * 8192))) = w; } }
    __syncthreads();
#undef RESC
#undef KBASE
#undef CB
#undef MLOAD
#undef MASKT
#undef HALF_STEP
}
#undef ROW
#undef VMW
#undef VMWN
#undef SLOAD_H
#undef SWRITE_HK
#undef SWRITE_HV
#undef SWRITE_H
__device__ __forceinline__ bool decode(int v, int G, int i, BlockRef& r) {
    const int L = v + (i >> 1) * G; if (L >= 512) return false;
    const int x = L & 3, k = L >> 5;
    r.h = (L >> 2) & 7; r.b = k & 7; r.grp = ((k & 1) ^ (k >> 3)) & 1; r.qb = (i & 1) ? 7 - x : x;
    return true;
}
__device__ __forceinline__ void attn_phase(char* lds, unsigned char* wsb, int v, int G) {
    BlockRef cur, nxt;
    if (!decode(v, G, 0, cur)) return;
    Seam S;
    prime(cur, wsb, lds, S);
    for (int i = 0;; ++i) {
        const bool more = decode(v, G, i + 1, nxt);
        if (!more) nxt = cur;
        block(cur, wsb, lds, S);
        if (!more) break;
        prime(nxt, wsb, lds, S);
        cur = nxt;
    }
}
#undef KSWZ
#undef SBAR
}

namespace sel {
#define SLAS __attribute__((address_space(3)))
typedef short bf16x8 __attribute__((ext_vector_type(8)));
typedef float f32x16 __attribute__((ext_vector_type(16)));
typedef float f32x4 __attribute__((ext_vector_type(4)));
typedef unsigned u32x4 __attribute__((ext_vector_type(4)));
constexpr int KB_OFF = 131072;
constexpr int LIST_OFF = 147456 + 2048;
__device__ __forceinline__ unsigned fkey(float x) { const unsigned b = __float_as_uint(x); return (b & 0x80000000u) ? ~b : (b | 0x80000000u); }
__device__ __forceinline__ void unit(SLAS unsigned char* lds, unsigned char* wsb, int b, int rg) {
    const int tid = threadIdx.x, wid = __builtin_amdgcn_readfirstlane(tid >> 6), lane = tid & 63, j = lane & 31, g = lane >> 5;
    const bf16_t* QI = (const bf16_t*)(wsb + WS_QI); const char* KIb = (const char*)((const bf16_t*)(wsb + WS_KI) + (size_t)b * SEQ * 64); const float* WI = (const float*)(wsb + WS_WI);
    unsigned long long* MASK = (unsigned long long*)(wsb + WS_MASK);
    const int ta = 16 * rg + 2 * wid, t = ta + g;
    const int nkeys = 16 * rg + 16, nk32 = (nkeys + 31) >> 5, nch = (nkeys + 63) >> 6;
    SLAS float* sc = (SLAS float*)lds + (wid * 2 + g) * 2048 + j;
    float vmin = __builtin_inff(), vmax = -__builtin_inff();
    bf16x8 af[4];
    { const int i = lane & 31, tok = (i >> 2) & 1, head = (i & 3) + 4 * (i >> 3);
      const bf16_t* qp = QI + ((size_t)b * SEQ + ta + tok) * 1024 + head * 64 + 8 * (lane >> 5);
#pragma unroll
      for (int ks = 0; ks < 4; ++ks) af[ks] = *(const bf16x8*)(qp + 16 * ks); }
    float wv[16];
    { const float* wp = WI + ((size_t)b * SEQ + t) * 16;
#pragma unroll
      for (int q4 = 0; q4 < 4; ++q4) { const f32x4 w4 = *(const f32x4*)(wp + 4 * q4); wv[4 * q4] = w4[0] * 0.03125f; wv[4 * q4 + 1] = w4[1] * 0.03125f; wv[4 * q4 + 2] = w4[2] * 0.03125f; wv[4 * q4 + 3] = w4[3] * 0.03125f; } }
    const int srow = tid >> 3, scol = tid & 7, swr = srow * 128 + ((scol ^ ((srow >> 1) & 7)) << 4);
    int koff[4];
#pragma unroll
    for (int ks = 0; ks < 4; ++ks) koff[ks] = j * 128 + (((2 * ks + g) ^ ((j >> 1) & 7)) << 4);
    u32x4 stA = *(const u32x4*)(KIb + (unsigned)(tid * 16)), stB = stA;
    *(SLAS u32x4*)(lds + KB_OFF + swr) = stA;
    stA = *(const u32x4*)(KIb + (unsigned)(min(1, nch - 1) * 8192 + tid * 16));
    stB = *(const u32x4*)(KIb + (unsigned)(min(2, nch - 1) * 8192 + tid * 16));
    __syncthreads();
#define SEL_EPI(ACC, kt) do { float s0 = 0.f, s1 = 0.f, s2 = 0.f, s3 = 0.f; \
        _Pragma("unroll") for (int r = 0; r < 4; ++r) { s0 = fmaf(wv[r], fmaxf(ACC[r], 0.f), s0); s1 = fmaf(wv[4 + r], fmaxf(ACC[4 + r], 0.f), s1); \
                                                       s2 = fmaf(wv[8 + r], fmaxf(ACC[8 + r], 0.f), s2); s3 = fmaf(wv[12 + r], fmaxf(ACC[12 + r], 0.f), s3); } \
        const float s = (s0 + s1) + (s2 + s3); \
        if (32 * (kt) + j <= t) { vmin = fminf(vmin, s); vmax = fmaxf(vmax, s); }     \
        sc[32 * (kt)] = s; } while (0)
#define SEL_TILES(cc) do { SLAS unsigned char* kb = lds + KB_OFF + ((cc) & 1) * 8192; const int kt0 = 2 * (cc); \
        if (kt0 + 1 < nk32) {                                  \
            f32x16 acc0 = {}, acc1 = {}; \
            _Pragma("unroll") for (int ks = 0; ks < 4; ++ks) { const bf16x8 b0 = *(const SLAS bf16x8*)(kb + koff[ks]), b1 = *(const SLAS bf16x8*)(kb + 4096 + koff[ks]); \
                acc0 = __builtin_amdgcn_mfma_f32_32x32x16_bf16(af[ks], b0, acc0, 0, 0, 0); acc1 = __builtin_amdgcn_mfma_f32_32x32x16_bf16(af[ks], b1, acc1, 0, 0, 0); } \
            SEL_EPI(acc0, kt0); SEL_EPI(acc1, kt0 + 1); \
        } else if (kt0 < nk32) { f32x16 acc0 = {}; \
            _Pragma("unroll") for (int ks = 0; ks < 4; ++ks) { const bf16x8 b0 = *(const SLAS bf16x8*)(kb + koff[ks]); acc0 = __builtin_amdgcn_mfma_f32_32x32x16_bf16(af[ks], b0, acc0, 0, 0, 0); } \
            SEL_EPI(acc0, kt0); } } while (0)
#pragma unroll 1
    for (int c = 0; c < nch; c += 2) {
        SEL_TILES(c);
        *(SLAS u32x4*)(lds + KB_OFF + 8192 + swr) = stA; stA = *(const u32x4*)(KIb + (unsigned)(min(c + 3, nch - 1) * 8192 + tid * 16));
        __syncthreads();
        SEL_TILES(c + 1);
        *(SLAS u32x4*)(lds + KB_OFF + swr) = stB; stB = *(const u32x4*)(KIb + (unsigned)(min(c + 4, nch - 1) * 8192 + tid * 16));
        __syncthreads();
    }
#undef SEL_TILES
#undef SEL_EPI
    unsigned T = 0u; int need = 0; bool ties = false;
    if (16 * rg >= TOPK) {
        SLAS unsigned* hist = (SLAS unsigned*)(lds + KB_OFF) + (wid * 2 + g) * 256;
#pragma unroll
        for (int off = 1; off < 32; off <<= 1) { vmin = fminf(vmin, __shfl_xor(vmin, off)); vmax = fmaxf(vmax, __shfl_xor(vmax, off)); }
        const float range = vmax - vmin, inv = (range > 0.f) ? 255.99f / range : 0.f;
        *(SLAS u32x4*)(hist + 8 * j) = (u32x4){0u, 0u, 0u, 0u}; *(SLAS u32x4*)(hist + 8 * j + 4) = (u32x4){0u, 0u, 0u, 0u};
#pragma unroll 1
        for (int kt0 = 0; kt0 < nk32; kt0 += 4) { float x[4];
#pragma unroll
            for (int i = 0; i < 4; ++i) x[i] = sc[32 * (kt0 + i)];
#pragma unroll
            for (int i = 0; i < 4; ++i) if (32 * (kt0 + i) + j <= t) { const int q = min((int)((x[i] - vmin) * inv), 255); __hip_atomic_fetch_add(hist + q, 1u, __ATOMIC_RELAXED, __HIP_MEMORY_SCOPE_WORKGROUP); } }
        asm volatile("s_waitcnt lgkmcnt(0)" ::: "memory");
        int qsel, cB;
        { const u32x4 c0 = *(const SLAS u32x4*)(hist + 8 * j), c1 = *(const SLAS u32x4*)(hist + 8 * j + 4);
          const int cnt[8] = {(int)c0[0], (int)c0[1], (int)c0[2], (int)c0[3], (int)c1[0], (int)c1[1], (int)c1[2], (int)c1[3]};
          const int s = ((cnt[0] + cnt[1]) + (cnt[2] + cnt[3])) + ((cnt[4] + cnt[5]) + (cnt[6] + cnt[7]));
          int S = s;
#pragma unroll
          for (int off = 1; off < 32; off <<= 1) { const int v = __shfl_down(S, off, 32); if (j + off < 32) S += v; }
          const int above = S - s;
          const bool found = (S >= TOPK) && (above < TOPK);
          int dsel = 0, nneed = 0, csel = 0;
          { const int rem = TOPK - above; int cum = 0; bool done = false;
#pragma unroll
            for (int i = 7; i >= 0; --i) { const int before = cum; cum += cnt[i]; if (!done && cum >= rem) { done = true; dsel = 8 * j + i; nneed = rem - before; csel = cnt[i]; } } }
          const unsigned long long bm = __ballot(found);
          const int src = 32 * g + __builtin_ctz((unsigned)(bm >> (32 * g)) | 0x80000000u);
          qsel = __shfl(dsel, src); need = __shfl(nneed, src); cB = __shfl(csel, src); }
        if (!__any(cB > 64)) {
            SLAS unsigned* list = (SLAS unsigned*)(lds + LIST_OFF) + (wid * 2 + g) * 128;
            int base = 0;
#pragma unroll 1
            for (int kt0 = 0; kt0 < nk32; kt0 += 4) { float x[4];
#pragma unroll
                for (int i = 0; i < 4; ++i) x[i] = sc[32 * (kt0 + i)];
#pragma unroll
                for (int i = 0; i < 4; ++i) { const int kt = kt0 + i;
                    const bool m = (32 * kt + j <= t) && (min((int)((x[i] - vmin) * inv), 255) == qsel);
                    const unsigned long long bal = __ballot(m); const unsigned hm = g ? (unsigned)(bal >> 32) : (unsigned)bal;
                    if (m) { const int pos = base + __builtin_popcount(hm & ((1u << j) - 1u)); list[2 * pos] = fkey(x[i]); list[2 * pos + 1] = (unsigned)(32 * kt + j); }
                    base += __builtin_popcount(hm); } }
            asm volatile("s_waitcnt lgkmcnt(0)" ::: "memory");
            const unsigned u0 = list[2 * j], i0 = list[2 * j + 1], u1 = list[2 * (j + 32)], i1 = list[2 * (j + 32) + 1];
            int r0 = 0, r1 = 0; const int cmax = max(cB, __shfl_xor(cB, 32));
#pragma unroll 1
            for (int e = 0; e < cmax; ++e) { const unsigned ue = list[2 * e], ie = list[2 * e + 1]; const bool in = e < cB;
                r0 += (in && (ue > u0 || (ue == u0 && ie < i0))) ? 1 : 0; r1 += (in && (ue > u1 || (ue == u1 && ie < i1))) ? 1 : 0; }
            const bool h0 = (j < cB) && (r0 == need - 1), h1 = (j + 32 < cB) && (r1 == need - 1);
            const unsigned long long bh = __ballot(h0 || h1);
            const int src = 32 * g + __builtin_ctz((unsigned)(bh >> (32 * g)) | 0x80000000u);
            T = __shfl(h0 ? u0 : u1, src);
            const unsigned long long bg0 = __ballot(j < cB && u0 > T), bg1 = __ballot(j + 32 < cB && u1 > T), be0 = __ballot(j < cB && u0 == T), be1 = __ballot(j + 32 < cB && u1 == T);
            const int ngt = __builtin_popcount(g ? (unsigned)(bg0 >> 32) : (unsigned)bg0) + __builtin_popcount(g ? (unsigned)(bg1 >> 32) : (unsigned)bg1);
            const int neq = __builtin_popcount(g ? (unsigned)(be0 >> 32) : (unsigned)be0) + __builtin_popcount(g ? (unsigned)(be1 >> 32) : (unsigned)be1);
            need = need - ngt; ties = (neq != need);
        } else {
            unsigned prefix = 0u; need = TOPK; int ceq = 0;
#pragma unroll 1
            for (int p = 0; p < 4; ++p) { const int shift = 24 - 8 * p;
                *(SLAS u32x4*)(hist + 8 * j) = (u32x4){0u, 0u, 0u, 0u}; *(SLAS u32x4*)(hist + 8 * j + 4) = (u32x4){0u, 0u, 0u, 0u};
                const unsigned phi = prefix >> ((shift + 8) & 31);
#pragma unroll 1
                for (int kt = 0; kt < nk32; ++kt) { const unsigned x = fkey(sc[32 * kt]);
                    const bool match = (32 * kt + j <= t) && ((p == 0) || ((x >> ((shift + 8) & 31)) == phi));
                    if (match) __hip_atomic_fetch_add(hist + ((x >> shift) & 255u), 1u, __ATOMIC_RELAXED, __HIP_MEMORY_SCOPE_WORKGROUP); }
                asm volatile("s_waitcnt lgkmcnt(0)" ::: "memory");
                const u32x4 c0 = *(const SLAS u32x4*)(hist + 8 * j), c1 = *(const SLAS u32x4*)(hist + 8 * j + 4);
                const int cnt[8] = {(int)c0[0], (int)c0[1], (int)c0[2], (int)c0[3], (int)c1[0], (int)c1[1], (int)c1[2], (int)c1[3]};
                const int s = ((cnt[0] + cnt[1]) + (cnt[2] + cnt[3])) + ((cnt[4] + cnt[5]) + (cnt[6] + cnt[7]));
                int S = s;
#pragma unroll
                for (int off = 1; off < 32; off <<= 1) { const int v = __shfl_down(S, off, 32); if (j + off < 32) S += v; }
                const int above = S - s;
                const bool found = (S >= need) && (above < need);
                int dsel = 0, nneed = 0, csel = 0;
                { const int rem = need - above; int cum = 0; bool done = false;
#pragma unroll
                  for (int i = 7; i >= 0; --i) { const int before = cum; cum += cnt[i]; if (!done && cum >= rem) { done = true; dsel = 8 * j + i; nneed = rem - before; csel = cnt[i]; } } }
                const unsigned long long bm = __ballot(found);
                const int src = 32 * g + __builtin_ctz((unsigned)(bm >> (32 * g)) | 0x80000000u);
                const int digit = __shfl(dsel, src); need = __shfl(nneed, src); ceq = __shfl(csel, src);
                prefix |= (unsigned)digit << shift;
            }
            T = prefix; ties = (ceq != need);
        }
    }
    unsigned wlo = 0u, whi = 0u;
    if (!__any(ties)) {
#pragma unroll 4
        for (int k64 = 0; k64 < 32; ++k64) {
            const bool s0 = (64 * k64 + j <= t) && (fkey(sc[64 * k64]) >= T), s1 = (64 * k64 + 32 + j <= t) && (fkey(sc[64 * k64 + 32]) >= T);
            const unsigned long long b0 = __ballot(s0), b1 = __ballot(s1);
            const unsigned lo = g ? (unsigned)(b0 >> 32) : (unsigned)b0, hi = g ? (unsigned)(b1 >> 32) : (unsigned)b1;
            if (j == k64) { wlo = lo; whi = hi; } }
    } else {
        int base = 0;
#pragma unroll 1
        for (int k64 = 0; k64 < 32; ++k64) { unsigned lo = 0u, hi = 0u;
#pragma unroll
            for (int hh = 0; hh < 2; ++hh) { const bool vld = (64 * k64 + 32 * hh + j <= t); const unsigned x = vld ? fkey(sc[64 * k64 + 32 * hh]) : 0u;
                const unsigned long long be = __ballot(vld && x == T); const unsigned em = g ? (unsigned)(be >> 32) : (unsigned)be;
                const int rank = base + __builtin_popcount(em & ((1u << j) - 1u));
                const bool s1 = vld && ((x > T) || (x == T && rank < need));
                base += __builtin_popcount(em);
                const unsigned long long bs = __ballot(s1); const unsigned sm = g ? (unsigned)(bs >> 32) : (unsigned)bs;
                if (hh == 0) lo = sm; else hi = sm; }
            if (j == k64) { wlo = lo; whi = hi; } }
    }
    MASK[((size_t)b * SEQ + t) * 32 + j] = (unsigned long long)wlo | ((unsigned long long)whi << 32);
    __syncthreads();
}
__device__ __forceinline__ void kmean_unit(SLAS unsigned char* lds, unsigned char* wsb, int b, int n, int h) {
    const int tid = threadIdx.x, d4 = tid & 31, rs = tid >> 5;
    const bf16_t* KB = (const bf16_t*)(wsb + WS_KB) + (((size_t)(b * NH + h) * SEQ) + n * 256) * 128;
    float a0 = 0.f, a1 = 0.f, a2 = 0.f, a3 = 0.f;
#pragma unroll 4
    for (int r = 0; r < 16; ++r) { const unsigned long long v = *(const unsigned long long*)(KB + (size_t)(rs * 16 + r) * 128 + d4 * 4);
        const unsigned lo = (unsigned)v, hi = (unsigned)(v >> 32);
        a0 += __uint_as_float(lo << 16); a1 += __uint_as_float(lo & 0xffff0000u); a2 += __uint_as_float(hi << 16); a3 += __uint_as_float(hi & 0xffff0000u); }
    SLAS float* red = (SLAS float*)lds;
    *(SLAS f32x4*)(red + rs * 128 + d4 * 4) = (f32x4){a0, a1, a2, a3};
    __syncthreads();
    if (tid < 128) { float s = 0.f;
#pragma unroll
        for (int q = 0; q < 16; ++q) s += red[q * 128 + tid];
        ((float*)(wsb + WS_KMEAN))[((size_t)(b * NBLK + n) * NH + h) * 128 + tid] = s * (1.f / 256.f); }
    __syncthreads();
}
__device__ __forceinline__ void select_phase(SLAS unsigned char* lds, unsigned char* wsb, int v, int G) {
    for (int L = v; L < 512; L += G) kmean_unit(lds, wsb, L >> 6, (L >> 3) & 7, L & 7);
    for (int L = v; L < 512; L += G) { const int b = L >> 6, x = L & 63;
        unit(lds, wsb, b, x);
        unit(lds, wsb, b, 127 - x); }
}
#undef SLAS
}

struct Args { const float* in[12]; float* out; unsigned char* ws; int ph_lo, ph_hi, li, pad; };
__global__ void __launch_bounds__(NWAVES * 64, 2) mega_fwd(Args args) {
    extern __shared__ __attribute__((aligned(16))) unsigned char lds[];
    Frame F;
    F.lds = (LAS unsigned char*)lds; F.MISC = (volatile LAS unsigned*)(F.lds + MISC_OFF);
    F.tid = threadIdx.x; F.lane = F.tid & 63; F.wave = __builtin_amdgcn_readfirstlane(F.tid >> 6);
    F.G = gridDim.x; { const int bx = blockIdx.x; F.vcu = (F.G % 8 == 0) ? (bx % 8) * (F.G / 8) + bx / 8 : bx; }
    unsigned char* ws = args.ws;
    F.ctl = (gu32*)(ws + WS_CTL);
    const float* x = args.in[0]; const float* c = args.in[1]; const float* w_ada = args.in[2]; const float* b_ada = args.in[3]; const float* g_norm = args.in[4];
    const float* w_in = args.in[5]; const float* w_out = args.in[11];
    float* MOD = (float*)(ws + WS_MOD); bf16_t* WinT = (bf16_t*)(ws + WS_WIN); bf16_t* HB = (bf16_t*)(ws + WS_HB); bf16_t* Y = (bf16_t*)(ws + WS_Y);
    for (int u = F.tid; u < (LDS_BYTES - LDSCTL_OFF) / 4; u += NWAVES * 64) ((LAS unsigned*)(F.lds + LDSCTL_OFF))[u] = 0u;
    __syncthreads();
    XcdBarrier bar = xcd_barrier_post((unsigned*)(F.ctl + CW_BAR) + args.li * XCD_BAR_WORDS, F.MISC + 8);
    const int lo = args.ph_lo, hi = args.ph_hi;
#define IN(k) (lo <= (k) && (k) < hi)
#define BOTH(k) (IN(k) && IN((k) + 1))
    if (IN(0)) for (int rep_ = 0; rep_ < (((PROBE_DOUBLE) >> 0) & 1) + 1; ++rep_) {
        if (rep_) __syncthreads();
        for (int id = (int)blockIdx.x; id < 256; id += F.G) p0_mod(F, id, c, w_ada, (float*)(ws + WS_MODP));
        if ((int)blockIdx.x == 192) { float* G = (float*)(ws + WS_GAIN);
            if (F.tid < 128) { G[F.tid] = args.in[6][F.tid]; G[128 + F.tid] = args.in[7][F.tid]; G[256 + F.tid] = args.in[9][F.tid]; G[384 + F.tid] = args.in[10][F.tid]; }
            if (F.tid < 64) G[512 + F.tid] = args.in[8][F.tid]; }
        p0_convert(F, w_in, w_out, WinT, ws + WS_WIN8, ws + WS_WOUT8);
    }
    if (BOTH(0)) xcd_barrier(bar);
    if (IN(1)) for (int rep_ = 0; rep_ < (((PROBE_DOUBLE) >> 1) & 1) + 1; ++rep_) p1_norm(F, x, g_norm, (const float*)(ws + WS_MODP), b_ada, MOD, HB, ws + WS_HB8);
    if (BOTH(1)) xcd_barrier(bar);
    if (IN(2)) for (int rep_ = 0; rep_ < (((PROBE_DOUBLE) >> 2) & 1) + 1; ++rep_) {
        { pg8::Gemm g{ws + WS_HB8, ws + WS_WIN8, M, 28 * 256, DM}; pg8::StaticOrder S; S.init(M, 28 * 256, F.G, (int)blockIdx.x, 0, 16, 9);
          EpiProj E{ws, (LAS float*)(F.lds + EPI_OFF), FP8_DESCALE};
          pg8::gemm_phase<EpiProj, pg8::StaticOrder, true, true, true>(F.lds, g, S, E); }
        { pg8::Gemm g{HB, WinT, M, 9 * 256, DM}; pg8::StaticOrder S; S.init(M, 9 * 256, F.G, (int)blockIdx.x, 16);
          EpiProj E{ws, (LAS float*)(F.lds + EPI_OFF), 1.f};
          pg8::gemm_phase<EpiProj, pg8::StaticOrder, true, true, false>(F.lds, g, S, E); }
    }
    if (BOTH(2)) xcd_barrier(bar);
    if (IN(3)) for (int rep_ = 0; rep_ < (((PROBE_DOUBLE) >> 3) & 1) + 1; ++rep_) sel::select_phase(F.lds, ws, F.vcu, F.G);
    if (BOTH(3)) xcd_barrier(bar);
    if (IN(4)) {
#pragma unroll 1
        for (int rep_ = 0; rep_ < (((PROBE_DOUBLE) >> 4) & 1) + 1; ++rep_) att::attn_phase((char*)lds, ws, F.vcu, F.G);
    }
    if (BOTH(4)) xcd_barrier(bar);
    if (IN(5)) for (int rep_ = 0; rep_ < (((PROBE_DOUBLE) >> 5) & 1) + 1; ++rep_) {
        pg8::Gemm g{ws + WS_Y8, ws + WS_WOUT8, M, DM, DM}; pg8::StaticOrder S; S.init(M, DM, F.G, (int)blockIdx.x);
        EpiOut E{x, MOD, args.out, FP8_DESCALE};
        pg8::gemm_phase<EpiOut, pg8::StaticOrder, true, true, true>(F.lds, g, S, E);
    }
#undef IN
#undef BOTH
}

static int mega_setup() {
    static int grid = 0;
    if (grid == 0) {
        int dev = 0, cus = 0;
        if (hipGetDevice(&dev) != hipSuccess || hipDeviceGetAttribute(&cus, hipDeviceAttributeMultiprocessorCount, dev) != hipSuccess) { fprintf(stderr, "kernel_launch: device query failed\n"); grid = -1; return grid; }
        if (hipFuncSetAttribute((const void*)mega_fwd, hipFuncAttributeMaxDynamicSharedMemorySize, LDS_BYTES) != hipSuccess) { fprintf(stderr, "kernel_launch: hipFuncSetAttribute failed\n"); grid = -1; return grid; }
        (void)hipGetLastError();
        grid = cus;
    }
    return grid;
}
static void mega_launch(int grid, void* const* d_in, void* d_out, void* d_ws, int ph_lo, int ph_hi, int li, hipStream_t stream) {
    Args a{};
    for (int i = 0; i < 12; ++i) a.in[i] = (const float*)d_in[i];
    a.out = (float*)d_out; a.ws = (unsigned char*)d_ws; a.ph_lo = ph_lo; a.ph_hi = ph_hi; a.li = li;
    hipLaunchKernelGGL(mega_fwd, dim3(grid), dim3(NWAVES * 64), LDS_BYTES, stream, a);
}

extern "C" void kernel_launch(void* const* d_in, const int* in_sizes, int n_in, void* d_out, int out_size, void* d_ws, size_t ws_size, hipStream_t stream) {
    if (n_in != 12 || in_sizes[0] != M * DM || out_size != M * DM || ws_size < WS_END) {
        fprintf(stderr, "kernel_launch: unexpected shapes (n_in %d, in0 %d, out %d, ws %zu); nothing launched\n", n_in, n_in > 0 ? in_sizes[0] : -1, out_size, ws_size); return; }
    const int grid = mega_setup(); if (grid <= 0) return;
    char* ws = (char*)d_ws;
    bf16_t* QA = (bf16_t*)(ws + WS_QA); bf16_t* KA = (bf16_t*)(ws + WS_KA); bf16_t* VA = (bf16_t*)(ws + WS_VA); bf16_t* SZA = (bf16_t*)(ws + WS_SZA);
    bf16_t* QB = (bf16_t*)(ws + WS_QB); bf16_t* KB = (bf16_t*)(ws + WS_KB); bf16_t* VB = (bf16_t*)(ws + WS_VB); bf16_t* SZB = (bf16_t*)(ws + WS_SZB);
    bf16_t* QI = (bf16_t*)(ws + WS_QI); bf16_t* KI = (bf16_t*)(ws + WS_KI); float* WI = (float*)(ws + WS_WI); float* KMEAN = (float*)(ws + WS_KMEAN);
    unsigned long long* MASKT = (unsigned long long*)(ws + WS_MASK); bf16_t* Y = (bf16_t*)(ws + WS_Y);
    (void)hipMemsetAsync(ws + WS_CTL, 0, CTL_ZERO_BYTES, stream);
#if NAIVE_SEL
    mega_launch(grid, d_in, d_out, d_ws, 0, 3, 0, stream);
    k_kmean<<<BATCH * NBLK * NH, 128, 0, stream>>>(KB, KMEAN);
    (void)hipMemsetAsync(MASKT, 0, 4 * MiB, stream);
    k_dsa_select_naive<<<dim3(SEQ, BATCH), 256, 0, stream>>>(QI, KI, WI, MASKT);
    mega_launch(grid, d_in, d_out, d_ws, 4, 6, 1, stream);
#else
    mega_launch(grid, d_in, d_out, d_ws, 0, 6, 0, stream);
#if PROBE_EXTRA >= 0
    mega_launch(grid, d_in, d_out, d_ws, PROBE_EXTRA, PROBE_EXTRA + 1, 1, stream);
#endif
#endif
}
```

```cpp
#include <hip/hip_runtime.h>
#include <cstdio>
#include <cstdint>

typedef unsigned short bf16_t;
#ifndef NAIVE_SEL
#define NAIVE_SEL 0
#endif
#ifndef PROBE_SEL
#define PROBE_SEL 0
#endif
#ifndef PROBE_EXTRA
#define PROBE_EXTRA -1
#endif
#ifndef PROBE_DOUBLE
#define PROBE_DOUBLE 0
#endif
constexpr int BATCH = 8, SEQ = 2048, DM = 2048, M = BATCH * SEQ, NH = 8, HD = 128, DA = 1024, IH = 16, ID = 64, DIN = 9296;
constexpr int TOPK = 256, NBLK = 8;
constexpr float RMS_EPS = 1e-6f;
constexpr float QK_SCALE = 0.08838834764831845f;

__device__ __forceinline__ float bf2f(bf16_t v) { return __uint_as_float(((unsigned)v) << 16); }
__device__ __forceinline__ bf16_t f2bf(float f) { unsigned u = __float_as_uint(f); return (bf16_t)((u + 0x7fffu + ((u >> 16) & 1u)) >> 16); }
__device__ __forceinline__ float rbf(float f) { return bf2f(f2bf(f)); }
__device__ __forceinline__ float silu_f(float v) { return v / (1.f + __expf(-v)); }
__device__ __forceinline__ size_t HM(int b, int h, int t, int d) { return (((size_t)(b * NH + h) * SEQ + t) * HD + d); }
__device__ __forceinline__ float wave_sum(float v) {
#pragma unroll
    for (int o = 1; o < 64; o <<= 1) v += __shfl_xor(v, o);
    return v;
}
__device__ __forceinline__ float wave_max(float v) {
#pragma unroll
    for (int o = 1; o < 64; o <<= 1) v = fmaxf(v, __shfl_xor(v, o));
    return v;
}
__device__ __forceinline__ void mask_pos(int t, int s, size_t& word, int& bit) { word = (size_t)t * 32 + (s >> 6); bit = s & 63; }

__global__ void k_mod(const float* __restrict__ c, const float* __restrict__ w_ada, const float* __restrict__ b_ada, float* __restrict__ MOD) {
    __shared__ float sc[DM];
    const int b = blockIdx.y, n = blockIdx.x * 256 + threadIdx.x;
    for (int k = threadIdx.x; k < DM; k += 256) sc[k] = silu_f(c[b * DM + k]);
    __syncthreads();
    float acc = 0.f;
    for (int k = 0; k < DM; ++k) acc += sc[k] * w_ada[(size_t)k * (3 * DM) + n];
    MOD[b * 3 * DM + n] = acc + b_ada[n];
}
__global__ void k_norm(const float* __restrict__ x, const float* __restrict__ g, const float* __restrict__ MOD, bf16_t* __restrict__ HB) {
    const int lane = threadIdx.x & 63, row = blockIdx.x * 4 + (threadIdx.x >> 6), b = row / SEQ;
    const float* xr = x + (size_t)row * DM;
    float ss = 0.f;
    for (int k = lane; k < DM; k += 64) { const float v = xr[k]; ss += v * v; }
    ss = wave_sum(ss);
    const float rstd = rsqrtf(ss / DM + RMS_EPS);
    const float* shift = MOD + b * 3 * DM; const float* scale = shift + DM;
    for (int k = lane; k < DM; k += 64) HB[(size_t)row * DM + k] = f2bf(xr[k] * rstd * g[k] * (1.f + scale[k]) + shift[k]);
}
template <int MODE>
__global__ void k_gemm_naive(const bf16_t* __restrict__ A, int K, const float* __restrict__ W, int ldw, int n0, int ncols,
                             float* __restrict__ C, int ldc, const float* __restrict__ xres, const float* __restrict__ MOD) {
    __shared__ float As[16][65], Bs[16][65];
    const int tid = threadIdx.x, tx = tid & 15, ty = tid >> 4, m0 = blockIdx.y * 64, c0 = blockIdx.x * 64;
    float acc[4][4] = {};
    for (int k0 = 0; k0 < K; k0 += 16) {
        for (int i = tid; i < 1024; i += 256) { const int r = i >> 4, kk = i & 15; As[kk][r] = bf2f(A[(size_t)(m0 + r) * K + k0 + kk]); }
        for (int i = tid; i < 1024; i += 256) { const int kk = i >> 6, cc = i & 63; Bs[kk][cc] = (c0 + cc < ncols) ? rbf(W[(size_t)(k0 + kk) * ldw + n0 + c0 + cc]) : 0.f; }
        __syncthreads();
#pragma unroll
        for (int kk = 0; kk < 16; ++kk) {
            float a[4], bb[4];
#pragma unroll
            for (int i = 0; i < 4; ++i) { a[i] = As[kk][ty * 4 + i]; bb[i] = Bs[kk][tx * 4 + i]; }
#pragma unroll
            for (int i = 0; i < 4; ++i)
#pragma unroll
                for (int j = 0; j < 4; ++j) acc[i][j] += a[i] * bb[j];
        }
        __syncthreads();
    }
#pragma unroll
    for (int i = 0; i < 4; ++i)
#pragma unroll
        for (int j = 0; j < 4; ++j) {
            const int m = m0 + ty * 4 + i, cc = c0 + tx * 4 + j;
            if (cc < ncols) {
                if (MODE == 0) C[(size_t)m * ldc + cc] = acc[i][j];
                else { const int b = m / SEQ; C[(size_t)m * ldc + cc] = xres[(size_t)m * ldc + cc] + MOD[b * 3 * DM + 2 * DM + cc] * acc[i][j]; }
            }
        }
}
__global__ void k_post(const float* __restrict__ T32, const float* __restrict__ gain, bf16_t* __restrict__ dst, int mode) {
    const int lane = threadIdx.x & 63, item = blockIdx.x * 4 + (threadIdx.x >> 6), m = item >> 3, h = item & 7, b = m / SEQ, t = m % SEQ;
    const float* src = T32 + (size_t)m * 1024 + h * 128;
    float v0 = src[lane], v1 = src[lane + 64];
    if (mode == 0) { const float ss = wave_sum(v0 * v0 + v1 * v1); const float rstd = rsqrtf(ss / 128.f + RMS_EPS); v0 = v0 * rstd * gain[lane]; v1 = v1 * rstd * gain[lane + 64]; }
    if (mode == 2) { v0 = silu_f(v0); v1 = silu_f(v1); }
    if (mode == 3) { dst[(size_t)m * 1024 + h * 128 + lane] = f2bf(v0); dst[(size_t)m * 1024 + h * 128 + lane + 64] = f2bf(v1); }
    else { dst[HM(b, h, t, lane)] = f2bf(v0); dst[HM(b, h, t, lane + 64)] = f2bf(v1); }
}
__global__ void k_post_idx(const float* __restrict__ T32, const float* __restrict__ gain, bf16_t* __restrict__ KI, float* __restrict__ WI) {
    const int lane = threadIdx.x & 63, m = blockIdx.x * 4 + (threadIdx.x >> 6);
    const float v = T32[(size_t)m * 80 + lane];
    const float ss = wave_sum(v * v); const float rstd = rsqrtf(ss / 64.f + RMS_EPS);
    KI[(size_t)m * 64 + lane] = f2bf(v * rstd * gain[lane]);
    if (lane < 16) WI[(size_t)m * 16 + lane] = T32[(size_t)m * 80 + 64 + lane];
}
__global__ void k_kmean(const bf16_t* __restrict__ KB, float* __restrict__ KMEAN) {
    const int d = threadIdx.x, h = blockIdx.x & 7, n = (blockIdx.x >> 3) & 7, b = blockIdx.x >> 6;
    float s = 0.f;
    for (int t = 0; t < 256; ++t) s += bf2f(KB[HM(b, h, n * 256 + t, d)]);
    KMEAN[((size_t)(b * NBLK + n) * NH + h) * HD + d] = s * (1.f / 256.f);
}
__global__ void k_dsa_select_naive(const bf16_t* __restrict__ QI, const bf16_t* __restrict__ KI, const float* __restrict__ WI, unsigned long long* __restrict__ MASKT) {
    const int t = blockIdx.x, b = blockIdx.y, tid = threadIdx.x; const size_t m = (size_t)b * SEQ + t;
    __shared__ float q[1024]; __shared__ float w[16]; __shared__ float sc[SEQ];
    for (int i = tid; i < 1024; i += 256) q[i] = bf2f(QI[m * 1024 + i]);
    if (tid < 16) w[tid] = WI[m * 16 + tid];
    __syncthreads();
    for (int s = tid; s <= t; s += 256) {
        float k[64];
        const bf16_t* kp = KI + ((size_t)b * SEQ + s) * 64;
#pragma unroll
        for (int d = 0; d < 64; ++d) k[d] = bf2f(kp[d]);
        float score = 0.f;
        for (int h = 0; h < 16; ++h) { float dot = 0.f;
#pragma unroll
            for (int d = 0; d < 64; ++d) dot += q[h * 64 + d] * k[d];
            score += w[h] * fmaxf(dot * 0.125f, 0.f); }
        sc[s] = score * 0.25f;
    }
    __syncthreads();
    for (int s = tid; s <= t; s += 256) {
        bool sel = true;
        if (t >= TOPK) { const float v = sc[s]; int cnt = 0; for (int s2 = 0; s2 <= t; ++s2) { const float u = sc[s2]; cnt += (u > v || (u == v && s2 < s)) ? 1 : 0; } sel = cnt < TOPK; }
        if (sel) { size_t word; int bit; mask_pos(t, s, word, bit); atomicOr(&MASKT[(size_t)b * 65536 + word], 1ull << bit); }
    }
}
__global__ void k_dsa_attn_naive(const bf16_t* __restrict__ QA, const bf16_t* __restrict__ KA, const bf16_t* __restrict__ VA, const bf16_t* __restrict__ SZA,
                                 const unsigned long long* __restrict__ MASKT, bf16_t* __restrict__ Y) {
    const int t = blockIdx.x, b = blockIdx.y, tid = threadIdx.x, lane = tid & 63, w = tid >> 6; const size_t m = (size_t)b * SEQ + t;
    __shared__ int idx[512]; __shared__ int nsel; __shared__ float qs[8][128]; __shared__ float p[4][256];
    if (tid == 0) nsel = 0;
    __syncthreads();
    for (int s = tid; s <= t; s += 256) { size_t word; int bit; mask_pos(t, s, word, bit);
        if ((MASKT[(size_t)b * 65536 + word] >> bit) & 1ull) { const int pos = atomicAdd(&nsel, 1); if (pos < 512) idx[pos] = s; } }
    for (int i = tid; i < 1024; i += 256) qs[i >> 7][i & 127] = bf2f(QA[HM(b, i >> 7, t, i & 127)]);
    __syncthreads();
    const int n = nsel < 256 ? nsel : 256;
    for (int hh = 0; hh < 2; ++hh) {
        const int h = w + 4 * hh; const float slope = exp2f(-(float)(h + 1));
        float sv[4]; float mx = -INFINITY;
#pragma unroll
        for (int i = 0; i < 4; ++i) { const int j = lane + 64 * i; sv[i] = -INFINITY;
            if (j < n) { const int s = idx[j]; const bf16_t* kp = KA + HM(b, h, s, 0); float dot = 0.f;
                for (int d = 0; d < 128; ++d) dot += qs[h][d] * bf2f(kp[d]);
                sv[i] = dot * QK_SCALE - slope * (float)(t - s); }
            mx = fmaxf(mx, sv[i]); }
        mx = wave_max(mx);
        float sum = 0.f;
#pragma unroll
        for (int i = 0; i < 4; ++i) { const int j = lane + 64 * i; const float pv = (j < n) ? __expf(sv[i] - mx) : 0.f; sum += pv; p[w][j] = pv; }
        sum = wave_sum(sum);
        __syncthreads();
        float o0 = 0.f, o1 = 0.f;
        for (int j = 0; j < n; ++j) { const float pj = p[w][j]; const int s = idx[j]; const unsigned vv = *(const unsigned*)(VA + HM(b, h, s, 2 * lane));
            o0 += pj * __uint_as_float(vv << 16); o1 += pj * __uint_as_float(vv & 0xffff0000u); }
        const float inv = 1.f / sum;
        const unsigned zz = *(const unsigned*)(SZA + HM(b, h, t, 2 * lane));
        o0 = o0 * inv * __uint_as_float(zz << 16); o1 = o1 * inv * __uint_as_float(zz & 0xffff0000u);
        *(unsigned*)(Y + m * 2048 + h * 128 + 2 * lane) = (unsigned)f2bf(o0) | ((unsigned)f2bf(o1) << 16);
        __syncthreads();
    }
}
__global__ void k_moba_naive(const bf16_t* __restrict__ QB, const bf16_t* __restrict__ KB, const bf16_t* __restrict__ VB, const bf16_t* __restrict__ SZB,
                             const float* __restrict__ KMEAN, bf16_t* __restrict__ Y) {
    const int t = blockIdx.x, b = blockIdx.y, tid = threadIdx.x, lane = tid & 63, w = tid >> 6; const size_t m = (size_t)b * SEQ + t;
    __shared__ float qs[8][128]; __shared__ float sc[4][SEQ];
    for (int i = tid; i < 1024; i += 256) qs[i >> 7][i & 127] = bf2f(QB[HM(b, i >> 7, t, i & 127)]);
    __syncthreads();
    const int qblk = t >> 8;
    for (int hh = 0; hh < 2; ++hh) {
        const int h = w + 4 * hh; const float slope = exp2f(-(float)(h + 1));
        float g = -INFINITY;
        if (lane < qblk) { const float* km = KMEAN + ((size_t)(b * NBLK + lane) * NH + h) * HD; float dot = 0.f; for (int d = 0; d < 128; ++d) dot += qs[h][d] * km[d]; g = dot; }
        int rank = 0;
        for (int n2 = 0; n2 < NBLK; ++n2) { const float g2 = __shfl(g, n2); if (n2 < qblk && (g2 > g || (g2 == g && n2 < lane))) ++rank; }
        const bool sel = (lane < qblk) && (rank < 3);
        const unsigned selmask = (unsigned)(__ballot(sel) & 0xffull);
        float mx = -INFINITY;
        for (int s = lane; s <= t; s += 64) { const int blk = s >> 8; float v = -INFINITY;
            if (blk == qblk || ((selmask >> blk) & 1u)) { const bf16_t* kp = KB + HM(b, h, s, 0); float dot = 0.f;
                for (int d = 0; d < 128; ++d) dot += qs[h][d] * bf2f(kp[d]);
                v = dot * QK_SCALE - slope * (float)(t - s); }
            sc[w][s] = v; mx = fmaxf(mx, v); }
        mx = wave_max(mx);
        float sum = 0.f;
        for (int s = lane; s <= t; s += 64) { const float v = sc[w][s]; const float pv = (v == -INFINITY) ? 0.f : __expf(v - mx); sc[w][s] = pv; sum += pv; }
        sum = wave_sum(sum);
        __syncthreads();
        float o0 = 0.f, o1 = 0.f;
        for (int s = 0; s <= t; ++s) { const float pj = sc[w][s]; if (pj == 0.f) continue; const unsigned vv = *(const unsigned*)(VB + HM(b, h, s, 2 * lane));
            o0 += pj * __uint_as_float(vv << 16); o1 += pj * __uint_as_float(vv & 0xffff0000u); }
        const float inv = 1.f / sum;
        const unsigned zz = *(const unsigned*)(SZB + HM(b, h, t, 2 * lane));
        o0 = o0 * inv * __uint_as_float(zz << 16); o1 = o1 * inv * __uint_as_float(zz & 0xffff0000u);
        *(unsigned*)(Y + m * 2048 + 1024 + h * 128 + 2 * lane) = (unsigned)f2bf(o0) | ((unsigned)f2bf(o1) << 16);
        __syncthreads();
    }
}

namespace pg8 {
#define PG8_LAS __attribute__((address_space(3)))
typedef unsigned short bf16_t;
typedef short bf16x8 __attribute__((ext_vector_type(8)));
typedef float f32x4 __attribute__((ext_vector_type(4)));
typedef unsigned u32x4 __attribute__((ext_vector_type(4)));
constexpr int BM = 256, BK = 64, HALF = 128, HTB = HALF * BK * 2  , STAGE_BYTES = 8 * HTB, NXCD = 8, WGM = 8;

__host__ __device__ __forceinline__ int lds_byte(int r, int c) { const int st = (r >> 4) * 2 + (c >> 5), rr = r & 15, cc = c & 31, ob = rr * 64 + cc * 2; return st * 1024 + (ob ^ (((ob >> 9) & 1) << 5)); }
__host__ __device__ __forceinline__ void stage_rc(int b, int& R, int& C) { const int st = b / 1024, sb = b % 1024, swz = sb ^ (((sb >> 9) & 1) << 5); R = (st >> 1) * 16 + swz / 64; C = (st & 1) * 32 + (swz % 64) / 2; }
__host__ __device__ __forceinline__ int perm32(int rho) { const int n = rho >> 4, i = rho & 15; return 8 * (i >> 2) + 4 * n + (i & 3); }

struct Unit { int pm, pn; };
struct Gemm { const void* A; const void* Bt; int M, N, K; };

struct StaticOrder {
    int nM, nN, nwg, G, c, jump_at, jump, base;
    __host__ __device__ void init(int M, int N, int G_, int c_, int base_ = 0, int jump_at_ = 1 << 30, int jump_ = 0) { nM = M / BM; nN = N / BM; nwg = nM * nN; G = G_; c = c_; base = base_; jump_at = jump_at_; jump = jump_; }
    __host__ __device__ bool next(int i, Unit& u) const {
        const long L = (long)i * G + c; if (L >= nwg) return false;
        int wgid = (int)L; { const int q = nwg / NXCD, r = nwg % NXCD, xcd = wgid % NXCD, off = wgid / NXCD; wgid = (xcd < r ? xcd * (q + 1) : r * (q + 1) + (xcd - r) * q) + off; }
        const int nig = WGM * nN, gid = wgid / nig, fm = gid * WGM, gsz = (nM - fm) < WGM ? (nM - fm) : WGM;
        u.pm = fm + ((wgid % nig) % gsz); const int d = (wgid % nig) / gsz; u.pn = d + (d >= jump_at ? jump : base); return true;
    }
    __device__ __forceinline__ void a_ready(const Unit&) const {}
    __device__ __forceinline__ void done(const Unit&) const {}
};

template <class Epi, class Sched, bool ALIGN_EPI = false, bool SP2 = false, bool FP8 = false>
__device__ __forceinline__ void gemm_phase(PG8_LAS unsigned char* lds, const Gemm g, const Sched& S, const Epi& E) {
    const int tid = threadIdx.x, wid = __builtin_amdgcn_readfirstlane(tid >> 6), lane = tid & 63, wr = wid >> 2, wc = wid & 3, fr = lane & 15, fq = lane >> 4;
    const int K = FP8 ? g.K / 2 : g.K, nt = K / BK;
    typedef int i32x8 __attribute__((ext_vector_type(8))); typedef int i32x4v __attribute__((ext_vector_type(4)));
    unsigned voffA[2], voffB[2];
#pragma unroll
    for (int i = 0; i < 2; ++i) { int R, C; stage_rc(tid * 16 + i * 8192, R, C); const int Rb = Epi::PERM ? ((R & ~31) + perm32(R & 31)) : R;
        voffA[i] = (unsigned)(R * K + C) * 2u; voffB[i] = (unsigned)(Rb * K + C) * 2u; }
    const size_t kstep = (size_t)(BK * 2);
    const size_t hstep = (size_t)HALF * K * 2;
    const size_t tstep = 2 * hstep;
    const unsigned ldsw = (unsigned)wid * 1024u;
    const int aoff = lds_byte(wr * 64 + fr, fq * 8), boff = lds_byte(wc * 32 + fr, fq * 8);
#define PG8_SA(b, h) (((b) * 2 + (h)) * HTB)
#define PG8_SB(b, h) ((4 + (b) * 2 + (h)) * HTB)
#define PG8_STAGE(bufoff, gbase, voff) do { _Pragma("unroll") for (int _i = 0; _i < 2; ++_i) \
        __builtin_amdgcn_global_load_lds((const unsigned*)((const char*)(gbase) + (voff)[_i]), (PG8_LAS unsigned*)(lds + (bufoff) + ldsw + _i * 8192), 16, 0, 0); } while (0)
#define PG8_LDA(dst, b, h) do { _Pragma("unroll") for (int m = 0; m < 4; ++m) { dst[m].lo = *(const PG8_LAS i32x4v*)(lds + PG8_SA(b, h) + aoff + m * 2048); dst[m].hi = *(const PG8_LAS i32x4v*)(lds + PG8_SA(b, h) + aoff + m * 2048 + 1024); } } while (0)
#define PG8_LDB(dst, b, h) do { _Pragma("unroll") for (int n = 0; n < 2; ++n) { dst[n].lo = *(const PG8_LAS i32x4v*)(lds + PG8_SB(b, h) + boff + n * 2048); dst[n].hi = *(const PG8_LAS i32x4v*)(lds + PG8_SB(b, h) + boff + n * 2048 + 1024); } } while (0)
#define PG8_MMA(ai, bj, At, Bt) do { __builtin_amdgcn_s_setprio(1); \
        if constexpr (FP8) { _Pragma("unroll") for (int m = 0; m < 4; ++m) _Pragma("unroll") for (int n = 0; n < 2; ++n) \
            asm volatile("v_mfma_f32_16x16x128_f8f6f4 %0, %1, %2, %0" : "+v"(acc[ai][bj][m][n]) : "v"(Bt[n]), "v"(At[m])); }   \
        else { _Pragma("unroll") for (int m = 0; m < 4; ++m) _Pragma("unroll") for (int n = 0; n < 2; ++n) { \
            const i32x4v bl_ = Bt[n].lo, bh_ = Bt[n].hi, al_ = At[m].lo, ah_ = At[m].hi;     \
            acc[ai][bj][m][n] = __builtin_amdgcn_mfma_f32_16x16x32_bf16(__builtin_bit_cast(bf16x8, bl_), __builtin_bit_cast(bf16x8, al_), acc[ai][bj][m][n], 0, 0, 0); \
            acc[ai][bj][m][n] = __builtin_amdgcn_mfma_f32_16x16x32_bf16(__builtin_bit_cast(bf16x8, bh_), __builtin_bit_cast(bf16x8, ah_), acc[ai][bj][m][n], 0, 0, 0); } } \
        __builtin_amdgcn_s_setprio(0); } while (0)
#define PG8_WAIT_V(n) asm volatile("s_waitcnt vmcnt(" #n ")" ::: "memory")
#define PG8_WAIT_L(n) asm volatile("s_waitcnt lgkmcnt(" #n ")" ::: "memory")
#define PG8_BAR __builtin_amdgcn_s_barrier()
#define PG8_SCHED __builtin_amdgcn_sched_barrier(0)
    Unit cur, nxt; int ui = 0;
    if (!S.next(0, cur)) return;
    f32x4 acc[2][2][4][2];
#pragma unroll
    for (int a = 0; a < 2; ++a)
#pragma unroll
        for (int b = 0; b < 2; ++b)
#pragma unroll
            for (int m = 0; m < 4; ++m)
#pragma unroll
                for (int n = 0; n < 2; ++n) acc[a][b][m][n] = (f32x4){0.f, 0.f, 0.f, 0.f};
    i32x8 At[4], B0[2], B1[2];
    const char* cA = (const char*)g.A + (size_t)cur.pm * tstep; const char* cB = (const char*)g.Bt + (size_t)cur.pn * tstep;
    S.a_ready(cur);
    if constexpr (SP2) {
        PG8_STAGE(PG8_SB(0, 0), cB, voffB); PG8_STAGE(PG8_SB(0, 1), cB + hstep, voffB); PG8_STAGE(PG8_SA(0, 0), cA, voffA); PG8_STAGE(PG8_SA(0, 1), cA + hstep, voffA);
        if (wr == 1) PG8_BAR;
        PG8_WAIT_V(2); PG8_BAR;
        PG8_STAGE(PG8_SB(1, 0), cB + kstep, voffB); PG8_STAGE(PG8_SA(1, 0), cA + kstep, voffA); PG8_STAGE(PG8_SB(1, 1), cB + hstep + kstep, voffB);
        PG8_WAIT_V(6); PG8_BAR;
    } else {
        PG8_STAGE(PG8_SB(0, 0), cB, voffB); PG8_STAGE(PG8_SA(0, 0), cA, voffA); PG8_STAGE(PG8_SB(0, 1), cB + hstep, voffB); PG8_STAGE(PG8_SA(0, 1), cA + hstep, voffA);
        if (wr == 1) PG8_BAR;
        PG8_WAIT_V(4); PG8_BAR;
        PG8_STAGE(PG8_SB(1, 0), cB + kstep, voffB); PG8_STAGE(PG8_SA(1, 0), cA + kstep, voffA); PG8_STAGE(PG8_SB(1, 1), cB + hstep + kstep, voffB);
        PG8_WAIT_V(6); PG8_BAR;
    }
    for (;;) {
        const bool has_next = S.next(ui + 1, nxt);
        const char* nA = has_next ? (const char*)g.A + (size_t)nxt.pm * tstep : cA; const char* nB = has_next ? (const char*)g.Bt + (size_t)nxt.pn * tstep : cB;
        for (int t = 0; t < nt; t += 2) {
            const bool last = (t == nt - 2);
            const char* a1 = cA + (size_t)(t + 1) * kstep;
            const char* a2 = last ? nA : cA + (size_t)(t + 2) * kstep; const char* b2 = last ? nB : cB + (size_t)(t + 2) * kstep;
            const char* a3 = a2 + kstep; const char* b3 = b2 + kstep;
            if (last && has_next) S.a_ready(nxt);
            if constexpr (SP2) {
            PG8_LDB(B0, 0, 0); PG8_LDB(B1, 0, 1); PG8_SCHED; PG8_LDA(At, 0, 0); PG8_STAGE(PG8_SA(1, 1), a1 + hstep, voffA);
            PG8_WAIT_V(8); PG8_WAIT_L(0); PG8_BAR; PG8_MMA(0, 0, At, B0); PG8_MMA(0, 1, At, B1); PG8_BAR; PG8_SCHED;
            PG8_LDA(At, 0, 1); PG8_STAGE(PG8_SB(0, 0), b2, voffB); PG8_STAGE(PG8_SB(0, 1), b2 + hstep, voffB); PG8_STAGE(PG8_SA(0, 0), a2, voffA);
            PG8_WAIT_V(8); PG8_WAIT_L(0); PG8_BAR; PG8_MMA(1, 0, At, B0); PG8_MMA(1, 1, At, B1); PG8_BAR; PG8_SCHED;
            PG8_LDB(B0, 1, 0); PG8_LDB(B1, 1, 1); PG8_SCHED; PG8_LDA(At, 1, 0); PG8_STAGE(PG8_SA(0, 1), a2 + hstep, voffA);
            PG8_WAIT_V(8); PG8_WAIT_L(0); PG8_BAR; PG8_MMA(0, 0, At, B0); PG8_MMA(0, 1, At, B1); PG8_BAR; PG8_SCHED;
            PG8_LDA(At, 1, 1); PG8_STAGE(PG8_SB(1, 0), b3, voffB); PG8_STAGE(PG8_SB(1, 1), b3 + hstep, voffB); PG8_STAGE(PG8_SA(1, 0), a3, voffA);
            PG8_WAIT_V(8); PG8_WAIT_L(0); PG8_BAR; PG8_MMA(1, 0, At, B0); PG8_MMA(1, 1, At, B1); PG8_BAR; PG8_SCHED;
            } else {
            PG8_LDB(B0, 0, 0); PG8_SCHED; PG8_LDA(At, 0, 0); PG8_STAGE(PG8_SA(1, 1), a1 + hstep, voffA);
            PG8_WAIT_L(8); PG8_BAR; PG8_WAIT_L(0); PG8_MMA(0, 0, At, B0); PG8_BAR; PG8_SCHED;
            PG8_LDB(B1, 0, 1); PG8_STAGE(PG8_SB(0, 0), b2, voffB);
            PG8_BAR; PG8_WAIT_L(0); PG8_MMA(0, 1, At, B1); PG8_BAR;
            PG8_LDA(At, 0, 1); PG8_STAGE(PG8_SA(0, 0), a2, voffA);
            PG8_BAR; PG8_WAIT_L(0); PG8_MMA(1, 0, At, B0); PG8_BAR; PG8_SCHED;
            PG8_STAGE(PG8_SB(0, 1), b2 + hstep, voffB);
            PG8_WAIT_V(6); PG8_BAR; PG8_MMA(1, 1, At, B1); PG8_BAR;
            PG8_LDB(B0, 1, 0); PG8_SCHED; PG8_LDA(At, 1, 0); PG8_STAGE(PG8_SA(0, 1), a2 + hstep, voffA);
            PG8_WAIT_L(8); PG8_BAR; PG8_WAIT_L(0); PG8_MMA(0, 0, At, B0); PG8_BAR; PG8_SCHED;
            PG8_LDB(B1, 1, 1); PG8_STAGE(PG8_SB(1, 0), b3, voffB);
            PG8_BAR; PG8_WAIT_L(0); PG8_MMA(0, 1, At, B1); PG8_BAR;
            PG8_LDA(At, 1, 1); PG8_STAGE(PG8_SA(1, 0), a3, voffA);
            PG8_BAR; PG8_WAIT_L(0); PG8_MMA(1, 0, At, B0); PG8_BAR; PG8_SCHED;
            PG8_STAGE(PG8_SB(1, 1), b3 + hstep, voffB);
            PG8_WAIT_V(6); PG8_BAR; PG8_MMA(1, 1, At, B1); PG8_BAR;
            }
        }
        if constexpr (ALIGN_EPI) { if (wr == 0) PG8_BAR; }
        if constexpr (FP8) asm volatile("s_nop 15\n\ts_nop 15" ::: "memory");
        PG8_SCHED;
        if constexpr (!Epi::AFTER_DRAIN) { E(acc, cur, wr, wc, fr, fq); S.done(cur); }
        PG8_SCHED;
        if (!has_next) break;
#pragma unroll
        for (int a = 0; a < 2; ++a)
#pragma unroll
            for (int b = 0; b < 2; ++b)
#pragma unroll
                for (int m = 0; m < 4; ++m)
#pragma unroll
                    for (int n = 0; n < 2; ++n) acc[a][b][m][n] = (f32x4){0.f, 0.f, 0.f, 0.f};
        cur = nxt; cA = nA; cB = nB; ++ui;
        if constexpr (ALIGN_EPI) { if (wr == 1) PG8_BAR; }
    }
    PG8_WAIT_V(0);
    if constexpr (!ALIGN_EPI) { if (wr == 0) PG8_BAR; }
    PG8_BAR;
    if constexpr (Epi::AFTER_DRAIN) { E.fused(acc, cur, wr, wc, fr, fq, lds, wid, lane); S.done(cur); }
#undef PG8_SA
#undef PG8_SB
#undef PG8_STAGE
#undef PG8_LDA
#undef PG8_LDB
#undef PG8_MMA
#undef PG8_WAIT_V
#undef PG8_WAIT_L
#undef PG8_BAR
#undef PG8_SCHED
}
}

#define GAS __attribute__((address_space(1)))
#define LAS __attribute__((address_space(3)))
typedef unsigned v4u __attribute__((ext_vector_type(4)));
typedef float f32x4 __attribute__((ext_vector_type(4)));
typedef GAS unsigned gu32;
#define RLX_AGENT __ATOMIC_RELAXED, __HIP_MEMORY_SCOPE_AGENT
#define LDS_WAIT() asm volatile("s_waitcnt lgkmcnt(0)" ::: "memory")
#define VM_WAIT() asm volatile("s_waitcnt vmcnt(0)" ::: "memory")
constexpr int NWAVES = 8;
constexpr int NPAD = 9472;
constexpr size_t MiB = 1u << 20;
constexpr size_t WS_CTL = 0, CTL_ZERO_BYTES = 1 * MiB;
constexpr size_t WS_MOD = 1 * MiB;
constexpr size_t WS_GAIN = 1 * MiB + 256 * 1024;
constexpr size_t WS_KMEAN = 1 * MiB + 512 * 1024;
constexpr size_t WS_WI = 2 * MiB;
constexpr size_t WS_KI = 3 * MiB;
constexpr size_t WS_MASK = 5 * MiB;
constexpr size_t WS_MODP = 10 * MiB;
constexpr size_t WS_WIN = 18 * MiB;
constexpr size_t WS_HB = 56 * MiB;
constexpr size_t WS_Y = 56 * MiB;
constexpr size_t WS_QA = 120 * MiB, WS_KA = 152 * MiB, WS_VA = 184 * MiB, WS_SZA = 216 * MiB;
constexpr size_t WS_QB = 248 * MiB, WS_KB = 280 * MiB, WS_VB = 312 * MiB, WS_SZB = 344 * MiB;
constexpr size_t WS_QI = 376 * MiB;
constexpr size_t WS_T32 = 408 * MiB;
constexpr size_t WS_Y8 = 408 * MiB;
constexpr size_t WS_HB8 = 440 * MiB;
constexpr size_t WS_WIN8 = 472 * MiB;
constexpr size_t WS_WOUT8 = 492 * MiB;
constexpr size_t WS_END = 496 * MiB;
constexpr float FP8_DESCALE = 1.f / 512.f;
constexpr int CW_QUEUE = 2048;
constexpr int CW_BAR = 4096;
constexpr int RING_BYTES = 131072;
constexpr int EPI_OFF = RING_BYTES;
constexpr int LDSCTL_OFF = EPI_OFF + 16384, MISC_OFF = LDSCTL_OFF + 320;
constexpr int LDS_BYTES = 163840;

#define XB_TMO      128
#define XB_XCNT(j)  (256  + 64 * (j))
#define XB_XSUB(j)  (1280 + 64 * (j))
#define XB_XGEN(j)  (2304 + 64 * (j))
#define XB_TOP      3328
#define XB_TOPGEN   3392
#define XCD_BAR_WORDS 3456
#define XB_SPIN_CAP (1u << 18)

__device__ __forceinline__ unsigned xb_ld(unsigned* p)              { return __hip_atomic_load(p, __ATOMIC_RELAXED, __HIP_MEMORY_SCOPE_AGENT); }
__device__ __forceinline__ unsigned xb_add(unsigned* p, unsigned v) { return __hip_atomic_fetch_add(p, v, __ATOMIC_RELAXED, __HIP_MEMORY_SCOPE_AGENT); }
__device__ __forceinline__ unsigned xb_xcc_id() { return (unsigned)__builtin_amdgcn_s_getreg((3 << 11) | 20) & 0xFu; }
#define XB_SPIN(cond, bar) do { unsigned _sp = 0; while (cond) { __builtin_amdgcn_s_sleep(1); \
    if ((++_sp & 255u) == 0u) { if (xb_ld(&(bar)[XB_TMO])) break; if (_sp > XB_SPIN_CAP) { atomicAdd(&(bar)[XB_TMO], 1u); break; } } } } while (0)

struct XcdBarrier {
    unsigned* bar; unsigned x;
    volatile LAS unsigned* st;
};

__device__ __forceinline__ XcdBarrier xcd_barrier_post(unsigned* bar, volatile LAS unsigned* st) {
    XcdBarrier b; b.bar = bar; b.x = xb_xcc_id(); b.st = st;
    if (threadIdx.x == 0) (void)xb_add(&bar[XB_XCNT(b.x)], 1u);
    return b;
}
__device__ __forceinline__ void xcd_barrier_complete(unsigned* bar, unsigned x, unsigned& nloc, unsigned& nx) {
    const unsigned G = gridDim.x * gridDim.y * gridDim.z;
    unsigned sum, cnt, mine, sp = 0u;
    for (;;) {
        sum = 0u; cnt = 0u; mine = 0u;
#pragma unroll
        for (unsigned j = 0; j < 16; ++j) { const unsigned c = xb_ld(&bar[XB_XCNT(j)]); sum += c; cnt += (c > 0u) ? 1u : 0u; mine = (j == x) ? c : mine; }
        if (sum == G) break;
        __builtin_amdgcn_s_sleep(1);
        if ((++sp & 255u) == 0u) { if (xb_ld(&bar[XB_TMO])) break; if (sp > XB_SPIN_CAP) { atomicAdd(&bar[XB_TMO], 1u); break; } }
    }
    nloc = mine > 0u ? mine : 1u; nx = cnt > 0u ? cnt : 1u;
}

__device__ __forceinline__ void xcd_barrier(const XcdBarrier& b) {
    asm volatile("s_waitcnt vmcnt(0)" ::: "memory");
    __syncthreads();
    if (threadIdx.x == 0) {
        unsigned* bar = b.bar;
        __builtin_amdgcn_s_waitcnt(0);
        unsigned nloc = b.st[0], nx = b.st[1];
        if (nloc == 0u) { xcd_barrier_complete(bar, b.x, nloc, nx); b.st[0] = nloc; b.st[1] = nx; }
        const unsigned old = xb_add(&bar[XB_XSUB(b.x)], 1u);
        const unsigned gen = old / nloc;
        if (old + 1u == (gen + 1u) * nloc) {
            __builtin_amdgcn_fence(__ATOMIC_RELEASE, "agent");
            asm volatile("s_waitcnt vmcnt(0)" ::: "memory");
            const unsigned og = xb_add(&bar[XB_TOP], 1u);
            const unsigned tg = og / nx;
            if (og + 1u == (tg + 1u) * nx) xb_add(&bar[XB_TOPGEN], 1u);
            else XB_SPIN(xb_ld(&bar[XB_TOPGEN]) == tg, bar);
            __builtin_amdgcn_fence(__ATOMIC_ACQUIRE, "agent");
            xb_add(&bar[XB_XGEN(b.x)], 1u);
            asm volatile("s_waitcnt vmcnt(0)" ::: "memory");
        } else {
            XB_SPIN(xb_ld(&bar[XB_XGEN(b.x)]) == gen, bar);
            __builtin_amdgcn_fence(__ATOMIC_ACQUIRE, "agent");
            asm volatile("s_waitcnt vmcnt(0)" ::: "memory");
        }
    }
    __syncthreads();
}


struct Frame {
    LAS unsigned char* lds; volatile LAS unsigned* MISC; gu32* ctl; int tid, lane, wave, vcu, G;
};
__device__ __forceinline__ unsigned cvt_pk_bf16(float lo, float hi) { unsigned r; asm volatile("v_cvt_pk_bf16_f32 %0, %1, %2" : "=v"(r) : "v"(lo), "v"(hi)); return r; }
__device__ __forceinline__ unsigned f2bf_u(float f) { unsigned u = __builtin_bit_cast(unsigned, f); return (u + 0x7fffu + ((u >> 16) & 1u)) >> 16; }
__device__ __forceinline__ unsigned pk2(float lo, float hi) { return f2bf_u(lo) | (f2bf_u(hi) << 16); }
__device__ __forceinline__ float fast_silu(float v) { return v * __builtin_amdgcn_rcpf(1.f + __expf(-v)); }

__device__ __forceinline__ void p0_mod(Frame& F, int id, const float* __restrict__ c, const float* __restrict__ w_ada, float* __restrict__ MODP) {
    const int cs = id & 15, ks = id >> 4;
    LAS float* sc = (LAS float*)(F.lds);
    LAS float* red = (LAS float*)(F.lds + 4096);
    for (int i = F.tid; i < BATCH * 128; i += NWAVES * 64) sc[i] = silu_f(c[(i >> 7) * DM + ks * 128 + (i & 127)]);
    __syncthreads();
    const int cq = F.tid % 96, kq = F.tid / 96;
    if (F.tid < 480) {
        f32x4 acc[8];
#pragma unroll
        for (int b = 0; b < 8; ++b) acc[b] = (f32x4){0.f, 0.f, 0.f, 0.f};
        const float* wp = w_ada + (size_t)(ks * 128) * (3 * DM) + cs * 384 + 4 * cq;
#pragma unroll 4
        for (int k = kq; k < 128; k += 5) { const f32x4 w = *(const f32x4*)(wp + (size_t)k * (3 * DM));
#pragma unroll
            for (int b = 0; b < 8; ++b) acc[b] += w * sc[b * 128 + k]; }
#pragma unroll
        for (int b = 0; b < 8; ++b) *(LAS f32x4*)(red + (kq * 8 + b) * 384 + 4 * cq) = acc[b];
    }
    __syncthreads();
    for (int o = F.tid; o < 8 * 384; o += NWAVES * 64) { const int b = o / 384, col = o % 384; float s = 0.f;
#pragma unroll
        for (int q = 0; q < 5; ++q) s += red[(q * 8 + b) * 384 + col];
        MODP[((size_t)ks * BATCH + b) * (3 * DM) + cs * 384 + col] = s; }
    __syncthreads();
}
__device__ __forceinline__ unsigned pk4_fp8(float a, float b, float c, float d) {
    a = fminf(fmaxf(a, -448.f), 448.f); b = fminf(fmaxf(b, -448.f), 448.f); c = fminf(fmaxf(c, -448.f), 448.f); d = fminf(fmaxf(d, -448.f), 448.f);
    int w = 0; w = __builtin_amdgcn_cvt_pk_fp8_f32(a, b, w, false); w = __builtin_amdgcn_cvt_pk_fp8_f32(c, d, w, true); return (unsigned)w; }
template <bool MAPWIN>
__device__ __forceinline__ void p0_transpose_item(const float* __restrict__ W, int K, int N, int NP, bf16_t* __restrict__ WT, unsigned char* __restrict__ WT8, LAS float* scr, int item, int lane) {
    const int nblk = NP / 32, kb = item / nblk, nb = item % nblk, k0 = 64 * kb, n0 = 32 * nb;
    const int np = n0 + (lane & 31);
    int src = np; bool valid = true;
    if (MAPWIN) { if (np >= 5376) src = np - 176; else if (np >= 5200) valid = false; }
    float wv_[32];
#pragma unroll
    for (int i = 0; i < 32; ++i) { const int kk = 2 * i + (lane >> 5); wv_[i] = valid ? W[(size_t)(k0 + kk) * N + src] : 0.f; }
#pragma unroll
    for (int i = 0; i < 32; ++i) { const int kk = 2 * i + (lane >> 5); scr[kk * 33 + (lane & 31)] = wv_[i]; }
    LDS_WAIT(); asm volatile("" ::: "memory");
    const int c = lane & 7;
    if (WT) {
#pragma unroll
    for (int j = 0; j < 4; ++j) { const int n = (lane >> 3) + 8 * j; const LAS float* s = scr + (8 * c) * 33 + n;
        v4u o; o.x = pk2(s[0 * 33], s[1 * 33]); o.y = pk2(s[2 * 33], s[3 * 33]); o.z = pk2(s[4 * 33], s[5 * 33]); o.w = pk2(s[6 * 33], s[7 * 33]);
        *(GAS v4u*)(WT + (size_t)(n0 + n) * K + k0 + 8 * c) = o; } }
    if (WT8) {
#pragma unroll
        for (int jj = 0; jj < 2; ++jj) { const int idx = lane + 64 * jj, n = idx >> 2, c4 = idx & 3; const LAS float* s = scr + (16 * c4) * 33 + n;
            v4u o; o.x = pk4_fp8(s[0 * 33] * 64.f, s[1 * 33] * 64.f, s[2 * 33] * 64.f, s[3 * 33] * 64.f); o.y = pk4_fp8(s[4 * 33] * 64.f, s[5 * 33] * 64.f, s[6 * 33] * 64.f, s[7 * 33] * 64.f);
            o.z = pk4_fp8(s[8 * 33] * 64.f, s[9 * 33] * 64.f, s[10 * 33] * 64.f, s[11 * 33] * 64.f); o.w = pk4_fp8(s[12 * 33] * 64.f, s[13 * 33] * 64.f, s[14 * 33] * 64.f, s[15 * 33] * 64.f);
            *(GAS v4u*)(WT8 + (size_t)(n0 + n) * K + k0 + 16 * c4) = o; } }
    LDS_WAIT(); asm volatile("" ::: "memory");
}
__device__ __forceinline__ void p0_convert(Frame& F, const float* __restrict__ w_in, const float* __restrict__ w_out, bf16_t* __restrict__ WinT, unsigned char* __restrict__ WinT8, unsigned char* __restrict__ WoutT8) {
    LAS float* scr = (LAS float*)(F.lds + F.wave * 16384);
    const int gw = F.vcu * NWAVES + F.wave, NGW = F.G * NWAVES;
    constexpr int I_IN = (DM / 64) * (NPAD / 32), I_OUT = (DM / 64) * (DM / 32);
    for (int it = gw; it < I_IN + I_OUT; it += NGW) {
        if (it < I_IN) { const int tile = (it % (NPAD / 32)) >> 3; const bool b16 = (tile >= 16 && tile <= 24);
            p0_transpose_item<true>(w_in, DM, DIN, NPAD, b16 ? WinT : nullptr, b16 ? nullptr : WinT8, scr, it, F.lane); }
        else p0_transpose_item<false>(w_out, DM, DM, DM, nullptr, WoutT8, scr, it - I_IN, F.lane);
    }
}
__device__ __forceinline__ void p1_norm(Frame& F, const float* __restrict__ x, const float* __restrict__ g, const float* __restrict__ MODP, const float* __restrict__ b_ada, float* __restrict__ MOD,
                                        bf16_t* __restrict__ HB, unsigned char* __restrict__ HB8) {
    LAS float* gsl = (LAS float*)(F.lds);
    LAS float* shl = (LAS float*)(F.lds + 8192);
    for (int v = F.vcu; v < M / 64; v += F.G) {
        const int b = v / (SEQ / 64);
        { const int k4 = F.tid * 4; const float* pp = MODP + (size_t)b * (3 * DM) + k4;
          f32x4 sh = *(const f32x4*)(b_ada + k4), scl = *(const f32x4*)(b_ada + DM + k4);
#pragma unroll 4
          for (int q = 0; q < 16; ++q) { sh += *(const f32x4*)(pp + (size_t)q * BATCH * (3 * DM)); scl += *(const f32x4*)(pp + (size_t)q * BATCH * (3 * DM) + DM); }
          const f32x4 gg = *(const f32x4*)(g + k4);
          *(LAS f32x4*)(gsl + k4) = gg * (scl + 1.0f); *(LAS f32x4*)(shl + k4) = sh;
          if (F.tid < 64) { const int col = 2 * DM + 64 * (v % (SEQ / 64)) + F.tid; float gt = b_ada[col];
              for (int q = 0; q < 16; ++q) gt += MODP[((size_t)q * BATCH + b) * (3 * DM) + col];
              MOD[b * 3 * DM + col] = gt; } }
        __syncthreads();
        f32x4 gs[8], sh[8];
#pragma unroll
        for (int j = 0; j < 8; ++j) { const int k = 4 * F.lane + 256 * j; gs[j] = *(const LAS f32x4*)(gsl + k); sh[j] = *(const LAS f32x4*)(shl + k); }
        for (int r = 0; r < 8; ++r) {
            const int row = 64 * v + 8 * F.wave + r;
            const f32x4* xr = (const f32x4*)(x + (size_t)row * DM) + F.lane;
            f32x4 xv[8]; float ss = 0.f;
#pragma unroll
            for (int j = 0; j < 8; ++j) { xv[j] = xr[64 * j]; ss += (xv[j].x * xv[j].x + xv[j].y * xv[j].y) + (xv[j].z * xv[j].z + xv[j].w * xv[j].w); }
            ss = wave_sum(ss);
            const float rstd = rsqrtf(ss * (1.f / DM) + RMS_EPS);
            unsigned long long* o8 = (unsigned long long*)(HB + (size_t)row * DM) + F.lane; unsigned* o4 = (unsigned*)(HB8 + (size_t)row * DM) + F.lane;
#pragma unroll
            for (int j = 0; j < 8; ++j) { const f32x4 h = xv[j] * rstd * gs[j] + sh[j];
                o8[64 * j] = (unsigned long long)pk2(h.x, h.y) | ((unsigned long long)pk2(h.z, h.w) << 32);
                o4[64 * j] = pk4_fp8(h.x * 8.f, h.y * 8.f, h.z * 8.f, h.w * 8.f); }
        }
        __syncthreads();
    }
}
struct EpiProj {
    static constexpr bool PERM = true, AFTER_DRAIN = false;
    unsigned char* ws;
    LAS float* P; float osc;
    __device__ __forceinline__ void operator()(const pg8::f32x4 (&acc)[2][2][4][2], const pg8::Unit& u, int wr, int wc, int fr, int fq) const {
        { int l_ = threadIdx.x & 63; asm volatile("" : "+v"(l_)); fr = l_ & 15; fq = l_ >> 4; }
        const int pn = u.pn;
        bf16_t* const KI = (bf16_t*)(ws + WS_KI); float* const WI = (float*)(ws + WS_WI); bf16_t* const QI = (bf16_t*)(ws + WS_QI);
        int grp, sub;
        if (pn < 20) { grp = pn >> 2; sub = pn & 3; } else if (pn == 20) { grp = 5; sub = 0; } else { grp = 6 + ((pn - 21) >> 2); sub = (pn - 21) & 3; }
        const int b = u.pm >> 3, t0 = (u.pm & 7) * 256 + wr * 64 + fr;
        const int cl = 32 * wc + 8 * fq;
        const bool norm = (grp == 0 || grp == 1 || grp == 6 || grp == 7 || grp == 5);
        float rs[2][4][2];
        if (norm) {
#pragma unroll
            for (int ai = 0; ai < 2; ++ai)
#pragma unroll
                for (int m = 0; m < 4; ++m)
#pragma unroll
                    for (int bj = 0; bj < 2; ++bj) { const pg8::f32x4 a = acc[ai][bj][m][0], c = acc[ai][bj][m][1];
                        float s = (a[0] * a[0] + a[1] * a[1]) + (a[2] * a[2] + a[3] * a[3]) + (c[0] * c[0] + c[1] * c[1]) + (c[2] * c[2] + c[3] * c[3]);
                        s += __shfl_xor(s, 16); s += __shfl_xor(s, 32);
                        if (fq == 0) P[((ai * 128 + wr * 64 + m * 16 + fr) * 2 + bj) * 4 + wc] = s; }
            asm volatile("s_waitcnt lgkmcnt(0)" ::: "memory"); __builtin_amdgcn_s_barrier(); asm volatile("" ::: "memory");
#pragma unroll
            for (int ai = 0; ai < 2; ++ai)
#pragma unroll
                for (int m = 0; m < 4; ++m)
#pragma unroll
                    for (int bj = 0; bj < 2; ++bj) { const pg8::f32x4 q = *(const LAS pg8::f32x4*)(P + ((ai * 128 + wr * 64 + m * 16 + fr) * 2 + bj) * 4);
                        rs[ai][m][bj] = ((grp == 5) ? rsqrtf((q[0] + q[1]) * (osc * osc * (1.f / 64.f)) + RMS_EPS) : rsqrtf(((q[0] + q[1]) + (q[2] + q[3])) * (osc * osc * (1.f / 128.f)) + RMS_EPS)) * osc; }
        }
        if (grp == 5) {
            if (wc < 2) { const float* gki = (const float*)(ws + WS_GAIN) + 4 * 128; const pg8::f32x4 g0 = *(const pg8::f32x4*)(gki + cl), g1 = *(const pg8::f32x4*)(gki + cl + 4);
#pragma unroll
                for (int ai = 0; ai < 2; ++ai)
#pragma unroll
                    for (int m = 0; m < 4; ++m) { const size_t row = (size_t)b * SEQ + t0 + 128 * ai + 16 * m; const float r = rs[ai][m][0];
                        const pg8::f32x4 v0 = acc[ai][0][m][0] * r * g0, v1 = acc[ai][0][m][1] * r * g1;
                        pg8::u32x4 w; w.x = cvt_pk_bf16(v0[0], v0[1]); w.y = cvt_pk_bf16(v0[2], v0[3]); w.z = cvt_pk_bf16(v1[0], v1[1]); w.w = cvt_pk_bf16(v1[2], v1[3]);
                        *(pg8::u32x4*)(KI + row * 64 + cl) = w; } }
            else if (wc == 2 && fq < 2) {
#pragma unroll
                for (int ai = 0; ai < 2; ++ai)
#pragma unroll
                    for (int m = 0; m < 4; ++m) { const size_t row = (size_t)b * SEQ + t0 + 128 * ai + 16 * m;
                        *(pg8::f32x4*)(WI + row * 16 + 8 * fq) = acc[ai][0][m][0]; *(pg8::f32x4*)(WI + row * 16 + 8 * fq + 4) = acc[ai][0][m][1]; } }
            return;
        }
        if (grp == 4) {
#pragma unroll
            for (int ai = 0; ai < 2; ++ai)
#pragma unroll
                for (int m = 0; m < 4; ++m) { const size_t row = (size_t)b * SEQ + t0 + 128 * ai + 16 * m;
#pragma unroll
                    for (int bj = 0; bj < 2; ++bj) { const pg8::f32x4 v0 = acc[ai][bj][m][0], v1 = acc[ai][bj][m][1];
                        pg8::u32x4 w; w.x = cvt_pk_bf16(v0[0], v0[1]); w.y = cvt_pk_bf16(v0[2], v0[3]); w.z = cvt_pk_bf16(v1[0], v1[1]); w.w = cvt_pk_bf16(v1[2], v1[3]);
                        *(pg8::u32x4*)(QI + row * 1024 + sub * 256 + bj * 128 + cl) = w; } }
            return;
        }
        bf16_t* dst; const float* gain = nullptr;
        { const int slot = grp < 4 ? grp : grp - 2;
          dst = (bf16_t*)(ws + WS_QA + (size_t)slot * (32 * MiB));
          gain = (const float*)(ws + WS_GAIN) + (grp < 2 ? grp : grp - 4) * 128; }
        pg8::f32x4 g0 = {1.f, 1.f, 1.f, 1.f}, g1 = {1.f, 1.f, 1.f, 1.f};
        if (norm) { g0 = *(const pg8::f32x4*)(gain + cl); g1 = *(const pg8::f32x4*)(gain + cl + 4); }
        const bool act = (grp == 3 || grp == 9);
#pragma unroll
        for (int ai = 0; ai < 2; ++ai)
#pragma unroll
            for (int m = 0; m < 4; ++m) { const int t = t0 + 128 * ai + 16 * m;
#pragma unroll
                for (int bj = 0; bj < 2; ++bj) { const int h = 2 * sub + bj;
                    pg8::f32x4 v0 = acc[ai][bj][m][0], v1 = acc[ai][bj][m][1];
                    if (norm) { const float r = rs[ai][m][bj]; v0 = v0 * r * g0; v1 = v1 * r * g1; } else { v0 = v0 * osc; v1 = v1 * osc; }
                    if (act) { v0[0] = fast_silu(v0[0]); v0[1] = fast_silu(v0[1]); v0[2] = fast_silu(v0[2]); v0[3] = fast_silu(v0[3]);
                               v1[0] = fast_silu(v1[0]); v1[1] = fast_silu(v1[1]); v1[2] = fast_silu(v1[2]); v1[3] = fast_silu(v1[3]); }
                    pg8::u32x4 w; w.x = cvt_pk_bf16(v0[0], v0[1]); w.y = cvt_pk_bf16(v0[2], v0[3]); w.z = cvt_pk_bf16(v1[0], v1[1]); w.w = cvt_pk_bf16(v1[2], v1[3]);
                    *(pg8::u32x4*)(dst + HM(b, h, t, cl)) = w; } }
    }
};
struct EpiOut {
    static constexpr bool PERM = false, AFTER_DRAIN = false;
    const float* x; const float* MOD; float* out; float oscale;
    __device__ __forceinline__ void operator()(const pg8::f32x4 (&acc)[2][2][4][2], const pg8::Unit& u, int wr, int wc, int fr, int fq) const {
        { int l_ = threadIdx.x & 63; asm volatile("" : "+v"(l_)); fr = l_ & 15; fq = l_ >> 4; }
        const int b = u.pm >> 3; const float* gate = MOD + b * 3 * DM + 2 * DM;
        const int col0 = u.pn * 256 + wc * 32 + 4 * fq;
        pg8::f32x4 gv[2][2];
#pragma unroll
        for (int bj = 0; bj < 2; ++bj)
#pragma unroll
            for (int n = 0; n < 2; ++n) gv[bj][n] = *(const pg8::f32x4*)(gate + col0 + bj * 128 + n * 16) * oscale;
#pragma unroll
        for (int ai = 0; ai < 2; ++ai)
#pragma unroll
            for (int m = 0; m < 4; ++m) { const size_t off = (size_t)(u.pm * 256 + ai * 128 + wr * 64 + m * 16 + fr) * DM + col0;
#pragma unroll
                for (int bj = 0; bj < 2; ++bj)
#pragma unroll
                    for (int n = 0; n < 2; ++n) { const pg8::f32x4 xv = *(const pg8::f32x4*)(x + off + bj * 128 + n * 16);
                        *(pg8::f32x4*)(out + off + bj * 128 + n * 16) = xv + gv[bj][n] * acc[ai][bj][m][n]; }
                if (m & 1) asm volatile("" ::: "memory"); }
    }
};

namespace att {
typedef short bf16x8 __attribute__((ext_vector_type(8)));
typedef short s16x4 __attribute__((ext_vector_type(4)));
typedef float f32x16 __attribute__((ext_vector_type(16)));
typedef float f32x4 __attribute__((ext_vector_type(4)));
typedef unsigned u32x4 __attribute__((ext_vector_type(4)));
constexpr int NW = 8, QBLK = 32, KVBLK = 64, QB = NW * QBLK, D = 128;
constexpr int SHM_V = KVBLK * D * 2, SHM_K = KVBLK * D * 2;
constexpr int LDS_WS = 2 * SHM_V + 2 * SHM_K, LDS_KM = LDS_WS + NW * 64 * 4, LDS_OST = 73728, MST_PITCH = 264, MST_WAVE = QBLK * MST_PITCH, LDS_BYTES = LDS_OST + NW * MST_WAVE;
constexpr float SCALE = 0.08838834764831845f, THR = 8.f;
#define KSWZ(row, colB) ((row) * 256 + ((colB) ^ (((row) & 7) << 4)))
#define SBAR() __builtin_amdgcn_sched_barrier(0)
__device__ __forceinline__ int v_st(int k, int c) { const int kk = (k & ~0xC) | ((k & 4) << 1) | ((k & 8) >> 1); return ((kk >> 3) * 4 + (c >> 5)) * 512 + ((kk & 7) * 32 + (c & 31)) * 2; }
__device__ __forceinline__ int v_rd_base(int lane) { return ((lane & 3) << 3) | (((lane >> 2) & 3) << 6) | (((lane >> 4) & 1) << 5) | (((lane >> 5) & 1) << 8); }
constexpr int v_rd_off(int d0, int ks, int half) { return d0 * 512 + ks * 4096 + half * 2048; }
__device__ __forceinline__ int crow(int r, int hi) { return (r & 3) + 8 * (r >> 2) + 4 * hi; }
__device__ __forceinline__ unsigned cvtpk(float lo, float hi) { unsigned r; asm volatile("v_cvt_pk_bf16_f32 %0, %1, %2" : "=v"(r) : "v"(lo), "v"(hi)); return r; }
__device__ __forceinline__ unsigned cvt1(float v) { unsigned r; asm volatile("v_cvt_pk_bf16_f32 %0, %1, 0" : "=v"(r) : "v"(v)); return r; }
__device__ __forceinline__ bf16x8 load8(const bf16_t* p) { return *reinterpret_cast<const bf16x8*>(p); }
__device__ __forceinline__ void mask_causal(f32x16& p0, f32x16& p1, int dq) {
    const float NEG = -__builtin_inff();
#pragma unroll
    for (int r = 0; r < 16; ++r) { const int c = (r & 3) + 8 * (r >> 2); if (dq - c < 0) p0[r] = NEG; if (dq - c - 32 < 0) p1[r] = NEG; }
}
__device__ __forceinline__ void mask_bits(f32x16& p0, f32x16& p1, unsigned w0, unsigned w1) {
    const unsigned NEGB = 0xff800000u;
#pragma unroll
    for (int r = 0; r < 16; ++r) { const int c = (r & 3) + 8 * (r >> 2);
        const unsigned t0 = (unsigned)(((int)(w0 << (31 - c))) >> 31), t1 = (unsigned)(((int)(w1 << (31 - c))) >> 31);
        p0[r] = __uint_as_float((__float_as_uint(p0[r]) & t0) | (NEGB & ~t0));
        p1[r] = __uint_as_float((__float_as_uint(p1[r]) & t1) | (NEGB & ~t1)); }
}
__device__ __forceinline__ void partialSM(f32x16& p0, f32x16& p1, float& m_reg, float& mn, float& alpha) {
    float pmax = p0[0]; for (int r = 1; r < 16; ++r) pmax = fmaxf(pmax, p0[r]); for (int r = 0; r < 16; ++r) pmax = fmaxf(pmax, p1[r]);
    { auto rr = __builtin_amdgcn_permlane32_swap(__float_as_uint(pmax), __float_as_uint(pmax), false, false);
      pmax = fmaxf(__uint_as_float(rr[0]), __uint_as_float(rr[1])); }
    constexpr float C2 = 1.4426950408889634f * SCALE;
    if (__builtin_expect(__all((pmax - m_reg) * SCALE <= THR), 1)) { mn = m_reg; alpha = 1.f; }
    else { mn = fmaxf(m_reg, pmax); alpha = __builtin_amdgcn_exp2f((m_reg - mn) * C2); m_reg = mn; }
    const float mnL = -mn * C2;
    for (int r = 0; r < 16; ++r) p0[r] = fmaf(p0[r], C2, mnL); for (int r = 0; r < 16; ++r) p1[r] = fmaf(p1[r], C2, mnL);
    for (int r = 0; r < 16; ++r) p0[r] = __builtin_amdgcn_exp2f(p0[r]);
}
__device__ __forceinline__ void finishSM(f32x16& p0, f32x16& p1, float alpha, float& l_reg, bf16x8& pa0, bf16x8& pa1, bf16x8& pa2, bf16x8& pa3) {
    for (int r = 0; r < 16; ++r) p1[r] = __builtin_amdgcn_exp2f(p1[r]);
    float ps = 0; for (int r = 0; r < 16; ++r) ps += p0[r]; for (int r = 0; r < 16; ++r) ps += p1[r];
    { auto rr = __builtin_amdgcn_permlane32_swap(__float_as_uint(ps), __float_as_uint(ps), false, false);
      ps = __uint_as_float(rr[0]) + __uint_as_float(rr[1]); }
    l_reg = l_reg * alpha + ps;
#define PK4(P, B_, OUT) do { unsigned a0 = cvtpk(P[B_+0], P[B_+1]), a1 = cvtpk(P[B_+2], P[B_+3]);                          \
        unsigned b0 = cvtpk(P[B_+4], P[B_+5]), b1 = cvtpk(P[B_+6], P[B_+7]);                                             \
        auto r0 = __builtin_amdgcn_permlane32_swap(a0, b0, false, false); auto r1 = __builtin_amdgcn_permlane32_swap(a1, b1, false, false); \
        u32x4 w = {r0[0], r1[0], r0[1], r1[1]}; OUT = *reinterpret_cast<bf16x8*>(&w); } while (0)
    PK4(p0, 0, pa0); PK4(p0, 8, pa1); PK4(p1, 0, pa2); PK4(p1, 8, pa3);
#undef PK4
}
template <int KB>
__device__ __forceinline__ void qkt(f32x16& p0, f32x16& p1, const char* K_lds, int r32, int hi, const bf16x8* qr, float cb, float sl, bool act) {
    if (!act) { p0 = f32x16{}; p1 = f32x16{}; return; }
#pragma unroll
    for (int r = 0; r < 16; ++r) { const int c = (r & 3) + 8 * (r >> 2); p0[r] = fmaf(sl, (float)c, cb); p1[r] = fmaf(sl, (float)(c + 32), cb); }
    const char* kb[4];
#pragma unroll
    for (int dd = 0; dd < 4; ++dd) kb[dd] = K_lds + KB * SHM_K + KSWZ(r32, (dd * 16 + hi * 8) * 2);
#pragma unroll
    for (int d0 = 0; d0 < 8; ++d0) { const char* a = kb[d0 & 3] + (d0 >> 2) * 128;
        bf16x8 b0 = *reinterpret_cast<const bf16x8*>(a);
        bf16x8 b1 = *reinterpret_cast<const bf16x8*>(a + 32 * 256);
        p0 = __builtin_amdgcn_mfma_f32_32x32x16_bf16(b0, qr[d0], p0, 0, 0, 0);
        p1 = __builtin_amdgcn_mfma_f32_32x32x16_bf16(b1, qr[d0], p1, 0, 0, 0); }
}
template <int VB>
__device__ __forceinline__ void pv_tile(f32x16* o, int vb0, bf16x8 pa0, bf16x8 pa1, bf16x8 pa2, bf16x8 pa3, bool act) {
    if (!act) return;
#define TRRD(dst, off) asm volatile("ds_read_b64_tr_b16 %0, %1 offset:%2" : "=&v"(dst) : "v"(vb0), "i"(off) : "memory")
#define PV_D0(d0) do { s16x4 l0, l1, l2, l3, h0, h1, h2, h3; constexpr int b_ = VB * SHM_V + v_rd_off(d0, 0, 0); \
        TRRD(l0, b_); TRRD(h0, b_ + 2048); TRRD(l1, b_ + 4096); TRRD(h1, b_ + 6144); TRRD(l2, b_ + 8192); TRRD(h2, b_ + 10240); TRRD(l3, b_ + 12288); TRRD(h3, b_ + 14336); \
        asm volatile("s_waitcnt lgkmcnt(0)" ::: "memory"); SBAR();   \
        o[d0] = __builtin_amdgcn_mfma_f32_32x32x16_bf16(pa0, (bf16x8){l0[0], l0[1], l0[2], l0[3], h0[0], h0[1], h0[2], h0[3]}, o[d0], 0, 0, 0);   \
        o[d0] = __builtin_amdgcn_mfma_f32_32x32x16_bf16(pa1, (bf16x8){l1[0], l1[1], l1[2], l1[3], h1[0], h1[1], h1[2], h1[3]}, o[d0], 0, 0, 0);   \
        o[d0] = __builtin_amdgcn_mfma_f32_32x32x16_bf16(pa2, (bf16x8){l2[0], l2[1], l2[2], l2[3], h2[0], h2[1], h2[2], h2[3]}, o[d0], 0, 0, 0);   \
        o[d0] = __builtin_amdgcn_mfma_f32_32x32x16_bf16(pa3, (bf16x8){l3[0], l3[1], l3[2], l3[3], h3[0], h3[1], h3[2], h3[3]}, o[d0], 0, 0, 0); } while (0)
    PV_D0(0); PV_D0(1); PV_D0(2); PV_D0(3);
#undef PV_D0
#undef TRRD
}

struct BlockRef { int grp, b, h, qb; };
__device__ __forceinline__ size_t hm_off(const BlockRef& r) { return ((size_t)(r.b * NH + r.h) * SEQ) * D; }
__device__ __forceinline__ const bf16_t* ptrQ(unsigned char* wsb, const BlockRef& r) { return (const bf16_t*)(wsb + (r.grp ? WS_QB : WS_QA)) + hm_off(r) + (size_t)r.qb * QB * D; }
__device__ __forceinline__ const bf16_t* ptrK(unsigned char* wsb, const BlockRef& r) { return (const bf16_t*)(wsb + (r.grp ? WS_KB : WS_KA)) + hm_off(r); }
__device__ __forceinline__ const bf16_t* ptrV(unsigned char* wsb, const BlockRef& r) { return (const bf16_t*)(wsb + (r.grp ? WS_VB : WS_VA)) + hm_off(r); }
__device__ __forceinline__ const bf16_t* ptrZ(unsigned char* wsb, const BlockRef& r) { return (const bf16_t*)(wsb + (r.grp ? WS_SZB : WS_SZA)) + hm_off(r) + (size_t)r.qb * QB * D; }
struct Seam { bf16x8 qr[8]; bf16x8 st_v0, st_v1, st_k0, st_k1; };
#define ROW(p, k0, rr) ((const bf16_t*)((const char*)(p) + (unsigned)(((k0) + (rr)) * (D * 2) + sc * 2)))
#define VMW() asm volatile("s_waitcnt vmcnt(0)" ::: "memory")
#define VMWN(n) asm volatile("s_waitcnt vmcnt(%0)" :: "i"(n) : "memory")
#define SLOAD_H(Kp, Vp, k0) do { S.st_v0 = load8(ROW(Vp, k0, sr)); S.st_v1 = load8(ROW(Vp, k0, 32 + sr));              \
                         S.st_k0 = load8(ROW(Kp, k0, sr)); S.st_k1 = load8(ROW(Kp, k0, 32 + sr)); } while (0)
#define SWRITE_HK(bf) do { *(bf16x8*)(K_lds + (bf) * SHM_K + kws) = S.st_k0; *(bf16x8*)(K_lds + (bf) * SHM_K + kws + 32 * 256) = S.st_k1; } while (0)
#define SWRITE_HV(bf) do { *(bf16x8*)(V_lds + (bf) * SHM_V + vst0) = S.st_v0; *(bf16x8*)(V_lds + (bf) * SHM_V + vst1) = S.st_v1; } while (0)
#define SWRITE_H(bf) do { SWRITE_HV(bf); SWRITE_HK(bf); } while (0)
__device__ __forceinline__ void prime(const BlockRef& cur, unsigned char* wsb, char* lds, Seam& S) {
    int tid = threadIdx.x; asm volatile("" : "+v"(tid));
    const int wid = __builtin_amdgcn_readfirstlane(tid >> 6), lane = tid & 63, r32 = lane & 31, hi = lane >> 5;
    const int sr = tid >> 4, sc = (tid & 15) * 8, kws = KSWZ(sr, sc * 2); char* K_lds = lds + 2 * SHM_V;
    const bf16_t* Qp = ptrQ(wsb, cur); const bf16_t* Kp = ptrK(wsb, cur); const bf16_t* Vp = ptrV(wsb, cur);
    for (int d0 = 0; d0 < 8; ++d0) S.qr[d0] = load8(Qp + (size_t)(wid * QBLK + r32) * D + d0 * 16 + hi * 8);
    SLOAD_H(Kp, Vp, (4 * cur.qb + 3) * KVBLK); VMW(); SWRITE_HK(0);
    __syncthreads();
}
__device__ __forceinline__ void block(const BlockRef& cur, unsigned char* wsb, char* lds, Seam& S, float Bq) {
    const int GRP = cur.grp;
    int tid = threadIdx.x; asm volatile("" : "+v"(tid));
    const int wid = __builtin_amdgcn_readfirstlane(tid >> 6), lane = tid & 63, r32 = lane & 31, hi = lane >> 5;
    const int NT = 4 * cur.qb + 4;
    const int qlo = cur.qb * QB + wid * QBLK, qm = qlo + r32 - 4 * hi;
    char* V_lds = lds; char* K_lds = lds + 2 * SHM_V;
    float* ws = (float*)(lds + LDS_WS) + wid * 64; float* li_l = ws, * al_l = ws + 32;
    float m_reg = -1e30f, l_reg = 0; f32x16 o[4] = {};
    const int sr = tid >> 4, sc = (tid & 15) * 8, vst0 = v_st(sr, sc), vst1 = v_st(32 + sr, sc), kws = KSWZ(sr, sc * 2);
    const int vb0 = (int)(uintptr_t)V_lds + v_rd_base(lane);
    const bf16_t* Kh = ptrK(wsb, cur); const bf16_t* Vh = ptrV(wsb, cur);
    const float sl = exp2f(-(float)(cur.h + 1)) * 11.313708498984761f;
    unsigned selbits = 0xffu;
    if (GRP == 1) {
        float* km = (float*)(lds + LDS_KM);
        const float* KM = (const float*)(wsb + WS_KMEAN) + ((size_t)(cur.b * NBLK) * NH + cur.h) * 128;
        if (tid < cur.qb * 32) { const int n = tid >> 5, c4 = (tid & 31) * 4; *(f32x4*)(km + n * 128 + c4) = *(const f32x4*)(KM + (size_t)n * (NH * 128) + c4); }
        __syncthreads();
        float v1 = -__builtin_inff(), v2 = v1, v3 = v1; int i1 = 31, i2 = 31, i3 = 31;
#pragma unroll 1
        for (int n = 0; n < cur.qb; ++n) { float a = 0.f;
#pragma unroll
            for (int d0 = 0; d0 < 8; ++d0) { const f32x4 k0 = *(const f32x4*)(km + n * 128 + d0 * 16 + hi * 8), k1 = *(const f32x4*)(km + n * 128 + d0 * 16 + hi * 8 + 4);
                const bf16x8 q = S.qr[d0];
                a += bf2f((bf16_t)q[0]) * k0[0] + bf2f((bf16_t)q[1]) * k0[1] + bf2f((bf16_t)q[2]) * k0[2] + bf2f((bf16_t)q[3]) * k0[3]
                   + bf2f((bf16_t)q[4]) * k1[0] + bf2f((bf16_t)q[5]) * k1[1] + bf2f((bf16_t)q[6]) * k1[2] + bf2f((bf16_t)q[7]) * k1[3]; }
            const float other = __shfl_xor(a, 32); const float g = a + other;
            const bool c1 = g > v1, c2 = g > v2, c3 = g > v3;
            v3 = c2 ? v2 : (c3 ? g : v3); i3 = c2 ? i2 : (c3 ? n : i3);
            v2 = c1 ? v1 : (c2 ? g : v2); i2 = c1 ? i1 : (c2 ? n : i2);
            v1 = c1 ? g : v1;             i1 = c1 ? n : i1; }
        selbits = ((1u << i1) | (1u << i2) | (1u << i3)) & 0xffu;
    }
    const char* mst = lds + LDS_OST + wid * MST_WAVE + r32 * MST_PITCH;
    if (GRP == 0) {
        const char* src = (const char*)(wsb + WS_MASK) + ((size_t)cur.b * SEQ + qlo) * 256 + (unsigned)(r32 * 256 + hi * 128);
        u32x4 tmp[8];
#pragma unroll
        for (int i = 0; i < 8; ++i) tmp[i] = *(const u32x4*)(src + 16 * i);
#pragma unroll
        for (int i = 0; i < 8; ++i) { unsigned long long* d = (unsigned long long*)(mst + hi * 128 + 16 * i);
            d[0] = (unsigned long long)tmp[i][0] | ((unsigned long long)tmp[i][1] << 32); d[1] = (unsigned long long)tmp[i][2] | ((unsigned long long)tmp[i][3] << 32); }
    }
#define RESC(a) do { if (__any((a) < 1.f)) { if (hi == 0) al_l[r32] = (a); asm volatile("s_waitcnt lgkmcnt(0)" ::: "memory");              \
                     for (int d_ = 0; d_ < 4; ++d_) for (int r = 0; r < 16; ++r) o[d_][r] *= al_l[crow(r, hi)]; } } while (0)
#define TIX(u) (NT - 1 - (u))
#define KBASE(u) (TIX(u) * KVBLK)
#define CB(u) ((GRP == 1 && TIX(u) < 4 * cur.qb && !((selbits >> (TIX(u) >> 2)) & 1u)) ? -__builtin_inff() : sl * (float)(KBASE(u) - qm))
#define MLOAD(u) ((GRP == 0) ? *(const unsigned long long*)(mst + TIX(u) * 8) : 0ull)
    constexpr float C2_ = 1.4426950408889634f * SCALE;
#define ACT(u) (!((qlo - KBASE(u) - (KVBLK - 1)) > 0 && __all((Bq - sl * (float)(qlo - KBASE(u) - (KVBLK - 1)) - m_reg) * C2_ < -160.f)))
#define MASKT(P0_, P1_, t, mw) do { const int kb_ = KBASE(t); \
        if (GRP == 0) { mask_bits(P0_, P1_, ((unsigned)(mw)) >> (4 * hi), ((unsigned)((mw) >> 32)) >> (4 * hi)); } \
        else if (kb_ + KVBLK - 1 > qlo) mask_causal(P0_, P1_, qm - kb_); } while (0)
    f32x16 pA0, pA1, pB0, pB1; float mnA, mnB, alA = 1.f, alB = 1.f;
    unsigned long long mwA, mwB; bool actA = true, actB = true;
    volatile unsigned* vote = (volatile unsigned*)(lds + LDS_KM + 4096 + 64);
    SWRITE_HV(0); SBAR();
    if (NT > 1) SLOAD_H(Kh, Vh, KBASE(1));
    mwA = MLOAD(0);
    SBAR(); qkt<0>(pA0, pA1, K_lds, r32, hi, S.qr, CB(0), sl, true);
    MASKT(pA0, pA1, 0, mwA); partialSM(pA0, pA1, m_reg, mnA, alA);
    if (NT > 1) { VMW(); SWRITE_H(1); }
    __syncthreads();
#define HALF_STEP(PX0, PX1, mnX, alX, mwX, actX, PY0, PY1, alY, actY, t, KB, VB, SB) do {                                     \
        actX = ACT(t);                                                                                                        \
        SBAR(); qkt<KB>(PX0, PX1, K_lds, r32, hi, S.qr, CB(t), sl, actX); SBAR();                                             \
        if ((t) + 1 < NT) { SLOAD_H(Kh, Vh, KBASE((t) + 1)); SBAR(); }                                                        \
        mwX = MLOAD(t);                                                                                                       \
        if (actY) { bf16x8 pa0, pa1, pa2, pa3; finishSM(PY0, PY1, alY, l_reg, pa0, pa1, pa2, pa3); SBAR(); pv_tile<VB>(o, vb0, pa0, pa1, pa2, pa3, true); } \
        alX = 1.f; if (actX) { MASKT(PX0, PX1, (t), mwX); partialSM(PX0, PX1, m_reg, mnX, alX); }                             \
        __syncthreads();                                                                                                      \
        if ((t) + 1 < NT) { VMW(); SWRITE_H(SB); }                                                                            \
        RESC(alX); } while (0)
    for (int t = 1; t + 1 < NT; t += 2) {
        HALF_STEP(pB0, pB1, mnB, alB, mwB, actB, pA0, pA1, alA, actA, t, 1, 0, 0); __syncthreads();
        HALF_STEP(pA0, pA1, mnA, alA, mwA, actA, pB0, pB1, alB, actB, t + 1, 0, 1, 1);
        if (lane == 0 && actA) vote[(t >> 1) & 1] = 1u;
        __syncthreads();
        const unsigned any_ = vote[(t >> 1) & 1];
        if (tid == 0) vote[((t >> 1) & 1) ^ 1] = 0u;
        if (!any_) break;
    }
    actB = ACT(NT - 1); SBAR(); qkt<1>(pB0, pB1, K_lds, r32, hi, S.qr, CB(NT - 1), sl, actB); SBAR(); mwB = MLOAD(NT - 1);
    if (actA) { bf16x8 pa0, pa1, pa2, pa3; finishSM(pA0, pA1, alA, l_reg, pa0, pa1, pa2, pa3); SBAR(); pv_tile<0>(o, vb0, pa0, pa1, pa2, pa3, true); }
    alB = 1.f; if (actB) { MASKT(pB0, pB1, NT - 1, mwB); partialSM(pB0, pB1, m_reg, mnB, alB); } __syncthreads(); RESC(alB);
    if (actB) { bf16x8 pa0, pa1, pa2, pa3; finishSM(pB0, pB1, alB, l_reg, pa0, pa1, pa2, pa3); SBAR(); pv_tile<1>(o, vb0, pa0, pa1, pa2, pa3, true); }
    if (hi == 0) li_l[r32] = l_reg; asm volatile("s_waitcnt lgkmcnt(0)" ::: "memory");
    float rli[16];
#pragma unroll
    for (int r = 0; r < 16; ++r) rli[r] = __builtin_amdgcn_rcpf(li_l[crow(r, hi)]);
    { bf16_t* stg = (bf16_t*)(lds + LDS_OST) + wid * (QBLK * D);
      int lane_e = lane; asm volatile("" : "+v"(lane_e));
      bf16_t* stw = stg + (4 * (lane_e >> 5)) * D + (lane_e & 31);
#pragma unroll
      for (int r = 0; r < 16; ++r) { const int orow = (r & 3) + 8 * (r >> 2);
#pragma unroll
          for (int d0 = 0; d0 < 4; ++d0) stw[orow * D + d0 * 32] = (bf16_t)cvt1(o[d0][r] * rli[r]); }
      asm volatile("s_waitcnt lgkmcnt(0)" ::: "memory");
      char* Ow = (char*)(wsb + WS_Y8) + ((size_t)cur.b * SEQ + qlo) * 2048 + cur.grp * 1024 + cur.h * 128;
      const char* Zw = (const char*)(ptrZ(wsb, cur) + (size_t)(wid * QBLK) * D);
      const unsigned eo = (unsigned)((lane_e >> 4) * 256 + (lane_e & 15) * 16), yo = (unsigned)((lane_e >> 4) * 2048 + (lane_e & 15) * 8);
#pragma unroll
      for (int i = 0; i < 8; ++i) {
          const u32x4 ov = *(const u32x4*)((const char*)stg + (eo + (unsigned)(i * 1024))), zv = *(const u32x4*)(Zw + (eo + (unsigned)(i * 1024))); float f[8];
#pragma unroll
          for (int j = 0; j < 4; ++j) { f[2 * j] = __uint_as_float(ov[j] << 16) * __uint_as_float(zv[j] << 16) * 8.f; f[2 * j + 1] = __uint_as_float(ov[j] & 0xffff0000u) * __uint_as_float(zv[j] & 0xffff0000u) * 8.f; }
          const unsigned long long w = (unsigned long long)pk4_fp8(f[0], f[1], f[2], f[3]) | ((unsigned long long)pk4_fp8(f[4], f[5], f[6], f[7]) << 32);
          *(unsigned long long*)(Ow + (yo + (unsigned)(i * 8192))) = w; } }
    __syncthreads();
#undef RESC
#undef TIX
#undef ACT
#undef KBASE
#undef CB
#undef MLOAD
#undef MASKT
#undef HALF_STEP
}
#undef ROW
#undef VMW
#undef VMWN
#undef SLOAD_H
#undef SWRITE_HK
#undef SWRITE_HV
#undef SWRITE_H
struct ClassOrder { unsigned char v[64]; };
constexpr int class_cost(int c) { const int h = c >> 3, qb = c & 7, full = 4 * qb + 4, cap = h == 0 ? 10 : h == 1 ? 14 : h == 2 ? 22 : 32; return full < cap ? full : cap; }
constexpr ClassOrder make_order() { ClassOrder o{}; for (int i = 0; i < 64; ++i) o.v[i] = (unsigned char)i;
    for (int i = 1; i < 64; ++i) { const unsigned char x = o.v[i]; int j = i - 1; while (j >= 0 && class_cost(o.v[j]) < class_cost(x)) { o.v[j + 1] = o.v[j]; --j; } o.v[j + 1] = x; }
    return o; }
__device__ __forceinline__ void decode(int p, BlockRef& r) { constexpr ClassOrder ORD = make_order(); const int c = ORD.v[p >> 4], m = p & 15; r.h = c >> 3; r.qb = c & 7; r.grp = m >> 3; r.b = m & 7; }
__device__ __forceinline__ void attn_phase(char* lds, unsigned char* wsb, int v, int G) {
    const int tid = threadIdx.x, lane = tid & 63;
    float BqG[2];
    { const float* G_ = (const float*)(wsb + WS_GAIN);
#pragma unroll
      for (int gsel = 0; gsel < 2; ++gsel) { const float* gq = G_ + gsel * 256; const float* gk = gq + 128;
          float mq = fmaxf(fabsf(gq[lane]), fabsf(gq[lane + 64])), mk = fmaxf(fabsf(gk[lane]), fabsf(gk[lane + 64]));
          mq = wave_max(mq); mk = wave_max(mk); BqG[gsel] = __uint_as_float(__builtin_amdgcn_readfirstlane(__float_as_uint(128.f * 1.02f * mq * mk))); } }
    if (tid == 0) { ((volatile unsigned*)(lds + LDS_KM + 4096 + 64))[0] = 0u; ((volatile unsigned*)(lds + LDS_KM + 4096 + 64))[1] = 0u; }
    Seam S;
    for (int r = 0; r * G < 1024; ++r) {
        const int p = r * G + ((r & 1) ? G - 1 - v : v); if (p >= 1024) continue;
        BlockRef cur; decode(p, cur);
        prime(cur, wsb, lds, S);
        block(cur, wsb, lds, S, cur.grp ? BqG[1] : BqG[0]);
    }
}
#undef KSWZ
#undef SBAR
}

namespace sel {
#define SLAS __attribute__((address_space(3)))
typedef short bf16x8 __attribute__((ext_vector_type(8)));
typedef float f32x16 __attribute__((ext_vector_type(16)));
typedef float f32x4 __attribute__((ext_vector_type(4)));
typedef unsigned u32x4 __attribute__((ext_vector_type(4)));
constexpr int KB_OFF = 131072;
constexpr int LIST_OFF = 147456 + 2048;
__device__ __forceinline__ unsigned fkey(float x) { const unsigned b = __float_as_uint(x); return (b & 0x80000000u) ? ~b : (b | 0x80000000u); }
__device__ __forceinline__ void unit(SLAS unsigned char* lds, unsigned char* wsb, int b, int rg) {
    const int tid = threadIdx.x, wid = __builtin_amdgcn_readfirstlane(tid >> 6), lane = tid & 63, j = lane & 31, g = lane >> 5;
    const bf16_t* QI = (const bf16_t*)(wsb + WS_QI); const char* KIb = (const char*)((const bf16_t*)(wsb + WS_KI) + (size_t)b * SEQ * 64); const float* WI = (const float*)(wsb + WS_WI);
    unsigned long long* MASK = (unsigned long long*)(wsb + WS_MASK);
    const int ta = 16 * rg + 2 * wid, t = ta + g;
    const int nkeys = 16 * rg + 16, nk32 = (nkeys + 31) >> 5, nch = (nkeys + 63) >> 6;
    SLAS float* sc = (SLAS float*)lds + (wid * 2 + g) * 2048 + j;
    float vmin = __builtin_inff(), vmax = -__builtin_inff();
    bf16x8 af[4];
    { const int i = lane & 31, tok = (i >> 2) & 1, head = (i & 3) + 4 * (i >> 3);
      const bf16_t* qp = QI + ((size_t)b * SEQ + ta + tok) * 1024 + head * 64 + 8 * (lane >> 5);
#pragma unroll
      for (int ks = 0; ks < 4; ++ks) af[ks] = *(const bf16x8*)(qp + 16 * ks); }
    float wv[16];
    { const float* wp = WI + ((size_t)b * SEQ + t) * 16;
#pragma unroll
      for (int q4 = 0; q4 < 4; ++q4) { const f32x4 w4 = *(const f32x4*)(wp + 4 * q4); wv[4 * q4] = w4[0] * 0.03125f; wv[4 * q4 + 1] = w4[1] * 0.03125f; wv[4 * q4 + 2] = w4[2] * 0.03125f; wv[4 * q4 + 3] = w4[3] * 0.03125f; } }
    const int srow = tid >> 3, scol = tid & 7, swr = srow * 128 + ((scol ^ ((srow >> 1) & 7)) << 4);
    int koff[4];
#pragma unroll
    for (int ks = 0; ks < 4; ++ks) koff[ks] = j * 128 + (((2 * ks + g) ^ ((j >> 1) & 7)) << 4);
    u32x4 stA = *(const u32x4*)(KIb + (unsigned)(tid * 16)), stB = stA;
    *(SLAS u32x4*)(lds + KB_OFF + swr) = stA;
    stA = *(const u32x4*)(KIb + (unsigned)(min(1, nch - 1) * 8192 + tid * 16));
    stB = *(const u32x4*)(KIb + (unsigned)(min(2, nch - 1) * 8192 + tid * 16));
    __syncthreads();
#define SEL_EPI(ACC, kt) do { float s0 = 0.f, s1 = 0.f, s2 = 0.f, s3 = 0.f; \
        _Pragma("unroll") for (int r = 0; r < 4; ++r) { s0 = fmaf(wv[r], fmaxf(ACC[r], 0.f), s0); s1 = fmaf(wv[4 + r], fmaxf(ACC[4 + r], 0.f), s1); \
                                                       s2 = fmaf(wv[8 + r], fmaxf(ACC[8 + r], 0.f), s2); s3 = fmaf(wv[12 + r], fmaxf(ACC[12 + r], 0.f), s3); } \
        const float s = (s0 + s1) + (s2 + s3); \
        if (32 * (kt) + j <= t) { vmin = fminf(vmin, s); vmax = fmaxf(vmax, s); }     \
        sc[32 * (kt)] = s; } while (0)
#define SEL_TILES(cc) do { SLAS unsigned char* kb = lds + KB_OFF + ((cc) & 1) * 8192; const int kt0 = 2 * (cc); \
        if (kt0 + 1 < nk32) {                                  \
            f32x16 acc0 = {}, acc1 = {}; \
            _Pragma("unroll") for (int ks = 0; ks < 4; ++ks) { const bf16x8 b0 = *(const SLAS bf16x8*)(kb + koff[ks]), b1 = *(const SLAS bf16x8*)(kb + 4096 + koff[ks]); \
                acc0 = __builtin_amdgcn_mfma_f32_32x32x16_bf16(af[ks], b0, acc0, 0, 0, 0); acc1 = __builtin_amdgcn_mfma_f32_32x32x16_bf16(af[ks], b1, acc1, 0, 0, 0); } \
            SEL_EPI(acc0, kt0); SEL_EPI(acc1, kt0 + 1); \
        } else if (kt0 < nk32) { f32x16 acc0 = {}; \
            _Pragma("unroll") for (int ks = 0; ks < 4; ++ks) { const bf16x8 b0 = *(const SLAS bf16x8*)(kb + koff[ks]); acc0 = __builtin_amdgcn_mfma_f32_32x32x16_bf16(af[ks], b0, acc0, 0, 0, 0); } \
            SEL_EPI(acc0, kt0); } } while (0)
#pragma unroll 1
    for (int c = 0; c < nch; c += 2) {
        SEL_TILES(c);
        *(SLAS u32x4*)(lds + KB_OFF + 8192 + swr) = stA; stA = *(const u32x4*)(KIb + (unsigned)(min(c + 3, nch - 1) * 8192 + tid * 16));
        __syncthreads();
        SEL_TILES(c + 1);
        *(SLAS u32x4*)(lds + KB_OFF + swr) = stB; stB = *(const u32x4*)(KIb + (unsigned)(min(c + 4, nch - 1) * 8192 + tid * 16));
        __syncthreads();
    }
#undef SEL_TILES
#undef SEL_EPI
    unsigned T = 0u; int need = 0; bool ties = false;
    if (16 * rg >= TOPK) {
        SLAS unsigned* hist = (SLAS unsigned*)(lds + KB_OFF) + (wid * 2 + g) * 256;
#pragma unroll
        for (int off = 1; off < 32; off <<= 1) { vmin = fminf(vmin, __shfl_xor(vmin, off)); vmax = fmaxf(vmax, __shfl_xor(vmax, off)); }
        const float range = vmax - vmin, inv = (range > 0.f) ? 255.99f / range : 0.f;
        *(SLAS u32x4*)(hist + 8 * j) = (u32x4){0u, 0u, 0u, 0u}; *(SLAS u32x4*)(hist + 8 * j + 4) = (u32x4){0u, 0u, 0u, 0u};
#pragma unroll 1
        for (int kt0 = 0; kt0 < nk32; kt0 += 4) { float x[4];
#pragma unroll
            for (int i = 0; i < 4; ++i) x[i] = sc[32 * (kt0 + i)];
#pragma unroll
            for (int i = 0; i < 4; ++i) if (32 * (kt0 + i) + j <= t) { const int q = min((int)((x[i] - vmin) * inv), 255); __hip_atomic_fetch_add(hist + q, 1u, __ATOMIC_RELAXED, __HIP_MEMORY_SCOPE_WORKGROUP); } }
        asm volatile("s_waitcnt lgkmcnt(0)" ::: "memory");
        int qsel, cB;
        { const u32x4 c0 = *(const SLAS u32x4*)(hist + 8 * j), c1 = *(const SLAS u32x4*)(hist + 8 * j + 4);
          const int cnt[8] = {(int)c0[0], (int)c0[1], (int)c0[2], (int)c0[3], (int)c1[0], (int)c1[1], (int)c1[2], (int)c1[3]};
          const int s = ((cnt[0] + cnt[1]) + (cnt[2] + cnt[3])) + ((cnt[4] + cnt[5]) + (cnt[6] + cnt[7]));
          int S = s;
#pragma unroll
          for (int off = 1; off < 32; off <<= 1) { const int v = __shfl_down(S, off, 32); if (j + off < 32) S += v; }
          const int above = S - s;
          const bool found = (S >= TOPK) && (above < TOPK);
          int dsel = 0, nneed = 0, csel = 0;
          { const int rem = TOPK - above; int cum = 0; bool done = false;
#pragma unroll
            for (int i = 7; i >= 0; --i) { const int before = cum; cum += cnt[i]; if (!done && cum >= rem) { done = true; dsel = 8 * j + i; nneed = rem - before; csel = cnt[i]; } } }
          const unsigned long long bm = __ballot(found);
          const int src = 32 * g + __builtin_ctz((unsigned)(bm >> (32 * g)) | 0x80000000u);
          qsel = __shfl(dsel, src); need = __shfl(nneed, src); cB = __shfl(csel, src); }
        if (!__any(cB > 64)) {
            SLAS unsigned* list = (SLAS unsigned*)(lds + LIST_OFF) + (wid * 2 + g) * 128;
            int base = 0;
#pragma unroll 1
            for (int kt0 = 0; kt0 < nk32; kt0 += 4) { float x[4];
#pragma unroll
                for (int i = 0; i < 4; ++i) x[i] = sc[32 * (kt0 + i)];
#pragma unroll
                for (int i = 0; i < 4; ++i) { const int kt = kt0 + i;
                    const bool m = (32 * kt + j <= t) && (min((int)((x[i] - vmin) * inv), 255) == qsel);
                    const unsigned long long bal = __ballot(m); const unsigned hm = g ? (unsigned)(bal >> 32) : (unsigned)bal;
                    if (m) { const int pos = base + __builtin_popcount(hm & ((1u << j) - 1u)); list[2 * pos] = fkey(x[i]); list[2 * pos + 1] = (unsigned)(32 * kt + j); }
                    base += __builtin_popcount(hm); } }
            asm volatile("s_waitcnt lgkmcnt(0)" ::: "memory");
            const unsigned u0 = list[2 * j], i0 = list[2 * j + 1], u1 = list[2 * (j + 32)], i1 = list[2 * (j + 32) + 1];
            int r0 = 0, r1 = 0; const int cmax = max(cB, __shfl_xor(cB, 32));
#pragma unroll 1
            for (int e = 0; e < cmax; ++e) { const unsigned ue = list[2 * e], ie = list[2 * e + 1]; const bool in = e < cB;
                r0 += (in && (ue > u0 || (ue == u0 && ie < i0))) ? 1 : 0; r1 += (in && (ue > u1 || (ue == u1 && ie < i1))) ? 1 : 0; }
            const bool h0 = (j < cB) && (r0 == need - 1), h1 = (j + 32 < cB) && (r1 == need - 1);
            const unsigned long long bh = __ballot(h0 || h1);
            const int src = 32 * g + __builtin_ctz((unsigned)(bh >> (32 * g)) | 0x80000000u);
            T = __shfl(h0 ? u0 : u1, src);
            const unsigned long long bg0 = __ballot(j < cB && u0 > T), bg1 = __ballot(j + 32 < cB && u1 > T), be0 = __ballot(j < cB && u0 == T), be1 = __ballot(j + 32 < cB && u1 == T);
            const int ngt = __builtin_popcount(g ? (unsigned)(bg0 >> 32) : (unsigned)bg0) + __builtin_popcount(g ? (unsigned)(bg1 >> 32) : (unsigned)bg1);
            const int neq = __builtin_popcount(g ? (unsigned)(be0 >> 32) : (unsigned)be0) + __builtin_popcount(g ? (unsigned)(be1 >> 32) : (unsigned)be1);
            need = need - ngt; ties = (neq != need);
        } else {
            unsigned prefix = 0u; need = TOPK; int ceq = 0;
#pragma unroll 1
            for (int p = 0; p < 4; ++p) { const int shift = 24 - 8 * p;
                *(SLAS u32x4*)(hist + 8 * j) = (u32x4){0u, 0u, 0u, 0u}; *(SLAS u32x4*)(hist + 8 * j + 4) = (u32x4){0u, 0u, 0u, 0u};
                const unsigned phi = prefix >> ((shift + 8) & 31);
#pragma unroll 1
                for (int kt = 0; kt < nk32; ++kt) { const unsigned x = fkey(sc[32 * kt]);
                    const bool match = (32 * kt + j <= t) && ((p == 0) || ((x >> ((shift + 8) & 31)) == phi));
                    if (match) __hip_atomic_fetch_add(hist + ((x >> shift) & 255u), 1u, __ATOMIC_RELAXED, __HIP_MEMORY_SCOPE_WORKGROUP); }
                asm volatile("s_waitcnt lgkmcnt(0)" ::: "memory");
                const u32x4 c0 = *(const SLAS u32x4*)(hist + 8 * j), c1 = *(const SLAS u32x4*)(hist + 8 * j + 4);
                const int cnt[8] = {(int)c0[0], (int)c0[1], (int)c0[2], (int)c0[3], (int)c1[0], (int)c1[1], (int)c1[2], (int)c1[3]};
                const int s = ((cnt[0] + cnt[1]) + (cnt[2] + cnt[3])) + ((cnt[4] + cnt[5]) + (cnt[6] + cnt[7]));
                int S = s;
#pragma unroll
                for (int off = 1; off < 32; off <<= 1) { const int v = __shfl_down(S, off, 32); if (j + off < 32) S += v; }
                const int above = S - s;
                const bool found = (S >= need) && (above < need);
                int dsel = 0, nneed = 0, csel = 0;
                { const int rem = need - above; int cum = 0; bool done = false;
#pragma unroll
                  for (int i = 7; i >= 0; --i) { const int before = cum; cum += cnt[i]; if (!done && cum >= rem) { done = true; dsel = 8 * j + i; nneed = rem - before; csel = cnt[i]; } } }
                const unsigned long long bm = __ballot(found);
                const int src = 32 * g + __builtin_ctz((unsigned)(bm >> (32 * g)) | 0x80000000u);
                const int digit = __shfl(dsel, src); need = __shfl(nneed, src); ceq = __shfl(csel, src);
                prefix |= (unsigned)digit << shift;
            }
            T = prefix; ties = (ceq != need);
        }
    }
    unsigned wlo = 0u, whi = 0u;
    if (!__any(ties)) {
#pragma unroll 4
        for (int k64 = 0; k64 < 32; ++k64) {
            const bool s0 = (64 * k64 + j <= t) && (fkey(sc[64 * k64]) >= T), s1 = (64 * k64 + 32 + j <= t) && (fkey(sc[64 * k64 + 32]) >= T);
            const unsigned long long b0 = __ballot(s0), b1 = __ballot(s1);
            const unsigned lo = g ? (unsigned)(b0 >> 32) : (unsigned)b0, hi = g ? (unsigned)(b1 >> 32) : (unsigned)b1;
            if (j == k64) { wlo = lo; whi = hi; } }
    } else {
        int base = 0;
#pragma unroll 1
        for (int k64 = 0; k64 < 32; ++k64) { unsigned lo = 0u, hi = 0u;
#pragma unroll
            for (int hh = 0; hh < 2; ++hh) { const bool vld = (64 * k64 + 32 * hh + j <= t); const unsigned x = vld ? fkey(sc[64 * k64 + 32 * hh]) : 0u;
                const unsigned long long be = __ballot(vld && x == T); const unsigned em = g ? (unsigned)(be >> 32) : (unsigned)be;
                const int rank = base + __builtin_popcount(em & ((1u << j) - 1u));
                const bool s1 = vld && ((x > T) || (x == T && rank < need));
                base += __builtin_popcount(em);
                const unsigned long long bs = __ballot(s1); const unsigned sm = g ? (unsigned)(bs >> 32) : (unsigned)bs;
                if (hh == 0) lo = sm; else hi = sm; }
            if (j == k64) { wlo = lo; whi = hi; } }
    }
    MASK[((size_t)b * SEQ + t) * 32 + j] = (unsigned long long)wlo | ((unsigned long long)whi << 32);
    __syncthreads();
}
__device__ __forceinline__ void kmean_unit(SLAS unsigned char* lds, unsigned char* wsb, int b, int n, int h) {
    const int tid = threadIdx.x, d4 = tid & 31, rs = tid >> 5;
    const bf16_t* KB = (const bf16_t*)(wsb + WS_KB) + (((size_t)(b * NH + h) * SEQ) + n * 256) * 128;
    float a0 = 0.f, a1 = 0.f, a2 = 0.f, a3 = 0.f;
#pragma unroll 4
    for (int r = 0; r < 16; ++r) { const unsigned long long v = *(const unsigned long long*)(KB + (size_t)(rs * 16 + r) * 128 + d4 * 4);
        const unsigned lo = (unsigned)v, hi = (unsigned)(v >> 32);
        a0 += __uint_as_float(lo << 16); a1 += __uint_as_float(lo & 0xffff0000u); a2 += __uint_as_float(hi << 16); a3 += __uint_as_float(hi & 0xffff0000u); }
    SLAS float* red = (SLAS float*)lds;
    *(SLAS f32x4*)(red + rs * 128 + d4 * 4) = (f32x4){a0, a1, a2, a3};
    __syncthreads();
    if (tid < 128) { float s = 0.f;
#pragma unroll
        for (int q = 0; q < 16; ++q) s += red[q * 128 + tid];
        ((float*)(wsb + WS_KMEAN))[((size_t)(b * NBLK + n) * NH + h) * 128 + tid] = s * (1.f / 256.f); }
    __syncthreads();
}
__device__ __forceinline__ void select_phase(SLAS unsigned char* lds, unsigned char* wsb, int v, int G) {
    for (int L = v; L < 512; L += G) kmean_unit(lds, wsb, L >> 6, (L >> 3) & 7, L & 7);
    for (int L = v; L < 512; L += G) { const int b = L >> 6, x = L & 63;
        unit(lds, wsb, b, x);
        unit(lds, wsb, b, 127 - x); }
}
#undef SLAS
}

struct Args { const float* in[12]; float* out; unsigned char* ws; int ph_lo, ph_hi, li, pad; };
__global__ void __launch_bounds__(NWAVES * 64, 2) mega_fwd(Args args) {
    extern __shared__ __attribute__((aligned(16))) unsigned char lds[];
    Frame F;
    F.lds = (LAS unsigned char*)lds; F.MISC = (volatile LAS unsigned*)(F.lds + MISC_OFF);
    F.tid = threadIdx.x; F.lane = F.tid & 63; F.wave = __builtin_amdgcn_readfirstlane(F.tid >> 6);
    F.G = gridDim.x; { const int bx = blockIdx.x; F.vcu = (F.G % 8 == 0) ? (bx % 8) * (F.G / 8) + bx / 8 : bx; }
    unsigned char* ws = args.ws;
    F.ctl = (gu32*)(ws + WS_CTL);
    const float* x = args.in[0]; const float* c = args.in[1]; const float* w_ada = args.in[2]; const float* b_ada = args.in[3]; const float* g_norm = args.in[4];
    const float* w_in = args.in[5]; const float* w_out = args.in[11];
    float* MOD = (float*)(ws + WS_MOD); bf16_t* WinT = (bf16_t*)(ws + WS_WIN); bf16_t* HB = (bf16_t*)(ws + WS_HB); bf16_t* Y = (bf16_t*)(ws + WS_Y);
    for (int u = F.tid; u < (LDS_BYTES - LDSCTL_OFF) / 4; u += NWAVES * 64) ((LAS unsigned*)(F.lds + LDSCTL_OFF))[u] = 0u;
    __syncthreads();
    XcdBarrier bar = xcd_barrier_post((unsigned*)(F.ctl + CW_BAR) + args.li * XCD_BAR_WORDS, F.MISC + 8);
    const int lo = args.ph_lo, hi = args.ph_hi;
#define IN(k) (lo <= (k) && (k) < hi)
#define BOTH(k) (IN(k) && IN((k) + 1))
    if (IN(0)) for (int rep_ = 0; rep_ < (((PROBE_DOUBLE) >> 0) & 1) + 1; ++rep_) {
        if (rep_) __syncthreads();
        for (int id = (int)blockIdx.x; id < 256; id += F.G) p0_mod(F, id, c, w_ada, (float*)(ws + WS_MODP));
        if ((int)blockIdx.x == 192) { float* G = (float*)(ws + WS_GAIN);
            if (F.tid < 128) { G[F.tid] = args.in[6][F.tid]; G[128 + F.tid] = args.in[7][F.tid]; G[256 + F.tid] = args.in[9][F.tid]; G[384 + F.tid] = args.in[10][F.tid]; }
            if (F.tid < 64) G[512 + F.tid] = args.in[8][F.tid]; }
        p0_convert(F, w_in, w_out, WinT, ws + WS_WIN8, ws + WS_WOUT8);
    }
    if (BOTH(0)) xcd_barrier(bar);
    if (IN(1)) for (int rep_ = 0; rep_ < (((PROBE_DOUBLE) >> 1) & 1) + 1; ++rep_) p1_norm(F, x, g_norm, (const float*)(ws + WS_MODP), b_ada, MOD, HB, ws + WS_HB8);
    if (BOTH(1)) xcd_barrier(bar);
    if (IN(2)) for (int rep_ = 0; rep_ < (((PROBE_DOUBLE) >> 2) & 1) + 1; ++rep_) {
        { pg8::Gemm g{ws + WS_HB8, ws + WS_WIN8, M, 28 * 256, DM}; pg8::StaticOrder S; S.init(M, 28 * 256, F.G, (int)blockIdx.x, 0, 16, 9);
          EpiProj E{ws, (LAS float*)(F.lds + EPI_OFF), FP8_DESCALE};
          pg8::gemm_phase<EpiProj, pg8::StaticOrder, true, true, true>(F.lds, g, S, E); }
        { pg8::Gemm g{HB, WinT, M, 9 * 256, DM}; pg8::StaticOrder S; S.init(M, 9 * 256, F.G, (int)blockIdx.x, 16);
          EpiProj E{ws, (LAS float*)(F.lds + EPI_OFF), 1.f};
          pg8::gemm_phase<EpiProj, pg8::StaticOrder, true, true, false>(F.lds, g, S, E); }
    }
    if (BOTH(2)) xcd_barrier(bar);
    if (IN(3)) for (int rep_ = 0; rep_ < (((PROBE_DOUBLE) >> 3) & 1) + 1; ++rep_) sel::select_phase(F.lds, ws, F.vcu, F.G);
    if (BOTH(3)) xcd_barrier(bar);
    if (IN(4)) {
#pragma unroll 1
        for (int rep_ = 0; rep_ < (((PROBE_DOUBLE) >> 4) & 1) + 1; ++rep_) att::attn_phase((char*)lds, ws, F.vcu, F.G);
    }
    if (BOTH(4)) xcd_barrier(bar);
    if (IN(5)) for (int rep_ = 0; rep_ < (((PROBE_DOUBLE) >> 5) & 1) + 1; ++rep_) {
        pg8::Gemm g{ws + WS_Y8, ws + WS_WOUT8, M, DM, DM}; pg8::StaticOrder S; S.init(M, DM, F.G, (int)blockIdx.x);
        EpiOut E{x, MOD, args.out, FP8_DESCALE};
        pg8::gemm_phase<EpiOut, pg8::StaticOrder, true, true, true>(F.lds, g, S, E);
    }
#undef IN
#undef BOTH
}

static int mega_setup() {
    static int grid = 0;
    if (grid == 0) {
        int dev = 0, cus = 0;
        if (hipGetDevice(&dev) != hipSuccess || hipDeviceGetAttribute(&cus, hipDeviceAttributeMultiprocessorCount, dev) != hipSuccess) { fprintf(stderr, "kernel_launch: device query failed\n"); grid = -1; return grid; }
        if (hipFuncSetAttribute((const void*)mega_fwd, hipFuncAttributeMaxDynamicSharedMemorySize, LDS_BYTES) != hipSuccess) { fprintf(stderr, "kernel_launch: hipFuncSetAttribute failed\n"); grid = -1; return grid; }
        (void)hipGetLastError();
        grid = cus;
    }
    return grid;
}
static void mega_launch(int grid, void* const* d_in, void* d_out, void* d_ws, int ph_lo, int ph_hi, int li, hipStream_t stream) {
    Args a{};
    for (int i = 0; i < 12; ++i) a.in[i] = (const float*)d_in[i];
    a.out = (float*)d_out; a.ws = (unsigned char*)d_ws; a.ph_lo = ph_lo; a.ph_hi = ph_hi; a.li = li;
    hipLaunchKernelGGL(mega_fwd, dim3(grid), dim3(NWAVES * 64), LDS_BYTES, stream, a);
}

extern "C" void kernel_launch(void* const* d_in, const int* in_sizes, int n_in, void* d_out, int out_size, void* d_ws, size_t ws_size, hipStream_t stream) {
    if (n_in != 12 || in_sizes[0] != M * DM || out_size != M * DM || ws_size < WS_END) {
        fprintf(stderr, "kernel_launch: unexpected shapes (n_in %d, in0 %d, out %d, ws %zu); nothing launched\n", n_in, n_in > 0 ? in_sizes[0] : -1, out_size, ws_size); return; }
    const int grid = mega_setup(); if (grid <= 0) return;
    char* ws = (char*)d_ws;
    bf16_t* QA = (bf16_t*)(ws + WS_QA); bf16_t* KA = (bf16_t*)(ws + WS_KA); bf16_t* VA = (bf16_t*)(ws + WS_VA); bf16_t* SZA = (bf16_t*)(ws + WS_SZA);
    bf16_t* QB = (bf16_t*)(ws + WS_QB); bf16_t* KB = (bf16_t*)(ws + WS_KB); bf16_t* VB = (bf16_t*)(ws + WS_VB); bf16_t* SZB = (bf16_t*)(ws + WS_SZB);
    bf16_t* QI = (bf16_t*)(ws + WS_QI); bf16_t* KI = (bf16_t*)(ws + WS_KI); float* WI = (float*)(ws + WS_WI); float* KMEAN = (float*)(ws + WS_KMEAN);
    unsigned long long* MASKT = (unsigned long long*)(ws + WS_MASK); bf16_t* Y = (bf16_t*)(ws + WS_Y);
    (void)hipMemsetAsync(ws + WS_CTL, 0, CTL_ZERO_BYTES, stream);
#if NAIVE_SEL
    mega_launch(grid, d_in, d_out, d_ws, 0, 3, 0, stream);
    k_kmean<<<BATCH * NBLK * NH, 128, 0, stream>>>(KB, KMEAN);
    (void)hipMemsetAsync(MASKT, 0, 4 * MiB, stream);
    k_dsa_select_naive<<<dim3(SEQ, BATCH), 256, 0, stream>>>(QI, KI, WI, MASKT);
    mega_launch(grid, d_in, d_out, d_ws, 4, 6, 1, stream);
#else
    mega_launch(grid, d_in, d_out, d_ws, 0, 6, 0, stream);
#if PROBE_EXTRA >= 0
    mega_launch(grid, d_in, d_out, d_ws, PROBE_EXTRA, PROBE_EXTRA + 1, 1, stream);
#endif
#endif
}
```

```cpp
#include <hip/hip_runtime.h>
#include <cstdio>
#include <cstdint>

typedef unsigned short bf16_t;
#ifndef NAIVE_SEL
#define NAIVE_SEL 0
#endif
#ifndef PROBE_SEL
#define PROBE_SEL 0
#endif
#ifndef PROBE_EXTRA
#define PROBE_EXTRA -1
#endif
#ifndef PROBE_DOUBLE
#define PROBE_DOUBLE 0
#endif
constexpr int BATCH = 8, SEQ = 2048, DM = 2048, M = BATCH * SEQ, NH = 8, HD = 128, DA = 1024, IH = 16, ID = 64, DIN = 9296;
constexpr int TOPK = 256, NBLK = 8;
constexpr float RMS_EPS = 1e-6f;
constexpr float QK_SCALE = 0.08838834764831845f;

__device__ __forceinline__ float bf2f(bf16_t v) { return __uint_as_float(((unsigned)v) << 16); }
__device__ __forceinline__ bf16_t f2bf(float f) { unsigned u = __float_as_uint(f); return (bf16_t)((u + 0x7fffu + ((u >> 16) & 1u)) >> 16); }
__device__ __forceinline__ float rbf(float f) { return bf2f(f2bf(f)); }
__device__ __forceinline__ float silu_f(float v) { return v / (1.f + __expf(-v)); }
__device__ __forceinline__ size_t HM(int b, int h, int t, int d) { return (((size_t)(b * NH + h) * SEQ + t) * HD + d); }
__device__ __forceinline__ float wave_sum(float v) {
#pragma unroll
    for (int o = 1; o < 64; o <<= 1) v += __shfl_xor(v, o);
    return v;
}
__device__ __forceinline__ float wave_max(float v) {
#pragma unroll
    for (int o = 1; o < 64; o <<= 1) v = fmaxf(v, __shfl_xor(v, o));
    return v;
}
__device__ __forceinline__ void mask_pos(int t, int s, size_t& word, int& bit) { word = (size_t)t * 32 + (s >> 6); bit = s & 63; }

__global__ void k_mod(const float* __restrict__ c, const float* __restrict__ w_ada, const float* __restrict__ b_ada, float* __restrict__ MOD) {
    __shared__ float sc[DM];
    const int b = blockIdx.y, n = blockIdx.x * 256 + threadIdx.x;
    for (int k = threadIdx.x; k < DM; k += 256) sc[k] = silu_f(c[b * DM + k]);
    __syncthreads();
    float acc = 0.f;
    for (int k = 0; k < DM; ++k) acc += sc[k] * w_ada[(size_t)k * (3 * DM) + n];
    MOD[b * 3 * DM + n] = acc + b_ada[n];
}
__global__ void k_norm(const float* __restrict__ x, const float* __restrict__ g, const float* __restrict__ MOD, bf16_t* __restrict__ HB) {
    const int lane = threadIdx.x & 63, row = blockIdx.x * 4 + (threadIdx.x >> 6), b = row / SEQ;
    const float* xr = x + (size_t)row * DM;
    float ss = 0.f;
    for (int k = lane; k < DM; k += 64) { const float v = xr[k]; ss += v * v; }
    ss = wave_sum(ss);
    const float rstd = rsqrtf(ss / DM + RMS_EPS);
    const float* shift = MOD + b * 3 * DM; const float* scale = shift + DM;
    for (int k = lane; k < DM; k += 64) HB[(size_t)row * DM + k] = f2bf(xr[k] * rstd * g[k] * (1.f + scale[k]) + shift[k]);
}
template <int MODE>
__global__ void k_gemm_naive(const bf16_t* __restrict__ A, int K, const float* __restrict__ W, int ldw, int n0, int ncols,
                             float* __restrict__ C, int ldc, const float* __restrict__ xres, const float* __restrict__ MOD) {
    __shared__ float As[16][65], Bs[16][65];
    const int tid = threadIdx.x, tx = tid & 15, ty = tid >> 4, m0 = blockIdx.y * 64, c0 = blockIdx.x * 64;
    float acc[4][4] = {};
    for (int k0 = 0; k0 < K; k0 += 16) {
        for (int i = tid; i < 1024; i += 256) { const int r = i >> 4, kk = i & 15; As[kk][r] = bf2f(A[(size_t)(m0 + r) * K + k0 + kk]); }
        for (int i = tid; i < 1024; i += 256) { const int kk = i >> 6, cc = i & 63; Bs[kk][cc] = (c0 + cc < ncols) ? rbf(W[(size_t)(k0 + kk) * ldw + n0 + c0 + cc]) : 0.f; }
        __syncthreads();
#pragma unroll
        for (int kk = 0; kk < 16; ++kk) {
            float a[4], bb[4];
#pragma unroll
            for (int i = 0; i < 4; ++i) { a[i] = As[kk][ty * 4 + i]; bb[i] = Bs[kk][tx * 4 + i]; }
#pragma unroll
            for (int i = 0; i < 4; ++i)
#pragma unroll
                for (int j = 0; j < 4; ++j) acc[i][j] += a[i] * bb[j];
        }
        __syncthreads();
    }
#pragma unroll
    for (int i = 0; i < 4; ++i)
#pragma unroll
        for (int j = 0; j < 4; ++j) {
            const int m = m0 + ty * 4 + i, cc = c0 + tx * 4 + j;
            if (cc < ncols) {
                if (MODE == 0) C[(size_t)m * ldc + cc] = acc[i][j];
                else { const int b = m / SEQ; C[(size_t)m * ldc + cc] = xres[(size_t)m * ldc + cc] + MOD[b * 3 * DM + 2 * DM + cc] * acc[i][j]; }
            }
        }
}
__global__ void k_post(const float* __restrict__ T32, const float* __restrict__ gain, bf16_t* __restrict__ dst, int mode) {
    const int lane = threadIdx.x & 63, item = blockIdx.x * 4 + (threadIdx.x >> 6), m = item >> 3, h = item & 7, b = m / SEQ, t = m % SEQ;
    const float* src = T32 + (size_t)m * 1024 + h * 128;
    float v0 = src[lane], v1 = src[lane + 64];
    if (mode == 0) { const float ss = wave_sum(v0 * v0 + v1 * v1); const float rstd = rsqrtf(ss / 128.f + RMS_EPS); v0 = v0 * rstd * gain[lane]; v1 = v1 * rstd * gain[lane + 64]; }
    if (mode == 2) { v0 = silu_f(v0); v1 = silu_f(v1); }
    if (mode == 3) { dst[(size_t)m * 1024 + h * 128 + lane] = f2bf(v0); dst[(size_t)m * 1024 + h * 128 + lane + 64] = f2bf(v1); }
    else { dst[HM(b, h, t, lane)] = f2bf(v0); dst[HM(b, h, t, lane + 64)] = f2bf(v1); }
}
__global__ void k_post_idx(const float* __restrict__ T32, const float* __restrict__ gain, bf16_t* __restrict__ KI, float* __restrict__ WI) {
    const int lane = threadIdx.x & 63, m = blockIdx.x * 4 + (threadIdx.x >> 6);
    const float v = T32[(size_t)m * 80 + lane];
    const float ss = wave_sum(v * v); const float rstd = rsqrtf(ss / 64.f + RMS_EPS);
    KI[(size_t)m * 64 + lane] = f2bf(v * rstd * gain[lane]);
    if (lane < 16) WI[(size_t)m * 16 + lane] = T32[(size_t)m * 80 + 64 + lane];
}
__global__ void k_kmean(const bf16_t* __restrict__ KB, float* __restrict__ KMEAN) {
    const int d = threadIdx.x, h = blockIdx.x & 7, n = (blockIdx.x >> 3) & 7, b = blockIdx.x >> 6;
    float s = 0.f;
    for (int t = 0; t < 256; ++t) s += bf2f(KB[HM(b, h, n * 256 + t, d)]);
    KMEAN[((size_t)(b * NBLK + n) * NH + h) * HD + d] = s * (1.f / 256.f);
}
__global__ void k_dsa_select_naive(const bf16_t* __restrict__ QI, const bf16_t* __restrict__ KI, const float* __restrict__ WI, unsigned long long* __restrict__ MASKT) {
    const int t = blockIdx.x, b = blockIdx.y, tid = threadIdx.x; const size_t m = (size_t)b * SEQ + t;
    __shared__ float q[1024]; __shared__ float w[16]; __shared__ float sc[SEQ];
    for (int i = tid; i < 1024; i += 256) q[i] = bf2f(QI[m * 1024 + i]);
    if (tid < 16) w[tid] = WI[m * 16 + tid];
    __syncthreads();
    for (int s = tid; s <= t; s += 256) {
        float k[64];
        const bf16_t* kp = KI + ((size_t)b * SEQ + s) * 64;
#pragma unroll
        for (int d = 0; d < 64; ++d) k[d] = bf2f(kp[d]);
        float score = 0.f;
        for (int h = 0; h < 16; ++h) { float dot = 0.f;
#pragma unroll
            for (int d = 0; d < 64; ++d) dot += q[h * 64 + d] * k[d];
            score += w[h] * fmaxf(dot * 0.125f, 0.f); }
        sc[s] = score * 0.25f;
    }
    __syncthreads();
    for (int s = tid; s <= t; s += 256) {
        bool sel = true;
        if (t >= TOPK) { const float v = sc[s]; int cnt = 0; for (int s2 = 0; s2 <= t; ++s2) { const float u = sc[s2]; cnt += (u > v || (u == v && s2 < s)) ? 1 : 0; } sel = cnt < TOPK; }
        if (sel) { size_t word; int bit; mask_pos(t, s, word, bit); atomicOr(&MASKT[(size_t)b * 65536 + word], 1ull << bit); }
    }
}
__global__ void k_dsa_attn_naive(const bf16_t* __restrict__ QA, const bf16_t* __restrict__ KA, const bf16_t* __restrict__ VA, const bf16_t* __restrict__ SZA,
                                 const unsigned long long* __restrict__ MASKT, bf16_t* __restrict__ Y) {
    const int t = blockIdx.x, b = blockIdx.y, tid = threadIdx.x, lane = tid & 63, w = tid >> 6; const size_t m = (size_t)b * SEQ + t;
    __shared__ int idx[512]; __shared__ int nsel; __shared__ float qs[8][128]; __shared__ float p[4][256];
    if (tid == 0) nsel = 0;
    __syncthreads();
    for (int s = tid; s <= t; s += 256) { size_t word; int bit; mask_pos(t, s, word, bit);
        if ((MASKT[(size_t)b * 65536 + word] >> bit) & 1ull) { const int pos = atomicAdd(&nsel, 1); if (pos < 512) idx[pos] = s; } }
    for (int i = tid; i < 1024; i += 256) qs[i >> 7][i & 127] = bf2f(QA[HM(b, i >> 7, t, i & 127)]);
    __syncthreads();
    const int n = nsel < 256 ? nsel : 256;
    for (int hh = 0; hh < 2; ++hh) {
        const int h = w + 4 * hh; const float slope = exp2f(-(float)(h + 1));
        float sv[4]; float mx = -INFINITY;
#pragma unroll
        for (int i = 0; i < 4; ++i) { const int j = lane + 64 * i; sv[i] = -INFINITY;
            if (j < n) { const int s = idx[j]; const bf16_t* kp = KA + HM(b, h, s, 0); float dot = 0.f;
                for (int d = 0; d < 128; ++d) dot += qs[h][d] * bf2f(kp[d]);
                sv[i] = dot * QK_SCALE - slope * (float)(t - s); }
            mx = fmaxf(mx, sv[i]); }
        mx = wave_max(mx);
        float sum = 0.f;
#pragma unroll
        for (int i = 0; i < 4; ++i) { const int j = lane + 64 * i; const float pv = (j < n) ? __expf(sv[i] - mx) : 0.f; sum += pv; p[w][j] = pv; }
        sum = wave_sum(sum);
        __syncthreads();
        float o0 = 0.f, o1 = 0.f;
        for (int j = 0; j < n; ++j) { const float pj = p[w][j]; const int s = idx[j]; const unsigned vv = *(const unsigned*)(VA + HM(b, h, s, 2 * lane));
            o0 += pj * __uint_as_float(vv << 16); o1 += pj * __uint_as_float(vv & 0xffff0000u); }
        const float inv = 1.f / sum;
        const unsigned zz = *(const unsigned*)(SZA + HM(b, h, t, 2 * lane));
        o0 = o0 * inv * __uint_as_float(zz << 16); o1 = o1 * inv * __uint_as_float(zz & 0xffff0000u);
        *(unsigned*)(Y + m * 2048 + h * 128 + 2 * lane) = (unsigned)f2bf(o0) | ((unsigned)f2bf(o1) << 16);
        __syncthreads();
    }
}
__global__ void k_moba_naive(const bf16_t* __restrict__ QB, const bf16_t* __restrict__ KB, const bf16_t* __restrict__ VB, const bf16_t* __restrict__ SZB,
                             const float* __restrict__ KMEAN, bf16_t* __restrict__ Y) {
    const int t = blockIdx.x, b = blockIdx.y, tid = threadIdx.x, lane = tid & 63, w = tid >> 6; const size_t m = (size_t)b * SEQ + t;
    __shared__ float qs[8][128]; __shared__ float sc[4][SEQ];
    for (int i = tid; i < 1024; i += 256) qs[i >> 7][i & 127] = bf2f(QB[HM(b, i >> 7, t, i & 127)]);
    __syncthreads();
    const int qblk = t >> 8;
    for (int hh = 0; hh < 2; ++hh) {
        const int h = w + 4 * hh; const float slope = exp2f(-(float)(h + 1));
        float g = -INFINITY;
        if (lane < qblk) { const float* km = KMEAN + ((size_t)(b * NBLK + lane) * NH + h) * HD; float dot = 0.f; for (int d = 0; d < 128; ++d) dot += qs[h][d] * km[d]; g = dot; }
        int rank = 0;
        for (int n2 = 0; n2 < NBLK; ++n2) { const float g2 = __shfl(g, n2); if (n2 < qblk && (g2 > g || (g2 == g && n2 < lane))) ++rank; }
        const bool sel = (lane < qblk) && (rank < 3);
        const unsigned selmask = (unsigned)(__ballot(sel) & 0xffull);
        float mx = -INFINITY;
        for (int s = lane; s <= t; s += 64) { const int blk = s >> 8; float v = -INFINITY;
            if (blk == qblk || ((selmask >> blk) & 1u)) { const bf16_t* kp = KB + HM(b, h, s, 0); float dot = 0.f;
                for (int d = 0; d < 128; ++d) dot += qs[h][d] * bf2f(kp[d]);
                v = dot * QK_SCALE - slope * (float)(t - s); }
            sc[w][s] = v; mx = fmaxf(mx, v); }
        mx = wave_max(mx);
        float sum = 0.f;
        for (int s = lane; s <= t; s += 64) { const float v = sc[w][s]; const float pv = (v == -INFINITY) ? 0.f : __expf(v - mx); sc[w][s] = pv; sum += pv; }
        sum = wave_sum(sum);
        __syncthreads();
        float o0 = 0.f, o1 = 0.f;
        for (int s = 0; s <= t; ++s) { const float pj = sc[w][s]; if (pj == 0.f) continue; const unsigned vv = *(const unsigned*)(VB + HM(b, h, s, 2 * lane));
            o0 += pj * __uint_as_float(vv << 16); o1 += pj * __uint_as_float(vv & 0xffff0000u); }
        const float inv = 1.f / sum;
        const unsigned zz = *(const unsigned*)(SZB + HM(b, h, t, 2 * lane));
        o0 = o0 * inv * __uint_as_float(zz << 16); o1 = o1 * inv * __uint_as_float(zz & 0xffff0000u);
        *(unsigned*)(Y + m * 2048 + 1024 + h * 128 + 2 * lane) = (unsigned)f2bf(o0) | ((unsigned)f2bf(o1) << 16);
        __syncthreads();
    }
}

namespace pg8 {
#define PG8_LAS __attribute__((address_space(3)))
typedef unsigned short bf16_t;
typedef short bf16x8 __attribute__((ext_vector_type(8)));
typedef float f32x4 __attribute__((ext_vector_type(4)));
typedef unsigned u32x4 __attribute__((ext_vector_type(4)));
constexpr int BM = 256, BK = 64, HALF = 128, HTB = HALF * BK * 2  , STAGE_BYTES = 8 * HTB, NXCD = 8, WGM = 8;

__host__ __device__ __forceinline__ int lds_byte(int r, int c) { const int st = (r >> 4) * 2 + (c >> 5), rr = r & 15, cc = c & 31, ob = rr * 64 + cc * 2; return st * 1024 + (ob ^ (((ob >> 9) & 1) << 5)); }
__host__ __device__ __forceinline__ void stage_rc(int b, int& R, int& C) { const int st = b / 1024, sb = b % 1024, swz = sb ^ (((sb >> 9) & 1) << 5); R = (st >> 1) * 16 + swz / 64; C = (st & 1) * 32 + (swz % 64) / 2; }
__host__ __device__ __forceinline__ int perm32(int rho) { const int n = rho >> 4, i = rho & 15; return 8 * (i >> 2) + 4 * n + (i & 3); }

struct Unit { int pm, pn; };
struct Gemm { const void* A; const void* Bt; int M, N, K; };

struct StaticOrder {
    int nM, nN, nwg, G, c, jump_at, jump, base, skew;
    __host__ __device__ void init(int M, int N, int G_, int c_, int base_ = 0, int jump_at_ = 1 << 30, int jump_ = 0, int skew_ = 0) { nM = M / BM; nN = N / BM; nwg = nM * nN; G = G_; c = c_; base = base_; jump_at = jump_at_; jump = jump_; skew = skew_; }
    __host__ __device__ bool next(int i, Unit& u) const {
        long L = (long)i * G + c;
        if (skew > 0) { const int k = nwg / G;
            if (i == k - 1) { if (c < skew) return false; L = (long)(k - 1) * G + (c - skew); }
            else if (i == k) { if (c < G - skew) return false; L = (long)(k - 1) * G + (G - skew) + (c - (G - skew)); }
            else if (i > k) return false; }
        if (L >= nwg) return false;
        int wgid = (int)L; { const int q = nwg / NXCD, r = nwg % NXCD, xcd = wgid % NXCD, off = wgid / NXCD; wgid = (xcd < r ? xcd * (q + 1) : r * (q + 1) + (xcd - r) * q) + off; }
        const int nig = WGM * nN, gid = wgid / nig, fm = gid * WGM, gsz = (nM - fm) < WGM ? (nM - fm) : WGM;
        u.pm = fm + ((wgid % nig) % gsz); const int d = (wgid % nig) / gsz; u.pn = d + (d >= jump_at ? jump : base); return true;
    }
    __device__ __forceinline__ void a_ready(const Unit&) const {}
    __device__ __forceinline__ void done(const Unit&) const {}
};

template <class Epi, class Sched, bool ALIGN_EPI = false, bool SP2 = false, bool FP8 = false>
__device__ __forceinline__ void gemm_phase(PG8_LAS unsigned char* lds, const Gemm g, const Sched& S, const Epi& E) {
    const int tid = threadIdx.x, wid = __builtin_amdgcn_readfirstlane(tid >> 6), lane = tid & 63, wr = wid >> 2, wc = wid & 3, fr = lane & 15, fq = lane >> 4;
    const int K = FP8 ? g.K / 2 : g.K, nt = K / BK;
    typedef int i32x8 __attribute__((ext_vector_type(8))); typedef int i32x4v __attribute__((ext_vector_type(4)));
    unsigned voffA[2], voffB[2];
#pragma unroll
    for (int i = 0; i < 2; ++i) { int R, C; stage_rc(tid * 16 + i * 8192, R, C); const int Rb = Epi::PERM ? ((R & ~31) + perm32(R & 31)) : R;
        voffA[i] = (unsigned)(R * K + C) * 2u; voffB[i] = (unsigned)(Rb * K + C) * 2u; }
    const size_t kstep = (size_t)(BK * 2);
    const size_t hstep = (size_t)HALF * K * 2;
    const size_t tstep = 2 * hstep;
    const unsigned ldsw = (unsigned)wid * 1024u;
    const int aoff = lds_byte(wr * 64 + fr, fq * 8), boff = lds_byte(wc * 32 + fr, fq * 8);
#define PG8_SA(b, h) (((b) * 2 + (h)) * HTB)
#define PG8_SB(b, h) ((4 + (b) * 2 + (h)) * HTB)
#define PG8_STAGE(bufoff, gbase, voff) do { _Pragma("unroll") for (int _i = 0; _i < 2; ++_i) \
        __builtin_amdgcn_global_load_lds((const unsigned*)((const char*)(gbase) + (voff)[_i]), (PG8_LAS unsigned*)(lds + (bufoff) + ldsw + _i * 8192), 16, 0, 0); } while (0)
#define PG8_LDA(dst, b, h) do { _Pragma("unroll") for (int m = 0; m < 4; ++m) { dst[m].lo = *(const PG8_LAS i32x4v*)(lds + PG8_SA(b, h) + aoff + m * 2048); dst[m].hi = *(const PG8_LAS i32x4v*)(lds + PG8_SA(b, h) + aoff + m * 2048 + 1024); } } while (0)
#define PG8_LDB(dst, b, h) do { _Pragma("unroll") for (int n = 0; n < 2; ++n) { dst[n].lo = *(const PG8_LAS i32x4v*)(lds + PG8_SB(b, h) + boff + n * 2048); dst[n].hi = *(const PG8_LAS i32x4v*)(lds + PG8_SB(b, h) + boff + n * 2048 + 1024); } } while (0)
#define PG8_MMA(ai, bj, At, Bt) do { __builtin_amdgcn_s_setprio(1); \
        if constexpr (FP8) { _Pragma("unroll") for (int m = 0; m < 4; ++m) _Pragma("unroll") for (int n = 0; n < 2; ++n) \
            asm volatile("v_mfma_f32_16x16x128_f8f6f4 %0, %1, %2, %0" : "+v"(acc[ai][bj][m][n]) : "v"(Bt[n]), "v"(At[m])); }   \
        else { _Pragma("unroll") for (int m = 0; m < 4; ++m) _Pragma("unroll") for (int n = 0; n < 2; ++n) { \
            const i32x4v bl_ = Bt[n].lo, bh_ = Bt[n].hi, al_ = At[m].lo, ah_ = At[m].hi;     \
            acc[ai][bj][m][n] = __builtin_amdgcn_mfma_f32_16x16x32_bf16(__builtin_bit_cast(bf16x8, bl_), __builtin_bit_cast(bf16x8, al_), acc[ai][bj][m][n], 0, 0, 0); \
            acc[ai][bj][m][n] = __builtin_amdgcn_mfma_f32_16x16x32_bf16(__builtin_bit_cast(bf16x8, bh_), __builtin_bit_cast(bf16x8, ah_), acc[ai][bj][m][n], 0, 0, 0); } } \
        __builtin_amdgcn_s_setprio(0); } while (0)
#define PG8_WAIT_V(n) asm volatile("s_waitcnt vmcnt(" #n ")" ::: "memory")
#define PG8_WAIT_L(n) asm volatile("s_waitcnt lgkmcnt(" #n ")" ::: "memory")
#define PG8_BAR __builtin_amdgcn_s_barrier()
#define PG8_SCHED __builtin_amdgcn_sched_barrier(0)
    Unit cur, nxt; int ui = 0;
    if (!S.next(0, cur)) return;
    f32x4 acc[2][2][4][2];
#pragma unroll
    for (int a = 0; a < 2; ++a)
#pragma unroll
        for (int b = 0; b < 2; ++b)
#pragma unroll
            for (int m = 0; m < 4; ++m)
#pragma unroll
                for (int n = 0; n < 2; ++n) acc[a][b][m][n] = (f32x4){0.f, 0.f, 0.f, 0.f};
    i32x8 At[4], B0[2], B1[2];
    const char* cA = (const char*)g.A + (size_t)cur.pm * tstep; const char* cB = (const char*)g.Bt + (size_t)cur.pn * tstep;
    S.a_ready(cur);
    if constexpr (SP2) {
        PG8_STAGE(PG8_SB(0, 0), cB, voffB); PG8_STAGE(PG8_SB(0, 1), cB + hstep, voffB); PG8_STAGE(PG8_SA(0, 0), cA, voffA); PG8_STAGE(PG8_SA(0, 1), cA + hstep, voffA);
        if (wr == 1) PG8_BAR;
        PG8_WAIT_V(2); PG8_BAR;
        PG8_STAGE(PG8_SB(1, 0), cB + kstep, voffB); PG8_STAGE(PG8_SA(1, 0), cA + kstep, voffA); PG8_STAGE(PG8_SB(1, 1), cB + hstep + kstep, voffB);
        PG8_WAIT_V(6); PG8_BAR;
    } else {
        PG8_STAGE(PG8_SB(0, 0), cB, voffB); PG8_STAGE(PG8_SA(0, 0), cA, voffA); PG8_STAGE(PG8_SB(0, 1), cB + hstep, voffB); PG8_STAGE(PG8_SA(0, 1), cA + hstep, voffA);
        if (wr == 1) PG8_BAR;
        PG8_WAIT_V(4); PG8_BAR;
        PG8_STAGE(PG8_SB(1, 0), cB + kstep, voffB); PG8_STAGE(PG8_SA(1, 0), cA + kstep, voffA); PG8_STAGE(PG8_SB(1, 1), cB + hstep + kstep, voffB);
        PG8_WAIT_V(6); PG8_BAR;
    }
    for (;;) {
        const bool has_next = S.next(ui + 1, nxt);
        const char* nA = has_next ? (const char*)g.A + (size_t)nxt.pm * tstep : cA; const char* nB = has_next ? (const char*)g.Bt + (size_t)nxt.pn * tstep : cB;
        for (int t = 0; t < nt; t += 2) {
            const bool last = (t == nt - 2);
            const char* a1 = cA + (size_t)(t + 1) * kstep;
            const char* a2 = last ? nA : cA + (size_t)(t + 2) * kstep; const char* b2 = last ? nB : cB + (size_t)(t + 2) * kstep;
            const char* a3 = a2 + kstep; const char* b3 = b2 + kstep;
            if (last && has_next) S.a_ready(nxt);
            if constexpr (SP2) {
            PG8_LDB(B0, 0, 0); PG8_LDB(B1, 0, 1); PG8_SCHED; PG8_LDA(At, 0, 0); PG8_STAGE(PG8_SA(1, 1), a1 + hstep, voffA);
            PG8_WAIT_V(8); PG8_WAIT_L(0); PG8_BAR; PG8_MMA(0, 0, At, B0); PG8_MMA(0, 1, At, B1); PG8_BAR; PG8_SCHED;
            PG8_LDA(At, 0, 1); PG8_STAGE(PG8_SB(0, 0), b2, voffB); PG8_STAGE(PG8_SB(0, 1), b2 + hstep, voffB); PG8_STAGE(PG8_SA(0, 0), a2, voffA);
            PG8_WAIT_V(8); PG8_WAIT_L(0); PG8_BAR; PG8_MMA(1, 0, At, B0); PG8_MMA(1, 1, At, B1); PG8_BAR; PG8_SCHED;
            PG8_LDB(B0, 1, 0); PG8_LDB(B1, 1, 1); PG8_SCHED; PG8_LDA(At, 1, 0); PG8_STAGE(PG8_SA(0, 1), a2 + hstep, voffA);
            PG8_WAIT_V(8); PG8_WAIT_L(0); PG8_BAR; PG8_MMA(0, 0, At, B0); PG8_MMA(0, 1, At, B1); PG8_BAR; PG8_SCHED;
            PG8_LDA(At, 1, 1); PG8_STAGE(PG8_SB(1, 0), b3, voffB); PG8_STAGE(PG8_SB(1, 1), b3 + hstep, voffB); PG8_STAGE(PG8_SA(1, 0), a3, voffA);
            PG8_WAIT_V(8); PG8_WAIT_L(0); PG8_BAR; PG8_MMA(1, 0, At, B0); PG8_MMA(1, 1, At, B1); PG8_BAR; PG8_SCHED;
            } else {
            PG8_LDB(B0, 0, 0); PG8_SCHED; PG8_LDA(At, 0, 0); PG8_STAGE(PG8_SA(1, 1), a1 + hstep, voffA);
            PG8_WAIT_L(8); PG8_BAR; PG8_WAIT_L(0); PG8_MMA(0, 0, At, B0); PG8_BAR; PG8_SCHED;
            PG8_LDB(B1, 0, 1); PG8_STAGE(PG8_SB(0, 0), b2, voffB);
            PG8_BAR; PG8_WAIT_L(0); PG8_MMA(0, 1, At, B1); PG8_BAR;
            PG8_LDA(At, 0, 1); PG8_STAGE(PG8_SA(0, 0), a2, voffA);
            PG8_BAR; PG8_WAIT_L(0); PG8_MMA(1, 0, At, B0); PG8_BAR; PG8_SCHED;
            PG8_STAGE(PG8_SB(0, 1), b2 + hstep, voffB);
            PG8_WAIT_V(6); PG8_BAR; PG8_MMA(1, 1, At, B1); PG8_BAR;
            PG8_LDB(B0, 1, 0); PG8_SCHED; PG8_LDA(At, 1, 0); PG8_STAGE(PG8_SA(0, 1), a2 + hstep, voffA);
            PG8_WAIT_L(8); PG8_BAR; PG8_WAIT_L(0); PG8_MMA(0, 0, At, B0); PG8_BAR; PG8_SCHED;
            PG8_LDB(B1, 1, 1); PG8_STAGE(PG8_SB(1, 0), b3, voffB);
            PG8_BAR; PG8_WAIT_L(0); PG8_MMA(0, 1, At, B1); PG8_BAR;
            PG8_LDA(At, 1, 1); PG8_STAGE(PG8_SA(1, 0), a3, voffA);
            PG8_BAR; PG8_WAIT_L(0); PG8_MMA(1, 0, At, B0); PG8_BAR; PG8_SCHED;
            PG8_STAGE(PG8_SB(1, 1), b3 + hstep, voffB);
            PG8_WAIT_V(6); PG8_BAR; PG8_MMA(1, 1, At, B1); PG8_BAR;
            }
        }
        if constexpr (ALIGN_EPI) { if (wr == 0) PG8_BAR; }
        if constexpr (FP8) asm volatile("s_nop 15\n\ts_nop 15" ::: "memory");
        PG8_SCHED;
        if constexpr (!Epi::AFTER_DRAIN) { E(acc, cur, wr, wc, fr, fq); S.done(cur); }
        PG8_SCHED;
        if (!has_next) break;
#pragma unroll
        for (int a = 0; a < 2; ++a)
#pragma unroll
            for (int b = 0; b < 2; ++b)
#pragma unroll
                for (int m = 0; m < 4; ++m)
#pragma unroll
                    for (int n = 0; n < 2; ++n) acc[a][b][m][n] = (f32x4){0.f, 0.f, 0.f, 0.f};
        cur = nxt; cA = nA; cB = nB; ++ui;
        if constexpr (ALIGN_EPI) { if (wr == 1) PG8_BAR; }
    }
    PG8_WAIT_V(0);
    if constexpr (!ALIGN_EPI) { if (wr == 0) PG8_BAR; }
    PG8_BAR;
    if constexpr (Epi::AFTER_DRAIN) { E.fused(acc, cur, wr, wc, fr, fq, lds, wid, lane); S.done(cur); }
#undef PG8_SA
#undef PG8_SB
#undef PG8_STAGE
#undef PG8_LDA
#undef PG8_LDB
#undef PG8_MMA
#undef PG8_WAIT_V
#undef PG8_WAIT_L
#undef PG8_BAR
#undef PG8_SCHED
}
}

#define GAS __attribute__((address_space(1)))
#define LAS __attribute__((address_space(3)))
typedef unsigned v4u __attribute__((ext_vector_type(4)));
typedef float f32x4 __attribute__((ext_vector_type(4)));
typedef GAS unsigned gu32;
#define RLX_AGENT __ATOMIC_RELAXED, __HIP_MEMORY_SCOPE_AGENT
#define LDS_WAIT() asm volatile("s_waitcnt lgkmcnt(0)" ::: "memory")
#define VM_WAIT() asm volatile("s_waitcnt vmcnt(0)" ::: "memory")
constexpr int NWAVES = 8;
constexpr int NPAD = 9472;
constexpr size_t MiB = 1u << 20;
constexpr size_t WS_CTL = 0, CTL_ZERO_BYTES = 1 * MiB;
constexpr size_t WS_MOD = 1 * MiB;
constexpr size_t WS_GAIN = 1 * MiB + 256 * 1024;
constexpr size_t WS_KMEAN = 1 * MiB + 512 * 1024;
constexpr size_t WS_WI = 2 * MiB;
constexpr size_t WS_KI = 3 * MiB;
constexpr size_t WS_MASK = 5 * MiB;
constexpr size_t WS_MODP = 10 * MiB;
constexpr size_t WS_WIN = 18 * MiB;
constexpr size_t WS_HB = 56 * MiB;
constexpr size_t WS_Y = 56 * MiB;
constexpr size_t WS_QA = 120 * MiB, WS_KA = 152 * MiB, WS_VA = 184 * MiB, WS_SZA = 216 * MiB;
constexpr size_t WS_QB = 248 * MiB, WS_KB = 280 * MiB, WS_VB = 312 * MiB, WS_SZB = 344 * MiB;
constexpr size_t WS_QI = 376 * MiB;
constexpr size_t WS_T32 = 408 * MiB;
constexpr size_t WS_Y8 = 408 * MiB;
constexpr size_t WS_HB8 = 440 * MiB;
constexpr size_t WS_WIN8 = 472 * MiB;
constexpr size_t WS_WOUT8 = 492 * MiB;
constexpr size_t WS_END = 496 * MiB;
constexpr float FP8_DESCALE = 1.f / 512.f;
constexpr int CW_QUEUE = 2048;
constexpr int CW_BAR = 4096;
constexpr int RING_BYTES = 131072;
constexpr int EPI_OFF = RING_BYTES;
constexpr int LDSCTL_OFF = EPI_OFF + 16384, MISC_OFF = LDSCTL_OFF + 320;
constexpr int LDS_BYTES = 163840;

#define XB_TMO      128
#define XB_XCNT(j)  (256  + 64 * (j))
#define XB_XSUB(j)  (1280 + 64 * (j))
#define XB_XGEN(j)  (2304 + 64 * (j))
#define XB_TOP      3328
#define XB_TOPGEN   3392
#define XCD_BAR_WORDS 3456
#define XB_SPIN_CAP (1u << 18)

__device__ __forceinline__ unsigned xb_ld(unsigned* p)              { return __hip_atomic_load(p, __ATOMIC_RELAXED, __HIP_MEMORY_SCOPE_AGENT); }
__device__ __forceinline__ unsigned xb_add(unsigned* p, unsigned v) { return __hip_atomic_fetch_add(p, v, __ATOMIC_RELAXED, __HIP_MEMORY_SCOPE_AGENT); }
__device__ __forceinline__ unsigned xb_xcc_id() { return (unsigned)__builtin_amdgcn_s_getreg((3 << 11) | 20) & 0xFu; }
#define XB_SPIN(cond, bar) do { unsigned _sp = 0; while (cond) { __builtin_amdgcn_s_sleep(1); \
    if ((++_sp & 255u) == 0u) { if (xb_ld(&(bar)[XB_TMO])) break; if (_sp > XB_SPIN_CAP) { atomicAdd(&(bar)[XB_TMO], 1u); break; } } } } while (0)

struct XcdBarrier {
    unsigned* bar; unsigned x;
    volatile LAS unsigned* st;
};

__device__ __forceinline__ XcdBarrier xcd_barrier_post(unsigned* bar, volatile LAS unsigned* st) {
    XcdBarrier b; b.bar = bar; b.x = xb_xcc_id(); b.st = st;
    if (threadIdx.x == 0) (void)xb_add(&bar[XB_XCNT(b.x)], 1u);
    return b;
}
__device__ __forceinline__ void xcd_barrier_complete(unsigned* bar, unsigned x, unsigned& nloc, unsigned& nx) {
    const unsigned G = gridDim.x * gridDim.y * gridDim.z;
    unsigned sum, cnt, mine, sp = 0u;
    for (;;) {
        sum = 0u; cnt = 0u; mine = 0u;
#pragma unroll
        for (unsigned j = 0; j < 16; ++j) { const unsigned c = xb_ld(&bar[XB_XCNT(j)]); sum += c; cnt += (c > 0u) ? 1u : 0u; mine = (j == x) ? c : mine; }
        if (sum == G) break;
        __builtin_amdgcn_s_sleep(1);
        if ((++sp & 255u) == 0u) { if (xb_ld(&bar[XB_TMO])) break; if (sp > XB_SPIN_CAP) { atomicAdd(&bar[XB_TMO], 1u); break; } }
    }
    nloc = mine > 0u ? mine : 1u; nx = cnt > 0u ? cnt : 1u;
}

__device__ __forceinline__ void xcd_barrier(const XcdBarrier& b) {
    asm volatile("s_waitcnt vmcnt(0)" ::: "memory");
    __syncthreads();
    if (threadIdx.x == 0) {
        unsigned* bar = b.bar;
        __builtin_amdgcn_s_waitcnt(0);
        unsigned nloc = b.st[0], nx = b.st[1];
        if (nloc == 0u) { xcd_barrier_complete(bar, b.x, nloc, nx); b.st[0] = nloc; b.st[1] = nx; }
        const unsigned old = xb_add(&bar[XB_XSUB(b.x)], 1u);
        const unsigned gen = old / nloc;
        if (old + 1u == (gen + 1u) * nloc) {
            __builtin_amdgcn_fence(__ATOMIC_RELEASE, "agent");
            asm volatile("s_waitcnt vmcnt(0)" ::: "memory");
            const unsigned og = xb_add(&bar[XB_TOP], 1u);
            const unsigned tg = og / nx;
            if (og + 1u == (tg + 1u) * nx) xb_add(&bar[XB_TOPGEN], 1u);
            else XB_SPIN(xb_ld(&bar[XB_TOPGEN]) == tg, bar);
            __builtin_amdgcn_fence(__ATOMIC_ACQUIRE, "agent");
            xb_add(&bar[XB_XGEN(b.x)], 1u);
            asm volatile("s_waitcnt vmcnt(0)" ::: "memory");
        } else {
            XB_SPIN(xb_ld(&bar[XB_XGEN(b.x)]) == gen, bar);
            __builtin_amdgcn_fence(__ATOMIC_ACQUIRE, "agent");
            asm volatile("s_waitcnt vmcnt(0)" ::: "memory");
        }
    }
    __syncthreads();
}


struct Frame {
    LAS unsigned char* lds; volatile LAS unsigned* MISC; gu32* ctl; int tid, lane, wave, vcu, G;
};
__device__ __forceinline__ unsigned cvt_pk_bf16(float lo, float hi) { unsigned r; asm volatile("v_cvt_pk_bf16_f32 %0, %1, %2" : "=v"(r) : "v"(lo), "v"(hi)); return r; }
__device__ __forceinline__ unsigned f2bf_u(float f) { unsigned u = __builtin_bit_cast(unsigned, f); return (u + 0x7fffu + ((u >> 16) & 1u)) >> 16; }
__device__ __forceinline__ unsigned pk2(float lo, float hi) { return f2bf_u(lo) | (f2bf_u(hi) << 16); }
__device__ __forceinline__ float fast_silu(float v) { return v * __builtin_amdgcn_rcpf(1.f + __expf(-v)); }

__device__ __forceinline__ void p0_mod(Frame& F, int id, const float* __restrict__ c, const float* __restrict__ w_ada, float* __restrict__ MODP) {
    const int cs = id & 15, ks = id >> 4;
    LAS float* sc = (LAS float*)(F.lds);
    LAS float* red = (LAS float*)(F.lds + 4096);
    for (int i = F.tid; i < BATCH * 128; i += NWAVES * 64) sc[i] = silu_f(c[(i >> 7) * DM + ks * 128 + (i & 127)]);
    __syncthreads();
    const int cq = F.tid % 96, kq = F.tid / 96;
    if (F.tid < 480) {
        f32x4 acc[8];
#pragma unroll
        for (int b = 0; b < 8; ++b) acc[b] = (f32x4){0.f, 0.f, 0.f, 0.f};
        const float* wp = w_ada + (size_t)(ks * 128) * (3 * DM) + cs * 384 + 4 * cq;
#pragma unroll 4
        for (int k = kq; k < 128; k += 5) { const f32x4 w = *(const f32x4*)(wp + (size_t)k * (3 * DM));
#pragma unroll
            for (int b = 0; b < 8; ++b) acc[b] += w * sc[b * 128 + k]; }
#pragma unroll
        for (int b = 0; b < 8; ++b) *(LAS f32x4*)(red + (kq * 8 + b) * 384 + 4 * cq) = acc[b];
    }
    __syncthreads();
    for (int o = F.tid; o < 8 * 384; o += NWAVES * 64) { const int b = o / 384, col = o % 384; float s = 0.f;
#pragma unroll
        for (int q = 0; q < 5; ++q) s += red[(q * 8 + b) * 384 + col];
        MODP[((size_t)ks * BATCH + b) * (3 * DM) + cs * 384 + col] = s; }
    __syncthreads();
}
__device__ __forceinline__ unsigned pk4_fp8(float a, float b, float c, float d) {
    a = fminf(fmaxf(a, -448.f), 448.f); b = fminf(fmaxf(b, -448.f), 448.f); c = fminf(fmaxf(c, -448.f), 448.f); d = fminf(fmaxf(d, -448.f), 448.f);
    int w = 0; w = __builtin_amdgcn_cvt_pk_fp8_f32(a, b, w, false); w = __builtin_amdgcn_cvt_pk_fp8_f32(c, d, w, true); return (unsigned)w; }
template <bool MAPWIN>
__device__ __forceinline__ void p0_transpose_item(const float* __restrict__ W, int K, int N, int NP, bf16_t* __restrict__ WT, unsigned char* __restrict__ WT8, LAS float* scr, int item, int lane) {
    const int nblk = NP / 32, kb = item / nblk, nb = item % nblk, k0 = 64 * kb, n0 = 32 * nb;
    const int np = n0 + (lane & 31);
    int src = np; bool valid = true;
    if (MAPWIN) { if (np >= 5376) src = np - 176; else if (np >= 5200) valid = false; }
    float wv_[32];
#pragma unroll
    for (int i = 0; i < 32; ++i) { const int kk = 2 * i + (lane >> 5); wv_[i] = valid ? W[(size_t)(k0 + kk) * N + src] : 0.f; }
#pragma unroll
    for (int i = 0; i < 32; ++i) { const int kk = 2 * i + (lane >> 5); scr[kk * 33 + (lane & 31)] = wv_[i]; }
    LDS_WAIT(); asm volatile("" ::: "memory");
    const int c = lane & 7;
    if (WT) {
#pragma unroll
    for (int j = 0; j < 4; ++j) { const int n = (lane >> 3) + 8 * j; const LAS float* s = scr + (8 * c) * 33 + n;
        v4u o; o.x = pk2(s[0 * 33], s[1 * 33]); o.y = pk2(s[2 * 33], s[3 * 33]); o.z = pk2(s[4 * 33], s[5 * 33]); o.w = pk2(s[6 * 33], s[7 * 33]);
        *(GAS v4u*)(WT + (size_t)(n0 + n) * K + k0 + 8 * c) = o; } }
    if (WT8) {
#pragma unroll
        for (int jj = 0; jj < 2; ++jj) { const int idx = lane + 64 * jj, n = idx >> 2, c4 = idx & 3; const LAS float* s = scr + (16 * c4) * 33 + n;
            v4u o; o.x = pk4_fp8(s[0 * 33] * 64.f, s[1 * 33] * 64.f, s[2 * 33] * 64.f, s[3 * 33] * 64.f); o.y = pk4_fp8(s[4 * 33] * 64.f, s[5 * 33] * 64.f, s[6 * 33] * 64.f, s[7 * 33] * 64.f);
            o.z = pk4_fp8(s[8 * 33] * 64.f, s[9 * 33] * 64.f, s[10 * 33] * 64.f, s[11 * 33] * 64.f); o.w = pk4_fp8(s[12 * 33] * 64.f, s[13 * 33] * 64.f, s[14 * 33] * 64.f, s[15 * 33] * 64.f);
            *(GAS v4u*)(WT8 + (size_t)(n0 + n) * K + k0 + 16 * c4) = o; } }
    LDS_WAIT(); asm volatile("" ::: "memory");
}
__device__ __forceinline__ void p0_convert(Frame& F, const float* __restrict__ w_in, const float* __restrict__ w_out, bf16_t* __restrict__ WinT, unsigned char* __restrict__ WinT8, unsigned char* __restrict__ WoutT8) {
    LAS float* scr = (LAS float*)(F.lds + F.wave * 16384);
    const int gw = F.vcu * NWAVES + F.wave, NGW = F.G * NWAVES;
    constexpr int I_IN = (DM / 64) * (NPAD / 32), I_OUT = (DM / 64) * (DM / 32);
    for (int it = gw; it < I_IN + I_OUT; it += NGW) {
        if (it < I_IN) { const int tile = (it % (NPAD / 32)) >> 3; const bool b16 = (tile >= 16 && tile <= 24);
            p0_transpose_item<true>(w_in, DM, DIN, NPAD, b16 ? WinT : nullptr, b16 ? nullptr : WinT8, scr, it, F.lane); }
        else p0_transpose_item<false>(w_out, DM, DM, DM, nullptr, WoutT8, scr, it - I_IN, F.lane);
    }
}
__device__ __forceinline__ void p1_norm(Frame& F, const float* __restrict__ x, const float* __restrict__ g, const float* __restrict__ MODP, const float* __restrict__ b_ada, float* __restrict__ MOD,
                                        bf16_t* __restrict__ HB, unsigned char* __restrict__ HB8) {
    LAS float* gsl = (LAS float*)(F.lds);
    LAS float* shl = (LAS float*)(F.lds + 8192);
    for (int v = F.vcu; v < M / 64; v += F.G) {
        const int b = v / (SEQ / 64);
        { const int k4 = F.tid * 4; const float* pp = MODP + (size_t)b * (3 * DM) + k4;
          f32x4 sh = *(const f32x4*)(b_ada + k4), scl = *(const f32x4*)(b_ada + DM + k4);
#pragma unroll 4
          for (int q = 0; q < 16; ++q) { sh += *(const f32x4*)(pp + (size_t)q * BATCH * (3 * DM)); scl += *(const f32x4*)(pp + (size_t)q * BATCH * (3 * DM) + DM); }
          const f32x4 gg = *(const f32x4*)(g + k4);
          *(LAS f32x4*)(gsl + k4) = gg * (scl + 1.0f); *(LAS f32x4*)(shl + k4) = sh;
          if (F.tid < 64) { const int col = 2 * DM + 64 * (v % (SEQ / 64)) + F.tid; float gt = b_ada[col];
              for (int q = 0; q < 16; ++q) gt += MODP[((size_t)q * BATCH + b) * (3 * DM) + col];
              MOD[b * 3 * DM + col] = gt; } }
        __syncthreads();
        f32x4 gs[8], sh[8];
#pragma unroll
        for (int j = 0; j < 8; ++j) { const int k = 4 * F.lane + 256 * j; gs[j] = *(const LAS f32x4*)(gsl + k); sh[j] = *(const LAS f32x4*)(shl + k); }
        for (int r = 0; r < 8; ++r) {
            const int row = 64 * v + 8 * F.wave + r;
            const f32x4* xr = (const f32x4*)(x + (size_t)row * DM) + F.lane;
            f32x4 xv[8]; float ss = 0.f;
#pragma unroll
            for (int j = 0; j < 8; ++j) { xv[j] = xr[64 * j]; ss += (xv[j].x * xv[j].x + xv[j].y * xv[j].y) + (xv[j].z * xv[j].z + xv[j].w * xv[j].w); }
            ss = wave_sum(ss);
            const float rstd = rsqrtf(ss * (1.f / DM) + RMS_EPS);
            unsigned long long* o8 = (unsigned long long*)(HB + (size_t)row * DM) + F.lane; unsigned* o4 = (unsigned*)(HB8 + (size_t)row * DM) + F.lane;
#pragma unroll
            for (int j = 0; j < 8; ++j) { const f32x4 h = xv[j] * rstd * gs[j] + sh[j];
                o8[64 * j] = (unsigned long long)pk2(h.x, h.y) | ((unsigned long long)pk2(h.z, h.w) << 32);
                o4[64 * j] = pk4_fp8(h.x * 8.f, h.y * 8.f, h.z * 8.f, h.w * 8.f); }
        }
        __syncthreads();
    }
}
struct EpiProj {
    static constexpr bool PERM = true, AFTER_DRAIN = false;
    unsigned char* ws;
    LAS float* P; float osc;
    __device__ __forceinline__ void operator()(const pg8::f32x4 (&acc)[2][2][4][2], const pg8::Unit& u, int wr, int wc, int fr, int fq) const {
        { int l_ = threadIdx.x & 63; asm volatile("" : "+v"(l_)); fr = l_ & 15; fq = l_ >> 4; }
        const int pn = u.pn;
        bf16_t* const KI = (bf16_t*)(ws + WS_KI); float* const WI = (float*)(ws + WS_WI); bf16_t* const QI = (bf16_t*)(ws + WS_QI);
        int grp, sub;
        if (pn < 20) { grp = pn >> 2; sub = pn & 3; } else if (pn == 20) { grp = 5; sub = 0; } else { grp = 6 + ((pn - 21) >> 2); sub = (pn - 21) & 3; }
        const int b = u.pm >> 3, t0 = (u.pm & 7) * 256 + wr * 64 + fr;
        const int cl = 32 * wc + 8 * fq;
        const bool norm = (grp == 0 || grp == 1 || grp == 6 || grp == 7 || grp == 5);
        float rs[2][4][2];
        if (norm) {
#pragma unroll
            for (int ai = 0; ai < 2; ++ai)
#pragma unroll
                for (int m = 0; m < 4; ++m)
#pragma unroll
                    for (int bj = 0; bj < 2; ++bj) { const pg8::f32x4 a = acc[ai][bj][m][0], c = acc[ai][bj][m][1];
                        float s = (a[0] * a[0] + a[1] * a[1]) + (a[2] * a[2] + a[3] * a[3]) + (c[0] * c[0] + c[1] * c[1]) + (c[2] * c[2] + c[3] * c[3]);
                        s += __shfl_xor(s, 16); s += __shfl_xor(s, 32);
                        if (fq == 0) P[((ai * 128 + wr * 64 + m * 16 + fr) * 2 + bj) * 4 + wc] = s; }
            asm volatile("s_waitcnt lgkmcnt(0)" ::: "memory"); __builtin_amdgcn_s_barrier(); asm volatile("" ::: "memory");
#pragma unroll
            for (int ai = 0; ai < 2; ++ai)
#pragma unroll
                for (int m = 0; m < 4; ++m)
#pragma unroll
                    for (int bj = 0; bj < 2; ++bj) { const pg8::f32x4 q = *(const LAS pg8::f32x4*)(P + ((ai * 128 + wr * 64 + m * 16 + fr) * 2 + bj) * 4);
                        rs[ai][m][bj] = ((grp == 5) ? rsqrtf((q[0] + q[1]) * (osc * osc * (1.f / 64.f)) + RMS_EPS) : rsqrtf(((q[0] + q[1]) + (q[2] + q[3])) * (osc * osc * (1.f / 128.f)) + RMS_EPS)) * osc; }
        }
        if (grp == 5) {
            if (wc < 2) { const float* gki = (const float*)(ws + WS_GAIN) + 4 * 128; const pg8::f32x4 g0 = *(const pg8::f32x4*)(gki + cl), g1 = *(const pg8::f32x4*)(gki + cl + 4);
#pragma unroll
                for (int ai = 0; ai < 2; ++ai)
#pragma unroll
                    for (int m = 0; m < 4; ++m) { const size_t row = (size_t)b * SEQ + t0 + 128 * ai + 16 * m; const float r = rs[ai][m][0];
                        const pg8::f32x4 v0 = acc[ai][0][m][0] * r * g0, v1 = acc[ai][0][m][1] * r * g1;
                        pg8::u32x4 w; w.x = cvt_pk_bf16(v0[0], v0[1]); w.y = cvt_pk_bf16(v0[2], v0[3]); w.z = cvt_pk_bf16(v1[0], v1[1]); w.w = cvt_pk_bf16(v1[2], v1[3]);
                        *(pg8::u32x4*)(KI + row * 64 + cl) = w; } }
            else if (wc == 2 && fq < 2) {
#pragma unroll
                for (int ai = 0; ai < 2; ++ai)
#pragma unroll
                    for (int m = 0; m < 4; ++m) { const size_t row = (size_t)b * SEQ + t0 + 128 * ai + 16 * m;
                        *(pg8::f32x4*)(WI + row * 16 + 8 * fq) = acc[ai][0][m][0]; *(pg8::f32x4*)(WI + row * 16 + 8 * fq + 4) = acc[ai][0][m][1]; } }
            return;
        }
        if (grp == 4) {
#pragma unroll
            for (int ai = 0; ai < 2; ++ai)
#pragma unroll
                for (int m = 0; m < 4; ++m) { const size_t row = (size_t)b * SEQ + t0 + 128 * ai + 16 * m;
#pragma unroll
                    for (int bj = 0; bj < 2; ++bj) { const pg8::f32x4 v0 = acc[ai][bj][m][0], v1 = acc[ai][bj][m][1];
                        pg8::u32x4 w; w.x = cvt_pk_bf16(v0[0], v0[1]); w.y = cvt_pk_bf16(v0[2], v0[3]); w.z = cvt_pk_bf16(v1[0], v1[1]); w.w = cvt_pk_bf16(v1[2], v1[3]);
                        *(pg8::u32x4*)(QI + row * 1024 + sub * 256 + bj * 128 + cl) = w; } }
            return;
        }
        bf16_t* dst; const float* gain = nullptr;
        { const int slot = grp < 4 ? grp : grp - 2;
          dst = (bf16_t*)(ws + WS_QA + (size_t)slot * (32 * MiB));
          gain = (const float*)(ws + WS_GAIN) + (grp < 2 ? grp : grp - 4) * 128; }
        pg8::f32x4 g0 = {1.f, 1.f, 1.f, 1.f}, g1 = {1.f, 1.f, 1.f, 1.f};
        if (norm) { g0 = *(const pg8::f32x4*)(gain + cl); g1 = *(const pg8::f32x4*)(gain + cl + 4); }
        const bool act = (grp == 3 || grp == 9);
#pragma unroll
        for (int ai = 0; ai < 2; ++ai)
#pragma unroll
            for (int m = 0; m < 4; ++m) { const int t = t0 + 128 * ai + 16 * m;
#pragma unroll
                for (int bj = 0; bj < 2; ++bj) { const int h = 2 * sub + bj;
                    pg8::f32x4 v0 = acc[ai][bj][m][0], v1 = acc[ai][bj][m][1];
                    if (norm) { const float r = rs[ai][m][bj]; v0 = v0 * r * g0; v1 = v1 * r * g1; } else { v0 = v0 * osc; v1 = v1 * osc; }
                    if (act) { v0[0] = fast_silu(v0[0]); v0[1] = fast_silu(v0[1]); v0[2] = fast_silu(v0[2]); v0[3] = fast_silu(v0[3]);
                               v1[0] = fast_silu(v1[0]); v1[1] = fast_silu(v1[1]); v1[2] = fast_silu(v1[2]); v1[3] = fast_silu(v1[3]); }
                    pg8::u32x4 w; w.x = cvt_pk_bf16(v0[0], v0[1]); w.y = cvt_pk_bf16(v0[2], v0[3]); w.z = cvt_pk_bf16(v1[0], v1[1]); w.w = cvt_pk_bf16(v1[2], v1[3]);
                    *(pg8::u32x4*)(dst + HM(b, h, t, cl)) = w; } }
    }
};
struct EpiOut {
    static constexpr bool PERM = false, AFTER_DRAIN = false;
    const float* x; const float* MOD; float* out; float oscale;
    __device__ __forceinline__ void operator()(const pg8::f32x4 (&acc)[2][2][4][2], const pg8::Unit& u, int wr, int wc, int fr, int fq) const {
        { int l_ = threadIdx.x & 63; asm volatile("" : "+v"(l_)); fr = l_ & 15; fq = l_ >> 4; }
        const int b = u.pm >> 3; const float* gate = MOD + b * 3 * DM + 2 * DM;
        const int col0 = u.pn * 256 + wc * 32 + 4 * fq;
        pg8::f32x4 gv[2][2];
#pragma unroll
        for (int bj = 0; bj < 2; ++bj)
#pragma unroll
            for (int n = 0; n < 2; ++n) gv[bj][n] = *(const pg8::f32x4*)(gate + col0 + bj * 128 + n * 16) * oscale;
#pragma unroll
        for (int ai = 0; ai < 2; ++ai)
#pragma unroll
            for (int m = 0; m < 4; ++m) { const size_t off = (size_t)(u.pm * 256 + ai * 128 + wr * 64 + m * 16 + fr) * DM + col0;
#pragma unroll
                for (int bj = 0; bj < 2; ++bj)
#pragma unroll
                    for (int n = 0; n < 2; ++n) { const pg8::f32x4 xv = *(const pg8::f32x4*)(x + off + bj * 128 + n * 16);
                        *(pg8::f32x4*)(out + off + bj * 128 + n * 16) = xv + gv[bj][n] * acc[ai][bj][m][n]; }
                if (m & 1) asm volatile("" ::: "memory"); }
    }
};

namespace att {
typedef short bf16x8 __attribute__((ext_vector_type(8)));
typedef short s16x4 __attribute__((ext_vector_type(4)));
typedef float f32x16 __attribute__((ext_vector_type(16)));
typedef float f32x4 __attribute__((ext_vector_type(4)));
typedef unsigned u32x4 __attribute__((ext_vector_type(4)));
constexpr int NW = 8, QBLK = 32, KVBLK = 64, QB = NW * QBLK, D = 128;
constexpr int SHM_V = KVBLK * D * 2, SHM_K = KVBLK * D * 2;
constexpr int LDS_WS = 2 * SHM_V + 2 * SHM_K, LDS_KM = LDS_WS + NW * 64 * 4, LDS_OST = 73728, MST_PITCH = 264, MST_WAVE = QBLK * MST_PITCH, LDS_BYTES = LDS_OST + NW * MST_WAVE;
constexpr float SCALE = 0.08838834764831845f, THR = 8.f;
#define KSWZ(row, colB) ((row) * 256 + ((colB) ^ (((row) & 7) << 4)))
#define SBAR() __builtin_amdgcn_sched_barrier(0)
__device__ __forceinline__ int v_st(int k, int c) { const int kk = (k & ~0xC) | ((k & 4) << 1) | ((k & 8) >> 1); return ((kk >> 3) * 4 + (c >> 5)) * 512 + ((kk & 7) * 32 + (c & 31)) * 2; }
__device__ __forceinline__ int v_rd_base(int lane) { return ((lane & 3) << 3) | (((lane >> 2) & 3) << 6) | (((lane >> 4) & 1) << 5) | (((lane >> 5) & 1) << 8); }
constexpr int v_rd_off(int d0, int ks, int half) { return d0 * 512 + ks * 4096 + half * 2048; }
__device__ __forceinline__ int crow(int r, int hi) { return (r & 3) + 8 * (r >> 2) + 4 * hi; }
__device__ __forceinline__ unsigned cvtpk(float lo, float hi) { unsigned r; asm volatile("v_cvt_pk_bf16_f32 %0, %1, %2" : "=v"(r) : "v"(lo), "v"(hi)); return r; }
__device__ __forceinline__ unsigned cvt1(float v) { unsigned r; asm volatile("v_cvt_pk_bf16_f32 %0, %1, 0" : "=v"(r) : "v"(v)); return r; }
__device__ __forceinline__ bf16x8 load8(const bf16_t* p) { return *reinterpret_cast<const bf16x8*>(p); }
__device__ __forceinline__ void mask_causal(f32x16& p0, f32x16& p1, int dq) {
    const float NEG = -__builtin_inff();
#pragma unroll
    for (int r = 0; r < 16; ++r) { const int c = (r & 3) + 8 * (r >> 2); if (dq - c < 0) p0[r] = NEG; if (dq - c - 32 < 0) p1[r] = NEG; }
}
__device__ __forceinline__ void mask_bits(f32x16& p0, f32x16& p1, unsigned w0, unsigned w1) {
    const unsigned NEGB = 0xff800000u;
#pragma unroll
    for (int r = 0; r < 16; ++r) { const int c = (r & 3) + 8 * (r >> 2);
        const unsigned t0 = (unsigned)(((int)(w0 << (31 - c))) >> 31), t1 = (unsigned)(((int)(w1 << (31 - c))) >> 31);
        p0[r] = __uint_as_float((__float_as_uint(p0[r]) & t0) | (NEGB & ~t0));
        p1[r] = __uint_as_float((__float_as_uint(p1[r]) & t1) | (NEGB & ~t1)); }
}
__device__ __forceinline__ void partialSM(f32x16& p0, f32x16& p1, float& m_reg, float& mn, float& alpha, float cb0, float cb1) {
    float pm0 = p0[0]; for (int r = 1; r < 16; ++r) pm0 = fmaxf(pm0, p0[r]); float pm1 = p1[0]; for (int r = 1; r < 16; ++r) pm1 = fmaxf(pm1, p1[r]);
    float pmax = fmaxf(pm0 + cb0, pm1 + cb1);
    { auto rr = __builtin_amdgcn_permlane32_swap(__float_as_uint(pmax), __float_as_uint(pmax), false, false);
      pmax = fmaxf(__uint_as_float(rr[0]), __uint_as_float(rr[1])); }
    constexpr float C2 = 1.4426950408889634f * SCALE;
    if (__builtin_expect(__all((pmax - m_reg) * SCALE <= THR), 1)) { mn = m_reg; alpha = 1.f; }
    else { mn = fmaxf(m_reg, pmax); alpha = __builtin_amdgcn_exp2f((m_reg - mn) * C2); m_reg = mn; }
    const float mnL0 = (cb0 - mn) * C2, mnL1 = (cb1 - mn) * C2;
    for (int r = 0; r < 16; ++r) p0[r] = fmaf(p0[r], C2, mnL0); for (int r = 0; r < 16; ++r) p1[r] = fmaf(p1[r], C2, mnL1);
    for (int r = 0; r < 16; ++r) p0[r] = __builtin_amdgcn_exp2f(p0[r]);
}
__device__ __forceinline__ void finishSM(f32x16& p0, f32x16& p1, float alpha, float& l_reg, bf16x8& pa0, bf16x8& pa1, bf16x8& pa2, bf16x8& pa3) {
    for (int r = 0; r < 16; ++r) p1[r] = __builtin_amdgcn_exp2f(p1[r]);
    float ps = 0; for (int r = 0; r < 16; ++r) ps += p0[r]; for (int r = 0; r < 16; ++r) ps += p1[r];
    { auto rr = __builtin_amdgcn_permlane32_swap(__float_as_uint(ps), __float_as_uint(ps), false, false);
      ps = __uint_as_float(rr[0]) + __uint_as_float(rr[1]); }
    l_reg = l_reg * alpha + ps;
#define PK4(P, B_, OUT) do { unsigned a0 = cvtpk(P[B_+0], P[B_+1]), a1 = cvtpk(P[B_+2], P[B_+3]);                          \
        unsigned b0 = cvtpk(P[B_+4], P[B_+5]), b1 = cvtpk(P[B_+6], P[B_+7]);                                             \
        auto r0 = __builtin_amdgcn_permlane32_swap(a0, b0, false, false); auto r1 = __builtin_amdgcn_permlane32_swap(a1, b1, false, false); \
        u32x4 w = {r0[0], r1[0], r0[1], r1[1]}; OUT = *reinterpret_cast<bf16x8*>(&w); } while (0)
    PK4(p0, 0, pa0); PK4(p0, 8, pa1); PK4(p1, 0, pa2); PK4(p1, 8, pa3);
#undef PK4
}
template <int KB>
__device__ __forceinline__ void qkt(f32x16& p0, f32x16& p1, const char* K_lds, int r32, int hi, const bf16x8* qr, const f32x16& kc, bool act) {
    if (!act) { p0 = f32x16{}; p1 = f32x16{}; return; }
    const char* kb[4];
#pragma unroll
    for (int dd = 0; dd < 4; ++dd) kb[dd] = K_lds + KB * SHM_K + KSWZ(r32, (dd * 16 + hi * 8) * 2);
#pragma unroll
    for (int d0 = 0; d0 < 8; ++d0) { const char* a = kb[d0 & 3] + (d0 >> 2) * 128;
        bf16x8 b0 = *reinterpret_cast<const bf16x8*>(a);
        bf16x8 b1 = *reinterpret_cast<const bf16x8*>(a + 32 * 256);
        if (d0 == 0) { p0 = __builtin_amdgcn_mfma_f32_32x32x16_bf16(b0, qr[0], kc, 0, 0, 0); p1 = __builtin_amdgcn_mfma_f32_32x32x16_bf16(b1, qr[0], kc, 0, 0, 0); }
        else { p0 = __builtin_amdgcn_mfma_f32_32x32x16_bf16(b0, qr[d0], p0, 0, 0, 0); p1 = __builtin_amdgcn_mfma_f32_32x32x16_bf16(b1, qr[d0], p1, 0, 0, 0); } }
}
template <int VB>
__device__ __forceinline__ void pv_tile(f32x16* o, int vb0, bf16x8 pa0, bf16x8 pa1, bf16x8 pa2, bf16x8 pa3, bool act) {
    if (!act) return;
#define TRRD(dst, off) asm volatile("ds_read_b64_tr_b16 %0, %1 offset:%2" : "=&v"(dst) : "v"(vb0), "i"(off) : "memory")
#define PV_D0(d0) do { s16x4 l0, l1, l2, l3, h0, h1, h2, h3; constexpr int b_ = VB * SHM_V + v_rd_off(d0, 0, 0); \
        TRRD(l0, b_); TRRD(h0, b_ + 2048); TRRD(l1, b_ + 4096); TRRD(h1, b_ + 6144); TRRD(l2, b_ + 8192); TRRD(h2, b_ + 10240); TRRD(l3, b_ + 12288); TRRD(h3, b_ + 14336); \
        asm volatile("s_waitcnt lgkmcnt(0)" ::: "memory"); SBAR();   \
        o[d0] = __builtin_amdgcn_mfma_f32_32x32x16_bf16(pa0, (bf16x8){l0[0], l0[1], l0[2], l0[3], h0[0], h0[1], h0[2], h0[3]}, o[d0], 0, 0, 0);   \
        o[d0] = __builtin_amdgcn_mfma_f32_32x32x16_bf16(pa1, (bf16x8){l1[0], l1[1], l1[2], l1[3], h1[0], h1[1], h1[2], h1[3]}, o[d0], 0, 0, 0);   \
        o[d0] = __builtin_amdgcn_mfma_f32_32x32x16_bf16(pa2, (bf16x8){l2[0], l2[1], l2[2], l2[3], h2[0], h2[1], h2[2], h2[3]}, o[d0], 0, 0, 0);   \
        o[d0] = __builtin_amdgcn_mfma_f32_32x32x16_bf16(pa3, (bf16x8){l3[0], l3[1], l3[2], l3[3], h3[0], h3[1], h3[2], h3[3]}, o[d0], 0, 0, 0); } while (0)
    PV_D0(0); PV_D0(1); PV_D0(2); PV_D0(3);
#undef PV_D0
#undef TRRD
}

struct BlockRef { int grp, b, h, qb; };
__device__ __forceinline__ size_t hm_off(const BlockRef& r) { return ((size_t)(r.b * NH + r.h) * SEQ) * D; }
__device__ __forceinline__ const bf16_t* ptrQ(unsigned char* wsb, const BlockRef& r) { return (const bf16_t*)(wsb + (r.grp ? WS_QB : WS_QA)) + hm_off(r) + (size_t)r.qb * QB * D; }
__device__ __forceinline__ const bf16_t* ptrK(unsigned char* wsb, const BlockRef& r) { return (const bf16_t*)(wsb + (r.grp ? WS_KB : WS_KA)) + hm_off(r); }
__device__ __forceinline__ const bf16_t* ptrV(unsigned char* wsb, const BlockRef& r) { return (const bf16_t*)(wsb + (r.grp ? WS_VB : WS_VA)) + hm_off(r); }
__device__ __forceinline__ const bf16_t* ptrZ(unsigned char* wsb, const BlockRef& r) { return (const bf16_t*)(wsb + (r.grp ? WS_SZB : WS_SZA)) + hm_off(r) + (size_t)r.qb * QB * D; }
struct Seam { bf16x8 qr[8]; bf16x8 st_v0, st_v1, st_k0, st_k1; };
#define ROW(p, k0, rr) ((const bf16_t*)((const char*)(p) + (unsigned)(((k0) + (rr)) * (D * 2) + sc * 2)))
#define VMW() asm volatile("s_waitcnt vmcnt(0)" ::: "memory")
#define VMWN(n) asm volatile("s_waitcnt vmcnt(%0)" :: "i"(n) : "memory")
#define SLOAD_H(Kp, Vp, k0) do { S.st_v0 = load8(ROW(Vp, k0, sr)); S.st_v1 = load8(ROW(Vp, k0, 32 + sr));              \
                         S.st_k0 = load8(ROW(Kp, k0, sr)); S.st_k1 = load8(ROW(Kp, k0, 32 + sr)); } while (0)
#define SWRITE_HK(bf) do { *(bf16x8*)(K_lds + (bf) * SHM_K + kws) = S.st_k0; *(bf16x8*)(K_lds + (bf) * SHM_K + kws + 32 * 256) = S.st_k1; } while (0)
#define SWRITE_HV(bf) do { *(bf16x8*)(V_lds + (bf) * SHM_V + vst0) = S.st_v0; *(bf16x8*)(V_lds + (bf) * SHM_V + vst1) = S.st_v1; } while (0)
#define SWRITE_H(bf) do { SWRITE_HV(bf); SWRITE_HK(bf); } while (0)
__device__ __forceinline__ void prime(const BlockRef& cur, unsigned char* wsb, char* lds, Seam& S) {
    int tid = threadIdx.x; asm volatile("" : "+v"(tid));
    const int wid = __builtin_amdgcn_readfirstlane(tid >> 6), lane = tid & 63, r32 = lane & 31, hi = lane >> 5;
    const int sr = tid >> 4, sc = (tid & 15) * 8, kws = KSWZ(sr, sc * 2); char* K_lds = lds + 2 * SHM_V;
    const bf16_t* Qp = ptrQ(wsb, cur); const bf16_t* Kp = ptrK(wsb, cur); const bf16_t* Vp = ptrV(wsb, cur);
    for (int d0 = 0; d0 < 8; ++d0) S.qr[d0] = load8(Qp + (size_t)(wid * QBLK + r32) * D + d0 * 16 + hi * 8);
    SLOAD_H(Kp, Vp, (4 * cur.qb + 3) * KVBLK); VMW(); SWRITE_HK(0);
    __syncthreads();
}
__device__ __forceinline__ void block(const BlockRef& cur, unsigned char* wsb, char* lds, Seam& S, float Bq) {
    const int GRP = cur.grp;
    int tid = threadIdx.x; asm volatile("" : "+v"(tid));
    const int wid = __builtin_amdgcn_readfirstlane(tid >> 6), lane = tid & 63, r32 = lane & 31, hi = lane >> 5;
    const int NT = 4 * cur.qb + 4;
    const int qlo = cur.qb * QB + wid * QBLK, qm = qlo + r32 - 4 * hi;
    char* V_lds = lds; char* K_lds = lds + 2 * SHM_V;
    float* ws = (float*)(lds + LDS_WS) + wid * 64; float* li_l = ws, * al_l = ws + 32;
    float m_reg = -1e30f, l_reg = 0; f32x16 o[4] = {};
    const int sr = tid >> 4, sc = (tid & 15) * 8, vst0 = v_st(sr, sc), vst1 = v_st(32 + sr, sc), kws = KSWZ(sr, sc * 2);
    const int vb0 = (int)(uintptr_t)V_lds + v_rd_base(lane);
    const bf16_t* Kh = ptrK(wsb, cur); const bf16_t* Vh = ptrV(wsb, cur);
    const float sl = exp2f(-(float)(cur.h + 1)) * 11.313708498984761f;
    f32x16 kc;
#pragma unroll
    for (int r = 0; r < 16; ++r) kc[r] = sl * (float)((r & 3) + 8 * (r >> 2));
    unsigned selbits = 0xffu;
    if (GRP == 1) {
        float* km = (float*)(lds + LDS_KM);
        const float* KM = (const float*)(wsb + WS_KMEAN) + ((size_t)(cur.b * NBLK) * NH + cur.h) * 128;
        if (tid < cur.qb * 32) { const int n = tid >> 5, c4 = (tid & 31) * 4; *(f32x4*)(km + n * 128 + c4) = *(const f32x4*)(KM + (size_t)n * (NH * 128) + c4); }
        __syncthreads();
        float v1 = -__builtin_inff(), v2 = v1, v3 = v1; int i1 = 31, i2 = 31, i3 = 31;
#pragma unroll 1
        for (int n = 0; n < cur.qb; ++n) { float a = 0.f;
#pragma unroll
            for (int d0 = 0; d0 < 8; ++d0) { const f32x4 k0 = *(const f32x4*)(km + n * 128 + d0 * 16 + hi * 8), k1 = *(const f32x4*)(km + n * 128 + d0 * 16 + hi * 8 + 4);
                const bf16x8 q = S.qr[d0];
                a += bf2f((bf16_t)q[0]) * k0[0] + bf2f((bf16_t)q[1]) * k0[1] + bf2f((bf16_t)q[2]) * k0[2] + bf2f((bf16_t)q[3]) * k0[3]
                   + bf2f((bf16_t)q[4]) * k1[0] + bf2f((bf16_t)q[5]) * k1[1] + bf2f((bf16_t)q[6]) * k1[2] + bf2f((bf16_t)q[7]) * k1[3]; }
            const float other = __shfl_xor(a, 32); const float g = a + other;
            const bool c1 = g > v1, c2 = g > v2, c3 = g > v3;
            v3 = c2 ? v2 : (c3 ? g : v3); i3 = c2 ? i2 : (c3 ? n : i3);
            v2 = c1 ? v1 : (c2 ? g : v2); i2 = c1 ? i1 : (c2 ? n : i2);
            v1 = c1 ? g : v1;             i1 = c1 ? n : i1; }
        selbits = ((1u << i1) | (1u << i2) | (1u << i3)) & 0xffu;
    }
    const char* mst = lds + LDS_OST + wid * MST_WAVE + r32 * MST_PITCH;
    if (GRP == 0) {
        const char* src = (const char*)(wsb + WS_MASK) + ((size_t)cur.b * SEQ + qlo) * 256 + (unsigned)(r32 * 256 + hi * 128);
        u32x4 tmp[8];
#pragma unroll
        for (int i = 0; i < 8; ++i) tmp[i] = *(const u32x4*)(src + 16 * i);
#pragma unroll
        for (int i = 0; i < 8; ++i) { unsigned long long* d = (unsigned long long*)(mst + hi * 128 + 16 * i);
            d[0] = (unsigned long long)tmp[i][0] | ((unsigned long long)tmp[i][1] << 32); d[1] = (unsigned long long)tmp[i][2] | ((unsigned long long)tmp[i][3] << 32); }
    }
#define RESC(a) do { if (__any((a) < 1.f)) { if (hi == 0) al_l[r32] = (a); asm volatile("s_waitcnt lgkmcnt(0)" ::: "memory");              \
                     for (int d_ = 0; d_ < 4; ++d_) for (int r = 0; r < 16; ++r) o[d_][r] *= al_l[crow(r, hi)]; } } while (0)
#define TIX(u) (NT - 1 - (u))
#define KBASE(u) (TIX(u) * KVBLK)
#define CB(u) ((GRP == 1 && TIX(u) < 4 * cur.qb && !((selbits >> (TIX(u) >> 2)) & 1u)) ? -__builtin_inff() : sl * (float)(KBASE(u) - qm))
#define MLOAD(u) ((GRP == 0) ? *(const unsigned long long*)(mst + TIX(u) * 8) : 0ull)
    constexpr float C2_ = 1.4426950408889634f * SCALE;
#define ACT(u) (!((qlo - KBASE(u) - (KVBLK - 1)) > 0 && __all((Bq - sl * (float)(qlo - KBASE(u) - (KVBLK - 1)) - m_reg) * C2_ < -160.f)))
#define MASKT(P0_, P1_, t, mw) do { const int kb_ = KBASE(t); \
        if (GRP == 0) { mask_bits(P0_, P1_, ((unsigned)(mw)) >> (4 * hi), ((unsigned)((mw) >> 32)) >> (4 * hi)); } \
        else if (kb_ + KVBLK - 1 > qlo) mask_causal(P0_, P1_, qm - kb_); } while (0)
    f32x16 pA0, pA1, pB0, pB1; float mnA, mnB, alA = 1.f, alB = 1.f;
    unsigned long long mwA, mwB; bool actA = true, actB = true;
    volatile unsigned* vote = (volatile unsigned*)(lds + LDS_KM + 4096 + 64);
    SWRITE_HV(0); SBAR();
    if (NT > 1) SLOAD_H(Kh, Vh, KBASE(1));
    mwA = MLOAD(0);
    SBAR(); qkt<0>(pA0, pA1, K_lds, r32, hi, S.qr, kc, true);
    MASKT(pA0, pA1, 0, mwA); { const float cb_ = CB(0); partialSM(pA0, pA1, m_reg, mnA, alA, cb_, cb_ + 32.f * sl); }
    if (NT > 1) { VMW(); SWRITE_H(1); }
    __syncthreads();
#define HALF_STEP(PX0, PX1, mnX, alX, mwX, actX, PY0, PY1, alY, actY, t, KB, VB, SB) do {                                     \
        actX = ACT(t);                                                                                                        \
        SBAR(); qkt<KB>(PX0, PX1, K_lds, r32, hi, S.qr, kc, actX); SBAR();                                             \
        if ((t) + 1 < NT) { SLOAD_H(Kh, Vh, KBASE((t) + 1)); SBAR(); }                                                        \
        mwX = MLOAD(t);                                                                                                       \
        if (actY) { bf16x8 pa0, pa1, pa2, pa3; finishSM(PY0, PY1, alY, l_reg, pa0, pa1, pa2, pa3); SBAR(); pv_tile<VB>(o, vb0, pa0, pa1, pa2, pa3, true); } \
        alX = 1.f; if (actX) { MASKT(PX0, PX1, (t), mwX); const float cb_ = CB(t); partialSM(PX0, PX1, m_reg, mnX, alX, cb_, cb_ + 32.f * sl); }                             \
        __syncthreads();                                                                                                      \
        if ((t) + 1 < NT) { VMW(); SWRITE_H(SB); }                                                                            \
        RESC(alX); } while (0)
    for (int t = 1; t + 1 < NT; t += 2) {
        HALF_STEP(pB0, pB1, mnB, alB, mwB, actB, pA0, pA1, alA, actA, t, 1, 0, 0); __syncthreads();
        HALF_STEP(pA0, pA1, mnA, alA, mwA, actA, pB0, pB1, alB, actB, t + 1, 0, 1, 1);
        if (lane == 0 && actA) vote[(t >> 1) & 1] = 1u;
        __syncthreads();
        const unsigned any_ = vote[(t >> 1) & 1];
        if (tid == 0) vote[((t >> 1) & 1) ^ 1] = 0u;
        if (!any_) break;
    }
    actB = ACT(NT - 1); SBAR(); qkt<1>(pB0, pB1, K_lds, r32, hi, S.qr, kc, actB); SBAR(); mwB = MLOAD(NT - 1);
    if (actA) { bf16x8 pa0, pa1, pa2, pa3; finishSM(pA0, pA1, alA, l_reg, pa0, pa1, pa2, pa3); SBAR(); pv_tile<0>(o, vb0, pa0, pa1, pa2, pa3, true); }
    alB = 1.f; if (actB) { MASKT(pB0, pB1, NT - 1, mwB); const float cb_ = CB(NT - 1); partialSM(pB0, pB1, m_reg, mnB, alB, cb_, cb_ + 32.f * sl); } __syncthreads(); RESC(alB);
    if (actB) { bf16x8 pa0, pa1, pa2, pa3; finishSM(pB0, pB1, alB, l_reg, pa0, pa1, pa2, pa3); SBAR(); pv_tile<1>(o, vb0, pa0, pa1, pa2, pa3, true); }
    if (hi == 0) li_l[r32] = l_reg; asm volatile("s_waitcnt lgkmcnt(0)" ::: "memory");
    float rli[16];
#pragma unroll
    for (int r = 0; r < 16; ++r) rli[r] = __builtin_amdgcn_rcpf(li_l[crow(r, hi)]);
    { bf16_t* stg = (bf16_t*)(lds + LDS_OST) + wid * (QBLK * D);
      int lane_e = lane; asm volatile("" : "+v"(lane_e));
      bf16_t* stw = stg + (4 * (lane_e >> 5)) * D + (lane_e & 31);
#pragma unroll
      for (int r = 0; r < 16; ++r) { const int orow = (r & 3) + 8 * (r >> 2);
#pragma unroll
          for (int d0 = 0; d0 < 4; ++d0) stw[orow * D + d0 * 32] = (bf16_t)cvt1(o[d0][r] * rli[r]); }
      asm volatile("s_waitcnt lgkmcnt(0)" ::: "memory");
      char* Ow = (char*)(wsb + WS_Y8) + ((size_t)cur.b * SEQ + qlo) * 2048 + cur.grp * 1024 + cur.h * 128;
      const char* Zw = (const char*)(ptrZ(wsb, cur) + (size_t)(wid * QBLK) * D);
      const unsigned eo = (unsigned)((lane_e >> 4) * 256 + (lane_e & 15) * 16), yo = (unsigned)((lane_e >> 4) * 2048 + (lane_e & 15) * 8);
#pragma unroll
      for (int i = 0; i < 8; ++i) {
          const u32x4 ov = *(const u32x4*)((const char*)stg + (eo + (unsigned)(i * 1024))), zv = *(const u32x4*)(Zw + (eo + (unsigned)(i * 1024))); float f[8];
#pragma unroll
          for (int j = 0; j < 4; ++j) { f[2 * j] = __uint_as_float(ov[j] << 16) * __uint_as_float(zv[j] << 16) * 8.f; f[2 * j + 1] = __uint_as_float(ov[j] & 0xffff0000u) * __uint_as_float(zv[j] & 0xffff0000u) * 8.f; }
          const unsigned long long w = (unsigned long long)pk4_fp8(f[0], f[1], f[2], f[3]) | ((unsigned long long)pk4_fp8(f[4], f[5], f[6], f[7]) << 32);
          *(unsigned long long*)(Ow + (yo + (unsigned)(i * 8192))) = w; } }
    __syncthreads();
#undef RESC
#undef TIX
#undef ACT
#undef KBASE
#undef CB
#undef MLOAD
#undef MASKT
#undef HALF_STEP
}
#undef ROW
#undef VMW
#undef VMWN
#undef SLOAD_H
#undef SWRITE_HK
#undef SWRITE_HV
#undef SWRITE_H
struct ClassOrder { unsigned char v[64]; };
constexpr int class_cost(int c) { const int h = c >> 3, qb = c & 7, full = 4 * qb + 4, cap = h == 0 ? 10 : h == 1 ? 14 : h == 2 ? 22 : 32; return full < cap ? full : cap; }
constexpr ClassOrder make_order() { ClassOrder o{}; for (int i = 0; i < 64; ++i) o.v[i] = (unsigned char)i;
    for (int i = 1; i < 64; ++i) { const unsigned char x = o.v[i]; int j = i - 1; while (j >= 0 && class_cost(o.v[j]) < class_cost(x)) { o.v[j + 1] = o.v[j]; --j; } o.v[j + 1] = x; }
    return o; }
__device__ __forceinline__ void decode(int p, BlockRef& r) { constexpr ClassOrder ORD = make_order(); const int c = ORD.v[p >> 4], m = p & 15; r.h = c >> 3; r.qb = c & 7; r.grp = m >> 3; r.b = m & 7; }
__device__ __forceinline__ void attn_phase(char* lds, unsigned char* wsb, int v, int G) {
    const int tid = threadIdx.x, lane = tid & 63;
    float BqG[2];
    { const float* G_ = (const float*)(wsb + WS_GAIN);
#pragma unroll
      for (int gsel = 0; gsel < 2; ++gsel) { const float* gq = G_ + gsel * 256; const float* gk = gq + 128;
          float mq = fmaxf(fabsf(gq[lane]), fabsf(gq[lane + 64])), mk = fmaxf(fabsf(gk[lane]), fabsf(gk[lane + 64]));
          mq = wave_max(mq); mk = wave_max(mk); BqG[gsel] = __uint_as_float(__builtin_amdgcn_readfirstlane(__float_as_uint(128.f * 1.02f * mq * mk))); } }
    if (tid == 0) { ((volatile unsigned*)(lds + LDS_KM + 4096 + 64))[0] = 0u; ((volatile unsigned*)(lds + LDS_KM + 4096 + 64))[1] = 0u; }
    Seam S;
    for (int r = 0; r * G < 1024; ++r) {
        const int p = r * G + ((r & 1) ? G - 1 - v : v); if (p >= 1024) continue;
        BlockRef cur; decode(p, cur);
        prime(cur, wsb, lds, S);
        block(cur, wsb, lds, S, cur.grp ? BqG[1] : BqG[0]);
    }
}
#undef KSWZ
#undef SBAR
}

namespace sel {
#define SLAS __attribute__((address_space(3)))
typedef short bf16x8 __attribute__((ext_vector_type(8)));
typedef float f32x16 __attribute__((ext_vector_type(16)));
typedef float f32x4 __attribute__((ext_vector_type(4)));
typedef unsigned u32x4 __attribute__((ext_vector_type(4)));
constexpr int KB_OFF = 131072;
constexpr int LIST_OFF = 147456 + 2048;
__device__ __forceinline__ unsigned fkey(float x) { const unsigned b = __float_as_uint(x); return (b & 0x80000000u) ? ~b : (b | 0x80000000u); }
__device__ __forceinline__ void unit(SLAS unsigned char* lds, unsigned char* wsb, int b, int rg) {
    const int tid = threadIdx.x, wid = __builtin_amdgcn_readfirstlane(tid >> 6), lane = tid & 63, j = lane & 31, g = lane >> 5;
    const bf16_t* QI = (const bf16_t*)(wsb + WS_QI); const char* KIb = (const char*)((const bf16_t*)(wsb + WS_KI) + (size_t)b * SEQ * 64); const float* WI = (const float*)(wsb + WS_WI);
    unsigned long long* MASK = (unsigned long long*)(wsb + WS_MASK);
    const int ta = 16 * rg + 2 * wid, t = ta + g;
    const int nkeys = 16 * rg + 16, nk32 = (nkeys + 31) >> 5, nch = (nkeys + 63) >> 6;
    SLAS float* sc = (SLAS float*)lds + (wid * 2 + g) * 2048 + j;
    float vmin = __builtin_inff(), vmax = -__builtin_inff();
    bf16x8 af[4];
    { const int i = lane & 31, tok = (i >> 2) & 1, head = (i & 3) + 4 * (i >> 3);
      const bf16_t* qp = QI + ((size_t)b * SEQ + ta + tok) * 1024 + head * 64 + 8 * (lane >> 5);
#pragma unroll
      for (int ks = 0; ks < 4; ++ks) af[ks] = *(const bf16x8*)(qp + 16 * ks); }
    float wv[16];
    { const float* wp = WI + ((size_t)b * SEQ + t) * 16;
#pragma unroll
      for (int q4 = 0; q4 < 4; ++q4) { const f32x4 w4 = *(const f32x4*)(wp + 4 * q4); wv[4 * q4] = w4[0] * 0.03125f; wv[4 * q4 + 1] = w4[1] * 0.03125f; wv[4 * q4 + 2] = w4[2] * 0.03125f; wv[4 * q4 + 3] = w4[3] * 0.03125f; } }
    const int srow = tid >> 3, scol = tid & 7, swr = srow * 128 + ((scol ^ ((srow >> 1) & 7)) << 4);
    int koff[4];
#pragma unroll
    for (int ks = 0; ks < 4; ++ks) koff[ks] = j * 128 + (((2 * ks + g) ^ ((j >> 1) & 7)) << 4);
    u32x4 stA = *(const u32x4*)(KIb + (unsigned)(tid * 16)), stB = stA;
    *(SLAS u32x4*)(lds + KB_OFF + swr) = stA;
    stA = *(const u32x4*)(KIb + (unsigned)(min(1, nch - 1) * 8192 + tid * 16));
    stB = *(const u32x4*)(KIb + (unsigned)(min(2, nch - 1) * 8192 + tid * 16));
    __syncthreads();
#define SEL_EPI(ACC, kt) do { float s0 = 0.f, s1 = 0.f, s2 = 0.f, s3 = 0.f; \
        _Pragma("unroll") for (int r = 0; r < 4; ++r) { s0 = fmaf(wv[r], fmaxf(ACC[r], 0.f), s0); s1 = fmaf(wv[4 + r], fmaxf(ACC[4 + r], 0.f), s1); \
                                                       s2 = fmaf(wv[8 + r], fmaxf(ACC[8 + r], 0.f), s2); s3 = fmaf(wv[12 + r], fmaxf(ACC[12 + r], 0.f), s3); } \
        const float s = (s0 + s1) + (s2 + s3); \
        if (32 * (kt) + j <= t) { vmin = fminf(vmin, s); vmax = fmaxf(vmax, s); }     \
        sc[32 * (kt)] = s; } while (0)
#define SEL_TILES(cc) do { SLAS unsigned char* kb = lds + KB_OFF + ((cc) & 1) * 8192; const int kt0 = 2 * (cc); \
        if (kt0 + 1 < nk32) {                                  \
            f32x16 acc0 = {}, acc1 = {}; \
            _Pragma("unroll") for (int ks = 0; ks < 4; ++ks) { const bf16x8 b0 = *(const SLAS bf16x8*)(kb + koff[ks]), b1 = *(const SLAS bf16x8*)(kb + 4096 + koff[ks]); \
                acc0 = __builtin_amdgcn_mfma_f32_32x32x16_bf16(af[ks], b0, acc0, 0, 0, 0); acc1 = __builtin_amdgcn_mfma_f32_32x32x16_bf16(af[ks], b1, acc1, 0, 0, 0); } \
            SEL_EPI(acc0, kt0); SEL_EPI(acc1, kt0 + 1); \
        } else if (kt0 < nk32) { f32x16 acc0 = {}; \
            _Pragma("unroll") for (int ks = 0; ks < 4; ++ks) { const bf16x8 b0 = *(const SLAS bf16x8*)(kb + koff[ks]); acc0 = __builtin_amdgcn_mfma_f32_32x32x16_bf16(af[ks], b0, acc0, 0, 0, 0); } \
            SEL_EPI(acc0, kt0); } } while (0)
#pragma unroll 1
    for (int c = 0; c < nch; c += 2) {
        SEL_TILES(c);
        *(SLAS u32x4*)(lds + KB_OFF + 8192 + swr) = stA; stA = *(const u32x4*)(KIb + (unsigned)(min(c + 3, nch - 1) * 8192 + tid * 16));
        __syncthreads();
        SEL_TILES(c + 1);
        *(SLAS u32x4*)(lds + KB_OFF + swr) = stB; stB = *(const u32x4*)(KIb + (unsigned)(min(c + 4, nch - 1) * 8192 + tid * 16));
        __syncthreads();
    }
#undef SEL_TILES
#undef SEL_EPI
    unsigned T = 0u; int need = 0; bool ties = false;
    if (16 * rg >= TOPK) {
        SLAS unsigned* hist = (SLAS unsigned*)(lds + KB_OFF) + (wid * 2 + g) * 256;
#pragma unroll
        for (int off = 1; off < 32; off <<= 1) { vmin = fminf(vmin, __shfl_xor(vmin, off)); vmax = fmaxf(vmax, __shfl_xor(vmax, off)); }
        const float range = vmax - vmin, inv = (range > 0.f) ? 255.99f / range : 0.f;
        *(SLAS u32x4*)(hist + 8 * j) = (u32x4){0u, 0u, 0u, 0u}; *(SLAS u32x4*)(hist + 8 * j + 4) = (u32x4){0u, 0u, 0u, 0u};
#pragma unroll 1
        for (int kt0 = 0; kt0 < nk32; kt0 += 4) { float x[4];
#pragma unroll
            for (int i = 0; i < 4; ++i) x[i] = sc[32 * (kt0 + i)];
#pragma unroll
            for (int i = 0; i < 4; ++i) if (32 * (kt0 + i) + j <= t) { const int q = min((int)((x[i] - vmin) * inv), 255); __hip_atomic_fetch_add(hist + q, 1u, __ATOMIC_RELAXED, __HIP_MEMORY_SCOPE_WORKGROUP); } }
        asm volatile("s_waitcnt lgkmcnt(0)" ::: "memory");
        int qsel, cB;
        { const u32x4 c0 = *(const SLAS u32x4*)(hist + 8 * j), c1 = *(const SLAS u32x4*)(hist + 8 * j + 4);
          const int cnt[8] = {(int)c0[0], (int)c0[1], (int)c0[2], (int)c0[3], (int)c1[0], (int)c1[1], (int)c1[2], (int)c1[3]};
          const int s = ((cnt[0] + cnt[1]) + (cnt[2] + cnt[3])) + ((cnt[4] + cnt[5]) + (cnt[6] + cnt[7]));
          int S = s;
#pragma unroll
          for (int off = 1; off < 32; off <<= 1) { const int v = __shfl_down(S, off, 32); if (j + off < 32) S += v; }
          const int above = S - s;
          const bool found = (S >= TOPK) && (above < TOPK);
          int dsel = 0, nneed = 0, csel = 0;
          { const int rem = TOPK - above; int cum = 0; bool done = false;
#pragma unroll
            for (int i = 7; i >= 0; --i) { const int before = cum; cum += cnt[i]; if (!done && cum >= rem) { done = true; dsel = 8 * j + i; nneed = rem - before; csel = cnt[i]; } } }
          const unsigned long long bm = __ballot(found);
          const int src = 32 * g + __builtin_ctz((unsigned)(bm >> (32 * g)) | 0x80000000u);
          qsel = __shfl(dsel, src); need = __shfl(nneed, src); cB = __shfl(csel, src); }
        if (!__any(cB > 64)) {
            SLAS unsigned* list = (SLAS unsigned*)(lds + LIST_OFF) + (wid * 2 + g) * 128;
            int base = 0;
#pragma unroll 1
            for (int kt0 = 0; kt0 < nk32; kt0 += 4) { float x[4];
#pragma unroll
                for (int i = 0; i < 4; ++i) x[i] = sc[32 * (kt0 + i)];
#pragma unroll
                for (int i = 0; i < 4; ++i) { const int kt = kt0 + i;
                    const bool m = (32 * kt + j <= t) && (min((int)((x[i] - vmin) * inv), 255) == qsel);
                    const unsigned long long bal = __ballot(m); const unsigned hm = g ? (unsigned)(bal >> 32) : (unsigned)bal;
                    if (m) { const int pos = base + __builtin_popcount(hm & ((1u << j) - 1u)); list[2 * pos] = fkey(x[i]); list[2 * pos + 1] = (unsigned)(32 * kt + j); }
                    base += __builtin_popcount(hm); } }
            asm volatile("s_waitcnt lgkmcnt(0)" ::: "memory");
            const unsigned u0 = list[2 * j], i0 = list[2 * j + 1], u1 = list[2 * (j + 32)], i1 = list[2 * (j + 32) + 1];
            int r0 = 0, r1 = 0; const int cmax = max(cB, __shfl_xor(cB, 32));
#pragma unroll 1
            for (int e = 0; e < cmax; ++e) { const unsigned ue = list[2 * e], ie = list[2 * e + 1]; const bool in = e < cB;
                r0 += (in && (ue > u0 || (ue == u0 && ie < i0))) ? 1 : 0; r1 += (in && (ue > u1 || (ue == u1 && ie < i1))) ? 1 : 0; }
            const bool h0 = (j < cB) && (r0 == need - 1), h1 = (j + 32 < cB) && (r1 == need - 1);
            const unsigned long long bh = __ballot(h0 || h1);
            const int src = 32 * g + __builtin_ctz((unsigned)(bh >> (32 * g)) | 0x80000000u);
            T = __shfl(h0 ? u0 : u1, src);
            const unsigned long long bg0 = __ballot(j < cB && u0 > T), bg1 = __ballot(j + 32 < cB && u1 > T), be0 = __ballot(j < cB && u0 == T), be1 = __ballot(j + 32 < cB && u1 == T);
            const int ngt = __builtin_popcount(g ? (unsigned)(bg0 >> 32) : (unsigned)bg0) + __builtin_popcount(g ? (unsigned)(bg1 >> 32) : (unsigned)bg1);
            const int neq = __builtin_popcount(g ? (unsigned)(be0 >> 32) : (unsigned)be0) + __builtin_popcount(g ? (unsigned)(be1 >> 32) : (unsigned)be1);
            need = need - ngt; ties = (neq != need);
        } else {
            unsigned prefix = 0u; need = TOPK; int ceq = 0;
#pragma unroll 1
            for (int p = 0; p < 4; ++p) { const int shift = 24 - 8 * p;
                *(SLAS u32x4*)(hist + 8 * j) = (u32x4){0u, 0u, 0u, 0u}; *(SLAS u32x4*)(hist + 8 * j + 4) = (u32x4){0u, 0u, 0u, 0u};
                const unsigned phi = prefix >> ((shift + 8) & 31);
#pragma unroll 1
                for (int kt = 0; kt < nk32; ++kt) { const unsigned x = fkey(sc[32 * kt]);
                    const bool match = (32 * kt + j <= t) && ((p == 0) || ((x >> ((shift + 8) & 31)) == phi));
                    if (match) __hip_atomic_fetch_add(hist + ((x >> shift) & 255u), 1u, __ATOMIC_RELAXED, __HIP_MEMORY_SCOPE_WORKGROUP); }
                asm volatile("s_waitcnt lgkmcnt(0)" ::: "memory");
                const u32x4 c0 = *(const SLAS u32x4*)(hist + 8 * j), c1 = *(const SLAS u32x4*)(hist + 8 * j + 4);
                const int cnt[8] = {(int)c0[0], (int)c0[1], (int)c0[2], (int)c0[3], (int)c1[0], (int)c1[1], (int)c1[2], (int)c1[3]};
                const int s = ((cnt[0] + cnt[1]) + (cnt[2] + cnt[3])) + ((cnt[4] + cnt[5]) + (cnt[6] + cnt[7]));
                int S = s;
#pragma unroll
                for (int off = 1; off < 32; off <<= 1) { const int v = __shfl_down(S, off, 32); if (j + off < 32) S += v; }
                const int above = S - s;
                const bool found = (S >= need) && (above < need);
                int dsel = 0, nneed = 0, csel = 0;
                { const int rem = need - above; int cum = 0; bool done = false;
#pragma unroll
                  for (int i = 7; i >= 0; --i) { const int before = cum; cum += cnt[i]; if (!done && cum >= rem) { done = true; dsel = 8 * j + i; nneed = rem - before; csel = cnt[i]; } } }
                const unsigned long long bm = __ballot(found);
                const int src = 32 * g + __builtin_ctz((unsigned)(bm >> (32 * g)) | 0x80000000u);
                const int digit = __shfl(dsel, src); need = __shfl(nneed, src); ceq = __shfl(csel, src);
                prefix |= (unsigned)digit << shift;
            }
            T = prefix; ties = (ceq != need);
        }
    }
    unsigned wlo = 0u, whi = 0u;
    if (!__any(ties)) {
#pragma unroll 4
        for (int k64 = 0; k64 < 32; ++k64) {
            const bool s0 = (64 * k64 + j <= t) && (fkey(sc[64 * k64]) >= T), s1 = (64 * k64 + 32 + j <= t) && (fkey(sc[64 * k64 + 32]) >= T);
            const unsigned long long b0 = __ballot(s0), b1 = __ballot(s1);
            const unsigned lo = g ? (unsigned)(b0 >> 32) : (unsigned)b0, hi = g ? (unsigned)(b1 >> 32) : (unsigned)b1;
            if (j == k64) { wlo = lo; whi = hi; } }
    } else {
        int base = 0;
#pragma unroll 1
        for (int k64 = 0; k64 < 32; ++k64) { unsigned lo = 0u, hi = 0u;
#pragma unroll
            for (int hh = 0; hh < 2; ++hh) { const bool vld = (64 * k64 + 32 * hh + j <= t); const unsigned x = vld ? fkey(sc[64 * k64 + 32 * hh]) : 0u;
                const unsigned long long be = __ballot(vld && x == T); const unsigned em = g ? (unsigned)(be >> 32) : (unsigned)be;
                const int rank = base + __builtin_popcount(em & ((1u << j) - 1u));
                const bool s1 = vld && ((x > T) || (x == T && rank < need));
                base += __builtin_popcount(em);
                const unsigned long long bs = __ballot(s1); const unsigned sm = g ? (unsigned)(bs >> 32) : (unsigned)bs;
                if (hh == 0) lo = sm; else hi = sm; }
            if (j == k64) { wlo = lo; whi = hi; } }
    }
    MASK[((size_t)b * SEQ + t) * 32 + j] = (unsigned long long)wlo | ((unsigned long long)whi << 32);
    __syncthreads();
}
__device__ __forceinline__ void kmean_unit(SLAS unsigned char* lds, unsigned char* wsb, int b, int n, int h) {
    const int tid = threadIdx.x, d4 = tid & 31, rs = tid >> 5;
    const bf16_t* KB = (const bf16_t*)(wsb + WS_KB) + (((size_t)(b * NH + h) * SEQ) + n * 256) * 128;
    float a0 = 0.f, a1 = 0.f, a2 = 0.f, a3 = 0.f;
#pragma unroll 4
    for (int r = 0; r < 16; ++r) { const unsigned long long v = *(const unsigned long long*)(KB + (size_t)(rs * 16 + r) * 128 + d4 * 4);
        const unsigned lo = (unsigned)v, hi = (unsigned)(v >> 32);
        a0 += __uint_as_float(lo << 16); a1 += __uint_as_float(lo & 0xffff0000u); a2 += __uint_as_float(hi << 16); a3 += __uint_as_float(hi & 0xffff0000u); }
    SLAS float* red = (SLAS float*)lds;
    *(SLAS f32x4*)(red + rs * 128 + d4 * 4) = (f32x4){a0, a1, a2, a3};
    __syncthreads();
    if (tid < 128) { float s = 0.f;
#pragma unroll
        for (int q = 0; q < 16; ++q) s += red[q * 128 + tid];
        ((float*)(wsb + WS_KMEAN))[((size_t)(b * NBLK + n) * NH + h) * 128 + tid] = s * (1.f / 256.f); }
    __syncthreads();
}
__device__ __forceinline__ void select_phase(SLAS unsigned char* lds, unsigned char* wsb, int v, int G) {
    for (int L = v; L < 512; L += G) kmean_unit(lds, wsb, L >> 6, (L >> 3) & 7, L & 7);
    for (int L = v; L < 512; L += G) { const int b = L >> 6, x = L & 63;
        unit(lds, wsb, b, x);
        unit(lds, wsb, b, 127 - x); }
}
#undef SLAS
}

struct Args { const float* in[12]; float* out; unsigned char* ws; int ph_lo, ph_hi, li, pad; };
__global__ void __launch_bounds__(NWAVES * 64, 2) mega_fwd(Args args) {
    extern __shared__ __attribute__((aligned(16))) unsigned char lds[];
    Frame F;
    F.lds = (LAS unsigned char*)lds; F.MISC = (volatile LAS unsigned*)(F.lds + MISC_OFF);
    F.tid = threadIdx.x; F.lane = F.tid & 63; F.wave = __builtin_amdgcn_readfirstlane(F.tid >> 6);
    F.G = gridDim.x; { const int bx = blockIdx.x; F.vcu = (F.G % 8 == 0) ? (bx % 8) * (F.G / 8) + bx / 8 : bx; }
    unsigned char* ws = args.ws;
    F.ctl = (gu32*)(ws + WS_CTL);
    const float* x = args.in[0]; const float* c = args.in[1]; const float* w_ada = args.in[2]; const float* b_ada = args.in[3]; const float* g_norm = args.in[4];
    const float* w_in = args.in[5]; const float* w_out = args.in[11];
    float* MOD = (float*)(ws + WS_MOD); bf16_t* WinT = (bf16_t*)(ws + WS_WIN); bf16_t* HB = (bf16_t*)(ws + WS_HB); bf16_t* Y = (bf16_t*)(ws + WS_Y);
    for (int u = F.tid; u < (LDS_BYTES - LDSCTL_OFF) / 4; u += NWAVES * 64) ((LAS unsigned*)(F.lds + LDSCTL_OFF))[u] = 0u;
    __syncthreads();
    XcdBarrier bar = xcd_barrier_post((unsigned*)(F.ctl + CW_BAR) + args.li * XCD_BAR_WORDS, F.MISC + 8);
    const int lo = args.ph_lo, hi = args.ph_hi;
#define IN(k) (lo <= (k) && (k) < hi)
#define BOTH(k) (IN(k) && IN((k) + 1))
    if (IN(0)) for (int rep_ = 0; rep_ < (((PROBE_DOUBLE) >> 0) & 1) + 1; ++rep_) {
        if (rep_) __syncthreads();
        for (int id = (int)blockIdx.x; id < 256; id += F.G) p0_mod(F, id, c, w_ada, (float*)(ws + WS_MODP));
        if ((int)blockIdx.x == 192) { float* G = (float*)(ws + WS_GAIN);
            if (F.tid < 128) { G[F.tid] = args.in[6][F.tid]; G[128 + F.tid] = args.in[7][F.tid]; G[256 + F.tid] = args.in[9][F.tid]; G[384 + F.tid] = args.in[10][F.tid]; }
            if (F.tid < 64) G[512 + F.tid] = args.in[8][F.tid]; }
        p0_convert(F, w_in, w_out, WinT, ws + WS_WIN8, ws + WS_WOUT8);
    }
    if (BOTH(0)) xcd_barrier(bar);
    if (IN(1)) for (int rep_ = 0; rep_ < (((PROBE_DOUBLE) >> 1) & 1) + 1; ++rep_) p1_norm(F, x, g_norm, (const float*)(ws + WS_MODP), b_ada, MOD, HB, ws + WS_HB8);
    if (BOTH(1)) xcd_barrier(bar);
    if (IN(2)) for (int rep_ = 0; rep_ < (((PROBE_DOUBLE) >> 2) & 1) + 1; ++rep_) {
        { pg8::Gemm g{ws + WS_HB8, ws + WS_WIN8, M, 28 * 256, DM}; pg8::StaticOrder S; S.init(M, 28 * 256, F.G, (int)blockIdx.x, 0, 16, 9, F.G == 256 ? 64 : 0);
          EpiProj E{ws, (LAS float*)(F.lds + EPI_OFF), FP8_DESCALE};
          pg8::gemm_phase<EpiProj, pg8::StaticOrder, true, true, true>(F.lds, g, S, E); }
        { pg8::Gemm g{HB, WinT, M, 9 * 256, DM}; pg8::StaticOrder S; S.init(M, 9 * 256, F.G, (int)blockIdx.x, 16);
          EpiProj E{ws, (LAS float*)(F.lds + EPI_OFF), 1.f};
          pg8::gemm_phase<EpiProj, pg8::StaticOrder, true, true, false>(F.lds, g, S, E); }
    }
    if (BOTH(2)) xcd_barrier(bar);
    if (IN(3)) for (int rep_ = 0; rep_ < (((PROBE_DOUBLE) >> 3) & 1) + 1; ++rep_) sel::select_phase(F.lds, ws, F.vcu, F.G);
    if (BOTH(3)) xcd_barrier(bar);
    if (IN(4)) {
#pragma unroll 1
        for (int rep_ = 0; rep_ < (((PROBE_DOUBLE) >> 4) & 1) + 1; ++rep_) att::attn_phase((char*)lds, ws, F.vcu, F.G);
    }
    if (BOTH(4)) xcd_barrier(bar);
    if (IN(5)) for (int rep_ = 0; rep_ < (((PROBE_DOUBLE) >> 5) & 1) + 1; ++rep_) {
        pg8::Gemm g{ws + WS_Y8, ws + WS_WOUT8, M, DM, DM}; pg8::StaticOrder S; S.init(M, DM, F.G, (int)blockIdx.x);
        EpiOut E{x, MOD, args.out, FP8_DESCALE};
        pg8::gemm_phase<EpiOut, pg8::StaticOrder, true, true, true>(F.lds, g, S, E);
    }
#undef IN
#undef BOTH
}

static int mega_setup() {
    static int grid = 0;
    if (grid == 0) {
        int dev = 0, cus = 0;
        if (hipGetDevice(&dev) != hipSuccess || hipDeviceGetAttribute(&cus, hipDeviceAttributeMultiprocessorCount, dev) != hipSuccess) { fprintf(stderr, "kernel_launch: device query failed\n"); grid = -1; return grid; }
        if (hipFuncSetAttribute((const void*)mega_fwd, hipFuncAttributeMaxDynamicSharedMemorySize, LDS_BYTES) != hipSuccess) { fprintf(stderr, "kernel_launch: hipFuncSetAttribute failed\n"); grid = -1; return grid; }
        (void)hipGetLastError();
        grid = cus;
    }
    return grid;
}
static void mega_launch(int grid, void* const* d_in, void* d_out, void* d_ws, int ph_lo, int ph_hi, int li, hipStream_t stream) {
    Args a{};
    for (int i = 0; i < 12; ++i) a.in[i] = (const float*)d_in[i];
    a.out = (float*)d_out; a.ws = (unsigned char*)d_ws; a.ph_lo = ph_lo; a.ph_hi = ph_hi; a.li = li;
    hipLaunchKernelGGL(mega_fwd, dim3(grid), dim3(NWAVES * 64), LDS_BYTES, stream, a);
}

extern "C" void kernel_launch(void* const* d_in, const int* in_sizes, int n_in, void* d_out, int out_size, void* d_ws, size_t ws_size, hipStream_t stream) {
    if (n_in != 12 || in_sizes[0] != M * DM || out_size != M * DM || ws_size < WS_END) {
        fprintf(stderr, "kernel_launch: unexpected shapes (n_in %d, in0 %d, out %d, ws %zu); nothing launched\n", n_in, n_in > 0 ? in_sizes[0] : -1, out_size, ws_size); return; }
    const int grid = mega_setup(); if (grid <= 0) return;
    char* ws = (char*)d_ws;
    bf16_t* QA = (bf16_t*)(ws + WS_QA); bf16_t* KA = (bf16_t*)(ws + WS_KA); bf16_t* VA = (bf16_t*)(ws + WS_VA); bf16_t* SZA = (bf16_t*)(ws + WS_SZA);
    bf16_t* QB = (bf16_t*)(ws + WS_QB); bf16_t* KB = (bf16_t*)(ws + WS_KB); bf16_t* VB = (bf16_t*)(ws + WS_VB); bf16_t* SZB = (bf16_t*)(ws + WS_SZB);
    bf16_t* QI = (bf16_t*)(ws + WS_QI); bf16_t* KI = (bf16_t*)(ws + WS_KI); float* WI = (float*)(ws + WS_WI); float* KMEAN = (float*)(ws + WS_KMEAN);
    unsigned long long* MASKT = (unsigned long long*)(ws + WS_MASK); bf16_t* Y = (bf16_t*)(ws + WS_Y);
    (void)hipMemsetAsync(ws + WS_CTL, 0, CTL_ZERO_BYTES, stream);
#if NAIVE_SEL
    mega_launch(grid, d_in, d_out, d_ws, 0, 3, 0, stream);
    k_kmean<<<BATCH * NBLK * NH, 128, 0, stream>>>(KB, KMEAN);
    (void)hipMemsetAsync(MASKT, 0, 4 * MiB, stream);
    k_dsa_select_naive<<<dim3(SEQ, BATCH), 256, 0, stream>>>(QI, KI, WI, MASKT);
    mega_launch(grid, d_in, d_out, d_ws, 4, 6, 1, stream);
#else
    mega_launch(grid, d_in, d_out, d_ws, 0, 6, 0, stream);
#if PROBE_EXTRA >= 0
    mega_launch(grid, d_in, d_out, d_ws, PROBE_EXTRA, PROBE_EXTRA + 1, 1, stream);
#endif
#endif
}
```

```cpp
#include <hip/hip_runtime.h>
#include <cstdio>
#include <cstdint>

typedef unsigned short bf16_t;
#ifndef PROBE_EXTRA
#define PROBE_EXTRA -1
#endif
#ifndef PROBE_DOUBLE
#define PROBE_DOUBLE 0
#endif
constexpr int BATCH = 8, SEQ = 2048, DM = 2048, M = BATCH * SEQ, NH = 8, HD = 128, DA = 1024, IH = 16, ID = 64, DIN = 9296;
constexpr int TOPK = 256, NBLK = 8;
constexpr float RMS_EPS = 1e-6f;
constexpr float QK_SCALE = 0.08838834764831845f;

__device__ __forceinline__ float bf2f(bf16_t v) { return __uint_as_float(((unsigned)v) << 16); }
__device__ __forceinline__ bf16_t f2bf(float f) { unsigned u = __float_as_uint(f); return (bf16_t)((u + 0x7fffu + ((u >> 16) & 1u)) >> 16); }
__device__ __forceinline__ float rbf(float f) { return bf2f(f2bf(f)); }
__device__ __forceinline__ float silu_f(float v) { return v / (1.f + __expf(-v)); }
__device__ __forceinline__ size_t HM(int b, int h, int t, int d) { return (((size_t)(b * NH + h) * SEQ + t) * HD + d); }
__device__ __forceinline__ float wave_sum(float v) {
#pragma unroll
    for (int o = 1; o < 64; o <<= 1) v += __shfl_xor(v, o);
    return v;
}
__device__ __forceinline__ float wave_max(float v) {
#pragma unroll
    for (int o = 1; o < 64; o <<= 1) v = fmaxf(v, __shfl_xor(v, o));
    return v;
}
__device__ __forceinline__ void mask_pos(int t, int s, size_t& word, int& bit) { word = (size_t)t * 32 + (s >> 6); bit = s & 63; }

namespace pg8 {
#define PG8_LAS __attribute__((address_space(3)))
typedef unsigned short bf16_t;
typedef short bf16x8 __attribute__((ext_vector_type(8)));
typedef float f32x4 __attribute__((ext_vector_type(4)));
typedef unsigned u32x4 __attribute__((ext_vector_type(4)));
constexpr int BM = 256, BK = 64, HALF = 128, HTB = HALF * BK * 2  , STAGE_BYTES = 8 * HTB, NXCD = 8, WGM = 8;

__host__ __device__ __forceinline__ int lds_byte(int r, int c) { const int st = (r >> 4) * 2 + (c >> 5), rr = r & 15, cc = c & 31, ob = rr * 64 + cc * 2; return st * 1024 + (ob ^ (((ob >> 9) & 1) << 5)); }
__host__ __device__ __forceinline__ void stage_rc(int b, int& R, int& C) { const int st = b / 1024, sb = b % 1024, swz = sb ^ (((sb >> 9) & 1) << 5); R = (st >> 1) * 16 + swz / 64; C = (st & 1) * 32 + (swz % 64) / 2; }
__host__ __device__ __forceinline__ int perm32(int rho) { const int n = rho >> 4, i = rho & 15; return 8 * (i >> 2) + 4 * n + (i & 3); }

struct Unit { int pm, pn; };
struct Gemm { const void* A; const void* Bt; int M, N, K; };

struct StaticOrder {
    int nM, nN, nwg, G, c, jump_at, jump, base, skew;
    __host__ __device__ void init(int M, int N, int G_, int c_, int base_ = 0, int jump_at_ = 1 << 30, int jump_ = 0, int skew_ = 0) { nM = M / BM; nN = N / BM; nwg = nM * nN; G = G_; c = c_; base = base_; jump_at = jump_at_; jump = jump_; skew = skew_; }
    __host__ __device__ bool next(int i, Unit& u) const {
        long L = (long)i * G + c;
        if (skew > 0) { const int k = nwg / G;
            if (i == k - 1) { if (c < skew) return false; L = (long)(k - 1) * G + (c - skew); }
            else if (i == k) { if (c < G - skew) return false; L = (long)(k - 1) * G + (G - skew) + (c - (G - skew)); }
            else if (i > k) return false; }
        if (L >= nwg) return false;
        int wgid = (int)L; { const int q = nwg / NXCD, r = nwg % NXCD, xcd = wgid % NXCD, off = wgid / NXCD; wgid = (xcd < r ? xcd * (q + 1) : r * (q + 1) + (xcd - r) * q) + off; }
        const int nig = WGM * nN, gid = wgid / nig, fm = gid * WGM, gsz = (nM - fm) < WGM ? (nM - fm) : WGM;
        u.pm = fm + ((wgid % nig) % gsz); const int d = (wgid % nig) / gsz; u.pn = d + (d >= jump_at ? jump : base); return true;
    }
    __device__ __forceinline__ void a_ready(const Unit&) const {}
    __device__ __forceinline__ void done(const Unit&) const {}
};

template <class Epi, class Sched, bool ALIGN_EPI = false, bool SP2 = false, bool FP8 = false>
__device__ __forceinline__ void gemm_phase(PG8_LAS unsigned char* lds, const Gemm g, const Sched& S, const Epi& E) {
    const int tid = threadIdx.x, wid = __builtin_amdgcn_readfirstlane(tid >> 6), lane = tid & 63, wr = wid >> 2, wc = wid & 3, fr = lane & 15, fq = lane >> 4;
    const int K = FP8 ? g.K / 2 : g.K, nt = K / BK;
    typedef int i32x8 __attribute__((ext_vector_type(8))); typedef int i32x4v __attribute__((ext_vector_type(4)));
    unsigned voffA[2], voffB[2];
#pragma unroll
    for (int i = 0; i < 2; ++i) { int R, C; stage_rc(tid * 16 + i * 8192, R, C); const int Rb = Epi::PERM ? ((R & ~31) + perm32(R & 31)) : R;
        voffA[i] = (unsigned)(R * K + C) * 2u; voffB[i] = (unsigned)(Rb * K + C) * 2u; }
    const size_t kstep = (size_t)(BK * 2);
    const size_t hstep = (size_t)HALF * K * 2;
    const size_t tstep = 2 * hstep;
    const unsigned ldsw = (unsigned)wid * 1024u;
    const int aoff = lds_byte(wr * 64 + fr, fq * 8), boff = lds_byte(wc * 32 + fr, fq * 8);
#define PG8_SA(b, h) (((b) * 2 + (h)) * HTB)
#define PG8_SB(b, h) ((4 + (b) * 2 + (h)) * HTB)
#define PG8_STAGE(bufoff, gbase, voff) do { _Pragma("unroll") for (int _i = 0; _i < 2; ++_i) \
        __builtin_amdgcn_global_load_lds((const unsigned*)((const char*)(gbase) + (voff)[_i]), (PG8_LAS unsigned*)(lds + (bufoff) + ldsw + _i * 8192), 16, 0, 0); } while (0)
#define PG8_LDA(dst, b, h) do { _Pragma("unroll") for (int m = 0; m < 4; ++m) { dst[m].lo = *(const PG8_LAS i32x4v*)(lds + PG8_SA(b, h) + aoff + m * 2048); dst[m].hi = *(const PG8_LAS i32x4v*)(lds + PG8_SA(b, h) + aoff + m * 2048 + 1024); } } while (0)
#define PG8_LDB(dst, b, h) do { _Pragma("unroll") for (int n = 0; n < 2; ++n) { dst[n].lo = *(const PG8_LAS i32x4v*)(lds + PG8_SB(b, h) + boff + n * 2048); dst[n].hi = *(const PG8_LAS i32x4v*)(lds + PG8_SB(b, h) + boff + n * 2048 + 1024); } } while (0)
#define PG8_MMA(ai, bj, At, Bt) do { __builtin_amdgcn_s_setprio(1); \
        if constexpr (FP8) { _Pragma("unroll") for (int m = 0; m < 4; ++m) _Pragma("unroll") for (int n = 0; n < 2; ++n) \
            asm volatile("v_mfma_f32_16x16x128_f8f6f4 %0, %1, %2, %0" : "+v"(acc[ai][bj][m][n]) : "v"(Bt[n]), "v"(At[m])); }   \
        else { _Pragma("unroll") for (int m = 0; m < 4; ++m) _Pragma("unroll") for (int n = 0; n < 2; ++n) { \
            const i32x4v bl_ = Bt[n].lo, bh_ = Bt[n].hi, al_ = At[m].lo, ah_ = At[m].hi;     \
            acc[ai][bj][m][n] = __builtin_amdgcn_mfma_f32_16x16x32_bf16(__builtin_bit_cast(bf16x8, bl_), __builtin_bit_cast(bf16x8, al_), acc[ai][bj][m][n], 0, 0, 0); \
            acc[ai][bj][m][n] = __builtin_amdgcn_mfma_f32_16x16x32_bf16(__builtin_bit_cast(bf16x8, bh_), __builtin_bit_cast(bf16x8, ah_), acc[ai][bj][m][n], 0, 0, 0); } } \
        __builtin_amdgcn_s_setprio(0); } while (0)
#define PG8_WAIT_V(n) asm volatile("s_waitcnt vmcnt(" #n ")" ::: "memory")
#define PG8_WAIT_L(n) asm volatile("s_waitcnt lgkmcnt(" #n ")" ::: "memory")
#define PG8_BAR __builtin_amdgcn_s_barrier()
#define PG8_SCHED __builtin_amdgcn_sched_barrier(0)
    Unit cur, nxt; int ui = 0;
    if (!S.next(0, cur)) return;
    f32x4 acc[2][2][4][2];
#pragma unroll
    for (int a = 0; a < 2; ++a)
#pragma unroll
        for (int b = 0; b < 2; ++b)
#pragma unroll
            for (int m = 0; m < 4; ++m)
#pragma unroll
                for (int n = 0; n < 2; ++n) acc[a][b][m][n] = (f32x4){0.f, 0.f, 0.f, 0.f};
    i32x8 At[4], B0[2], B1[2];
    const char* cA = (const char*)g.A + (size_t)cur.pm * tstep; const char* cB = (const char*)g.Bt + (size_t)cur.pn * tstep;
    S.a_ready(cur);
    if constexpr (SP2) {
        PG8_STAGE(PG8_SB(0, 0), cB, voffB); PG8_STAGE(PG8_SB(0, 1), cB + hstep, voffB); PG8_STAGE(PG8_SA(0, 0), cA, voffA); PG8_STAGE(PG8_SA(0, 1), cA + hstep, voffA);
        if (wr == 1) PG8_BAR;
        PG8_WAIT_V(2); PG8_BAR;
        PG8_STAGE(PG8_SB(1, 0), cB + kstep, voffB); PG8_STAGE(PG8_SA(1, 0), cA + kstep, voffA); PG8_STAGE(PG8_SB(1, 1), cB + hstep + kstep, voffB);
        PG8_WAIT_V(6); PG8_BAR;
    } else {
        PG8_STAGE(PG8_SB(0, 0), cB, voffB); PG8_STAGE(PG8_SA(0, 0), cA, voffA); PG8_STAGE(PG8_SB(0, 1), cB + hstep, voffB); PG8_STAGE(PG8_SA(0, 1), cA + hstep, voffA);
        if (wr == 1) PG8_BAR;
        PG8_WAIT_V(4); PG8_BAR;
        PG8_STAGE(PG8_SB(1, 0), cB + kstep, voffB); PG8_STAGE(PG8_SA(1, 0), cA + kstep, voffA); PG8_STAGE(PG8_SB(1, 1), cB + hstep + kstep, voffB);
        PG8_WAIT_V(6); PG8_BAR;
    }
    for (;;) {
        const bool has_next = S.next(ui + 1, nxt);
        const char* nA = has_next ? (const char*)g.A + (size_t)nxt.pm * tstep : cA; const char* nB = has_next ? (const char*)g.Bt + (size_t)nxt.pn * tstep : cB;
        for (int t = 0; t < nt; t += 2) {
            const bool last = (t == nt - 2);
            const char* a1 = cA + (size_t)(t + 1) * kstep;
            const char* a2 = last ? nA : cA + (size_t)(t + 2) * kstep; const char* b2 = last ? nB : cB + (size_t)(t + 2) * kstep;
            const char* a3 = a2 + kstep; const char* b3 = b2 + kstep;
            if (last && has_next) S.a_ready(nxt);
            if constexpr (SP2) {
            PG8_LDB(B0, 0, 0); PG8_LDB(B1, 0, 1); PG8_SCHED; PG8_LDA(At, 0, 0); PG8_STAGE(PG8_SA(1, 1), a1 + hstep, voffA);
            PG8_WAIT_V(8); PG8_WAIT_L(0); PG8_BAR; PG8_MMA(0, 0, At, B0); PG8_MMA(0, 1, At, B1); PG8_BAR; PG8_SCHED;
            PG8_LDA(At, 0, 1); PG8_STAGE(PG8_SB(0, 0), b2, voffB); PG8_STAGE(PG8_SB(0, 1), b2 + hstep, voffB); PG8_STAGE(PG8_SA(0, 0), a2, voffA);
            PG8_WAIT_V(8); PG8_WAIT_L(0); PG8_BAR; PG8_MMA(1, 0, At, B0); PG8_MMA(1, 1, At, B1); PG8_BAR; PG8_SCHED;
            PG8_LDB(B0, 1, 0); PG8_LDB(B1, 1, 1); PG8_SCHED; PG8_LDA(At, 1, 0); PG8_STAGE(PG8_SA(0, 1), a2 + hstep, voffA);
            PG8_WAIT_V(8); PG8_WAIT_L(0); PG8_BAR; PG8_MMA(0, 0, At, B0); PG8_MMA(0, 1, At, B1); PG8_BAR; PG8_SCHED;
            PG8_LDA(At, 1, 1); PG8_STAGE(PG8_SB(1, 0), b3, voffB); PG8_STAGE(PG8_SB(1, 1), b3 + hstep, voffB); PG8_STAGE(PG8_SA(1, 0), a3, voffA);
            PG8_WAIT_V(8); PG8_WAIT_L(0); PG8_BAR; PG8_MMA(1, 0, At, B0); PG8_MMA(1, 1, At, B1); PG8_BAR; PG8_SCHED;
            } else {
            PG8_LDB(B0, 0, 0); PG8_SCHED; PG8_LDA(At, 0, 0); PG8_STAGE(PG8_SA(1, 1), a1 + hstep, voffA);
            PG8_WAIT_L(8); PG8_BAR; PG8_WAIT_L(0); PG8_MMA(0, 0, At, B0); PG8_BAR; PG8_SCHED;
            PG8_LDB(B1, 0, 1); PG8_STAGE(PG8_SB(0, 0), b2, voffB);
            PG8_BAR; PG8_WAIT_L(0); PG8_MMA(0, 1, At, B1); PG8_BAR;
            PG8_LDA(At, 0, 1); PG8_STAGE(PG8_SA(0, 0), a2, voffA);
            PG8_BAR; PG8_WAIT_L(0); PG8_MMA(1, 0, At, B0); PG8_BAR; PG8_SCHED;
            PG8_STAGE(PG8_SB(0, 1), b2 + hstep, voffB);
            PG8_WAIT_V(6); PG8_BAR; PG8_MMA(1, 1, At, B1); PG8_BAR;
            PG8_LDB(B0, 1, 0); PG8_SCHED; PG8_LDA(At, 1, 0); PG8_STAGE(PG8_SA(0, 1), a2 + hstep, voffA);
            PG8_WAIT_L(8); PG8_BAR; PG8_WAIT_L(0); PG8_MMA(0, 0, At, B0); PG8_BAR; PG8_SCHED;
            PG8_LDB(B1, 1, 1); PG8_STAGE(PG8_SB(1, 0), b3, voffB);
            PG8_BAR; PG8_WAIT_L(0); PG8_MMA(0, 1, At, B1); PG8_BAR;
            PG8_LDA(At, 1, 1); PG8_STAGE(PG8_SA(1, 0), a3, voffA);
            PG8_BAR; PG8_WAIT_L(0); PG8_MMA(1, 0, At, B0); PG8_BAR; PG8_SCHED;
            PG8_STAGE(PG8_SB(1, 1), b3 + hstep, voffB);
            PG8_WAIT_V(6); PG8_BAR; PG8_MMA(1, 1, At, B1); PG8_BAR;
            }
        }
        if constexpr (ALIGN_EPI) { if (wr == 0) PG8_BAR; }
        if constexpr (FP8) asm volatile("s_nop 15\n\ts_nop 15" ::: "memory");
        PG8_SCHED;
        if constexpr (!Epi::AFTER_DRAIN) { E(acc, cur, wr, wc, fr, fq); S.done(cur); }
        PG8_SCHED;
        if (!has_next) break;
#pragma unroll
        for (int a = 0; a < 2; ++a)
#pragma unroll
            for (int b = 0; b < 2; ++b)
#pragma unroll
                for (int m = 0; m < 4; ++m)
#pragma unroll
                    for (int n = 0; n < 2; ++n) acc[a][b][m][n] = (f32x4){0.f, 0.f, 0.f, 0.f};
        cur = nxt; cA = nA; cB = nB; ++ui;
        if constexpr (ALIGN_EPI) { if (wr == 1) PG8_BAR; }
    }
    PG8_WAIT_V(0);
    if constexpr (!ALIGN_EPI) { if (wr == 0) PG8_BAR; }
    PG8_BAR;
    if constexpr (Epi::AFTER_DRAIN) { E.fused(acc, cur, wr, wc, fr, fq, lds, wid, lane); S.done(cur); }
#undef PG8_SA
#undef PG8_SB
#undef PG8_STAGE
#undef PG8_LDA
#undef PG8_LDB
#undef PG8_MMA
#undef PG8_WAIT_V
#undef PG8_WAIT_L
#undef PG8_BAR
#undef PG8_SCHED
}
}

#define GAS __attribute__((address_space(1)))
#define LAS __attribute__((address_space(3)))
typedef unsigned v4u __attribute__((ext_vector_type(4)));
typedef float f32x4 __attribute__((ext_vector_type(4)));
typedef GAS unsigned gu32;
#define RLX_AGENT __ATOMIC_RELAXED, __HIP_MEMORY_SCOPE_AGENT
#define LDS_WAIT() asm volatile("s_waitcnt lgkmcnt(0)" ::: "memory")
#define VM_WAIT() asm volatile("s_waitcnt vmcnt(0)" ::: "memory")
constexpr int NWAVES = 8;
constexpr int NPAD = 9472;
constexpr size_t MiB = 1u << 20;
constexpr size_t WS_CTL = 0, CTL_ZERO_BYTES = 1 * MiB;
constexpr size_t WS_MOD = 1 * MiB;
constexpr size_t WS_GAIN = 1 * MiB + 256 * 1024;
constexpr size_t WS_KMEAN = 1 * MiB + 512 * 1024;
constexpr size_t WS_WI = 2 * MiB;
constexpr size_t WS_KI = 3 * MiB;
constexpr size_t WS_MASK = 5 * MiB;
constexpr size_t WS_MODP = 10 * MiB;
constexpr size_t WS_WIN = 18 * MiB;
constexpr size_t WS_HB = 56 * MiB;
constexpr size_t WS_Y = 56 * MiB;
constexpr size_t WS_QA = 120 * MiB, WS_KA = 152 * MiB, WS_VA = 184 * MiB, WS_SZA = 216 * MiB;
constexpr size_t WS_QB = 248 * MiB, WS_KB = 280 * MiB, WS_VB = 312 * MiB, WS_SZB = 344 * MiB;
constexpr size_t WS_QI = 376 * MiB;
constexpr size_t WS_T32 = 408 * MiB;
constexpr size_t WS_Y8 = 408 * MiB;
constexpr size_t WS_HB8 = 440 * MiB;
constexpr size_t WS_WIN8 = 472 * MiB;
constexpr size_t WS_WOUT8 = 492 * MiB;
constexpr size_t WS_END = 496 * MiB;
constexpr float FP8_DESCALE = 1.f / 512.f;
constexpr int CW_QUEUE = 2048;
constexpr int CW_BAR = 4096;
constexpr int RING_BYTES = 131072;
constexpr int EPI_OFF = RING_BYTES;
constexpr int LDSCTL_OFF = EPI_OFF + 16384, MISC_OFF = LDSCTL_OFF + 320;
constexpr int LDS_BYTES = 163840;

#define XB_TMO      128
#define XB_XCNT(j)  (256  + 64 * (j))
#define XB_XSUB(j)  (1280 + 64 * (j))
#define XB_XGEN(j)  (2304 + 64 * (j))
#define XB_TOP      3328
#define XB_TOPGEN   3392
#define XCD_BAR_WORDS 3456
#define XB_SPIN_CAP (1u << 18)

__device__ __forceinline__ unsigned xb_ld(unsigned* p)              { return __hip_atomic_load(p, __ATOMIC_RELAXED, __HIP_MEMORY_SCOPE_AGENT); }
__device__ __forceinline__ unsigned xb_add(unsigned* p, unsigned v) { return __hip_atomic_fetch_add(p, v, __ATOMIC_RELAXED, __HIP_MEMORY_SCOPE_AGENT); }
__device__ __forceinline__ unsigned xb_xcc_id() { return (unsigned)__builtin_amdgcn_s_getreg((3 << 11) | 20) & 0xFu; }
#define XB_SPIN(cond, bar) do { unsigned _sp = 0; while (cond) { __builtin_amdgcn_s_sleep(1); \
    if ((++_sp & 255u) == 0u) { if (xb_ld(&(bar)[XB_TMO])) break; if (_sp > XB_SPIN_CAP) { atomicAdd(&(bar)[XB_TMO], 1u); break; } } } } while (0)

struct XcdBarrier {
    unsigned* bar; unsigned x;
    volatile LAS unsigned* st;
};

__device__ __forceinline__ XcdBarrier xcd_barrier_post(unsigned* bar, volatile LAS unsigned* st) {
    XcdBarrier b; b.bar = bar; b.x = xb_xcc_id(); b.st = st;
    if (threadIdx.x == 0) (void)xb_add(&bar[XB_XCNT(b.x)], 1u);
    return b;
}
__device__ __forceinline__ void xcd_barrier_complete(unsigned* bar, unsigned x, unsigned& nloc, unsigned& nx) {
    const unsigned G = gridDim.x * gridDim.y * gridDim.z;
    unsigned sum, cnt, mine, sp = 0u;
    for (;;) {
        sum = 0u; cnt = 0u; mine = 0u;
#pragma unroll
        for (unsigned j = 0; j < 16; ++j) { const unsigned c = xb_ld(&bar[XB_XCNT(j)]); sum += c; cnt += (c > 0u) ? 1u : 0u; mine = (j == x) ? c : mine; }
        if (sum == G) break;
        __builtin_amdgcn_s_sleep(1);
        if ((++sp & 255u) == 0u) { if (xb_ld(&bar[XB_TMO])) break; if (sp > XB_SPIN_CAP) { atomicAdd(&bar[XB_TMO], 1u); break; } }
    }
    nloc = mine > 0u ? mine : 1u; nx = cnt > 0u ? cnt : 1u;
}

__device__ __forceinline__ void xcd_barrier(const XcdBarrier& b) {
    asm volatile("s_waitcnt vmcnt(0)" ::: "memory");
    __syncthreads();
    if (threadIdx.x == 0) {
        unsigned* bar = b.bar;
        __builtin_amdgcn_s_waitcnt(0);
        unsigned nloc = b.st[0], nx = b.st[1];
        if (nloc == 0u) { xcd_barrier_complete(bar, b.x, nloc, nx); b.st[0] = nloc; b.st[1] = nx; }
        const unsigned old = xb_add(&bar[XB_XSUB(b.x)], 1u);
        const unsigned gen = old / nloc;
        if (old + 1u == (gen + 1u) * nloc) {
            __builtin_amdgcn_fence(__ATOMIC_RELEASE, "agent");
            asm volatile("s_waitcnt vmcnt(0)" ::: "memory");
            const unsigned og = xb_add(&bar[XB_TOP], 1u);
            const unsigned tg = og / nx;
            if (og + 1u == (tg + 1u) * nx) xb_add(&bar[XB_TOPGEN], 1u);
            else XB_SPIN(xb_ld(&bar[XB_TOPGEN]) == tg, bar);
            __builtin_amdgcn_fence(__ATOMIC_ACQUIRE, "agent");
            xb_add(&bar[XB_XGEN(b.x)], 1u);
            asm volatile("s_waitcnt vmcnt(0)" ::: "memory");
        } else {
            XB_SPIN(xb_ld(&bar[XB_XGEN(b.x)]) == gen, bar);
            __builtin_amdgcn_fence(__ATOMIC_ACQUIRE, "agent");
            asm volatile("s_waitcnt vmcnt(0)" ::: "memory");
        }
    }
    __syncthreads();
}


struct Frame {
    LAS unsigned char* lds; volatile LAS unsigned* MISC; gu32* ctl; int tid, lane, wave, vcu, G;
};
__device__ __forceinline__ unsigned cvt_pk_bf16(float lo, float hi) { unsigned r; asm volatile("v_cvt_pk_bf16_f32 %0, %1, %2" : "=v"(r) : "v"(lo), "v"(hi)); return r; }
__device__ __forceinline__ unsigned f2bf_u(float f) { unsigned u = __builtin_bit_cast(unsigned, f); return (u + 0x7fffu + ((u >> 16) & 1u)) >> 16; }
__device__ __forceinline__ unsigned pk2(float lo, float hi) { return f2bf_u(lo) | (f2bf_u(hi) << 16); }
__device__ __forceinline__ float fast_silu(float v) { return v * __builtin_amdgcn_rcpf(1.f + __expf(-v)); }

__device__ __forceinline__ void p0_mod(Frame& F, int id, const float* __restrict__ c, const float* __restrict__ w_ada, float* __restrict__ MODP) {
    const int cs = id & 15, ks = id >> 4;
    LAS float* sc = (LAS float*)(F.lds);
    LAS float* red = (LAS float*)(F.lds + 4096);
    for (int i = F.tid; i < BATCH * 128; i += NWAVES * 64) sc[i] = silu_f(c[(i >> 7) * DM + ks * 128 + (i & 127)]);
    __syncthreads();
    const int cq = F.tid % 96, kq = F.tid / 96;
    if (F.tid < 480) {
        f32x4 acc[8];
#pragma unroll
        for (int b = 0; b < 8; ++b) acc[b] = (f32x4){0.f, 0.f, 0.f, 0.f};
        const float* wp = w_ada + (size_t)(ks * 128) * (3 * DM) + cs * 384 + 4 * cq;
#pragma unroll 4
        for (int k = kq; k < 128; k += 5) { const f32x4 w = *(const f32x4*)(wp + (size_t)k * (3 * DM));
#pragma unroll
            for (int b = 0; b < 8; ++b) acc[b] += w * sc[b * 128 + k]; }
#pragma unroll
        for (int b = 0; b < 8; ++b) *(LAS f32x4*)(red + (kq * 8 + b) * 384 + 4 * cq) = acc[b];
    }
    __syncthreads();
    for (int o = F.tid; o < 8 * 384; o += NWAVES * 64) { const int b = o / 384, col = o % 384; float s = 0.f;
#pragma unroll
        for (int q = 0; q < 5; ++q) s += red[(q * 8 + b) * 384 + col];
        MODP[((size_t)ks * BATCH + b) * (3 * DM) + cs * 384 + col] = s; }
    __syncthreads();
}
__device__ __forceinline__ unsigned pk4_fp8(float a, float b, float c, float d) {
    a = fminf(fmaxf(a, -448.f), 448.f); b = fminf(fmaxf(b, -448.f), 448.f); c = fminf(fmaxf(c, -448.f), 448.f); d = fminf(fmaxf(d, -448.f), 448.f);
    int w = 0; w = __builtin_amdgcn_cvt_pk_fp8_f32(a, b, w, false); w = __builtin_amdgcn_cvt_pk_fp8_f32(c, d, w, true); return (unsigned)w; }
template <bool MAPWIN>
__device__ __forceinline__ void p0_transpose_item(const float* __restrict__ W, int K, int N, int NP, bf16_t* __restrict__ WT, unsigned char* __restrict__ WT8, LAS float* scr, int item, int lane) {
    const int nblk = NP / 32, kb = item / nblk, nb = item % nblk, k0 = 64 * kb, n0 = 32 * nb;
    const int np = n0 + (lane & 31);
    int src = np; bool valid = true;
    if (MAPWIN) { if (np >= 5376) src = np - 176; else if (np >= 5200) valid = false; }
    float wv_[32];
#pragma unroll
    for (int i = 0; i < 32; ++i) { const int kk = 2 * i + (lane >> 5); wv_[i] = valid ? W[(size_t)(k0 + kk) * N + src] : 0.f; }
#pragma unroll
    for (int i = 0; i < 32; ++i) { const int kk = 2 * i + (lane >> 5); scr[kk * 33 + (lane & 31)] = wv_[i]; }
    LDS_WAIT(); asm volatile("" ::: "memory");
    const int c = lane & 7;
    if (WT) {
#pragma unroll
    for (int j = 0; j < 4; ++j) { const int n = (lane >> 3) + 8 * j; const LAS float* s = scr + (8 * c) * 33 + n;
        v4u o; o.x = pk2(s[0 * 33], s[1 * 33]); o.y = pk2(s[2 * 33], s[3 * 33]); o.z = pk2(s[4 * 33], s[5 * 33]); o.w = pk2(s[6 * 33], s[7 * 33]);
        *(GAS v4u*)(WT + (size_t)(n0 + n) * K + k0 + 8 * c) = o; } }
    if (WT8) {
#pragma unroll
        for (int jj = 0; jj < 2; ++jj) { const int idx = lane + 64 * jj, n = idx >> 2, c4 = idx & 3; const LAS float* s = scr + (16 * c4) * 33 + n;
            v4u o; o.x = pk4_fp8(s[0 * 33] * 64.f, s[1 * 33] * 64.f, s[2 * 33] * 64.f, s[3 * 33] * 64.f); o.y = pk4_fp8(s[4 * 33] * 64.f, s[5 * 33] * 64.f, s[6 * 33] * 64.f, s[7 * 33] * 64.f);
            o.z = pk4_fp8(s[8 * 33] * 64.f, s[9 * 33] * 64.f, s[10 * 33] * 64.f, s[11 * 33] * 64.f); o.w = pk4_fp8(s[12 * 33] * 64.f, s[13 * 33] * 64.f, s[14 * 33] * 64.f, s[15 * 33] * 64.f);
            *(GAS v4u*)(WT8 + (size_t)(n0 + n) * K + k0 + 16 * c4) = o; } }
    LDS_WAIT(); asm volatile("" ::: "memory");
}
__device__ __forceinline__ void p0_convert(Frame& F, const float* __restrict__ w_in, const float* __restrict__ w_out, bf16_t* __restrict__ WinT, unsigned char* __restrict__ WinT8, unsigned char* __restrict__ WoutT8) {
    LAS float* scr = (LAS float*)(F.lds + F.wave * 16384);
    const int gw = F.vcu * NWAVES + F.wave, NGW = F.G * NWAVES;
    constexpr int I_IN = (DM / 64) * (NPAD / 32), I_OUT = (DM / 64) * (DM / 32);
    for (int it = gw; it < I_IN + I_OUT; it += NGW) {
        if (it < I_IN) { const int tile = (it % (NPAD / 32)) >> 3; const bool b16 = (tile >= 16 && tile <= 24);
            p0_transpose_item<true>(w_in, DM, DIN, NPAD, b16 ? WinT : nullptr, b16 ? nullptr : WinT8, scr, it, F.lane); }
        else p0_transpose_item<false>(w_out, DM, DM, DM, nullptr, WoutT8, scr, it - I_IN, F.lane);
    }
}
__device__ __forceinline__ void p1_norm(Frame& F, const float* __restrict__ x, const float* __restrict__ g, const float* __restrict__ MODP, const float* __restrict__ b_ada, float* __restrict__ MOD,
                                        bf16_t* __restrict__ HB, unsigned char* __restrict__ HB8) {
    LAS float* gsl = (LAS float*)(F.lds);
    LAS float* shl = (LAS float*)(F.lds + 8192);
    for (int v = F.vcu; v < M / 64; v += F.G) {
        const int b = v / (SEQ / 64);
        { const int k4 = F.tid * 4; const float* pp = MODP + (size_t)b * (3 * DM) + k4;
          f32x4 sh = *(const f32x4*)(b_ada + k4), scl = *(const f32x4*)(b_ada + DM + k4);
#pragma unroll 4
          for (int q = 0; q < 16; ++q) { sh += *(const f32x4*)(pp + (size_t)q * BATCH * (3 * DM)); scl += *(const f32x4*)(pp + (size_t)q * BATCH * (3 * DM) + DM); }
          const f32x4 gg = *(const f32x4*)(g + k4);
          *(LAS f32x4*)(gsl + k4) = gg * (scl + 1.0f); *(LAS f32x4*)(shl + k4) = sh;
          if (F.tid < 64) { const int col = 2 * DM + 64 * (v % (SEQ / 64)) + F.tid; float gt = b_ada[col];
              for (int q = 0; q < 16; ++q) gt += MODP[((size_t)q * BATCH + b) * (3 * DM) + col];
              MOD[b * 3 * DM + col] = gt; } }
        __syncthreads();
        f32x4 gs[8], sh[8];
#pragma unroll
        for (int j = 0; j < 8; ++j) { const int k = 4 * F.lane + 256 * j; gs[j] = *(const LAS f32x4*)(gsl + k); sh[j] = *(const LAS f32x4*)(shl + k); }
        for (int r = 0; r < 8; ++r) {
            const int row = 64 * v + 8 * F.wave + r;
            const f32x4* xr = (const f32x4*)(x + (size_t)row * DM) + F.lane;
            f32x4 xv[8]; float ss = 0.f;
#pragma unroll
            for (int j = 0; j < 8; ++j) { xv[j] = xr[64 * j]; ss += (xv[j].x * xv[j].x + xv[j].y * xv[j].y) + (xv[j].z * xv[j].z + xv[j].w * xv[j].w); }
            ss = wave_sum(ss);
            const float rstd = rsqrtf(ss * (1.f / DM) + RMS_EPS);
            unsigned long long* o8 = (unsigned long long*)(HB + (size_t)row * DM) + F.lane; unsigned* o4 = (unsigned*)(HB8 + (size_t)row * DM) + F.lane;
#pragma unroll
            for (int j = 0; j < 8; ++j) { const f32x4 h = xv[j] * rstd * gs[j] + sh[j];
                o8[64 * j] = (unsigned long long)pk2(h.x, h.y) | ((unsigned long long)pk2(h.z, h.w) << 32);
                o4[64 * j] = pk4_fp8(h.x * 8.f, h.y * 8.f, h.z * 8.f, h.w * 8.f); }
        }
        __syncthreads();
    }
}
struct EpiProj {
    static constexpr bool PERM = true, AFTER_DRAIN = false;
    unsigned char* ws;
    LAS float* P; float osc;
    __device__ __forceinline__ void operator()(const pg8::f32x4 (&acc)[2][2][4][2], const pg8::Unit& u, int wr, int wc, int fr, int fq) const {
        { int l_ = threadIdx.x & 63; asm volatile("" : "+v"(l_)); fr = l_ & 15; fq = l_ >> 4; }
        const int pn = u.pn;
        bf16_t* const KI = (bf16_t*)(ws + WS_KI); float* const WI = (float*)(ws + WS_WI); bf16_t* const QI = (bf16_t*)(ws + WS_QI);
        int grp, sub;
        if (pn < 20) { grp = pn >> 2; sub = pn & 3; } else if (pn == 20) { grp = 5; sub = 0; } else { grp = 6 + ((pn - 21) >> 2); sub = (pn - 21) & 3; }
        const int b = u.pm >> 3, t0 = (u.pm & 7) * 256 + wr * 64 + fr;
        const int cl = 32 * wc + 8 * fq;
        const bool norm = (grp == 0 || grp == 1 || grp == 6 || grp == 7 || grp == 5);
        float rs[2][4][2];
        if (norm) {
#pragma unroll
            for (int ai = 0; ai < 2; ++ai)
#pragma unroll
                for (int m = 0; m < 4; ++m)
#pragma unroll
                    for (int bj = 0; bj < 2; ++bj) { const pg8::f32x4 a = acc[ai][bj][m][0], c = acc[ai][bj][m][1];
                        float s = (a[0] * a[0] + a[1] * a[1]) + (a[2] * a[2] + a[3] * a[3]) + (c[0] * c[0] + c[1] * c[1]) + (c[2] * c[2] + c[3] * c[3]);
                        s += __shfl_xor(s, 16); s += __shfl_xor(s, 32);
                        if (fq == 0) P[((ai * 128 + wr * 64 + m * 16 + fr) * 2 + bj) * 4 + wc] = s; }
            asm volatile("s_waitcnt lgkmcnt(0)" ::: "memory"); __builtin_amdgcn_s_barrier(); asm volatile("" ::: "memory");
#pragma unroll
            for (int ai = 0; ai < 2; ++ai)
#pragma unroll
                for (int m = 0; m < 4; ++m)
#pragma unroll
                    for (int bj = 0; bj < 2; ++bj) { const pg8::f32x4 q = *(const LAS pg8::f32x4*)(P + ((ai * 128 + wr * 64 + m * 16 + fr) * 2 + bj) * 4);
                        rs[ai][m][bj] = ((grp == 5) ? rsqrtf((q[0] + q[1]) * (osc * osc * (1.f / 64.f)) + RMS_EPS) : rsqrtf(((q[0] + q[1]) + (q[2] + q[3])) * (osc * osc * (1.f / 128.f)) + RMS_EPS)) * osc; }
        }
        if (grp == 5) {
            if (wc < 2) { const float* gki = (const float*)(ws + WS_GAIN) + 4 * 128; const pg8::f32x4 g0 = *(const pg8::f32x4*)(gki + cl), g1 = *(const pg8::f32x4*)(gki + cl + 4);
#pragma unroll
                for (int ai = 0; ai < 2; ++ai)
#pragma unroll
                    for (int m = 0; m < 4; ++m) { const size_t row = (size_t)b * SEQ + t0 + 128 * ai + 16 * m; const float r = rs[ai][m][0];
                        const pg8::f32x4 v0 = acc[ai][0][m][0] * r * g0, v1 = acc[ai][0][m][1] * r * g1;
                        pg8::u32x4 w; w.x = cvt_pk_bf16(v0[0], v0[1]); w.y = cvt_pk_bf16(v0[2], v0[3]); w.z = cvt_pk_bf16(v1[0], v1[1]); w.w = cvt_pk_bf16(v1[2], v1[3]);
                        *(pg8::u32x4*)(KI + row * 64 + cl) = w; } }
            else if (wc == 2 && fq < 2) {
#pragma unroll
                for (int ai = 0; ai < 2; ++ai)
#pragma unroll
                    for (int m = 0; m < 4; ++m) { const size_t row = (size_t)b * SEQ + t0 + 128 * ai + 16 * m;
                        *(pg8::f32x4*)(WI + row * 16 + 8 * fq) = acc[ai][0][m][0]; *(pg8::f32x4*)(WI + row * 16 + 8 * fq + 4) = acc[ai][0][m][1]; } }
            return;
        }
        if (grp == 4) {
#pragma unroll
            for (int ai = 0; ai < 2; ++ai)
#pragma unroll
                for (int m = 0; m < 4; ++m) { const size_t row = (size_t)b * SEQ + t0 + 128 * ai + 16 * m;
#pragma unroll
                    for (int bj = 0; bj < 2; ++bj) { const pg8::f32x4 v0 = acc[ai][bj][m][0], v1 = acc[ai][bj][m][1];
                        pg8::u32x4 w; w.x = cvt_pk_bf16(v0[0], v0[1]); w.y = cvt_pk_bf16(v0[2], v0[3]); w.z = cvt_pk_bf16(v1[0], v1[1]); w.w = cvt_pk_bf16(v1[2], v1[3]);
                        *(pg8::u32x4*)(QI + row * 1024 + sub * 256 + bj * 128 + cl) = w; } }
            return;
        }
        bf16_t* dst; const float* gain = nullptr;
        { const int slot = grp < 4 ? grp : grp - 2;
          dst = (bf16_t*)(ws + WS_QA + (size_t)slot * (32 * MiB));
          gain = (const float*)(ws + WS_GAIN) + (grp < 2 ? grp : grp - 4) * 128; }
        pg8::f32x4 g0 = {1.f, 1.f, 1.f, 1.f}, g1 = {1.f, 1.f, 1.f, 1.f};
        if (norm) { g0 = *(const pg8::f32x4*)(gain + cl); g1 = *(const pg8::f32x4*)(gain + cl + 4); }
        const bool act = (grp == 3 || grp == 9);
#pragma unroll
        for (int ai = 0; ai < 2; ++ai)
#pragma unroll
            for (int m = 0; m < 4; ++m) { const int t = t0 + 128 * ai + 16 * m;
#pragma unroll
                for (int bj = 0; bj < 2; ++bj) { const int h = 2 * sub + bj;
                    pg8::f32x4 v0 = acc[ai][bj][m][0], v1 = acc[ai][bj][m][1];
                    if (norm) { const float r = rs[ai][m][bj]; v0 = v0 * r * g0; v1 = v1 * r * g1; } else { v0 = v0 * osc; v1 = v1 * osc; }
                    if (act) { v0[0] = fast_silu(v0[0]); v0[1] = fast_silu(v0[1]); v0[2] = fast_silu(v0[2]); v0[3] = fast_silu(v0[3]);
                               v1[0] = fast_silu(v1[0]); v1[1] = fast_silu(v1[1]); v1[2] = fast_silu(v1[2]); v1[3] = fast_silu(v1[3]); }
                    pg8::u32x4 w; w.x = cvt_pk_bf16(v0[0], v0[1]); w.y = cvt_pk_bf16(v0[2], v0[3]); w.z = cvt_pk_bf16(v1[0], v1[1]); w.w = cvt_pk_bf16(v1[2], v1[3]);
                    *(pg8::u32x4*)(dst + HM(b, h, t, cl)) = w; } }
    }
};
struct EpiOut {
    static constexpr bool PERM = false, AFTER_DRAIN = false;
    const float* x; const float* MOD; float* out; float oscale;
    __device__ __forceinline__ void operator()(const pg8::f32x4 (&acc)[2][2][4][2], const pg8::Unit& u, int wr, int wc, int fr, int fq) const {
        { int l_ = threadIdx.x & 63; asm volatile("" : "+v"(l_)); fr = l_ & 15; fq = l_ >> 4; }
        const int b = u.pm >> 3; const float* gate = MOD + b * 3 * DM + 2 * DM;
        const int col0 = u.pn * 256 + wc * 32 + 4 * fq;
        pg8::f32x4 gv[2][2];
#pragma unroll
        for (int bj = 0; bj < 2; ++bj)
#pragma unroll
            for (int n = 0; n < 2; ++n) gv[bj][n] = *(const pg8::f32x4*)(gate + col0 + bj * 128 + n * 16) * oscale;
#pragma unroll
        for (int ai = 0; ai < 2; ++ai)
#pragma unroll
            for (int m = 0; m < 4; ++m) { const size_t off = (size_t)(u.pm * 256 + ai * 128 + wr * 64 + m * 16 + fr) * DM + col0;
#pragma unroll
                for (int bj = 0; bj < 2; ++bj)
#pragma unroll
                    for (int n = 0; n < 2; ++n) { const pg8::f32x4 xv = *(const pg8::f32x4*)(x + off + bj * 128 + n * 16);
                        *(pg8::f32x4*)(out + off + bj * 128 + n * 16) = xv + gv[bj][n] * acc[ai][bj][m][n]; }
                if (m & 1) asm volatile("" ::: "memory"); }
    }
};

namespace att {
typedef short bf16x8 __attribute__((ext_vector_type(8)));
typedef short s16x4 __attribute__((ext_vector_type(4)));
typedef float f32x16 __attribute__((ext_vector_type(16)));
typedef float f32x4 __attribute__((ext_vector_type(4)));
typedef unsigned u32x4 __attribute__((ext_vector_type(4)));
constexpr int NW = 8, QBLK = 32, KVBLK = 64, QB = NW * QBLK, D = 128;
constexpr int SHM_V = KVBLK * D * 2, SHM_K = KVBLK * D * 2;
constexpr int LDS_WS = 2 * SHM_V + 2 * SHM_K, LDS_KM = LDS_WS + NW * 64 * 4, LDS_OST = 73728, MST_PITCH = 264, MST_WAVE = QBLK * MST_PITCH, LDS_BYTES = LDS_OST + NW * MST_WAVE;
constexpr float SCALE = 0.08838834764831845f, THR = 8.f;
#define KSWZ(row, colB) ((row) * 256 + ((colB) ^ (((row) & 7) << 4)))
#define SBAR() __builtin_amdgcn_sched_barrier(0)
__device__ __forceinline__ int v_st(int k, int c) { const int kk = (k & ~0xC) | ((k & 4) << 1) | ((k & 8) >> 1); return ((kk >> 3) * 4 + (c >> 5)) * 512 + ((kk & 7) * 32 + (c & 31)) * 2; }
__device__ __forceinline__ int v_rd_base(int lane) { return ((lane & 3) << 3) | (((lane >> 2) & 3) << 6) | (((lane >> 4) & 1) << 5) | (((lane >> 5) & 1) << 8); }
constexpr int v_rd_off(int d0, int ks, int half) { return d0 * 512 + ks * 4096 + half * 2048; }
__device__ __forceinline__ int crow(int r, int hi) { return (r & 3) + 8 * (r >> 2) + 4 * hi; }
__device__ __forceinline__ unsigned cvtpk(float lo, float hi) { unsigned r; asm volatile("v_cvt_pk_bf16_f32 %0, %1, %2" : "=v"(r) : "v"(lo), "v"(hi)); return r; }
__device__ __forceinline__ unsigned cvt1(float v) { unsigned r; asm volatile("v_cvt_pk_bf16_f32 %0, %1, 0" : "=v"(r) : "v"(v)); return r; }
__device__ __forceinline__ bf16x8 load8(const bf16_t* p) { return *reinterpret_cast<const bf16x8*>(p); }
__device__ __forceinline__ void mask_causal(f32x16& p0, f32x16& p1, int dq) {
    const float NEG = -__builtin_inff();
#pragma unroll
    for (int r = 0; r < 16; ++r) { const int c = (r & 3) + 8 * (r >> 2); if (dq - c < 0) p0[r] = NEG; if (dq - c - 32 < 0) p1[r] = NEG; }
}
__device__ __forceinline__ void mask_bits(f32x16& p0, f32x16& p1, unsigned w0, unsigned w1) {
    const unsigned NEGB = 0xff800000u;
#pragma unroll
    for (int r = 0; r < 16; ++r) { const int c = (r & 3) + 8 * (r >> 2);
        const unsigned t0 = (unsigned)(((int)(w0 << (31 - c))) >> 31), t1 = (unsigned)(((int)(w1 << (31 - c))) >> 31);
        p0[r] = __uint_as_float((__float_as_uint(p0[r]) & t0) | (NEGB & ~t0));
        p1[r] = __uint_as_float((__float_as_uint(p1[r]) & t1) | (NEGB & ~t1)); }
}
__device__ __forceinline__ void partialSM(f32x16& p0, f32x16& p1, float& m_reg, float& mn, float& alpha, float cb0, float cb1) {
    float pm0 = p0[0]; for (int r = 1; r < 16; ++r) pm0 = fmaxf(pm0, p0[r]); float pm1 = p1[0]; for (int r = 1; r < 16; ++r) pm1 = fmaxf(pm1, p1[r]);
    float pmax = fmaxf(pm0 + cb0, pm1 + cb1);
    { auto rr = __builtin_amdgcn_permlane32_swap(__float_as_uint(pmax), __float_as_uint(pmax), false, false);
      pmax = fmaxf(__uint_as_float(rr[0]), __uint_as_float(rr[1])); }
    constexpr float C2 = 1.4426950408889634f * SCALE;
    if (__builtin_expect(__all((pmax - m_reg) * SCALE <= THR), 1)) { mn = m_reg; alpha = 1.f; }
    else { mn = fmaxf(m_reg, pmax); alpha = __builtin_amdgcn_exp2f((m_reg - mn) * C2); m_reg = mn; }
    const float mnL0 = (cb0 - mn) * C2, mnL1 = (cb1 - mn) * C2;
    for (int r = 0; r < 16; ++r) p0[r] = fmaf(p0[r], C2, mnL0); for (int r = 0; r < 16; ++r) p1[r] = fmaf(p1[r], C2, mnL1);
    for (int r = 0; r < 16; ++r) p0[r] = __builtin_amdgcn_exp2f(p0[r]);
}
__device__ __forceinline__ void finishSM(f32x16& p0, f32x16& p1, float alpha, float& l_reg, bf16x8& pa0, bf16x8& pa1, bf16x8& pa2, bf16x8& pa3) {
    for (int r = 0; r < 16; ++r) p1[r] = __builtin_amdgcn_exp2f(p1[r]);
    float ps = 0; for (int r = 0; r < 16; ++r) ps += p0[r]; for (int r = 0; r < 16; ++r) ps += p1[r];
    { auto rr = __builtin_amdgcn_permlane32_swap(__float_as_uint(ps), __float_as_uint(ps), false, false);
      ps = __uint_as_float(rr[0]) + __uint_as_float(rr[1]); }
    l_reg = l_reg * alpha + ps;
#define PK4(P, B_, OUT) do { unsigned a0 = cvtpk(P[B_+0], P[B_+1]), a1 = cvtpk(P[B_+2], P[B_+3]);                          \
        unsigned b0 = cvtpk(P[B_+4], P[B_+5]), b1 = cvtpk(P[B_+6], P[B_+7]);                                             \
        auto r0 = __builtin_amdgcn_permlane32_swap(a0, b0, false, false); auto r1 = __builtin_amdgcn_permlane32_swap(a1, b1, false, false); \
        u32x4 w = {r0[0], r1[0], r0[1], r1[1]}; OUT = *reinterpret_cast<bf16x8*>(&w); } while (0)
    PK4(p0, 0, pa0); PK4(p0, 8, pa1); PK4(p1, 0, pa2); PK4(p1, 8, pa3);
#undef PK4
}
template <int KB>
__device__ __forceinline__ void qkt(f32x16& p0, f32x16& p1, const char* K_lds, int r32, int hi, const bf16x8* qr, const f32x16& kc, bool act) {
    if (!act) { p0 = f32x16{}; p1 = f32x16{}; return; }
    const char* kb[4];
#pragma unroll
    for (int dd = 0; dd < 4; ++dd) kb[dd] = K_lds + KB * SHM_K + KSWZ(r32, (dd * 16 + hi * 8) * 2);
#pragma unroll
    for (int d0 = 0; d0 < 8; ++d0) { const char* a = kb[d0 & 3] + (d0 >> 2) * 128;
        bf16x8 b0 = *reinterpret_cast<const bf16x8*>(a);
        bf16x8 b1 = *reinterpret_cast<const bf16x8*>(a + 32 * 256);
        if (d0 == 0) { p0 = __builtin_amdgcn_mfma_f32_32x32x16_bf16(b0, qr[0], kc, 0, 0, 0); p1 = __builtin_amdgcn_mfma_f32_32x32x16_bf16(b1, qr[0], kc, 0, 0, 0); }
        else { p0 = __builtin_amdgcn_mfma_f32_32x32x16_bf16(b0, qr[d0], p0, 0, 0, 0); p1 = __builtin_amdgcn_mfma_f32_32x32x16_bf16(b1, qr[d0], p1, 0, 0, 0); } }
}
template <int VB>
__device__ __forceinline__ void pv_tile(f32x16* o, int vb0, bf16x8 pa0, bf16x8 pa1, bf16x8 pa2, bf16x8 pa3, bool act) {
    if (!act) return;
#define TRRD(dst, off) asm volatile("ds_read_b64_tr_b16 %0, %1 offset:%2" : "=&v"(dst) : "v"(vb0), "i"(off) : "memory")
#define PV_D0(d0) do { s16x4 l0, l1, l2, l3, h0, h1, h2, h3; constexpr int b_ = VB * SHM_V + v_rd_off(d0, 0, 0); \
        TRRD(l0, b_); TRRD(h0, b_ + 2048); TRRD(l1, b_ + 4096); TRRD(h1, b_ + 6144); TRRD(l2, b_ + 8192); TRRD(h2, b_ + 10240); TRRD(l3, b_ + 12288); TRRD(h3, b_ + 14336); \
        asm volatile("s_waitcnt lgkmcnt(0)" ::: "memory"); SBAR();   \
        o[d0] = __builtin_amdgcn_mfma_f32_32x32x16_bf16(pa0, (bf16x8){l0[0], l0[1], l0[2], l0[3], h0[0], h0[1], h0[2], h0[3]}, o[d0], 0, 0, 0);   \
        o[d0] = __builtin_amdgcn_mfma_f32_32x32x16_bf16(pa1, (bf16x8){l1[0], l1[1], l1[2], l1[3], h1[0], h1[1], h1[2], h1[3]}, o[d0], 0, 0, 0);   \
        o[d0] = __builtin_amdgcn_mfma_f32_32x32x16_bf16(pa2, (bf16x8){l2[0], l2[1], l2[2], l2[3], h2[0], h2[1], h2[2], h2[3]}, o[d0], 0, 0, 0);   \
        o[d0] = __builtin_amdgcn_mfma_f32_32x32x16_bf16(pa3, (bf16x8){l3[0], l3[1], l3[2], l3[3], h3[0], h3[1], h3[2], h3[3]}, o[d0], 0, 0, 0); } while (0)
    PV_D0(0); PV_D0(1); PV_D0(2); PV_D0(3);
#undef PV_D0
#undef TRRD
}

struct BlockRef { int grp, b, h, qb; };
__device__ __forceinline__ size_t hm_off(const BlockRef& r) { return ((size_t)(r.b * NH + r.h) * SEQ) * D; }
__device__ __forceinline__ const bf16_t* ptrQ(unsigned char* wsb, const BlockRef& r) { return (const bf16_t*)(wsb + (r.grp ? WS_QB : WS_QA)) + hm_off(r) + (size_t)r.qb * QB * D; }
__device__ __forceinline__ const bf16_t* ptrK(unsigned char* wsb, const BlockRef& r) { return (const bf16_t*)(wsb + (r.grp ? WS_KB : WS_KA)) + hm_off(r); }
__device__ __forceinline__ const bf16_t* ptrV(unsigned char* wsb, const BlockRef& r) { return (const bf16_t*)(wsb + (r.grp ? WS_VB : WS_VA)) + hm_off(r); }
__device__ __forceinline__ const bf16_t* ptrZ(unsigned char* wsb, const BlockRef& r) { return (const bf16_t*)(wsb + (r.grp ? WS_SZB : WS_SZA)) + hm_off(r) + (size_t)r.qb * QB * D; }
struct Seam { bf16x8 qr[8]; bf16x8 st_v0, st_v1, st_k0, st_k1; };
#define ROW(p, k0, rr) ((const bf16_t*)((const char*)(p) + (unsigned)(((k0) + (rr)) * (D * 2) + sc * 2)))
#define VMW() asm volatile("s_waitcnt vmcnt(0)" ::: "memory")
#define VMWN(n) asm volatile("s_waitcnt vmcnt(%0)" :: "i"(n) : "memory")
#define SLOAD_H(Kp, Vp, k0) do { S.st_v0 = load8(ROW(Vp, k0, sr)); S.st_v1 = load8(ROW(Vp, k0, 32 + sr));              \
                         S.st_k0 = load8(ROW(Kp, k0, sr)); S.st_k1 = load8(ROW(Kp, k0, 32 + sr)); } while (0)
#define SWRITE_HK(bf) do { *(bf16x8*)(K_lds + (bf) * SHM_K + kws) = S.st_k0; *(bf16x8*)(K_lds + (bf) * SHM_K + kws + 32 * 256) = S.st_k1; } while (0)
#define SWRITE_HV(bf) do { *(bf16x8*)(V_lds + (bf) * SHM_V + vst0) = S.st_v0; *(bf16x8*)(V_lds + (bf) * SHM_V + vst1) = S.st_v1; } while (0)
#define SWRITE_H(bf) do { SWRITE_HV(bf); SWRITE_HK(bf); } while (0)
__device__ __forceinline__ void prime(const BlockRef& cur, unsigned char* wsb, char* lds, Seam& S) {
    int tid = threadIdx.x; asm volatile("" : "+v"(tid));
    const int wid = __builtin_amdgcn_readfirstlane(tid >> 6), lane = tid & 63, r32 = lane & 31, hi = lane >> 5;
    const int sr = tid >> 4, sc = (tid & 15) * 8, kws = KSWZ(sr, sc * 2); char* K_lds = lds + 2 * SHM_V;
    const bf16_t* Qp = ptrQ(wsb, cur); const bf16_t* Kp = ptrK(wsb, cur); const bf16_t* Vp = ptrV(wsb, cur);
    for (int d0 = 0; d0 < 8; ++d0) S.qr[d0] = load8(Qp + (size_t)(wid * QBLK + r32) * D + d0 * 16 + hi * 8);
    SLOAD_H(Kp, Vp, (4 * cur.qb + 3) * KVBLK); VMW(); SWRITE_HK(0);
    __syncthreads();
}
__device__ __forceinline__ void block(const BlockRef& cur, unsigned char* wsb, char* lds, Seam& S, float Bq) {
    const int GRP = cur.grp;
    int tid = threadIdx.x; asm volatile("" : "+v"(tid));
    const int wid = __builtin_amdgcn_readfirstlane(tid >> 6), lane = tid & 63, r32 = lane & 31, hi = lane >> 5;
    const int NT = 4 * cur.qb + 4;
    const int qlo = cur.qb * QB + wid * QBLK, qm = qlo + r32 - 4 * hi;
    char* V_lds = lds; char* K_lds = lds + 2 * SHM_V;
    float* ws = (float*)(lds + LDS_WS) + wid * 64; float* li_l = ws, * al_l = ws + 32;
    float m_reg = -1e30f, l_reg = 0; f32x16 o[4] = {};
    const int sr = tid >> 4, sc = (tid & 15) * 8, vst0 = v_st(sr, sc), vst1 = v_st(32 + sr, sc), kws = KSWZ(sr, sc * 2);
    const int vb0 = (int)(uintptr_t)V_lds + v_rd_base(lane);
    const bf16_t* Kh = ptrK(wsb, cur); const bf16_t* Vh = ptrV(wsb, cur);
    const float sl = exp2f(-(float)(cur.h + 1)) * 11.313708498984761f;
    f32x16 kc;
#pragma unroll
    for (int r = 0; r < 16; ++r) kc[r] = sl * (float)((r & 3) + 8 * (r >> 2));
    unsigned selbits = 0xffu;
    if (GRP == 1) {
        float* km = (float*)(lds + LDS_KM);
        const float* KM = (const float*)(wsb + WS_KMEAN) + ((size_t)(cur.b * NBLK) * NH + cur.h) * 128;
        if (tid < cur.qb * 32) { const int n = tid >> 5, c4 = (tid & 31) * 4; *(f32x4*)(km + n * 128 + c4) = *(const f32x4*)(KM + (size_t)n * (NH * 128) + c4); }
        __syncthreads();
        float v1 = -__builtin_inff(), v2 = v1, v3 = v1; int i1 = 31, i2 = 31, i3 = 31;
#pragma unroll 1
        for (int n = 0; n < cur.qb; ++n) { float a = 0.f;
#pragma unroll
            for (int d0 = 0; d0 < 8; ++d0) { const f32x4 k0 = *(const f32x4*)(km + n * 128 + d0 * 16 + hi * 8), k1 = *(const f32x4*)(km + n * 128 + d0 * 16 + hi * 8 + 4);
                const bf16x8 q = S.qr[d0];
                a += bf2f((bf16_t)q[0]) * k0[0] + bf2f((bf16_t)q[1]) * k0[1] + bf2f((bf16_t)q[2]) * k0[2] + bf2f((bf16_t)q[3]) * k0[3]
                   + bf2f((bf16_t)q[4]) * k1[0] + bf2f((bf16_t)q[5]) * k1[1] + bf2f((bf16_t)q[6]) * k1[2] + bf2f((bf16_t)q[7]) * k1[3]; }
            const float other = __shfl_xor(a, 32); const float g = a + other;
            const bool c1 = g > v1, c2 = g > v2, c3 = g > v3;
            v3 = c2 ? v2 : (c3 ? g : v3); i3 = c2 ? i2 : (c3 ? n : i3);
            v2 = c1 ? v1 : (c2 ? g : v2); i2 = c1 ? i1 : (c2 ? n : i2);
            v1 = c1 ? g : v1;             i1 = c1 ? n : i1; }
        selbits = ((1u << i1) | (1u << i2) | (1u << i3)) & 0xffu;
    }
    const char* mst = lds + LDS_OST + wid * MST_WAVE + r32 * MST_PITCH;
    if (GRP == 0) {
        const char* src = (const char*)(wsb + WS_MASK) + ((size_t)cur.b * SEQ + qlo) * 256 + (unsigned)(r32 * 256 + hi * 128);
        u32x4 tmp[8];
#pragma unroll
        for (int i = 0; i < 8; ++i) tmp[i] = *(const u32x4*)(src + 16 * i);
#pragma unroll
        for (int i = 0; i < 8; ++i) { unsigned long long* d = (unsigned long long*)(mst + hi * 128 + 16 * i);
            d[0] = (unsigned long long)tmp[i][0] | ((unsigned long long)tmp[i][1] << 32); d[1] = (unsigned long long)tmp[i][2] | ((unsigned long long)tmp[i][3] << 32); }
    }
#define RESC(a) do { if (__any((a) < 1.f)) { if (hi == 0) al_l[r32] = (a); asm volatile("s_waitcnt lgkmcnt(0)" ::: "memory");              \
                     for (int d_ = 0; d_ < 4; ++d_) for (int r = 0; r < 16; ++r) o[d_][r] *= al_l[crow(r, hi)]; } } while (0)
#define TIX(u) (NT - 1 - (u))
#define KBASE(u) (TIX(u) * KVBLK)
#define CB(u) ((GRP == 1 && TIX(u) < 4 * cur.qb && !((selbits >> (TIX(u) >> 2)) & 1u)) ? -__builtin_inff() : sl * (float)(KBASE(u) - qm))
#define MLOAD(u) ((GRP == 0) ? *(const unsigned long long*)(mst + TIX(u) * 8) : 0ull)
    constexpr float C2_ = 1.4426950408889634f * SCALE;
#define ACT(u) (!((qlo - KBASE(u) - (KVBLK - 1)) > 0 && __all((Bq - sl * (float)(qlo - KBASE(u) - (KVBLK - 1)) - m_reg) * C2_ < -160.f)))
#define MASKT(P0_, P1_, t, mw) do { const int kb_ = KBASE(t); \
        if (GRP == 0) { mask_bits(P0_, P1_, ((unsigned)(mw)) >> (4 * hi), ((unsigned)((mw) >> 32)) >> (4 * hi)); } \
        else if (kb_ + KVBLK - 1 > qlo) mask_causal(P0_, P1_, qm - kb_); } while (0)
    f32x16 pA0, pA1, pB0, pB1; float mnA, mnB, alA = 1.f, alB = 1.f;
    unsigned long long mwA, mwB; bool actA = true, actB = true;
    volatile unsigned* vote = (volatile unsigned*)(lds + LDS_KM + 4096 + 64);
    SWRITE_HV(0); SBAR();
    if (NT > 1) SLOAD_H(Kh, Vh, KBASE(1));
    mwA = MLOAD(0);
    SBAR(); qkt<0>(pA0, pA1, K_lds, r32, hi, S.qr, kc, true);
    MASKT(pA0, pA1, 0, mwA); { const float cb_ = CB(0); partialSM(pA0, pA1, m_reg, mnA, alA, cb_, cb_ + 32.f * sl); }
    if (NT > 1) { VMW(); SWRITE_H(1); }
    __syncthreads();
#define HALF_STEP(PX0, PX1, mnX, alX, mwX, actX, PY0, PY1, alY, actY, t, KB, VB, SB) do {                                     \
        actX = ACT(t);                                                                                                        \
        SBAR(); qkt<KB>(PX0, PX1, K_lds, r32, hi, S.qr, kc, actX); SBAR();                                             \
        if ((t) + 1 < NT) { SLOAD_H(Kh, Vh, KBASE((t) + 1)); SBAR(); }                                                        \
        mwX = MLOAD(t);                                                                                                       \
        if (actY) { bf16x8 pa0, pa1, pa2, pa3; finishSM(PY0, PY1, alY, l_reg, pa0, pa1, pa2, pa3); SBAR(); pv_tile<VB>(o, vb0, pa0, pa1, pa2, pa3, true); } \
        alX = 1.f; if (actX) { MASKT(PX0, PX1, (t), mwX); const float cb_ = CB(t); partialSM(PX0, PX1, m_reg, mnX, alX, cb_, cb_ + 32.f * sl); }                             \
        __syncthreads();                                                                                                      \
        if ((t) + 1 < NT) { VMW(); SWRITE_H(SB); }                                                                            \
        RESC(alX); } while (0)
    for (int t = 1; t + 1 < NT; t += 2) {
        HALF_STEP(pB0, pB1, mnB, alB, mwB, actB, pA0, pA1, alA, actA, t, 1, 0, 0); __syncthreads();
        HALF_STEP(pA0, pA1, mnA, alA, mwA, actA, pB0, pB1, alB, actB, t + 1, 0, 1, 1);
        if (lane == 0 && actA) vote[(t >> 1) & 1] = 1u;
        __syncthreads();
        const unsigned any_ = vote[(t >> 1) & 1];
        if (tid == 0) vote[((t >> 1) & 1) ^ 1] = 0u;
        if (!any_) break;
    }
    actB = ACT(NT - 1); SBAR(); qkt<1>(pB0, pB1, K_lds, r32, hi, S.qr, kc, actB); SBAR(); mwB = MLOAD(NT - 1);
    if (actA) { bf16x8 pa0, pa1, pa2, pa3; finishSM(pA0, pA1, alA, l_reg, pa0, pa1, pa2, pa3); SBAR(); pv_tile<0>(o, vb0, pa0, pa1, pa2, pa3, true); }
    alB = 1.f; if (actB) { MASKT(pB0, pB1, NT - 1, mwB); const float cb_ = CB(NT - 1); partialSM(pB0, pB1, m_reg, mnB, alB, cb_, cb_ + 32.f * sl); } __syncthreads(); RESC(alB);
    if (actB) { bf16x8 pa0, pa1, pa2, pa3; finishSM(pB0, pB1, alB, l_reg, pa0, pa1, pa2, pa3); SBAR(); pv_tile<1>(o, vb0, pa0, pa1, pa2, pa3, true); }
    if (hi == 0) li_l[r32] = l_reg; asm volatile("s_waitcnt lgkmcnt(0)" ::: "memory");
    float rli[16];
#pragma unroll
    for (int r = 0; r < 16; ++r) rli[r] = __builtin_amdgcn_rcpf(li_l[crow(r, hi)]);
    { bf16_t* stg = (bf16_t*)(lds + LDS_OST) + wid * (QBLK * D);
      int lane_e = lane; asm volatile("" : "+v"(lane_e));
      bf16_t* stw = stg + (4 * (lane_e >> 5)) * D + (lane_e & 31);
#pragma unroll
      for (int r = 0; r < 16; ++r) { const int orow = (r & 3) + 8 * (r >> 2);
#pragma unroll
          for (int d0 = 0; d0 < 4; ++d0) stw[orow * D + d0 * 32] = (bf16_t)cvt1(o[d0][r] * rli[r]); }
      asm volatile("s_waitcnt lgkmcnt(0)" ::: "memory");
      char* Ow = (char*)(wsb + WS_Y8) + ((size_t)cur.b * SEQ + qlo) * 2048 + cur.grp * 1024 + cur.h * 128;
      const char* Zw = (const char*)(ptrZ(wsb, cur) + (size_t)(wid * QBLK) * D);
      const unsigned eo = (unsigned)((lane_e >> 4) * 256 + (lane_e & 15) * 16), yo = (unsigned)((lane_e >> 4) * 2048 + (lane_e & 15) * 8);
#pragma unroll
      for (int i = 0; i < 8; ++i) {
          const u32x4 ov = *(const u32x4*)((const char*)stg + (eo + (unsigned)(i * 1024))), zv = *(const u32x4*)(Zw + (eo + (unsigned)(i * 1024))); float f[8];
#pragma unroll
          for (int j = 0; j < 4; ++j) { f[2 * j] = __uint_as_float(ov[j] << 16) * __uint_as_float(zv[j] << 16) * 8.f; f[2 * j + 1] = __uint_as_float(ov[j] & 0xffff0000u) * __uint_as_float(zv[j] & 0xffff0000u) * 8.f; }
          const unsigned long long w = (unsigned long long)pk4_fp8(f[0], f[1], f[2], f[3]) | ((unsigned long long)pk4_fp8(f[4], f[5], f[6], f[7]) << 32);
          *(unsigned long long*)(Ow + (yo + (unsigned)(i * 8192))) = w; } }
    __syncthreads();
#undef RESC
#undef TIX
#undef ACT
#undef KBASE
#undef CB
#undef MLOAD
#undef MASKT
#undef HALF_STEP
}
#undef ROW
#undef VMW
#undef VMWN
#undef SLOAD_H
#undef SWRITE_HK
#undef SWRITE_HV
#undef SWRITE_H
struct ClassOrder { unsigned char v[64]; };
constexpr int class_cost(int c) { const int h = c >> 3, qb = c & 7, full = 4 * qb + 4, cap = h == 0 ? 10 : h == 1 ? 14 : h == 2 ? 22 : 32; return full < cap ? full : cap; }
constexpr ClassOrder make_order() { ClassOrder o{}; for (int i = 0; i < 64; ++i) o.v[i] = (unsigned char)i;
    for (int i = 1; i < 64; ++i) { const unsigned char x = o.v[i]; int j = i - 1; while (j >= 0 && class_cost(o.v[j]) < class_cost(x)) { o.v[j + 1] = o.v[j]; --j; } o.v[j + 1] = x; }
    return o; }
__device__ __forceinline__ void decode(int p, BlockRef& r) { constexpr ClassOrder ORD = make_order(); const int c = ORD.v[p >> 4], m = p & 15; r.h = c >> 3; r.qb = c & 7; r.grp = m >> 3; r.b = m & 7; }
__device__ __forceinline__ void attn_phase(char* lds, unsigned char* wsb, int v, int G) {
    const int tid = threadIdx.x, lane = tid & 63;
    float BqG[2];
    { const float* G_ = (const float*)(wsb + WS_GAIN);
#pragma unroll
      for (int gsel = 0; gsel < 2; ++gsel) { const float* gq = G_ + gsel * 256; const float* gk = gq + 128;
          float mq = fmaxf(fabsf(gq[lane]), fabsf(gq[lane + 64])), mk = fmaxf(fabsf(gk[lane]), fabsf(gk[lane + 64]));
          mq = wave_max(mq); mk = wave_max(mk); BqG[gsel] = __uint_as_float(__builtin_amdgcn_readfirstlane(__float_as_uint(128.f * 1.02f * mq * mk))); } }
    if (tid == 0) { ((volatile unsigned*)(lds + LDS_KM + 4096 + 64))[0] = 0u; ((volatile unsigned*)(lds + LDS_KM + 4096 + 64))[1] = 0u; }
    Seam S;
    for (int r = 0; r * G < 1024; ++r) {
        const int p = r * G + ((r & 1) ? G - 1 - v : v); if (p >= 1024) continue;
        BlockRef cur; decode(p, cur);
        prime(cur, wsb, lds, S);
        block(cur, wsb, lds, S, cur.grp ? BqG[1] : BqG[0]);
    }
}
#undef KSWZ
#undef SBAR
}

namespace sel {
#define SLAS __attribute__((address_space(3)))
typedef short bf16x8 __attribute__((ext_vector_type(8)));
typedef float f32x16 __attribute__((ext_vector_type(16)));
typedef float f32x4 __attribute__((ext_vector_type(4)));
typedef unsigned u32x4 __attribute__((ext_vector_type(4)));
constexpr int KB_OFF = 131072;
constexpr int LIST_OFF = 147456 + 2048;
__device__ __forceinline__ unsigned fkey(float x) { const unsigned b = __float_as_uint(x); return (b & 0x80000000u) ? ~b : (b | 0x80000000u); }
__device__ __forceinline__ void unit(SLAS unsigned char* lds, unsigned char* wsb, int b, int rg) {
    const int tid = threadIdx.x, wid = __builtin_amdgcn_readfirstlane(tid >> 6), lane = tid & 63, j = lane & 31, g = lane >> 5;
    const bf16_t* QI = (const bf16_t*)(wsb + WS_QI); const char* KIb = (const char*)((const bf16_t*)(wsb + WS_KI) + (size_t)b * SEQ * 64); const float* WI = (const float*)(wsb + WS_WI);
    unsigned long long* MASK = (unsigned long long*)(wsb + WS_MASK);
    const int ta = 16 * rg + 2 * wid, t = ta + g;
    const int nkeys = 16 * rg + 16, nk32 = (nkeys + 31) >> 5, nch = (nkeys + 63) >> 6;
    SLAS float* sc = (SLAS float*)lds + (wid * 2 + g) * 2048 + j;
    float vmin = __builtin_inff(), vmax = -__builtin_inff();
    bf16x8 af[4];
    { const int i = lane & 31, tok = (i >> 2) & 1, head = (i & 3) + 4 * (i >> 3);
      const bf16_t* qp = QI + ((size_t)b * SEQ + ta + tok) * 1024 + head * 64 + 8 * (lane >> 5);
#pragma unroll
      for (int ks = 0; ks < 4; ++ks) af[ks] = *(const bf16x8*)(qp + 16 * ks); }
    float wv[16];
    { const float* wp = WI + ((size_t)b * SEQ + t) * 16;
#pragma unroll
      for (int q4 = 0; q4 < 4; ++q4) { const f32x4 w4 = *(const f32x4*)(wp + 4 * q4); wv[4 * q4] = w4[0] * 0.03125f; wv[4 * q4 + 1] = w4[1] * 0.03125f; wv[4 * q4 + 2] = w4[2] * 0.03125f; wv[4 * q4 + 3] = w4[3] * 0.03125f; } }
    const int srow = tid >> 3, scol = tid & 7, swr = srow * 128 + ((scol ^ ((srow >> 1) & 7)) << 4);
    int koff[4];
#pragma unroll
    for (int ks = 0; ks < 4; ++ks) koff[ks] = j * 128 + (((2 * ks + g) ^ ((j >> 1) & 7)) << 4);
    u32x4 stA = *(const u32x4*)(KIb + (unsigned)(tid * 16)), stB = stA;
    *(SLAS u32x4*)(lds + KB_OFF + swr) = stA;
    stA = *(const u32x4*)(KIb + (unsigned)(min(1, nch - 1) * 8192 + tid * 16));
    stB = *(const u32x4*)(KIb + (unsigned)(min(2, nch - 1) * 8192 + tid * 16));
    __syncthreads();
#define SEL_EPI(ACC, kt) do { float s0 = 0.f, s1 = 0.f, s2 = 0.f, s3 = 0.f; \
        _Pragma("unroll") for (int r = 0; r < 4; ++r) { s0 = fmaf(wv[r], fmaxf(ACC[r], 0.f), s0); s1 = fmaf(wv[4 + r], fmaxf(ACC[4 + r], 0.f), s1); \
                                                       s2 = fmaf(wv[8 + r], fmaxf(ACC[8 + r], 0.f), s2); s3 = fmaf(wv[12 + r], fmaxf(ACC[12 + r], 0.f), s3); } \
        const float s = (s0 + s1) + (s2 + s3); \
        if (32 * (kt) + j <= t) { vmin = fminf(vmin, s); vmax = fmaxf(vmax, s); }     \
        sc[32 * (kt)] = s; } while (0)
#define SEL_TILES(cc) do { SLAS unsigned char* kb = lds + KB_OFF + ((cc) & 1) * 8192; const int kt0 = 2 * (cc); \
        if (kt0 + 1 < nk32) {                                  \
            f32x16 acc0 = {}, acc1 = {}; \
            _Pragma("unroll") for (int ks = 0; ks < 4; ++ks) { const bf16x8 b0 = *(const SLAS bf16x8*)(kb + koff[ks]), b1 = *(const SLAS bf16x8*)(kb + 4096 + koff[ks]); \
                acc0 = __builtin_amdgcn_mfma_f32_32x32x16_bf16(af[ks], b0, acc0, 0, 0, 0); acc1 = __builtin_amdgcn_mfma_f32_32x32x16_bf16(af[ks], b1, acc1, 0, 0, 0); } \
            SEL_EPI(acc0, kt0); SEL_EPI(acc1, kt0 + 1); \
        } else if (kt0 < nk32) { f32x16 acc0 = {}; \
            _Pragma("unroll") for (int ks = 0; ks < 4; ++ks) { const bf16x8 b0 = *(const SLAS bf16x8*)(kb + koff[ks]); acc0 = __builtin_amdgcn_mfma_f32_32x32x16_bf16(af[ks], b0, acc0, 0, 0, 0); } \
            SEL_EPI(acc0, kt0); } } while (0)
#pragma unroll 1
    for (int c = 0; c < nch; c += 2) {
        SEL_TILES(c);
        *(SLAS u32x4*)(lds + KB_OFF + 8192 + swr) = stA; stA = *(const u32x4*)(KIb + (unsigned)(min(c + 3, nch - 1) * 8192 + tid * 16));
        __syncthreads();
        SEL_TILES(c + 1);
        *(SLAS u32x4*)(lds + KB_OFF + swr) = stB; stB = *(const u32x4*)(KIb + (unsigned)(min(c + 4, nch - 1) * 8192 + tid * 16));
        __syncthreads();
    }
#undef SEL_TILES
#undef SEL_EPI
    unsigned T = 0u; int need = 0; bool ties = false;
    if (16 * rg >= TOPK) {
        SLAS unsigned* hist = (SLAS unsigned*)(lds + KB_OFF) + (wid * 2 + g) * 256;
#pragma unroll
        for (int off = 1; off < 32; off <<= 1) { vmin = fminf(vmin, __shfl_xor(vmin, off)); vmax = fmaxf(vmax, __shfl_xor(vmax, off)); }
        const float range = vmax - vmin, inv = (range > 0.f) ? 255.99f / range : 0.f;
        *(SLAS u32x4*)(hist + 8 * j) = (u32x4){0u, 0u, 0u, 0u}; *(SLAS u32x4*)(hist + 8 * j + 4) = (u32x4){0u, 0u, 0u, 0u};
#pragma unroll 1
        for (int kt0 = 0; kt0 < nk32; kt0 += 4) { float x[4];
#pragma unroll
            for (int i = 0; i < 4; ++i) x[i] = sc[32 * (kt0 + i)];
#pragma unroll
            for (int i = 0; i < 4; ++i) if (32 * (kt0 + i) + j <= t) { const int q = min((int)((x[i] - vmin) * inv), 255); __hip_atomic_fetch_add(hist + q, 1u, __ATOMIC_RELAXED, __HIP_MEMORY_SCOPE_WORKGROUP); } }
        asm volatile("s_waitcnt lgkmcnt(0)" ::: "memory");
        int qsel, cB;
        { const u32x4 c0 = *(const SLAS u32x4*)(hist + 8 * j), c1 = *(const SLAS u32x4*)(hist + 8 * j + 4);
          const int cnt[8] = {(int)c0[0], (int)c0[1], (int)c0[2], (int)c0[3], (int)c1[0], (int)c1[1], (int)c1[2], (int)c1[3]};
          const int s = ((cnt[0] + cnt[1]) + (cnt[2] + cnt[3])) + ((cnt[4] + cnt[5]) + (cnt[6] + cnt[7]));
          int S = s;
#pragma unroll
          for (int off = 1; off < 32; off <<= 1) { const int v = __shfl_down(S, off, 32); if (j + off < 32) S += v; }
          const int above = S - s;
          const bool found = (S >= TOPK) && (above < TOPK);
          int dsel = 0, nneed = 0, csel = 0;
          { const int rem = TOPK - above; int cum = 0; bool done = false;
#pragma unroll
            for (int i = 7; i >= 0; --i) { const int before = cum; cum += cnt[i]; if (!done && cum >= rem) { done = true; dsel = 8 * j + i; nneed = rem - before; csel = cnt[i]; } } }
          const unsigned long long bm = __ballot(found);
          const int src = 32 * g + __builtin_ctz((unsigned)(bm >> (32 * g)) | 0x80000000u);
          qsel = __shfl(dsel, src); need = __shfl(nneed, src); cB = __shfl(csel, src); }
        if (!__any(cB > 64)) {
            SLAS unsigned* list = (SLAS unsigned*)(lds + LIST_OFF) + (wid * 2 + g) * 128;
            int base = 0;
#pragma unroll 1
            for (int kt0 = 0; kt0 < nk32; kt0 += 4) { float x[4];
#pragma unroll
                for (int i = 0; i < 4; ++i) x[i] = sc[32 * (kt0 + i)];
#pragma unroll
                for (int i = 0; i < 4; ++i) { const int kt = kt0 + i;
                    const bool m = (32 * kt + j <= t) && (min((int)((x[i] - vmin) * inv), 255) == qsel);
                    const unsigned long long bal = __ballot(m); const unsigned hm = g ? (unsigned)(bal >> 32) : (unsigned)bal;
                    if (m) { const int pos = base + __builtin_popcount(hm & ((1u << j) - 1u)); list[2 * pos] = fkey(x[i]); list[2 * pos + 1] = (unsigned)(32 * kt + j); }
                    base += __builtin_popcount(hm); } }
            asm volatile("s_waitcnt lgkmcnt(0)" ::: "memory");
            const unsigned u0 = list[2 * j], i0 = list[2 * j + 1], u1 = list[2 * (j + 32)], i1 = list[2 * (j + 32) + 1];
            int r0 = 0, r1 = 0; const int cmax = max(cB, __shfl_xor(cB, 32));
#pragma unroll 1
            for (int e = 0; e < cmax; ++e) { const unsigned ue = list[2 * e], ie = list[2 * e + 1]; const bool in = e < cB;
                r0 += (in && (ue > u0 || (ue == u0 && ie < i0))) ? 1 : 0; r1 += (in && (ue > u1 || (ue == u1 && ie < i1))) ? 1 : 0; }
            const bool h0 = (j < cB) && (r0 == need - 1), h1 = (j + 32 < cB) && (r1 == need - 1);
            const unsigned long long bh = __ballot(h0 || h1);
            const int src = 32 * g + __builtin_ctz((unsigned)(bh >> (32 * g)) | 0x80000000u);
            T = __shfl(h0 ? u0 : u1, src);
            const unsigned long long bg0 = __ballot(j < cB && u0 > T), bg1 = __ballot(j + 32 < cB && u1 > T), be0 = __ballot(j < cB && u0 == T), be1 = __ballot(j + 32 < cB && u1 == T);
            const int ngt = __builtin_popcount(g ? (unsigned)(bg0 >> 32) : (unsigned)bg0) + __builtin_popcount(g ? (unsigned)(bg1 >> 32) : (unsigned)bg1);
            const int neq = __builtin_popcount(g ? (unsigned)(be0 >> 32) : (unsigned)be0) + __builtin_popcount(g ? (unsigned)(be1 >> 32) : (unsigned)be1);
            need = need - ngt; ties = (neq != need);
        } else {
            unsigned prefix = 0u; need = TOPK; int ceq = 0;
#pragma unroll 1
            for (int p = 0; p < 4; ++p) { const int shift = 24 - 8 * p;
                *(SLAS u32x4*)(hist + 8 * j) = (u32x4){0u, 0u, 0u, 0u}; *(SLAS u32x4*)(hist + 8 * j + 4) = (u32x4){0u, 0u, 0u, 0u};
                const unsigned phi = prefix >> ((shift + 8) & 31);
#pragma unroll 1
                for (int kt = 0; kt < nk32; ++kt) { const unsigned x = fkey(sc[32 * kt]);
                    const bool match = (32 * kt + j <= t) && ((p == 0) || ((x >> ((shift + 8) & 31)) == phi));
                    if (match) __hip_atomic_fetch_add(hist + ((x >> shift) & 255u), 1u, __ATOMIC_RELAXED, __HIP_MEMORY_SCOPE_WORKGROUP); }
                asm volatile("s_waitcnt lgkmcnt(0)" ::: "memory");
                const u32x4 c0 = *(const SLAS u32x4*)(hist + 8 * j), c1 = *(const SLAS u32x4*)(hist + 8 * j + 4);
                const int cnt[8] = {(int)c0[0], (int)c0[1], (int)c0[2], (int)c0[3], (int)c1[0], (int)c1[1], (int)c1[2], (int)c1[3]};
                const int s = ((cnt[0] + cnt[1]) + (cnt[2] + cnt[3])) + ((cnt[4] + cnt[5]) + (cnt[6] + cnt[7]));
                int S = s;
#pragma unroll
                for (int off = 1; off < 32; off <<= 1) { const int v = __shfl_down(S, off, 32); if (j + off < 32) S += v; }
                const int above = S - s;
                const bool found = (S >= need) && (above < need);
                int dsel = 0, nneed = 0, csel = 0;
                { const int rem = need - above; int cum = 0; bool done = false;
#pragma unroll
                  for (int i = 7; i >= 0; --i) { const int before = cum; cum += cnt[i]; if (!done && cum >= rem) { done = true; dsel = 8 * j + i; nneed = rem - before; csel = cnt[i]; } } }
                const unsigned long long bm = __ballot(found);
                const int src = 32 * g + __builtin_ctz((unsigned)(bm >> (32 * g)) | 0x80000000u);
                const int digit = __shfl(dsel, src); need = __shfl(nneed, src); ceq = __shfl(csel, src);
                prefix |= (unsigned)digit << shift;
            }
            T = prefix; ties = (ceq != need);
        }
    }
    unsigned wlo = 0u, whi = 0u;
    if (!__any(ties)) {
#pragma unroll 4
        for (int k64 = 0; k64 < 32; ++k64) {
            const bool s0 = (64 * k64 + j <= t) && (fkey(sc[64 * k64]) >= T), s1 = (64 * k64 + 32 + j <= t) && (fkey(sc[64 * k64 + 32]) >= T);
            const unsigned long long b0 = __ballot(s0), b1 = __ballot(s1);
            const unsigned lo = g ? (unsigned)(b0 >> 32) : (unsigned)b0, hi = g ? (unsigned)(b1 >> 32) : (unsigned)b1;
            if (j == k64) { wlo = lo; whi = hi; } }
    } else {
        int base = 0;
#pragma unroll 1
        for (int k64 = 0; k64 < 32; ++k64) { unsigned lo = 0u, hi = 0u;
#pragma unroll
            for (int hh = 0; hh < 2; ++hh) { const bool vld = (64 * k64 + 32 * hh + j <= t); const unsigned x = vld ? fkey(sc[64 * k64 + 32 * hh]) : 0u;
                const unsigned long long be = __ballot(vld && x == T); const unsigned em = g ? (unsigned)(be >> 32) : (unsigned)be;
                const int rank = base + __builtin_popcount(em & ((1u << j) - 1u));
                const bool s1 = vld && ((x > T) || (x == T && rank < need));
                base += __builtin_popcount(em);
                const unsigned long long bs = __ballot(s1); const unsigned sm = g ? (unsigned)(bs >> 32) : (unsigned)bs;
                if (hh == 0) lo = sm; else hi = sm; }
            if (j == k64) { wlo = lo; whi = hi; } }
    }
    MASK[((size_t)b * SEQ + t) * 32 + j] = (unsigned long long)wlo | ((unsigned long long)whi << 32);
    __syncthreads();
}
__device__ __forceinline__ void kmean_unit(SLAS unsigned char* lds, unsigned char* wsb, int b, int n, int h) {
    const int tid = threadIdx.x, d4 = tid & 31, rs = tid >> 5;
    const bf16_t* KB = (const bf16_t*)(wsb + WS_KB) + (((size_t)(b * NH + h) * SEQ) + n * 256) * 128;
    float a0 = 0.f, a1 = 0.f, a2 = 0.f, a3 = 0.f;
#pragma unroll 4
    for (int r = 0; r < 16; ++r) { const unsigned long long v = *(const unsigned long long*)(KB + (size_t)(rs * 16 + r) * 128 + d4 * 4);
        const unsigned lo = (unsigned)v, hi = (unsigned)(v >> 32);
        a0 += __uint_as_float(lo << 16); a1 += __uint_as_float(lo & 0xffff0000u); a2 += __uint_as_float(hi << 16); a3 += __uint_as_float(hi & 0xffff0000u); }
    SLAS float* red = (SLAS float*)lds;
    *(SLAS f32x4*)(red + rs * 128 + d4 * 4) = (f32x4){a0, a1, a2, a3};
    __syncthreads();
    if (tid < 128) { float s = 0.f;
#pragma unroll
        for (int q = 0; q < 16; ++q) s += red[q * 128 + tid];
        ((float*)(wsb + WS_KMEAN))[((size_t)(b * NBLK + n) * NH + h) * 128 + tid] = s * (1.f / 256.f); }
    __syncthreads();
}
__device__ __forceinline__ void select_phase(SLAS unsigned char* lds, unsigned char* wsb, int v, int G) {
    for (int L = v; L < 512; L += G) kmean_unit(lds, wsb, L >> 6, (L >> 3) & 7, L & 7);
    for (int L = v; L < 512; L += G) { const int b = L >> 6, x = L & 63;
        unit(lds, wsb, b, x);
        unit(lds, wsb, b, 127 - x); }
}
#undef SLAS
}

struct Args { const float* in[12]; float* out; unsigned char* ws; int ph_lo, ph_hi, li, pad; };
__global__ void __launch_bounds__(NWAVES * 64, 2) mega_fwd(Args args) {
    extern __shared__ __attribute__((aligned(16))) unsigned char lds[];
    Frame F;
    F.lds = (LAS unsigned char*)lds; F.MISC = (volatile LAS unsigned*)(F.lds + MISC_OFF);
    F.tid = threadIdx.x; F.lane = F.tid & 63; F.wave = __builtin_amdgcn_readfirstlane(F.tid >> 6);
    F.G = gridDim.x; { const int bx = blockIdx.x; F.vcu = (F.G % 8 == 0) ? (bx % 8) * (F.G / 8) + bx / 8 : bx; }
    unsigned char* ws = args.ws;
    F.ctl = (gu32*)(ws + WS_CTL);
    const float* x = args.in[0]; const float* c = args.in[1]; const float* w_ada = args.in[2]; const float* b_ada = args.in[3]; const float* g_norm = args.in[4];
    const float* w_in = args.in[5]; const float* w_out = args.in[11];
    float* MOD = (float*)(ws + WS_MOD); bf16_t* WinT = (bf16_t*)(ws + WS_WIN); bf16_t* HB = (bf16_t*)(ws + WS_HB); bf16_t* Y = (bf16_t*)(ws + WS_Y);
    for (int u = F.tid; u < (LDS_BYTES - LDSCTL_OFF) / 4; u += NWAVES * 64) ((LAS unsigned*)(F.lds + LDSCTL_OFF))[u] = 0u;
    __syncthreads();
    XcdBarrier bar = xcd_barrier_post((unsigned*)(F.ctl + CW_BAR) + args.li * XCD_BAR_WORDS, F.MISC + 8);
    const int lo = args.ph_lo, hi = args.ph_hi;
#define IN(k) (lo <= (k) && (k) < hi)
#define BOTH(k) (IN(k) && IN((k) + 1))
    if (IN(0)) for (int rep_ = 0; rep_ < (((PROBE_DOUBLE) >> 0) & 1) + 1; ++rep_) {
        if (rep_) __syncthreads();
        for (int id = (int)blockIdx.x; id < 256; id += F.G) p0_mod(F, id, c, w_ada, (float*)(ws + WS_MODP));
        if ((int)blockIdx.x == 192) { float* G = (float*)(ws + WS_GAIN);
            if (F.tid < 128) { G[F.tid] = args.in[6][F.tid]; G[128 + F.tid] = args.in[7][F.tid]; G[256 + F.tid] = args.in[9][F.tid]; G[384 + F.tid] = args.in[10][F.tid]; }
            if (F.tid < 64) G[512 + F.tid] = args.in[8][F.tid]; }
        p0_convert(F, w_in, w_out, WinT, ws + WS_WIN8, ws + WS_WOUT8);
    }
    if (BOTH(0)) xcd_barrier(bar);
    if (IN(1)) for (int rep_ = 0; rep_ < (((PROBE_DOUBLE) >> 1) & 1) + 1; ++rep_) p1_norm(F, x, g_norm, (const float*)(ws + WS_MODP), b_ada, MOD, HB, ws + WS_HB8);
    if (BOTH(1)) xcd_barrier(bar);
    if (IN(2)) for (int rep_ = 0; rep_ < (((PROBE_DOUBLE) >> 2) & 1) + 1; ++rep_) {
        { pg8::Gemm g{ws + WS_HB8, ws + WS_WIN8, M, 28 * 256, DM}; pg8::StaticOrder S; S.init(M, 28 * 256, F.G, (int)blockIdx.x, 0, 16, 9, F.G == 256 ? 64 : 0);
          EpiProj E{ws, (LAS float*)(F.lds + EPI_OFF), FP8_DESCALE};
          pg8::gemm_phase<EpiProj, pg8::StaticOrder, true, true, true>(F.lds, g, S, E); }
        { pg8::Gemm g{HB, WinT, M, 9 * 256, DM}; pg8::StaticOrder S; S.init(M, 9 * 256, F.G, (int)blockIdx.x, 16);
          EpiProj E{ws, (LAS float*)(F.lds + EPI_OFF), 1.f};
          pg8::gemm_phase<EpiProj, pg8::StaticOrder, true, true, false>(F.lds, g, S, E); }
    }
    if (BOTH(2)) xcd_barrier(bar);
    if (IN(3)) for (int rep_ = 0; rep_ < (((PROBE_DOUBLE) >> 3) & 1) + 1; ++rep_) sel::select_phase(F.lds, ws, F.vcu, F.G);
    if (BOTH(3)) xcd_barrier(bar);
    if (IN(4)) {
#pragma unroll 1
        for (int rep_ = 0; rep_ < (((PROBE_DOUBLE) >> 4) & 1) + 1; ++rep_) att::attn_phase((char*)lds, ws, F.vcu, F.G);
    }
    if (BOTH(4)) xcd_barrier(bar);
    if (IN(5)) for (int rep_ = 0; rep_ < (((PROBE_DOUBLE) >> 5) & 1) + 1; ++rep_) {
        pg8::Gemm g{ws + WS_Y8, ws + WS_WOUT8, M, DM, DM}; pg8::StaticOrder S; S.init(M, DM, F.G, (int)blockIdx.x);
        EpiOut E{x, MOD, args.out, FP8_DESCALE};
        pg8::gemm_phase<EpiOut, pg8::StaticOrder, true, true, true>(F.lds, g, S, E);
    }
#undef IN
#undef BOTH
}

static int mega_setup() {
    static int grid = 0;
    if (grid == 0) {
        int dev = 0, cus = 0;
        if (hipGetDevice(&dev) != hipSuccess || hipDeviceGetAttribute(&cus, hipDeviceAttributeMultiprocessorCount, dev) != hipSuccess) { fprintf(stderr, "kernel_launch: device query failed\n"); grid = -1; return grid; }
        if (hipFuncSetAttribute((const void*)mega_fwd, hipFuncAttributeMaxDynamicSharedMemorySize, LDS_BYTES) != hipSuccess) { fprintf(stderr, "kernel_launch: hipFuncSetAttribute failed\n"); grid = -1; return grid; }
        (void)hipGetLastError();
        grid = cus;
    }
    return grid;
}
static void mega_launch(int grid, void* const* d_in, void* d_out, void* d_ws, int ph_lo, int ph_hi, int li, hipStream_t stream) {
    Args a{};
    for (int i = 0; i < 12; ++i) a.in[i] = (const float*)d_in[i];
    a.out = (float*)d_out; a.ws = (unsigned char*)d_ws; a.ph_lo = ph_lo; a.ph_hi = ph_hi; a.li = li;
    hipLaunchKernelGGL(mega_fwd, dim3(grid), dim3(NWAVES * 64), LDS_BYTES, stream, a);
}

extern "C" void kernel_launch(void* const* d_in, const int* in_sizes, int n_in, void* d_out, int out_size, void* d_ws, size_t ws_size, hipStream_t stream) {
    if (n_in != 12 || in_sizes[0] != M * DM || out_size != M * DM || ws_size < WS_END) {
        fprintf(stderr, "kernel_launch: unexpected shapes (n_in %d, in0 %d, out %d, ws %zu); nothing launched\n", n_in, n_in > 0 ? in_sizes[0] : -1, out_size, ws_size); return; }
    const int grid = mega_setup(); if (grid <= 0) return;
    char* ws = (char*)d_ws;
    (void)hipMemsetAsync(ws + WS_CTL, 0, CTL_ZERO_BYTES, stream);
    mega_launch(grid, d_in, d_out, d_ws, 0, 6, 0, stream);
#if PROBE_EXTRA >= 0
    mega_launch(grid, d_in, d_out, d_ws, PROBE_EXTRA, PROBE_EXTRA + 1, 1, stream);
#endif
}
```

```cpp
#include <hip/hip_runtime.h>
#include <cstdio>
#include <cstdint>

typedef unsigned short bf16_t;
#ifndef PROBE_EXTRA
#define PROBE_EXTRA -1
#endif
#ifndef PROBE_DOUBLE
#define PROBE_DOUBLE 0
#endif
constexpr int BATCH = 8, SEQ = 2048, DM = 2048, M = BATCH * SEQ, NH = 8, HD = 128, DA = 1024, IH = 16, ID = 64, DIN = 9296;
constexpr int TOPK = 256, NBLK = 8;
constexpr float RMS_EPS = 1e-6f;
constexpr float QK_SCALE = 0.08838834764831845f;

__device__ __forceinline__ float bf2f(bf16_t v) { return __uint_as_float(((unsigned)v) << 16); }
__device__ __forceinline__ bf16_t f2bf(float f) { unsigned u = __float_as_uint(f); return (bf16_t)((u + 0x7fffu + ((u >> 16) & 1u)) >> 16); }
__device__ __forceinline__ float rbf(float f) { return bf2f(f2bf(f)); }
__device__ __forceinline__ float silu_f(float v) { return v / (1.f + __expf(-v)); }
__device__ __forceinline__ size_t HM(int b, int h, int t, int d) { return (((size_t)(b * NH + h) * SEQ + t) * HD + d); }
__device__ __forceinline__ float wave_sum(float v) {
#pragma unroll
    for (int o = 1; o < 64; o <<= 1) v += __shfl_xor(v, o);
    return v;
}
__device__ __forceinline__ float wave_max(float v) {
#pragma unroll
    for (int o = 1; o < 64; o <<= 1) v = fmaxf(v, __shfl_xor(v, o));
    return v;
}
__device__ __forceinline__ void mask_pos(int t, int s, size_t& word, int& bit) { word = (size_t)t * 32 + (s >> 6); bit = s & 63; }

namespace pg8 {
#define PG8_LAS __attribute__((address_space(3)))
typedef unsigned short bf16_t;
typedef short bf16x8 __attribute__((ext_vector_type(8)));
typedef float f32x4 __attribute__((ext_vector_type(4)));
typedef unsigned u32x4 __attribute__((ext_vector_type(4)));
constexpr int BM = 256, BK = 64, HALF = 128, HTB = HALF * BK * 2  , STAGE_BYTES = 8 * HTB, NXCD = 8;

__host__ __device__ __forceinline__ int lds_byte(int r, int c) { const int st = (r >> 4) * 2 + (c >> 5), rr = r & 15, cc = c & 31, ob = rr * 64 + cc * 2; return st * 1024 + (ob ^ (((ob >> 9) & 1) << 5)); }
__host__ __device__ __forceinline__ void stage_rc(int b, int& R, int& C) { const int st = b / 1024, sb = b % 1024, swz = sb ^ (((sb >> 9) & 1) << 5); R = (st >> 1) * 16 + swz / 64; C = (st & 1) * 32 + (swz % 64) / 2; }
__host__ __device__ __forceinline__ int perm32(int rho) { const int n = rho >> 4, i = rho & 15; return 8 * (i >> 2) + 4 * n + (i & 3); }

struct Unit { int pm, pn; };
struct Gemm { const void* A; const void* Bt; int M, N, K; };

struct StaticOrder {
    int nM, nN, nwg, G, c, jump_at, jump, base, skew, WGM = 4, rot = 1, full = 0, ext_q0 = 0, ext_n = 0, ext_st = 0;
    __host__ __device__ void init(int M, int N, int G_, int c_, int base_ = 0, int jump_at_ = 1 << 30, int jump_ = 0, int skew_ = 0) { nM = M / BM; nN = N / BM; nwg = nM * nN; G = G_; c = c_; base = base_; jump_at = jump_at_; jump = jump_; skew = skew_; }
    __host__ __device__ void uneven(int full_, int ext_q0_, int ext_n_, int ext_st_) { skew = -1; full = full_; ext_q0 = ext_q0_; ext_n = ext_n_; ext_st = ext_st_; }
    __host__ __device__ bool next(int i, Unit& u) const {
        long L = (long)i * G + c;
        if (skew < 0) { if (i >= full) { if (i - full >= ext_n) return false; L = (long)full * G + 8 * (ext_q0 + (i - full) * ext_st) + (c & 7); } }
        else if (skew > 0) { const int k = nwg / G;
            if (i == k - 1) { if (c < skew) return false; L = (long)(k - 1) * G + (c - skew); }
            else if (i == k) { if (c < G - skew) return false; L = (long)(k - 1) * G + (G - skew) + (c - (G - skew)); }
            else if (i > k) return false; }
        if (L >= nwg) return false;
        int wgid = (int)L; { const int q = nwg / NXCD, r = nwg % NXCD, xcd = wgid % NXCD, off = wgid / NXCD; wgid = (xcd < r ? xcd * (q + 1) : r * (q + 1) + (xcd - r) * q) + off; }
        const int nig = WGM * nN, gid = wgid / nig, fm = gid * WGM, gsz = (nM - fm) < WGM ? (nM - fm) : WGM;
        u.pm = fm + ((wgid % nig) % gsz); int d = (wgid % nig) / gsz;
        if (rot) { d += (int)((L % NXCD) * nN) / NXCD; d -= (d >= nN) ? nN : 0; }
        u.pn = d + (d >= jump_at ? jump : base); return true;
    }
    __device__ __forceinline__ void a_ready(const Unit&) const {}
    __device__ __forceinline__ void done(const Unit&) const {}
};

template <class Epi, class Sched, bool ALIGN_EPI = false, bool SP2 = false, bool FP8 = false>
__device__ __forceinline__ void gemm_phase(PG8_LAS unsigned char* lds, const Gemm g, const Sched& S, const Epi& E) {
    const int tid = threadIdx.x, wid = __builtin_amdgcn_readfirstlane(tid >> 6), lane = tid & 63, wr = wid >> 2, wc = wid & 3, fr = lane & 15, fq = lane >> 4;
    const int K = FP8 ? g.K / 2 : g.K, nt = K / BK;
    typedef int i32x8 __attribute__((ext_vector_type(8))); typedef int i32x4v __attribute__((ext_vector_type(4)));
    unsigned voffA[2], voffB[2];
#pragma unroll
    for (int i = 0; i < 2; ++i) { int R, C; stage_rc(tid * 16 + i * 8192, R, C); const int Rb = Epi::PERM ? ((R & ~31) + perm32(R & 31)) : R;
        voffA[i] = (unsigned)(R * K + C) * 2u; voffB[i] = (unsigned)(Rb * K + C) * 2u; }
    const size_t kstep = (size_t)(BK * 2);
    const size_t hstep = (size_t)HALF * K * 2;
    const size_t tstep = 2 * hstep;
    const unsigned ldsw = (unsigned)wid * 1024u;
    const int aoff = lds_byte(wr * 64 + fr, fq * 8), boff = lds_byte(wc * 32 + fr, fq * 8);
#define PG8_SA(b, h) (((b) * 2 + (h)) * HTB)
#define PG8_SB(b, h) ((4 + (b) * 2 + (h)) * HTB)
#define PG8_STAGE(bufoff, gbase, voff) do { _Pragma("unroll") for (int _i = 0; _i < 2; ++_i) \
        __builtin_amdgcn_global_load_lds((const unsigned*)((const char*)(gbase) + (voff)[_i]), (PG8_LAS unsigned*)(lds + (bufoff) + ldsw + _i * 8192), 16, 0, 0); } while (0)
#define PG8_LDA(dst, b, h) do { _Pragma("unroll") for (int m = 0; m < 4; ++m) { dst[m].lo = *(const PG8_LAS i32x4v*)(lds + PG8_SA(b, h) + aoff + m * 2048); dst[m].hi = *(const PG8_LAS i32x4v*)(lds + PG8_SA(b, h) + aoff + m * 2048 + 1024); } } while (0)
#define PG8_LDB(dst, b, h) do { _Pragma("unroll") for (int n = 0; n < 2; ++n) { dst[n].lo = *(const PG8_LAS i32x4v*)(lds + PG8_SB(b, h) + boff + n * 2048); dst[n].hi = *(const PG8_LAS i32x4v*)(lds + PG8_SB(b, h) + boff + n * 2048 + 1024); } } while (0)
#define PG8_MMA(ai, bj, At, Bt) do { __builtin_amdgcn_s_setprio(1); \
        if constexpr (FP8) { _Pragma("unroll") for (int m = 0; m < 4; ++m) _Pragma("unroll") for (int n = 0; n < 2; ++n) \
            asm volatile("v_mfma_f32_16x16x128_f8f6f4 %0, %1, %2, %0" : "+v"(acc[ai][bj][m][n]) : "v"(Bt[n]), "v"(At[m])); }   \
        else { _Pragma("unroll") for (int m = 0; m < 4; ++m) _Pragma("unroll") for (int n = 0; n < 2; ++n) { \
            const i32x4v bl_ = Bt[n].lo, bh_ = Bt[n].hi, al_ = At[m].lo, ah_ = At[m].hi;     \
            acc[ai][bj][m][n] = __builtin_amdgcn_mfma_f32_16x16x32_bf16(__builtin_bit_cast(bf16x8, bl_), __builtin_bit_cast(bf16x8, al_), acc[ai][bj][m][n], 0, 0, 0); \
            acc[ai][bj][m][n] = __builtin_amdgcn_mfma_f32_16x16x32_bf16(__builtin_bit_cast(bf16x8, bh_), __builtin_bit_cast(bf16x8, ah_), acc[ai][bj][m][n], 0, 0, 0); } } \
        __builtin_amdgcn_s_setprio(0); } while (0)
#define PG8_WAIT_V(n) asm volatile("s_waitcnt vmcnt(" #n ")" ::: "memory")
#define PG8_WAIT_L(n) asm volatile("s_waitcnt lgkmcnt(" #n ")" ::: "memory")
#define PG8_BAR __builtin_amdgcn_s_barrier()
#define PG8_SCHED __builtin_amdgcn_sched_barrier(0)
    Unit cur, nxt; int ui = 0;
    if (!S.next(0, cur)) return;
    f32x4 acc[2][2][4][2];
#pragma unroll
    for (int a = 0; a < 2; ++a)
#pragma unroll
        for (int b = 0; b < 2; ++b)
#pragma unroll
            for (int m = 0; m < 4; ++m)
#pragma unroll
                for (int n = 0; n < 2; ++n) acc[a][b][m][n] = (f32x4){0.f, 0.f, 0.f, 0.f};
    i32x8 At[4], B0[2], B1[2];
    const char* cA = (const char*)g.A + (size_t)cur.pm * tstep; const char* cB = (const char*)g.Bt + (size_t)cur.pn * tstep;
    S.a_ready(cur);
    if constexpr (SP2) {
        PG8_STAGE(PG8_SB(0, 0), cB, voffB); PG8_STAGE(PG8_SB(0, 1), cB + hstep, voffB); PG8_STAGE(PG8_SA(0, 0), cA, voffA); PG8_STAGE(PG8_SA(0, 1), cA + hstep, voffA);
        if (wr == 1) PG8_BAR;
        PG8_WAIT_V(2); PG8_BAR;
        PG8_STAGE(PG8_SB(1, 0), cB + kstep, voffB); PG8_STAGE(PG8_SA(1, 0), cA + kstep, voffA); PG8_STAGE(PG8_SB(1, 1), cB + hstep + kstep, voffB);
        PG8_WAIT_V(6); PG8_BAR;
    } else {
        PG8_STAGE(PG8_SB(0, 0), cB, voffB); PG8_STAGE(PG8_SA(0, 0), cA, voffA); PG8_STAGE(PG8_SB(0, 1), cB + hstep, voffB); PG8_STAGE(PG8_SA(0, 1), cA + hstep, voffA);
        if (wr == 1) PG8_BAR;
        PG8_WAIT_V(4); PG8_BAR;
        PG8_STAGE(PG8_SB(1, 0), cB + kstep, voffB); PG8_STAGE(PG8_SA(1, 0), cA + kstep, voffA); PG8_STAGE(PG8_SB(1, 1), cB + hstep + kstep, voffB);
        PG8_WAIT_V(6); PG8_BAR;
    }
    for (;;) {
        const bool has_next = S.next(ui + 1, nxt);
        const char* nA = has_next ? (const char*)g.A + (size_t)nxt.pm * tstep : cA; const char* nB = has_next ? (const char*)g.Bt + (size_t)nxt.pn * tstep : cB;
        for (int t = 0; t < nt; t += 2) {
            const bool last = (t == nt - 2);
            const char* a1 = cA + (size_t)(t + 1) * kstep;
            const char* a2 = last ? nA : cA + (size_t)(t + 2) * kstep; const char* b2 = last ? nB : cB + (size_t)(t + 2) * kstep;
            const char* a3 = a2 + kstep; const char* b3 = b2 + kstep;
            if (last && has_next) S.a_ready(nxt);
            if constexpr (SP2) {
            PG8_LDB(B0, 0, 0); PG8_LDB(B1, 0, 1); PG8_SCHED; PG8_LDA(At, 0, 0); PG8_STAGE(PG8_SA(1, 1), a1 + hstep, voffA);
            PG8_WAIT_V(8); PG8_WAIT_L(0); PG8_BAR; PG8_MMA(0, 0, At, B0); PG8_MMA(0, 1, At, B1); PG8_BAR; PG8_SCHED;
            PG8_LDA(At, 0, 1); PG8_STAGE(PG8_SB(0, 0), b2, voffB); PG8_STAGE(PG8_SB(0, 1), b2 + hstep, voffB); PG8_STAGE(PG8_SA(0, 0), a2, voffA);
            PG8_WAIT_V(8); PG8_WAIT_L(0); PG8_BAR; PG8_MMA(1, 0, At, B0); PG8_MMA(1, 1, At, B1); PG8_BAR; PG8_SCHED;
            PG8_LDB(B0, 1, 0); PG8_LDB(B1, 1, 1); PG8_SCHED; PG8_LDA(At, 1, 0); PG8_STAGE(PG8_SA(0, 1), a2 + hstep, voffA);
            PG8_WAIT_V(8); PG8_WAIT_L(0); PG8_BAR; PG8_MMA(0, 0, At, B0); PG8_MMA(0, 1, At, B1); PG8_BAR; PG8_SCHED;
            PG8_LDA(At, 1, 1); PG8_STAGE(PG8_SB(1, 0), b3, voffB); PG8_STAGE(PG8_SB(1, 1), b3 + hstep, voffB); PG8_STAGE(PG8_SA(1, 0), a3, voffA);
            PG8_WAIT_V(8); PG8_WAIT_L(0); PG8_BAR; PG8_MMA(1, 0, At, B0); PG8_MMA(1, 1, At, B1); PG8_BAR; PG8_SCHED;
            } else {
            PG8_LDB(B0, 0, 0); PG8_SCHED; PG8_LDA(At, 0, 0); PG8_STAGE(PG8_SA(1, 1), a1 + hstep, voffA);
            PG8_WAIT_L(8); PG8_BAR; PG8_WAIT_L(0); PG8_MMA(0, 0, At, B0); PG8_BAR; PG8_SCHED;
            PG8_LDB(B1, 0, 1); PG8_STAGE(PG8_SB(0, 0), b2, voffB);
            PG8_BAR; PG8_WAIT_L(0); PG8_MMA(0, 1, At, B1); PG8_BAR;
            PG8_LDA(At, 0, 1); PG8_STAGE(PG8_SA(0, 0), a2, voffA);
            PG8_BAR; PG8_WAIT_L(0); PG8_MMA(1, 0, At, B0); PG8_BAR; PG8_SCHED;
            PG8_STAGE(PG8_SB(0, 1), b2 + hstep, voffB);
            PG8_WAIT_V(6); PG8_BAR; PG8_MMA(1, 1, At, B1); PG8_BAR;
            PG8_LDB(B0, 1, 0); PG8_SCHED; PG8_LDA(At, 1, 0); PG8_STAGE(PG8_SA(0, 1), a2 + hstep, voffA);
            PG8_WAIT_L(8); PG8_BAR; PG8_WAIT_L(0); PG8_MMA(0, 0, At, B0); PG8_BAR; PG8_SCHED;
            PG8_LDB(B1, 1, 1); PG8_STAGE(PG8_SB(1, 0), b3, voffB);
            PG8_BAR; PG8_WAIT_L(0); PG8_MMA(0, 1, At, B1); PG8_BAR;
            PG8_LDA(At, 1, 1); PG8_STAGE(PG8_SA(1, 0), a3, voffA);
            PG8_BAR; PG8_WAIT_L(0); PG8_MMA(1, 0, At, B0); PG8_BAR; PG8_SCHED;
            PG8_STAGE(PG8_SB(1, 1), b3 + hstep, voffB);
            PG8_WAIT_V(6); PG8_BAR; PG8_MMA(1, 1, At, B1); PG8_BAR;
            }
        }
        if constexpr (ALIGN_EPI) { if (wr == 0) PG8_BAR; }
        if constexpr (FP8) asm volatile("s_nop 15\n\ts_nop 15" ::: "memory");
        PG8_SCHED;
        if constexpr (!Epi::AFTER_DRAIN) { E(acc, cur, wr, wc, fr, fq); S.done(cur); }
        PG8_SCHED;
        if (!has_next) break;
#pragma unroll
        for (int a = 0; a < 2; ++a)
#pragma unroll
            for (int b = 0; b < 2; ++b)
#pragma unroll
                for (int m = 0; m < 4; ++m)
#pragma unroll
                    for (int n = 0; n < 2; ++n) acc[a][b][m][n] = (f32x4){0.f, 0.f, 0.f, 0.f};
        cur = nxt; cA = nA; cB = nB; ++ui;
        if constexpr (ALIGN_EPI) { if (wr == 1) PG8_BAR; }
    }
    PG8_WAIT_V(0);
    if constexpr (!ALIGN_EPI) { if (wr == 0) PG8_BAR; }
    PG8_BAR;
    if constexpr (Epi::AFTER_DRAIN) { E.fused(acc, cur, wr, wc, fr, fq, lds, wid, lane); S.done(cur); }
#undef PG8_SA
#undef PG8_SB
#undef PG8_STAGE
#undef PG8_LDA
#undef PG8_LDB
#undef PG8_MMA
#undef PG8_WAIT_V
#undef PG8_WAIT_L
#undef PG8_BAR
#undef PG8_SCHED
}
}

#define GAS __attribute__((address_space(1)))
#define LAS __attribute__((address_space(3)))
typedef unsigned v4u __attribute__((ext_vector_type(4)));
typedef float f32x4 __attribute__((ext_vector_type(4)));
typedef GAS unsigned gu32;
#define RLX_AGENT __ATOMIC_RELAXED, __HIP_MEMORY_SCOPE_AGENT
#define LDS_WAIT() asm volatile("s_waitcnt lgkmcnt(0)" ::: "memory")
#define VM_WAIT() asm volatile("s_waitcnt vmcnt(0)" ::: "memory")
constexpr int NWAVES = 8;
constexpr int NPAD = 9472;
constexpr size_t MiB = 1u << 20;
constexpr size_t WS_CTL = 0, CTL_ZERO_BYTES = 1 * MiB;
constexpr size_t WS_MOD = 1 * MiB;
constexpr size_t WS_GAIN = 1 * MiB + 256 * 1024;
constexpr size_t WS_KMEAN = 1 * MiB + 512 * 1024;
constexpr size_t WS_WI = 2 * MiB;
constexpr size_t WS_KI = 3 * MiB;
constexpr size_t WS_MASK = 5 * MiB;
constexpr size_t WS_MODP = 10 * MiB;
constexpr size_t WS_WIN = 18 * MiB;
constexpr size_t WS_HB = 56 * MiB;
constexpr size_t WS_Y = 56 * MiB;
constexpr size_t WS_QA = 120 * MiB, WS_KA = 152 * MiB, WS_VA = 184 * MiB, WS_SZA = 216 * MiB;
constexpr size_t WS_QB = 248 * MiB, WS_KB = 280 * MiB, WS_VB = 312 * MiB, WS_SZB = 344 * MiB;
constexpr size_t WS_QI = 376 * MiB;
constexpr size_t WS_T32 = 408 * MiB;
constexpr size_t WS_Y8 = 408 * MiB;
constexpr size_t WS_HB8 = 440 * MiB;
constexpr size_t WS_WIN8 = 472 * MiB;
constexpr size_t WS_WOUT8 = 492 * MiB;
constexpr size_t WS_END = 496 * MiB;
constexpr float FP8_DESCALE = 1.f / 512.f;
constexpr int CW_QUEUE = 2048;
constexpr int CW_BAR = 4096;
constexpr int RING_BYTES = 131072;
constexpr int EPI_OFF = RING_BYTES;
constexpr int LDSCTL_OFF = EPI_OFF + 16384, MISC_OFF = LDSCTL_OFF + 320;
constexpr int LDS_BYTES = 163840;

#define XB_TMO      128
#define XB_XCNT(j)  (256  + 64 * (j))
#define XB_XSUB(j)  (1280 + 64 * (j))
#define XB_XGEN(j)  (2304 + 64 * (j))
#define XB_TOP      3328
#define XB_TOPGEN   3392
#define XCD_BAR_WORDS 3456
#define XB_SPIN_CAP (1u << 18)

__device__ __forceinline__ unsigned xb_ld(unsigned* p)              { return __hip_atomic_load(p, __ATOMIC_RELAXED, __HIP_MEMORY_SCOPE_AGENT); }
__device__ __forceinline__ unsigned xb_add(unsigned* p, unsigned v) { return __hip_atomic_fetch_add(p, v, __ATOMIC_RELAXED, __HIP_MEMORY_SCOPE_AGENT); }
__device__ __forceinline__ unsigned xb_xcc_id() { return (unsigned)__builtin_amdgcn_s_getreg((3 << 11) | 20) & 0xFu; }
#define XB_SPIN(cond, bar) do { unsigned _sp = 0; while (cond) { __builtin_amdgcn_s_sleep(1); \
    if ((++_sp & 255u) == 0u) { if (xb_ld(&(bar)[XB_TMO])) break; if (_sp > XB_SPIN_CAP) { atomicAdd(&(bar)[XB_TMO], 1u); break; } } } } while (0)

struct XcdBarrier {
    unsigned* bar; unsigned x;
    volatile LAS unsigned* st;
};

__device__ __forceinline__ XcdBarrier xcd_barrier_post(unsigned* bar, volatile LAS unsigned* st) {
    XcdBarrier b; b.bar = bar; b.x = xb_xcc_id(); b.st = st;
    if (threadIdx.x == 0) (void)xb_add(&bar[XB_XCNT(b.x)], 1u);
    return b;
}
__device__ __forceinline__ void xcd_barrier_complete(unsigned* bar, unsigned x, unsigned& nloc, unsigned& nx) {
    const unsigned G = gridDim.x * gridDim.y * gridDim.z;
    unsigned sum, cnt, mine, sp = 0u;
    for (;;) {
        sum = 0u; cnt = 0u; mine = 0u;
#pragma unroll
        for (unsigned j = 0; j < 16; ++j) { const unsigned c = xb_ld(&bar[XB_XCNT(j)]); sum += c; cnt += (c > 0u) ? 1u : 0u; mine = (j == x) ? c : mine; }
        if (sum == G) break;
        __builtin_amdgcn_s_sleep(1);
        if ((++sp & 255u) == 0u) { if (xb_ld(&bar[XB_TMO])) break; if (sp > XB_SPIN_CAP) { atomicAdd(&bar[XB_TMO], 1u); break; } }
    }
    nloc = mine > 0u ? mine : 1u; nx = cnt > 0u ? cnt : 1u;
}

__device__ __forceinline__ void xcd_barrier(const XcdBarrier& b) {
    asm volatile("s_waitcnt vmcnt(0)" ::: "memory");
    __syncthreads();
    if (threadIdx.x == 0) {
        unsigned* bar = b.bar;
        __builtin_amdgcn_s_waitcnt(0);
        unsigned nloc = b.st[0], nx = b.st[1];
        if (nloc == 0u) { xcd_barrier_complete(bar, b.x, nloc, nx); b.st[0] = nloc; b.st[1] = nx; }
        const unsigned old = xb_add(&bar[XB_XSUB(b.x)], 1u);
        const unsigned gen = old / nloc;
        if (old + 1u == (gen + 1u) * nloc) {
            __builtin_amdgcn_fence(__ATOMIC_RELEASE, "agent");
            asm volatile("s_waitcnt vmcnt(0)" ::: "memory");
            const unsigned og = xb_add(&bar[XB_TOP], 1u);
            const unsigned tg = og / nx;
            if (og + 1u == (tg + 1u) * nx) xb_add(&bar[XB_TOPGEN], 1u);
            else XB_SPIN(xb_ld(&bar[XB_TOPGEN]) == tg, bar);
            __builtin_amdgcn_fence(__ATOMIC_ACQUIRE, "agent");
            xb_add(&bar[XB_XGEN(b.x)], 1u);
            asm volatile("s_waitcnt vmcnt(0)" ::: "memory");
        } else {
            XB_SPIN(xb_ld(&bar[XB_XGEN(b.x)]) == gen, bar);
            __builtin_amdgcn_fence(__ATOMIC_ACQUIRE, "agent");
            asm volatile("s_waitcnt vmcnt(0)" ::: "memory");
        }
    }
    __syncthreads();
}


struct Frame {
    LAS unsigned char* lds; volatile LAS unsigned* MISC; gu32* ctl; int tid, lane, wave, vcu, G;
};
__device__ __forceinline__ unsigned cvt_pk_bf16(float lo, float hi) { unsigned r; asm volatile("v_cvt_pk_bf16_f32 %0, %1, %2" : "=v"(r) : "v"(lo), "v"(hi)); return r; }
__device__ __forceinline__ unsigned f2bf_u(float f) { unsigned u = __builtin_bit_cast(unsigned, f); return (u + 0x7fffu + ((u >> 16) & 1u)) >> 16; }
__device__ __forceinline__ unsigned pk2(float lo, float hi) { return f2bf_u(lo) | (f2bf_u(hi) << 16); }
__device__ __forceinline__ float fast_silu(float v) { return v * __builtin_amdgcn_rcpf(1.f + __expf(-v)); }

__device__ __forceinline__ void p0_mod(Frame& F, int id, const float* __restrict__ c, const float* __restrict__ w_ada, float* __restrict__ MODP) {
    const int cs = id & 15, ks = id >> 4;
    LAS float* sc = (LAS float*)(F.lds);
    LAS float* red = (LAS float*)(F.lds + 4096);
    for (int i = F.tid; i < BATCH * 128; i += NWAVES * 64) sc[i] = silu_f(c[(i >> 7) * DM + ks * 128 + (i & 127)]);
    __syncthreads();
    const int cq = F.tid % 96, kq = F.tid / 96;
    if (F.tid < 480) {
        f32x4 acc[8];
#pragma unroll
        for (int b = 0; b < 8; ++b) acc[b] = (f32x4){0.f, 0.f, 0.f, 0.f};
        const float* wp = w_ada + (size_t)(ks * 128) * (3 * DM) + cs * 384 + 4 * cq;
#pragma unroll 4
        for (int k = kq; k < 128; k += 5) { const f32x4 w = *(const f32x4*)(wp + (size_t)k * (3 * DM));
#pragma unroll
            for (int b = 0; b < 8; ++b) acc[b] += w * sc[b * 128 + k]; }
#pragma unroll
        for (int b = 0; b < 8; ++b) *(LAS f32x4*)(red + (kq * 8 + b) * 384 + 4 * cq) = acc[b];
    }
    __syncthreads();
    for (int o = F.tid; o < 8 * 384; o += NWAVES * 64) { const int b = o / 384, col = o % 384; float s = 0.f;
#pragma unroll
        for (int q = 0; q < 5; ++q) s += red[(q * 8 + b) * 384 + col];
        MODP[((size_t)ks * BATCH + b) * (3 * DM) + cs * 384 + col] = s; }
    __syncthreads();
}
__device__ __forceinline__ unsigned pk4_fp8(float a, float b, float c, float d) {
    a = fminf(fmaxf(a, -448.f), 448.f); b = fminf(fmaxf(b, -448.f), 448.f); c = fminf(fmaxf(c, -448.f), 448.f); d = fminf(fmaxf(d, -448.f), 448.f);
    int w = 0; w = __builtin_amdgcn_cvt_pk_fp8_f32(a, b, w, false); w = __builtin_amdgcn_cvt_pk_fp8_f32(c, d, w, true); return (unsigned)w; }
template <bool MAPWIN>
__device__ __forceinline__ void p0_transpose_item(const float* __restrict__ W, int K, int N, int NP, bf16_t* __restrict__ WT, unsigned char* __restrict__ WT8, LAS float* scr, int item, int lane) {
    const int nblk = NP / 32, kb = item / nblk, nb = item % nblk, k0 = 64 * kb, n0 = 32 * nb;
    const int np = n0 + (lane & 31);
    int src = np; bool valid = true;
    if (MAPWIN) { if (np >= 5376) src = np - 176; else if (np >= 5200) valid = false; }
    float wv_[32];
#pragma unroll
    for (int i = 0; i < 32; ++i) { const int kk = 2 * i + (lane >> 5); wv_[i] = valid ? W[(size_t)(k0 + kk) * N + src] : 0.f; }
#pragma unroll
    for (int i = 0; i < 32; ++i) { const int kk = 2 * i + (lane >> 5); scr[kk * 33 + (lane & 31)] = wv_[i]; }
    LDS_WAIT(); asm volatile("" ::: "memory");
    const int c = lane & 7;
    if (WT) {
#pragma unroll
    for (int j = 0; j < 4; ++j) { const int n = (lane >> 3) + 8 * j; const LAS float* s = scr + (8 * c) * 33 + n;
        v4u o; o.x = pk2(s[0 * 33], s[1 * 33]); o.y = pk2(s[2 * 33], s[3 * 33]); o.z = pk2(s[4 * 33], s[5 * 33]); o.w = pk2(s[6 * 33], s[7 * 33]);
        *(GAS v4u*)(WT + (size_t)(n0 + n) * K + k0 + 8 * c) = o; } }
    if (WT8) {
#pragma unroll
        for (int jj = 0; jj < 2; ++jj) { const int idx = lane + 64 * jj, n = idx >> 2, c4 = idx & 3; const LAS float* s = scr + (16 * c4) * 33 + n;
            v4u o; o.x = pk4_fp8(s[0 * 33] * 64.f, s[1 * 33] * 64.f, s[2 * 33] * 64.f, s[3 * 33] * 64.f); o.y = pk4_fp8(s[4 * 33] * 64.f, s[5 * 33] * 64.f, s[6 * 33] * 64.f, s[7 * 33] * 64.f);
            o.z = pk4_fp8(s[8 * 33] * 64.f, s[9 * 33] * 64.f, s[10 * 33] * 64.f, s[11 * 33] * 64.f); o.w = pk4_fp8(s[12 * 33] * 64.f, s[13 * 33] * 64.f, s[14 * 33] * 64.f, s[15 * 33] * 64.f);
            *(GAS v4u*)(WT8 + (size_t)(n0 + n) * K + k0 + 16 * c4) = o; } }
    LDS_WAIT(); asm volatile("" ::: "memory");
}
__device__ __forceinline__ void p0_convert(Frame& F, const float* __restrict__ w_in, const float* __restrict__ w_out, bf16_t* __restrict__ WinT, unsigned char* __restrict__ WinT8, unsigned char* __restrict__ WoutT8) {
    LAS float* scr = (LAS float*)(F.lds + F.wave * 16384);
    const int gw = F.vcu * NWAVES + F.wave, NGW = F.G * NWAVES;
    constexpr int I_IN = (DM / 64) * (NPAD / 32), I_OUT = (DM / 64) * (DM / 32);
    for (int it = gw; it < I_IN + I_OUT; it += NGW) {
        if (it < I_IN) { const int tile = (it % (NPAD / 32)) >> 3; const bool b16 = (tile >= 16 && tile <= 20);
            p0_transpose_item<true>(w_in, DM, DIN, NPAD, b16 ? WinT : nullptr, b16 ? nullptr : WinT8, scr, it, F.lane); }
        else p0_transpose_item<false>(w_out, DM, DM, DM, nullptr, WoutT8, scr, it - I_IN, F.lane);
    }
}
__device__ __forceinline__ void p1_norm(Frame& F, const float* __restrict__ x, const float* __restrict__ g, const float* __restrict__ MODP, const float* __restrict__ b_ada, float* __restrict__ MOD,
                                        bf16_t* __restrict__ HB, unsigned char* __restrict__ HB8) {
    LAS float* gsl = (LAS float*)(F.lds);
    LAS float* shl = (LAS float*)(F.lds + 8192);
    for (int v = F.vcu; v < M / 64; v += F.G) {
        const int b = v / (SEQ / 64);
        { const int k4 = F.tid * 4; const float* pp = MODP + (size_t)b * (3 * DM) + k4;
          f32x4 sh = *(const f32x4*)(b_ada + k4), scl = *(const f32x4*)(b_ada + DM + k4);
#pragma unroll 4
          for (int q = 0; q < 16; ++q) { sh += *(const f32x4*)(pp + (size_t)q * BATCH * (3 * DM)); scl += *(const f32x4*)(pp + (size_t)q * BATCH * (3 * DM) + DM); }
          const f32x4 gg = *(const f32x4*)(g + k4);
          *(LAS f32x4*)(gsl + k4) = gg * (scl + 1.0f); *(LAS f32x4*)(shl + k4) = sh;
          if (F.tid < 64) { const int col = 2 * DM + 64 * (v % (SEQ / 64)) + F.tid; float gt = b_ada[col];
              for (int q = 0; q < 16; ++q) gt += MODP[((size_t)q * BATCH + b) * (3 * DM) + col];
              MOD[b * 3 * DM + col] = gt; } }
        __syncthreads();
        f32x4 gs[8], sh[8];
#pragma unroll
        for (int j = 0; j < 8; ++j) { const int k = 4 * F.lane + 256 * j; gs[j] = *(const LAS f32x4*)(gsl + k); sh[j] = *(const LAS f32x4*)(shl + k); }
        for (int r = 0; r < 8; ++r) {
            const int row = 64 * v + 8 * F.wave + r;
            const f32x4* xr = (const f32x4*)(x + (size_t)row * DM) + F.lane;
            f32x4 xv[8]; float ss = 0.f;
#pragma unroll
            for (int j = 0; j < 8; ++j) { xv[j] = xr[64 * j]; ss += (xv[j].x * xv[j].x + xv[j].y * xv[j].y) + (xv[j].z * xv[j].z + xv[j].w * xv[j].w); }
            ss = wave_sum(ss);
            const float rstd = rsqrtf(ss * (1.f / DM) + RMS_EPS);
            unsigned long long* o8 = (unsigned long long*)(HB + (size_t)row * DM) + F.lane; unsigned* o4 = (unsigned*)(HB8 + (size_t)row * DM) + F.lane;
#pragma unroll
            for (int j = 0; j < 8; ++j) { const f32x4 h = xv[j] * rstd * gs[j] + sh[j];
                o8[64 * j] = (unsigned long long)pk2(h.x, h.y) | ((unsigned long long)pk2(h.z, h.w) << 32);
                o4[64 * j] = pk4_fp8(h.x * 8.f, h.y * 8.f, h.z * 8.f, h.w * 8.f); }
        }
        __syncthreads();
    }
}
struct EpiProj {
    static constexpr bool PERM = true, AFTER_DRAIN = false;
    unsigned char* ws;
    LAS float* P; float osc;
    __device__ __forceinline__ void operator()(const pg8::f32x4 (&acc)[2][2][4][2], const pg8::Unit& u, int wr, int wc, int fr, int fq) const {
        { int l_ = threadIdx.x & 63; asm volatile("" : "+v"(l_)); fr = l_ & 15; fq = l_ >> 4; }
        const int pn = u.pn;
        bf16_t* const KI = (bf16_t*)(ws + WS_KI); float* const WI = (float*)(ws + WS_WI); bf16_t* const QI = (bf16_t*)(ws + WS_QI);
        int grp, sub;
        if (pn < 20) { grp = pn >> 2; sub = pn & 3; } else if (pn == 20) { grp = 5; sub = 0; } else { grp = 6 + ((pn - 21) >> 2); sub = (pn - 21) & 3; }
        const int b = u.pm >> 3, t0 = (u.pm & 7) * 256 + wr * 64 + fr;
        const int cl = 32 * wc + 8 * fq;
        const bool norm = (grp == 0 || grp == 1 || grp == 6 || grp == 7 || grp == 5);
        float rs[2][4][2];
        if (norm) {
#pragma unroll
            for (int ai = 0; ai < 2; ++ai)
#pragma unroll
                for (int m = 0; m < 4; ++m)
#pragma unroll
                    for (int bj = 0; bj < 2; ++bj) { const pg8::f32x4 a = acc[ai][bj][m][0], c = acc[ai][bj][m][1];
                        float s = (a[0] * a[0] + a[1] * a[1]) + (a[2] * a[2] + a[3] * a[3]) + (c[0] * c[0] + c[1] * c[1]) + (c[2] * c[2] + c[3] * c[3]);
                        s += __shfl_xor(s, 16); s += __shfl_xor(s, 32);
                        if (fq == 0) P[((ai * 128 + wr * 64 + m * 16 + fr) * 2 + bj) * 4 + wc] = s; }
            asm volatile("s_waitcnt lgkmcnt(0)" ::: "memory"); __builtin_amdgcn_s_barrier(); asm volatile("" ::: "memory");
#pragma unroll
            for (int ai = 0; ai < 2; ++ai)
#pragma unroll
                for (int m = 0; m < 4; ++m)
#pragma unroll
                    for (int bj = 0; bj < 2; ++bj) { const pg8::f32x4 q = *(const LAS pg8::f32x4*)(P + ((ai * 128 + wr * 64 + m * 16 + fr) * 2 + bj) * 4);
                        rs[ai][m][bj] = ((grp == 5) ? rsqrtf((q[0] + q[1]) * (osc * osc * (1.f / 64.f)) + RMS_EPS) : rsqrtf(((q[0] + q[1]) + (q[2] + q[3])) * (osc * osc * (1.f / 128.f)) + RMS_EPS)) * osc; }
        }
        if (grp == 5) {
            if (wc < 2) { const float* gki = (const float*)(ws + WS_GAIN) + 4 * 128; const pg8::f32x4 g0 = *(const pg8::f32x4*)(gki + cl), g1 = *(const pg8::f32x4*)(gki + cl + 4);
#pragma unroll
                for (int ai = 0; ai < 2; ++ai)
#pragma unroll
                    for (int m = 0; m < 4; ++m) { const size_t row = (size_t)b * SEQ + t0 + 128 * ai + 16 * m; const float r = rs[ai][m][0];
                        const pg8::f32x4 v0 = acc[ai][0][m][0] * r * g0, v1 = acc[ai][0][m][1] * r * g1;
                        pg8::u32x4 w; w.x = cvt_pk_bf16(v0[0], v0[1]); w.y = cvt_pk_bf16(v0[2], v0[3]); w.z = cvt_pk_bf16(v1[0], v1[1]); w.w = cvt_pk_bf16(v1[2], v1[3]);
                        *(pg8::u32x4*)(KI + row * 64 + cl) = w; } }
            else if (wc == 2 && fq < 2) {
#pragma unroll
                for (int ai = 0; ai < 2; ++ai)
#pragma unroll
                    for (int m = 0; m < 4; ++m) { const size_t row = (size_t)b * SEQ + t0 + 128 * ai + 16 * m;
                        *(pg8::f32x4*)(WI + row * 16 + 8 * fq) = acc[ai][0][m][0]; *(pg8::f32x4*)(WI + row * 16 + 8 * fq + 4) = acc[ai][0][m][1]; } }
            return;
        }
        if (grp == 4) {
#pragma unroll
            for (int ai = 0; ai < 2; ++ai)
#pragma unroll
                for (int m = 0; m < 4; ++m) { const size_t row = (size_t)b * SEQ + t0 + 128 * ai + 16 * m;
#pragma unroll
                    for (int bj = 0; bj < 2; ++bj) { const pg8::f32x4 v0 = acc[ai][bj][m][0], v1 = acc[ai][bj][m][1];
                        pg8::u32x4 w; w.x = cvt_pk_bf16(v0[0], v0[1]); w.y = cvt_pk_bf16(v0[2], v0[3]); w.z = cvt_pk_bf16(v1[0], v1[1]); w.w = cvt_pk_bf16(v1[2], v1[3]);
                        *(pg8::u32x4*)(QI + row * 1024 + sub * 256 + bj * 128 + cl) = w; } }
            return;
        }
        bf16_t* dst; const float* gain = nullptr;
        { const int slot = grp < 4 ? grp : grp - 2;
          dst = (bf16_t*)(ws + WS_QA + (size_t)slot * (32 * MiB));
          gain = (const float*)(ws + WS_GAIN) + (grp < 2 ? grp : grp - 4) * 128; }
        pg8::f32x4 g0 = {1.f, 1.f, 1.f, 1.f}, g1 = {1.f, 1.f, 1.f, 1.f};
        if (norm) { g0 = *(const pg8::f32x4*)(gain + cl); g1 = *(const pg8::f32x4*)(gain + cl + 4); }
        const bool act = (grp == 3 || grp == 9);
#pragma unroll
        for (int ai = 0; ai < 2; ++ai)
#pragma unroll
            for (int m = 0; m < 4; ++m) { const int t = t0 + 128 * ai + 16 * m;
#pragma unroll
                for (int bj = 0; bj < 2; ++bj) { const int h = 2 * sub + bj;
                    pg8::f32x4 v0 = acc[ai][bj][m][0], v1 = acc[ai][bj][m][1];
                    if (norm) { const float r = rs[ai][m][bj]; v0 = v0 * r * g0; v1 = v1 * r * g1; } else { v0 = v0 * osc; v1 = v1 * osc; }
                    if (act) { v0[0] = fast_silu(v0[0]); v0[1] = fast_silu(v0[1]); v0[2] = fast_silu(v0[2]); v0[3] = fast_silu(v0[3]);
                               v1[0] = fast_silu(v1[0]); v1[1] = fast_silu(v1[1]); v1[2] = fast_silu(v1[2]); v1[3] = fast_silu(v1[3]); }
                    pg8::u32x4 w; w.x = cvt_pk_bf16(v0[0], v0[1]); w.y = cvt_pk_bf16(v0[2], v0[3]); w.z = cvt_pk_bf16(v1[0], v1[1]); w.w = cvt_pk_bf16(v1[2], v1[3]);
                    *(pg8::u32x4*)(dst + HM(b, h, t, cl)) = w; } }
    }
};
struct EpiOut {
    static constexpr bool PERM = false, AFTER_DRAIN = false;
    const float* x; const float* MOD; float* out; float oscale;
    __device__ __forceinline__ void operator()(const pg8::f32x4 (&acc)[2][2][4][2], const pg8::Unit& u, int wr, int wc, int fr, int fq) const {
        { int l_ = threadIdx.x & 63; asm volatile("" : "+v"(l_)); fr = l_ & 15; fq = l_ >> 4; }
        const int b = u.pm >> 3; const float* gate = MOD + b * 3 * DM + 2 * DM;
        const int col0 = u.pn * 256 + wc * 32 + 4 * fq;
        pg8::f32x4 gv[2][2];
#pragma unroll
        for (int bj = 0; bj < 2; ++bj)
#pragma unroll
            for (int n = 0; n < 2; ++n) gv[bj][n] = *(const pg8::f32x4*)(gate + col0 + bj * 128 + n * 16) * oscale;
#pragma unroll
        for (int ai = 0; ai < 2; ++ai)
#pragma unroll
            for (int m = 0; m < 4; ++m) { const size_t off = (size_t)(u.pm * 256 + ai * 128 + wr * 64 + m * 16 + fr) * DM + col0;
#pragma unroll
                for (int bj = 0; bj < 2; ++bj)
#pragma unroll
                    for (int n = 0; n < 2; ++n) { const pg8::f32x4 xv = *(const pg8::f32x4*)(x + off + bj * 128 + n * 16);
                        *(pg8::f32x4*)(out + off + bj * 128 + n * 16) = xv + gv[bj][n] * acc[ai][bj][m][n]; }
                if (m & 1) asm volatile("" ::: "memory"); }
    }
};

namespace att {
typedef short bf16x8 __attribute__((ext_vector_type(8)));
typedef short s16x4 __attribute__((ext_vector_type(4)));
typedef float f32x16 __attribute__((ext_vector_type(16)));
typedef float f32x4 __attribute__((ext_vector_type(4)));
typedef unsigned u32x4 __attribute__((ext_vector_type(4)));
constexpr int NW = 8, QBLK = 32, KVBLK = 64, QB = NW * QBLK, D = 128;
constexpr int SHM_V = KVBLK * D * 2, SHM_K = KVBLK * D * 2;
constexpr int LDS_WS = 2 * SHM_V + 2 * SHM_K, LDS_KM = LDS_WS + NW * 64 * 4, LDS_OST = 73728, MST_PITCH = 264, MST_WAVE = QBLK * MST_PITCH, LDS_BYTES = LDS_OST + NW * MST_WAVE;
constexpr float SCALE = 0.08838834764831845f, THR = 8.f;
#define KSWZ(row, colB) ((row) * 256 + ((colB) ^ (((row) & 7) << 4)))
#define SBAR() __builtin_amdgcn_sched_barrier(0)
__device__ __forceinline__ int v_st(int k, int c) { const int kk = (k & ~0xC) | ((k & 4) << 1) | ((k & 8) >> 1); return ((kk >> 3) * 4 + (c >> 5)) * 512 + ((kk & 7) * 32 + (c & 31)) * 2; }
__device__ __forceinline__ int v_rd_base(int lane) { return ((lane & 3) << 3) | (((lane >> 2) & 3) << 6) | (((lane >> 4) & 1) << 5) | (((lane >> 5) & 1) << 8); }
constexpr int v_rd_off(int d0, int ks, int half) { return d0 * 512 + ks * 4096 + half * 2048; }
__device__ __forceinline__ int crow(int r, int hi) { return (r & 3) + 8 * (r >> 2) + 4 * hi; }
__device__ __forceinline__ unsigned cvtpk(float lo, float hi) { unsigned r; asm volatile("v_cvt_pk_bf16_f32 %0, %1, %2" : "=v"(r) : "v"(lo), "v"(hi)); return r; }
__device__ __forceinline__ unsigned cvt1(float v) { unsigned r; asm volatile("v_cvt_pk_bf16_f32 %0, %1, 0" : "=v"(r) : "v"(v)); return r; }
__device__ __forceinline__ bf16x8 load8(const bf16_t* p) { return *reinterpret_cast<const bf16x8*>(p); }
__device__ __forceinline__ void mask_causal(f32x16& p0, f32x16& p1, int dq) {
    const float NEG = -__builtin_inff();
#pragma unroll
    for (int r = 0; r < 16; ++r) { const int c = (r & 3) + 8 * (r >> 2); if (dq - c < 0) p0[r] = NEG; if (dq - c - 32 < 0) p1[r] = NEG; }
}
__device__ __forceinline__ void mask_bits(f32x16& p0, f32x16& p1, unsigned w0, unsigned w1) {
    const unsigned NEGB = 0xff800000u;
#pragma unroll
    for (int r = 0; r < 16; ++r) { const int c = (r & 3) + 8 * (r >> 2);
        const unsigned t0 = (unsigned)(((int)(w0 << (31 - c))) >> 31), t1 = (unsigned)(((int)(w1 << (31 - c))) >> 31);
        p0[r] = __uint_as_float((__float_as_uint(p0[r]) & t0) | (NEGB & ~t0));
        p1[r] = __uint_as_float((__float_as_uint(p1[r]) & t1) | (NEGB & ~t1)); }
}
__device__ __forceinline__ void partialSM(f32x16& p0, f32x16& p1, float& m_reg, float& mn, float& alpha, float cb0, float cb1) {
    float pm0 = p0[0]; for (int r = 1; r < 16; ++r) pm0 = fmaxf(pm0, p0[r]); float pm1 = p1[0]; for (int r = 1; r < 16; ++r) pm1 = fmaxf(pm1, p1[r]);
    float pmax = fmaxf(pm0 + cb0, pm1 + cb1);
    { auto rr = __builtin_amdgcn_permlane32_swap(__float_as_uint(pmax), __float_as_uint(pmax), false, false);
      pmax = fmaxf(__uint_as_float(rr[0]), __uint_as_float(rr[1])); }
    constexpr float C2 = 1.4426950408889634f * SCALE;
    if (__builtin_expect(__all((pmax - m_reg) * SCALE <= THR), 1)) { mn = m_reg; alpha = 1.f; }
    else { mn = fmaxf(m_reg, pmax); alpha = __builtin_amdgcn_exp2f((m_reg - mn) * C2); m_reg = mn; }
    const float mnL0 = (cb0 - mn) * C2, mnL1 = (cb1 - mn) * C2;
    for (int r = 0; r < 16; ++r) p0[r] = fmaf(p0[r], C2, mnL0); for (int r = 0; r < 16; ++r) p1[r] = fmaf(p1[r], C2, mnL1);
    for (int r = 0; r < 16; ++r) p0[r] = __builtin_amdgcn_exp2f(p0[r]);
}
__device__ __forceinline__ void finishSM(f32x16& p0, f32x16& p1, float alpha, float& l_reg, bf16x8& pa0, bf16x8& pa1, bf16x8& pa2, bf16x8& pa3) {
    for (int r = 0; r < 16; ++r) p1[r] = __builtin_amdgcn_exp2f(p1[r]);
    float ps = 0; for (int r = 0; r < 16; ++r) ps += p0[r]; for (int r = 0; r < 16; ++r) ps += p1[r];
    { auto rr = __builtin_amdgcn_permlane32_swap(__float_as_uint(ps), __float_as_uint(ps), false, false);
      ps = __uint_as_float(rr[0]) + __uint_as_float(rr[1]); }
    l_reg = l_reg * alpha + ps;
#define PK4(P, B_, OUT) do { unsigned a0 = cvtpk(P[B_+0], P[B_+1]), a1 = cvtpk(P[B_+2], P[B_+3]);                          \
        unsigned b0 = cvtpk(P[B_+4], P[B_+5]), b1 = cvtpk(P[B_+6], P[B_+7]);                                             \
        auto r0 = __builtin_amdgcn_permlane32_swap(a0, b0, false, false); auto r1 = __builtin_amdgcn_permlane32_swap(a1, b1, false, false); \
        u32x4 w = {r0[0], r1[0], r0[1], r1[1]}; OUT = *reinterpret_cast<bf16x8*>(&w); } while (0)
    PK4(p0, 0, pa0); PK4(p0, 8, pa1); PK4(p1, 0, pa2); PK4(p1, 8, pa3);
#undef PK4
}
template <int KB>
__device__ __forceinline__ void qkt(f32x16& p0, f32x16& p1, const char* K_lds, int r32, int hi, const bf16x8* qr, const f32x16& kc, bool act) {
    if (!act) { p0 = f32x16{}; p1 = f32x16{}; return; }
    const char* kb[4];
#pragma unroll
    for (int dd = 0; dd < 4; ++dd) kb[dd] = K_lds + KB * SHM_K + KSWZ(r32, (dd * 16 + hi * 8) * 2);
#pragma unroll
    for (int d0 = 0; d0 < 8; ++d0) { const char* a = kb[d0 & 3] + (d0 >> 2) * 128;
        bf16x8 b0 = *reinterpret_cast<const bf16x8*>(a);
        bf16x8 b1 = *reinterpret_cast<const bf16x8*>(a + 32 * 256);
        if (d0 == 0) { p0 = __builtin_amdgcn_mfma_f32_32x32x16_bf16(b0, qr[0], kc, 0, 0, 0); p1 = __builtin_amdgcn_mfma_f32_32x32x16_bf16(b1, qr[0], kc, 0, 0, 0); }
        else { p0 = __builtin_amdgcn_mfma_f32_32x32x16_bf16(b0, qr[d0], p0, 0, 0, 0); p1 = __builtin_amdgcn_mfma_f32_32x32x16_bf16(b1, qr[d0], p1, 0, 0, 0); } }
}
template <int VB>
__device__ __forceinline__ void pv_tile(f32x16* o, int vb0, bf16x8 pa0, bf16x8 pa1, bf16x8 pa2, bf16x8 pa3, bool act) {
    if (!act) return;
#define TRRD(dst, off) asm volatile("ds_read_b64_tr_b16 %0, %1 offset:%2" : "=&v"(dst) : "v"(vb0), "i"(off) : "memory")
#define PV_D0(d0) do { s16x4 l0, l1, l2, l3, h0, h1, h2, h3; constexpr int b_ = VB * SHM_V + v_rd_off(d0, 0, 0); \
        TRRD(l0, b_); TRRD(h0, b_ + 2048); TRRD(l1, b_ + 4096); TRRD(h1, b_ + 6144); TRRD(l2, b_ + 8192); TRRD(h2, b_ + 10240); TRRD(l3, b_ + 12288); TRRD(h3, b_ + 14336); \
        asm volatile("s_waitcnt lgkmcnt(0)" ::: "memory"); SBAR();   \
        o[d0] = __builtin_amdgcn_mfma_f32_32x32x16_bf16(pa0, (bf16x8){l0[0], l0[1], l0[2], l0[3], h0[0], h0[1], h0[2], h0[3]}, o[d0], 0, 0, 0);   \
        o[d0] = __builtin_amdgcn_mfma_f32_32x32x16_bf16(pa1, (bf16x8){l1[0], l1[1], l1[2], l1[3], h1[0], h1[1], h1[2], h1[3]}, o[d0], 0, 0, 0);   \
        o[d0] = __builtin_amdgcn_mfma_f32_32x32x16_bf16(pa2, (bf16x8){l2[0], l2[1], l2[2], l2[3], h2[0], h2[1], h2[2], h2[3]}, o[d0], 0, 0, 0);   \
        o[d0] = __builtin_amdgcn_mfma_f32_32x32x16_bf16(pa3, (bf16x8){l3[0], l3[1], l3[2], l3[3], h3[0], h3[1], h3[2], h3[3]}, o[d0], 0, 0, 0); } while (0)
    PV_D0(0); PV_D0(1); PV_D0(2); PV_D0(3);
#undef PV_D0
#undef TRRD
}

struct BlockRef { int grp, b, h, qb; };
__device__ __forceinline__ size_t hm_off(const BlockRef& r) { return ((size_t)(r.b * NH + r.h) * SEQ) * D; }
__device__ __forceinline__ const bf16_t* ptrQ(unsigned char* wsb, const BlockRef& r) { return (const bf16_t*)(wsb + (r.grp ? WS_QB : WS_QA)) + hm_off(r) + (size_t)r.qb * QB * D; }
__device__ __forceinline__ const bf16_t* ptrK(unsigned char* wsb, const BlockRef& r) { return (const bf16_t*)(wsb + (r.grp ? WS_KB : WS_KA)) + hm_off(r); }
__device__ __forceinline__ const bf16_t* ptrV(unsigned char* wsb, const BlockRef& r) { return (const bf16_t*)(wsb + (r.grp ? WS_VB : WS_VA)) + hm_off(r); }
__device__ __forceinline__ const bf16_t* ptrZ(unsigned char* wsb, const BlockRef& r) { return (const bf16_t*)(wsb + (r.grp ? WS_SZB : WS_SZA)) + hm_off(r) + (size_t)r.qb * QB * D; }
struct Seam { bf16x8 qr[8]; bf16x8 st_v0, st_v1, st_k0, st_k1; f32x4 km4; };
#define ROW(p, k0, rr) ((const bf16_t*)((const char*)(p) + (unsigned)(((k0) + (rr)) * (D * 2) + sc * 2)))
#define VMW() asm volatile("s_waitcnt vmcnt(0)" ::: "memory")
#define VMWN(n) asm volatile("s_waitcnt vmcnt(%0)" :: "i"(n) : "memory")
#define SLOAD_H(Kp, Vp, k0) do { S.st_v0 = load8(ROW(Vp, k0, sr)); S.st_v1 = load8(ROW(Vp, k0, 32 + sr));              \
                         S.st_k0 = load8(ROW(Kp, k0, sr)); S.st_k1 = load8(ROW(Kp, k0, 32 + sr)); } while (0)
#define SWRITE_HK(bf) do { *(bf16x8*)(K_lds + (bf) * SHM_K + kws) = S.st_k0; *(bf16x8*)(K_lds + (bf) * SHM_K + kws + 32 * 256) = S.st_k1; } while (0)
#define SWRITE_HV(bf) do { *(bf16x8*)(V_lds + (bf) * SHM_V + vst0) = S.st_v0; *(bf16x8*)(V_lds + (bf) * SHM_V + vst1) = S.st_v1; } while (0)
#define SWRITE_H(bf) do { SWRITE_HV(bf); SWRITE_HK(bf); } while (0)
__device__ __forceinline__ void prime_issue(const BlockRef& cur, unsigned char* wsb, Seam& S) {
    int tid = threadIdx.x; asm volatile("" : "+v"(tid));
    const int wid = __builtin_amdgcn_readfirstlane(tid >> 6), lane = tid & 63, r32 = lane & 31, hi = lane >> 5;
    const int sr = tid >> 4, sc = (tid & 15) * 8;
    const bf16_t* Qp = ptrQ(wsb, cur); const bf16_t* Kp = ptrK(wsb, cur); const bf16_t* Vp = ptrV(wsb, cur);
    for (int d0 = 0; d0 < 8; ++d0) S.qr[d0] = load8(Qp + (size_t)(wid * QBLK + r32) * D + d0 * 16 + hi * 8);
    SLOAD_H(Kp, Vp, (4 * cur.qb + 3) * KVBLK);
    if (cur.grp == 1 && tid < cur.qb * 32) { const float* KM = (const float*)(wsb + WS_KMEAN) + ((size_t)(cur.b * NBLK) * NH + cur.h) * 128; S.km4 = *(const f32x4*)(KM + (size_t)(tid >> 5) * (NH * 128) + (tid & 31) * 4); }
}
__device__ __forceinline__ void prime_finish(const BlockRef& cur, unsigned char* wsb, char* lds, Seam& S) {
    int tid = threadIdx.x; asm volatile("" : "+v"(tid));
    const int sr = tid >> 4, sc = (tid & 15) * 8, kws = KSWZ(sr, sc * 2), vst0 = v_st(sr, sc), vst1 = v_st(32 + sr, sc); char* V_lds = lds; char* K_lds = lds + 2 * SHM_V;
    VMW(); SWRITE_H(0);
    if (cur.grp == 1 && tid < cur.qb * 32) *(f32x4*)((float*)(lds + LDS_KM) + (tid >> 5) * 128 + (tid & 31) * 4) = S.km4;
    { const bf16_t* Kp = ptrK(wsb, cur); const bf16_t* Vp = ptrV(wsb, cur); SLOAD_H(Kp, Vp, (4 * cur.qb + 2) * KVBLK); }
    __syncthreads();
}
__device__ __forceinline__ void block(const BlockRef& cur, unsigned char* wsb, char* lds, Seam& S, float Bq, bool has_next, const BlockRef& nxt) {
    const int GRP = cur.grp;
    int tid = threadIdx.x; asm volatile("" : "+v"(tid));
    const int wid = __builtin_amdgcn_readfirstlane(tid >> 6), lane = tid & 63, r32 = lane & 31, hi = lane >> 5;
    const int NT = 4 * cur.qb + 4;
    const int qlo = cur.qb * QB + wid * QBLK, qm = qlo + r32 - 4 * hi;
    char* V_lds = lds; char* K_lds = lds + 2 * SHM_V;
    float* ws = (float*)(lds + LDS_WS) + wid * 64; float* li_l = ws, * al_l = ws + 32;
    float m_reg = -1e30f, l_reg = 0; f32x16 o[4] = {};
    const int sr = tid >> 4, sc = (tid & 15) * 8, vst0 = v_st(sr, sc), vst1 = v_st(32 + sr, sc), kws = KSWZ(sr, sc * 2);
    const int vb0 = (int)(uintptr_t)V_lds + v_rd_base(lane);
    const bf16_t* Kh = ptrK(wsb, cur); const bf16_t* Vh = ptrV(wsb, cur);
    const float sl = exp2f(-(float)(cur.h + 1)) * 11.313708498984761f;
    f32x16 kc;
#pragma unroll
    for (int r = 0; r < 16; ++r) kc[r] = sl * (float)((r & 3) + 8 * (r >> 2));
    unsigned selbits = 0xffu;
    if (GRP == 1) {
        float* km = (float*)(lds + LDS_KM);
        float v1 = -__builtin_inff(), v2 = v1, v3 = v1; int i1 = 31, i2 = 31, i3 = 31;
#pragma unroll 1
        for (int n = 0; n < cur.qb; ++n) { float a = 0.f;
#pragma unroll
            for (int d0 = 0; d0 < 8; ++d0) { const f32x4 k0 = *(const f32x4*)(km + n * 128 + d0 * 16 + hi * 8), k1 = *(const f32x4*)(km + n * 128 + d0 * 16 + hi * 8 + 4);
                const bf16x8 q = S.qr[d0];
                a += bf2f((bf16_t)q[0]) * k0[0] + bf2f((bf16_t)q[1]) * k0[1] + bf2f((bf16_t)q[2]) * k0[2] + bf2f((bf16_t)q[3]) * k0[3]
                   + bf2f((bf16_t)q[4]) * k1[0] + bf2f((bf16_t)q[5]) * k1[1] + bf2f((bf16_t)q[6]) * k1[2] + bf2f((bf16_t)q[7]) * k1[3]; }
            const float other = __shfl_xor(a, 32); const float g = a + other;
            const bool c1 = g > v1, c2 = g > v2, c3 = g > v3;
            v3 = c2 ? v2 : (c3 ? g : v3); i3 = c2 ? i2 : (c3 ? n : i3);
            v2 = c1 ? v1 : (c2 ? g : v2); i2 = c1 ? i1 : (c2 ? n : i2);
            v1 = c1 ? g : v1;             i1 = c1 ? n : i1; }
        selbits = ((1u << i1) | (1u << i2) | (1u << i3)) & 0xffu;
    }
    const char* mst = lds + LDS_OST + wid * MST_WAVE + r32 * MST_PITCH;
    if (GRP == 0) {
        const char* src = (const char*)(wsb + WS_MASK) + ((size_t)cur.b * SEQ + qlo) * 256 + (unsigned)(r32 * 256 + hi * 128);
        u32x4 tmp[8];
#pragma unroll
        for (int i = 0; i < 8; ++i) tmp[i] = *(const u32x4*)(src + 16 * i);
#pragma unroll
        for (int i = 0; i < 8; ++i) { unsigned long long* d = (unsigned long long*)(mst + hi * 128 + 16 * i);
            d[0] = (unsigned long long)tmp[i][0] | ((unsigned long long)tmp[i][1] << 32); d[1] = (unsigned long long)tmp[i][2] | ((unsigned long long)tmp[i][3] << 32); }
    }
#define RESC(a) do { if (__any((a) < 1.f)) { if (hi == 0) al_l[r32] = (a); asm volatile("s_waitcnt lgkmcnt(0)" ::: "memory");              \
                     for (int d_ = 0; d_ < 4; ++d_) for (int r = 0; r < 16; ++r) o[d_][r] *= al_l[crow(r, hi)]; } } while (0)
#define TIX(u) (NT - 1 - (u))
#define KBASE(u) (TIX(u) * KVBLK)
#define CB(u) ((GRP == 1 && TIX(u) < 4 * cur.qb && !((selbits >> (TIX(u) >> 2)) & 1u)) ? -__builtin_inff() : sl * (float)(KBASE(u) - qm))
#define MLOAD(u) ((GRP == 0) ? *(const unsigned long long*)(mst + TIX(u) * 8) : 0ull)
    constexpr float C2_ = 1.4426950408889634f * SCALE;
#define ACT(u) (!((qlo - KBASE(u) - (KVBLK - 1)) > 0 && __all((Bq - sl * (float)(qlo - KBASE(u) - (KVBLK - 1)) - m_reg) * C2_ < -160.f)))
#define MASKT(P0_, P1_, t, mw) do { const int kb_ = KBASE(t); \
        if (GRP == 0) { mask_bits(P0_, P1_, ((unsigned)(mw)) >> (4 * hi), ((unsigned)((mw) >> 32)) >> (4 * hi)); } \
        else if (kb_ + KVBLK - 1 > qlo) mask_causal(P0_, P1_, qm - kb_); } while (0)
    f32x16 pA0, pA1, pB0, pB1; float mnA, mnB, alA = 1.f, alB = 1.f;
    unsigned long long mwA, mwB; bool actA = true, actB = true;
    volatile unsigned* vote = (volatile unsigned*)(lds + LDS_KM + 4096 + 64);
    SBAR();
    mwA = MLOAD(0);
    SBAR(); qkt<0>(pA0, pA1, K_lds, r32, hi, S.qr, kc, true);
    MASKT(pA0, pA1, 0, mwA); { const float cb_ = CB(0); partialSM(pA0, pA1, m_reg, mnA, alA, cb_, cb_ + 32.f * sl); }
    if (NT > 1) { VMW(); SWRITE_H(1); }
    __syncthreads();
#define HALF_STEP(PX0, PX1, mnX, alX, mwX, actX, PY0, PY1, alY, actY, t, KB, VB, SB) do {                                     \
        actX = ACT(t);                                                                                                        \
        SBAR(); qkt<KB>(PX0, PX1, K_lds, r32, hi, S.qr, kc, actX); SBAR();                                             \
        if ((t) + 1 < NT) { SLOAD_H(Kh, Vh, KBASE((t) + 1)); SBAR(); }                                                        \
        mwX = MLOAD(t);                                                                                                       \
        if (actY) { bf16x8 pa0, pa1, pa2, pa3; finishSM(PY0, PY1, alY, l_reg, pa0, pa1, pa2, pa3); SBAR(); pv_tile<VB>(o, vb0, pa0, pa1, pa2, pa3, true); } \
        alX = 1.f; if (actX) { MASKT(PX0, PX1, (t), mwX); const float cb_ = CB(t); partialSM(PX0, PX1, m_reg, mnX, alX, cb_, cb_ + 32.f * sl); }                             \
        __syncthreads();                                                                                                      \
        if ((t) + 1 < NT) { VMW(); SWRITE_H(SB); }                                                                            \
        RESC(alX); } while (0)
    for (int t = 1; t + 1 < NT; t += 2) {
        HALF_STEP(pB0, pB1, mnB, alB, mwB, actB, pA0, pA1, alA, actA, t, 1, 0, 0); __syncthreads();
        HALF_STEP(pA0, pA1, mnA, alA, mwA, actA, pB0, pB1, alB, actB, t + 1, 0, 1, 1);
        if (lane == 0 && actA) vote[(t >> 1) & 1] = 1u;
        __syncthreads();
        const unsigned any_ = vote[(t >> 1) & 1];
        if (tid == 0) vote[((t >> 1) & 1) ^ 1] = 0u;
        if (!any_) break;
    }
    actB = ACT(NT - 1); SBAR(); qkt<1>(pB0, pB1, K_lds, r32, hi, S.qr, kc, actB); SBAR(); mwB = MLOAD(NT - 1);
    if (has_next) prime_issue(nxt, wsb, S);
    if (actA) { bf16x8 pa0, pa1, pa2, pa3; finishSM(pA0, pA1, alA, l_reg, pa0, pa1, pa2, pa3); SBAR(); pv_tile<0>(o, vb0, pa0, pa1, pa2, pa3, true); }
    alB = 1.f; if (actB) { MASKT(pB0, pB1, NT - 1, mwB); const float cb_ = CB(NT - 1); partialSM(pB0, pB1, m_reg, mnB, alB, cb_, cb_ + 32.f * sl); } __syncthreads(); RESC(alB);
    if (actB) { bf16x8 pa0, pa1, pa2, pa3; finishSM(pB0, pB1, alB, l_reg, pa0, pa1, pa2, pa3); SBAR(); pv_tile<1>(o, vb0, pa0, pa1, pa2, pa3, true); }
    u32x4 zvr[8];
    { int lane_z = lane; asm volatile("" : "+v"(lane_z));
      const char* Zw_ = (const char*)(ptrZ(wsb, cur) + (size_t)(wid * QBLK) * D) + (unsigned)(lane_z * 16);
#pragma unroll
      for (int i = 0; i < 8; ++i) zvr[i] = *(const u32x4*)(Zw_ + (unsigned)(i * 1024)); }
    if (hi == 0) li_l[r32] = l_reg; asm volatile("s_waitcnt lgkmcnt(0)" ::: "memory");
    float rli[16];
#pragma unroll
    for (int r = 0; r < 16; ++r) rli[r] = __builtin_amdgcn_rcpf(li_l[crow(r, hi)]);
    { bf16_t* stg = (bf16_t*)(lds + LDS_OST) + wid * (QBLK * D);
      int lane_e = lane; asm volatile("" : "+v"(lane_e));
      bf16_t* stw = stg + (4 * (lane_e >> 5)) * D + (lane_e & 31);
#pragma unroll
      for (int r = 0; r < 16; ++r) { const int orow = (r & 3) + 8 * (r >> 2);
#pragma unroll
          for (int d0 = 0; d0 < 4; ++d0) stw[orow * D + d0 * 32] = (bf16_t)cvt1(o[d0][r] * rli[r]); }
      asm volatile("s_waitcnt lgkmcnt(0)" ::: "memory");
      char* Ow = (char*)(wsb + WS_Y8) + ((size_t)cur.b * SEQ + qlo) * 2048 + cur.grp * 1024 + cur.h * 128;
      const unsigned eo = (unsigned)((lane_e >> 4) * 256 + (lane_e & 15) * 16), yo = (unsigned)((lane_e >> 4) * 2048 + (lane_e & 15) * 8);
#pragma unroll
      for (int i = 0; i < 8; ++i) {
          const u32x4 ov = *(const u32x4*)((const char*)stg + (eo + (unsigned)(i * 1024))), zv = zvr[i]; float f[8];
#pragma unroll
          for (int j = 0; j < 4; ++j) { f[2 * j] = __uint_as_float(ov[j] << 16) * __uint_as_float(zv[j] << 16) * 8.f; f[2 * j + 1] = __uint_as_float(ov[j] & 0xffff0000u) * __uint_as_float(zv[j] & 0xffff0000u) * 8.f; }
          const unsigned long long w = (unsigned long long)pk4_fp8(f[0], f[1], f[2], f[3]) | ((unsigned long long)pk4_fp8(f[4], f[5], f[6], f[7]) << 32);
          *(unsigned long long*)(Ow + (yo + (unsigned)(i * 8192))) = w; } }
    __syncthreads();
#undef RESC
#undef TIX
#undef ACT
#undef KBASE
#undef CB
#undef MLOAD
#undef MASKT
#undef HALF_STEP
}
#undef ROW
#undef VMW
#undef VMWN
#undef SLOAD_H
#undef SWRITE_HK
#undef SWRITE_HV
#undef SWRITE_H
struct ClassOrder { unsigned char v[64]; };
constexpr int class_cost(int c) { const int h = c >> 3, qb = c & 7, full = 4 * qb + 4, cap = h == 0 ? 10 : h == 1 ? 14 : h == 2 ? 22 : 32; return full < cap ? full : cap; }
constexpr ClassOrder make_order() { ClassOrder o{}; for (int i = 0; i < 64; ++i) o.v[i] = (unsigned char)i;
    for (int i = 1; i < 64; ++i) { const unsigned char x = o.v[i]; int j = i - 1; while (j >= 0 && class_cost(o.v[j]) < class_cost(x)) { o.v[j + 1] = o.v[j]; --j; } o.v[j + 1] = x; }
    return o; }
struct XcdPlan { unsigned char n[32]; unsigned char e[32][8]; };
constexpr XcdPlan make_plan() { XcdPlan P{}; const ClassOrder o = make_order(); int load[32] = {};
    for (int k = 0; k < 128; ++k) { const int c = o.v[k >> 1], g = k & 1; int best = 0; for (int j = 1; j < 32; ++j) if (load[j] < load[best]) best = j;
        P.e[best][P.n[best]++] = (unsigned char)(c * 2 + g); load[best] += class_cost(c); }
    return P; }
__device__ __forceinline__ void decode(int p, BlockRef& r) { constexpr ClassOrder ORD = make_order(); const int c = ORD.v[p >> 4], m = p & 15; r.h = c >> 3; r.qb = c & 7; r.grp = m >> 3; r.b = m & 7; }
__device__ __forceinline__ void attn_phase(char* lds, unsigned char* wsb, int v, int G) {
    const int tid = threadIdx.x, lane = tid & 63;
    float BqG[2];
    { const float* G_ = (const float*)(wsb + WS_GAIN);
#pragma unroll
      for (int gsel = 0; gsel < 2; ++gsel) { const float* gq = G_ + gsel * 256; const float* gk = gq + 128;
          float mq = fmaxf(fabsf(gq[lane]), fabsf(gq[lane + 64])), mk = fmaxf(fabsf(gk[lane]), fabsf(gk[lane + 64]));
          mq = wave_max(mq); mk = wave_max(mk); BqG[gsel] = __uint_as_float(__builtin_amdgcn_readfirstlane(__float_as_uint(128.f * 1.02f * mq * mk))); } }
    if (tid == 0) { ((volatile unsigned*)(lds + LDS_KM + 4096 + 64))[0] = 0u; ((volatile unsigned*)(lds + LDS_KM + 4096 + 64))[1] = 0u; }
    Seam S;
    constexpr XcdPlan PLAN = make_plan();
    const int nr = (G == 256) ? PLAN.n[v & 31] : (1024 + G - 1) / G;
    auto get = [&](int r, BlockRef& br) -> bool {
        if (r >= nr) return false;
        if (G == 256) { const int e = PLAN.e[v & 31][r]; br.h = e >> 4; br.qb = (e >> 1) & 7; br.grp = e & 1; br.b = v >> 5; return true; }
        const int p = r * G + ((r & 1) ? G - 1 - v : v); if (p >= 1024) return false; decode(p, br); return true; };
    BlockRef cur, nxt;
    if (!get(0, cur)) return;
    prime_issue(cur, wsb, S);
    for (int r = 0;; ++r) {
        const bool more = get(r + 1, nxt);
        prime_finish(cur, wsb, lds, S);
        block(cur, wsb, lds, S, cur.grp ? BqG[1] : BqG[0], more, nxt);
        if (!more) break;
        cur = nxt;
    }
}
#undef KSWZ
#undef SBAR
}

namespace sel {
#define SLAS __attribute__((address_space(3)))
typedef short bf16x8 __attribute__((ext_vector_type(8)));
typedef float f32x16 __attribute__((ext_vector_type(16)));
typedef float f32x4 __attribute__((ext_vector_type(4)));
typedef unsigned u32x4 __attribute__((ext_vector_type(4)));
constexpr int KB_OFF = 131072;
constexpr int LIST_OFF = 147456 + 2048;
__device__ __forceinline__ float relu1(float x) { return __int_as_float(max(__float_as_int(x), 0)); }
__device__ __forceinline__ unsigned fkey(float x) { const unsigned b = __float_as_uint(x); return (b & 0x80000000u) ? ~b : (b | 0x80000000u); }
struct UnitIn { bf16x8 af[4]; f32x4 w4[4]; u32x4 k0; };
__device__ __forceinline__ void unit_load(unsigned char* wsb, int b, int rg, UnitIn& u) {
    const int tid = threadIdx.x, wid = __builtin_amdgcn_readfirstlane(tid >> 6), lane = tid & 63, g = lane >> 5;
    const int ta = 16 * rg + 2 * wid, t = ta + g, i = lane & 31, tok = (i >> 2) & 1, head = (i & 3) + 4 * (i >> 3);
    const bf16_t* qp = (const bf16_t*)(wsb + WS_QI) + ((size_t)b * SEQ + ta + tok) * 1024 + head * 64 + 8 * (lane >> 5);
#pragma unroll
    for (int ks = 0; ks < 4; ++ks) u.af[ks] = *(const bf16x8*)(qp + 16 * ks);
    const float* wp = (const float*)(wsb + WS_WI) + ((size_t)b * SEQ + t) * 16;
#pragma unroll
    for (int q4 = 0; q4 < 4; ++q4) u.w4[q4] = *(const f32x4*)(wp + 4 * q4);
    u.k0 = *(const u32x4*)((const char*)((const bf16_t*)(wsb + WS_KI) + (size_t)b * SEQ * 64) + (unsigned)(tid * 16));
}
__device__ __forceinline__ void unit(SLAS unsigned char* lds, unsigned char* wsb, int b, int rg, const UnitIn& in, bool has_next, int nb, int nrg, UnitIn& nxt) {
    const int tid = threadIdx.x, wid = __builtin_amdgcn_readfirstlane(tid >> 6), lane = tid & 63, j = lane & 31, g = lane >> 5;
    const char* KIb = (const char*)((const bf16_t*)(wsb + WS_KI) + (size_t)b * SEQ * 64);
    unsigned long long* MASK = (unsigned long long*)(wsb + WS_MASK);
    const int ta = 16 * rg + 2 * wid, t = ta + g;
    const int nkeys = 16 * rg + 16, nk32 = (nkeys + 31) >> 5, nch = (nkeys + 63) >> 6;
    SLAS float* sc = (SLAS float*)lds + (wid * 2 + g) * 2048 + j;
    float vmin = __builtin_inff(), vmax = -__builtin_inff();
    bf16x8 af[4];
#pragma unroll
    for (int ks = 0; ks < 4; ++ks) af[ks] = in.af[ks];
    float wv[16];
#pragma unroll
    for (int q4 = 0; q4 < 4; ++q4) { wv[4 * q4] = in.w4[q4][0] * 0.03125f; wv[4 * q4 + 1] = in.w4[q4][1] * 0.03125f; wv[4 * q4 + 2] = in.w4[q4][2] * 0.03125f; wv[4 * q4 + 3] = in.w4[q4][3] * 0.03125f; }
    const int srow = tid >> 3, scol = tid & 7, swr = srow * 128 + ((scol ^ ((srow >> 1) & 7)) << 4);
    int koff[4];
#pragma unroll
    for (int ks = 0; ks < 4; ++ks) koff[ks] = j * 128 + (((2 * ks + g) ^ ((j >> 1) & 7)) << 4);
    u32x4 stA = in.k0, stB, stC, stD;
    *(SLAS u32x4*)(lds + KB_OFF + swr) = stA;
    stB = *(const u32x4*)(KIb + (unsigned)(min(1, nch - 1) * 8192 + tid * 16));
    stC = *(const u32x4*)(KIb + (unsigned)(min(2, nch - 1) * 8192 + tid * 16));
    stD = *(const u32x4*)(KIb + (unsigned)(min(3, nch - 1) * 8192 + tid * 16));
    stA = *(const u32x4*)(KIb + (unsigned)(min(4, nch - 1) * 8192 + tid * 16));
    __syncthreads();
#define SEL_EPI(ACC, kt) do { float s0 = 0.f, s1 = 0.f, s2 = 0.f, s3 = 0.f; \
        _Pragma("unroll") for (int r = 0; r < 4; ++r) { s0 = fmaf(wv[r], relu1(ACC[r]), s0); s1 = fmaf(wv[4 + r], relu1(ACC[4 + r]), s1); \
                                                       s2 = fmaf(wv[8 + r], relu1(ACC[8 + r]), s2); s3 = fmaf(wv[12 + r], relu1(ACC[12 + r]), s3); } \
        const float s = (s0 + s1) + (s2 + s3); \
        { const bool c_ = 32 * (kt) + j <= t; vmin = (c_ && s < vmin) ? s : vmin; vmax = (c_ && s > vmax) ? s : vmax; }     \
        sc[32 * (kt)] = s; } while (0)
#define SEL_TILES(cc) do { SLAS unsigned char* kb = lds + KB_OFF + ((cc) & 1) * 8192; const int kt0 = 2 * (cc); \
        if (kt0 + 1 < nk32) {                                  \
            f32x16 acc0 = {}, acc1 = {}; \
            _Pragma("unroll") for (int ks = 0; ks < 4; ++ks) { const bf16x8 b0 = *(const SLAS bf16x8*)(kb + koff[ks]), b1 = *(const SLAS bf16x8*)(kb + 4096 + koff[ks]); \
                acc0 = __builtin_amdgcn_mfma_f32_32x32x16_bf16(af[ks], b0, acc0, 0, 0, 0); acc1 = __builtin_amdgcn_mfma_f32_32x32x16_bf16(af[ks], b1, acc1, 0, 0, 0); } \
            SEL_EPI(acc0, kt0); SEL_EPI(acc1, kt0 + 1); \
        } else if (kt0 < nk32) { f32x16 acc0 = {}; \
            _Pragma("unroll") for (int ks = 0; ks < 4; ++ks) { const bf16x8 b0 = *(const SLAS bf16x8*)(kb + koff[ks]); acc0 = __builtin_amdgcn_mfma_f32_32x32x16_bf16(af[ks], b0, acc0, 0, 0, 0); } \
            SEL_EPI(acc0, kt0); } } while (0)
#pragma unroll 1
    for (int c = 0; c < nch; c += 4) {
        SEL_TILES(c);
        *(SLAS u32x4*)(lds + KB_OFF + 8192 + swr) = stB; stB = *(const u32x4*)(KIb + (unsigned)(min(c + 5, nch - 1) * 8192 + tid * 16));
        __syncthreads();
        SEL_TILES(c + 1);
        *(SLAS u32x4*)(lds + KB_OFF + swr) = stC; stC = *(const u32x4*)(KIb + (unsigned)(min(c + 6, nch - 1) * 8192 + tid * 16));
        __syncthreads();
        SEL_TILES(c + 2);
        *(SLAS u32x4*)(lds + KB_OFF + 8192 + swr) = stD; stD = *(const u32x4*)(KIb + (unsigned)(min(c + 7, nch - 1) * 8192 + tid * 16));
        __syncthreads();
        SEL_TILES(c + 3);
        *(SLAS u32x4*)(lds + KB_OFF + swr) = stA; stA = *(const u32x4*)(KIb + (unsigned)(min(c + 8, nch - 1) * 8192 + tid * 16));
        __syncthreads();
    }
#undef SEL_TILES
#undef SEL_EPI
    if (has_next) unit_load(wsb, nb, nrg, nxt);
    unsigned T = 0u; int need = 0; bool ties = false;
    if (16 * rg >= TOPK) {
        SLAS unsigned* hist = (SLAS unsigned*)(lds + KB_OFF) + (wid * 2 + g) * 256;
#pragma unroll
        for (int off = 1; off < 32; off <<= 1) { vmin = fminf(vmin, __shfl_xor(vmin, off)); vmax = fmaxf(vmax, __shfl_xor(vmax, off)); }
        const float range = vmax - vmin, inv = (range > 0.f) ? 255.99f / range : 0.f;
        *(SLAS u32x4*)(hist + 8 * j) = (u32x4){0u, 0u, 0u, 0u}; *(SLAS u32x4*)(hist + 8 * j + 4) = (u32x4){0u, 0u, 0u, 0u};
#pragma unroll 1
        for (int kt0 = 0; kt0 < nk32; kt0 += 4) { float x[4];
#pragma unroll
            for (int i = 0; i < 4; ++i) x[i] = sc[32 * (kt0 + i)];
#pragma unroll
            for (int i = 0; i < 4; ++i) if (32 * (kt0 + i) + j <= t) { const int q = min((int)((x[i] - vmin) * inv), 255); __hip_atomic_fetch_add(hist + q, 1u, __ATOMIC_RELAXED, __HIP_MEMORY_SCOPE_WORKGROUP); } }
        asm volatile("s_waitcnt lgkmcnt(0)" ::: "memory");
        int qsel, cB;
        { const u32x4 c0 = *(const SLAS u32x4*)(hist + 8 * j), c1 = *(const SLAS u32x4*)(hist + 8 * j + 4);
          const int cnt[8] = {(int)c0[0], (int)c0[1], (int)c0[2], (int)c0[3], (int)c1[0], (int)c1[1], (int)c1[2], (int)c1[3]};
          const int s = ((cnt[0] + cnt[1]) + (cnt[2] + cnt[3])) + ((cnt[4] + cnt[5]) + (cnt[6] + cnt[7]));
          int S = s;
#pragma unroll
          for (int off = 1; off < 32; off <<= 1) { const int v = __shfl_down(S, off, 32); if (j + off < 32) S += v; }
          const int above = S - s;
          const bool found = (S >= TOPK) && (above < TOPK);
          int dsel = 0, nneed = 0, csel = 0;
          { const int rem = TOPK - above; int cum = 0; bool done = false;
#pragma unroll
            for (int i = 7; i >= 0; --i) { const int before = cum; cum += cnt[i]; if (!done && cum >= rem) { done = true; dsel = 8 * j + i; nneed = rem - before; csel = cnt[i]; } } }
          const unsigned long long bm = __ballot(found);
          const int src = 32 * g + __builtin_ctz((unsigned)(bm >> (32 * g)) | 0x80000000u);
          qsel = __shfl(dsel, src); need = __shfl(nneed, src); cB = __shfl(csel, src); }
        if (!__any(cB > 64)) {
            SLAS unsigned* list = (SLAS unsigned*)(lds + LIST_OFF) + (wid * 2 + g) * 128;
            int base = 0;
#pragma unroll 1
            for (int kt0 = 0; kt0 < nk32; kt0 += 4) { float x[4];
#pragma unroll
                for (int i = 0; i < 4; ++i) x[i] = sc[32 * (kt0 + i)];
#pragma unroll
                for (int i = 0; i < 4; ++i) { const int kt = kt0 + i;
                    const bool m = (32 * kt + j <= t) && (min((int)((x[i] - vmin) * inv), 255) == qsel);
                    const unsigned long long bal = __ballot(m); const unsigned hm = g ? (unsigned)(bal >> 32) : (unsigned)bal;
                    if (m) { const int pos = base + __builtin_popcount(hm & ((1u << j) - 1u)); list[2 * pos] = fkey(x[i]); list[2 * pos + 1] = (unsigned)(32 * kt + j); }
                    base += __builtin_popcount(hm); } }
            asm volatile("s_waitcnt lgkmcnt(0)" ::: "memory");
            const unsigned u0 = list[2 * j], i0 = list[2 * j + 1], u1 = list[2 * (j + 32)], i1 = list[2 * (j + 32) + 1];
            int r0 = 0, r1 = 0; const int cmax = max(cB, __shfl_xor(cB, 32));
#pragma unroll 1
            for (int e = 0; e < cmax; ++e) { const unsigned ue = list[2 * e], ie = list[2 * e + 1]; const bool in = e < cB;
                r0 += (in && (ue > u0 || (ue == u0 && ie < i0))) ? 1 : 0; r1 += (in && (ue > u1 || (ue == u1 && ie < i1))) ? 1 : 0; }
            const bool h0 = (j < cB) && (r0 == need - 1), h1 = (j + 32 < cB) && (r1 == need - 1);
            const unsigned long long bh = __ballot(h0 || h1);
            const int src = 32 * g + __builtin_ctz((unsigned)(bh >> (32 * g)) | 0x80000000u);
            T = __shfl(h0 ? u0 : u1, src);
            const unsigned long long bg0 = __ballot(j < cB && u0 > T), bg1 = __ballot(j + 32 < cB && u1 > T), be0 = __ballot(j < cB && u0 == T), be1 = __ballot(j + 32 < cB && u1 == T);
            const int ngt = __builtin_popcount(g ? (unsigned)(bg0 >> 32) : (unsigned)bg0) + __builtin_popcount(g ? (unsigned)(bg1 >> 32) : (unsigned)bg1);
            const int neq = __builtin_popcount(g ? (unsigned)(be0 >> 32) : (unsigned)be0) + __builtin_popcount(g ? (unsigned)(be1 >> 32) : (unsigned)be1);
            need = need - ngt; ties = (neq != need);
        } else {
            unsigned prefix = 0u; need = TOPK; int ceq = 0;
#pragma unroll 1
            for (int p = 0; p < 4; ++p) { const int shift = 24 - 8 * p;
                *(SLAS u32x4*)(hist + 8 * j) = (u32x4){0u, 0u, 0u, 0u}; *(SLAS u32x4*)(hist + 8 * j + 4) = (u32x4){0u, 0u, 0u, 0u};
                const unsigned phi = prefix >> ((shift + 8) & 31);
#pragma unroll 1
                for (int kt = 0; kt < nk32; ++kt) { const unsigned x = fkey(sc[32 * kt]);
                    const bool match = (32 * kt + j <= t) && ((p == 0) || ((x >> ((shift + 8) & 31)) == phi));
                    if (match) __hip_atomic_fetch_add(hist + ((x >> shift) & 255u), 1u, __ATOMIC_RELAXED, __HIP_MEMORY_SCOPE_WORKGROUP); }
                asm volatile("s_waitcnt lgkmcnt(0)" ::: "memory");
                const u32x4 c0 = *(const SLAS u32x4*)(hist + 8 * j), c1 = *(const SLAS u32x4*)(hist + 8 * j + 4);
                const int cnt[8] = {(int)c0[0], (int)c0[1], (int)c0[2], (int)c0[3], (int)c1[0], (int)c1[1], (int)c1[2], (int)c1[3]};
                const int s = ((cnt[0] + cnt[1]) + (cnt[2] + cnt[3])) + ((cnt[4] + cnt[5]) + (cnt[6] + cnt[7]));
                int S = s;
#pragma unroll
                for (int off = 1; off < 32; off <<= 1) { const int v = __shfl_down(S, off, 32); if (j + off < 32) S += v; }
                const int above = S - s;
                const bool found = (S >= need) && (above < need);
                int dsel = 0, nneed = 0, csel = 0;
                { const int rem = need - above; int cum = 0; bool done = false;
#pragma unroll
                  for (int i = 7; i >= 0; --i) { const int before = cum; cum += cnt[i]; if (!done && cum >= rem) { done = true; dsel = 8 * j + i; nneed = rem - before; csel = cnt[i]; } } }
                const unsigned long long bm = __ballot(found);
                const int src = 32 * g + __builtin_ctz((unsigned)(bm >> (32 * g)) | 0x80000000u);
                const int digit = __shfl(dsel, src); need = __shfl(nneed, src); ceq = __shfl(csel, src);
                prefix |= (unsigned)digit << shift;
            }
            T = prefix; ties = (ceq != need);
        }
    }
    unsigned wlo = 0u, whi = 0u;
    if (!__any(ties)) {
#pragma unroll 4
        for (int k64 = 0; k64 < 32; ++k64) {
            const bool s0 = (64 * k64 + j <= t) && (fkey(sc[64 * k64]) >= T), s1 = (64 * k64 + 32 + j <= t) && (fkey(sc[64 * k64 + 32]) >= T);
            const unsigned long long b0 = __ballot(s0), b1 = __ballot(s1);
            const unsigned lo = g ? (unsigned)(b0 >> 32) : (unsigned)b0, hi = g ? (unsigned)(b1 >> 32) : (unsigned)b1;
            if (j == k64) { wlo = lo; whi = hi; } }
    } else {
        int base = 0;
#pragma unroll 1
        for (int k64 = 0; k64 < 32; ++k64) { unsigned lo = 0u, hi = 0u;
#pragma unroll
            for (int hh = 0; hh < 2; ++hh) { const bool vld = (64 * k64 + 32 * hh + j <= t); const unsigned x = vld ? fkey(sc[64 * k64 + 32 * hh]) : 0u;
                const unsigned long long be = __ballot(vld && x == T); const unsigned em = g ? (unsigned)(be >> 32) : (unsigned)be;
                const int rank = base + __builtin_popcount(em & ((1u << j) - 1u));
                const bool s1 = vld && ((x > T) || (x == T && rank < need));
                base += __builtin_popcount(em);
                const unsigned long long bs = __ballot(s1); const unsigned sm = g ? (unsigned)(bs >> 32) : (unsigned)bs;
                if (hh == 0) lo = sm; else hi = sm; }
            if (j == k64) { wlo = lo; whi = hi; } }
    }
    MASK[((size_t)b * SEQ + t) * 32 + j] = (unsigned long long)wlo | ((unsigned long long)whi << 32);
    __syncthreads();
}
__device__ __forceinline__ void kmean_unit(SLAS unsigned char* lds, unsigned char* wsb, int b, int n, int h) {
    const int tid = threadIdx.x, d4 = tid & 31, rs = tid >> 5;
    const bf16_t* KB = (const bf16_t*)(wsb + WS_KB) + (((size_t)(b * NH + h) * SEQ) + n * 256) * 128;
    float a0 = 0.f, a1 = 0.f, a2 = 0.f, a3 = 0.f;
#pragma unroll 4
    for (int r = 0; r < 16; ++r) { const unsigned long long v = *(const unsigned long long*)(KB + (size_t)(rs * 16 + r) * 128 + d4 * 4);
        const unsigned lo = (unsigned)v, hi = (unsigned)(v >> 32);
        a0 += __uint_as_float(lo << 16); a1 += __uint_as_float(lo & 0xffff0000u); a2 += __uint_as_float(hi << 16); a3 += __uint_as_float(hi & 0xffff0000u); }
    SLAS float* red = (SLAS float*)lds;
    *(SLAS f32x4*)(red + rs * 128 + d4 * 4) = (f32x4){a0, a1, a2, a3};
    __syncthreads();
    if (tid < 128) { float s = 0.f;
#pragma unroll
        for (int q = 0; q < 16; ++q) s += red[q * 128 + tid];
        ((float*)(wsb + WS_KMEAN))[((size_t)(b * NBLK + n) * NH + h) * 128 + tid] = s * (1.f / 256.f); }
    __syncthreads();
}
__device__ __forceinline__ void select_phase(SLAS unsigned char* lds, unsigned char* wsb, int v, int G) {
    for (int L = v; L < 512; L += G) kmean_unit(lds, wsb, L >> 6, (L >> 3) & 7, L & 7);
    auto get = [&](int k, int& b, int& rg) { const int L = v + (k >> 1) * G; b = L >> 6; rg = (k & 1) ? 127 - (L & 63) : (L & 63); return L < 512; };
    UnitIn cur, nxt; int b, rg, nb, nrg;
    if (!get(0, b, rg)) return;
    unit_load(wsb, b, rg, cur);
    for (int k = 0;; ++k) {
        const bool more = get(k + 1, nb, nrg);
        unit(lds, wsb, b, rg, cur, more, nb, nrg, nxt);
        if (!more) break;
        cur = nxt; b = nb; rg = nrg;
    }
}
#undef SLAS
}

struct Args { const float* in[12]; float* out; unsigned char* ws; int ph_lo, ph_hi, li, pad; };
__global__ void __launch_bounds__(NWAVES * 64, 2) mega_fwd(Args args) {
    extern __shared__ __attribute__((aligned(16))) unsigned char lds[];
    Frame F;
    F.lds = (LAS unsigned char*)lds; F.MISC = (volatile LAS unsigned*)(F.lds + MISC_OFF);
    F.tid = threadIdx.x; F.lane = F.tid & 63; F.wave = __builtin_amdgcn_readfirstlane(F.tid >> 6);
    F.G = gridDim.x; { const int bx = blockIdx.x; F.vcu = (F.G % 8 == 0) ? (bx % 8) * (F.G / 8) + bx / 8 : bx; }
    unsigned char* ws = args.ws;
    F.ctl = (gu32*)(ws + WS_CTL);
    const float* x = args.in[0]; const float* c = args.in[1]; const float* w_ada = args.in[2]; const float* b_ada = args.in[3]; const float* g_norm = args.in[4];
    const float* w_in = args.in[5]; const float* w_out = args.in[11];
    float* MOD = (float*)(ws + WS_MOD); bf16_t* WinT = (bf16_t*)(ws + WS_WIN); bf16_t* HB = (bf16_t*)(ws + WS_HB); bf16_t* Y = (bf16_t*)(ws + WS_Y);
    for (int u = F.tid; u < (LDS_BYTES - LDSCTL_OFF) / 4; u += NWAVES * 64) ((LAS unsigned*)(F.lds + LDSCTL_OFF))[u] = 0u;
    __syncthreads();
    XcdBarrier bar = xcd_barrier_post((unsigned*)(F.ctl + CW_BAR) + args.li * XCD_BAR_WORDS, F.MISC + 8);
    const int lo = args.ph_lo, hi = args.ph_hi;
#define IN(k) (lo <= (k) && (k) < hi)
#define BOTH(k) (IN(k) && IN((k) + 1))
    if (IN(0)) for (int rep_ = 0; rep_ < (((PROBE_DOUBLE) >> 0) & 1) + 1; ++rep_) {
        if (rep_) __syncthreads();
        for (int id = (int)blockIdx.x; id < 256; id += F.G) p0_mod(F, id, c, w_ada, (float*)(ws + WS_MODP));
        if ((int)blockIdx.x == 192) { float* G = (float*)(ws + WS_GAIN);
            if (F.tid < 128) { G[F.tid] = args.in[6][F.tid]; G[128 + F.tid] = args.in[7][F.tid]; G[256 + F.tid] = args.in[9][F.tid]; G[384 + F.tid] = args.in[10][F.tid]; }
            if (F.tid < 64) G[512 + F.tid] = args.in[8][F.tid]; }
        p0_convert(F, w_in, w_out, WinT, ws + WS_WIN8, ws + WS_WOUT8);
    }
    if (BOTH(0)) xcd_barrier(bar);
    if (IN(1)) for (int rep_ = 0; rep_ < (((PROBE_DOUBLE) >> 1) & 1) + 1; ++rep_) p1_norm(F, x, g_norm, (const float*)(ws + WS_MODP), b_ada, MOD, HB, ws + WS_HB8);
    if (BOTH(1)) xcd_barrier(bar);
    if (IN(2)) for (int rep_ = 0; rep_ < (((PROBE_DOUBLE) >> 2) & 1) + 1; ++rep_) {
        const int lc_ = (int)blockIdx.x >> 3;
        { pg8::Gemm g{ws + WS_HB8, ws + WS_WIN8, M, 32 * 256, DM}; pg8::StaticOrder S; S.init(M, 32 * 256, F.G, (int)blockIdx.x, 0, 16, 5); S.WGM = 2;
          if (F.G == 256) S.uneven(7, lc_ < 24 ? lc_ - 16 : 8 + (lc_ - 24), lc_ < 16 ? 0 : lc_ < 24 ? 1 : 3, 8);
          EpiProj E{ws, (LAS float*)(F.lds + EPI_OFF), FP8_DESCALE};
          pg8::gemm_phase<EpiProj, pg8::StaticOrder, true, true, true>(F.lds, g, S, E); }
        { pg8::Gemm g{HB, WinT, M, 5 * 256, DM}; pg8::StaticOrder S; S.init(M, 5 * 256, F.G, (int)blockIdx.x, 16);
          if (F.G == 256) S.uneven(0, lc_ < 16 ? lc_ : 32 + (lc_ - 16), lc_ < 16 ? 2 : lc_ < 24 ? 1 : 0, 16);
          EpiProj E{ws, (LAS float*)(F.lds + EPI_OFF), 1.f};
          pg8::gemm_phase<EpiProj, pg8::StaticOrder, true, true, false>(F.lds, g, S, E); }
    }
    if (BOTH(2)) xcd_barrier(bar);
    if (IN(3)) for (int rep_ = 0; rep_ < (((PROBE_DOUBLE) >> 3) & 1) + 1; ++rep_) sel::select_phase(F.lds, ws, F.vcu, F.G);
    if (BOTH(3)) xcd_barrier(bar);
    if (IN(4)) {
#pragma unroll 1
        for (int rep_ = 0; rep_ < (((PROBE_DOUBLE) >> 4) & 1) + 1; ++rep_) att::attn_phase((char*)lds, ws, F.vcu, F.G);
    }
    if (BOTH(4)) xcd_barrier(bar);
    if (IN(5)) for (int rep_ = 0; rep_ < (((PROBE_DOUBLE) >> 5) & 1) + 1; ++rep_) {
        pg8::Gemm g{ws + WS_Y8, ws + WS_WOUT8, M, DM, DM}; pg8::StaticOrder S; S.init(M, DM, F.G, (int)blockIdx.x);
        EpiOut E{x, MOD, args.out, FP8_DESCALE};
        pg8::gemm_phase<EpiOut, pg8::StaticOrder, true, true, true>(F.lds, g, S, E);
    }
#undef IN
#undef BOTH
}

static int mega_setup() {
    static int grid = 0;
    if (grid == 0) {
        int dev = 0, cus = 0;
        if (hipGetDevice(&dev) != hipSuccess || hipDeviceGetAttribute(&cus, hipDeviceAttributeMultiprocessorCount, dev) != hipSuccess) { fprintf(stderr, "kernel_launch: device query failed\n"); grid = -1; return grid; }
        if (hipFuncSetAttribute((const void*)mega_fwd, hipFuncAttributeMaxDynamicSharedMemorySize, LDS_BYTES) != hipSuccess) { fprintf(stderr, "kernel_launch: hipFuncSetAttribute failed\n"); grid = -1; return grid; }
        (void)hipGetLastError();
        grid = cus;
    }
    return grid;
}
static void mega_launch(int grid, void* const* d_in, void* d_out, void* d_ws, int ph_lo, int ph_hi, int li, hipStream_t stream) {
    Args a{};
    for (int i = 0; i < 12; ++i) a.in[i] = (const float*)d_in[i];
    a.out = (float*)d_out; a.ws = (unsigned char*)d_ws; a.ph_lo = ph_lo; a.ph_hi = ph_hi; a.li = li;
    hipLaunchKernelGGL(mega_fwd, dim3(grid), dim3(NWAVES * 64), LDS_BYTES, stream, a);
}

extern "C" void kernel_launch(void* const* d_in, const int* in_sizes, int n_in, void* d_out, int out_size, void* d_ws, size_t ws_size, hipStream_t stream) {
    if (n_in != 12 || in_sizes[0] != M * DM || out_size != M * DM || ws_size < WS_END) {
        fprintf(stderr, "kernel_launch: unexpected shapes (n_in %d, in0 %d, out %d, ws %zu); nothing launched\n", n_in, n_in > 0 ? in_sizes[0] : -1, out_size, ws_size); return; }
    const int grid = mega_setup(); if (grid <= 0) return;
    char* ws = (char*)d_ws;
    (void)hipMemsetAsync(ws + WS_CTL, 0, CTL_ZERO_BYTES, stream);
    mega_launch(grid, d_in, d_out, d_ws, 0, 6, 0, stream);
#if PROBE_EXTRA >= 0
    mega_launch(grid, d_in, d_out, d_ws, PROBE_EXTRA, PROBE_EXTRA + 1, 1, stream);
#endif
}
```

```cpp
#include <hip/hip_runtime.h>
#include <cstdio>
#include <cstdint>

typedef unsigned short bf16_t;
#ifndef PROBE_EXTRA
#define PROBE_EXTRA -1
#endif
#ifndef PROBE_DOUBLE
#define PROBE_DOUBLE 0
#endif
constexpr int BATCH = 8, SEQ = 2048, DM = 2048, M = BATCH * SEQ, NH = 8, HD = 128, DA = 1024, IH = 16, ID = 64, DIN = 9296;
constexpr int TOPK = 256, NBLK = 8;
constexpr float RMS_EPS = 1e-6f;
constexpr float QK_SCALE = 0.08838834764831845f;

__device__ __forceinline__ float bf2f(bf16_t v) { return __uint_as_float(((unsigned)v) << 16); }
__device__ __forceinline__ bf16_t f2bf(float f) { unsigned u = __float_as_uint(f); return (bf16_t)((u + 0x7fffu + ((u >> 16) & 1u)) >> 16); }
__device__ __forceinline__ float rbf(float f) { return bf2f(f2bf(f)); }
__device__ __forceinline__ float silu_f(float v) { return v / (1.f + __expf(-v)); }
__device__ __forceinline__ size_t HM(int b, int h, int t, int d) { return (((size_t)(b * NH + h) * SEQ + t) * HD + d); }
__device__ __forceinline__ float wave_sum(float v) {
#pragma unroll
    for (int o = 1; o < 64; o <<= 1) v += __shfl_xor(v, o);
    return v;
}
__device__ __forceinline__ float wave_max(float v) {
#pragma unroll
    for (int o = 1; o < 64; o <<= 1) v = fmaxf(v, __shfl_xor(v, o));
    return v;
}
__device__ __forceinline__ void mask_pos(int t, int s, size_t& word, int& bit) { word = (size_t)t * 32 + (s >> 6); bit = s & 63; }

namespace pg8 {
#define PG8_LAS __attribute__((address_space(3)))
typedef unsigned short bf16_t;
typedef short bf16x8 __attribute__((ext_vector_type(8)));
typedef float f32x4 __attribute__((ext_vector_type(4)));
typedef unsigned u32x4 __attribute__((ext_vector_type(4)));
constexpr int BM = 256, BK = 64, HALF = 128, HTB = HALF * BK * 2  , STAGE_BYTES = 8 * HTB, NXCD = 8;

__host__ __device__ __forceinline__ int lds_byte(int r, int c) { const int st = (r >> 4) * 2 + (c >> 5), rr = r & 15, cc = c & 31, ob = rr * 64 + cc * 2; return st * 1024 + (ob ^ (((ob >> 9) & 1) << 5)); }
__host__ __device__ __forceinline__ void stage_rc(int b, int& R, int& C) { const int st = b / 1024, sb = b % 1024, swz = sb ^ (((sb >> 9) & 1) << 5); R = (st >> 1) * 16 + swz / 64; C = (st & 1) * 32 + (swz % 64) / 2; }
__host__ __device__ __forceinline__ int perm32(int rho) { const int n = rho >> 4, i = rho & 15; return 8 * (i >> 2) + 4 * n + (i & 3); }

struct Unit { int pm, pn; };
struct Gemm { const void* A; const void* Bt; int M, N, K; };

struct StaticOrder {
    int nM, nN, nwg, G, c, jump_at, jump, base, skew, WGM = 4, rot = 1, full = 0, ext_q0 = 0, ext_n = 0, ext_st = 0;
    __host__ __device__ void init(int M, int N, int G_, int c_, int base_ = 0, int jump_at_ = 1 << 30, int jump_ = 0, int skew_ = 0) { nM = M / BM; nN = N / BM; nwg = nM * nN; G = G_; c = c_; base = base_; jump_at = jump_at_; jump = jump_; skew = skew_; }
    __host__ __device__ void uneven(int full_, int ext_q0_, int ext_n_, int ext_st_) { skew = -1; full = full_; ext_q0 = ext_q0_; ext_n = ext_n_; ext_st = ext_st_; }
    __host__ __device__ void pair(int pm_, int pn_) { skew = -2; full = pm_; ext_q0 = pn_; }
    __host__ __device__ bool next(int i, Unit& u) const {
        if (skew == -2) { if (i >= 2) return false; u.pm = full; u.pn = ext_q0 + i; return true; }
        long L = (long)i * G + c;
        if (skew < 0) { if (i >= full) { if (i - full >= ext_n) return false; L = (long)full * G + 8 * (ext_q0 + (i - full) * ext_st) + (c & 7); } }
        else if (skew > 0) { const int k = nwg / G;
            if (i == k - 1) { if (c < skew) return false; L = (long)(k - 1) * G + (c - skew); }
            else if (i == k) { if (c < G - skew) return false; L = (long)(k - 1) * G + (G - skew) + (c - (G - skew)); }
            else if (i > k) return false; }
        if (L >= nwg) return false;
        int wgid = (int)L; { const int q = nwg / NXCD, r = nwg % NXCD, xcd = wgid % NXCD, off = wgid / NXCD; wgid = (xcd < r ? xcd * (q + 1) : r * (q + 1) + (xcd - r) * q) + off; }
        const int nig = WGM * nN, gid = wgid / nig, fm = gid * WGM, gsz = (nM - fm) < WGM ? (nM - fm) : WGM;
        u.pm = fm + ((wgid % nig) % gsz); int d = (wgid % nig) / gsz;
        if (rot) { d += (int)((L % NXCD) * nN) / NXCD; d -= (d >= nN) ? nN : 0; }
        u.pn = d + (d >= jump_at ? jump : base); return true;
    }
    __device__ __forceinline__ void a_ready(const Unit&) const {}
    __device__ __forceinline__ void done(const Unit&) const {}
};

template <class Epi, class Sched, bool ALIGN_EPI = false, bool SP2 = false, bool FP8 = false>
__device__ __forceinline__ void gemm_phase(PG8_LAS unsigned char* lds, const Gemm g, const Sched& S, const Epi& E) {
    const int tid = threadIdx.x, wid = __builtin_amdgcn_readfirstlane(tid >> 6), lane = tid & 63, wr = wid >> 2, wc = wid & 3, fr = lane & 15, fq = lane >> 4;
    const int K = FP8 ? g.K / 2 : g.K, nt = K / BK;
    typedef int i32x8 __attribute__((ext_vector_type(8))); typedef int i32x4v __attribute__((ext_vector_type(4)));
    unsigned voffA[2], voffB[2];
#pragma unroll
    for (int i = 0; i < 2; ++i) { int R, C; stage_rc(tid * 16 + i * 8192, R, C); const int Rb = Epi::PERM ? ((R & ~31) + perm32(R & 31)) : R;
        voffA[i] = (unsigned)(R * K + C) * 2u; voffB[i] = (unsigned)(Rb * K + C) * 2u; }
    const size_t kstep = (size_t)(BK * 2);
    const size_t hstep = (size_t)HALF * K * 2;
    const size_t tstep = 2 * hstep;
    const unsigned ldsw = (unsigned)wid * 1024u;
    const int aoff = lds_byte(wr * 64 + fr, fq * 8), boff = lds_byte(wc * 32 + fr, fq * 8);
#define PG8_SA(b, h) (((b) * 2 + (h)) * HTB)
#define PG8_SB(b, h) ((4 + (b) * 2 + (h)) * HTB)
#define PG8_STAGE(bufoff, gbase, voff) do { _Pragma("unroll") for (int _i = 0; _i < 2; ++_i) \
        __builtin_amdgcn_global_load_lds((const unsigned*)((const char*)(gbase) + (voff)[_i]), (PG8_LAS unsigned*)(lds + (bufoff) + ldsw + _i * 8192), 16, 0, 0); } while (0)
#define PG8_LDA(dst, b, h) do { _Pragma("unroll") for (int m = 0; m < 4; ++m) { dst[m].lo = *(const PG8_LAS i32x4v*)(lds + PG8_SA(b, h) + aoff + m * 2048); dst[m].hi = *(const PG8_LAS i32x4v*)(lds + PG8_SA(b, h) + aoff + m * 2048 + 1024); } } while (0)
#define PG8_LDB(dst, b, h) do { _Pragma("unroll") for (int n = 0; n < 2; ++n) { dst[n].lo = *(const PG8_LAS i32x4v*)(lds + PG8_SB(b, h) + boff + n * 2048); dst[n].hi = *(const PG8_LAS i32x4v*)(lds + PG8_SB(b, h) + boff + n * 2048 + 1024); } } while (0)
#define PG8_MMA(ai, bj, At, Bt) do { __builtin_amdgcn_s_setprio(1); \
        if constexpr (FP8) { _Pragma("unroll") for (int m = 0; m < 4; ++m) _Pragma("unroll") for (int n = 0; n < 2; ++n) \
            asm volatile("v_mfma_f32_16x16x128_f8f6f4 %0, %1, %2, %0" : "+v"(acc[ai][bj][m][n]) : "v"(Bt[n]), "v"(At[m])); }   \
        else { _Pragma("unroll") for (int m = 0; m < 4; ++m) _Pragma("unroll") for (int n = 0; n < 2; ++n) { \
            const i32x4v bl_ = Bt[n].lo, bh_ = Bt[n].hi, al_ = At[m].lo, ah_ = At[m].hi;     \
            acc[ai][bj][m][n] = __builtin_amdgcn_mfma_f32_16x16x32_bf16(__builtin_bit_cast(bf16x8, bl_), __builtin_bit_cast(bf16x8, al_), acc[ai][bj][m][n], 0, 0, 0); \
            acc[ai][bj][m][n] = __builtin_amdgcn_mfma_f32_16x16x32_bf16(__builtin_bit_cast(bf16x8, bh_), __builtin_bit_cast(bf16x8, ah_), acc[ai][bj][m][n], 0, 0, 0); } } \
        __builtin_amdgcn_s_setprio(0); } while (0)
#define PG8_WAIT_V(n) asm volatile("s_waitcnt vmcnt(" #n ")" ::: "memory")
#define PG8_WAIT_L(n) asm volatile("s_waitcnt lgkmcnt(" #n ")" ::: "memory")
#define PG8_BAR __builtin_amdgcn_s_barrier()
#define PG8_SCHED __builtin_amdgcn_sched_barrier(0)
    Unit cur, nxt; int ui = 0;
    if (!S.next(0, cur)) return;
    f32x4 acc[2][2][4][2];
#pragma unroll
    for (int a = 0; a < 2; ++a)
#pragma unroll
        for (int b = 0; b < 2; ++b)
#pragma unroll
            for (int m = 0; m < 4; ++m)
#pragma unroll
                for (int n = 0; n < 2; ++n) acc[a][b][m][n] = (f32x4){0.f, 0.f, 0.f, 0.f};
    i32x8 At[4], B0[2], B1[2];
    const char* cA = (const char*)g.A + (size_t)cur.pm * tstep; const char* cB = (const char*)g.Bt + (size_t)cur.pn * tstep;
    S.a_ready(cur);
    if constexpr (SP2) {
        PG8_STAGE(PG8_SB(0, 0), cB, voffB); PG8_STAGE(PG8_SB(0, 1), cB + hstep, voffB); PG8_STAGE(PG8_SA(0, 0), cA, voffA); PG8_STAGE(PG8_SA(0, 1), cA + hstep, voffA);
        if (wr == 1) PG8_BAR;
        PG8_WAIT_V(2); PG8_BAR;
        PG8_STAGE(PG8_SB(1, 0), cB + kstep, voffB); PG8_STAGE(PG8_SA(1, 0), cA + kstep, voffA); PG8_STAGE(PG8_SB(1, 1), cB + hstep + kstep, voffB);
        PG8_WAIT_V(6); PG8_BAR;
    } else {
        PG8_STAGE(PG8_SB(0, 0), cB, voffB); PG8_STAGE(PG8_SA(0, 0), cA, voffA); PG8_STAGE(PG8_SB(0, 1), cB + hstep, voffB); PG8_STAGE(PG8_SA(0, 1), cA + hstep, voffA);
        if (wr == 1) PG8_BAR;
        PG8_WAIT_V(4); PG8_BAR;
        PG8_STAGE(PG8_SB(1, 0), cB + kstep, voffB); PG8_STAGE(PG8_SA(1, 0), cA + kstep, voffA); PG8_STAGE(PG8_SB(1, 1), cB + hstep + kstep, voffB);
        PG8_WAIT_V(6); PG8_BAR;
    }
    for (;;) {
        const bool has_next = S.next(ui + 1, nxt);
        const char* nA = has_next ? (const char*)g.A + (size_t)nxt.pm * tstep : cA; const char* nB = has_next ? (const char*)g.Bt + (size_t)nxt.pn * tstep : cB;
        for (int t = 0; t < nt; t += 2) {
            const bool last = (t == nt - 2);
            const char* a1 = cA + (size_t)(t + 1) * kstep;
            const char* a2 = last ? nA : cA + (size_t)(t + 2) * kstep; const char* b2 = last ? nB : cB + (size_t)(t + 2) * kstep;
            const char* a3 = a2 + kstep; const char* b3 = b2 + kstep;
            if (last && has_next) S.a_ready(nxt);
            if constexpr (SP2) {
            PG8_LDB(B0, 0, 0); PG8_LDB(B1, 0, 1); PG8_SCHED; PG8_LDA(At, 0, 0); PG8_STAGE(PG8_SA(1, 1), a1 + hstep, voffA);
            PG8_WAIT_V(8); PG8_WAIT_L(0); PG8_BAR; PG8_MMA(0, 0, At, B0); PG8_MMA(0, 1, At, B1); PG8_BAR; PG8_SCHED;
            PG8_LDA(At, 0, 1); PG8_STAGE(PG8_SB(0, 0), b2, voffB); PG8_STAGE(PG8_SB(0, 1), b2 + hstep, voffB); PG8_STAGE(PG8_SA(0, 0), a2, voffA);
            PG8_WAIT_V(8); PG8_WAIT_L(0); PG8_BAR; PG8_MMA(1, 0, At, B0); PG8_MMA(1, 1, At, B1); PG8_BAR; PG8_SCHED;
            PG8_LDB(B0, 1, 0); PG8_LDB(B1, 1, 1); PG8_SCHED; PG8_LDA(At, 1, 0); PG8_STAGE(PG8_SA(0, 1), a2 + hstep, voffA);
            PG8_WAIT_V(8); PG8_WAIT_L(0); PG8_BAR; PG8_MMA(0, 0, At, B0); PG8_MMA(0, 1, At, B1); PG8_BAR; PG8_SCHED;
            PG8_LDA(At, 1, 1); PG8_STAGE(PG8_SB(1, 0), b3, voffB); PG8_STAGE(PG8_SB(1, 1), b3 + hstep, voffB); PG8_STAGE(PG8_SA(1, 0), a3, voffA);
            PG8_WAIT_V(8); PG8_WAIT_L(0); PG8_BAR; PG8_MMA(1, 0, At, B0); PG8_MMA(1, 1, At, B1); PG8_BAR; PG8_SCHED;
            } else {
            PG8_LDB(B0, 0, 0); PG8_SCHED; PG8_LDA(At, 0, 0); PG8_STAGE(PG8_SA(1, 1), a1 + hstep, voffA);
            PG8_WAIT_L(8); PG8_BAR; PG8_WAIT_L(0); PG8_MMA(0, 0, At, B0); PG8_BAR; PG8_SCHED;
            PG8_LDB(B1, 0, 1); PG8_STAGE(PG8_SB(0, 0), b2, voffB);
            PG8_BAR; PG8_WAIT_L(0); PG8_MMA(0, 1, At, B1); PG8_BAR;
            PG8_LDA(At, 0, 1); PG8_STAGE(PG8_SA(0, 0), a2, voffA);
            PG8_BAR; PG8_WAIT_L(0); PG8_MMA(1, 0, At, B0); PG8_BAR; PG8_SCHED;
            PG8_STAGE(PG8_SB(0, 1), b2 + hstep, voffB);
            PG8_WAIT_V(6); PG8_BAR; PG8_MMA(1, 1, At, B1); PG8_BAR;
            PG8_LDB(B0, 1, 0); PG8_SCHED; PG8_LDA(At, 1, 0); PG8_STAGE(PG8_SA(0, 1), a2 + hstep, voffA);
            PG8_WAIT_L(8); PG8_BAR; PG8_WAIT_L(0); PG8_MMA(0, 0, At, B0); PG8_BAR; PG8_SCHED;
            PG8_LDB(B1, 1, 1); PG8_STAGE(PG8_SB(1, 0), b3, voffB);
            PG8_BAR; PG8_WAIT_L(0); PG8_MMA(0, 1, At, B1); PG8_BAR;
            PG8_LDA(At, 1, 1); PG8_STAGE(PG8_SA(1, 0), a3, voffA);
            PG8_BAR; PG8_WAIT_L(0); PG8_MMA(1, 0, At, B0); PG8_BAR; PG8_SCHED;
            PG8_STAGE(PG8_SB(1, 1), b3 + hstep, voffB);
            PG8_WAIT_V(6); PG8_BAR; PG8_MMA(1, 1, At, B1); PG8_BAR;
            }
        }
        if constexpr (ALIGN_EPI) { if (wr == 0) PG8_BAR; }
        if constexpr (FP8) asm volatile("s_nop 15\n\ts_nop 15" ::: "memory");
        PG8_SCHED;
        if constexpr (!Epi::AFTER_DRAIN) { E(acc, cur, wr, wc, fr, fq); S.done(cur); }
        PG8_SCHED;
        if (!has_next) break;
#pragma unroll
        for (int a = 0; a < 2; ++a)
#pragma unroll
            for (int b = 0; b < 2; ++b)
#pragma unroll
                for (int m = 0; m < 4; ++m)
#pragma unroll
                    for (int n = 0; n < 2; ++n) acc[a][b][m][n] = (f32x4){0.f, 0.f, 0.f, 0.f};
        cur = nxt; cA = nA; cB = nB; ++ui;
        if constexpr (ALIGN_EPI) { if (wr == 1) PG8_BAR; }
    }
    PG8_WAIT_V(0);
    if constexpr (!ALIGN_EPI) { if (wr == 0) PG8_BAR; }
    PG8_BAR;
    if constexpr (Epi::AFTER_DRAIN) { E.fused(acc, cur, wr, wc, fr, fq, lds, wid, lane); S.done(cur); }
#undef PG8_SA
#undef PG8_SB
#undef PG8_STAGE
#undef PG8_LDA
#undef PG8_LDB
#undef PG8_MMA
#undef PG8_WAIT_V
#undef PG8_WAIT_L
#undef PG8_BAR
#undef PG8_SCHED
}
}

#define GAS __attribute__((address_space(1)))
#define LAS __attribute__((address_space(3)))
typedef unsigned v4u __attribute__((ext_vector_type(4)));
typedef float f32x4 __attribute__((ext_vector_type(4)));
typedef GAS unsigned gu32;
#define RLX_AGENT __ATOMIC_RELAXED, __HIP_MEMORY_SCOPE_AGENT
#define LDS_WAIT() asm volatile("s_waitcnt lgkmcnt(0)" ::: "memory")
#define VM_WAIT() asm volatile("s_waitcnt vmcnt(0)" ::: "memory")
constexpr int NWAVES = 8;
constexpr int NPAD = 9472;
constexpr size_t MiB = 1u << 20;
constexpr size_t WS_CTL = 0, CTL_ZERO_BYTES = 1 * MiB;
constexpr size_t WS_MOD = 1 * MiB;
constexpr size_t WS_GAIN = 1 * MiB + 256 * 1024;
constexpr size_t WS_KMEAN = 1 * MiB + 512 * 1024;
constexpr size_t WS_WI = 2 * MiB;
constexpr size_t WS_KI = 3 * MiB;
constexpr size_t WS_MASK = 5 * MiB;
constexpr size_t WS_MODP = 10 * MiB;
constexpr size_t WS_WIN = 18 * MiB;
constexpr size_t WS_HB = 56 * MiB;
constexpr size_t WS_Y = 56 * MiB;
constexpr size_t WS_QA = 120 * MiB, WS_KA = 152 * MiB, WS_VA = 184 * MiB, WS_SZA = 216 * MiB;
constexpr size_t WS_QB = 248 * MiB, WS_KB = 280 * MiB, WS_VB = 312 * MiB, WS_SZB = 344 * MiB;
constexpr size_t WS_QI = 376 * MiB;
constexpr size_t WS_T32 = 408 * MiB;
constexpr size_t WS_Y8 = 408 * MiB;
constexpr size_t WS_HB8 = 440 * MiB;
constexpr size_t WS_WIN8 = 472 * MiB;
constexpr size_t WS_WOUT8 = 492 * MiB;
constexpr size_t WS_END = 496 * MiB;
constexpr float FP8_DESCALE = 1.f / 512.f;
constexpr int CW_QUEUE = 2048;
constexpr int CW_BAR = 4096;
constexpr int RING_BYTES = 131072;
constexpr int EPI_OFF = RING_BYTES;
constexpr int LDSCTL_OFF = EPI_OFF + 16384, MISC_OFF = LDSCTL_OFF + 320;
constexpr int LDS_BYTES = 163840;

#define XB_TMO      128
#define XB_XCNT(j)  (256  + 64 * (j))
#define XB_XSUB(j)  (1280 + 64 * (j))
#define XB_XGEN(j)  (2304 + 64 * (j))
#define XB_TOP      3328
#define XB_TOPGEN   3392
#define XCD_BAR_WORDS 3456
#define XB_SPIN_CAP (1u << 18)

__device__ __forceinline__ unsigned xb_ld(unsigned* p)              { return __hip_atomic_load(p, __ATOMIC_RELAXED, __HIP_MEMORY_SCOPE_AGENT); }
__device__ __forceinline__ unsigned xb_add(unsigned* p, unsigned v) { return __hip_atomic_fetch_add(p, v, __ATOMIC_RELAXED, __HIP_MEMORY_SCOPE_AGENT); }
__device__ __forceinline__ unsigned xb_xcc_id() { return (unsigned)__builtin_amdgcn_s_getreg((3 << 11) | 20) & 0xFu; }
#define XB_SPIN(cond, bar) do { unsigned _sp = 0; while (cond) { __builtin_amdgcn_s_sleep(1); \
    if ((++_sp & 255u) == 0u) { if (xb_ld(&(bar)[XB_TMO])) break; if (_sp > XB_SPIN_CAP) { atomicAdd(&(bar)[XB_TMO], 1u); break; } } } } while (0)

struct XcdBarrier {
    unsigned* bar; unsigned x;
    volatile LAS unsigned* st;
};

__device__ __forceinline__ XcdBarrier xcd_barrier_post(unsigned* bar, volatile LAS unsigned* st) {
    XcdBarrier b; b.bar = bar; b.x = xb_xcc_id(); b.st = st;
    if (threadIdx.x == 0) st[2] = xb_add(&bar[XB_XCNT(b.x)], 1u);
    return b;
}
__device__ __forceinline__ void xcd_barrier_complete(unsigned* bar, unsigned x, unsigned& nloc, unsigned& nx, unsigned& place) {
    const unsigned G = gridDim.x * gridDim.y * gridDim.z;
    unsigned sum, cnt, mine, rank, n32, sp = 0u;
    for (;;) {
        sum = 0u; cnt = 0u; mine = 0u; rank = 0u; n32 = 0u;
#pragma unroll
        for (unsigned j = 0; j < 16; ++j) { const unsigned c = xb_ld(&bar[XB_XCNT(j)]); sum += c; cnt += (c > 0u) ? 1u : 0u; mine = (j == x) ? c : mine; rank += (c > 0u && j < x) ? 1u : 0u; n32 += (c == 32u) ? 1u : 0u; }
        if (sum == G) break;
        __builtin_amdgcn_s_sleep(1);
        if ((++sp & 255u) == 0u) { if (xb_ld(&bar[XB_TMO])) break; if (sp > XB_SPIN_CAP) { atomicAdd(&bar[XB_TMO], 1u); break; } }
    }
    nloc = mine > 0u ? mine : 1u; nx = cnt > 0u ? cnt : 1u;
    place = 1u | (rank << 1) | ((sum == G && cnt == 8u && n32 == 8u) ? 16u : 0u);
}

__device__ __forceinline__ void xcd_barrier(const XcdBarrier& b) {
    asm volatile("s_waitcnt vmcnt(0)" ::: "memory");
    __syncthreads();
    if (threadIdx.x == 0) {
        unsigned* bar = b.bar;
        __builtin_amdgcn_s_waitcnt(0);
        unsigned nloc = b.st[0], nx = b.st[1];
        if (nloc == 0u) { unsigned place; xcd_barrier_complete(bar, b.x, nloc, nx, place); b.st[0] = nloc; b.st[1] = nx; b.st[3] = place; }
        const unsigned old = xb_add(&bar[XB_XSUB(b.x)], 1u);
        const unsigned gen = old / nloc;
        if (old + 1u == (gen + 1u) * nloc) {
            __builtin_amdgcn_fence(__ATOMIC_RELEASE, "agent");
            asm volatile("s_waitcnt vmcnt(0)" ::: "memory");
            const unsigned og = xb_add(&bar[XB_TOP], 1u);
            const unsigned tg = og / nx;
            if (og + 1u == (tg + 1u) * nx) xb_add(&bar[XB_TOPGEN], 1u);
            else XB_SPIN(xb_ld(&bar[XB_TOPGEN]) == tg, bar);
            __builtin_amdgcn_fence(__ATOMIC_ACQUIRE, "agent");
            xb_add(&bar[XB_XGEN(b.x)], 1u);
            asm volatile("s_waitcnt vmcnt(0)" ::: "memory");
        } else {
            XB_SPIN(xb_ld(&bar[XB_XGEN(b.x)]) == gen, bar);
            __builtin_amdgcn_fence(__ATOMIC_ACQUIRE, "agent");
            asm volatile("s_waitcnt vmcnt(0)" ::: "memory");
        }
    }
    __syncthreads();
}

__device__ __forceinline__ void xcc_barrier(const XcdBarrier& b) {
    asm volatile("s_waitcnt vmcnt(0)" ::: "memory");
    __syncthreads();
    if (threadIdx.x == 0) {
        unsigned* bar = b.bar;
        __builtin_amdgcn_s_waitcnt(0);
        const unsigned nloc = b.st[0];
        __builtin_amdgcn_fence(__ATOMIC_RELEASE, "workgroup");
        const unsigned old = xb_add(&bar[XB_XSUB(b.x)], 1u);
        const unsigned gen = old / nloc;
        if (old + 1u == (gen + 1u) * nloc) xb_add(&bar[XB_XGEN(b.x)], 1u);
        else XB_SPIN(xb_ld(&bar[XB_XGEN(b.x)]) == gen, bar);
        __builtin_amdgcn_fence(__ATOMIC_ACQUIRE, "agent");
        asm volatile("s_waitcnt vmcnt(0)" ::: "memory");
    }
    __syncthreads();
}

__device__ __forceinline__ void cnt_signal(unsigned* p) {
    asm volatile("s_waitcnt vmcnt(0)" ::: "memory"); __syncthreads();
    if (threadIdx.x == 0) (void)__hip_atomic_fetch_add(p, 1u, __ATOMIC_RELAXED, __HIP_MEMORY_SCOPE_AGENT);
}
__device__ __forceinline__ void cnt_wait(unsigned* p, unsigned target, unsigned* bar) {
    if (threadIdx.x == 0) { XB_SPIN(xb_ld(p) < target, bar); __builtin_amdgcn_fence(__ATOMIC_ACQUIRE, "agent"); asm volatile("s_waitcnt vmcnt(0)" ::: "memory"); }
    __syncthreads();
}

struct Frame {
    LAS unsigned char* lds; volatile LAS unsigned* MISC; gu32* ctl; int tid, lane, wave, vcu, G;
};
__device__ __forceinline__ unsigned cvt_pk_bf16(float lo, float hi) { unsigned r; asm volatile("v_cvt_pk_bf16_f32 %0, %1, %2" : "=v"(r) : "v"(lo), "v"(hi)); return r; }
__device__ __forceinline__ unsigned f2bf_u(float f) { unsigned u = __builtin_bit_cast(unsigned, f); return (u + 0x7fffu + ((u >> 16) & 1u)) >> 16; }
__device__ __forceinline__ unsigned pk2(float lo, float hi) { return cvt_pk_bf16(lo, hi); }
__device__ __forceinline__ float fast_silu(float v) { return v * __builtin_amdgcn_rcpf(1.f + __expf(-v)); }

__device__ __forceinline__ void p0_mod(Frame& F, int id, const float* __restrict__ c, const float* __restrict__ w_ada, float* __restrict__ MODP) {
    const int cs = id & 15, ks = id >> 4;
    LAS float* sc = (LAS float*)(F.lds);
    LAS float* red = (LAS float*)(F.lds + 4096);
    for (int i = F.tid; i < BATCH * 128; i += NWAVES * 64) sc[i] = silu_f(c[(i >> 7) * DM + ks * 128 + (i & 127)]);
    __syncthreads();
    const int cq = F.tid % 96, kq = F.tid / 96;
    if (F.tid < 480) {
        f32x4 acc[8];
#pragma unroll
        for (int b = 0; b < 8; ++b) acc[b] = (f32x4){0.f, 0.f, 0.f, 0.f};
        const float* wp = w_ada + (size_t)(ks * 128) * (3 * DM) + cs * 384 + 4 * cq;
#pragma unroll 4
        for (int k = kq; k < 128; k += 5) { const f32x4 w = *(const f32x4*)(wp + (size_t)k * (3 * DM));
#pragma unroll
            for (int b = 0; b < 8; ++b) acc[b] += w * sc[b * 128 + k]; }
#pragma unroll
        for (int b = 0; b < 8; ++b) *(LAS f32x4*)(red + (kq * 8 + b) * 384 + 4 * cq) = acc[b];
    }
    __syncthreads();
    for (int o = F.tid; o < 8 * 384; o += NWAVES * 64) { const int b = o / 384, col = o % 384; float s = 0.f;
#pragma unroll
        for (int q = 0; q < 5; ++q) s += red[(q * 8 + b) * 384 + col];
        MODP[((size_t)ks * BATCH + b) * (3 * DM) + cs * 384 + col] = s; }
    __syncthreads();
}
__device__ __forceinline__ unsigned pk4_fp8(float a, float b, float c, float d) {
    a = __builtin_amdgcn_fmed3f(a, -448.f, 448.f); b = __builtin_amdgcn_fmed3f(b, -448.f, 448.f); c = __builtin_amdgcn_fmed3f(c, -448.f, 448.f); d = __builtin_amdgcn_fmed3f(d, -448.f, 448.f);
    int w = 0; w = __builtin_amdgcn_cvt_pk_fp8_f32(a, b, w, false); w = __builtin_amdgcn_cvt_pk_fp8_f32(c, d, w, true); return (unsigned)w; }
template <bool MAPWIN>
__device__ __forceinline__ void p0_transpose_item(const float* __restrict__ W, int K, int N, int NP, bf16_t* __restrict__ WT, unsigned char* __restrict__ WT8, LAS float* scr, int item, int lane) {
    const int nblk = NP / 32, kb = item / nblk, nb = item % nblk, k0 = 64 * kb, n0 = 32 * nb;
    const int np = n0 + (lane & 31);
    int src = np; bool valid = true;
    if (MAPWIN) { if (np >= 5376) src = np - 176; else if (np >= 5200) valid = false; }
    float wv_[32];
#pragma unroll
    for (int i = 0; i < 32; ++i) { const int kk = 2 * i + (lane >> 5); wv_[i] = valid ? W[(size_t)(k0 + kk) * N + src] : 0.f; }
#pragma unroll
    for (int i = 0; i < 32; ++i) { const int kk = 2 * i + (lane >> 5); scr[kk * 33 + (lane & 31)] = wv_[i]; }
    LDS_WAIT(); asm volatile("" ::: "memory");
    const int c = lane & 7;
    if (WT) {
#pragma unroll
    for (int j = 0; j < 4; ++j) { const int n = (lane >> 3) + 8 * j; const LAS float* s = scr + (8 * c) * 33 + n;
        v4u o; o.x = pk2(s[0 * 33], s[1 * 33]); o.y = pk2(s[2 * 33], s[3 * 33]); o.z = pk2(s[4 * 33], s[5 * 33]); o.w = pk2(s[6 * 33], s[7 * 33]);
        *(GAS v4u*)(WT + (size_t)(n0 + n) * K + k0 + 8 * c) = o; } }
    if (WT8) {
#pragma unroll
        for (int jj = 0; jj < 2; ++jj) { const int idx = lane + 64 * jj, n = idx >> 2, c4 = idx & 3; const LAS float* s = scr + (16 * c4) * 33 + n;
            v4u o; o.x = pk4_fp8(s[0 * 33] * 64.f, s[1 * 33] * 64.f, s[2 * 33] * 64.f, s[3 * 33] * 64.f); o.y = pk4_fp8(s[4 * 33] * 64.f, s[5 * 33] * 64.f, s[6 * 33] * 64.f, s[7 * 33] * 64.f);
            o.z = pk4_fp8(s[8 * 33] * 64.f, s[9 * 33] * 64.f, s[10 * 33] * 64.f, s[11 * 33] * 64.f); o.w = pk4_fp8(s[12 * 33] * 64.f, s[13 * 33] * 64.f, s[14 * 33] * 64.f, s[15 * 33] * 64.f);
            *(GAS v4u*)(WT8 + (size_t)(n0 + n) * K + k0 + 16 * c4) = o; } }
    LDS_WAIT(); asm volatile("" ::: "memory");
}
__device__ __forceinline__ void p0_convert(Frame& F, const float* __restrict__ w_in, const float* __restrict__ w_out, bf16_t* __restrict__ WinT, unsigned char* __restrict__ WinT8, unsigned char* __restrict__ WoutT8) {
    LAS float* scr = (LAS float*)(F.lds + F.wave * 16384);
    const int gw = F.vcu * NWAVES + F.wave, NGW = F.G * NWAVES;
    constexpr int I_IN = (DM / 64) * (NPAD / 32), I_OUT = (DM / 64) * (DM / 32);
    for (int it = gw; it < I_IN + I_OUT; it += NGW) {
        if (it < I_IN) { const int tile = (it % (NPAD / 32)) >> 3; const bool b16 = (tile >= 16 && tile <= 20);
            p0_transpose_item<true>(w_in, DM, DIN, NPAD, b16 ? WinT : nullptr, b16 ? nullptr : WinT8, scr, it, F.lane); }
        else p0_transpose_item<false>(w_out, DM, DM, DM, nullptr, WoutT8, scr, it - I_IN, F.lane);
    }
}
__device__ __forceinline__ void p1_norm(Frame& F, const float* __restrict__ x, const float* __restrict__ g, const float* __restrict__ MODP, const float* __restrict__ b_ada, float* __restrict__ MOD,
                                        bf16_t* __restrict__ HB, unsigned char* __restrict__ HB8) {
    LAS float* gsl = (LAS float*)(F.lds);
    LAS float* shl = (LAS float*)(F.lds + 8192);
    for (int v = F.vcu; v < M / 64; v += F.G) {
        const int b = v / (SEQ / 64);
        { const int k4 = F.tid * 4; const float* pp = MODP + (size_t)b * (3 * DM) + k4;
          f32x4 sh = *(const f32x4*)(b_ada + k4), scl = *(const f32x4*)(b_ada + DM + k4);
#pragma unroll 4
          for (int q = 0; q < 16; ++q) { sh += *(const f32x4*)(pp + (size_t)q * BATCH * (3 * DM)); scl += *(const f32x4*)(pp + (size_t)q * BATCH * (3 * DM) + DM); }
          const f32x4 gg = *(const f32x4*)(g + k4);
          *(LAS f32x4*)(gsl + k4) = gg * (scl + 1.0f); *(LAS f32x4*)(shl + k4) = sh;
          if (F.tid < 64) { const int col = 2 * DM + 64 * (v % (SEQ / 64)) + F.tid; float gt = b_ada[col];
              for (int q = 0; q < 16; ++q) gt += MODP[((size_t)q * BATCH + b) * (3 * DM) + col];
              MOD[b * 3 * DM + col] = gt; } }
        __syncthreads();
        f32x4 gs[8], sh[8];
#pragma unroll
        for (int j = 0; j < 8; ++j) { const int k = 4 * F.lane + 256 * j; gs[j] = *(const LAS f32x4*)(gsl + k); sh[j] = *(const LAS f32x4*)(shl + k); }
        for (int r = 0; r < 8; ++r) {
            const int row = 64 * v + 8 * F.wave + r;
            const f32x4* xr = (const f32x4*)(x + (size_t)row * DM) + F.lane;
            f32x4 xv[8]; float ss = 0.f;
#pragma unroll
            for (int j = 0; j < 8; ++j) { xv[j] = xr[64 * j]; ss += (xv[j].x * xv[j].x + xv[j].y * xv[j].y) + (xv[j].z * xv[j].z + xv[j].w * xv[j].w); }
            ss = wave_sum(ss);
            const float rstd = rsqrtf(ss * (1.f / DM) + RMS_EPS);
            unsigned long long* o8 = (unsigned long long*)(HB + (size_t)row * DM) + F.lane; unsigned* o4 = (unsigned*)(HB8 + (size_t)row * DM) + F.lane;
#pragma unroll
            for (int j = 0; j < 8; ++j) { const f32x4 h = xv[j] * rstd * gs[j] + sh[j];
                o8[64 * j] = (unsigned long long)pk2(h.x, h.y) | ((unsigned long long)pk2(h.z, h.w) << 32);
                o4[64 * j] = pk4_fp8(h.x * 8.f, h.y * 8.f, h.z * 8.f, h.w * 8.f); }
        }
        __syncthreads();
    }
}
struct EpiProj {
    static constexpr bool PERM = true, AFTER_DRAIN = false;
    unsigned char* ws;
    LAS float* P; float osc;
    __device__ __forceinline__ void operator()(const pg8::f32x4 (&acc)[2][2][4][2], const pg8::Unit& u, int wr, int wc, int fr, int fq) const {
        { int l_ = threadIdx.x & 63; asm volatile("" : "+v"(l_)); fr = l_ & 15; fq = l_ >> 4; }
        const int pn = u.pn;
        bf16_t* const KI = (bf16_t*)(ws + WS_KI); float* const WI = (float*)(ws + WS_WI); bf16_t* const QI = (bf16_t*)(ws + WS_QI);
        int grp, sub;
        if (pn < 20) { grp = pn >> 2; sub = pn & 3; } else if (pn == 20) { grp = 5; sub = 0; } else { grp = 6 + ((pn - 21) >> 2); sub = (pn - 21) & 3; }
        const int b = u.pm >> 3, t0 = (u.pm & 7) * 256 + wr * 64 + fr;
        const int cl = 32 * wc + 8 * fq;
        const bool norm = (grp == 0 || grp == 1 || grp == 6 || grp == 7 || grp == 5);
        float rs[2][4][2];
        if (norm) {
#pragma unroll
            for (int ai = 0; ai < 2; ++ai)
#pragma unroll
                for (int m = 0; m < 4; ++m)
#pragma unroll
                    for (int bj = 0; bj < 2; ++bj) { const pg8::f32x4 a = acc[ai][bj][m][0], c = acc[ai][bj][m][1];
                        float s = (a[0] * a[0] + a[1] * a[1]) + (a[2] * a[2] + a[3] * a[3]) + (c[0] * c[0] + c[1] * c[1]) + (c[2] * c[2] + c[3] * c[3]);
                        s += __shfl_xor(s, 16); s += __shfl_xor(s, 32);
                        if (fq == 0) P[((ai * 128 + wr * 64 + m * 16 + fr) * 2 + bj) * 4 + wc] = s; }
            asm volatile("s_waitcnt lgkmcnt(0)" ::: "memory"); __builtin_amdgcn_s_barrier(); asm volatile("" ::: "memory");
#pragma unroll
            for (int ai = 0; ai < 2; ++ai)
#pragma unroll
                for (int m = 0; m < 4; ++m)
#pragma unroll
                    for (int bj = 0; bj < 2; ++bj) { const pg8::f32x4 q = *(const LAS pg8::f32x4*)(P + ((ai * 128 + wr * 64 + m * 16 + fr) * 2 + bj) * 4);
                        rs[ai][m][bj] = ((grp == 5) ? rsqrtf((q[0] + q[1]) * (osc * osc * (1.f / 64.f)) + RMS_EPS) : rsqrtf(((q[0] + q[1]) + (q[2] + q[3])) * (osc * osc * (1.f / 128.f)) + RMS_EPS)) * osc; }
        }
        if (grp == 5) {
            if (wc < 2) { const float* gki = (const float*)(ws + WS_GAIN) + 4 * 128; const pg8::f32x4 g0 = *(const pg8::f32x4*)(gki + cl), g1 = *(const pg8::f32x4*)(gki + cl + 4);
#pragma unroll
                for (int ai = 0; ai < 2; ++ai)
#pragma unroll
                    for (int m = 0; m < 4; ++m) { const size_t row = (size_t)b * SEQ + t0 + 128 * ai + 16 * m; const float r = rs[ai][m][0];
                        const pg8::f32x4 v0 = acc[ai][0][m][0] * r * g0, v1 = acc[ai][0][m][1] * r * g1;
                        pg8::u32x4 w; w.x = cvt_pk_bf16(v0[0], v0[1]); w.y = cvt_pk_bf16(v0[2], v0[3]); w.z = cvt_pk_bf16(v1[0], v1[1]); w.w = cvt_pk_bf16(v1[2], v1[3]);
                        *(pg8::u32x4*)(KI + row * 64 + cl) = w; } }
            else if (wc == 2 && fq < 2) {
#pragma unroll
                for (int ai = 0; ai < 2; ++ai)
#pragma unroll
                    for (int m = 0; m < 4; ++m) { const size_t row = (size_t)b * SEQ + t0 + 128 * ai + 16 * m;
                        *(pg8::f32x4*)(WI + row * 16 + 8 * fq) = acc[ai][0][m][0]; *(pg8::f32x4*)(WI + row * 16 + 8 * fq + 4) = acc[ai][0][m][1]; } }
            return;
        }
        if (grp == 4) {
#pragma unroll
            for (int ai = 0; ai < 2; ++ai)
#pragma unroll
                for (int m = 0; m < 4; ++m) { const size_t row = (size_t)b * SEQ + t0 + 128 * ai + 16 * m;
#pragma unroll
                    for (int bj = 0; bj < 2; ++bj) { const pg8::f32x4 v0 = acc[ai][bj][m][0], v1 = acc[ai][bj][m][1];
                        pg8::u32x4 w; w.x = cvt_pk_bf16(v0[0], v0[1]); w.y = cvt_pk_bf16(v0[2], v0[3]); w.z = cvt_pk_bf16(v1[0], v1[1]); w.w = cvt_pk_bf16(v1[2], v1[3]);
                        *(pg8::u32x4*)(QI + row * 1024 + sub * 256 + bj * 128 + cl) = w; } }
            return;
        }
        bf16_t* dst; const float* gain = nullptr;
        { const int slot = grp < 4 ? grp : grp - 2;
          dst = (bf16_t*)(ws + WS_QA + (size_t)slot * (32 * MiB));
          gain = (const float*)(ws + WS_GAIN) + (grp < 2 ? grp : grp - 4) * 128; }
        pg8::f32x4 g0 = {1.f, 1.f, 1.f, 1.f}, g1 = {1.f, 1.f, 1.f, 1.f};
        if (norm) { g0 = *(const pg8::f32x4*)(gain + cl); g1 = *(const pg8::f32x4*)(gain + cl + 4); }
        const bool act = (grp == 3 || grp == 9);
#pragma unroll
        for (int ai = 0; ai < 2; ++ai)
#pragma unroll
            for (int m = 0; m < 4; ++m) { const int t = t0 + 128 * ai + 16 * m;
#pragma unroll
                for (int bj = 0; bj < 2; ++bj) { const int h = 2 * sub + bj;
                    pg8::f32x4 v0 = acc[ai][bj][m][0], v1 = acc[ai][bj][m][1];
                    if (norm) { const float r = rs[ai][m][bj]; v0 = v0 * r * g0; v1 = v1 * r * g1; } else { v0 = v0 * osc; v1 = v1 * osc; }
                    if (act) { v0[0] = fast_silu(v0[0]); v0[1] = fast_silu(v0[1]); v0[2] = fast_silu(v0[2]); v0[3] = fast_silu(v0[3]);
                               v1[0] = fast_silu(v1[0]); v1[1] = fast_silu(v1[1]); v1[2] = fast_silu(v1[2]); v1[3] = fast_silu(v1[3]); }
                    pg8::u32x4 w; w.x = cvt_pk_bf16(v0[0], v0[1]); w.y = cvt_pk_bf16(v0[2], v0[3]); w.z = cvt_pk_bf16(v1[0], v1[1]); w.w = cvt_pk_bf16(v1[2], v1[3]);
                    *(pg8::u32x4*)(dst + HM(b, h, t, cl)) = w; } }
        if (grp == 7) {
            LAS float* P2 = P + 2048;
#pragma unroll 1
            for (int bj = 0; bj < 2; ++bj) {
                pg8::f32x4 k0 = {0.f, 0.f, 0.f, 0.f}, k1 = {0.f, 0.f, 0.f, 0.f};
#pragma unroll
                for (int ai = 0; ai < 2; ++ai)
#pragma unroll
                    for (int m = 0; m < 4; ++m) { const float r = bj ? rs[ai][m][1] : rs[ai][m][0]; k0 += (bj ? acc[ai][1][m][0] : acc[ai][0][m][0]) * r; k1 += (bj ? acc[ai][1][m][1] : acc[ai][0][m][1]) * r; }
                k0 = k0 * g0; k1 = k1 * g1;
#pragma unroll
                for (int off = 1; off < 16; off <<= 1) {
#pragma unroll
                    for (int e = 0; e < 4; ++e) { k0[e] += __shfl_xor(k0[e], off); k1[e] += __shfl_xor(k1[e], off); } }
                if (fr == 0) { *(LAS pg8::f32x4*)(P2 + (wr * 2 + bj) * 128 + cl) = k0; *(LAS pg8::f32x4*)(P2 + (wr * 2 + bj) * 128 + cl + 4) = k1; } }
            asm volatile("s_waitcnt lgkmcnt(0)" ::: "memory"); __builtin_amdgcn_s_barrier(); asm volatile("" ::: "memory");
            const int tid_ = (int)threadIdx.x;
            if (tid_ < 256) { const int bj = tid_ >> 7, col = tid_ & 127;
                ((float*)(ws + WS_KMEAN))[((size_t)(b * NBLK + (u.pm & 7)) * NH + 2 * sub + bj) * 128 + col] = (P2[bj * 128 + col] + P2[(2 + bj) * 128 + col]) * (1.f / 256.f); }
        }
    }
};
struct EpiOut {
    static constexpr bool PERM = false, AFTER_DRAIN = false;
    const float* x; const float* MOD; float* out; float oscale;
    __device__ __forceinline__ void operator()(const pg8::f32x4 (&acc)[2][2][4][2], const pg8::Unit& u, int wr, int wc, int fr, int fq) const {
        { int l_ = threadIdx.x & 63; asm volatile("" : "+v"(l_)); fr = l_ & 15; fq = l_ >> 4; }
        const int b = u.pm >> 3; const float* gate = MOD + b * 3 * DM + 2 * DM;
        const int col0 = u.pn * 256 + wc * 32 + 4 * fq;
        pg8::f32x4 gv[2][2];
#pragma unroll
        for (int bj = 0; bj < 2; ++bj)
#pragma unroll
            for (int n = 0; n < 2; ++n) gv[bj][n] = *(const pg8::f32x4*)(gate + col0 + bj * 128 + n * 16) * oscale;
#pragma unroll
        for (int ai = 0; ai < 2; ++ai)
#pragma unroll
            for (int m = 0; m < 4; ++m) { const size_t off = (size_t)(u.pm * 256 + ai * 128 + wr * 64 + m * 16 + fr) * DM + col0;
#pragma unroll
                for (int bj = 0; bj < 2; ++bj)
#pragma unroll
                    for (int n = 0; n < 2; ++n) { const pg8::f32x4 xv = *(const pg8::f32x4*)(x + off + bj * 128 + n * 16);
                        *(pg8::f32x4*)(out + off + bj * 128 + n * 16) = xv + gv[bj][n] * acc[ai][bj][m][n]; }
                if (m & 1) asm volatile("" ::: "memory"); }
    }
};

namespace att {
typedef short bf16x8 __attribute__((ext_vector_type(8)));
typedef short s16x4 __attribute__((ext_vector_type(4)));
typedef float f32x16 __attribute__((ext_vector_type(16)));
typedef float f32x4 __attribute__((ext_vector_type(4)));
typedef unsigned u32x4 __attribute__((ext_vector_type(4)));
constexpr int NW = 8, QBLK = 32, KVBLK = 64, QB = NW * QBLK, D = 128;
constexpr int SHM_V = KVBLK * D * 2, SHM_K = KVBLK * D * 2;
constexpr int LDS_WS = 2 * SHM_V + 2 * SHM_K, LDS_KM = LDS_WS + NW * 64 * 4, LDS_OST = 73728, MST_PITCH = 264, MST_WAVE = QBLK * MST_PITCH, LDS_BYTES = LDS_OST + NW * MST_WAVE;
constexpr float SCALE = 0.08838834764831845f, THR = 8.f;
#define KSWZ(row, colB) ((row) * 256 + ((colB) ^ (((row) & 7) << 4)))
#define SBAR() __builtin_amdgcn_sched_barrier(0)
__device__ __forceinline__ int v_st(int k, int c) { const int kk = (k & ~0xC) | ((k & 4) << 1) | ((k & 8) >> 1); return ((kk >> 3) * 4 + (c >> 5)) * 512 + ((kk & 7) * 32 + (c & 31)) * 2; }
__device__ __forceinline__ int v_rd_base(int lane) { return ((lane & 3) << 3) | (((lane >> 2) & 3) << 6) | (((lane >> 4) & 1) << 5) | (((lane >> 5) & 1) << 8); }
constexpr int v_rd_off(int d0, int ks, int half) { return d0 * 512 + ks * 4096 + half * 2048; }
__device__ __forceinline__ int crow(int r, int hi) { return (r & 3) + 8 * (r >> 2) + 4 * hi; }
__device__ __forceinline__ unsigned cvtpk(float lo, float hi) { unsigned r; asm volatile("v_cvt_pk_bf16_f32 %0, %1, %2" : "=v"(r) : "v"(lo), "v"(hi)); return r; }
__device__ __forceinline__ unsigned cvt1(float v) { unsigned r; asm volatile("v_cvt_pk_bf16_f32 %0, %1, 0" : "=v"(r) : "v"(v)); return r; }
__device__ __forceinline__ bf16x8 load8(const bf16_t* p) { return *reinterpret_cast<const bf16x8*>(p); }
__device__ __forceinline__ void mask_causal(f32x16& p0, f32x16& p1, int dq) {
    const float NEG = -__builtin_inff();
#pragma unroll
    for (int r = 0; r < 16; ++r) { const int c = (r & 3) + 8 * (r >> 2); if (dq - c < 0) p0[r] = NEG; if (dq - c - 32 < 0) p1[r] = NEG; }
}
__device__ __forceinline__ void mask_bits(f32x16& p0, f32x16& p1, unsigned w0, unsigned w1) {
    const unsigned NEGB = 0xff800000u;
#pragma unroll
    for (int r = 0; r < 16; ++r) { const int c = (r & 3) + 8 * (r >> 2);
        const unsigned t0 = (unsigned)(((int)(w0 << (31 - c))) >> 31), t1 = (unsigned)(((int)(w1 << (31 - c))) >> 31);
        p0[r] = __uint_as_float((__float_as_uint(p0[r]) & t0) | (NEGB & ~t0));
        p1[r] = __uint_as_float((__float_as_uint(p1[r]) & t1) | (NEGB & ~t1)); }
}
__device__ __forceinline__ void partialSM(f32x16& p0, f32x16& p1, float& m_reg, float& mn, float& alpha, float cb0, float cb1) {
    float pm0 = p0[0]; for (int r = 1; r < 16; ++r) pm0 = fmaxf(pm0, p0[r]); float pm1 = p1[0]; for (int r = 1; r < 16; ++r) pm1 = fmaxf(pm1, p1[r]);
    float pmax = fmaxf(pm0 + cb0, pm1 + cb1);
    { auto rr = __builtin_amdgcn_permlane32_swap(__float_as_uint(pmax), __float_as_uint(pmax), false, false);
      pmax = fmaxf(__uint_as_float(rr[0]), __uint_as_float(rr[1])); }
    constexpr float C2 = 1.4426950408889634f * SCALE;
    if (__builtin_expect(__all((pmax - m_reg) * SCALE <= THR), 1)) { mn = m_reg; alpha = 1.f; }
    else { mn = fmaxf(m_reg, pmax); alpha = __builtin_amdgcn_exp2f((m_reg - mn) * C2); m_reg = mn; }
    const float mnL0 = (cb0 - mn) * C2, mnL1 = (cb1 - mn) * C2;
    for (int r = 0; r < 16; ++r) p0[r] = fmaf(p0[r], C2, mnL0); for (int r = 0; r < 16; ++r) p1[r] = fmaf(p1[r], C2, mnL1);
    for (int r = 0; r < 16; ++r) p0[r] = __builtin_amdgcn_exp2f(p0[r]);
}
__device__ __forceinline__ void finishSM(f32x16& p0, f32x16& p1, float alpha, float& l_reg, bf16x8& pa0, bf16x8& pa1, bf16x8& pa2, bf16x8& pa3) {
    for (int r = 0; r < 16; ++r) p1[r] = __builtin_amdgcn_exp2f(p1[r]);
    float ps = 0; for (int r = 0; r < 16; ++r) ps += p0[r]; for (int r = 0; r < 16; ++r) ps += p1[r];
    { auto rr = __builtin_amdgcn_permlane32_swap(__float_as_uint(ps), __float_as_uint(ps), false, false);
      ps = __uint_as_float(rr[0]) + __uint_as_float(rr[1]); }
    l_reg = l_reg * alpha + ps;
#define PK4(P, B_, OUT) do { unsigned a0 = cvtpk(P[B_+0], P[B_+1]), a1 = cvtpk(P[B_+2], P[B_+3]);                          \
        unsigned b0 = cvtpk(P[B_+4], P[B_+5]), b1 = cvtpk(P[B_+6], P[B_+7]);                                             \
        auto r0 = __builtin_amdgcn_permlane32_swap(a0, b0, false, false); auto r1 = __builtin_amdgcn_permlane32_swap(a1, b1, false, false); \
        u32x4 w = {r0[0], r1[0], r0[1], r1[1]}; OUT = *reinterpret_cast<bf16x8*>(&w); } while (0)
    PK4(p0, 0, pa0); PK4(p0, 8, pa1); PK4(p1, 0, pa2); PK4(p1, 8, pa3);
#undef PK4
}
template <int KB>
__device__ __forceinline__ void qkt(f32x16& p0, f32x16& p1, const char* K_lds, int r32, int hi, const bf16x8* qr, const f32x16& kc, bool act) {
    if (!act) { p0 = f32x16{}; p1 = f32x16{}; return; }
    const char* kb[4];
#pragma unroll
    for (int dd = 0; dd < 4; ++dd) kb[dd] = K_lds + KB * SHM_K + KSWZ(r32, (dd * 16 + hi * 8) * 2);
#pragma unroll
    for (int d0 = 0; d0 < 8; ++d0) { const char* a = kb[d0 & 3] + (d0 >> 2) * 128;
        bf16x8 b0 = *reinterpret_cast<const bf16x8*>(a);
        bf16x8 b1 = *reinterpret_cast<const bf16x8*>(a + 32 * 256);
        if (d0 == 0) { p0 = __builtin_amdgcn_mfma_f32_32x32x16_bf16(b0, qr[0], kc, 0, 0, 0); p1 = __builtin_amdgcn_mfma_f32_32x32x16_bf16(b1, qr[0], kc, 0, 0, 0); }
        else { p0 = __builtin_amdgcn_mfma_f32_32x32x16_bf16(b0, qr[d0], p0, 0, 0, 0); p1 = __builtin_amdgcn_mfma_f32_32x32x16_bf16(b1, qr[d0], p1, 0, 0, 0); } }
}
template <int VB>
__device__ __forceinline__ void pv_tile(f32x16* o, int vb0, bf16x8 pa0, bf16x8 pa1, bf16x8 pa2, bf16x8 pa3, bool act) {
    if (!act) return;
#define TRRD(dst, off) asm volatile("ds_read_b64_tr_b16 %0, %1 offset:%2" : "=&v"(dst) : "v"(vb0), "i"(off) : "memory")
#define PV_D0(d0) do { s16x4 l0, l1, l2, l3, h0, h1, h2, h3; constexpr int b_ = VB * SHM_V + v_rd_off(d0, 0, 0); \
        TRRD(l0, b_); TRRD(h0, b_ + 2048); TRRD(l1, b_ + 4096); TRRD(h1, b_ + 6144); TRRD(l2, b_ + 8192); TRRD(h2, b_ + 10240); TRRD(l3, b_ + 12288); TRRD(h3, b_ + 14336); \
        asm volatile("s_waitcnt lgkmcnt(0)" ::: "memory"); SBAR();   \
        o[d0] = __builtin_amdgcn_mfma_f32_32x32x16_bf16(pa0, (bf16x8){l0[0], l0[1], l0[2], l0[3], h0[0], h0[1], h0[2], h0[3]}, o[d0], 0, 0, 0);   \
        o[d0] = __builtin_amdgcn_mfma_f32_32x32x16_bf16(pa1, (bf16x8){l1[0], l1[1], l1[2], l1[3], h1[0], h1[1], h1[2], h1[3]}, o[d0], 0, 0, 0);   \
        o[d0] = __builtin_amdgcn_mfma_f32_32x32x16_bf16(pa2, (bf16x8){l2[0], l2[1], l2[2], l2[3], h2[0], h2[1], h2[2], h2[3]}, o[d0], 0, 0, 0);   \
        o[d0] = __builtin_amdgcn_mfma_f32_32x32x16_bf16(pa3, (bf16x8){l3[0], l3[1], l3[2], l3[3], h3[0], h3[1], h3[2], h3[3]}, o[d0], 0, 0, 0); } while (0)
    PV_D0(0); PV_D0(1); PV_D0(2); PV_D0(3);
#undef PV_D0
#undef TRRD
}

struct BlockRef { int grp, b, h, qb; };
__device__ __forceinline__ size_t hm_off(const BlockRef& r) { return ((size_t)(r.b * NH + r.h) * SEQ) * D; }
__device__ __forceinline__ const bf16_t* ptrQ(unsigned char* wsb, const BlockRef& r) { return (const bf16_t*)(wsb + (r.grp ? WS_QB : WS_QA)) + hm_off(r) + (size_t)r.qb * QB * D; }
__device__ __forceinline__ const bf16_t* ptrK(unsigned char* wsb, const BlockRef& r) { return (const bf16_t*)(wsb + (r.grp ? WS_KB : WS_KA)) + hm_off(r); }
__device__ __forceinline__ const bf16_t* ptrV(unsigned char* wsb, const BlockRef& r) { return (const bf16_t*)(wsb + (r.grp ? WS_VB : WS_VA)) + hm_off(r); }
__device__ __forceinline__ const bf16_t* ptrZ(unsigned char* wsb, const BlockRef& r) { return (const bf16_t*)(wsb + (r.grp ? WS_SZB : WS_SZA)) + hm_off(r) + (size_t)r.qb * QB * D; }
struct Seam { bf16x8 qr[8]; bf16x8 st_v0, st_v1, st_k0, st_k1; f32x4 km4; };
#define ROW(p, k0, rr) ((const bf16_t*)((const char*)(p) + (unsigned)(((k0) + (rr)) * (D * 2) + sc * 2)))
#define VMW() asm volatile("s_waitcnt vmcnt(0)" ::: "memory")
#define VMWN(n) asm volatile("s_waitcnt vmcnt(%0)" :: "i"(n) : "memory")
#define SLOAD_H(Kp, Vp, k0) do { S.st_v0 = load8(ROW(Vp, k0, sr)); S.st_v1 = load8(ROW(Vp, k0, 32 + sr));              \
                         S.st_k0 = load8(ROW(Kp, k0, sr)); S.st_k1 = load8(ROW(Kp, k0, 32 + sr)); } while (0)
#define SWRITE_HK(bf) do { *(bf16x8*)(K_lds + (bf) * SHM_K + kws) = S.st_k0; *(bf16x8*)(K_lds + (bf) * SHM_K + kws + 32 * 256) = S.st_k1; } while (0)
#define SWRITE_HV(bf) do { *(bf16x8*)(V_lds + (bf) * SHM_V + vst0) = S.st_v0; *(bf16x8*)(V_lds + (bf) * SHM_V + vst1) = S.st_v1; } while (0)
#define SWRITE_H(bf) do { SWRITE_HV(bf); SWRITE_HK(bf); } while (0)
__device__ __forceinline__ void prime_issue(const BlockRef& cur, unsigned char* wsb, Seam& S) {
    int tid = threadIdx.x; asm volatile("" : "+v"(tid));
    const int wid = __builtin_amdgcn_readfirstlane(tid >> 6), lane = tid & 63, r32 = lane & 31, hi = lane >> 5;
    const int sr = tid >> 4, sc = (tid & 15) * 8;
    const bf16_t* Qp = ptrQ(wsb, cur); const bf16_t* Kp = ptrK(wsb, cur); const bf16_t* Vp = ptrV(wsb, cur);
    for (int d0 = 0; d0 < 8; ++d0) S.qr[d0] = load8(Qp + (size_t)(wid * QBLK + r32) * D + d0 * 16 + hi * 8);
    SLOAD_H(Kp, Vp, (4 * cur.qb + 3) * KVBLK);
    if (cur.grp == 1 && tid < cur.qb * 32) { const float* KM = (const float*)(wsb + WS_KMEAN) + ((size_t)(cur.b * NBLK) * NH + cur.h) * 128; S.km4 = *(const f32x4*)(KM + (size_t)(tid >> 5) * (NH * 128) + (tid & 31) * 4); }
}
__device__ __forceinline__ void prime_finish(const BlockRef& cur, unsigned char* wsb, char* lds, Seam& S) {
    int tid = threadIdx.x; asm volatile("" : "+v"(tid));
    const int sr = tid >> 4, sc = (tid & 15) * 8, kws = KSWZ(sr, sc * 2), vst0 = v_st(sr, sc), vst1 = v_st(32 + sr, sc); char* V_lds = lds; char* K_lds = lds + 2 * SHM_V;
    VMW(); SWRITE_H(0);
    if (cur.grp == 1 && tid < cur.qb * 32) *(f32x4*)((float*)(lds + LDS_KM) + (tid >> 5) * 128 + (tid & 31) * 4) = S.km4;
    { const bf16_t* Kp = ptrK(wsb, cur); const bf16_t* Vp = ptrV(wsb, cur); SLOAD_H(Kp, Vp, (4 * cur.qb + 2) * KVBLK); }
    __syncthreads();
}
__device__ __forceinline__ void block(const BlockRef& cur, unsigned char* wsb, char* lds, Seam& S, float Bq, bool& has_next, BlockRef& nxt, unsigned* qh, unsigned tlimit, const unsigned char* sorted) {
    const int GRP = cur.grp;
    int tid = threadIdx.x; asm volatile("" : "+v"(tid));
    const int wid = __builtin_amdgcn_readfirstlane(tid >> 6), lane = tid & 63, r32 = lane & 31, hi = lane >> 5;
    const int NT = 4 * cur.qb + 4;
    const int qlo = cur.qb * QB + wid * QBLK, qm = qlo + r32 - 4 * hi;
    char* V_lds = lds; char* K_lds = lds + 2 * SHM_V;
    float* ws = (float*)(lds + LDS_WS) + wid * 64; float* li_l = ws, * al_l = ws + 32;
    float m_reg = -1e30f, l_reg = 0; f32x16 o[4] = {};
    const int sr = tid >> 4, sc = (tid & 15) * 8, vst0 = v_st(sr, sc), vst1 = v_st(32 + sr, sc), kws = KSWZ(sr, sc * 2);
    const int vb0 = (int)(uintptr_t)V_lds + v_rd_base(lane);
    const bf16_t* Kh = ptrK(wsb, cur); const bf16_t* Vh = ptrV(wsb, cur);
    const float sl = exp2f(-(float)(cur.h + 1)) * 11.313708498984761f;
    f32x16 kc;
#pragma unroll
    for (int r = 0; r < 16; ++r) kc[r] = sl * (float)((r & 3) + 8 * (r >> 2));
    unsigned selbits = 0xffu;
    if (GRP == 1) {
        float* km = (float*)(lds + LDS_KM);
        float v1 = -__builtin_inff(), v2 = v1, v3 = v1; int i1 = 31, i2 = 31, i3 = 31;
#pragma unroll 1
        for (int n = 0; n < cur.qb; ++n) { float a = 0.f;
#pragma unroll
            for (int d0 = 0; d0 < 8; ++d0) { const f32x4 k0 = *(const f32x4*)(km + n * 128 + d0 * 16 + hi * 8), k1 = *(const f32x4*)(km + n * 128 + d0 * 16 + hi * 8 + 4);
                const bf16x8 q = S.qr[d0];
                a += bf2f((bf16_t)q[0]) * k0[0] + bf2f((bf16_t)q[1]) * k0[1] + bf2f((bf16_t)q[2]) * k0[2] + bf2f((bf16_t)q[3]) * k0[3]
                   + bf2f((bf16_t)q[4]) * k1[0] + bf2f((bf16_t)q[5]) * k1[1] + bf2f((bf16_t)q[6]) * k1[2] + bf2f((bf16_t)q[7]) * k1[3]; }
            const float other = __shfl_xor(a, 32); const float g = a + other;
            const bool c1 = g > v1, c2 = g > v2, c3 = g > v3;
            v3 = c2 ? v2 : (c3 ? g : v3); i3 = c2 ? i2 : (c3 ? n : i3);
            v2 = c1 ? v1 : (c2 ? g : v2); i2 = c1 ? i1 : (c2 ? n : i2);
            v1 = c1 ? g : v1;             i1 = c1 ? n : i1; }
        selbits = ((1u << i1) | (1u << i2) | (1u << i3)) & 0xffu;
    }
    const char* mst = lds + LDS_OST + wid * MST_WAVE + r32 * MST_PITCH;
    u32x4 tmp[8];
    if (GRP == 0) {
        const char* src = (const char*)(wsb + WS_MASK) + ((size_t)cur.b * SEQ + qlo) * 256 + (unsigned)(r32 * 256 + hi * 128);
#pragma unroll
        for (int i = 0; i < 8; ++i) tmp[i] = *(const u32x4*)(src + 16 * i);
    }
#define RESC(a) do { if (__any((a) < 1.f)) { if (hi == 0) al_l[r32] = (a); asm volatile("s_waitcnt lgkmcnt(0)" ::: "memory");              \
                     for (int d_ = 0; d_ < 4; ++d_) for (int r = 0; r < 16; ++r) o[d_][r] *= al_l[crow(r, hi)]; } } while (0)
#define TIX(u) (NT - 1 - (u))
#define KBASE(u) (TIX(u) * KVBLK)
#define CB(u) ((GRP == 1 && TIX(u) < 4 * cur.qb && !((selbits >> (TIX(u) >> 2)) & 1u)) ? -__builtin_inff() : sl * (float)(KBASE(u) - qm))
#define MLOAD(u) ((GRP == 0) ? *(const unsigned long long*)(mst + TIX(u) * 8) : 0ull)
    constexpr float C2_ = 1.4426950408889634f * SCALE;
#define ACT(u) (!((qlo - KBASE(u) - (KVBLK - 1)) > 0 && __all((Bq - sl * (float)(qlo - KBASE(u) - (KVBLK - 1)) - m_reg) * C2_ < -40.f)))
#define MASKT(P0_, P1_, t, mw) do { const int kb_ = KBASE(t); \
        if (GRP == 0) { mask_bits(P0_, P1_, ((unsigned)(mw)) >> (4 * hi), ((unsigned)((mw) >> 32)) >> (4 * hi)); } \
        else if (kb_ + KVBLK - 1 > qlo) mask_causal(P0_, P1_, qm - kb_); } while (0)
    f32x16 pA0, pA1, pB0, pB1; float mnA, mnB, alA = 1.f, alB = 1.f;
    unsigned long long mwA, mwB; bool actA = true, actB = true;
    volatile unsigned* vote = (volatile unsigned*)(lds + LDS_KM + 4096 + 64);
    SBAR(); qkt<0>(pA0, pA1, K_lds, r32, hi, S.qr, kc, true);
    if (GRP == 0) {
#pragma unroll
        for (int i = 0; i < 8; ++i) { unsigned long long* d = (unsigned long long*)(mst + hi * 128 + 16 * i);
            d[0] = (unsigned long long)tmp[i][0] | ((unsigned long long)tmp[i][1] << 32); d[1] = (unsigned long long)tmp[i][2] | ((unsigned long long)tmp[i][3] << 32); }
        asm volatile("s_waitcnt lgkmcnt(0)" ::: "memory");
    }
    mwA = MLOAD(0);
    MASKT(pA0, pA1, 0, mwA); { const float cb_ = CB(0); partialSM(pA0, pA1, m_reg, mnA, alA, cb_, cb_ + 32.f * sl); }
    if (NT > 1) { VMW(); SWRITE_H(1); }
    __syncthreads();
#define HALF_STEP(PX0, PX1, mnX, alX, mwX, actX, PY0, PY1, alY, actY, t, KB, VB, SB) do {                                     \
        actX = ACT(t);                                                                                                        \
        SBAR(); qkt<KB>(PX0, PX1, K_lds, r32, hi, S.qr, kc, actX); SBAR();                                             \
        if ((t) + 1 < NT) { SLOAD_H(Kh, Vh, KBASE((t) + 1)); SBAR(); }                                                        \
        mwX = MLOAD(t);                                                                                                       \
        if (actY) { bf16x8 pa0, pa1, pa2, pa3; finishSM(PY0, PY1, alY, l_reg, pa0, pa1, pa2, pa3); SBAR(); pv_tile<VB>(o, vb0, pa0, pa1, pa2, pa3, true); } \
        alX = 1.f; if (actX) { MASKT(PX0, PX1, (t), mwX); const float cb_ = CB(t); partialSM(PX0, PX1, m_reg, mnX, alX, cb_, cb_ + 32.f * sl); }                             \
        __syncthreads();                                                                                                      \
        if ((t) + 1 < NT) { VMW(); SWRITE_H(SB); }                                                                            \
        RESC(alX); } while (0)
    for (int t = 1; t + 1 < NT; t += 2) {
        HALF_STEP(pB0, pB1, mnB, alB, mwB, actB, pA0, pA1, alA, actA, t, 1, 0, 0); __syncthreads();
        HALF_STEP(pA0, pA1, mnA, alA, mwA, actA, pB0, pB1, alB, actB, t + 1, 0, 1, 1);
        if (lane == 0 && actA) vote[(t >> 1) & 1] = 1u;
        __syncthreads();
        const unsigned any_ = vote[(t >> 1) & 1];
        if (tid == 0) vote[((t >> 1) & 1) ^ 1] = 0u;
        if (!any_) break;
    }
    unsigned tk_ = 0u; if (qh && tid == 0) tk_ = __hip_atomic_fetch_add(qh, 1u, __ATOMIC_RELAXED, __HIP_MEMORY_SCOPE_AGENT);
    actB = ACT(NT - 1); SBAR(); qkt<1>(pB0, pB1, K_lds, r32, hi, S.qr, kc, actB); SBAR(); mwB = MLOAD(NT - 1);
    if (!qh && has_next) prime_issue(nxt, wsb, S);
    if (actA) { bf16x8 pa0, pa1, pa2, pa3; finishSM(pA0, pA1, alA, l_reg, pa0, pa1, pa2, pa3); SBAR(); pv_tile<0>(o, vb0, pa0, pa1, pa2, pa3, true); }
    alB = 1.f; if (actB) { MASKT(pB0, pB1, NT - 1, mwB); const float cb_ = CB(NT - 1); partialSM(pB0, pB1, m_reg, mnB, alB, cb_, cb_ + 32.f * sl); }
    volatile unsigned* qs_ = (volatile unsigned*)(lds + LDS_KM + 4096 + 96);
    if (qh && tid == 0) qs_[0] = tk_;
    __syncthreads();
    if (qh) { const unsigned tn = __builtin_amdgcn_readfirstlane(qs_[0]); has_next = tn < tlimit; const int e = sorted[tn < 128u ? tn : 127u]; nxt.h = e >> 4; nxt.qb = (e >> 1) & 7; nxt.grp = e & 1; nxt.b = cur.b;
        if (has_next) prime_issue(nxt, wsb, S); }
    RESC(alB);
    if (actB) { bf16x8 pa0, pa1, pa2, pa3; finishSM(pB0, pB1, alB, l_reg, pa0, pa1, pa2, pa3); SBAR(); pv_tile<1>(o, vb0, pa0, pa1, pa2, pa3, true); }
    u32x4 zvr[8];
    { int lane_z = lane; asm volatile("" : "+v"(lane_z));
      const char* Zw_ = (const char*)(ptrZ(wsb, cur) + (size_t)(wid * QBLK) * D) + (unsigned)(lane_z * 16);
#pragma unroll
      for (int i = 0; i < 8; ++i) zvr[i] = *(const u32x4*)(Zw_ + (unsigned)(i * 1024)); }
    if (hi == 0) li_l[r32] = l_reg; asm volatile("s_waitcnt lgkmcnt(0)" ::: "memory");
    float rli[16];
#pragma unroll
    for (int r = 0; r < 16; ++r) rli[r] = __builtin_amdgcn_rcpf(li_l[crow(r, hi)]);
    { bf16_t* stg = (bf16_t*)(lds + LDS_OST) + wid * (QBLK * D);
      int lane_e = lane; asm volatile("" : "+v"(lane_e));
      bf16_t* stw = stg + (4 * (lane_e >> 5)) * D + (lane_e & 31);
#pragma unroll
      for (int r = 0; r < 16; ++r) { const int orow = (r & 3) + 8 * (r >> 2);
#pragma unroll
          for (int d0 = 0; d0 < 4; ++d0) stw[orow * D + d0 * 32] = (bf16_t)cvt1(o[d0][r] * rli[r]); }
      asm volatile("s_waitcnt lgkmcnt(0)" ::: "memory");
      char* Ow = (char*)(wsb + WS_Y8) + ((size_t)cur.b * SEQ + qlo) * 2048 + cur.grp * 1024 + cur.h * 128;
      const unsigned eo = (unsigned)((lane_e >> 4) * 256 + (lane_e & 15) * 16), yo = (unsigned)((lane_e >> 4) * 2048 + (lane_e & 15) * 8);
#pragma unroll
      for (int i = 0; i < 8; ++i) {
          const u32x4 ov = *(const u32x4*)((const char*)stg + (eo + (unsigned)(i * 1024))), zv = zvr[i]; float f[8];
#pragma unroll
          for (int j = 0; j < 4; ++j) { f[2 * j] = __uint_as_float(ov[j] << 16) * __uint_as_float(zv[j] << 16) * 8.f; f[2 * j + 1] = __uint_as_float(ov[j] & 0xffff0000u) * __uint_as_float(zv[j] & 0xffff0000u) * 8.f; }
          const unsigned long long w = (unsigned long long)pk4_fp8(f[0], f[1], f[2], f[3]) | ((unsigned long long)pk4_fp8(f[4], f[5], f[6], f[7]) << 32);
          *(unsigned long long*)(Ow + (yo + (unsigned)(i * 8192))) = w; } }
    __syncthreads();
#undef RESC
#undef TIX
#undef ACT
#undef KBASE
#undef CB
#undef MLOAD
#undef MASKT
#undef HALF_STEP
}
#undef ROW
#undef VMW
#undef VMWN
#undef SLOAD_H
#undef SWRITE_HK
#undef SWRITE_HV
#undef SWRITE_H
struct ClassOrder { unsigned char v[64]; };
constexpr int class_cost(int c) { const int h = c >> 3, qb = c & 7, full = 4 * qb + 4, cap = h == 0 ? 10 : h == 1 ? 14 : h == 2 ? 22 : 32; return full < cap ? full : cap; }
constexpr ClassOrder make_order() { ClassOrder o{}; for (int i = 0; i < 64; ++i) o.v[i] = (unsigned char)i;
    for (int i = 1; i < 64; ++i) { const unsigned char x = o.v[i]; int j = i - 1; while (j >= 0 && class_cost(o.v[j]) < class_cost(x)) { o.v[j + 1] = o.v[j]; --j; } o.v[j + 1] = x; }
    return o; }
#ifndef PLAN_LEAD_A
#define PLAN_LEAD_A 65
#endif
#ifndef PLAN_LEAD_C
#define PLAN_LEAD_C 44
#endif
struct XcdPlan { unsigned char n[32]; unsigned char e[32][8]; unsigned char ord[32]; unsigned char sorted[128]; };
constexpr int block_cost(int h, int qb, int g) { const int full = (4 * qb + 4) * (g ? 103 : 100) / 10, cap = g ? (h == 0 ? 60 : h == 1 ? 75 : h == 2 ? 95 : h == 3 ? 145 : h == 4 ? 230 : 330) : (h == 0 ? 65 : h == 1 ? 80 : h == 2 ? 100 : h == 3 ? 150 : h == 4 ? 235 : 320);
    return 36 + (full < cap ? full : cap); }
constexpr XcdPlan make_plan() { XcdPlan P{}; int item[128] = {}, cost[128] = {};
    for (int k = 0; k < 128; ++k) { item[k] = k; cost[k] = block_cost(k >> 4, (k >> 1) & 7, k & 1); }
    for (int i = 1; i < 128; ++i) { const int it = item[i], c = cost[i]; int j = i - 1; while (j >= 0 && cost[j] < c) { item[j + 1] = item[j]; cost[j + 1] = cost[j]; --j; } item[j + 1] = it; cost[j + 1] = c; }
    for (int k = 0; k < 128; ++k) P.sorted[k] = (unsigned char)item[k];
    int load[32] = {};
    for (int j = 0; j < 32; ++j) load[j] = j < 16 ? PLAN_LEAD_A : j < 24 ? 0 : PLAN_LEAD_C;
    for (int k = 0; k < 128; ++k) { int best = 0; for (int j = 1; j < 32; ++j) if (load[j] < load[best]) best = j;
        P.e[best][P.n[best]++] = (unsigned char)item[k]; load[best] += cost[k]; }
    for (int j = 0; j < 32; ++j) { int r = 0; for (int k = 0; k < 32; ++k) r += (load[k] < load[j] || (load[k] == load[j] && k < j)) ? 1 : 0; P.ord[j] = (unsigned char)r; }
    return P; }
__device__ __forceinline__ void decode(int p, BlockRef& r) { constexpr ClassOrder ORD = make_order(); const int c = ORD.v[p >> 4], m = p & 15; r.h = c >> 3; r.qb = c & 7; r.grp = m >> 3; r.b = m & 7; }
__device__ __forceinline__ void attn_phase(char* lds, unsigned char* wsb, int v, int G, unsigned* pcnt, unsigned* mcnt, unsigned* bw, unsigned* qh) {
    const int tid = threadIdx.x, lane = tid & 63;
    float BqG[2];
    { const float* G_ = (const float*)(wsb + WS_GAIN);
#pragma unroll
      for (int gsel = 0; gsel < 2; ++gsel) { const float* gq = G_ + gsel * 256; const float* gk = gq + 128;
          float mq = fmaxf(fabsf(gq[lane]), fabsf(gq[lane + 64])), mk = fmaxf(fabsf(gk[lane]), fabsf(gk[lane + 64]));
          mq = wave_max(mq); mk = wave_max(mk); BqG[gsel] = __uint_as_float(__builtin_amdgcn_readfirstlane(__float_as_uint(128.f * 1.02f * mq * mk))); } }
    if (tid == 0) { ((volatile unsigned*)(lds + LDS_KM + 4096 + 64))[0] = 0u; ((volatile unsigned*)(lds + LDS_KM + 4096 + 64))[1] = 0u; }
    Seam S;
    constexpr XcdPlan PLAN = make_plan();
    const int nr = (G == 256) ? PLAN.n[v & 31] : (1024 + G - 1) / G;
    auto get = [&](int r, BlockRef& br) -> bool {
        if (r >= nr) return false;
        if (G == 256) { const int e = PLAN.e[v & 31][r]; br.h = e >> 4; br.qb = (e >> 1) & 7; br.grp = e & 1; br.b = v >> 5; return true; }
        const int p = r * G + ((r & 1) ? G - 1 - v : v); if (p >= 1024) return false; decode(p, br); return true; };
    BlockRef cur, nxt;
    volatile unsigned* qslot = (volatile unsigned*)(lds + LDS_KM + 4096 + 96);
    auto item = [&](unsigned tk, BlockRef& br) { const int e = PLAN.sorted[tk < 128u ? tk : 127u]; br.h = e >> 4; br.qb = (e >> 1) & 7; br.grp = e & 1; br.b = v >> 5; };
    if (qh) {
        if (tid == 0) qslot[0] = __hip_atomic_fetch_add(qh, 1u, __ATOMIC_RELAXED, __HIP_MEMORY_SCOPE_AGENT);
        __syncthreads();
        const unsigned t0 = __builtin_amdgcn_readfirstlane(qslot[0]); if (t0 >= 128u) return;
        item(t0, cur);
    } else if (!get(0, cur)) return;
    prime_issue(cur, wsb, S);
    for (int r = 0;; ++r) {
        bool more = false;
        if (!qh) more = get(r + 1, nxt);
        if (mcnt && cur.grp == 0) cnt_wait(mcnt + cur.qb, 16u, bw);
        prime_finish(cur, wsb, lds, S);
        block(cur, wsb, lds, S, cur.grp ? BqG[1] : BqG[0], more, nxt, qh, 128u, PLAN.sorted);
        if (pcnt) { asm volatile("s_waitcnt vmcnt(0)" ::: "memory"); __syncthreads();
            if (tid == 0) (void)__hip_atomic_fetch_add(pcnt + cur.qb, 1u, __ATOMIC_RELAXED, __HIP_MEMORY_SCOPE_AGENT); }
        if (!more) break;
        cur = nxt;
    }
}
#undef KSWZ
#undef SBAR
}

namespace sel {
#define SLAS __attribute__((address_space(3)))
typedef short bf16x8 __attribute__((ext_vector_type(8)));
typedef float f32x16 __attribute__((ext_vector_type(16)));
typedef float f32x4 __attribute__((ext_vector_type(4)));
typedef unsigned u32x4 __attribute__((ext_vector_type(4)));
constexpr int KB_OFF = 131072;
constexpr int LIST_OFF = 147456 + 2048;
__device__ __forceinline__ float relu1(float x) { return __int_as_float(max(__float_as_int(x), 0)); }
__device__ __forceinline__ unsigned fkey(float x) { const unsigned b = __float_as_uint(x); return (b & 0x80000000u) ? ~b : (b | 0x80000000u); }
struct UnitIn { bf16x8 af[4]; f32x4 w4[4]; u32x4 k0; };
__device__ __forceinline__ void unit_load(unsigned char* wsb, int b, int rg, UnitIn& u) {
    const int tid = threadIdx.x, wid = __builtin_amdgcn_readfirstlane(tid >> 6), lane = tid & 63, g = lane >> 5;
    const int ta = 16 * rg + 2 * wid, t = ta + g, i = lane & 31, tok = (i >> 2) & 1, head = (i & 3) + 4 * (i >> 3);
    const bf16_t* qp = (const bf16_t*)(wsb + WS_QI) + ((size_t)b * SEQ + ta + tok) * 1024 + head * 64 + 8 * (lane >> 5);
#pragma unroll
    for (int ks = 0; ks < 4; ++ks) u.af[ks] = *(const bf16x8*)(qp + 16 * ks);
    const float* wp = (const float*)(wsb + WS_WI) + ((size_t)b * SEQ + t) * 16;
#pragma unroll
    for (int q4 = 0; q4 < 4; ++q4) u.w4[q4] = *(const f32x4*)(wp + 4 * q4);
    u.k0 = *(const u32x4*)((const char*)((const bf16_t*)(wsb + WS_KI) + (size_t)b * SEQ * 64) + (unsigned)(tid * 16));
}
__device__ __forceinline__ void unit(SLAS unsigned char* lds, unsigned char* wsb, int b, int rg, const UnitIn& in, bool has_next, int nb, int nrg, UnitIn& nxt) {
    const int tid = threadIdx.x, wid = __builtin_amdgcn_readfirstlane(tid >> 6), lane = tid & 63, j = lane & 31, g = lane >> 5;
    const char* KIb = (const char*)((const bf16_t*)(wsb + WS_KI) + (size_t)b * SEQ * 64);
    unsigned long long* MASK = (unsigned long long*)(wsb + WS_MASK);
    const int ta = 16 * rg + 2 * wid, t = ta + g;
    const int nkeys = 16 * rg + 16, nk32 = (nkeys + 31) >> 5, nch = (nkeys + 63) >> 6;
    SLAS float* sc = (SLAS float*)lds + (wid * 2 + g) * 2048 + j;
    float vmin = __builtin_inff(), vmax = -__builtin_inff();
    bf16x8 af[4];
#pragma unroll
    for (int ks = 0; ks < 4; ++ks) af[ks] = in.af[ks];
    float wv[16];
#pragma unroll
    for (int q4 = 0; q4 < 4; ++q4) { wv[4 * q4] = in.w4[q4][0] * 0.03125f; wv[4 * q4 + 1] = in.w4[q4][1] * 0.03125f; wv[4 * q4 + 2] = in.w4[q4][2] * 0.03125f; wv[4 * q4 + 3] = in.w4[q4][3] * 0.03125f; }
    const int srow = tid >> 3, scol = tid & 7, swr = srow * 128 + ((scol ^ ((srow >> 1) & 7)) << 4);
    int koff[4];
#pragma unroll
    for (int ks = 0; ks < 4; ++ks) koff[ks] = j * 128 + (((2 * ks + g) ^ ((j >> 1) & 7)) << 4);
    u32x4 stA = in.k0, stB, stC, stD;
    *(SLAS u32x4*)(lds + KB_OFF + swr) = stA;
    stB = *(const u32x4*)(KIb + (unsigned)(min(1, nch - 1) * 8192 + tid * 16));
    stC = *(const u32x4*)(KIb + (unsigned)(min(2, nch - 1) * 8192 + tid * 16));
    stD = *(const u32x4*)(KIb + (unsigned)(min(3, nch - 1) * 8192 + tid * 16));
    stA = *(const u32x4*)(KIb + (unsigned)(min(4, nch - 1) * 8192 + tid * 16));
    __syncthreads();
#define SEL_EPI(ACC, kt) do { float s0 = 0.f, s1 = 0.f, s2 = 0.f, s3 = 0.f; \
        _Pragma("unroll") for (int r = 0; r < 4; ++r) { s0 = fmaf(wv[r], relu1(ACC[r]), s0); s1 = fmaf(wv[4 + r], relu1(ACC[4 + r]), s1); \
                                                       s2 = fmaf(wv[8 + r], relu1(ACC[8 + r]), s2); s3 = fmaf(wv[12 + r], relu1(ACC[12 + r]), s3); } \
        const float s = (s0 + s1) + (s2 + s3); \
        { const bool c_ = 32 * (kt) + j <= t; vmin = (c_ && s < vmin) ? s : vmin; vmax = (c_ && s > vmax) ? s : vmax; }     \
        sc[32 * (kt)] = s; } while (0)
#define SEL_TILES(cc) do { SLAS unsigned char* kb = lds + KB_OFF + ((cc) & 1) * 8192; const int kt0 = 2 * (cc); \
        if (kt0 + 1 < nk32) {                                  \
            f32x16 acc0 = {}, acc1 = {}; \
            _Pragma("unroll") for (int ks = 0; ks < 4; ++ks) { const bf16x8 b0 = *(const SLAS bf16x8*)(kb + koff[ks]), b1 = *(const SLAS bf16x8*)(kb + 4096 + koff[ks]); \
                acc0 = __builtin_amdgcn_mfma_f32_32x32x16_bf16(af[ks], b0, acc0, 0, 0, 0); acc1 = __builtin_amdgcn_mfma_f32_32x32x16_bf16(af[ks], b1, acc1, 0, 0, 0); } \
            SEL_EPI(acc0, kt0); SEL_EPI(acc1, kt0 + 1); \
        } else if (kt0 < nk32) { f32x16 acc0 = {}; \
            _Pragma("unroll") for (int ks = 0; ks < 4; ++ks) { const bf16x8 b0 = *(const SLAS bf16x8*)(kb + koff[ks]); acc0 = __builtin_amdgcn_mfma_f32_32x32x16_bf16(af[ks], b0, acc0, 0, 0, 0); } \
            SEL_EPI(acc0, kt0); } } while (0)
#pragma unroll 1
    for (int c = 0; c < nch; c += 4) {
        SEL_TILES(c);
        *(SLAS u32x4*)(lds + KB_OFF + 8192 + swr) = stB; stB = *(const u32x4*)(KIb + (unsigned)(min(c + 5, nch - 1) * 8192 + tid * 16));
        __syncthreads();
        SEL_TILES(c + 1);
        *(SLAS u32x4*)(lds + KB_OFF + swr) = stC; stC = *(const u32x4*)(KIb + (unsigned)(min(c + 6, nch - 1) * 8192 + tid * 16));
        __syncthreads();
        SEL_TILES(c + 2);
        *(SLAS u32x4*)(lds + KB_OFF + 8192 + swr) = stD; stD = *(const u32x4*)(KIb + (unsigned)(min(c + 7, nch - 1) * 8192 + tid * 16));
        __syncthreads();
        SEL_TILES(c + 3);
        *(SLAS u32x4*)(lds + KB_OFF + swr) = stA; stA = *(const u32x4*)(KIb + (unsigned)(min(c + 8, nch - 1) * 8192 + tid * 16));
        __syncthreads();
    }
#undef SEL_TILES
#undef SEL_EPI
    if (has_next) unit_load(wsb, nb, nrg, nxt);
    unsigned T = 0u; int need = 0; bool ties = false;
    if (16 * rg >= TOPK) {
        SLAS unsigned* hist = (SLAS unsigned*)(lds + KB_OFF) + (wid * 2 + g) * 256;
#pragma unroll
        for (int off = 1; off < 32; off <<= 1) { vmin = fminf(vmin, __shfl_xor(vmin, off)); vmax = fmaxf(vmax, __shfl_xor(vmax, off)); }
        const float range = vmax - vmin, inv = (range > 0.f) ? 255.99f / range : 0.f;
        *(SLAS u32x4*)(hist + 8 * j) = (u32x4){0u, 0u, 0u, 0u}; *(SLAS u32x4*)(hist + 8 * j + 4) = (u32x4){0u, 0u, 0u, 0u};
#pragma unroll 1
        for (int kt0 = 0; kt0 < nk32; kt0 += 4) { float x[4];
#pragma unroll
            for (int i = 0; i < 4; ++i) x[i] = sc[32 * (kt0 + i)];
#pragma unroll
            for (int i = 0; i < 4; ++i) if (32 * (kt0 + i) + j <= t) { const int q = min((int)((x[i] - vmin) * inv), 255); __hip_atomic_fetch_add(hist + q, 1u, __ATOMIC_RELAXED, __HIP_MEMORY_SCOPE_WORKGROUP); } }
        asm volatile("s_waitcnt lgkmcnt(0)" ::: "memory");
        int qsel, cB;
        { const u32x4 c0 = *(const SLAS u32x4*)(hist + 8 * j), c1 = *(const SLAS u32x4*)(hist + 8 * j + 4);
          const int cnt[8] = {(int)c0[0], (int)c0[1], (int)c0[2], (int)c0[3], (int)c1[0], (int)c1[1], (int)c1[2], (int)c1[3]};
          const int s = ((cnt[0] + cnt[1]) + (cnt[2] + cnt[3])) + ((cnt[4] + cnt[5]) + (cnt[6] + cnt[7]));
          int S = s;
#pragma unroll
          for (int off = 1; off < 32; off <<= 1) { const int v = __shfl_down(S, off, 32); if (j + off < 32) S += v; }
          const int above = S - s;
          const bool found = (S >= TOPK) && (above < TOPK);
          int dsel = 0, nneed = 0, csel = 0;
          { const int rem = TOPK - above; int cum = 0; bool done = false;
#pragma unroll
            for (int i = 7; i >= 0; --i) { const int before = cum; cum += cnt[i]; if (!done && cum >= rem) { done = true; dsel = 8 * j + i; nneed = rem - before; csel = cnt[i]; } } }
          const unsigned long long bm = __ballot(found);
          const int src = 32 * g + __builtin_ctz((unsigned)(bm >> (32 * g)) | 0x80000000u);
          qsel = __shfl(dsel, src); need = __shfl(nneed, src); cB = __shfl(csel, src); }
        if (!__any(cB > 64)) {
            SLAS unsigned* list = (SLAS unsigned*)(lds + LIST_OFF) + (wid * 2 + g) * 128;
            int base = 0;
#pragma unroll 1
            for (int kt0 = 0; kt0 < nk32; kt0 += 4) { float x[4];
#pragma unroll
                for (int i = 0; i < 4; ++i) x[i] = sc[32 * (kt0 + i)];
#pragma unroll
                for (int i = 0; i < 4; ++i) { const int kt = kt0 + i;
                    const bool m = (32 * kt + j <= t) && (min((int)((x[i] - vmin) * inv), 255) == qsel);
                    const unsigned long long bal = __ballot(m); const unsigned hm = g ? (unsigned)(bal >> 32) : (unsigned)bal;
                    if (m) { const int pos = base + __builtin_popcount(hm & ((1u << j) - 1u)); list[2 * pos] = fkey(x[i]); list[2 * pos + 1] = (unsigned)(32 * kt + j); }
                    base += __builtin_popcount(hm); } }
            asm volatile("s_waitcnt lgkmcnt(0)" ::: "memory");
            const unsigned u0 = list[2 * j], i0 = list[2 * j + 1], u1 = list[2 * (j + 32)], i1 = list[2 * (j + 32) + 1];
            int r0 = 0, r1 = 0; const int cmax = max(cB, __shfl_xor(cB, 32));
#pragma unroll 1
            for (int e4 = 0; e4 < cmax; e4 += 4) {
                unsigned ue[4], ie[4];
#pragma unroll
                for (int q = 0; q < 4; ++q) { ue[q] = list[2 * (e4 + q)]; ie[q] = list[2 * (e4 + q) + 1]; }
#pragma unroll
                for (int q = 0; q < 4; ++q) { const bool in = e4 + q < cB;
                    r0 += (in && (ue[q] > u0 || (ue[q] == u0 && ie[q] < i0))) ? 1 : 0; r1 += (in && (ue[q] > u1 || (ue[q] == u1 && ie[q] < i1))) ? 1 : 0; } }
            const bool h0 = (j < cB) && (r0 == need - 1), h1 = (j + 32 < cB) && (r1 == need - 1);
            const unsigned long long bh = __ballot(h0 || h1);
            const int src = 32 * g + __builtin_ctz((unsigned)(bh >> (32 * g)) | 0x80000000u);
            T = __shfl(h0 ? u0 : u1, src);
            const unsigned long long bg0 = __ballot(j < cB && u0 > T), bg1 = __ballot(j + 32 < cB && u1 > T), be0 = __ballot(j < cB && u0 == T), be1 = __ballot(j + 32 < cB && u1 == T);
            const int ngt = __builtin_popcount(g ? (unsigned)(bg0 >> 32) : (unsigned)bg0) + __builtin_popcount(g ? (unsigned)(bg1 >> 32) : (unsigned)bg1);
            const int neq = __builtin_popcount(g ? (unsigned)(be0 >> 32) : (unsigned)be0) + __builtin_popcount(g ? (unsigned)(be1 >> 32) : (unsigned)be1);
            need = need - ngt; ties = (neq != need);
        } else {
            unsigned prefix = 0u; need = TOPK; int ceq = 0;
#pragma unroll 1
            for (int p = 0; p < 4; ++p) { const int shift = 24 - 8 * p;
                *(SLAS u32x4*)(hist + 8 * j) = (u32x4){0u, 0u, 0u, 0u}; *(SLAS u32x4*)(hist + 8 * j + 4) = (u32x4){0u, 0u, 0u, 0u};
                const unsigned phi = prefix >> ((shift + 8) & 31);
#pragma unroll 1
                for (int kt = 0; kt < nk32; ++kt) { const unsigned x = fkey(sc[32 * kt]);
                    const bool match = (32 * kt + j <= t) && ((p == 0) || ((x >> ((shift + 8) & 31)) == phi));
                    if (match) __hip_atomic_fetch_add(hist + ((x >> shift) & 255u), 1u, __ATOMIC_RELAXED, __HIP_MEMORY_SCOPE_WORKGROUP); }
                asm volatile("s_waitcnt lgkmcnt(0)" ::: "memory");
                const u32x4 c0 = *(const SLAS u32x4*)(hist + 8 * j), c1 = *(const SLAS u32x4*)(hist + 8 * j + 4);
                const int cnt[8] = {(int)c0[0], (int)c0[1], (int)c0[2], (int)c0[3], (int)c1[0], (int)c1[1], (int)c1[2], (int)c1[3]};
                const int s = ((cnt[0] + cnt[1]) + (cnt[2] + cnt[3])) + ((cnt[4] + cnt[5]) + (cnt[6] + cnt[7]));
                int S = s;
#pragma unroll
                for (int off = 1; off < 32; off <<= 1) { const int v = __shfl_down(S, off, 32); if (j + off < 32) S += v; }
                const int above = S - s;
                const bool found = (S >= need) && (above < need);
                int dsel = 0, nneed = 0, csel = 0;
                { const int rem = need - above; int cum = 0; bool done = false;
#pragma unroll
                  for (int i = 7; i >= 0; --i) { const int before = cum; cum += cnt[i]; if (!done && cum >= rem) { done = true; dsel = 8 * j + i; nneed = rem - before; csel = cnt[i]; } } }
                const unsigned long long bm = __ballot(found);
                const int src = 32 * g + __builtin_ctz((unsigned)(bm >> (32 * g)) | 0x80000000u);
                const int digit = __shfl(dsel, src); need = __shfl(nneed, src); ceq = __shfl(csel, src);
                prefix |= (unsigned)digit << shift;
            }
            T = prefix; ties = (ceq != need);
        }
    }
    unsigned wlo = 0u, whi = 0u;
    if (!__any(ties)) {
#pragma unroll 4
        for (int k64 = 0; k64 < nch; ++k64) {
            const bool s0 = (64 * k64 + j <= t) && (fkey(sc[64 * k64]) >= T), s1 = (64 * k64 + 32 + j <= t) && (fkey(sc[64 * k64 + 32]) >= T);
            const unsigned long long b0 = __ballot(s0), b1 = __ballot(s1);
            const unsigned lo = g ? (unsigned)(b0 >> 32) : (unsigned)b0, hi = g ? (unsigned)(b1 >> 32) : (unsigned)b1;
            if (j == k64) { wlo = lo; whi = hi; } }
    } else {
        int base = 0;
#pragma unroll 1
        for (int k64 = 0; k64 < 32; ++k64) { unsigned lo = 0u, hi = 0u;
#pragma unroll
            for (int hh = 0; hh < 2; ++hh) { const bool vld = (64 * k64 + 32 * hh + j <= t); const unsigned x = vld ? fkey(sc[64 * k64 + 32 * hh]) : 0u;
                const unsigned long long be = __ballot(vld && x == T); const unsigned em = g ? (unsigned)(be >> 32) : (unsigned)be;
                const int rank = base + __builtin_popcount(em & ((1u << j) - 1u));
                const bool s1 = vld && ((x > T) || (x == T && rank < need));
                base += __builtin_popcount(em);
                const unsigned long long bs = __ballot(s1); const unsigned sm = g ? (unsigned)(bs >> 32) : (unsigned)bs;
                if (hh == 0) lo = sm; else hi = sm; }
            if (j == k64) { wlo = lo; whi = hi; } }
    }
    MASK[((size_t)b * SEQ + t) * 32 + j] = (unsigned long long)wlo | ((unsigned long long)whi << 32);
    __syncthreads();
}
__device__ __forceinline__ void kmean_unit(SLAS unsigned char* lds, unsigned char* wsb, int b, int n, int h) {
    const int tid = threadIdx.x, d4 = tid & 31, rs = tid >> 5;
    const bf16_t* KB = (const bf16_t*)(wsb + WS_KB) + (((size_t)(b * NH + h) * SEQ) + n * 256) * 128;
    float a0 = 0.f, a1 = 0.f, a2 = 0.f, a3 = 0.f;
#pragma unroll 4
    for (int r = 0; r < 16; ++r) { const unsigned long long v = *(const unsigned long long*)(KB + (size_t)(rs * 16 + r) * 128 + d4 * 4);
        const unsigned lo = (unsigned)v, hi = (unsigned)(v >> 32);
        a0 += __uint_as_float(lo << 16); a1 += __uint_as_float(lo & 0xffff0000u); a2 += __uint_as_float(hi << 16); a3 += __uint_as_float(hi & 0xffff0000u); }
    SLAS float* red = (SLAS float*)lds;
    *(SLAS f32x4*)(red + rs * 128 + d4 * 4) = (f32x4){a0, a1, a2, a3};
    __syncthreads();
    if (tid < 128) { float s = 0.f;
#pragma unroll
        for (int q = 0; q < 16; ++q) s += red[q * 128 + tid];
        ((float*)(wsb + WS_KMEAN))[((size_t)(b * NBLK + n) * NH + h) * 128 + tid] = s * (1.f / 256.f); }
    __syncthreads();
}
__device__ __forceinline__ void select_phase(SLAS unsigned char* lds, unsigned char* wsb, int v, int G, bool xb, unsigned* mcnt) {
    auto get = [&](int k, int& b, int& rg) { const int L = xb ? (k < 4 ? (v >> 5) * 64 + (v & 31) + 32 * (k >> 1) : 512) : v + (k >> 1) * G; b = L >> 6; rg = (k & 1) ? 127 - (L & 63) : (L & 63); return L < 512; };
    UnitIn cur, nxt; int b, rg, nb, nrg;
    if (!get(0, b, rg)) return;
    unit_load(wsb, b, rg, cur);
    for (int k = 0;; ++k) {
        const bool more = get(k + 1, nb, nrg);
        unit(lds, wsb, b, rg, cur, more, nb, nrg, nxt);
        if (mcnt) cnt_signal(mcnt + (rg >> 4));
        if (!more) break;
        cur = nxt; b = nb; rg = nrg;
    }
}
#undef SLAS
}

struct Args { const float* in[12]; float* out; unsigned char* ws; int ph_lo, ph_hi, li, pad; };
__global__ void __launch_bounds__(NWAVES * 64, 2) mega_fwd(Args args) {
    extern __shared__ __attribute__((aligned(16))) unsigned char lds[];
    Frame F;
    F.lds = (LAS unsigned char*)lds; F.MISC = (volatile LAS unsigned*)(F.lds + MISC_OFF);
    F.tid = threadIdx.x; F.lane = F.tid & 63; F.wave = __builtin_amdgcn_readfirstlane(F.tid >> 6);
    F.G = gridDim.x; { const int bx = blockIdx.x; F.vcu = (F.G % 8 == 0) ? (bx % 8) * (F.G / 8) + bx / 8 : bx; }
    unsigned char* ws = args.ws;
    F.ctl = (gu32*)(ws + WS_CTL);
    const float* x = args.in[0]; const float* c = args.in[1]; const float* w_ada = args.in[2]; const float* b_ada = args.in[3]; const float* g_norm = args.in[4];
    const float* w_in = args.in[5]; const float* w_out = args.in[11];
    float* MOD = (float*)(ws + WS_MOD); bf16_t* WinT = (bf16_t*)(ws + WS_WIN); bf16_t* HB = (bf16_t*)(ws + WS_HB); bf16_t* Y = (bf16_t*)(ws + WS_Y);
    for (int u = F.tid; u < (LDS_BYTES - LDSCTL_OFF) / 4; u += NWAVES * 64) ((LAS unsigned*)(F.lds + LDSCTL_OFF))[u] = 0u;
    __syncthreads();
    XcdBarrier bar = xcd_barrier_post((unsigned*)(F.ctl + CW_BAR) + args.li * XCD_BAR_WORDS, F.MISC + 8);
    const int lo = args.ph_lo, hi = args.ph_hi;
#define IN(k) (lo <= (k) && (k) < hi)
#define BOTH(k) (IN(k) && IN((k) + 1))
    if (IN(0)) for (int rep_ = 0; rep_ < (((PROBE_DOUBLE) >> 0) & 1) + 1; ++rep_) {
        if (rep_) __syncthreads();
        for (int id = (int)blockIdx.x; id < 256; id += F.G) p0_mod(F, id, c, w_ada, (float*)(ws + WS_MODP));
        if ((int)blockIdx.x == 192) { float* G = (float*)(ws + WS_GAIN);
            if (F.tid < 128) { G[F.tid] = args.in[6][F.tid]; G[128 + F.tid] = args.in[7][F.tid]; G[256 + F.tid] = args.in[9][F.tid]; G[384 + F.tid] = args.in[10][F.tid]; }
            if (F.tid < 64) G[512 + F.tid] = args.in[8][F.tid]; }
        p0_convert(F, w_in, w_out, WinT, ws + WS_WIN8, ws + WS_WOUT8);
    }
    int cid = (int)blockIdx.x; bool fast = false;
    if (BOTH(0)) { xcd_barrier(bar);
        const unsigned place = __builtin_amdgcn_readfirstlane(F.MISC[11]), idx = __builtin_amdgcn_readfirstlane(F.MISC[10]);
        if ((place & 16u) && F.G == 256 && idx < 32u) { fast = true; const int rank = (int)((place >> 1) & 7u); cid = (int)idx * 8 + rank; F.vcu = rank * 32 + (int)idx; } }
#define PHASE_BARRIER() do { if (fast) xcc_barrier(bar); else xcd_barrier(bar); } while (0)
    if (IN(1)) for (int rep_ = 0; rep_ < (((PROBE_DOUBLE) >> 1) & 1) + 1; ++rep_) p1_norm(F, x, g_norm, (const float*)(ws + WS_MODP), b_ada, MOD, HB, ws + WS_HB8);
    if (BOTH(1)) PHASE_BARRIER();
    if (IN(2)) for (int rep_ = 0; rep_ < (((PROBE_DOUBLE) >> 2) & 1) + 1; ++rep_) {
        const int lc_ = cid >> 3;
        { pg8::Gemm g{HB, WinT, M, 5 * 256, DM}; pg8::StaticOrder S; S.init(M, 5 * 256, F.G, cid, 16);
          if (F.G == 256) S.uneven(0, lc_ < 16 ? lc_ : 32 + (lc_ - 16), lc_ < 16 ? 2 : lc_ < 24 ? 1 : 0, 16);
          EpiProj E{ws, (LAS float*)(F.lds + EPI_OFF), 1.f};
          pg8::gemm_phase<EpiProj, pg8::StaticOrder, true, true, false>(F.lds, g, S, E); }
        if (fast) cnt_signal((unsigned*)(F.ctl + CW_QUEUE + 192) + (F.vcu >> 5));
        { pg8::Gemm g{ws + WS_HB8, ws + WS_WIN8, M, 32 * 256, DM}; pg8::StaticOrder S; S.init(M, 32 * 256, F.G, cid, 0, 16, 5); S.WGM = 4;
          if (F.G == 256) S.uneven(7, lc_ < 24 ? lc_ - 16 : 8 + (lc_ - 24), lc_ < 16 ? 0 : lc_ < 24 ? 1 : 3, 8);
          EpiProj E{ws, (LAS float*)(F.lds + EPI_OFF), FP8_DESCALE};
          pg8::gemm_phase<EpiProj, pg8::StaticOrder, true, true, true>(F.lds, g, S, E); }
        if (fast) cnt_signal((unsigned*)(F.ctl + CW_QUEUE + 200) + (F.vcu >> 5));
    }
    unsigned* const bw_ = (unsigned*)(F.ctl + CW_BAR) + args.li * XCD_BAR_WORDS;
    if (BOTH(2)) { if (fast) cnt_wait((unsigned*)(F.ctl + CW_QUEUE + 192) + (F.vcu >> 5), 32u, bw_); else xcd_barrier(bar); }
    if (IN(3)) for (int rep_ = 0; rep_ < (((PROBE_DOUBLE) >> 3) & 1) + 1; ++rep_) sel::select_phase(F.lds, ws, F.vcu, F.G, fast, fast ? (unsigned*)(F.ctl + CW_QUEUE + 128) + (F.vcu >> 5) * 8 : nullptr);
    if (BOTH(3)) { if (fast) cnt_wait((unsigned*)(F.ctl + CW_QUEUE + 200) + (F.vcu >> 5), 32u, bw_); else xcd_barrier(bar); }
    if (IN(4)) {
#pragma unroll 1
        for (int rep_ = 0; rep_ < (((PROBE_DOUBLE) >> 4) & 1) + 1; ++rep_) att::attn_phase((char*)lds, ws, F.vcu, F.G, fast ? (unsigned*)(F.ctl + CW_QUEUE + 64) + (F.vcu >> 5) * 8 : nullptr, fast ? (unsigned*)(F.ctl + CW_QUEUE + 128) + (F.vcu >> 5) * 8 : nullptr, bw_, fast ? (unsigned*)(F.ctl + CW_QUEUE + 256) + (F.vcu >> 5) * 16 : nullptr);
    }
    if (BOTH(4) && !fast) xcd_barrier(bar);
    if (IN(5)) for (int rep_ = 0; rep_ < (((PROBE_DOUBLE) >> 5) & 1) + 1; ++rep_) {
        pg8::Gemm g{ws + WS_Y8, ws + WS_WOUT8, M, DM, DM}; pg8::StaticOrder S; S.init(M, DM, F.G, cid);
        if (fast) {
            if (F.tid == 0) F.MISC[12] = __hip_atomic_fetch_add((unsigned*)(F.ctl + CW_QUEUE + 256) + (F.vcu >> 5) * 16 + 8, 1u, __ATOMIC_RELAXED, __HIP_MEMORY_SCOPE_AGENT);
            __syncthreads();
            const int o_ = (int)(F.MISC[12] & 31u), e_ = o_ & 15, p_ = (o_ < 16 ? 4 : 0) + (e_ & 3);
            S.pair((F.vcu >> 5) * 8 + p_, (e_ >> 2) * 2);
            if (F.tid == 0) { unsigned* pc_ = (unsigned*)(F.ctl + CW_QUEUE + 64) + (F.vcu >> 5) * 8 + p_;
                XB_SPIN(xb_ld(pc_) < 16u, bw_);
                __builtin_amdgcn_fence(__ATOMIC_ACQUIRE, "agent"); asm volatile("s_waitcnt vmcnt(0)" ::: "memory"); }
            __syncthreads();
        }
        EpiOut E{x, MOD, args.out, FP8_DESCALE};
        pg8::gemm_phase<EpiOut, pg8::StaticOrder, true, true, true>(F.lds, g, S, E);
    }
#undef IN
#undef BOTH
#undef PHASE_BARRIER
}

static int mega_setup() {
    static int grid = 0;
    if (grid == 0) {
        int dev = 0, cus = 0;
        if (hipGetDevice(&dev) != hipSuccess || hipDeviceGetAttribute(&cus, hipDeviceAttributeMultiprocessorCount, dev) != hipSuccess) { fprintf(stderr, "kernel_launch: device query failed\n"); grid = -1; return grid; }
        if (hipFuncSetAttribute((const void*)mega_fwd, hipFuncAttributeMaxDynamicSharedMemorySize, LDS_BYTES) != hipSuccess) { fprintf(stderr, "kernel_launch: hipFuncSetAttribute failed\n"); grid = -1; return grid; }
        (void)hipGetLastError();
        grid = cus;
    }
    return grid;
}
static void mega_launch(int grid, void* const* d_in, void* d_out, void* d_ws, int ph_lo, int ph_hi, int li, hipStream_t stream) {
    Args a{};
    for (int i = 0; i < 12; ++i) a.in[i] = (const float*)d_in[i];
    a.out = (float*)d_out; a.ws = (unsigned char*)d_ws; a.ph_lo = ph_lo; a.ph_hi = ph_hi; a.li = li;
    hipLaunchKernelGGL(mega_fwd, dim3(grid), dim3(NWAVES * 64), LDS_BYTES, stream, a);
}

extern "C" void kernel_launch(void* const* d_in, const int* in_sizes, int n_in, void* d_out, int out_size, void* d_ws, size_t ws_size, hipStream_t stream) {
    if (n_in != 12 || in_sizes[0] != M * DM || out_size != M * DM || ws_size < WS_END) {
        fprintf(stderr, "kernel_launch: unexpected shapes (n_in %d, in0 %d, out %d, ws %zu); nothing launched\n", n_in, n_in > 0 ? in_sizes[0] : -1, out_size, ws_size); return; }
    const int grid = mega_setup(); if (grid <= 0) return;
    char* ws = (char*)d_ws;
    (void)hipMemsetAsync(ws + WS_CTL, 0, CTL_ZERO_BYTES, stream);
    mega_launch(grid, d_in, d_out, d_ws, 0, 6, 0, stream);
#if PROBE_EXTRA >= 0
    mega_launch(grid, d_in, d_out, d_ws, PROBE_EXTRA, PROBE_EXTRA + 1, 1, stream);
#endif
}
```
